# Optimizing an MI355X kernel written in HIP

```python
import math
import jax, jax.numpy as jnp
from jax import lax
import numpy as np

D_MODEL = 2048
BATCH = 2
SEQ = 4096
DEPTH = 2

GRID_W = 64
CTX_LEN = 256
EPS = 1e-6
NEG_STATE = -1e30

D_MIX = D_MODEL
H_A = 4
D_NOPE = 128
D_ROPE = 64
D_V = 128
Q_RANK = 384
KV_RANK = 128
ROPE_AXIS = D_ROPE // 2
ROPE_BASE = 10000.0
Q_BLOCK = 128
D_MLA = H_A * D_V
D_SSD = D_MIX // 4
P_B = 64
H_B = D_SSD // P_B
G_B = 2
N_B = 128
SSD_CONV = 5
SSD_CHUNK = 128
CONV_CH = D_SSD + 2 * G_B * N_B
D_MLSTM = D_MIX // 4
H_C = 4
DV_C = D_MLSTM // H_C
DQK_C = DV_C // 2
MLSTM_CHUNK = 128
D_S5 = D_MIX - D_MLA - D_SSD - D_MLSTM
S5_GROUP = 16
G_S5 = D_S5 // S5_GROUP
P_S5 = 64
A_COLS = Q_RANK + KV_RANK + D_ROPE
B_COLS = D_SSD + CONV_CH + 2 * H_B
C_COLS = 2 * H_C * DQK_C + 2 * D_MLSTM + 4 * H_C
D_COLS = D_S5
N_IN = A_COLS + B_COLS + C_COLS + D_COLS
N_GROUPS = 4
EXPERTS_PER_GROUP = 8
N_EXPERTS = N_GROUPS * EXPERTS_PER_GROUP
TOP_K = 2
D_EXPERT = 512
MOE_BLOCK = 128

kernel_name = "hybrid_parallel_heads_diffusion_block"

F32 = jnp.float32


def rmsnorm(x, w=None):
    xf = x.astype(F32)
    y = xf * lax.rsqrt(jnp.mean(xf * xf, axis=-1, keepdims=True) + EPS)
    if w is not None:
        y = y * w.astype(F32)
    return y.astype(x.dtype)


def flip(t):
    return jnp.flip(t, axis=1)


def axial_rope_tables(L):
    pos = jnp.arange(L)
    row = (pos // GRID_W).astype(F32)
    col = (pos % GRID_W).astype(F32)
    inv_freq = ROPE_BASE ** (-jnp.arange(ROPE_AXIS // 2, dtype=F32) * 2.0 / ROPE_AXIS)
    ang = jnp.stack([row[:, None] * inv_freq, col[:, None] * inv_freq], axis=1)
    return jnp.cos(ang), jnp.sin(ang)


def apply_rope2d(x, cos, sin):
    xs = x.astype(F32).reshape(x.shape[:-1] + (2, 2, ROPE_AXIS // 2))
    x1, x2 = xs[..., 0, :], xs[..., 1, :]
    c = cos[None, :, None]
    s = sin[None, :, None]
    out = jnp.stack([x1 * c - x2 * s, x1 * s + x2 * c], axis=-2)
    return out.reshape(x.shape).astype(x.dtype)


def block_attention(q_nope, q_rope, k_nope, k_rope, v):
    B, Lq, H, _ = q_nope.shape
    nb = Lq // Q_BLOCK
    scale = (D_NOPE + D_ROPE) ** -0.5

    def to_blocks(t):
        return t.reshape((B, nb, Q_BLOCK) + t.shape[2:]).swapaxes(0, 1)

    def one_block(qb):
        qn, qr = qb
        s = jnp.einsum('bqhd,bkhd->bhqk', qn, k_nope) + jnp.einsum('bqhd,bkd->bhqk', qr, k_rope)
        p = jax.nn.softmax(s.astype(F32) * scale, axis=-1).astype(v.dtype)
        return jnp.einsum('bhqk,bkhd->bqhd', p, v)

    out = lax.map(one_block, (to_blocks(q_nope), to_blocks(q_rope)))
    return out.swapaxes(0, 1).reshape(B, Lq, H, D_V)


def mla_mixer(ax, ac, q_norm_w, kv_norm_w, w_uq, w_ukv, want_ctx):
    B, L, _ = ax.shape
    cos, sin = axial_rope_tables(L)

    def project(a, rope, want_q):
        Lt = a.shape[1]
        cq, ckv, kr = jnp.split(a, [Q_RANK, Q_RANK + KV_RANK], axis=-1)
        kv = (rmsnorm(ckv, kv_norm_w) @ w_ukv).reshape(B, Lt, H_A, D_NOPE + D_V)
        k_nope, v = kv[..., :D_NOPE], kv[..., D_NOPE:]
        k_rope = kr[:, :, None, :]
        if rope:
            k_rope = apply_rope2d(k_rope, cos, sin)
        k_rope = k_rope[:, :, 0]
        if not want_q:
            return None, None, k_nope, k_rope, v
        q = (rmsnorm(cq, q_norm_w) @ w_uq).reshape(B, Lt, H_A, D_NOPE + D_ROPE)
        q_nope, q_rope = q[..., :D_NOPE], q[..., D_NOPE:]
        if rope:
            q_rope = apply_rope2d(q_rope, cos, sin)
        return q_nope, q_rope, k_nope, k_rope, v

    qn_c, qr_c, kn_c, kr_c, v_c = project(ac, False, want_ctx)
    qn_x, qr_x, kn_x, kr_x, v_x = project(ax, True, True)
    kn = jnp.concatenate([kn_x, kn_c], axis=1)
    kr = jnp.concatenate([kr_x, kr_c], axis=1)
    vv = jnp.concatenate([v_x, v_c], axis=1)
    y_x = rmsnorm(block_attention(qn_x, qr_x, kn, kr, vv).reshape(B, L, D_MLA))
    y_c = None
    if want_ctx:
        y_c = rmsnorm(block_attention(qn_c, qr_c, kn_c, kr_c, v_c).reshape(B, ac.shape[1], D_MLA))
    return y_x, y_c


def centred_depthwise_conv(x, w, b):
    C = x.shape[-1]
    K = w.shape[0]
    y = lax.conv_general_dilated(x, w[:, None, :], window_strides=(1,),
                                 padding=[((K - 1) // 2, (K - 1) // 2)],
                                 dimension_numbers=('NWC', 'WIO', 'NWC'),
                                 feature_group_count=C)
    return y + b


def ssd_chunked(x, dt, A, Bm, Cm, h0, want_y):
    B, L, H, P = x.shape
    nc = L // SSD_CHUNK
    rep = H // Bm.shape[2]
    Bh = jnp.repeat(Bm, rep, axis=2).reshape(B, nc, SSD_CHUNK, H, -1)
    Ch = jnp.repeat(Cm, rep, axis=2).reshape(B, nc, SSD_CHUNK, H, -1)
    xc = x.reshape(B, nc, SSD_CHUNK, H, P)
    dtc = dt.reshape(B, nc, SSD_CHUNK, H)
    acum = jnp.cumsum(dtc * A, axis=2)
    a_tot = acum[:, :, -1]
    w_end = jnp.exp(a_tot[:, :, None] - acum) * dtc
    s_loc = jnp.einsum('bcqh,bcqhn,bcqhp->bchpn', w_end, Bh, xc)

    def step(h, inp):
        s, dec = inp
        return jnp.exp(dec)[:, :, None, None] * h + s, h

    h_fin, h_start = lax.scan(step, h0, (s_loc.swapaxes(0, 1), a_tot.swapaxes(0, 1)))
    if not want_y:
        return None, h_fin
    h_start = h_start.swapaxes(0, 1)
    causal = jnp.tril(jnp.ones((SSD_CHUNK, SSD_CHUNK), dtype=bool))
    seg = acum[:, :, :, None, :] - acum[:, :, None, :, :]
    decay = jnp.exp(jnp.where(causal[None, None, :, :, None], seg, -jnp.inf))
    scores = jnp.einsum('bcihn,bcjhn->bcijh', Ch, Bh) * decay
    y = (jnp.einsum('bcijh,bcjh,bcjhp->bcihp', scores, dtc, xc)
         + jnp.exp(acum)[..., None] * jnp.einsum('bcihn,bchpn->bcihp', Ch, h_start))
    return y.reshape(B, L, H, P), h_fin


def ssd_mixer(bx, bc, conv_w, conv_b, a_log, dt_bias, d_skip, want_ctx):
    A = -jnp.exp(a_log.astype(F32))
    dtb = dt_bias.astype(F32)
    dsk = d_skip.astype(F32)

    def prep(b):
        Bt, Lt, _ = b.shape
        z, xbc, dt = jnp.split(b, [D_SSD, D_SSD + CONV_CH], axis=-1)
        xbc = jax.nn.silu(centred_depthwise_conv(xbc, conv_w, conv_b)).astype(F32)
        xs, Bm, Cm = jnp.split(xbc, [D_SSD, D_SSD + G_B * N_B], axis=-1)
        xs = xs.reshape(Bt, Lt, H_B, P_B)
        Bm = Bm.reshape(Bt, Lt, G_B, N_B)
        Cm = Cm.reshape(Bt, Lt, G_B, N_B)
        dt = jax.nn.softplus(dt.astype(F32).reshape(Bt, Lt, 2, H_B) + dtb)
        return z, xs, Bm, Cm, dt[:, :, 0], dt[:, :, 1]

    def run(b, h0f, h0b, want_y):
        z, xs, Bm, Cm, dtf, dtbk = prep(b)
        yf, hf = ssd_chunked(xs, dtf, A[0], Bm, Cm, h0f, want_y)
        yb, hb = ssd_chunked(flip(xs), flip(dtbk), A[1], flip(Bm), flip(Cm), h0b, want_y)
        if not want_y:
            return None, hf, hb
        y = yf + flip(yb) + dsk[:, None] * xs
        y = y.reshape(b.shape[0], b.shape[1], D_SSD) * jax.nn.silu(z.astype(F32))
        return rmsnorm(y), hf, hb

    h0 = jnp.zeros((bc.shape[0], H_B, P_B, N_B), F32)
    y_c, hf_c, hb_c = run(bc, h0, h0, want_ctx)
    y_x, _, _ = run(bx, hf_c, hb_c, True)
    return y_x, y_c


def mlstm_chunked(q, k, v, log_i, log_f, state0, want_y):
    B, L, H, _ = q.shape
    nc = L // MLSTM_CHUNK

    def chunks(t):
        return t.reshape((B, nc, MLSTM_CHUNK) + t.shape[2:]).swapaxes(0, 1)

    causal = jnp.tril(jnp.ones((MLSTM_CHUNK, MLSTM_CHUNK), dtype=bool))[None, :, :, None]

    def step(carry, inp):
        C, n, m = carry
        qc, kc, vc, li, lf = inp
        b = jnp.cumsum(lf, axis=1)
        g = b[:, -1]
        w_log = g[:, None] - b + li
        m_new = jnp.maximum(g + m, jnp.max(w_log, axis=1))
        wj = jnp.exp(w_log - m_new[:, None])
        dec = jnp.exp(g + m - m_new)
        C_new = dec[:, :, None, None] * C + jnp.einsum('bjh,bjhv,bjhk->bhvk', wj, vc, kc)
        n_new = dec[:, :, None] * n + jnp.einsum('bjh,bjhk->bhk', wj, kc)
        if not want_y:
            return (C_new, n_new, m_new), None
        dmat = jnp.where(causal, b[:, :, None] - b[:, None] + li[:, None], -jnp.inf)
        inter_log = b + m[:, None]
        m_row = jnp.maximum(inter_log, jnp.max(dmat, axis=2))
        s = jnp.einsum('bihk,bjhk->bijh', qc, kc) * jnp.exp(dmat - m_row[:, :, None])
        w_inter = jnp.exp(inter_log - m_row)
        num = jnp.einsum('bijh,bjhv->bihv', s, vc) + w_inter[..., None] * jnp.einsum('bhvk,bihk->bihv', C, qc)
        den = jnp.sum(s, axis=2) + w_inter * jnp.einsum('bhk,bihk->bih', n, qc)
        h = num / jnp.maximum(jnp.abs(den), jnp.exp(-m_row))[..., None]
        return (C_new, n_new, m_new), h

    state, hs = lax.scan(step, state0, (chunks(q), chunks(k), chunks(v), chunks(log_i), chunks(log_f)))
    if not want_y:
        return None, state
    return hs.swapaxes(0, 1).reshape(B, L, H, v.shape[-1]), state


def mlstm_mixer(cx, cc, gate_b, want_ctx):
    gb = gate_b.astype(F32)
    o1 = H_C * DQK_C

    def prep(t):
        Bt, Lt, _ = t.shape
        q, k, v, o, g = jnp.split(t, [o1, 2 * o1, 2 * o1 + D_MLSTM, 2 * o1 + 2 * D_MLSTM], axis=-1)
        q = q.astype(F32).reshape(Bt, Lt, H_C, DQK_C) * DQK_C ** -0.5
        k = k.astype(F32).reshape(Bt, Lt, H_C, DQK_C)
        v = v.astype(F32).reshape(Bt, Lt, H_C, DV_C)
        g = g.astype(F32).reshape(Bt, Lt, 2, 2, H_C) + gb
        li = g[:, :, :, 0]
        lf = jax.nn.log_sigmoid(g[:, :, :, 1])
        return q, k, v, o, li, lf

    def run(t, s_f, s_b, want_y):
        q, k, v, o, li, lf = prep(t)
        h_f, s_f_new = mlstm_chunked(q, k, v, li[:, :, 0], lf[:, :, 0], s_f, want_y)
        h_b, s_b_new = mlstm_chunked(flip(q), flip(k), flip(v), flip(li[:, :, 1]), flip(lf[:, :, 1]), s_b, want_y)
        if not want_y:
            return None, s_f_new, s_b_new
        h = rmsnorm(h_f + flip(h_b))
        y = h.reshape(t.shape[0], t.shape[1], D_MLSTM) * jax.nn.sigmoid(o.astype(F32))
        return y, s_f_new, s_b_new

    Bt = cc.shape[0]
    s0 = (jnp.zeros((Bt, H_C, DV_C, DQK_C), F32), jnp.zeros((Bt, H_C, DQK_C), F32),
          jnp.full((Bt, H_C), NEG_STATE, F32))
    y_c, sf_c, sb_c = run(cc, s0, s0, want_ctx)
    y_x, _, _ = run(cx, sf_c, sb_c, True)
    return y_x, y_c


def s5_discretise(lam_re, lam_im, log_dt, b_re, b_im):
    lr = lam_re.astype(F32)
    lim = lam_im.astype(F32)
    dt = jnp.exp(log_dt.astype(F32))[..., None]
    mag = jnp.exp(lr * dt)
    ar = mag * jnp.cos(lim * dt)
    ai = mag * jnp.sin(lim * dt)
    den = lr * lr + lim * lim
    cr = ((ar - 1.0) * lr + ai * lim) / den
    ci = (ai * lr - (ar - 1.0) * lim) / den
    br_, bi_ = b_re.astype(F32), b_im.astype(F32)
    bbar_re = cr[..., None] * br_ - ci[..., None] * bi_
    bbar_im = cr[..., None] * bi_ + ci[..., None] * br_
    return ar, ai, bbar_re, bbar_im


def complex_linear_scan(ar, ai, ur, ui, x0r, x0i):
    ur = ur.at[:, 0].add(ar * x0r - ai * x0i)
    ui = ui.at[:, 0].add(ar * x0i + ai * x0r)
    a_r = jnp.broadcast_to(ar, ur.shape)
    a_i = jnp.broadcast_to(ai, ur.shape)

    def combine(e1, e2):
        a1r, a1i, b1r, b1i = e1
        a2r, a2i, b2r, b2i = e2
        return (a2r * a1r - a2i * a1i, a2r * a1i + a2i * a1r,
                a2r * b1r - a2i * b1i + b2r, a2r * b1i + a2i * b1r + b2i)

    _, _, xr, xi = lax.associative_scan(combine, (a_r, a_i, ur, ui), axis=1)
    return xr, xi


def s5_mixer(dx, dc, lam_re, lam_im, log_dt, b_re, b_im, c_re, c_im, d_skip, glu_w, glu_b, want_ctx):
    ar, ai, bbr, bbi = s5_discretise(lam_re, lam_im, log_dt, b_re, b_im)
    cr = c_re.astype(F32)
    ci = c_im.astype(F32)

    def drive(u, d):
        ug = u.reshape(u.shape[0], u.shape[1], G_S5, S5_GROUP)
        return jnp.einsum('blgc,gpc->blgp', ug, bbr[d]), jnp.einsum('blgc,gpc->blgp', ug, bbi[d])

    def readout(xr, xi):
        y = jnp.einsum('gcp,blgp->blgc', cr, xr) - jnp.einsum('gcp,blgp->blgc', ci, xi)
        return y.reshape(y.shape[0], y.shape[1], D_S5)

    def run(u, s0f, s0b, want_y):
        u = u.astype(F32)
        ufr, ufi = drive(u, 0)
        ubr, ubi = drive(flip(u), 1)
        xfr, xfi = complex_linear_scan(ar[0], ai[0], ufr, ufi, s0f[0], s0f[1])
        xbr, xbi = complex_linear_scan(ar[1], ai[1], ubr, ubi, s0b[0], s0b[1])
        sf = (xfr[:, -1], xfi[:, -1])
        sb = (xbr[:, -1], xbi[:, -1])
        if not want_y:
            return None, sf, sb
        y = readout(xfr, xfi) + flip(readout(xbr, xbi)) + d_skip.astype(F32) * u
        y = jax.nn.gelu(y)
        y = y * jax.nn.sigmoid(y @ glu_w.astype(F32) + glu_b.astype(F32))
        return rmsnorm(y), sf, sb

    z0 = jnp.zeros((dc.shape[0], G_S5, P_S5), F32)
    y_c, sf_c, sb_c = run(dc, (z0, z0), (z0, z0), want_ctx)
    y_x, _, _ = run(dx, sf_c, sb_c, True)
    return y_x, y_c


def hybrid_mixer(hx, hc, lp, want_ctx):
    zx = hx @ lp["w_in"]
    zc = hc @ lp["w_in"]
    cuts = [A_COLS, A_COLS + B_COLS, A_COLS + B_COLS + C_COLS]
    ax, bx, cx, dx = jnp.split(zx, cuts, axis=-1)
    ac, bc, cc, dc = jnp.split(zc, cuts, axis=-1)
    ya_x, ya_c = mla_mixer(ax, ac, lp["mla_q_norm_w"], lp["mla_kv_norm_w"], lp["mla_w_uq"], lp["mla_w_ukv"], want_ctx)
    yb_x, yb_c = ssd_mixer(bx, bc, lp["ssd_conv_w"], lp["ssd_conv_b"], lp["ssd_a_log"], lp["ssd_dt_bias"], lp["ssd_d"], want_ctx)
    yc_x, yc_c = mlstm_mixer(cx, cc, lp["mlstm_gate_b"], want_ctx)
    yd_x, yd_c = s5_mixer(dx, dc, lp["s5_lam_re"], lp["s5_lam_im"], lp["s5_log_dt"], lp["s5_b_re"], lp["s5_b_im"],
                          lp["s5_c_re"], lp["s5_c_im"], lp["s5_d"], lp["s5_glu_w"], lp["s5_glu_b"], want_ctx)

    def merge(ya, yb, yc, yd):
        y = jnp.concatenate([ya.astype(F32), yb.astype(F32), yc.astype(F32), yd.astype(F32)], axis=-1)
        y = (y * lp["out_norm_w"].astype(F32)).astype(hx.dtype)
        return y @ lp["w_out"]

    y_x = merge(ya_x, yb_x, yc_x, yd_x)
    y_c = merge(ya_c, yb_c, yc_c, yd_c) if want_ctx else None
    return y_x, y_c


def hier_moe(h, w_group, w_expert, w_gate, w_up, w_down):
    T, D = h.shape
    hf = h.astype(F32)
    g_prob = jax.nn.softmax(hf @ w_group.astype(F32), axis=-1)
    g_w, g_idx = lax.top_k(g_prob, 1)
    e_logits = (hf @ w_expert.astype(F32)).reshape(T, N_GROUPS, EXPERTS_PER_GROUP)
    e_in = jnp.take_along_axis(e_logits, g_idx[:, :, None], axis=1)[:, 0]
    e_val, e_idx = lax.top_k(e_in, TOP_K)
    weights = (g_w * jax.nn.softmax(e_val, axis=-1)).reshape(-1)
    experts = (g_idx * EXPERTS_PER_GROUP + e_idx).reshape(-1).astype(jnp.int32)
    tokens = jnp.repeat(jnp.arange(T, dtype=jnp.int32), TOP_K)
    M = T * TOP_K
    order = jnp.argsort(experts)
    se, stok, sw = experts[order], tokens[order], weights[order]
    counts = jnp.bincount(experts, length=N_EXPERTS)
    starts = jnp.cumsum(counts) - counts
    pcounts = (counts + MOE_BLOCK - 1) // MOE_BLOCK * MOE_BLOCK
    pends = jnp.cumsum(pcounts)
    pstarts = pends - pcounts
    dest = pstarts[se] + (jnp.arange(M, dtype=jnp.int32) - starts[se])
    nb = (M + N_EXPERTS * (MOE_BLOCK - 1) + MOE_BLOCK - 1) // MOE_BLOCK
    buf_tok = jnp.full((nb * MOE_BLOCK,), T, jnp.int32).at[dest].set(stok)
    buf_w = jnp.zeros((nb * MOE_BLOCK,), F32).at[dest].set(sw)
    block_e = jnp.clip(jnp.searchsorted(pends, jnp.arange(nb, dtype=jnp.int32) * MOE_BLOCK, side='right'),
                       0, N_EXPERTS - 1)
    h_pad = jnp.concatenate([h, jnp.zeros((1, D), h.dtype)], axis=0)
    xb = h_pad[buf_tok].reshape(nb, MOE_BLOCK, D)

    def expert_block(args):
        xblk, e = args
        return (jax.nn.silu(xblk @ w_gate[e]) * (xblk @ w_up[e])) @ w_down[e]

    yb = lax.map(expert_block, (xb, block_e)).reshape(nb * MOE_BLOCK, D)
    out = jnp.zeros((T + 1, D), h.dtype).at[buf_tok].add((yb * buf_w[:, None]).astype(h.dtype))
    return out[:T]


def hybrid_layer(x, ctx, mod_x, mod_c, lp, last):
    B, L, D = x.shape
    sh1, sc1, g1, sh2, sc2, g2 = [mod_x[:, i][:, None] for i in range(6)]
    csh1, csc1, cg1, csh2, csc2, cg2 = [mod_c[i] for i in range(6)]
    hx = rmsnorm(x, lp["norm1_w"]) * (1 + sc1) + sh1
    hc = rmsnorm(ctx, lp["norm1_w"]) * (1 + csc1) + csh1
    yx, yc = hybrid_mixer(hx, hc, lp, not last)
    x = x + g1 * yx
    hx2 = rmsnorm(x, lp["norm2_w"]) * (1 + sc2) + sh2
    if last:
        f = hier_moe(hx2.reshape(B * L, D), lp["moe_w_group"], lp["moe_w_expert"], lp["moe_w_gate"],
                     lp["moe_w_up"], lp["moe_w_down"])
        return x + g2 * f.reshape(B, L, D), None
    ctx = ctx + cg1 * yc
    hc2 = rmsnorm(ctx, lp["norm2_w"]) * (1 + csc2) + csh2
    Lc = ctx.shape[1]
    f = hier_moe(jnp.concatenate([hx2.reshape(B * L, D), hc2.reshape(B * Lc, D)], axis=0),
                 lp["moe_w_group"], lp["moe_w_expert"], lp["moe_w_gate"], lp["moe_w_up"], lp["moe_w_down"])
    x = x + g2 * f[:B * L].reshape(B, L, D)
    ctx = ctx + cg2 * f[B * L:].reshape(B, Lc, D)
    return x, ctx


def setup_inputs(seed: int = 0) -> dict:
    key = jax.random.key(seed)
    keys = iter(jax.random.split(key, 64))

    def nrm(shape, scale):
        return jax.random.normal(next(keys), shape, F32) * scale

    def unif(shape, lo, hi):
        return jax.random.uniform(next(keys), shape, F32, lo, hi)

    x = nrm((BATCH, SEQ, D_MODEL), 1.0)
    c = nrm((BATCH, D_MODEL), 1.0)
    ctx = nrm((BATCH, CTX_LEN, D_MODEL), 1.0)
    c_ctx = nrm((D_MODEL,), 1.0)
    mod_w = nrm((DEPTH, D_MODEL, 6 * D_MODEL), 0.5 * D_MODEL ** -0.5)
    mod_b = nrm((DEPTH, 6 * D_MODEL), 0.02)
    norm1_w = 1.0 + nrm((DEPTH, D_MODEL), 0.02)
    w_in = nrm((DEPTH, D_MODEL, N_IN), D_MODEL ** -0.5)
    mla_q_norm_w = 1.0 + nrm((DEPTH, Q_RANK), 0.02)
    mla_kv_norm_w = 1.0 + nrm((DEPTH, KV_RANK), 0.02)
    mla_w_uq = nrm((DEPTH, Q_RANK, H_A * (D_NOPE + D_ROPE)), Q_RANK ** -0.5)
    mla_w_ukv = nrm((DEPTH, KV_RANK, H_A * (D_NOPE + D_V)), KV_RANK ** -0.5)
    ssd_conv_w = nrm((DEPTH, SSD_CONV, CONV_CH), SSD_CONV ** -0.5)
    ssd_conv_b = nrm((DEPTH, CONV_CH), 0.02)
    ssd_a_log = jnp.log(unif((DEPTH, 2, H_B), 1.0, 16.0))
    dt0 = jnp.exp(unif((DEPTH, 2, H_B), math.log(1e-3), math.log(1e-1)))
    ssd_dt_bias = dt0 + jnp.log(-jnp.expm1(-dt0))
    ssd_d = 1.0 + nrm((DEPTH, H_B), 0.1)
    i_b = nrm((DEPTH, 2, 1, H_C), 0.1)
    f_b = jnp.linspace(3.0, 6.0, H_C, dtype=F32) + nrm((DEPTH, 2, 1, H_C), 0.1)
    mlstm_gate_b = jnp.concatenate([i_b, f_b], axis=2)
    s5_lam_re = -0.5 + nrm((DEPTH, 2, G_S5, P_S5), 0.01)
    s5_lam_im = math.pi * jnp.arange(P_S5, dtype=F32) + nrm((DEPTH, 2, G_S5, P_S5), 0.01)
    s5_log_dt = unif((DEPTH, 2, G_S5), math.log(1e-3), math.log(1e-1))
    s5_b_re = nrm((DEPTH, G_S5, P_S5, S5_GROUP), (2 * S5_GROUP) ** -0.5)
    s5_b_im = nrm((DEPTH, G_S5, P_S5, S5_GROUP), (2 * S5_GROUP) ** -0.5)
    s5_c_re = nrm((DEPTH, G_S5, S5_GROUP, P_S5), (2 * P_S5) ** -0.5)
    s5_c_im = nrm((DEPTH, G_S5, S5_GROUP, P_S5), (2 * P_S5) ** -0.5)
    s5_d = nrm((DEPTH, D_S5), 1.0)
    s5_glu_w = nrm((DEPTH, D_S5, D_S5), D_S5 ** -0.5)
    s5_glu_b = nrm((DEPTH, D_S5), 0.02)
    out_norm_w = 1.0 + nrm((DEPTH, D_MIX), 0.02)
    w_out = nrm((DEPTH, D_MIX, D_MODEL), D_MIX ** -0.5)
    norm2_w = 1.0 + nrm((DEPTH, D_MODEL), 0.02)
    moe_w_group = nrm((DEPTH, D_MODEL, N_GROUPS), D_MODEL ** -0.5)
    moe_w_expert = nrm((DEPTH, D_MODEL, N_EXPERTS), D_MODEL ** -0.5)
    moe_w_gate = nrm((DEPTH, N_EXPERTS, D_MODEL, D_EXPERT), D_MODEL ** -0.5)
    moe_w_up = nrm((DEPTH, N_EXPERTS, D_MODEL, D_EXPERT), D_MODEL ** -0.5)
    moe_w_down = nrm((DEPTH, N_EXPERTS, D_EXPERT, D_MODEL), D_EXPERT ** -0.5)
    final_norm_w = 1.0 + nrm((D_MODEL,), 0.02)
    return {"x": x, "c": c, "ctx": ctx, "c_ctx": c_ctx, "mod_w": mod_w, "mod_b": mod_b,
            "norm1_w": norm1_w, "w_in": w_in, "mla_q_norm_w": mla_q_norm_w, "mla_kv_norm_w": mla_kv_norm_w,
            "mla_w_uq": mla_w_uq, "mla_w_ukv": mla_w_ukv, "ssd_conv_w": ssd_conv_w, "ssd_conv_b": ssd_conv_b,
            "ssd_a_log": ssd_a_log, "ssd_dt_bias": ssd_dt_bias, "ssd_d": ssd_d, "mlstm_gate_b": mlstm_gate_b,
            "s5_lam_re": s5_lam_re, "s5_lam_im": s5_lam_im, "s5_log_dt": s5_log_dt, "s5_b_re": s5_b_re,
            "s5_b_im": s5_b_im, "s5_c_re": s5_c_re, "s5_c_im": s5_c_im, "s5_d": s5_d, "s5_glu_w": s5_glu_w,
            "s5_glu_b": s5_glu_b, "out_norm_w": out_norm_w, "w_out": w_out, "norm2_w": norm2_w,
            "moe_w_group": moe_w_group, "moe_w_expert": moe_w_expert, "moe_w_gate": moe_w_gate,
            "moe_w_up": moe_w_up, "moe_w_down": moe_w_down, "final_norm_w": final_norm_w}


def reference(x, c, ctx, c_ctx, mod_w, mod_b, norm1_w, w_in, mla_q_norm_w, mla_kv_norm_w, mla_w_uq, mla_w_ukv,
              ssd_conv_w, ssd_conv_b, ssd_a_log, ssd_dt_bias, ssd_d, mlstm_gate_b, s5_lam_re, s5_lam_im,
              s5_log_dt, s5_b_re, s5_b_im, s5_c_re, s5_c_im, s5_d, s5_glu_w, s5_glu_b, out_norm_w, w_out,
              norm2_w, moe_w_group, moe_w_expert, moe_w_gate, moe_w_up, moe_w_down, final_norm_w):
    B = x.shape[0]
    for l in range(DEPTH):
        mod_x = (jax.nn.silu(c) @ mod_w[l] + mod_b[l]).reshape(B, 6, D_MODEL)
        mod_c = (jax.nn.silu(c_ctx) @ mod_w[l] + mod_b[l]).reshape(6, D_MODEL)
        lp = {"norm1_w": norm1_w[l], "w_in": w_in[l], "mla_q_norm_w": mla_q_norm_w[l],
              "mla_kv_norm_w": mla_kv_norm_w[l], "mla_w_uq": mla_w_uq[l], "mla_w_ukv": mla_w_ukv[l],
              "ssd_conv_w": ssd_conv_w[l], "ssd_conv_b": ssd_conv_b[l], "ssd_a_log": ssd_a_log[l],
              "ssd_dt_bias": ssd_dt_bias[l], "ssd_d": ssd_d[l], "mlstm_gate_b": mlstm_gate_b[l],
              "s5_lam_re": s5_lam_re[l], "s5_lam_im": s5_lam_im[l], "s5_log_dt": s5_log_dt[l],
              "s5_b_re": s5_b_re[l], "s5_b_im": s5_b_im[l], "s5_c_re": s5_c_re[l], "s5_c_im": s5_c_im[l],
              "s5_d": s5_d[l], "s5_glu_w": s5_glu_w[l], "s5_glu_b": s5_glu_b[l], "out_norm_w": out_norm_w[l],
              "w_out": w_out[l], "norm2_w": norm2_w[l], "moe_w_group": moe_w_group[l],
              "moe_w_expert": moe_w_expert[l], "moe_w_gate": moe_w_gate[l], "moe_w_up": moe_w_up[l],
              "moe_w_down": moe_w_down[l]}
        x, ctx = hybrid_layer(x, ctx, mod_x, mod_c, lp, l == DEPTH - 1)
    return rmsnorm(x, final_norm_w)
```

```cpp
#include <hip/hip_runtime.h>
#include <stdint.h>

#define DM 2048
#define SL 4096
#define CL 256
#define TLAT 8192
#define TCTX 512
#define TTOT 8704
#define NIN 4192
#define NKEY 4352
#define ZC_CQ 0
#define ZC_CKV 384
#define ZC_KR 512
#define ZC_BZ 576
#define ZC_XBC 1088
#define ZC_DT 2112
#define ZC_MQ 2128
#define ZC_MK 2384
#define ZC_MV 2640
#define ZC_MO 3152
#define ZC_MG 3664
#define ZC_U 3680
#define CAPE 8704
#define EPSV 1e-6f
#define ACT_ROWS 21632

typedef float f32x16 __attribute__((ext_vector_type(16)));

struct P {
  const float *x, *c, *ctx, *c_ctx, *mod_w, *mod_b, *norm1_w, *w_in, *q_norm_w, *kv_norm_w, *w_uq, *w_ukv;
  const float *conv_w, *conv_b, *a_log, *dt_bias, *ssd_d, *gate_b, *lam_re, *lam_im, *log_dt, *b_re, *b_im;
  const float *c_re, *c_im, *s5_d, *glu_w, *glu_b, *out_norm_w, *w_out, *norm2_w, *w_group, *w_expert;
  const float *w_gate, *w_up, *w_down, *final_w;
  float* out;
  float *modv, *H, *X, *Z, *Aq, *Akv, *qraw, *kvraw, *Q, *Qc, *K, *V, *O;
  float *ssd_xs, *ssd_B, *ssd_C, *ssd_dt, *ssd_yf, *ssd_yb, *ml_hf, *ml_hb, *s5_rf, *s5_rb, *ydpre, *ydg, *Y;
  float *list_w, *ACT, *Yslot;
  int *cnt, *list_tok;
};

__device__ __forceinline__ int row_modidx(int r) { return r < TLAT ? (r >> 12) : 2; }
__device__ __forceinline__ float sigmoidf_(float v) { return 1.f / (1.f + expf(-v)); }
__device__ __forceinline__ float siluf_(float v) { return v / (1.f + expf(-v)); }
__device__ __forceinline__ float wave_sum(float v) {
#pragma unroll
  for (int o = 32; o; o >>= 1) v += __shfl_xor(v, o);
  return v;
}
__device__ __forceinline__ float block_sum(float v, float* red) {
  v = wave_sum(v);
  __syncthreads();
  if ((threadIdx.x & 63) == 0) red[threadIdx.x >> 6] = v;
  __syncthreads();
  return red[0] + red[1] + red[2] + red[3];
}

__device__ __forceinline__ void ph_mod(const P& p, char* smem) {
  float* sc = (float*)smem;
  float* red = sc + 3 * 2048;
  const int tid = threadIdx.x;
  if (blockIdx.x == 0 && tid < 64) p.cnt[tid] = 0;
  for (int i = tid; i < 3 * 2048; i += 256) {
    int r = i >> 11, k = i & 2047;
    float v = r < 2 ? p.c[r * 2048 + k] : p.c_ctx[k];
    sc[i] = siluf_(v);
  }
  __syncthreads();
  for (int w = blockIdx.x; w < 2 * 96; w += gridDim.x) {
    int l = w / 96, j0 = (w % 96) * 128;
    int cg = tid & 31, ks = tid >> 5;
    const float* W = p.mod_w + (size_t)l * 2048 * 12288 + j0 + cg * 4;
    float acc[3][4];
#pragma unroll
    for (int r = 0; r < 3; ++r)
#pragma unroll
      for (int c = 0; c < 4; ++c) acc[r][c] = 0.f;
#pragma unroll 4
    for (int k = ks * 256; k < ks * 256 + 256; ++k) {
      float4 wv = *(const float4*)(W + (size_t)k * 12288);
      float s0 = sc[k], s1 = sc[2048 + k], s2 = sc[4096 + k];
      acc[0][0] += s0 * wv.x; acc[0][1] += s0 * wv.y; acc[0][2] += s0 * wv.z; acc[0][3] += s0 * wv.w;
      acc[1][0] += s1 * wv.x; acc[1][1] += s1 * wv.y; acc[1][2] += s1 * wv.z; acc[1][3] += s1 * wv.w;
      acc[2][0] += s2 * wv.x; acc[2][1] += s2 * wv.y; acc[2][2] += s2 * wv.z; acc[2][3] += s2 * wv.w;
    }
    __syncthreads();
#pragma unroll
    for (int r = 0; r < 3; ++r)
#pragma unroll
      for (int c = 0; c < 4; ++c) red[(ks * 32 + cg) * 12 + r * 4 + c] = acc[r][c];
    __syncthreads();
    for (int o = tid; o < 384; o += 256) {
      int r = o >> 7, c = o & 127;
      float s = 0.f;
#pragma unroll
      for (int q = 0; q < 8; ++q) s += red[(q * 32 + (c >> 2)) * 12 + r * 4 + (c & 3)];
      s += p.mod_b[l * 12288 + j0 + c];
      p.modv[(l * 3 + r) * 12288 + j0 + c] = s;
    }
    __syncthreads();
  }
}

__device__ __forceinline__ void ph_norm1(const P& p, int layer, char* smem) {
  float* red = (float*)smem;
  const int tid = threadIdx.x;
  const float* nw = p.norm1_w + layer * 2048;
  for (int r = blockIdx.x; r < TTOT; r += gridDim.x) {
    const int mi = row_modidx(r);
    const float* mrow = p.modv + (layer * 3 + mi) * 12288;
    float v[8];
    float ss = 0.f;
#pragma unroll
    for (int hf = 0; hf < 2; ++hf) {
      int col = hf * 1024 + tid * 4;
      float4 xv;
      if (layer == 0) {
        const float* src = r < TLAT ? p.x + (size_t)r * 2048 : p.ctx + (size_t)(r - TLAT) * 2048;
        xv = *(const float4*)(src + col);
      } else {
        xv = *(const float4*)(p.X + (size_t)r * 2048 + col);
        const float* g2 = p.modv + ((layer - 1) * 3 + mi) * 12288 + 5 * 2048;
        float4 gv = *(const float4*)(g2 + col);
        float4 y0 = *(const float4*)(p.Yslot + (size_t)(2 * r) * 2048 + col);
        float4 y1 = *(const float4*)(p.Yslot + (size_t)(2 * r + 1) * 2048 + col);
        xv.x += gv.x * (y0.x + y1.x); xv.y += gv.y * (y0.y + y1.y);
        xv.z += gv.z * (y0.z + y1.z); xv.w += gv.w * (y0.w + y1.w);
        *(float4*)(p.X + (size_t)r * 2048 + col) = xv;
      }
      v[hf * 4 + 0] = xv.x; v[hf * 4 + 1] = xv.y; v[hf * 4 + 2] = xv.z; v[hf * 4 + 3] = xv.w;
      ss += xv.x * xv.x + xv.y * xv.y + xv.z * xv.z + xv.w * xv.w;
    }
    float tot = block_sum(ss, red);
    float rs = rsqrtf(tot * (1.f / 2048.f) + EPSV);
#pragma unroll
    for (int hf = 0; hf < 2; ++hf) {
      int col = hf * 1024 + tid * 4;
      float4 w4 = *(const float4*)(nw + col);
      float4 sh = *(const float4*)(mrow + col);
      float4 scv = *(const float4*)(mrow + 2048 + col);
      float4 o;
      o.x = v[hf * 4 + 0] * rs * w4.x * (1.f + scv.x) + sh.x;
      o.y = v[hf * 4 + 1] * rs * w4.y * (1.f + scv.y) + sh.y;
      o.z = v[hf * 4 + 2] * rs * w4.z * (1.f + scv.z) + sh.z;
      o.w = v[hf * 4 + 3] * rs * w4.w * (1.f + scv.w) + sh.w;
      *(float4*)(p.H + (size_t)r * 2048 + col) = o;
    }
  }
}

template <class AF, class BF, class EF>
__device__ __forceinline__ void gemm_tile(const AF& af, const BF& bf, const EF& ef, int K, char* smem) {
  float* As = (float*)smem;
  float* Bs = As + 128 * 33;
  const int tid = threadIdx.x, lane = tid & 63, wid = tid >> 6, wr = wid >> 1, wc = wid & 1;
  const int l31 = lane & 31, lh = lane >> 5;
  f32x16 acc[2][2];
#pragma unroll
  for (int i = 0; i < 2; ++i)
#pragma unroll
    for (int j = 0; j < 2; ++j)
#pragma unroll
      for (int r = 0; r < 16; ++r) acc[i][j][r] = 0.f;
  const int arl = tid >> 3, akq = (tid & 7) * 4;
  const float* ar0 = af.row(arl);
  const float* ar1 = af.row(arl + 32);
  const float* ar2 = af.row(arl + 64);
  const float* ar3 = af.row(arl + 96);
  const bool av0 = ar0 != nullptr, av1 = ar1 != nullptr, av2 = ar2 != nullptr, av3 = ar3 != nullptr;
  const float* asafe = af.safe();
  if (!av0) ar0 = asafe; if (!av1) ar1 = asafe; if (!av2) ar2 = asafe; if (!av3) ar3 = asafe;
  const float* bc = bf.col((tid & 31) * 4);
  const bool bv = bc != nullptr;
  if (!bv) bc = bf.safe();
  const int ldb = bf.ldb;
  const int bk = tid >> 5;
  float4 ra0, ra1, ra2, ra3, rb0, rb1, rb2, rb3;
  const float4 z4 = make_float4(0.f, 0.f, 0.f, 0.f);
#define GLOAD(k0)                                                        \
  {                                                                      \
    ra0 = *(const float4*)(ar0 + (k0) + akq); if (!av0) ra0 = z4;        \
    ra1 = *(const float4*)(ar1 + (k0) + akq); if (!av1) ra1 = z4;        \
    ra2 = *(const float4*)(ar2 + (k0) + akq); if (!av2) ra2 = z4;        \
    ra3 = *(const float4*)(ar3 + (k0) + akq); if (!av3) ra3 = z4;        \
    rb0 = *(const float4*)(bc + (size_t)((k0) + bk) * ldb);              \
    rb1 = *(const float4*)(bc + (size_t)((k0) + bk + 8) * ldb);          \
    rb2 = *(const float4*)(bc + (size_t)((k0) + bk + 16) * ldb);         \
    rb3 = *(const float4*)(bc + (size_t)((k0) + bk + 24) * ldb);         \
    if (!bv) { rb0 = z4; rb1 = z4; rb2 = z4; rb3 = z4; }                 \
  }
#define SWRITE_A(ps, v)                                                  \
  { float* d = As + (arl + 32 * (ps)) * 33 + akq; d[0] = v.x; d[1] = v.y; d[2] = v.z; d[3] = v.w; }
#define SWRITE()                                                         \
  {                                                                      \
    SWRITE_A(0, ra0) SWRITE_A(1, ra1) SWRITE_A(2, ra2) SWRITE_A(3, ra3)  \
    *(float4*)(Bs + (bk) * 128 + (tid & 31) * 4) = rb0;                  \
    *(float4*)(Bs + (bk + 8) * 128 + (tid & 31) * 4) = rb1;              \
    *(float4*)(Bs + (bk + 16) * 128 + (tid & 31) * 4) = rb2;             \
    *(float4*)(Bs + (bk + 24) * 128 + (tid & 31) * 4) = rb3;             \
  }
  __syncthreads();
  GLOAD(0)
  SWRITE()
  __syncthreads();
  for (int k0 = 0; k0 < K; k0 += 32) {
    const bool more = (k0 + 32) < K;
    if (more) GLOAD(k0 + 32)
    const float* ap = As + (wr * 64 + l31) * 33 + lh;
    const float* bp = Bs + lh * 128 + wc * 64 + l31;
#pragma unroll
    for (int kk = 0; kk < 16; ++kk) {
      float a0 = ap[2 * kk], a1 = ap[32 * 33 + 2 * kk];
      float b0 = bp[2 * kk * 128], b1 = bp[2 * kk * 128 + 32];
      acc[0][0] = __builtin_amdgcn_mfma_f32_32x32x2f32(a0, b0, acc[0][0], 0, 0, 0);
      acc[0][1] = __builtin_amdgcn_mfma_f32_32x32x2f32(a0, b1, acc[0][1], 0, 0, 0);
      acc[1][0] = __builtin_amdgcn_mfma_f32_32x32x2f32(a1, b0, acc[1][0], 0, 0, 0);
      acc[1][1] = __builtin_amdgcn_mfma_f32_32x32x2f32(a1, b1, acc[1][1], 0, 0, 0);
    }
    __syncthreads();
    if (more) SWRITE()
    __syncthreads();
  }
  ef(acc, wr, wc, lane);
}
#define ACC_ROW(wr, i, r, lane) ((wr) * 64 + (i) * 32 + ((r) & 3) + 8 * ((r) >> 2) + 4 * ((lane) >> 5))
#define ACC_COL(wc, j, lane) ((wc) * 64 + (j) * 32 + ((lane) & 31))

struct ARows { const float* base; int ld; int m0; int M;
  __device__ __forceinline__ const float* row(int r) const { int g = m0 + r; return g < M ? base + (size_t)g * ld : nullptr; }
  __device__ __forceinline__ const float* safe() const { return base; } };
struct BPlain { const float* B; int ldb; int n0; int N;
  __device__ __forceinline__ const float* col(int v) const { int n = n0 + v; return n < N ? B + n : nullptr; }
  __device__ __forceinline__ const float* safe() const { return B; } };

template <class EPI>
__device__ __forceinline__ void gemm_dense(const float* A, int lda, const float* B, int ldb, int M, int N, int K, const EPI& epi, char* smem) {
  const int mt = (M + 127) >> 7, nt = (N + 127) >> 7;
  for (int w = blockIdx.x; w < mt * nt; w += gridDim.x) {
    const int m0 = (w / nt) * 128, n0 = (w % nt) * 128;
    ARows af{A, lda, m0, M};
    BPlain bf{B, ldb, n0, N};
    auto ef = [&](const f32x16 (&acc)[2][2], int wr, int wc, int lane) {
#pragma unroll
      for (int i = 0; i < 2; ++i)
#pragma unroll
        for (int j = 0; j < 2; ++j)
#pragma unroll
          for (int r = 0; r < 16; ++r) {
            int row = m0 + ACC_ROW(wr, i, r, lane), col = n0 + ACC_COL(wc, j, lane);
            if (row < M && col < N) epi(row, col, acc[i][j][r]);
          }
    };
    gemm_tile(af, bf, ef, K, smem);
  }
}

__device__ __forceinline__ void ph_win(const P& p, int layer, char* smem) {
  float* Z = p.Z;
  auto epi = [=](int row, int col, float v) { Z[(size_t)row * NIN + col] = v; };
  gemm_dense(p.H, 2048, p.w_in + (size_t)layer * 2048 * NIN, NIN, TTOT, NIN, 2048, epi, smem);
}

__device__ __forceinline__ void ph_prep(const P& p, int layer, char* smem) {
  const int tid = threadIdx.x, lane = tid & 63, wid = tid >> 6;
  for (int r = blockIdx.x * 4 + wid; r < TTOT; r += gridDim.x * 4) {
    const float* z = p.Z + (size_t)r * NIN;
    float q[6]; float ss = 0.f;
#pragma unroll
    for (int i = 0; i < 6; ++i) { q[i] = z[ZC_CQ + i * 64 + lane]; ss += q[i] * q[i]; }
    ss = wave_sum(ss);
    float rs = rsqrtf(ss * (1.f / 384.f) + EPSV);
#pragma unroll
    for (int i = 0; i < 6; ++i) p.Aq[(size_t)r * 384 + i * 64 + lane] = q[i] * rs * p.q_norm_w[layer * 384 + i * 64 + lane];
    float k0 = z[ZC_CKV + lane], k1 = z[ZC_CKV + 64 + lane];
    float s2 = wave_sum(k0 * k0 + k1 * k1);
    float rs2 = rsqrtf(s2 * (1.f / 128.f) + EPSV);
    p.Akv[(size_t)r * 128 + lane] = k0 * rs2 * p.kv_norm_w[layer * 128 + lane];
    p.Akv[(size_t)r * 128 + 64 + lane] = k1 * rs2 * p.kv_norm_w[layer * 128 + 64 + lane];
  }
  const float* cw = p.conv_w + layer * 5 * 1024;
  const float* cb = p.conv_b + layer * 1024;
  for (int r = blockIdx.x; r < TTOT; r += gridDim.x) {
    int base, len;
    if (r < TLAT) { base = (r >> 12) << 12; len = SL; } else { base = TLAT + (((r - TLAT) >> 8) << 8); len = CL; }
    const int t = r - base;
    const int ch = tid * 4;
    float4 acc = *(const float4*)(cb + ch);
#pragma unroll
    for (int k = 0; k < 5; ++k) {
      int tt = t + k - 2;
      if (tt >= 0 && tt < len) {
        float4 xv = *(const float4*)(p.Z + (size_t)(base + tt) * NIN + ZC_XBC + ch);
        float4 wv = *(const float4*)(cw + k * 1024 + ch);
        acc.x += xv.x * wv.x; acc.y += xv.y * wv.y; acc.z += xv.z * wv.z; acc.w += xv.w * wv.w;
      }
    }
    acc.x = siluf_(acc.x); acc.y = siluf_(acc.y); acc.z = siluf_(acc.z); acc.w = siluf_(acc.w);
    if (ch < 512) *(float4*)(p.ssd_xs + (size_t)r * 512 + ch) = acc;
    else if (ch < 768) *(float4*)(p.ssd_B + (size_t)r * 256 + (ch - 512)) = acc;
    else *(float4*)(p.ssd_C + (size_t)r * 256 + (ch - 768)) = acc;
    if (tid < 16) {
      float v = p.Z[(size_t)r * NIN + ZC_DT + tid] + p.dt_bias[layer * 16 + tid];
      float sp = v > 20.f ? v : log1pf(expf(v));
      p.ssd_dt[(size_t)r * 16 + tid] = sp;
    }
  }
}

__device__ __forceinline__ void ph_qkv(const P& p, int layer, char* smem) {
  float* qraw = p.qraw; float* kvraw = p.kvraw;
  auto e1 = [=](int row, int col, float v) { qraw[(size_t)row * 768 + col] = v; };
  gemm_dense(p.Aq, 384, p.w_uq + (size_t)layer * 384 * 768, 768, TTOT, 768, 384, e1, smem);
  auto e2 = [=](int row, int col, float v) { kvraw[(size_t)row * 1024 + col] = v; };
  gemm_dense(p.Akv, 128, p.w_ukv + (size_t)layer * 128 * 1024, 1024, TTOT, 1024, 128, e2, smem);
}

__device__ __forceinline__ void ph_mlapost(const P& p, int layer, char* smem) {
  const int tid = threadIdx.x;
  const float qscale = 0.07216878364870322f;
  for (int r = blockIdx.x; r < TTOT; r += gridDim.x) {
    const bool lat = r < TLAT;
    int b, pos;
    if (lat) { b = r >> 12; pos = r & 4095; } else { b = (r - TLAT) >> 8; pos = (r - TLAT) & 255; }
    const int kpos = lat ? pos : SL + pos;
    const float* qr = p.qraw + (size_t)r * 768;
    const float* kv = p.kvraw + (size_t)r * 1024;
    const float* zr = p.Z + (size_t)r * NIN + ZC_KR;
    const float frow = (float)(pos >> 6), fcol = (float)(pos & 63);
    for (int i = tid; i < 768; i += 256) {
      int h = i / 192, d = i % 192;
      float v;
      if (d < 128 || !lat) v = qr[i];
      else {
        int e = d - 128, a = e >> 5, half = (e >> 4) & 1, f = e & 15;
        float x1 = qr[h * 192 + 128 + a * 32 + f], x2 = qr[h * 192 + 128 + a * 32 + 16 + f];
        float invf = powf(10000.f, -(float)f * (1.f / 16.f));
        float ang = (a == 0 ? frow : fcol) * invf;
        float cs = cosf(ang), sn = sinf(ang);
        v = half == 0 ? x1 * cs - x2 * sn : x1 * sn + x2 * cs;
      }
      v *= qscale;
      if (lat) p.Q[((size_t)(b * 4 + h) * SL + pos) * 192 + d] = v;
      else p.Qc[((size_t)(b * 4 + h) * CL + pos) * 192 + d] = v;
    }
    for (int i = tid; i < 768; i += 256) {
      int h = i / 192, d = i % 192;
      float v;
      if (d < 128) v = kv[h * 256 + d];
      else {
        int e = d - 128;
        if (!lat) v = zr[e];
        else {
          int a = e >> 5, half = (e >> 4) & 1, f = e & 15;
          float x1 = zr[a * 32 + f], x2 = zr[a * 32 + 16 + f];
          float invf = powf(10000.f, -(float)f * (1.f / 16.f));
          float ang = (a == 0 ? frow : fcol) * invf;
          float cs = cosf(ang), sn = sinf(ang);
          v = half == 0 ? x1 * cs - x2 * sn : x1 * sn + x2 * cs;
        }
      }
      p.K[((size_t)(b * 4 + h) * NKEY + kpos) * 192 + d] = v;
    }
    for (int i = tid; i < 512; i += 256) {
      int h = i >> 7, d = i & 127;
      p.V[((size_t)(b * 4 + h) * NKEY + kpos) * 128 + d] = kv[h * 256 + 128 + d];
    }
  }
}

__device__ __forceinline__ void attn_item(const float* __restrict__ Qp, const float* __restrict__ Kp, const float* __restrict__ Vp, int nk,
                          float* __restrict__ Op, char* smem) {
  float* Ks = (float*)smem;
  float* Vs = Ks + 32 * 193;
  const int tid = threadIdx.x, lane = tid & 63, wid = tid >> 6, l31 = lane & 31, lh = lane >> 5;
  float qf[96];
  {
    const float* qrow = Qp + (size_t)(wid * 32 + l31) * 192 + lh;
#pragma unroll
    for (int s8 = 0; s8 < 12; ++s8)
#pragma unroll
      for (int s1 = 0; s1 < 8; ++s1) qf[s8 * 8 + s1] = qrow[2 * (s8 * 8 + s1)];
  }
  f32x16 o[4];
#pragma unroll
  for (int d = 0; d < 4; ++d)
#pragma unroll
    for (int r = 0; r < 16; ++r) o[d][r] = 0.f;
  float m = -INFINITY, l = 0.f;
  for (int kt = 0; kt < nk; kt += 32) {
    __syncthreads();
    for (int i = tid; i < 1536; i += 256) {
      int key = i / 48, c4 = i % 48;
      float4 v = *(const float4*)(Kp + (size_t)(kt + key) * 192 + c4 * 4);
      float* d = Ks + key * 193 + c4 * 4;
      d[0] = v.x; d[1] = v.y; d[2] = v.z; d[3] = v.w;
    }
    for (int i = tid; i < 1024; i += 256) {
      int key = i >> 5, c4 = i & 31;
      *(float4*)(Vs + key * 128 + c4 * 4) = *(const float4*)(Vp + (size_t)(kt + key) * 128 + c4 * 4);
    }
    __syncthreads();
    f32x16 s;
#pragma unroll
    for (int r = 0; r < 16; ++r) s[r] = 0.f;
    const float* kp = Ks + l31 * 193 + lh;
#pragma unroll
    for (int s8 = 0; s8 < 12; ++s8)
#pragma unroll
      for (int s1 = 0; s1 < 8; ++s1)
        s = __builtin_amdgcn_mfma_f32_32x32x2f32(kp[2 * (s8 * 8 + s1)], qf[s8 * 8 + s1], s, 0, 0, 0);
    float tmax = s[0];
#pragma unroll
    for (int r = 1; r < 16; ++r) tmax = fmaxf(tmax, s[r]);
    tmax = fmaxf(tmax, __shfl_xor(tmax, 32));
    float mn = fmaxf(m, tmax);
    float alpha = expf(m - mn);
    float rs = 0.f;
#pragma unroll
    for (int r = 0; r < 16; ++r) { s[r] = expf(s[r] - mn); rs += s[r]; }
    rs += __shfl_xor(rs, 32);
    l = l * alpha + rs;
    m = mn;
#pragma unroll
    for (int d = 0; d < 4; ++d)
#pragma unroll
      for (int r = 0; r < 16; ++r) o[d][r] *= alpha;
#pragma unroll
    for (int r = 0; r < 16; ++r) {
      const int key = (r & 3) + 8 * (r >> 2) + 4 * lh;
      const float* vp = Vs + key * 128 + l31;
#pragma unroll
      for (int d = 0; d < 4; ++d) o[d] = __builtin_amdgcn_mfma_f32_32x32x2f32(vp[d * 32], s[r], o[d], 0, 0, 0);
    }
  }
  const float inv = 1.f / l;
  float* orow = Op + (size_t)(wid * 32 + l31) * 512;
#pragma unroll
  for (int d = 0; d < 4; ++d)
#pragma unroll
    for (int r = 0; r < 16; ++r) orow[d * 32 + (r & 3) + 8 * (r >> 2) + 4 * lh] = o[d][r] * inv;
}

__device__ __forceinline__ void ssd_item(const P& p, int layer, int item, char* smem) {
  const int pq = item & 3, h = (item >> 2) & 7, dir = (item >> 5) & 1, b = item >> 6;
  float* sdt = (float*)smem;
  float* sx = sdt + 32;
  float* sB = sx + 32 * 16;
  float* sC = sB + 32 * 128;
  const int tid = threadIdx.x, pl = tid >> 4, nc = tid & 15;
  const float A = -expf(p.a_log[layer * 16 + dir * 8 + h]);
  const int g = h >> 2;
  float hs[8];
#pragma unroll
  for (int j = 0; j < 8; ++j) hs[j] = 0.f;
  float* yout = dir ? p.ssd_yb : p.ssd_yf;
  for (int seg = 0; seg < 2; ++seg) {
    const int base = seg == 0 ? TLAT + b * CL : b * SL;
    const int len = seg == 0 ? CL : SL;
    for (int c0 = 0; c0 < len; c0 += 32) {
      __syncthreads();
      if (tid < 32) {
        int row = dir ? base + len - 1 - (c0 + tid) : base + c0 + tid;
        sdt[tid] = p.ssd_dt[(size_t)row * 16 + dir * 8 + h];
      }
      for (int i = tid; i < 512; i += 256) {
        int st = i >> 4, pp = i & 15;
        int row = dir ? base + len - 1 - (c0 + st) : base + c0 + st;
        sx[i] = p.ssd_xs[(size_t)row * 512 + h * 64 + pq * 16 + pp];
      }
      for (int i = tid; i < 4096; i += 256) {
        int st = i >> 7, n = i & 127;
        int row = dir ? base + len - 1 - (c0 + st) : base + c0 + st;
        sB[i] = p.ssd_B[(size_t)row * 256 + g * 128 + n];
        sC[i] = p.ssd_C[(size_t)row * 256 + g * 128 + n];
      }
      __syncthreads();
      for (int st = 0; st < 32; ++st) {
        const float dt = sdt[st];
        const float dA = expf(dt * A);
        const float xv = sx[st * 16 + pl] * dt;
        float y = 0.f;
#pragma unroll
        for (int j = 0; j < 8; ++j) {
          const int n = j * 16 + nc;
          hs[j] = dA * hs[j] + xv * sB[st * 128 + n];
          y += hs[j] * sC[st * 128 + n];
        }
        y += __shfl_xor(y, 1); y += __shfl_xor(y, 2); y += __shfl_xor(y, 4); y += __shfl_xor(y, 8);
        if (nc == 0) {
          int row = dir ? base + len - 1 - (c0 + st) : base + c0 + st;
          yout[(size_t)row * 512 + h * 64 + pq * 16 + pl] = y;
        }
      }
    }
  }
}

__device__ __forceinline__ void mlstm_item(const P& p, int layer, int item, char* smem) {
  const int vq = item & 3, h = (item >> 2) & 3, dir = (item >> 4) & 1, b = item >> 5;
  float* sq = (float*)smem;
  float* sk = sq + 32 * 64;
  float* sv = sk + 32 * 64;
  float* sf = sv + 32 * 32;
  float* si = sf + 32;
  const int tid = threadIdx.x, vl = tid >> 3, kc = tid & 7;
  const float bi = p.gate_b[layer * 16 + dir * 8 + h], bfv = p.gate_b[layer * 16 + dir * 8 + 4 + h];
  float Cs[8], ns[8];
#pragma unroll
  for (int j = 0; j < 8; ++j) { Cs[j] = 0.f; ns[j] = 0.f; }
  float* hout = dir ? p.ml_hb : p.ml_hf;
  for (int seg = 0; seg < 2; ++seg) {
    const int base = seg == 0 ? TLAT + b * CL : b * SL;
    const int len = seg == 0 ? CL : SL;
    for (int c0 = 0; c0 < len; c0 += 32) {
      __syncthreads();
      for (int i = tid; i < 2048; i += 256) {
        int st = i >> 6, k = i & 63;
        int row = dir ? base + len - 1 - (c0 + st) : base + c0 + st;
        const float* z = p.Z + (size_t)row * NIN;
        sq[i] = z[ZC_MQ + h * 64 + k] * 0.125f;
        sk[i] = z[ZC_MK + h * 64 + k];
      }
      for (int i = tid; i < 1024; i += 256) {
        int st = i >> 5, vv = i & 31;
        int row = dir ? base + len - 1 - (c0 + st) : base + c0 + st;
        sv[i] = p.Z[(size_t)row * NIN + ZC_MV + h * 128 + vq * 32 + vv];
      }
      if (tid < 32) {
        int row = dir ? base + len - 1 - (c0 + tid) : base + c0 + tid;
        const float* z = p.Z + (size_t)row * NIN + ZC_MG + dir * 8;
        si[tid] = expf(z[h] + bi);
        sf[tid] = sigmoidf_(z[4 + h] + bfv);
      }
      __syncthreads();
      for (int st = 0; st < 32; ++st) {
        const float f = sf[st], ig = si[st];
        const float vv = sv[st * 32 + vl] * ig;
        float num = 0.f, den = 0.f;
#pragma unroll
        for (int j = 0; j < 8; ++j) {
          const int k = j * 8 + kc;
          const float kk = sk[st * 64 + k], qq = sq[st * 64 + k];
          Cs[j] = f * Cs[j] + vv * kk;
          ns[j] = f * ns[j] + ig * kk;
          num += Cs[j] * qq;
          den += ns[j] * qq;
        }
        num += __shfl_xor(num, 1); num += __shfl_xor(num, 2); num += __shfl_xor(num, 4);
        den += __shfl_xor(den, 1); den += __shfl_xor(den, 2); den += __shfl_xor(den, 4);
        if (kc == 0) {
          int row = dir ? base + len - 1 - (c0 + st) : base + c0 + st;
          hout[(size_t)row * 512 + h * 128 + vq * 32 + vl] = num / fmaxf(fabsf(den), 1.f);
        }
      }
    }
  }
}

__device__ __forceinline__ void s5_item(const P& p, int layer, int item, char* smem) {
  const int g = item & 31, dir = (item >> 5) & 1, b = item >> 6;
  float* sxr = (float*)smem;
  float* sxi = sxr + 64 * 65;
  float* su = sxi + 64 * 65;
  float* scr = su + 64 * 16;
  float* sci = scr + 16 * 64;
  const int tid = threadIdx.x, sp = tid & 63, tq = tid >> 6;
  const int dg = (layer * 2 + dir) * 32 + g;
  const float lr = p.lam_re[dg * 64 + sp], li = p.lam_im[dg * 64 + sp];
  const float dt = expf(p.log_dt[dg]);
  const float mag = expf(lr * dt);
  const float ar = mag * cosf(li * dt), ai = mag * sinf(li * dt);
  const float den = lr * lr + li * li;
  const float cr_ = ((ar - 1.f) * lr + ai * li) / den;
  const float ci_ = (ai * lr - (ar - 1.f) * li) / den;
  float bbr[16], bbi[16];
#pragma unroll
  for (int c = 0; c < 16; ++c) {
    float br = p.b_re[((size_t)(layer * 32 + g) * 64 + sp) * 16 + c];
    float bim = p.b_im[((size_t)(layer * 32 + g) * 64 + sp) * 16 + c];
    bbr[c] = cr_ * br - ci_ * bim;
    bbi[c] = cr_ * bim + ci_ * br;
  }
  __syncthreads();
  for (int i = tid; i < 1024; i += 256) {
    scr[i] = p.c_re[(size_t)(layer * 32 + g) * 1024 + i];
    sci[i] = p.c_im[(size_t)(layer * 32 + g) * 1024 + i];
  }
  float xr = 0.f, xi = 0.f;
  float* rout = dir ? p.s5_rb : p.s5_rf;
  for (int seg = 0; seg < 2; ++seg) {
    const int base = seg == 0 ? TLAT + b * CL : b * SL;
    const int len = seg == 0 ? CL : SL;
    for (int c0 = 0; c0 < len; c0 += 64) {
      __syncthreads();
      for (int i = tid; i < 1024; i += 256) {
        int st = i >> 4, c = i & 15;
        int row = dir ? base + len - 1 - (c0 + st) : base + c0 + st;
        su[i] = p.Z[(size_t)row * NIN + ZC_U + g * 16 + c];
      }
      __syncthreads();
      for (int tt = 0; tt < 16; ++tt) {
        const int t = tq * 16 + tt;
        float ur = 0.f, ui = 0.f;
#pragma unroll
        for (int c = 0; c < 16; ++c) { float uu = su[t * 16 + c]; ur += bbr[c] * uu; ui += bbi[c] * uu; }
        sxr[t * 65 + sp] = ur; sxi[t * 65 + sp] = ui;
      }
      __syncthreads();
      if (tq == 0) {
        for (int t = 0; t < 64; ++t) {
          float ur = sxr[t * 65 + sp], ui = sxi[t * 65 + sp];
          float nr = ar * xr - ai * xi + ur;
          float ni = ar * xi + ai * xr + ui;
          xr = nr; xi = ni;
          sxr[t * 65 + sp] = xr; sxi[t * 65 + sp] = xi;
        }
      }
      __syncthreads();
      {
        const int t = sp;
        const int row = dir ? base + len - 1 - (c0 + t) : base + c0 + t;
#pragma unroll
        for (int cc = 0; cc < 4; ++cc) {
          const int c = tq * 4 + cc;
          float y = 0.f;
          for (int pp = 0; pp < 64; ++pp) y += scr[c * 64 + pp] * sxr[t * 65 + pp] - sci[c * 64 + pp] * sxi[t * 65 + pp];
          rout[(size_t)row * 512 + g * 16 + c] = y;
        }
      }
    }
  }
}

#define N_SSD_ITEMS 128
#define N_ML_ITEMS 64
#define N_S5_ITEMS 128
#define N_ATT_LAT 256
#define N_ATT_CTX 16
__device__ __forceinline__ void ph_mix(const P& p, int layer, char* smem) {
  const int nitems = N_S5_ITEMS + N_SSD_ITEMS + N_ML_ITEMS + N_ATT_LAT + (layer == 0 ? N_ATT_CTX : 0);
  for (int w = blockIdx.x; w < nitems; w += gridDim.x) {
    int it = w;
    if (it < N_S5_ITEMS) { s5_item(p, layer, it, smem); continue; }
    it -= N_S5_ITEMS;
    if (it < N_SSD_ITEMS) { ssd_item(p, layer, it, smem); continue; }
    it -= N_SSD_ITEMS;
    if (it < N_ML_ITEMS) { mlstm_item(p, layer, it, smem); continue; }
    it -= N_ML_ITEMS;
    {
      const float *qp, *kp, *vp; float* op; int nk;
      if (it < N_ATT_LAT) {
        int qb = it & 31, hh = (it >> 5) & 3, b = it >> 7;
        qp = p.Q + ((size_t)(b * 4 + hh) * SL + qb * 128) * 192; kp = p.K + (size_t)(b * 4 + hh) * NKEY * 192;
        vp = p.V + (size_t)(b * 4 + hh) * NKEY * 128; nk = NKEY; op = p.O + (size_t)(b * SL + qb * 128) * 512 + hh * 128;
      } else {
        it -= N_ATT_LAT;
        int qb = it & 1, hh = (it >> 1) & 3, b = it >> 3;
        qp = p.Qc + ((size_t)(b * 4 + hh) * CL + qb * 128) * 192; kp = p.K + ((size_t)(b * 4 + hh) * NKEY + SL) * 192;
        vp = p.V + ((size_t)(b * 4 + hh) * NKEY + SL) * 128; nk = CL; op = p.O + (size_t)(TLAT + b * CL + qb * 128) * 512 + hh * 128;
      }
      attn_item(qp, kp, vp, nk, op, smem);
    }
  }
}

__device__ __forceinline__ float gelu_tanh(float x) {
  const float k0 = 0.7978845608028654f;
  return 0.5f * x * (1.f + tanhf(k0 * (x + 0.044715f * x * x * x)));
}
__device__ __forceinline__ void ph_s5pre(const P& p, int layer, char* smem) {
  const size_t n = (size_t)TTOT * 512;
  for (size_t i = (size_t)blockIdx.x * 256 + threadIdx.x; i < n; i += (size_t)gridDim.x * 256) {
    int r = (int)(i >> 9), c = (int)(i & 511);
    float u = p.Z[(size_t)r * NIN + ZC_U + c];
    float y = p.s5_rf[i] + p.s5_rb[i] + p.s5_d[layer * 512 + c] * u;
    p.ydpre[i] = gelu_tanh(y);
  }
}
__device__ __forceinline__ void ph_glu(const P& p, int layer, char* smem) {
  const float* yp = p.ydpre; float* yg = p.ydg; const float* gb = p.glu_b + layer * 512;
  auto epi = [=](int row, int col, float v) {
    float y = yp[(size_t)row * 512 + col];
    yg[(size_t)row * 512 + col] = y * sigmoidf_(v + gb[col]);
  };
  gemm_dense(p.ydpre, 512, p.glu_w + (size_t)layer * 512 * 512, 512, TTOT, 512, 512, epi, smem);
}

__device__ __forceinline__ void ph_final_mix(const P& p, int layer, char* smem) {
  float* red = (float*)smem;
  const int tid = threadIdx.x;
  const float* onw = p.out_norm_w + layer * 2048;
  for (int r = blockIdx.x; r < TTOT; r += gridDim.x) {
    const int c = tid * 2;
    const float* z = p.Z + (size_t)r * NIN;
    float2 oa = *(const float2*)(p.O + (size_t)r * 512 + c);
    float sa = block_sum(oa.x * oa.x + oa.y * oa.y, red);
    float ra = rsqrtf(sa * (1.f / 512.f) + EPSV);
    float2 yf = *(const float2*)(p.ssd_yf + (size_t)r * 512 + c);
    float2 yb = *(const float2*)(p.ssd_yb + (size_t)r * 512 + c);
    float2 xs = *(const float2*)(p.ssd_xs + (size_t)r * 512 + c);
    float2 zz = *(const float2*)(z + ZC_BZ + c);
    float dsk = p.ssd_d[layer * 8 + (c >> 6)];
    float b0 = (yf.x + yb.x + dsk * xs.x) * siluf_(zz.x);
    float b1 = (yf.y + yb.y + dsk * xs.y) * siluf_(zz.y);
    float sb = block_sum(b0 * b0 + b1 * b1, red);
    float rb = rsqrtf(sb * (1.f / 512.f) + EPSV);
    float2 hf = *(const float2*)(p.ml_hf + (size_t)r * 512 + c);
    float2 hb = *(const float2*)(p.ml_hb + (size_t)r * 512 + c);
    float c0 = hf.x + hb.x, c1 = hf.y + hb.y;
    float scs = wave_sum(c0 * c0 + c1 * c1);
    float rc = rsqrtf(scs * (1.f / 128.f) + EPSV);
    float2 og = *(const float2*)(z + ZC_MO + c);
    c0 = c0 * rc * sigmoidf_(og.x); c1 = c1 * rc * sigmoidf_(og.y);
    float2 yd = *(const float2*)(p.ydg + (size_t)r * 512 + c);
    float sd = block_sum(yd.x * yd.x + yd.y * yd.y, red);
    float rd = rsqrtf(sd * (1.f / 512.f) + EPSV);
    float* Y = p.Y + (size_t)r * 2048;
    Y[c] = oa.x * ra * onw[c];                 Y[c + 1] = oa.y * ra * onw[c + 1];
    Y[512 + c] = b0 * rb * onw[512 + c];       Y[512 + c + 1] = b1 * rb * onw[512 + c + 1];
    Y[1024 + c] = c0 * onw[1024 + c];          Y[1024 + c + 1] = c1 * onw[1024 + c + 1];
    Y[1536 + c] = yd.x * rd * onw[1536 + c];   Y[1536 + c + 1] = yd.y * rd * onw[1536 + c + 1];
  }
}

__device__ __forceinline__ void ph_wout(const P& p, int layer, char* smem) {
  const P pp = p;
  const int M = layer == 0 ? TTOT : TLAT;
  auto epi = [=](int row, int col, float v) {
    const int mi = row_modidx(row);
    const float g1 = pp.modv[(layer * 3 + mi) * 12288 + 2 * 2048 + col];
    float xin;
    if (layer == 0) xin = row < TLAT ? pp.x[(size_t)row * 2048 + col] : pp.ctx[(size_t)(row - TLAT) * 2048 + col];
    else xin = pp.X[(size_t)row * 2048 + col];
    pp.X[(size_t)row * 2048 + col] = xin + g1 * v;
  };
  gemm_dense(p.Y, 2048, p.w_out + (size_t)layer * 2048 * 2048, 2048, M, 2048, 2048, epi, smem);
}

__device__ __forceinline__ void ph_router(const P& p, int layer, char* smem) {
  float* red = (float*)smem;
  float* lred = red + 4;
  float* lg = lred + 4 * 36;
  const int tid = threadIdx.x, lane = tid & 63, wid = tid >> 6;
  const int T = layer == 0 ? TTOT : TLAT;
  const float* nw = p.norm2_w + layer * 2048;
  const float* wg = p.w_group + (size_t)layer * 2048 * 4;
  const float* we = p.w_expert + (size_t)layer * 2048 * 32;
  for (int r = blockIdx.x; r < T; r += gridDim.x) {
    const int mi = row_modidx(r);
    const float* mrow = p.modv + (layer * 3 + mi) * 12288;
    const int k0 = tid * 8;
    float v[8]; float ss = 0.f;
#pragma unroll
    for (int hf = 0; hf < 2; ++hf) {
      float4 xv = *(const float4*)(p.X + (size_t)r * 2048 + k0 + hf * 4);
      v[hf * 4 + 0] = xv.x; v[hf * 4 + 1] = xv.y; v[hf * 4 + 2] = xv.z; v[hf * 4 + 3] = xv.w;
      ss += xv.x * xv.x + xv.y * xv.y + xv.z * xv.z + xv.w * xv.w;
    }
    float tot = block_sum(ss, red);
    float rs = rsqrtf(tot * (1.f / 2048.f) + EPSV);
#pragma unroll
    for (int i = 0; i < 8; ++i) {
      int col = k0 + i;
      v[i] = v[i] * rs * nw[col] * (1.f + mrow[4 * 2048 + col]) + mrow[3 * 2048 + col];
    }
    *(float4*)(p.H + (size_t)r * 2048 + k0) = make_float4(v[0], v[1], v[2], v[3]);
    *(float4*)(p.H + (size_t)r * 2048 + k0 + 4) = make_float4(v[4], v[5], v[6], v[7]);
    float lgt[36];
#pragma unroll
    for (int j = 0; j < 36; ++j) lgt[j] = 0.f;
#pragma unroll
    for (int i = 0; i < 8; ++i) {
      float4 g4 = *(const float4*)(wg + (size_t)(k0 + i) * 4);
      lgt[0] += v[i] * g4.x; lgt[1] += v[i] * g4.y; lgt[2] += v[i] * g4.z; lgt[3] += v[i] * g4.w;
#pragma unroll
      for (int j4 = 0; j4 < 8; ++j4) {
        float4 e4 = *(const float4*)(we + (size_t)(k0 + i) * 32 + j4 * 4);
        lgt[4 + j4 * 4 + 0] += v[i] * e4.x; lgt[4 + j4 * 4 + 1] += v[i] * e4.y;
        lgt[4 + j4 * 4 + 2] += v[i] * e4.z; lgt[4 + j4 * 4 + 3] += v[i] * e4.w;
      }
    }
#pragma unroll
    for (int j = 0; j < 36; ++j) lgt[j] = wave_sum(lgt[j]);
    __syncthreads();
    if (lane == 0) {
#pragma unroll
      for (int j = 0; j < 36; ++j) lred[wid * 36 + j] = lgt[j];
    }
    __syncthreads();
    if (tid < 36) lg[tid] = lred[tid] + lred[36 + tid] + lred[72 + tid] + lred[108 + tid];
    __syncthreads();
    if (tid == 0) {
      int gi = 0; float gm = lg[0];
      for (int j = 1; j < 4; ++j) if (lg[j] > gm) { gm = lg[j]; gi = j; }
      float gs = 0.f;
      for (int j = 0; j < 4; ++j) gs += expf(lg[j] - gm);
      float gw = 1.f / gs;
      const float* el = lg + 4 + gi * 8;
      int i1 = 0; float v1 = el[0];
      for (int j = 1; j < 8; ++j) if (el[j] > v1) { v1 = el[j]; i1 = j; }
      int i2 = -1; float v2 = -INFINITY;
      for (int j = 0; j < 8; ++j) if (j != i1 && el[j] > v2) { v2 = el[j]; i2 = j; }
      float e2 = expf(v2 - v1);
      float w1 = gw / (1.f + e2), w2 = gw * e2 / (1.f + e2);
      int ex1 = gi * 8 + i1, ex2 = gi * 8 + i2;
      int* cnt = p.cnt + layer * 32;
      int p1 = atomicAdd(&cnt[ex1], 1);
      p.list_tok[ex1 * CAPE + p1] = r * 2; p.list_w[ex1 * CAPE + p1] = w1;
      int p2 = atomicAdd(&cnt[ex2], 1);
      p.list_tok[ex2 * CAPE + p2] = r * 2 + 1; p.list_w[ex2 * CAPE + p2] = w2;
    }
  }
}

struct AGather { const float* H; const int* toks; int nvalid;
  __device__ __forceinline__ const float* row(int r) const { return r < nvalid ? H + (size_t)(toks[r] >> 1) * 2048 : nullptr; }
  __device__ __forceinline__ const float* safe() const { return H; } };
struct BGateUp { const float *g, *u; int ldb; int nb;
  __device__ __forceinline__ const float* col(int v) const { int wc = v >> 6, j = (v >> 5) & 1, c = v & 31;
    const float* b = (const float*)((uintptr_t)g + (uintptr_t)j * ((uintptr_t)u - (uintptr_t)g)); return b + nb + wc * 32 + c; }
  __device__ __forceinline__ const float* safe() const { return g; } };

__device__ __forceinline__ void moe_prefix(const P& p, int layer, int* spre) {
  __syncthreads();
  if (threadIdx.x == 0) {
    int acc = 0;
    for (int e = 0; e < 32; ++e) { spre[e] = acc; acc += (p.cnt[layer * 32 + e] + 127) >> 7; }
    spre[32] = acc;
  }
  __syncthreads();
}
__device__ __forceinline__ void ph_moe_up(const P& p, int layer, char* smem) {
  int* spre = (int*)(smem + 40960);
  moe_prefix(p, layer, spre);
  const int ntile = spre[32];
  for (int w = blockIdx.x; w < ntile * 8; w += gridDim.x) {
    const int rbg = w >> 3, nt = w & 7;
    int e = 0;
    while (e < 31 && spre[e + 1] <= rbg) ++e;
    const int rb = rbg - spre[e];
    const int cnt = p.cnt[layer * 32 + e];
    AGather af{p.H, p.list_tok + e * CAPE + rb * 128, cnt - rb * 128};
    const size_t wo = ((size_t)layer * 32 + e) * 2048 * 512;
    BGateUp bf{p.w_gate + wo, p.w_up + wo, 512, nt * 64};
    float* act = p.ACT + (size_t)rbg * 128 * 512 + nt * 64;
    auto ef = [&](const f32x16 (&acc)[2][2], int wr, int wc, int lane) {
#pragma unroll
      for (int i = 0; i < 2; ++i)
#pragma unroll
        for (int r = 0; r < 16; ++r) {
          int row = ACC_ROW(wr, i, r, lane);
          float gv = acc[i][0][r], uv = acc[i][1][r];
          act[(size_t)row * 512 + wc * 32 + (lane & 31)] = siluf_(gv) * uv;
        }
    };
    gemm_tile(af, bf, ef, 2048, smem);
  }
}
__device__ __forceinline__ void ph_moe_down(const P& p, int layer, char* smem) {
  int* spre = (int*)(smem + 40960);
  moe_prefix(p, layer, spre);
  const int ntile = spre[32];
  for (int w = blockIdx.x; w < ntile * 16; w += gridDim.x) {
    const int rbg = w >> 4, nt = w & 15;
    int e = 0;
    while (e < 31 && spre[e + 1] <= rbg) ++e;
    const int rb = rbg - spre[e];
    const int nvalid = p.cnt[layer * 32 + e] - rb * 128;
    ARows af{p.ACT + (size_t)rbg * 128 * 512, 512, 0, 128};
    BPlain bf{p.w_down + ((size_t)layer * 32 + e) * 512 * 2048, 2048, nt * 128, 2048};
    const int* toks = p.list_tok + e * CAPE + rb * 128;
    const float* lw = p.list_w + e * CAPE + rb * 128;
    float* Ys = p.Yslot;
    auto ef = [&](const f32x16 (&acc)[2][2], int wr, int wc, int lane) {
#pragma unroll
      for (int i = 0; i < 2; ++i)
#pragma unroll
        for (int r = 0; r < 16; ++r) {
          int row = ACC_ROW(wr, i, r, lane);
          if (row < nvalid) {
            int ts = toks[row]; float wgt = lw[row];
#pragma unroll
            for (int j = 0; j < 2; ++j) Ys[(size_t)ts * 2048 + nt * 128 + ACC_COL(wc, j, lane)] = wgt * acc[i][j][r];
          }
        }
    };
    gemm_tile(af, bf, ef, 512, smem);
  }
}

__device__ __forceinline__ void ph_out(const P& p, char* smem) {
  float* red = (float*)smem;
  const int tid = threadIdx.x;
  for (int r = blockIdx.x; r < TLAT; r += gridDim.x) {
    const int mi = r >> 12;
    const float* g2 = p.modv + (1 * 3 + mi) * 12288 + 5 * 2048;
    float v[8]; float ss = 0.f;
#pragma unroll
    for (int hf = 0; hf < 2; ++hf) {
      int col = hf * 1024 + tid * 4;
      float4 xv = *(const float4*)(p.X + (size_t)r * 2048 + col);
      float4 gv = *(const float4*)(g2 + col);
      float4 y0 = *(const float4*)(p.Yslot + (size_t)(2 * r) * 2048 + col);
      float4 y1 = *(const float4*)(p.Yslot + (size_t)(2 * r + 1) * 2048 + col);
      xv.x += gv.x * (y0.x + y1.x); xv.y += gv.y * (y0.y + y1.y);
      xv.z += gv.z * (y0.z + y1.z); xv.w += gv.w * (y0.w + y1.w);
      v[hf * 4 + 0] = xv.x; v[hf * 4 + 1] = xv.y; v[hf * 4 + 2] = xv.z; v[hf * 4 + 3] = xv.w;
      ss += xv.x * xv.x + xv.y * xv.y + xv.z * xv.z + xv.w * xv.w;
    }
    float tot = block_sum(ss, red);
    float rs = rsqrtf(tot * (1.f / 2048.f) + EPSV);
#pragma unroll
    for (int hf = 0; hf < 2; ++hf) {
      int col = hf * 1024 + tid * 4;
      float4 w4 = *(const float4*)(p.final_w + col);
      float4 o;
      o.x = v[hf * 4 + 0] * rs * w4.x; o.y = v[hf * 4 + 1] * rs * w4.y;
      o.z = v[hf * 4 + 2] * rs * w4.z; o.w = v[hf * 4 + 3] * rs * w4.w;
      *(float4*)(p.out + (size_t)r * 2048 + col) = o;
    }
  }
}

#define SMEM_BYTES 49152
template <int PH>
__global__ void __launch_bounds__(256) k_phase(P p, int layer) {
  extern __shared__ __attribute__((aligned(16))) char smem[];
  if (PH == 0) ph_mod(p, smem);
  if (PH == 1) ph_norm1(p, layer, smem);
  if (PH == 2) ph_win(p, layer, smem);
  if (PH == 3) ph_prep(p, layer, smem);
  if (PH == 4) ph_qkv(p, layer, smem);
  if (PH == 5) ph_mlapost(p, layer, smem);
  if (PH == 6) ph_mix(p, layer, smem);
  if (PH == 7) ph_s5pre(p, layer, smem);
  if (PH == 8) ph_glu(p, layer, smem);
  if (PH == 9) ph_final_mix(p, layer, smem);
  if (PH == 10) ph_wout(p, layer, smem);
  if (PH == 11) ph_router(p, layer, smem);
  if (PH == 12) ph_moe_up(p, layer, smem);
  if (PH == 13) ph_moe_down(p, layer, smem);
  if (PH == 14) ph_out(p, smem);
}

extern "C" void kernel_launch(void* const* d_in, const int* in_sizes, int n_in, void* d_out, int out_size, void* d_ws,
                              size_t ws_size, hipStream_t stream) {
  P p{};
  const float* const* in = (const float* const*)d_in;
  p.x = in[0]; p.c = in[1]; p.ctx = in[2]; p.c_ctx = in[3]; p.mod_w = in[4]; p.mod_b = in[5]; p.norm1_w = in[6];
  p.w_in = in[7]; p.q_norm_w = in[8]; p.kv_norm_w = in[9]; p.w_uq = in[10]; p.w_ukv = in[11]; p.conv_w = in[12];
  p.conv_b = in[13]; p.a_log = in[14]; p.dt_bias = in[15]; p.ssd_d = in[16]; p.gate_b = in[17]; p.lam_re = in[18];
  p.lam_im = in[19]; p.log_dt = in[20]; p.b_re = in[21]; p.b_im = in[22]; p.c_re = in[23]; p.c_im = in[24];
  p.s5_d = in[25]; p.glu_w = in[26]; p.glu_b = in[27]; p.out_norm_w = in[28]; p.w_out = in[29]; p.norm2_w = in[30];
  p.w_group = in[31]; p.w_expert = in[32]; p.w_gate = in[33]; p.w_up = in[34]; p.w_down = in[35]; p.final_w = in[36];
  p.out = (float*)d_out;
  float* w = (float*)d_ws;
  size_t off = 0;
  auto take = [&](size_t n) { float* r = w + off; off += (n + 63) & ~(size_t)63; return r; };
  p.cnt = (int*)take(64);
  p.modv = take(2 * 3 * 12288);
  p.H = take((size_t)TTOT * 2048);
  p.X = take((size_t)TTOT * 2048);
  p.Z = take((size_t)TTOT * NIN);
  p.Aq = take((size_t)TTOT * 384);
  p.Akv = take((size_t)TTOT * 128);
  p.qraw = take((size_t)TTOT * 768);
  p.kvraw = take((size_t)TTOT * 1024);
  p.Q = take((size_t)8 * SL * 192);
  p.Qc = take((size_t)8 * CL * 192);
  p.K = take((size_t)8 * NKEY * 192);
  p.V = take((size_t)8 * NKEY * 128);
  p.O = take((size_t)TTOT * 512);
  p.ssd_xs = take((size_t)TTOT * 512);
  p.ssd_B = take((size_t)TTOT * 256);
  p.ssd_C = take((size_t)TTOT * 256);
  p.ssd_dt = take((size_t)TTOT * 16);
  p.ssd_yf = take((size_t)TTOT * 512);
  p.ssd_yb = take((size_t)TTOT * 512);
  p.ml_hf = take((size_t)TTOT * 512);
  p.ml_hb = take((size_t)TTOT * 512);
  p.s5_rf = take((size_t)TTOT * 512);
  p.s5_rb = take((size_t)TTOT * 512);
  p.ydpre = take((size_t)TTOT * 512);
  p.ydg = take((size_t)TTOT * 512);
  p.Y = take((size_t)TTOT * 2048);
  p.list_tok = (int*)take((size_t)32 * CAPE);
  p.list_w = take((size_t)32 * CAPE);
  p.ACT = take((size_t)ACT_ROWS * 512);
  p.Yslot = take((size_t)TTOT * 2 * 2048);
  (void)ws_size; (void)in_sizes; (void)n_in; (void)out_size;

  const int G = 1024;
#define LAUNCH(PH, grid, layer) hipLaunchKernelGGL((k_phase<PH>), dim3(grid), dim3(256), SMEM_BYTES, stream, p, layer)
  LAUNCH(0, 192, 0);
  for (int l = 0; l < 2; ++l) {
    LAUNCH(1, G, l);
    LAUNCH(2, G, l);
    LAUNCH(3, G, l);
    LAUNCH(4, G, l);
    LAUNCH(5, G, l);
    LAUNCH(6, 592, l);
    LAUNCH(7, G, l);
    LAUNCH(8, G, l);
    LAUNCH(9, G, l);
    LAUNCH(10, G, l);
    LAUNCH(11, G, l);
    LAUNCH(12, G, l);
    LAUNCH(13, G, l);
  }
  LAUNCH(14, G, 0);
}
```

```cpp
#include <hip/hip_runtime.h>
#include <stdint.h>

#define DM 2048
#define SL 4096
#define CL 256
#define TLAT 8192
#define TCTX 512
#define TTOT 8704
#define NIN 4192
#define NKEY 4352
#define ZC_CQ 0
#define ZC_CKV 384
#define ZC_KR 512
#define ZC_BZ 576
#define ZC_XBC 1088
#define ZC_DT 2112
#define ZC_MQ 2128
#define ZC_MK 2384
#define ZC_MV 2640
#define ZC_MO 3152
#define ZC_MG 3664
#define ZC_U 3680
#define CAPE 8704
#define EPSV 1e-6f
#define ACT_ROWS 21632

typedef float f32x16 __attribute__((ext_vector_type(16)));

struct P {
  const float *x, *c, *ctx, *c_ctx, *mod_w, *mod_b, *norm1_w, *w_in, *q_norm_w, *kv_norm_w, *w_uq, *w_ukv;
  const float *conv_w, *conv_b, *a_log, *dt_bias, *ssd_d, *gate_b, *lam_re, *lam_im, *log_dt, *b_re, *b_im;
  const float *c_re, *c_im, *s5_d, *glu_w, *glu_b, *out_norm_w, *w_out, *norm2_w, *w_group, *w_expert;
  const float *w_gate, *w_up, *w_down, *final_w;
  float* out;
  float *modv, *H, *X, *Z, *Aq, *Akv, *qraw, *kvraw, *Q, *Qc, *K, *V, *O;
  float *ssd_xs, *ssd_B, *ssd_C, *ssd_dt, *ssd_yf, *ssd_yb, *ml_hf, *ml_hb, *s5_rf, *s5_rb, *ydpre, *ydg, *Y;
  float *list_w, *ACT, *Yslot;
  int *cnt, *list_tok;
};

__device__ __forceinline__ int row_modidx(int r) { return r < TLAT ? (r >> 12) : 2; }
__device__ __forceinline__ float sigmoidf_(float v) { return 1.f / (1.f + expf(-v)); }
__device__ __forceinline__ float siluf_(float v) { return v / (1.f + expf(-v)); }
__device__ __forceinline__ float wave_sum(float v) {
#pragma unroll
  for (int o = 32; o; o >>= 1) v += __shfl_xor(v, o);
  return v;
}
__device__ __forceinline__ float block_sum(float v, float* red) {
  v = wave_sum(v);
  __syncthreads();
  if ((threadIdx.x & 63) == 0) red[threadIdx.x >> 6] = v;
  __syncthreads();
  return red[0] + red[1] + red[2] + red[3];
}

__device__ __forceinline__ void ph_mod(const P& p, char* smem) {
  float* sc = (float*)smem;
  float* red = sc + 3 * 2048;
  const int tid = threadIdx.x;
  if (blockIdx.x == 0 && tid < 64) p.cnt[tid] = 0;
  for (int i = tid; i < 3 * 2048; i += 256) {
    int r = i >> 11, k = i & 2047;
    float v = r < 2 ? p.c[r * 2048 + k] : p.c_ctx[k];
    sc[i] = siluf_(v);
  }
  __syncthreads();
  for (int w = blockIdx.x; w < 2 * 96; w += gridDim.x) {
    int l = w / 96, j0 = (w % 96) * 128;
    int cg = tid & 31, ks = tid >> 5;
    const float* W = p.mod_w + (size_t)l * 2048 * 12288 + j0 + cg * 4;
    float acc[3][4];
#pragma unroll
    for (int r = 0; r < 3; ++r)
#pragma unroll
      for (int c = 0; c < 4; ++c) acc[r][c] = 0.f;
#pragma unroll 4
    for (int k = ks * 256; k < ks * 256 + 256; ++k) {
      float4 wv = *(const float4*)(W + (size_t)k * 12288);
      float s0 = sc[k], s1 = sc[2048 + k], s2 = sc[4096 + k];
      acc[0][0] += s0 * wv.x; acc[0][1] += s0 * wv.y; acc[0][2] += s0 * wv.z; acc[0][3] += s0 * wv.w;
      acc[1][0] += s1 * wv.x; acc[1][1] += s1 * wv.y; acc[1][2] += s1 * wv.z; acc[1][3] += s1 * wv.w;
      acc[2][0] += s2 * wv.x; acc[2][1] += s2 * wv.y; acc[2][2] += s2 * wv.z; acc[2][3] += s2 * wv.w;
    }
    __syncthreads();
#pragma unroll
    for (int r = 0; r < 3; ++r)
#pragma unroll
      for (int c = 0; c < 4; ++c) red[(ks * 32 + cg) * 12 + r * 4 + c] = acc[r][c];
    __syncthreads();
    for (int o = tid; o < 384; o += 256) {
      int r = o >> 7, c = o & 127;
      float s = 0.f;
#pragma unroll
      for (int q = 0; q < 8; ++q) s += red[(q * 32 + (c >> 2)) * 12 + r * 4 + (c & 3)];
      s += p.mod_b[l * 12288 + j0 + c];
      p.modv[(l * 3 + r) * 12288 + j0 + c] = s;
    }
    __syncthreads();
  }
}

__device__ __forceinline__ void ph_norm1(const P& p, int layer, char* smem) {
  float* red = (float*)smem;
  const int tid = threadIdx.x;
  const float* nw = p.norm1_w + layer * 2048;
  for (int r = blockIdx.x; r < TTOT; r += gridDim.x) {
    const int mi = row_modidx(r);
    const float* mrow = p.modv + (layer * 3 + mi) * 12288;
    float v[8];
    float ss = 0.f;
#pragma unroll
    for (int hf = 0; hf < 2; ++hf) {
      int col = hf * 1024 + tid * 4;
      float4 xv;
      if (layer == 0) {
        const float* src = r < TLAT ? p.x + (size_t)r * 2048 : p.ctx + (size_t)(r - TLAT) * 2048;
        xv = *(const float4*)(src + col);
      } else {
        xv = *(const float4*)(p.X + (size_t)r * 2048 + col);
        const float* g2 = p.modv + ((layer - 1) * 3 + mi) * 12288 + 5 * 2048;
        float4 gv = *(const float4*)(g2 + col);
        float4 y0 = *(const float4*)(p.Yslot + (size_t)(2 * r) * 2048 + col);
        float4 y1 = *(const float4*)(p.Yslot + (size_t)(2 * r + 1) * 2048 + col);
        xv.x += gv.x * (y0.x + y1.x); xv.y += gv.y * (y0.y + y1.y);
        xv.z += gv.z * (y0.z + y1.z); xv.w += gv.w * (y0.w + y1.w);
        *(float4*)(p.X + (size_t)r * 2048 + col) = xv;
      }
      v[hf * 4 + 0] = xv.x; v[hf * 4 + 1] = xv.y; v[hf * 4 + 2] = xv.z; v[hf * 4 + 3] = xv.w;
      ss += xv.x * xv.x + xv.y * xv.y + xv.z * xv.z + xv.w * xv.w;
    }
    float tot = block_sum(ss, red);
    float rs = rsqrtf(tot * (1.f / 2048.f) + EPSV);
#pragma unroll
    for (int hf = 0; hf < 2; ++hf) {
      int col = hf * 1024 + tid * 4;
      float4 w4 = *(const float4*)(nw + col);
      float4 sh = *(const float4*)(mrow + col);
      float4 scv = *(const float4*)(mrow + 2048 + col);
      float4 o;
      o.x = v[hf * 4 + 0] * rs * w4.x * (1.f + scv.x) + sh.x;
      o.y = v[hf * 4 + 1] * rs * w4.y * (1.f + scv.y) + sh.y;
      o.z = v[hf * 4 + 2] * rs * w4.z * (1.f + scv.z) + sh.z;
      o.w = v[hf * 4 + 3] * rs * w4.w * (1.f + scv.w) + sh.w;
      *(float4*)(p.H + (size_t)r * 2048 + col) = o;
    }
  }
}

template <class AF, class BF, class EF>
__device__ __forceinline__ void gemm_tile(const AF& af, const BF& bf, const EF& ef, int K, char* smem) {
  float* As = (float*)smem;
  float* Bs = As + 128 * 33;
  const int tid = threadIdx.x, lane = tid & 63, wid = tid >> 6, wr = wid >> 1, wc = wid & 1;
  const int l31 = lane & 31, lh = lane >> 5;
  f32x16 acc[2][2];
#pragma unroll
  for (int i = 0; i < 2; ++i)
#pragma unroll
    for (int j = 0; j < 2; ++j)
#pragma unroll
      for (int r = 0; r < 16; ++r) acc[i][j][r] = 0.f;
  const int arl = tid >> 3, akq = (tid & 7) * 4;
  const float* ar0 = af.row(arl);
  const float* ar1 = af.row(arl + 32);
  const float* ar2 = af.row(arl + 64);
  const float* ar3 = af.row(arl + 96);
  const bool av0 = ar0 != nullptr, av1 = ar1 != nullptr, av2 = ar2 != nullptr, av3 = ar3 != nullptr;
  const float* asafe = af.safe();
  if (!av0) ar0 = asafe; if (!av1) ar1 = asafe; if (!av2) ar2 = asafe; if (!av3) ar3 = asafe;
  const float* bc = bf.col((tid & 31) * 4);
  const bool bv = bc != nullptr;
  if (!bv) bc = bf.safe();
  const int ldb = bf.ldb;
  const int bk = tid >> 5;
  float4 ra0, ra1, ra2, ra3, rb0, rb1, rb2, rb3;
  const float4 z4 = make_float4(0.f, 0.f, 0.f, 0.f);
#define GLOAD(k0)                                                        \
  {                                                                      \
    ra0 = *(const float4*)(ar0 + (k0) + akq); if (!av0) ra0 = z4;        \
    ra1 = *(const float4*)(ar1 + (k0) + akq); if (!av1) ra1 = z4;        \
    ra2 = *(const float4*)(ar2 + (k0) + akq); if (!av2) ra2 = z4;        \
    ra3 = *(const float4*)(ar3 + (k0) + akq); if (!av3) ra3 = z4;        \
    rb0 = *(const float4*)(bc + (size_t)((k0) + bk) * ldb);              \
    rb1 = *(const float4*)(bc + (size_t)((k0) + bk + 8) * ldb);          \
    rb2 = *(const float4*)(bc + (size_t)((k0) + bk + 16) * ldb);         \
    rb3 = *(const float4*)(bc + (size_t)((k0) + bk + 24) * ldb);         \
    if (!bv) { rb0 = z4; rb1 = z4; rb2 = z4; rb3 = z4; }                 \
  }
#define SWRITE_A(ps, v)                                                  \
  { float* d = As + (arl + 32 * (ps)) * 33 + akq; d[0] = v.x; d[1] = v.y; d[2] = v.z; d[3] = v.w; }
#define SWRITE()                                                         \
  {                                                                      \
    SWRITE_A(0, ra0) SWRITE_A(1, ra1) SWRITE_A(2, ra2) SWRITE_A(3, ra3)  \
    *(float4*)(Bs + (bk) * 128 + (tid & 31) * 4) = rb0;                  \
    *(float4*)(Bs + (bk + 8) * 128 + (tid & 31) * 4) = rb1;              \
    *(float4*)(Bs + (bk + 16) * 128 + (tid & 31) * 4) = rb2;             \
    *(float4*)(Bs + (bk + 24) * 128 + (tid & 31) * 4) = rb3;             \
  }
  __syncthreads();
  GLOAD(0)
  SWRITE()
  __syncthreads();
  for (int k0 = 0; k0 < K; k0 += 32) {
    const bool more = (k0 + 32) < K;
    if (more) GLOAD(k0 + 32)
    const float* ap = As + (wr * 64 + l31) * 33 + lh;
    const float* bp = Bs + lh * 128 + wc * 64 + l31;
#pragma unroll
    for (int kk = 0; kk < 16; ++kk) {
      float a0 = ap[2 * kk], a1 = ap[32 * 33 + 2 * kk];
      float b0 = bp[2 * kk * 128], b1 = bp[2 * kk * 128 + 32];
      acc[0][0] = __builtin_amdgcn_mfma_f32_32x32x2f32(a0, b0, acc[0][0], 0, 0, 0);
      acc[0][1] = __builtin_amdgcn_mfma_f32_32x32x2f32(a0, b1, acc[0][1], 0, 0, 0);
      acc[1][0] = __builtin_amdgcn_mfma_f32_32x32x2f32(a1, b0, acc[1][0], 0, 0, 0);
      acc[1][1] = __builtin_amdgcn_mfma_f32_32x32x2f32(a1, b1, acc[1][1], 0, 0, 0);
    }
    __syncthreads();
    if (more) SWRITE()
    __syncthreads();
  }
  ef(acc, wr, wc, lane);
}
#define ACC_ROW(wr, i, r, lane) ((wr) * 64 + (i) * 32 + ((r) & 3) + 8 * ((r) >> 2) + 4 * ((lane) >> 5))
#define ACC_COL(wc, j, lane) ((wc) * 64 + (j) * 32 + ((lane) & 31))

struct ARows { const float* base; int ld; int m0; int M;
  __device__ __forceinline__ const float* row(int r) const { int g = m0 + r; return g < M ? base + (size_t)g * ld : nullptr; }
  __device__ __forceinline__ const float* safe() const { return base; } };
struct BPlain { const float* B; int ldb; int n0; int N;
  __device__ __forceinline__ const float* col(int v) const { int n = n0 + v; return n < N ? B + n : nullptr; }
  __device__ __forceinline__ const float* safe() const { return B; } };

template <class EPI>
__device__ __forceinline__ void gemm_dense(const float* A, int lda, const float* B, int ldb, int M, int N, int K, const EPI& epi, char* smem) {
  const int mt = (M + 127) >> 7, nt = (N + 127) >> 7;
  for (int w = blockIdx.x; w < mt * nt; w += gridDim.x) {
    const int m0 = (w / nt) * 128, n0 = (w % nt) * 128;
    ARows af{A, lda, m0, M};
    BPlain bf{B, ldb, n0, N};
    auto ef = [&](const f32x16 (&acc)[2][2], int wr, int wc, int lane) {
#pragma unroll
      for (int i = 0; i < 2; ++i)
#pragma unroll
        for (int j = 0; j < 2; ++j)
#pragma unroll
          for (int r = 0; r < 16; ++r) {
            int row = m0 + ACC_ROW(wr, i, r, lane), col = n0 + ACC_COL(wc, j, lane);
            if (row < M && col < N) epi(row, col, acc[i][j][r]);
          }
    };
    gemm_tile(af, bf, ef, K, smem);
  }
}

__device__ __forceinline__ void ph_win(const P& p, int layer, char* smem) {
  float* Z = p.Z;
  auto epi = [=](int row, int col, float v) { Z[(size_t)row * NIN + col] = v; };
  gemm_dense(p.H, 2048, p.w_in + (size_t)layer * 2048 * NIN, NIN, TTOT, NIN, 2048, epi, smem);
}

__device__ __forceinline__ void ph_prep(const P& p, int layer, char* smem) {
  const int tid = threadIdx.x, lane = tid & 63, wid = tid >> 6;
  for (int r = blockIdx.x * 4 + wid; r < TTOT; r += gridDim.x * 4) {
    const float* z = p.Z + (size_t)r * NIN;
    float q[6]; float ss = 0.f;
#pragma unroll
    for (int i = 0; i < 6; ++i) { q[i] = z[ZC_CQ + i * 64 + lane]; ss += q[i] * q[i]; }
    ss = wave_sum(ss);
    float rs = rsqrtf(ss * (1.f / 384.f) + EPSV);
#pragma unroll
    for (int i = 0; i < 6; ++i) p.Aq[(size_t)r * 384 + i * 64 + lane] = q[i] * rs * p.q_norm_w[layer * 384 + i * 64 + lane];
    float k0 = z[ZC_CKV + lane], k1 = z[ZC_CKV + 64 + lane];
    float s2 = wave_sum(k0 * k0 + k1 * k1);
    float rs2 = rsqrtf(s2 * (1.f / 128.f) + EPSV);
    p.Akv[(size_t)r * 128 + lane] = k0 * rs2 * p.kv_norm_w[layer * 128 + lane];
    p.Akv[(size_t)r * 128 + 64 + lane] = k1 * rs2 * p.kv_norm_w[layer * 128 + 64 + lane];
  }
  const float* cw = p.conv_w + layer * 5 * 1024;
  const float* cb = p.conv_b + layer * 1024;
  for (int r = blockIdx.x; r < TTOT; r += gridDim.x) {
    int base, len;
    if (r < TLAT) { base = (r >> 12) << 12; len = SL; } else { base = TLAT + (((r - TLAT) >> 8) << 8); len = CL; }
    const int t = r - base;
    const int ch = tid * 4;
    float4 acc = *(const float4*)(cb + ch);
#pragma unroll
    for (int k = 0; k < 5; ++k) {
      int tt = t + k - 2;
      if (tt >= 0 && tt < len) {
        float4 xv = *(const float4*)(p.Z + (size_t)(base + tt) * NIN + ZC_XBC + ch);
        float4 wv = *(const float4*)(cw + k * 1024 + ch);
        acc.x += xv.x * wv.x; acc.y += xv.y * wv.y; acc.z += xv.z * wv.z; acc.w += xv.w * wv.w;
      }
    }
    acc.x = siluf_(acc.x); acc.y = siluf_(acc.y); acc.z = siluf_(acc.z); acc.w = siluf_(acc.w);
    if (ch < 512) *(float4*)(p.ssd_xs + (size_t)r * 512 + ch) = acc;
    else if (ch < 768) *(float4*)(p.ssd_B + (size_t)r * 256 + (ch - 512)) = acc;
    else *(float4*)(p.ssd_C + (size_t)r * 256 + (ch - 768)) = acc;
    if (tid < 16) {
      float v = p.Z[(size_t)r * NIN + ZC_DT + tid] + p.dt_bias[layer * 16 + tid];
      float sp = v > 20.f ? v : log1pf(expf(v));
      p.ssd_dt[(size_t)r * 16 + tid] = sp;
    }
  }
}

__device__ __forceinline__ void ph_qkv(const P& p, int layer, char* smem) {
  float* qraw = p.qraw; float* kvraw = p.kvraw;
  auto e1 = [=](int row, int col, float v) { qraw[(size_t)row * 768 + col] = v; };
  gemm_dense(p.Aq, 384, p.w_uq + (size_t)layer * 384 * 768, 768, TTOT, 768, 384, e1, smem);
  auto e2 = [=](int row, int col, float v) { kvraw[(size_t)row * 1024 + col] = v; };
  gemm_dense(p.Akv, 128, p.w_ukv + (size_t)layer * 128 * 1024, 1024, TTOT, 1024, 128, e2, smem);
}

__device__ __forceinline__ void ph_mlapost(const P& p, int layer, char* smem) {
  const int tid = threadIdx.x;
  const float qscale = 0.07216878364870322f;
  for (int r = blockIdx.x; r < TTOT; r += gridDim.x) {
    const bool lat = r < TLAT;
    int b, pos;
    if (lat) { b = r >> 12; pos = r & 4095; } else { b = (r - TLAT) >> 8; pos = (r - TLAT) & 255; }
    const int kpos = lat ? pos : SL + pos;
    const float* qr = p.qraw + (size_t)r * 768;
    const float* kv = p.kvraw + (size_t)r * 1024;
    const float* zr = p.Z + (size_t)r * NIN + ZC_KR;
    const float frow = (float)(pos >> 6), fcol = (float)(pos & 63);
    for (int i = tid; i < 768; i += 256) {
      int h = i / 192, d = i % 192;
      float v;
      if (d < 128 || !lat) v = qr[i];
      else {
        int e = d - 128, a = e >> 5, half = (e >> 4) & 1, f = e & 15;
        float x1 = qr[h * 192 + 128 + a * 32 + f], x2 = qr[h * 192 + 128 + a * 32 + 16 + f];
        float invf = powf(10000.f, -(float)f * (1.f / 16.f));
        float ang = (a == 0 ? frow : fcol) * invf;
        float cs = cosf(ang), sn = sinf(ang);
        v = half == 0 ? x1 * cs - x2 * sn : x1 * sn + x2 * cs;
      }
      v *= qscale;
      if (lat) p.Q[((size_t)(b * 4 + h) * SL + pos) * 192 + d] = v;
      else p.Qc[((size_t)(b * 4 + h) * CL + pos) * 192 + d] = v;
    }
    for (int i = tid; i < 768; i += 256) {
      int h = i / 192, d = i % 192;
      float v;
      if (d < 128) v = kv[h * 256 + d];
      else {
        int e = d - 128;
        if (!lat) v = zr[e];
        else {
          int a = e >> 5, half = (e >> 4) & 1, f = e & 15;
          float x1 = zr[a * 32 + f], x2 = zr[a * 32 + 16 + f];
          float invf = powf(10000.f, -(float)f * (1.f / 16.f));
          float ang = (a == 0 ? frow : fcol) * invf;
          float cs = cosf(ang), sn = sinf(ang);
          v = half == 0 ? x1 * cs - x2 * sn : x1 * sn + x2 * cs;
        }
      }
      p.K[((size_t)(b * 4 + h) * NKEY + kpos) * 192 + d] = v;
    }
    for (int i = tid; i < 512; i += 256) {
      int h = i >> 7, d = i & 127;
      p.V[((size_t)(b * 4 + h) * NKEY + kpos) * 128 + d] = kv[h * 256 + 128 + d];
    }
  }
}

__device__ __forceinline__ void attn_item(const float* __restrict__ Qp, const float* __restrict__ Kp, const float* __restrict__ Vp, int nk,
                          float* __restrict__ Op, char* smem) {
  float* Ks = (float*)smem;
  float* Vs = Ks + 32 * 193;
  const int tid = threadIdx.x, lane = tid & 63, wid = tid >> 6, l31 = lane & 31, lh = lane >> 5;
  float qf[96];
  {
    const float* qrow = Qp + (size_t)(wid * 32 + l31) * 192 + lh;
#pragma unroll
    for (int s8 = 0; s8 < 12; ++s8)
#pragma unroll
      for (int s1 = 0; s1 < 8; ++s1) qf[s8 * 8 + s1] = qrow[2 * (s8 * 8 + s1)];
  }
  f32x16 o[4];
#pragma unroll
  for (int d = 0; d < 4; ++d)
#pragma unroll
    for (int r = 0; r < 16; ++r) o[d][r] = 0.f;
  float m = -INFINITY, l = 0.f;
  for (int kt = 0; kt < nk; kt += 32) {
    __syncthreads();
    for (int i = tid; i < 1536; i += 256) {
      int key = i / 48, c4 = i % 48;
      float4 v = *(const float4*)(Kp + (size_t)(kt + key) * 192 + c4 * 4);
      float* d = Ks + key * 193 + c4 * 4;
      d[0] = v.x; d[1] = v.y; d[2] = v.z; d[3] = v.w;
    }
    for (int i = tid; i < 1024; i += 256) {
      int key = i >> 5, c4 = i & 31;
      *(float4*)(Vs + key * 128 + c4 * 4) = *(const float4*)(Vp + (size_t)(kt + key) * 128 + c4 * 4);
    }
    __syncthreads();
    f32x16 s;
#pragma unroll
    for (int r = 0; r < 16; ++r) s[r] = 0.f;
    const float* kp = Ks + l31 * 193 + lh;
#pragma unroll
    for (int s8 = 0; s8 < 12; ++s8)
#pragma unroll
      for (int s1 = 0; s1 < 8; ++s1)
        s = __builtin_amdgcn_mfma_f32_32x32x2f32(kp[2 * (s8 * 8 + s1)], qf[s8 * 8 + s1], s, 0, 0, 0);
    float tmax = s[0];
#pragma unroll
    for (int r = 1; r < 16; ++r) tmax = fmaxf(tmax, s[r]);
    tmax = fmaxf(tmax, __shfl_xor(tmax, 32));
    float mn = fmaxf(m, tmax);
    float alpha = expf(m - mn);
    float rs = 0.f;
#pragma unroll
    for (int r = 0; r < 16; ++r) { s[r] = expf(s[r] - mn); rs += s[r]; }
    rs += __shfl_xor(rs, 32);
    l = l * alpha + rs;
    m = mn;
#pragma unroll
    for (int d = 0; d < 4; ++d)
#pragma unroll
      for (int r = 0; r < 16; ++r) o[d][r] *= alpha;
#pragma unroll
    for (int r = 0; r < 16; ++r) {
      const int key = (r & 3) + 8 * (r >> 2) + 4 * lh;
      const float* vp = Vs + key * 128 + l31;
#pragma unroll
      for (int d = 0; d < 4; ++d) o[d] = __builtin_amdgcn_mfma_f32_32x32x2f32(vp[d * 32], s[r], o[d], 0, 0, 0);
    }
  }
  const float inv = 1.f / l;
  float* orow = Op + (size_t)(wid * 32 + l31) * 512;
#pragma unroll
  for (int d = 0; d < 4; ++d)
#pragma unroll
    for (int r = 0; r < 16; ++r) orow[d * 32 + (r & 3) + 8 * (r >> 2) + 4 * lh] = o[d][r] * inv;
}

__device__ __forceinline__ void ssd_item(const P& p, int layer, int item, char* smem) {
  const int pq = item & 3, h = (item >> 2) & 7, dir = (item >> 5) & 1, b = item >> 6;
  float* sdt = (float*)smem;
  float* sx = sdt + 32;
  float* sB = sx + 32 * 16;
  float* sC = sB + 32 * 128;
  const int tid = threadIdx.x, pl = tid >> 4, nc = tid & 15;
  const float A = -expf(p.a_log[layer * 16 + dir * 8 + h]);
  const int g = h >> 2;
  float hs[8];
#pragma unroll
  for (int j = 0; j < 8; ++j) hs[j] = 0.f;
  float* yout = dir ? p.ssd_yb : p.ssd_yf;
  for (int seg = 0; seg < 2; ++seg) {
    const int base = seg == 0 ? TLAT + b * CL : b * SL;
    const int len = seg == 0 ? CL : SL;
    for (int c0 = 0; c0 < len; c0 += 32) {
      __syncthreads();
      if (tid < 32) {
        int row = dir ? base + len - 1 - (c0 + tid) : base + c0 + tid;
        sdt[tid] = p.ssd_dt[(size_t)row * 16 + dir * 8 + h];
      }
      for (int i = tid; i < 512; i += 256) {
        int st = i >> 4, pp = i & 15;
        int row = dir ? base + len - 1 - (c0 + st) : base + c0 + st;
        sx[i] = p.ssd_xs[(size_t)row * 512 + h * 64 + pq * 16 + pp];
      }
      for (int i = tid; i < 4096; i += 256) {
        int st = i >> 7, n = i & 127;
        int row = dir ? base + len - 1 - (c0 + st) : base + c0 + st;
        sB[i] = p.ssd_B[(size_t)row * 256 + g * 128 + n];
        sC[i] = p.ssd_C[(size_t)row * 256 + g * 128 + n];
      }
      __syncthreads();
      for (int st = 0; st < 32; ++st) {
        const float dt = sdt[st];
        const float dA = expf(dt * A);
        const float xv = sx[st * 16 + pl] * dt;
        float y = 0.f;
#pragma unroll
        for (int j = 0; j < 8; ++j) {
          const int n = j * 16 + nc;
          hs[j] = dA * hs[j] + xv * sB[st * 128 + n];
          y += hs[j] * sC[st * 128 + n];
        }
        y += __shfl_xor(y, 1); y += __shfl_xor(y, 2); y += __shfl_xor(y, 4); y += __shfl_xor(y, 8);
        if (nc == 0) {
          int row = dir ? base + len - 1 - (c0 + st) : base + c0 + st;
          yout[(size_t)row * 512 + h * 64 + pq * 16 + pl] = y;
        }
      }
    }
  }
}

__device__ __forceinline__ void mlstm_item(const P& p, int layer, int item, char* smem) {
  const int vq = item & 3, h = (item >> 2) & 3, dir = (item >> 4) & 1, b = item >> 5;
  float* sq = (float*)smem;
  float* sk = sq + 32 * 64;
  float* sv = sk + 32 * 64;
  float* sf = sv + 32 * 32;
  float* si = sf + 32;
  const int tid = threadIdx.x, vl = tid >> 3, kc = tid & 7;
  const float bi = p.gate_b[layer * 16 + dir * 8 + h], bfv = p.gate_b[layer * 16 + dir * 8 + 4 + h];
  float Cs[8], ns[8];
#pragma unroll
  for (int j = 0; j < 8; ++j) { Cs[j] = 0.f; ns[j] = 0.f; }
  float* hout = dir ? p.ml_hb : p.ml_hf;
  for (int seg = 0; seg < 2; ++seg) {
    const int base = seg == 0 ? TLAT + b * CL : b * SL;
    const int len = seg == 0 ? CL : SL;
    for (int c0 = 0; c0 < len; c0 += 32) {
      __syncthreads();
      for (int i = tid; i < 2048; i += 256) {
        int st = i >> 6, k = i & 63;
        int row = dir ? base + len - 1 - (c0 + st) : base + c0 + st;
        const float* z = p.Z + (size_t)row * NIN;
        sq[i] = z[ZC_MQ + h * 64 + k] * 0.125f;
        sk[i] = z[ZC_MK + h * 64 + k];
      }
      for (int i = tid; i < 1024; i += 256) {
        int st = i >> 5, vv = i & 31;
        int row = dir ? base + len - 1 - (c0 + st) : base + c0 + st;
        sv[i] = p.Z[(size_t)row * NIN + ZC_MV + h * 128 + vq * 32 + vv];
      }
      if (tid < 32) {
        int row = dir ? base + len - 1 - (c0 + tid) : base + c0 + tid;
        const float* z = p.Z + (size_t)row * NIN + ZC_MG + dir * 8;
        si[tid] = expf(z[h] + bi);
        sf[tid] = sigmoidf_(z[4 + h] + bfv);
      }
      __syncthreads();
      for (int st = 0; st < 32; ++st) {
        const float f = sf[st], ig = si[st];
        const float vv = sv[st * 32 + vl] * ig;
        float num = 0.f, den = 0.f;
#pragma unroll
        for (int j = 0; j < 8; ++j) {
          const int k = j * 8 + kc;
          const float kk = sk[st * 64 + k], qq = sq[st * 64 + k];
          Cs[j] = f * Cs[j] + vv * kk;
          ns[j] = f * ns[j] + ig * kk;
          num += Cs[j] * qq;
          den += ns[j] * qq;
        }
        num += __shfl_xor(num, 1); num += __shfl_xor(num, 2); num += __shfl_xor(num, 4);
        den += __shfl_xor(den, 1); den += __shfl_xor(den, 2); den += __shfl_xor(den, 4);
        if (kc == 0) {
          int row = dir ? base + len - 1 - (c0 + st) : base + c0 + st;
          hout[(size_t)row * 512 + h * 128 + vq * 32 + vl] = num / fmaxf(fabsf(den), 1.f);
        }
      }
    }
  }
}

__device__ __forceinline__ void s5_item(const P& p, int layer, int item, char* smem) {
  const int g = item & 31, dir = (item >> 5) & 1, b = item >> 6;
  float* sxr = (float*)smem;
  float* sxi = sxr + 64 * 65;
  float* su = sxi + 64 * 65;
  float* scr = su + 64 * 16;
  float* sci = scr + 16 * 64;
  const int tid = threadIdx.x, sp = tid & 63, tq = tid >> 6;
  const int dg = (layer * 2 + dir) * 32 + g;
  const float lr = p.lam_re[dg * 64 + sp], li = p.lam_im[dg * 64 + sp];
  const float dt = expf(p.log_dt[dg]);
  const float mag = expf(lr * dt);
  const float ar = mag * cosf(li * dt), ai = mag * sinf(li * dt);
  const float den = lr * lr + li * li;
  const float cr_ = ((ar - 1.f) * lr + ai * li) / den;
  const float ci_ = (ai * lr - (ar - 1.f) * li) / den;
  float bbr[16], bbi[16];
#pragma unroll
  for (int c = 0; c < 16; ++c) {
    float br = p.b_re[((size_t)(layer * 32 + g) * 64 + sp) * 16 + c];
    float bim = p.b_im[((size_t)(layer * 32 + g) * 64 + sp) * 16 + c];
    bbr[c] = cr_ * br - ci_ * bim;
    bbi[c] = cr_ * bim + ci_ * br;
  }
  __syncthreads();
  for (int i = tid; i < 1024; i += 256) {
    scr[i] = p.c_re[(size_t)(layer * 32 + g) * 1024 + i];
    sci[i] = p.c_im[(size_t)(layer * 32 + g) * 1024 + i];
  }
  float xr = 0.f, xi = 0.f;
  float* rout = dir ? p.s5_rb : p.s5_rf;
  for (int seg = 0; seg < 2; ++seg) {
    const int base = seg == 0 ? TLAT + b * CL : b * SL;
    const int len = seg == 0 ? CL : SL;
    for (int c0 = 0; c0 < len; c0 += 64) {
      __syncthreads();
      for (int i = tid; i < 1024; i += 256) {
        int st = i >> 4, c = i & 15;
        int row = dir ? base + len - 1 - (c0 + st) : base + c0 + st;
        su[i] = p.Z[(size_t)row * NIN + ZC_U + g * 16 + c];
      }
      __syncthreads();
      for (int tt = 0; tt < 16; ++tt) {
        const int t = tq * 16 + tt;
        float ur = 0.f, ui = 0.f;
#pragma unroll
        for (int c = 0; c < 16; ++c) { float uu = su[t * 16 + c]; ur += bbr[c] * uu; ui += bbi[c] * uu; }
        sxr[t * 65 + sp] = ur; sxi[t * 65 + sp] = ui;
      }
      __syncthreads();
      if (tq == 0) {
        for (int t = 0; t < 64; ++t) {
          float ur = sxr[t * 65 + sp], ui = sxi[t * 65 + sp];
          float nr = ar * xr - ai * xi + ur;
          float ni = ar * xi + ai * xr + ui;
          xr = nr; xi = ni;
          sxr[t * 65 + sp] = xr; sxi[t * 65 + sp] = xi;
        }
      }
      __syncthreads();
      {
        const int t = sp;
        const int row = dir ? base + len - 1 - (c0 + t) : base + c0 + t;
#pragma unroll
        for (int cc = 0; cc < 4; ++cc) {
          const int c = tq * 4 + cc;
          float y = 0.f;
          for (int pp = 0; pp < 64; ++pp) y += scr[c * 64 + pp] * sxr[t * 65 + pp] - sci[c * 64 + pp] * sxi[t * 65 + pp];
          rout[(size_t)row * 512 + g * 16 + c] = y;
        }
      }
    }
  }
}

#define N_SSD_ITEMS 128
#define N_ML_ITEMS 64
#define N_S5_ITEMS 128
#define N_ATT_LAT 256
#define N_ATT_CTX 16
__device__ __forceinline__ void ph_mix(const P& p, int layer, char* smem) {
  const int nitems = N_S5_ITEMS + N_SSD_ITEMS + N_ML_ITEMS + N_ATT_LAT + (layer == 0 ? N_ATT_CTX : 0);
  for (int w = blockIdx.x; w < nitems; w += gridDim.x) {
    int it = w;
    if (it < N_S5_ITEMS) { s5_item(p, layer, it, smem); continue; }
    it -= N_S5_ITEMS;
    if (it < N_SSD_ITEMS) { ssd_item(p, layer, it, smem); continue; }
    it -= N_SSD_ITEMS;
    if (it < N_ML_ITEMS) { mlstm_item(p, layer, it, smem); continue; }
    it -= N_ML_ITEMS;
    {
      const float *qp, *kp, *vp; float* op; int nk;
      if (it < N_ATT_LAT) {
        int qb = it & 31, hh = (it >> 5) & 3, b = it >> 7;
        qp = p.Q + ((size_t)(b * 4 + hh) * SL + qb * 128) * 192; kp = p.K + (size_t)(b * 4 + hh) * NKEY * 192;
        vp = p.V + (size_t)(b * 4 + hh) * NKEY * 128; nk = NKEY; op = p.O + (size_t)(b * SL + qb * 128) * 512 + hh * 128;
      } else {
        it -= N_ATT_LAT;
        int qb = it & 1, hh = (it >> 1) & 3, b = it >> 3;
        qp = p.Qc + ((size_t)(b * 4 + hh) * CL + qb * 128) * 192; kp = p.K + ((size_t)(b * 4 + hh) * NKEY + SL) * 192;
        vp = p.V + ((size_t)(b * 4 + hh) * NKEY + SL) * 128; nk = CL; op = p.O + (size_t)(TLAT + b * CL + qb * 128) * 512 + hh * 128;
      }
      attn_item(qp, kp, vp, nk, op, smem);
    }
  }
}

__device__ __forceinline__ float gelu_tanh(float x) {
  const float k0 = 0.7978845608028654f;
  return 0.5f * x * (1.f + tanhf(k0 * (x + 0.044715f * x * x * x)));
}
__device__ __forceinline__ void ph_s5pre(const P& p, int layer, char* smem) {
  const size_t n = (size_t)TTOT * 512;
  for (size_t i = (size_t)blockIdx.x * 256 + threadIdx.x; i < n; i += (size_t)gridDim.x * 256) {
    int r = (int)(i >> 9), c = (int)(i & 511);
    float u = p.Z[(size_t)r * NIN + ZC_U + c];
    float y = p.s5_rf[i] + p.s5_rb[i] + p.s5_d[layer * 512 + c] * u;
    p.ydpre[i] = gelu_tanh(y);
  }
}
__device__ __forceinline__ void ph_glu(const P& p, int layer, char* smem) {
  const float* yp = p.ydpre; float* yg = p.ydg; const float* gb = p.glu_b + layer * 512;
  auto epi = [=](int row, int col, float v) {
    float y = yp[(size_t)row * 512 + col];
    yg[(size_t)row * 512 + col] = y * sigmoidf_(v + gb[col]);
  };
  gemm_dense(p.ydpre, 512, p.glu_w + (size_t)layer * 512 * 512, 512, TTOT, 512, 512, epi, smem);
}

__device__ __forceinline__ void ph_final_mix(const P& p, int layer, char* smem) {
  float* red = (float*)smem;
  const int tid = threadIdx.x;
  const float* onw = p.out_norm_w + layer * 2048;
  for (int r = blockIdx.x; r < TTOT; r += gridDim.x) {
    const int c = tid * 2;
    const float* z = p.Z + (size_t)r * NIN;
    float2 oa = *(const float2*)(p.O + (size_t)r * 512 + c);
    float sa = block_sum(oa.x * oa.x + oa.y * oa.y, red);
    float ra = rsqrtf(sa * (1.f / 512.f) + EPSV);
    float2 yf = *(const float2*)(p.ssd_yf + (size_t)r * 512 + c);
    float2 yb = *(const float2*)(p.ssd_yb + (size_t)r * 512 + c);
    float2 xs = *(const float2*)(p.ssd_xs + (size_t)r * 512 + c);
    float2 zz = *(const float2*)(z + ZC_BZ + c);
    float dsk = p.ssd_d[layer * 8 + (c >> 6)];
    float b0 = (yf.x + yb.x + dsk * xs.x) * siluf_(zz.x);
    float b1 = (yf.y + yb.y + dsk * xs.y) * siluf_(zz.y);
    float sb = block_sum(b0 * b0 + b1 * b1, red);
    float rb = rsqrtf(sb * (1.f / 512.f) + EPSV);
    float2 hf = *(const float2*)(p.ml_hf + (size_t)r * 512 + c);
    float2 hb = *(const float2*)(p.ml_hb + (size_t)r * 512 + c);
    float c0 = hf.x + hb.x, c1 = hf.y + hb.y;
    float scs = wave_sum(c0 * c0 + c1 * c1);
    float rc = rsqrtf(scs * (1.f / 128.f) + EPSV);
    float2 og = *(const float2*)(z + ZC_MO + c);
    c0 = c0 * rc * sigmoidf_(og.x); c1 = c1 * rc * sigmoidf_(og.y);
    float2 yd = *(const float2*)(p.ydg + (size_t)r * 512 + c);
    float sd = block_sum(yd.x * yd.x + yd.y * yd.y, red);
    float rd = rsqrtf(sd * (1.f / 512.f) + EPSV);
    float* Y = p.Y + (size_t)r * 2048;
    Y[c] = oa.x * ra * onw[c];                 Y[c + 1] = oa.y * ra * onw[c + 1];
    Y[512 + c] = b0 * rb * onw[512 + c];       Y[512 + c + 1] = b1 * rb * onw[512 + c + 1];
    Y[1024 + c] = c0 * onw[1024 + c];          Y[1024 + c + 1] = c1 * onw[1024 + c + 1];
    Y[1536 + c] = yd.x * rd * onw[1536 + c];   Y[1536 + c + 1] = yd.y * rd * onw[1536 + c + 1];
  }
}

__device__ __forceinline__ void ph_wout(const P& p, int layer, char* smem) {
  const P pp = p;
  const int M = layer == 0 ? TTOT : TLAT;
  auto epi = [=](int row, int col, float v) {
    const int mi = row_modidx(row);
    const float g1 = pp.modv[(layer * 3 + mi) * 12288 + 2 * 2048 + col];
    float xin;
    if (layer == 0) xin = row < TLAT ? pp.x[(size_t)row * 2048 + col] : pp.ctx[(size_t)(row - TLAT) * 2048 + col];
    else xin = pp.X[(size_t)row * 2048 + col];
    pp.X[(size_t)row * 2048 + col] = xin + g1 * v;
  };
  gemm_dense(p.Y, 2048, p.w_out + (size_t)layer * 2048 * 2048, 2048, M, 2048, 2048, epi, smem);
}

__device__ __forceinline__ void ph_router(const P& p, int layer, char* smem) {
  float* red = (float*)smem;
  float* lred = red + 4;
  float* lg = lred + 4 * 36;
  const int tid = threadIdx.x, lane = tid & 63, wid = tid >> 6;
  const int T = layer == 0 ? TTOT : TLAT;
  const float* nw = p.norm2_w + layer * 2048;
  const float* wg = p.w_group + (size_t)layer * 2048 * 4;
  const float* we = p.w_expert + (size_t)layer * 2048 * 32;
  for (int r = blockIdx.x; r < T; r += gridDim.x) {
    const int mi = row_modidx(r);
    const float* mrow = p.modv + (layer * 3 + mi) * 12288;
    const int k0 = tid * 8;
    float v[8]; float ss = 0.f;
#pragma unroll
    for (int hf = 0; hf < 2; ++hf) {
      float4 xv = *(const float4*)(p.X + (size_t)r * 2048 + k0 + hf * 4);
      v[hf * 4 + 0] = xv.x; v[hf * 4 + 1] = xv.y; v[hf * 4 + 2] = xv.z; v[hf * 4 + 3] = xv.w;
      ss += xv.x * xv.x + xv.y * xv.y + xv.z * xv.z + xv.w * xv.w;
    }
    float tot = block_sum(ss, red);
    float rs = rsqrtf(tot * (1.f / 2048.f) + EPSV);
#pragma unroll
    for (int i = 0; i < 8; ++i) {
      int col = k0 + i;
      v[i] = v[i] * rs * nw[col] * (1.f + mrow[4 * 2048 + col]) + mrow[3 * 2048 + col];
    }
    *(float4*)(p.H + (size_t)r * 2048 + k0) = make_float4(v[0], v[1], v[2], v[3]);
    *(float4*)(p.H + (size_t)r * 2048 + k0 + 4) = make_float4(v[4], v[5], v[6], v[7]);
    float lgt[36];
#pragma unroll
    for (int j = 0; j < 36; ++j) lgt[j] = 0.f;
#pragma unroll
    for (int i = 0; i < 8; ++i) {
      float4 g4 = *(const float4*)(wg + (size_t)(k0 + i) * 4);
      lgt[0] += v[i] * g4.x; lgt[1] += v[i] * g4.y; lgt[2] += v[i] * g4.z; lgt[3] += v[i] * g4.w;
#pragma unroll
      for (int j4 = 0; j4 < 8; ++j4) {
        float4 e4 = *(const float4*)(we + (size_t)(k0 + i) * 32 + j4 * 4);
        lgt[4 + j4 * 4 + 0] += v[i] * e4.x; lgt[4 + j4 * 4 + 1] += v[i] * e4.y;
        lgt[4 + j4 * 4 + 2] += v[i] * e4.z; lgt[4 + j4 * 4 + 3] += v[i] * e4.w;
      }
    }
#pragma unroll
    for (int j = 0; j < 36; ++j) lgt[j] = wave_sum(lgt[j]);
    __syncthreads();
    if (lane == 0) {
#pragma unroll
      for (int j = 0; j < 36; ++j) lred[wid * 36 + j] = lgt[j];
    }
    __syncthreads();
    if (tid < 36) lg[tid] = lred[tid] + lred[36 + tid] + lred[72 + tid] + lred[108 + tid];
    __syncthreads();
    if (tid == 0) {
      int gi = 0; float gm = lg[0];
      for (int j = 1; j < 4; ++j) if (lg[j] > gm) { gm = lg[j]; gi = j; }
      float gs = 0.f;
      for (int j = 0; j < 4; ++j) gs += expf(lg[j] - gm);
      float gw = 1.f / gs;
      const float* el = lg + 4 + gi * 8;
      int i1 = 0; float v1 = el[0];
      for (int j = 1; j < 8; ++j) if (el[j] > v1) { v1 = el[j]; i1 = j; }
      int i2 = -1; float v2 = -INFINITY;
      for (int j = 0; j < 8; ++j) if (j != i1 && el[j] > v2) { v2 = el[j]; i2 = j; }
      float e2 = expf(v2 - v1);
      float w1 = gw / (1.f + e2), w2 = gw * e2 / (1.f + e2);
      int ex1 = gi * 8 + i1, ex2 = gi * 8 + i2;
      int* cnt = p.cnt + layer * 32;
      int p1 = atomicAdd(&cnt[ex1], 1);
      p.list_tok[ex1 * CAPE + p1] = r * 2; p.list_w[ex1 * CAPE + p1] = w1;
      int p2 = atomicAdd(&cnt[ex2], 1);
      p.list_tok[ex2 * CAPE + p2] = r * 2 + 1; p.list_w[ex2 * CAPE + p2] = w2;
    }
  }
}

struct AGather { const float* H; const int* toks; int nvalid;
  __device__ __forceinline__ const float* row(int r) const { return r < nvalid ? H + (size_t)(toks[r] >> 1) * 2048 : nullptr; }
  __device__ __forceinline__ const float* safe() const { return H; } };
struct BGateUp { const float *g, *u; int ldb; int nb;
  __device__ __forceinline__ const float* col(int v) const { int wc = v >> 6, j = (v >> 5) & 1, c = v & 31;
    const float* b = (const float*)((uintptr_t)g + (uintptr_t)j * ((uintptr_t)u - (uintptr_t)g)); return b + nb + wc * 32 + c; }
  __device__ __forceinline__ const float* safe() const { return g; } };

__device__ __forceinline__ void moe_prefix(const P& p, int layer, int* spre) {
  __syncthreads();
  if (threadIdx.x == 0) {
    int acc = 0;
    for (int e = 0; e < 32; ++e) { spre[e] = acc; acc += (p.cnt[layer * 32 + e] + 127) >> 7; }
    spre[32] = acc;
  }
  __syncthreads();
}
__device__ __forceinline__ void ph_moe_up(const P& p, int layer, char* smem) {
  int* spre = (int*)(smem + 40960);
  moe_prefix(p, layer, spre);
  const int ntile = spre[32];
  for (int w = blockIdx.x; w < ntile * 8; w += gridDim.x) {
    const int rbg = w >> 3, nt = w & 7;
    int e = 0;
    while (e < 31 && spre[e + 1] <= rbg) ++e;
    const int rb = rbg - spre[e];
    const int cnt = p.cnt[layer * 32 + e];
    AGather af{p.H, p.list_tok + e * CAPE + rb * 128, cnt - rb * 128};
    const size_t wo = ((size_t)layer * 32 + e) * 2048 * 512;
    BGateUp bf{p.w_gate + wo, p.w_up + wo, 512, nt * 64};
    float* act = p.ACT + (size_t)rbg * 128 * 512 + nt * 64;
    auto ef = [&](const f32x16 (&acc)[2][2], int wr, int wc, int lane) {
#pragma unroll
      for (int i = 0; i < 2; ++i)
#pragma unroll
        for (int r = 0; r < 16; ++r) {
          int row = ACC_ROW(wr, i, r, lane);
          float gv = acc[i][0][r], uv = acc[i][1][r];
          act[(size_t)row * 512 + wc * 32 + (lane & 31)] = siluf_(gv) * uv;
        }
    };
    gemm_tile(af, bf, ef, 2048, smem);
  }
}
__device__ __forceinline__ void ph_moe_down(const P& p, int layer, char* smem) {
  int* spre = (int*)(smem + 40960);
  moe_prefix(p, layer, spre);
  const int ntile = spre[32];
  for (int w = blockIdx.x; w < ntile * 16; w += gridDim.x) {
    const int rbg = w >> 4, nt = w & 15;
    int e = 0;
    while (e < 31 && spre[e + 1] <= rbg) ++e;
    const int rb = rbg - spre[e];
    const int nvalid = p.cnt[layer * 32 + e] - rb * 128;
    ARows af{p.ACT + (size_t)rbg * 128 * 512, 512, 0, 128};
    BPlain bf{p.w_down + ((size_t)layer * 32 + e) * 512 * 2048, 2048, nt * 128, 2048};
    const int* toks = p.list_tok + e * CAPE + rb * 128;
    const float* lw = p.list_w + e * CAPE + rb * 128;
    float* Ys = p.Yslot;
    auto ef = [&](const f32x16 (&acc)[2][2], int wr, int wc, int lane) {
#pragma unroll
      for (int i = 0; i < 2; ++i)
#pragma unroll
        for (int r = 0; r < 16; ++r) {
          int row = ACC_ROW(wr, i, r, lane);
          if (row < nvalid) {
            int ts = toks[row]; float wgt = lw[row];
#pragma unroll
            for (int j = 0; j < 2; ++j) Ys[(size_t)ts * 2048 + nt * 128 + ACC_COL(wc, j, lane)] = wgt * acc[i][j][r];
          }
        }
    };
    gemm_tile(af, bf, ef, 512, smem);
  }
}

__device__ __forceinline__ void ph_out(const P& p, char* smem) {
  float* red = (float*)smem;
  const int tid = threadIdx.x;
  for (int r = blockIdx.x; r < TLAT; r += gridDim.x) {
    const int mi = r >> 12;
    const float* g2 = p.modv + (1 * 3 + mi) * 12288 + 5 * 2048;
    float v[8]; float ss = 0.f;
#pragma unroll
    for (int hf = 0; hf < 2; ++hf) {
      int col = hf * 1024 + tid * 4;
      float4 xv = *(const float4*)(p.X + (size_t)r * 2048 + col);
      float4 gv = *(const float4*)(g2 + col);
      float4 y0 = *(const float4*)(p.Yslot + (size_t)(2 * r) * 2048 + col);
      float4 y1 = *(const float4*)(p.Yslot + (size_t)(2 * r + 1) * 2048 + col);
      xv.x += gv.x * (y0.x + y1.x); xv.y += gv.y * (y0.y + y1.y);
      xv.z += gv.z * (y0.z + y1.z); xv.w += gv.w * (y0.w + y1.w);
      v[hf * 4 + 0] = xv.x; v[hf * 4 + 1] = xv.y; v[hf * 4 + 2] = xv.z; v[hf * 4 + 3] = xv.w;
      ss += xv.x * xv.x + xv.y * xv.y + xv.z * xv.z + xv.w * xv.w;
    }
    float tot = block_sum(ss, red);
    float rs = rsqrtf(tot * (1.f / 2048.f) + EPSV);
#pragma unroll
    for (int hf = 0; hf < 2; ++hf) {
      int col = hf * 1024 + tid * 4;
      float4 w4 = *(const float4*)(p.final_w + col);
      float4 o;
      o.x = v[hf * 4 + 0] * rs * w4.x; o.y = v[hf * 4 + 1] * rs * w4.y;
      o.z = v[hf * 4 + 2] * rs * w4.z; o.w = v[hf * 4 + 3] * rs * w4.w;
      *(float4*)(p.out + (size_t)r * 2048 + col) = o;
    }
  }
}

#define XB_TMO      128
#define XB_XCNT(j)  (256  + 64 * (j))
#define XB_XSUB(j)  (1280 + 64 * (j))
#define XB_XGEN(j)  (2304 + 64 * (j))
#define XB_TOP      3328
#define XB_TOPGEN   3392
#define XCD_BAR_WORDS 3456
#define XB_SPIN_CAP (1u << 22)
#define LAS __attribute__((address_space(3)))
__device__ __forceinline__ unsigned xb_ld(unsigned* p)              { return __hip_atomic_load(p, __ATOMIC_RELAXED, __HIP_MEMORY_SCOPE_AGENT); }
__device__ __forceinline__ unsigned xb_add(unsigned* p, unsigned v) { return __hip_atomic_fetch_add(p, v, __ATOMIC_RELAXED, __HIP_MEMORY_SCOPE_AGENT); }
__device__ __forceinline__ unsigned xb_xcc_id() { return (unsigned)__builtin_amdgcn_s_getreg((3 << 11) | 20) & 0xFu; }
#define XB_SPIN(cond, bar) do { unsigned _sp = 0; while (cond) { __builtin_amdgcn_s_sleep(1); \
    if ((++_sp & 255u) == 0u) { if (xb_ld(&(bar)[XB_TMO])) break; if (_sp > XB_SPIN_CAP) { atomicAdd(&(bar)[XB_TMO], 1u); break; } } } } while (0)
struct XcdBarrier { unsigned* bar; unsigned x; volatile LAS unsigned* st; };
__device__ __forceinline__ XcdBarrier xcd_barrier_post(unsigned* bar, volatile LAS unsigned* st) {
    XcdBarrier b; b.bar = bar; b.x = xb_xcc_id(); b.st = st;
    if (threadIdx.x == 0) (void)xb_add(&bar[XB_XCNT(b.x)], 1u);
    return b;
}
__device__ __forceinline__ void xcd_barrier_complete(unsigned* bar, unsigned x, unsigned& nloc, unsigned& nx) {
    const unsigned G = gridDim.x * gridDim.y * gridDim.z;
    unsigned sum, cnt, mine, sp = 0u;
    for (;;) {
        sum = 0u; cnt = 0u; mine = 0u;
#pragma unroll
        for (unsigned j = 0; j < 16; ++j) { const unsigned c = xb_ld(&bar[XB_XCNT(j)]); sum += c; cnt += (c > 0u) ? 1u : 0u; mine = (j == x) ? c : mine; }
        if (sum == G) break;
        __builtin_amdgcn_s_sleep(1);
        if ((++sp & 255u) == 0u) { if (xb_ld(&bar[XB_TMO])) break; if (sp > XB_SPIN_CAP) { atomicAdd(&bar[XB_TMO], 1u); break; } }
    }
    nloc = mine > 0u ? mine : 1u; nx = cnt > 0u ? cnt : 1u;
}
__device__ __forceinline__ void xcd_barrier(const XcdBarrier& b) {
    asm volatile("s_waitcnt vmcnt(0)" ::: "memory");
    __syncthreads();
    if (threadIdx.x == 0) {
        unsigned* bar = b.bar;
        __builtin_amdgcn_s_waitcnt(0);
        unsigned nloc = b.st[0], nx = b.st[1];
        if (nloc == 0u) { xcd_barrier_complete(bar, b.x, nloc, nx); b.st[0] = nloc; b.st[1] = nx; }
        const unsigned old = xb_add(&bar[XB_XSUB(b.x)], 1u);
        const unsigned gen = old / nloc;
        if (old + 1u == (gen + 1u) * nloc) {
            __builtin_amdgcn_fence(__ATOMIC_RELEASE, "agent");
            asm volatile("s_waitcnt vmcnt(0)" ::: "memory");
            const unsigned og = xb_add(&bar[XB_TOP], 1u);
            const unsigned tg = og / nx;
            if (og + 1u == (tg + 1u) * nx) xb_add(&bar[XB_TOPGEN], 1u);
            else XB_SPIN(xb_ld(&bar[XB_TOPGEN]) == tg, bar);
            __builtin_amdgcn_fence(__ATOMIC_ACQUIRE, "agent");
            xb_add(&bar[XB_XGEN(b.x)], 1u);
            asm volatile("s_waitcnt vmcnt(0)" ::: "memory");
        } else {
            XB_SPIN(xb_ld(&bar[XB_XGEN(b.x)]) == gen, bar);
            __builtin_amdgcn_fence(__ATOMIC_ACQUIRE, "agent");
            asm volatile("s_waitcnt vmcnt(0)" ::: "memory");
        }
    }
    __syncthreads();
}

__global__ void __launch_bounds__(256, 1) k_fused(P p, unsigned* bar) {
  extern __shared__ __attribute__((aligned(16))) char smem_all[];
  char* smem = smem_all + 64;
  if (threadIdx.x == 0) *(uint4*)smem_all = make_uint4(0u, 0u, 0u, 0u);
  __syncthreads();
  XcdBarrier b = xcd_barrier_post(bar, (volatile LAS unsigned*)smem_all);
  ph_mod(p, smem); xcd_barrier(b);
  {
    ph_norm1(p, 0, smem); xcd_barrier(b);
    ph_win(p, 0, smem); xcd_barrier(b);
    ph_prep(p, 0, smem); xcd_barrier(b);
    ph_qkv(p, 0, smem); xcd_barrier(b);
    ph_mlapost(p, 0, smem); xcd_barrier(b);
    ph_mix(p, 0, smem); xcd_barrier(b);
    ph_s5pre(p, 0, smem); xcd_barrier(b);
    ph_glu(p, 0, smem); xcd_barrier(b);
    ph_final_mix(p, 0, smem); xcd_barrier(b);
    ph_wout(p, 0, smem); xcd_barrier(b);
    ph_router(p, 0, smem); xcd_barrier(b);
    ph_moe_up(p, 0, smem); xcd_barrier(b);
    ph_moe_down(p, 0, smem); xcd_barrier(b);
  }
  {
    ph_norm1(p, 1, smem); xcd_barrier(b);
    ph_win(p, 1, smem); xcd_barrier(b);
    ph_prep(p, 1, smem); xcd_barrier(b);
    ph_qkv(p, 1, smem); xcd_barrier(b);
    ph_mlapost(p, 1, smem); xcd_barrier(b);
    ph_mix(p, 1, smem); xcd_barrier(b);
    ph_s5pre(p, 1, smem); xcd_barrier(b);
    ph_glu(p, 1, smem); xcd_barrier(b);
    ph_final_mix(p, 1, smem); xcd_barrier(b);
    ph_wout(p, 1, smem); xcd_barrier(b);
    ph_router(p, 1, smem); xcd_barrier(b);
    ph_moe_up(p, 1, smem); xcd_barrier(b);
    ph_moe_down(p, 1, smem); xcd_barrier(b);
  }
  ph_out(p, smem);
}

#define SMEM_BYTES 49152
template <int PH>
__global__ void __launch_bounds__(256) k_phase(P p, int layer) {
  extern __shared__ __attribute__((aligned(16))) char smem[];
  if (PH == 0) ph_mod(p, smem);
  if (PH == 1) ph_norm1(p, layer, smem);
  if (PH == 2) ph_win(p, layer, smem);
  if (PH == 3) ph_prep(p, layer, smem);
  if (PH == 4) ph_qkv(p, layer, smem);
  if (PH == 5) ph_mlapost(p, layer, smem);
  if (PH == 6) ph_mix(p, layer, smem);
  if (PH == 7) ph_s5pre(p, layer, smem);
  if (PH == 8) ph_glu(p, layer, smem);
  if (PH == 9) ph_final_mix(p, layer, smem);
  if (PH == 10) ph_wout(p, layer, smem);
  if (PH == 11) ph_router(p, layer, smem);
  if (PH == 12) ph_moe_up(p, layer, smem);
  if (PH == 13) ph_moe_down(p, layer, smem);
  if (PH == 14) ph_out(p, smem);
}

extern "C" void kernel_launch(void* const* d_in, const int* in_sizes, int n_in, void* d_out, int out_size, void* d_ws,
                              size_t ws_size, hipStream_t stream) {
  P p{};
  const float* const* in = (const float* const*)d_in;
  p.x = in[0]; p.c = in[1]; p.ctx = in[2]; p.c_ctx = in[3]; p.mod_w = in[4]; p.mod_b = in[5]; p.norm1_w = in[6];
  p.w_in = in[7]; p.q_norm_w = in[8]; p.kv_norm_w = in[9]; p.w_uq = in[10]; p.w_ukv = in[11]; p.conv_w = in[12];
  p.conv_b = in[13]; p.a_log = in[14]; p.dt_bias = in[15]; p.ssd_d = in[16]; p.gate_b = in[17]; p.lam_re = in[18];
  p.lam_im = in[19]; p.log_dt = in[20]; p.b_re = in[21]; p.b_im = in[22]; p.c_re = in[23]; p.c_im = in[24];
  p.s5_d = in[25]; p.glu_w = in[26]; p.glu_b = in[27]; p.out_norm_w = in[28]; p.w_out = in[29]; p.norm2_w = in[30];
  p.w_group = in[31]; p.w_expert = in[32]; p.w_gate = in[33]; p.w_up = in[34]; p.w_down = in[35]; p.final_w = in[36];
  p.out = (float*)d_out;
  float* w = (float*)d_ws;
  size_t off = 0;
  auto take = [&](size_t n) { float* r = w + off; off += (n + 63) & ~(size_t)63; return r; };
  p.cnt = (int*)take(64);
  p.modv = take(2 * 3 * 12288);
  p.H = take((size_t)TTOT * 2048);
  p.X = take((size_t)TTOT * 2048);
  p.Z = take((size_t)TTOT * NIN);
  p.Aq = take((size_t)TTOT * 384);
  p.Akv = take((size_t)TTOT * 128);
  p.qraw = take((size_t)TTOT * 768);
  p.kvraw = take((size_t)TTOT * 1024);
  p.Q = take((size_t)8 * SL * 192);
  p.Qc = take((size_t)8 * CL * 192);
  p.K = take((size_t)8 * NKEY * 192);
  p.V = take((size_t)8 * NKEY * 128);
  p.O = take((size_t)TTOT * 512);
  p.ssd_xs = take((size_t)TTOT * 512);
  p.ssd_B = take((size_t)TTOT * 256);
  p.ssd_C = take((size_t)TTOT * 256);
  p.ssd_dt = take((size_t)TTOT * 16);
  p.ssd_yf = take((size_t)TTOT * 512);
  p.ssd_yb = take((size_t)TTOT * 512);
  p.ml_hf = take((size_t)TTOT * 512);
  p.ml_hb = take((size_t)TTOT * 512);
  p.s5_rf = take((size_t)TTOT * 512);
  p.s5_rb = take((size_t)TTOT * 512);
  p.ydpre = take((size_t)TTOT * 512);
  p.ydg = take((size_t)TTOT * 512);
  p.Y = take((size_t)TTOT * 2048);
  p.list_tok = (int*)take((size_t)32 * CAPE);
  p.list_w = take((size_t)32 * CAPE);
  p.ACT = take((size_t)ACT_ROWS * 512);
  p.Yslot = take((size_t)TTOT * 2 * 2048);
  (void)ws_size; (void)in_sizes; (void)n_in; (void)out_size;

#ifdef MULTI_LAUNCH
  const int G = 1024;
#define LAUNCH(PH, grid, layer) hipLaunchKernelGGL((k_phase<PH>), dim3(grid), dim3(256), SMEM_BYTES, stream, p, layer)
  LAUNCH(0, 192, 0);
  for (int l = 0; l < 2; ++l) {
    LAUNCH(1, G, l); LAUNCH(2, G, l); LAUNCH(3, G, l); LAUNCH(4, G, l); LAUNCH(5, G, l); LAUNCH(6, 592, l); LAUNCH(7, G, l);
    LAUNCH(8, G, l); LAUNCH(9, G, l); LAUNCH(10, G, l); LAUNCH(11, G, l); LAUNCH(12, G, l); LAUNCH(13, G, l);
  }
  LAUNCH(14, G, 0);
#else
  unsigned* bar = (unsigned*)take(XCD_BAR_WORDS);
  static int grid = 0;
  if (!grid) {
    int dev = 0, cus = 0, per_cu = 0;
    hipGetDevice(&dev);
    hipDeviceGetAttribute(&cus, hipDeviceAttributeMultiprocessorCount, dev);
    hipOccupancyMaxActiveBlocksPerMultiprocessor(&per_cu, k_fused, 256, SMEM_BYTES + 64);
    if (per_cu < 1) per_cu = 1;
    grid = cus * (per_cu < 1 ? per_cu : 1);
  }
  hipMemsetAsync(bar, 0, XCD_BAR_WORDS * sizeof(unsigned), stream);
  hipLaunchKernelGGL(k_fused, dim3(grid), dim3(256), SMEM_BYTES + 64, stream, p, bar);
#endif
}
```

```cpp
#include <hip/hip_runtime.h>
#include <stdint.h>

#define DM 2048
#define SL 4096
#define CL 256
#define TLAT 8192
#define TCTX 512
#define TTOT 8704
#define NIN 4192
#define NKEY 4352
#define ZC_CQ 0
#define ZC_CKV 384
#define ZC_KR 512
#define ZC_BZ 576
#define ZC_XBC 1088
#define ZC_DT 2112
#define ZC_MQ 2128
#define ZC_MK 2384
#define ZC_MV 2640
#define ZC_MO 3152
#define ZC_MG 3664
#define ZC_U 3680
#define CAPE 8704
#define EPSV 1e-6f
#define ACT_ROWS 21632

typedef float f32x16 __attribute__((ext_vector_type(16)));
typedef short bf16x8 __attribute__((ext_vector_type(8)));
typedef float f32x4v __attribute__((ext_vector_type(4)));
typedef unsigned short bfraw;
__device__ __forceinline__ unsigned pack_bf16(float lo, float hi) {
  typedef __bf16 bf2 __attribute__((ext_vector_type(2)));
  bf2 v; v[0] = (__bf16)lo; v[1] = (__bf16)hi;
  return __builtin_bit_cast(unsigned, v);
}
__device__ __forceinline__ bfraw to_bf16(float x) { __bf16 b = (__bf16)x; return __builtin_bit_cast(unsigned short, b); }
__device__ __forceinline__ float from_bf16(bfraw x) { return __uint_as_float((unsigned)x << 16); }

struct P {
  const float *x, *c, *ctx, *c_ctx, *mod_w, *mod_b, *norm1_w, *w_in, *q_norm_w, *kv_norm_w, *w_uq, *w_ukv;
  const float *conv_w, *conv_b, *a_log, *dt_bias, *ssd_d, *gate_b, *lam_re, *lam_im, *log_dt, *b_re, *b_im;
  const float *c_re, *c_im, *s5_d, *glu_w, *glu_b, *out_norm_w, *w_out, *norm2_w, *w_group, *w_expert;
  const float *w_gate, *w_up, *w_down, *final_w;
  float* out;
  bfraw *H, *Aq, *Akv, *Y, *ACT, *ydpre_bf;
  float *modv, *X, *Z, *qraw, *kvraw, *Q, *Qc, *K, *V, *O;
  float *ssd_xs, *ssd_B, *ssd_C, *ssd_dt, *ssd_yf, *ssd_yb, *ml_hf, *ml_hb, *s5_rf, *s5_rb, *ydpre, *ydg;
  float *list_w, *Yslot;
  int *cnt, *list_tok;
};

__device__ __forceinline__ int row_modidx(int r) { return r < TLAT ? (r >> 12) : 2; }
__device__ __forceinline__ float sigmoidf_(float v) { return 1.f / (1.f + expf(-v)); }
__device__ __forceinline__ float siluf_(float v) { return v / (1.f + expf(-v)); }
__device__ __forceinline__ float wave_sum(float v) {
#pragma unroll
  for (int o = 32; o; o >>= 1) v += __shfl_xor(v, o);
  return v;
}
__device__ __forceinline__ float block_sum(float v, float* red) {
  v = wave_sum(v);
  __syncthreads();
  if ((threadIdx.x & 63) == 0) red[threadIdx.x >> 6] = v;
  __syncthreads();
  return red[0] + red[1] + red[2] + red[3];
}

__device__ __forceinline__ void ph_mod(const P& p, char* smem) {
  float* sc = (float*)smem;
  float* red = sc + 3 * 2048;
  const int tid = threadIdx.x;
  if (blockIdx.x == 0 && tid < 64) p.cnt[tid] = 0;
  for (int i = tid; i < 3 * 2048; i += 256) {
    int r = i >> 11, k = i & 2047;
    float v = r < 2 ? p.c[r * 2048 + k] : p.c_ctx[k];
    sc[i] = siluf_(v);
  }
  __syncthreads();
  for (int w = blockIdx.x; w < 2 * 96; w += gridDim.x) {
    int l = w / 96, j0 = (w % 96) * 128;
    int cg = tid & 31, ks = tid >> 5;
    const float* W = p.mod_w + (size_t)l * 2048 * 12288 + j0 + cg * 4;
    float acc[3][4];
#pragma unroll
    for (int r = 0; r < 3; ++r)
#pragma unroll
      for (int c = 0; c < 4; ++c) acc[r][c] = 0.f;
#pragma unroll 4
    for (int k = ks * 256; k < ks * 256 + 256; ++k) {
      float4 wv = *(const float4*)(W + (size_t)k * 12288);
      float s0 = sc[k], s1 = sc[2048 + k], s2 = sc[4096 + k];
      acc[0][0] += s0 * wv.x; acc[0][1] += s0 * wv.y; acc[0][2] += s0 * wv.z; acc[0][3] += s0 * wv.w;
      acc[1][0] += s1 * wv.x; acc[1][1] += s1 * wv.y; acc[1][2] += s1 * wv.z; acc[1][3] += s1 * wv.w;
      acc[2][0] += s2 * wv.x; acc[2][1] += s2 * wv.y; acc[2][2] += s2 * wv.z; acc[2][3] += s2 * wv.w;
    }
    __syncthreads();
#pragma unroll
    for (int r = 0; r < 3; ++r)
#pragma unroll
      for (int c = 0; c < 4; ++c) red[(ks * 32 + cg) * 12 + r * 4 + c] = acc[r][c];
    __syncthreads();
    for (int o = tid; o < 384; o += 256) {
      int r = o >> 7, c = o & 127;
      float s = 0.f;
#pragma unroll
      for (int q = 0; q < 8; ++q) s += red[(q * 32 + (c >> 2)) * 12 + r * 4 + (c & 3)];
      s += p.mod_b[l * 12288 + j0 + c];
      p.modv[(l * 3 + r) * 12288 + j0 + c] = s;
    }
    __syncthreads();
  }
}

__device__ __forceinline__ void ph_norm1(const P& p, int layer, char* smem) {
  float* red = (float*)smem;
  const int tid = threadIdx.x;
  const float* nw = p.norm1_w + layer * 2048;
  for (int r = blockIdx.x; r < TTOT; r += gridDim.x) {
    const int mi = row_modidx(r);
    const float* mrow = p.modv + (layer * 3 + mi) * 12288;
    float v[8];
    float ss = 0.f;
#pragma unroll
    for (int hf = 0; hf < 2; ++hf) {
      int col = hf * 1024 + tid * 4;
      float4 xv;
      if (layer == 0) {
        const float* src = r < TLAT ? p.x + (size_t)r * 2048 : p.ctx + (size_t)(r - TLAT) * 2048;
        xv = *(const float4*)(src + col);
      } else {
        xv = *(const float4*)(p.X + (size_t)r * 2048 + col);
        const float* g2 = p.modv + ((layer - 1) * 3 + mi) * 12288 + 5 * 2048;
        float4 gv = *(const float4*)(g2 + col);
        float4 y0 = *(const float4*)(p.Yslot + (size_t)(2 * r) * 2048 + col);
        float4 y1 = *(const float4*)(p.Yslot + (size_t)(2 * r + 1) * 2048 + col);
        xv.x += gv.x * (y0.x + y1.x); xv.y += gv.y * (y0.y + y1.y);
        xv.z += gv.z * (y0.z + y1.z); xv.w += gv.w * (y0.w + y1.w);
        *(float4*)(p.X + (size_t)r * 2048 + col) = xv;
      }
      v[hf * 4 + 0] = xv.x; v[hf * 4 + 1] = xv.y; v[hf * 4 + 2] = xv.z; v[hf * 4 + 3] = xv.w;
      ss += xv.x * xv.x + xv.y * xv.y + xv.z * xv.z + xv.w * xv.w;
    }
    float tot = block_sum(ss, red);
    float rs = rsqrtf(tot * (1.f / 2048.f) + EPSV);
#pragma unroll
    for (int hf = 0; hf < 2; ++hf) {
      int col = hf * 1024 + tid * 4;
      float4 w4 = *(const float4*)(nw + col);
      float4 sh = *(const float4*)(mrow + col);
      float4 scv = *(const float4*)(mrow + 2048 + col);
      float4 o;
      o.x = v[hf * 4 + 0] * rs * w4.x * (1.f + scv.x) + sh.x;
      o.y = v[hf * 4 + 1] * rs * w4.y * (1.f + scv.y) + sh.y;
      o.z = v[hf * 4 + 2] * rs * w4.z * (1.f + scv.z) + sh.z;
      o.w = v[hf * 4 + 3] * rs * w4.w * (1.f + scv.w) + sh.w;
      uint2 ob; ob.x = pack_bf16(o.x, o.y); ob.y = pack_bf16(o.z, o.w);
      *(uint2*)(p.H + (size_t)r * 2048 + col) = ob;
    }
  }
}


template <class AF, class BF, class EF>
__device__ __forceinline__ void gemm_tile(const AF& af, const BF& bf, const EF& ef, int K, char* smem) {
  char* As = smem;
  char* Bs = smem + 16384;
  const int tid = threadIdx.x, lane = tid & 63, wid = tid >> 6, wr = wid >> 1, wc = wid & 1;
  const int l31 = lane & 31, lh = lane >> 5;
  f32x16 acc[2][2];
#pragma unroll
  for (int i = 0; i < 2; ++i)
#pragma unroll
    for (int j = 0; j < 2; ++j)
#pragma unroll
      for (int r = 0; r < 16; ++r) acc[i][j][r] = 0.f;
  const int arl = tid >> 3, ac = tid & 7;
  const bfraw* ar0 = af.row(arl);
  const bfraw* ar1 = af.row(arl + 32);
  const bfraw* ar2 = af.row(arl + 64);
  const bfraw* ar3 = af.row(arl + 96);
  const bool av0 = ar0 != nullptr, av1 = ar1 != nullptr, av2 = ar2 != nullptr, av3 = ar3 != nullptr;
  const bfraw* asafe = af.safe();
  if (!av0) ar0 = asafe; if (!av1) ar1 = asafe; if (!av2) ar2 = asafe; if (!av3) ar3 = asafe;
  const int n4 = tid & 31, kg = tid >> 5;
  const float* bc = bf.col(n4 * 4);
  const bool bv = bc != nullptr;
  if (!bv) bc = bf.safe();
  const int ldb = bf.ldb;
  uint4 ra0, ra1, ra2, ra3;
  f32x4v rb0, rb1, rb2, rb3, rb4, rb5, rb6, rb7;
  const uint4 zu4 = make_uint4(0u, 0u, 0u, 0u);
  const f32x4v zf4 = {0.f, 0.f, 0.f, 0.f};
#define GLOAD(k0)                                                              \
  {                                                                            \
    ra0 = *(const uint4*)(ar0 + (k0) + ac * 8); if (!av0) ra0 = zu4;           \
    ra1 = *(const uint4*)(ar1 + (k0) + ac * 8); if (!av1) ra1 = zu4;           \
    ra2 = *(const uint4*)(ar2 + (k0) + ac * 8); if (!av2) ra2 = zu4;           \
    ra3 = *(const uint4*)(ar3 + (k0) + ac * 8); if (!av3) ra3 = zu4;           \
    const float* bq = bc + (size_t)((k0) + kg * 8) * ldb;                      \
    rb0 = *(const f32x4v*)(bq);                                                \
    rb1 = *(const f32x4v*)(bq + (size_t)ldb);                                  \
    rb2 = *(const f32x4v*)(bq + (size_t)2 * ldb);                              \
    rb3 = *(const f32x4v*)(bq + (size_t)3 * ldb);                              \
    rb4 = *(const f32x4v*)(bq + (size_t)4 * ldb);                              \
    rb5 = *(const f32x4v*)(bq + (size_t)5 * ldb);                              \
    rb6 = *(const f32x4v*)(bq + (size_t)6 * ldb);                              \
    rb7 = *(const f32x4v*)(bq + (size_t)7 * ldb);                              \
    if (!bv) { rb0 = zf4; rb1 = zf4; rb2 = zf4; rb3 = zf4; rb4 = zf4; rb5 = zf4; rb6 = zf4; rb7 = zf4; } \
  }
#define SWRITE_B(i)                                                            \
  {                                                                            \
    const int n = n4 * 4 + (i);                                                \
    uint4 v;                                                                   \
    v.x = pack_bf16(rb0[i], rb1[i]); v.y = pack_bf16(rb2[i], rb3[i]);          \
    v.z = pack_bf16(rb4[i], rb5[i]); v.w = pack_bf16(rb6[i], rb7[i]);          \
    *(uint4*)(Bs + n * 128 + ((kg ^ ((n >> 1) & 7)) << 4)) = v;                \
  }
#define SWRITE()                                                               \
  {                                                                            \
    const int asw = (ac ^ ((arl >> 1) & 7)) << 4;                              \
    *(uint4*)(As + (arl) * 128 + asw) = ra0;                                   \
    *(uint4*)(As + (arl + 32) * 128 + asw) = ra1;                              \
    *(uint4*)(As + (arl + 64) * 128 + asw) = ra2;                              \
    *(uint4*)(As + (arl + 96) * 128 + asw) = ra3;                              \
    SWRITE_B(0) SWRITE_B(1) SWRITE_B(2) SWRITE_B(3)                            \
  }
  __syncthreads();
  GLOAD(0)
  SWRITE()
  __syncthreads();
  const int fsw = (l31 >> 1) & 7;
  const char* ap = As + (wr * 64 + l31) * 128;
  const char* bp = Bs + (wc * 64 + l31) * 128;
  for (int k0 = 0; k0 < K; k0 += 64) {
    const bool more = (k0 + 64) < K;
    if (more) GLOAD(k0 + 64)
#pragma unroll
    for (int kk = 0; kk < 4; ++kk) {
      const int co = ((2 * kk + lh) ^ fsw) << 4;
      bf16x8 a0 = *(const bf16x8*)(ap + co), a1 = *(const bf16x8*)(ap + 32 * 128 + co);
      bf16x8 b0 = *(const bf16x8*)(bp + co), b1 = *(const bf16x8*)(bp + 32 * 128 + co);
      acc[0][0] = __builtin_amdgcn_mfma_f32_32x32x16_bf16(a0, b0, acc[0][0], 0, 0, 0);
      acc[0][1] = __builtin_amdgcn_mfma_f32_32x32x16_bf16(a0, b1, acc[0][1], 0, 0, 0);
      acc[1][0] = __builtin_amdgcn_mfma_f32_32x32x16_bf16(a1, b0, acc[1][0], 0, 0, 0);
      acc[1][1] = __builtin_amdgcn_mfma_f32_32x32x16_bf16(a1, b1, acc[1][1], 0, 0, 0);
    }
    __syncthreads();
    if (more) SWRITE()
    __syncthreads();
  }
  ef(acc, wr, wc, lane);
}
#define ACC_ROW(wr, i, r, lane) ((wr) * 64 + (i) * 32 + ((r) & 3) + 8 * ((r) >> 2) + 4 * ((lane) >> 5))
#define ACC_COL(wc, j, lane) ((wc) * 64 + (j) * 32 + ((lane) & 31))

struct ARows { const bfraw* base; int ld; int m0; int M;
  __device__ __forceinline__ const bfraw* row(int r) const { int g = m0 + r; return g < M ? base + (size_t)g * ld : nullptr; }
  __device__ __forceinline__ const bfraw* safe() const { return base; } };
struct BPlain { const float* B; int ldb; int n0; int N;
  __device__ __forceinline__ const float* col(int v) const { int n = n0 + v; return n < N ? B + n : nullptr; }
  __device__ __forceinline__ const float* safe() const { return B; } };

template <class EPI>
__device__ __forceinline__ void gemm_dense(const bfraw* A, int lda, const float* B, int ldb, int M, int N, int K, const EPI& epi, char* smem) {
  const int mt = (M + 127) >> 7, nt = (N + 127) >> 7;
  for (int w = blockIdx.x; w < mt * nt; w += gridDim.x) {
    const int m0 = (w / nt) * 128, n0 = (w % nt) * 128;
    ARows af{A, lda, m0, M};
    BPlain bf{B, ldb, n0, N};
    auto ef = [&](const f32x16 (&acc)[2][2], int wr, int wc, int lane) {
#pragma unroll
      for (int i = 0; i < 2; ++i)
#pragma unroll
        for (int j = 0; j < 2; ++j)
#pragma unroll
          for (int r = 0; r < 16; ++r) {
            int row = m0 + ACC_ROW(wr, i, r, lane), col = n0 + ACC_COL(wc, j, lane);
            if (row < M && col < N) epi(row, col, acc[i][j][r]);
          }
    };
    gemm_tile(af, bf, ef, K, smem);
  }
}

__device__ __forceinline__ void ph_win(const P& p, int layer, char* smem) {
  float* Z = p.Z;
  auto epi = [=](int row, int col, float v) { Z[(size_t)row * NIN + col] = v; };
  gemm_dense(p.H, 2048, p.w_in + (size_t)layer * 2048 * NIN, NIN, TTOT, NIN, 2048, epi, smem);
}

__device__ __forceinline__ void ph_prep(const P& p, int layer, char* smem) {
  const int tid = threadIdx.x, lane = tid & 63, wid = tid >> 6;
  for (int r = blockIdx.x * 4 + wid; r < TTOT; r += gridDim.x * 4) {
    const float* z = p.Z + (size_t)r * NIN;
    float q[6]; float ss = 0.f;
#pragma unroll
    for (int i = 0; i < 6; ++i) { q[i] = z[ZC_CQ + i * 64 + lane]; ss += q[i] * q[i]; }
    ss = wave_sum(ss);
    float rs = rsqrtf(ss * (1.f / 384.f) + EPSV);
#pragma unroll
    for (int i = 0; i < 6; ++i) p.Aq[(size_t)r * 384 + i * 64 + lane] = to_bf16(q[i] * rs * p.q_norm_w[layer * 384 + i * 64 + lane]);
    float k0 = z[ZC_CKV + lane], k1 = z[ZC_CKV + 64 + lane];
    float s2 = wave_sum(k0 * k0 + k1 * k1);
    float rs2 = rsqrtf(s2 * (1.f / 128.f) + EPSV);
    p.Akv[(size_t)r * 128 + lane] = to_bf16(k0 * rs2 * p.kv_norm_w[layer * 128 + lane]);
    p.Akv[(size_t)r * 128 + 64 + lane] = to_bf16(k1 * rs2 * p.kv_norm_w[layer * 128 + 64 + lane]);
  }
  const float* cw = p.conv_w + layer * 5 * 1024;
  const float* cb = p.conv_b + layer * 1024;
  for (int r = blockIdx.x; r < TTOT; r += gridDim.x) {
    int base, len;
    if (r < TLAT) { base = (r >> 12) << 12; len = SL; } else { base = TLAT + (((r - TLAT) >> 8) << 8); len = CL; }
    const int t = r - base;
    const int ch = tid * 4;
    float4 acc = *(const float4*)(cb + ch);
#pragma unroll
    for (int k = 0; k < 5; ++k) {
      int tt = t + k - 2;
      if (tt >= 0 && tt < len) {
        float4 xv = *(const float4*)(p.Z + (size_t)(base + tt) * NIN + ZC_XBC + ch);
        float4 wv = *(const float4*)(cw + k * 1024 + ch);
        acc.x += xv.x * wv.x; acc.y += xv.y * wv.y; acc.z += xv.z * wv.z; acc.w += xv.w * wv.w;
      }
    }
    acc.x = siluf_(acc.x); acc.y = siluf_(acc.y); acc.z = siluf_(acc.z); acc.w = siluf_(acc.w);
    if (ch < 512) *(float4*)(p.ssd_xs + (size_t)r * 512 + ch) = acc;
    else if (ch < 768) *(float4*)(p.ssd_B + (size_t)r * 256 + (ch - 512)) = acc;
    else *(float4*)(p.ssd_C + (size_t)r * 256 + (ch - 768)) = acc;
    if (tid < 16) {
      float v = p.Z[(size_t)r * NIN + ZC_DT + tid] + p.dt_bias[layer * 16 + tid];
      float sp = v > 20.f ? v : log1pf(expf(v));
      p.ssd_dt[(size_t)r * 16 + tid] = sp;
    }
  }
}

__device__ __forceinline__ void ph_qkv(const P& p, int layer, char* smem) {
  float* qraw = p.qraw; float* kvraw = p.kvraw;
  auto e1 = [=](int row, int col, float v) { qraw[(size_t)row * 768 + col] = v; };
  gemm_dense(p.Aq, 384, p.w_uq + (size_t)layer * 384 * 768, 768, TTOT, 768, 384, e1, smem);
  auto e2 = [=](int row, int col, float v) { kvraw[(size_t)row * 1024 + col] = v; };
  gemm_dense(p.Akv, 128, p.w_ukv + (size_t)layer * 128 * 1024, 1024, TTOT, 1024, 128, e2, smem);
}

__device__ __forceinline__ void ph_mlapost(const P& p, int layer, char* smem) {
  const int tid = threadIdx.x;
  const float qscale = 0.07216878364870322f;
  for (int r = blockIdx.x; r < TTOT; r += gridDim.x) {
    const bool lat = r < TLAT;
    int b, pos;
    if (lat) { b = r >> 12; pos = r & 4095; } else { b = (r - TLAT) >> 8; pos = (r - TLAT) & 255; }
    const int kpos = lat ? pos : SL + pos;
    const float* qr = p.qraw + (size_t)r * 768;
    const float* kv = p.kvraw + (size_t)r * 1024;
    const float* zr = p.Z + (size_t)r * NIN + ZC_KR;
    const float frow = (float)(pos >> 6), fcol = (float)(pos & 63);
    for (int i = tid; i < 768; i += 256) {
      int h = i / 192, d = i % 192;
      float v;
      if (d < 128 || !lat) v = qr[i];
      else {
        int e = d - 128, a = e >> 5, half = (e >> 4) & 1, f = e & 15;
        float x1 = qr[h * 192 + 128 + a * 32 + f], x2 = qr[h * 192 + 128 + a * 32 + 16 + f];
        float invf = powf(10000.f, -(float)f * (1.f / 16.f));
        float ang = (a == 0 ? frow : fcol) * invf;
        float cs = cosf(ang), sn = sinf(ang);
        v = half == 0 ? x1 * cs - x2 * sn : x1 * sn + x2 * cs;
      }
      v *= qscale;
      if (lat) p.Q[((size_t)(b * 4 + h) * SL + pos) * 192 + d] = v;
      else p.Qc[((size_t)(b * 4 + h) * CL + pos) * 192 + d] = v;
    }
    for (int i = tid; i < 768; i += 256) {
      int h = i / 192, d = i % 192;
      float v;
      if (d < 128) v = kv[h * 256 + d];
      else {
        int e = d - 128;
        if (!lat) v = zr[e];
        else {
          int a = e >> 5, half = (e >> 4) & 1, f = e & 15;
          float x1 = zr[a * 32 + f], x2 = zr[a * 32 + 16 + f];
          float invf = powf(10000.f, -(float)f * (1.f / 16.f));
          float ang = (a == 0 ? frow : fcol) * invf;
          float cs = cosf(ang), sn = sinf(ang);
          v = half == 0 ? x1 * cs - x2 * sn : x1 * sn + x2 * cs;
        }
      }
      p.K[((size_t)(b * 4 + h) * NKEY + kpos) * 192 + d] = v;
    }
    for (int i = tid; i < 512; i += 256) {
      int h = i >> 7, d = i & 127;
      p.V[((size_t)(b * 4 + h) * NKEY + kpos) * 128 + d] = kv[h * 256 + 128 + d];
    }
  }
}

__device__ __forceinline__ void attn_item(const float* __restrict__ Qp, const float* __restrict__ Kp, const float* __restrict__ Vp, int nk,
                          float* __restrict__ Op, char* smem) {
  float* Ks = (float*)smem;
  float* Vs = Ks + 32 * 193;
  const int tid = threadIdx.x, lane = tid & 63, wid = tid >> 6, l31 = lane & 31, lh = lane >> 5;
  float qf[96];
  {
    const float* qrow = Qp + (size_t)(wid * 32 + l31) * 192 + lh;
#pragma unroll
    for (int s8 = 0; s8 < 12; ++s8)
#pragma unroll
      for (int s1 = 0; s1 < 8; ++s1) qf[s8 * 8 + s1] = qrow[2 * (s8 * 8 + s1)];
  }
  f32x16 o[4];
#pragma unroll
  for (int d = 0; d < 4; ++d)
#pragma unroll
    for (int r = 0; r < 16; ++r) o[d][r] = 0.f;
  float m = -INFINITY, l = 0.f;
  for (int kt = 0; kt < nk; kt += 32) {
    __syncthreads();
    for (int i = tid; i < 1536; i += 256) {
      int key = i / 48, c4 = i % 48;
      float4 v = *(const float4*)(Kp + (size_t)(kt + key) * 192 + c4 * 4);
      float* d = Ks + key * 193 + c4 * 4;
      d[0] = v.x; d[1] = v.y; d[2] = v.z; d[3] = v.w;
    }
    for (int i = tid; i < 1024; i += 256) {
      int key = i >> 5, c4 = i & 31;
      *(float4*)(Vs + key * 128 + c4 * 4) = *(const float4*)(Vp + (size_t)(kt + key) * 128 + c4 * 4);
    }
    __syncthreads();
    f32x16 s;
#pragma unroll
    for (int r = 0; r < 16; ++r) s[r] = 0.f;
    const float* kp = Ks + l31 * 193 + lh;
#pragma unroll
    for (int s8 = 0; s8 < 12; ++s8)
#pragma unroll
      for (int s1 = 0; s1 < 8; ++s1)
        s = __builtin_amdgcn_mfma_f32_32x32x2f32(kp[2 * (s8 * 8 + s1)], qf[s8 * 8 + s1], s, 0, 0, 0);
    float tmax = s[0];
#pragma unroll
    for (int r = 1; r < 16; ++r) tmax = fmaxf(tmax, s[r]);
    tmax = fmaxf(tmax, __shfl_xor(tmax, 32));
    float mn = fmaxf(m, tmax);
    float alpha = expf(m - mn);
    float rs = 0.f;
#pragma unroll
    for (int r = 0; r < 16; ++r) { s[r] = expf(s[r] - mn); rs += s[r]; }
    rs += __shfl_xor(rs, 32);
    l = l * alpha + rs;
    m = mn;
#pragma unroll
    for (int d = 0; d < 4; ++d)
#pragma unroll
      for (int r = 0; r < 16; ++r) o[d][r] *= alpha;
#pragma unroll
    for (int r = 0; r < 16; ++r) {
      const int key = (r & 3) + 8 * (r >> 2) + 4 * lh;
      const float* vp = Vs + key * 128 + l31;
#pragma unroll
      for (int d = 0; d < 4; ++d) o[d] = __builtin_amdgcn_mfma_f32_32x32x2f32(vp[d * 32], s[r], o[d], 0, 0, 0);
    }
  }
  const float inv = 1.f / l;
  float* orow = Op + (size_t)(wid * 32 + l31) * 512;
#pragma unroll
  for (int d = 0; d < 4; ++d)
#pragma unroll
    for (int r = 0; r < 16; ++r) orow[d * 32 + (r & 3) + 8 * (r >> 2) + 4 * lh] = o[d][r] * inv;
}

__device__ __forceinline__ void ssd_item(const P& p, int layer, int item, char* smem) {
  const int pq = item & 3, h = (item >> 2) & 7, dir = (item >> 5) & 1, b = item >> 6;
  float* sdt = (float*)smem;
  float* sx = sdt + 32;
  float* sB = sx + 32 * 16;
  float* sC = sB + 32 * 128;
  const int tid = threadIdx.x, pl = tid >> 4, nc = tid & 15;
  const float A = -expf(p.a_log[layer * 16 + dir * 8 + h]);
  const int g = h >> 2;
  float hs[8];
#pragma unroll
  for (int j = 0; j < 8; ++j) hs[j] = 0.f;
  float* yout = dir ? p.ssd_yb : p.ssd_yf;
  for (int seg = 0; seg < 2; ++seg) {
    const int base = seg == 0 ? TLAT + b * CL : b * SL;
    const int len = seg == 0 ? CL : SL;
    for (int c0 = 0; c0 < len; c0 += 32) {
      __syncthreads();
      if (tid < 32) {
        int row = dir ? base + len - 1 - (c0 + tid) : base + c0 + tid;
        sdt[tid] = p.ssd_dt[(size_t)row * 16 + dir * 8 + h];
      }
      for (int i = tid; i < 512; i += 256) {
        int st = i >> 4, pp = i & 15;
        int row = dir ? base + len - 1 - (c0 + st) : base + c0 + st;
        sx[i] = p.ssd_xs[(size_t)row * 512 + h * 64 + pq * 16 + pp];
      }
      for (int i = tid; i < 4096; i += 256) {
        int st = i >> 7, n = i & 127;
        int row = dir ? base + len - 1 - (c0 + st) : base + c0 + st;
        sB[i] = p.ssd_B[(size_t)row * 256 + g * 128 + n];
        sC[i] = p.ssd_C[(size_t)row * 256 + g * 128 + n];
      }
      __syncthreads();
      for (int st = 0; st < 32; ++st) {
        const float dt = sdt[st];
        const float dA = expf(dt * A);
        const float xv = sx[st * 16 + pl] * dt;
        float y = 0.f;
#pragma unroll
        for (int j = 0; j < 8; ++j) {
          const int n = j * 16 + nc;
          hs[j] = dA * hs[j] + xv * sB[st * 128 + n];
          y += hs[j] * sC[st * 128 + n];
        }
        y += __shfl_xor(y, 1); y += __shfl_xor(y, 2); y += __shfl_xor(y, 4); y += __shfl_xor(y, 8);
        if (nc == 0) {
          int row = dir ? base + len - 1 - (c0 + st) : base + c0 + st;
          yout[(size_t)row * 512 + h * 64 + pq * 16 + pl] = y;
        }
      }
    }
  }
}

__device__ __forceinline__ void mlstm_item(const P& p, int layer, int item, char* smem) {
  const int vq = item & 3, h = (item >> 2) & 3, dir = (item >> 4) & 1, b = item >> 5;
  float* sq = (float*)smem;
  float* sk = sq + 32 * 64;
  float* sv = sk + 32 * 64;
  float* sf = sv + 32 * 32;
  float* si = sf + 32;
  const int tid = threadIdx.x, vl = tid >> 3, kc = tid & 7;
  const float bi = p.gate_b[layer * 16 + dir * 8 + h], bfv = p.gate_b[layer * 16 + dir * 8 + 4 + h];
  float Cs[8], ns[8];
#pragma unroll
  for (int j = 0; j < 8; ++j) { Cs[j] = 0.f; ns[j] = 0.f; }
  float* hout = dir ? p.ml_hb : p.ml_hf;
  for (int seg = 0; seg < 2; ++seg) {
    const int base = seg == 0 ? TLAT + b * CL : b * SL;
    const int len = seg == 0 ? CL : SL;
    for (int c0 = 0; c0 < len; c0 += 32) {
      __syncthreads();
      for (int i = tid; i < 2048; i += 256) {
        int st = i >> 6, k = i & 63;
        int row = dir ? base + len - 1 - (c0 + st) : base + c0 + st;
        const float* z = p.Z + (size_t)row * NIN;
        sq[i] = z[ZC_MQ + h * 64 + k] * 0.125f;
        sk[i] = z[ZC_MK + h * 64 + k];
      }
      for (int i = tid; i < 1024; i += 256) {
        int st = i >> 5, vv = i & 31;
        int row = dir ? base + len - 1 - (c0 + st) : base + c0 + st;
        sv[i] = p.Z[(size_t)row * NIN + ZC_MV + h * 128 + vq * 32 + vv];
      }
      if (tid < 32) {
        int row = dir ? base + len - 1 - (c0 + tid) : base + c0 + tid;
        const float* z = p.Z + (size_t)row * NIN + ZC_MG + dir * 8;
        si[tid] = expf(z[h] + bi);
        sf[tid] = sigmoidf_(z[4 + h] + bfv);
      }
      __syncthreads();
      for (int st = 0; st < 32; ++st) {
        const float f = sf[st], ig = si[st];
        const float vv = sv[st * 32 + vl] * ig;
        float num = 0.f, den = 0.f;
#pragma unroll
        for (int j = 0; j < 8; ++j) {
          const int k = j * 8 + kc;
          const float kk = sk[st * 64 + k], qq = sq[st * 64 + k];
          Cs[j] = f * Cs[j] + vv * kk;
          ns[j] = f * ns[j] + ig * kk;
          num += Cs[j] * qq;
          den += ns[j] * qq;
        }
        num += __shfl_xor(num, 1); num += __shfl_xor(num, 2); num += __shfl_xor(num, 4);
        den += __shfl_xor(den, 1); den += __shfl_xor(den, 2); den += __shfl_xor(den, 4);
        if (kc == 0) {
          int row = dir ? base + len - 1 - (c0 + st) : base + c0 + st;
          hout[(size_t)row * 512 + h * 128 + vq * 32 + vl] = num / fmaxf(fabsf(den), 1.f);
        }
      }
    }
  }
}

__device__ __forceinline__ void s5_item(const P& p, int layer, int item, char* smem) {
  const int g = item & 31, dir = (item >> 5) & 1, b = item >> 6;
  float* sxr = (float*)smem;
  float* sxi = sxr + 64 * 65;
  float* su = sxi + 64 * 65;
  float* scr = su + 64 * 16;
  float* sci = scr + 16 * 64;
  const int tid = threadIdx.x, sp = tid & 63, tq = tid >> 6;
  const int dg = (layer * 2 + dir) * 32 + g;
  const float lr = p.lam_re[dg * 64 + sp], li = p.lam_im[dg * 64 + sp];
  const float dt = expf(p.log_dt[dg]);
  const float mag = expf(lr * dt);
  const float ar = mag * cosf(li * dt), ai = mag * sinf(li * dt);
  const float den = lr * lr + li * li;
  const float cr_ = ((ar - 1.f) * lr + ai * li) / den;
  const float ci_ = (ai * lr - (ar - 1.f) * li) / den;
  float bbr[16], bbi[16];
#pragma unroll
  for (int c = 0; c < 16; ++c) {
    float br = p.b_re[((size_t)(layer * 32 + g) * 64 + sp) * 16 + c];
    float bim = p.b_im[((size_t)(layer * 32 + g) * 64 + sp) * 16 + c];
    bbr[c] = cr_ * br - ci_ * bim;
    bbi[c] = cr_ * bim + ci_ * br;
  }
  __syncthreads();
  for (int i = tid; i < 1024; i += 256) {
    scr[i] = p.c_re[(size_t)(layer * 32 + g) * 1024 + i];
    sci[i] = p.c_im[(size_t)(layer * 32 + g) * 1024 + i];
  }
  float xr = 0.f, xi = 0.f;
  float* rout = dir ? p.s5_rb : p.s5_rf;
  for (int seg = 0; seg < 2; ++seg) {
    const int base = seg == 0 ? TLAT + b * CL : b * SL;
    const int len = seg == 0 ? CL : SL;
    for (int c0 = 0; c0 < len; c0 += 64) {
      __syncthreads();
      for (int i = tid; i < 1024; i += 256) {
        int st = i >> 4, c = i & 15;
        int row = dir ? base + len - 1 - (c0 + st) : base + c0 + st;
        su[i] = p.Z[(size_t)row * NIN + ZC_U + g * 16 + c];
      }
      __syncthreads();
      for (int tt = 0; tt < 16; ++tt) {
        const int t = tq * 16 + tt;
        float ur = 0.f, ui = 0.f;
#pragma unroll
        for (int c = 0; c < 16; ++c) { float uu = su[t * 16 + c]; ur += bbr[c] * uu; ui += bbi[c] * uu; }
        sxr[t * 65 + sp] = ur; sxi[t * 65 + sp] = ui;
      }
      __syncthreads();
      if (tq == 0) {
        for (int t = 0; t < 64; ++t) {
          float ur = sxr[t * 65 + sp], ui = sxi[t * 65 + sp];
          float nr = ar * xr - ai * xi + ur;
          float ni = ar * xi + ai * xr + ui;
          xr = nr; xi = ni;
          sxr[t * 65 + sp] = xr; sxi[t * 65 + sp] = xi;
        }
      }
      __syncthreads();
      {
        const int t = sp;
        const int row = dir ? base + len - 1 - (c0 + t) : base + c0 + t;
#pragma unroll
        for (int cc = 0; cc < 4; ++cc) {
          const int c = tq * 4 + cc;
          float y = 0.f;
          for (int pp = 0; pp < 64; ++pp) y += scr[c * 64 + pp] * sxr[t * 65 + pp] - sci[c * 64 + pp] * sxi[t * 65 + pp];
          rout[(size_t)row * 512 + g * 16 + c] = y;
        }
      }
    }
  }
}

#define N_SSD_ITEMS 128
#define N_ML_ITEMS 64
#define N_S5_ITEMS 128
#define N_ATT_LAT 256
#define N_ATT_CTX 16
__device__ __forceinline__ void ph_mix(const P& p, int layer, char* smem) {
  const int nitems = N_S5_ITEMS + N_SSD_ITEMS + N_ML_ITEMS + N_ATT_LAT + (layer == 0 ? N_ATT_CTX : 0);
  for (int w = blockIdx.x; w < nitems; w += gridDim.x) {
    int it = w;
    if (it < N_S5_ITEMS) { s5_item(p, layer, it, smem); continue; }
    it -= N_S5_ITEMS;
    if (it < N_SSD_ITEMS) { ssd_item(p, layer, it, smem); continue; }
    it -= N_SSD_ITEMS;
    if (it < N_ML_ITEMS) { mlstm_item(p, layer, it, smem); continue; }
    it -= N_ML_ITEMS;
    {
      const float *qp, *kp, *vp; float* op; int nk;
      if (it < N_ATT_LAT) {
        int qb = it & 31, hh = (it >> 5) & 3, b = it >> 7;
        qp = p.Q + ((size_t)(b * 4 + hh) * SL + qb * 128) * 192; kp = p.K + (size_t)(b * 4 + hh) * NKEY * 192;
        vp = p.V + (size_t)(b * 4 + hh) * NKEY * 128; nk = NKEY; op = p.O + (size_t)(b * SL + qb * 128) * 512 + hh * 128;
      } else {
        it -= N_ATT_LAT;
        int qb = it & 1, hh = (it >> 1) & 3, b = it >> 3;
        qp = p.Qc + ((size_t)(b * 4 + hh) * CL + qb * 128) * 192; kp = p.K + ((size_t)(b * 4 + hh) * NKEY + SL) * 192;
        vp = p.V + ((size_t)(b * 4 + hh) * NKEY + SL) * 128; nk = CL; op = p.O + (size_t)(TLAT + b * CL + qb * 128) * 512 + hh * 128;
      }
      attn_item(qp, kp, vp, nk, op, smem);
    }
  }
}

__device__ __forceinline__ float gelu_tanh(float x) {
  const float k0 = 0.7978845608028654f;
  return 0.5f * x * (1.f + tanhf(k0 * (x + 0.044715f * x * x * x)));
}
__device__ __forceinline__ void ph_s5pre(const P& p, int layer, char* smem) {
  const size_t n = (size_t)TTOT * 512;
  for (size_t i = (size_t)blockIdx.x * 256 + threadIdx.x; i < n; i += (size_t)gridDim.x * 256) {
    int r = (int)(i >> 9), c = (int)(i & 511);
    float u = p.Z[(size_t)r * NIN + ZC_U + c];
    float y = p.s5_rf[i] + p.s5_rb[i] + p.s5_d[layer * 512 + c] * u;
    float gy = gelu_tanh(y);
    p.ydpre[i] = gy; p.ydpre_bf[i] = to_bf16(gy);
  }
}
__device__ __forceinline__ void ph_glu(const P& p, int layer, char* smem) {
  const float* yp = p.ydpre; float* yg = p.ydg; const float* gb = p.glu_b + layer * 512;
  auto epi = [=](int row, int col, float v) {
    float y = yp[(size_t)row * 512 + col];
    yg[(size_t)row * 512 + col] = y * sigmoidf_(v + gb[col]);
  };
  gemm_dense(p.ydpre_bf, 512, p.glu_w + (size_t)layer * 512 * 512, 512, TTOT, 512, 512, epi, smem);
}

__device__ __forceinline__ void ph_final_mix(const P& p, int layer, char* smem) {
  float* red = (float*)smem;
  const int tid = threadIdx.x;
  const float* onw = p.out_norm_w + layer * 2048;
  for (int r = blockIdx.x; r < TTOT; r += gridDim.x) {
    const int c = tid * 2;
    const float* z = p.Z + (size_t)r * NIN;
    float2 oa = *(const float2*)(p.O + (size_t)r * 512 + c);
    float sa = block_sum(oa.x * oa.x + oa.y * oa.y, red);
    float ra = rsqrtf(sa * (1.f / 512.f) + EPSV);
    float2 yf = *(const float2*)(p.ssd_yf + (size_t)r * 512 + c);
    float2 yb = *(const float2*)(p.ssd_yb + (size_t)r * 512 + c);
    float2 xs = *(const float2*)(p.ssd_xs + (size_t)r * 512 + c);
    float2 zz = *(const float2*)(z + ZC_BZ + c);
    float dsk = p.ssd_d[layer * 8 + (c >> 6)];
    float b0 = (yf.x + yb.x + dsk * xs.x) * siluf_(zz.x);
    float b1 = (yf.y + yb.y + dsk * xs.y) * siluf_(zz.y);
    float sb = block_sum(b0 * b0 + b1 * b1, red);
    float rb = rsqrtf(sb * (1.f / 512.f) + EPSV);
    float2 hf = *(const float2*)(p.ml_hf + (size_t)r * 512 + c);
    float2 hb = *(const float2*)(p.ml_hb + (size_t)r * 512 + c);
    float c0 = hf.x + hb.x, c1 = hf.y + hb.y;
    float scs = wave_sum(c0 * c0 + c1 * c1);
    float rc = rsqrtf(scs * (1.f / 128.f) + EPSV);
    float2 og = *(const float2*)(z + ZC_MO + c);
    c0 = c0 * rc * sigmoidf_(og.x); c1 = c1 * rc * sigmoidf_(og.y);
    float2 yd = *(const float2*)(p.ydg + (size_t)r * 512 + c);
    float sd = block_sum(yd.x * yd.x + yd.y * yd.y, red);
    float rd = rsqrtf(sd * (1.f / 512.f) + EPSV);
    bfraw* Y = p.Y + (size_t)r * 2048;
    *(unsigned*)(Y + c) = pack_bf16(oa.x * ra * onw[c], oa.y * ra * onw[c + 1]);
    *(unsigned*)(Y + 512 + c) = pack_bf16(b0 * rb * onw[512 + c], b1 * rb * onw[512 + c + 1]);
    *(unsigned*)(Y + 1024 + c) = pack_bf16(c0 * onw[1024 + c], c1 * onw[1024 + c + 1]);
    *(unsigned*)(Y + 1536 + c) = pack_bf16(yd.x * rd * onw[1536 + c], yd.y * rd * onw[1536 + c + 1]);
  }
}

__device__ __forceinline__ void ph_wout(const P& p, int layer, char* smem) {
  const P pp = p;
  const int M = layer == 0 ? TTOT : TLAT;
  auto epi = [=](int row, int col, float v) {
    const int mi = row_modidx(row);
    const float g1 = pp.modv[(layer * 3 + mi) * 12288 + 2 * 2048 + col];
    float xin;
    if (layer == 0) xin = row < TLAT ? pp.x[(size_t)row * 2048 + col] : pp.ctx[(size_t)(row - TLAT) * 2048 + col];
    else xin = pp.X[(size_t)row * 2048 + col];
    pp.X[(size_t)row * 2048 + col] = xin + g1 * v;
  };
  gemm_dense(p.Y, 2048, p.w_out + (size_t)layer * 2048 * 2048, 2048, M, 2048, 2048, epi, smem);
}

__device__ __forceinline__ void ph_router(const P& p, int layer, char* smem) {
  float* red = (float*)smem;
  float* lred = red + 4;
  float* lg = lred + 4 * 36;
  const int tid = threadIdx.x, lane = tid & 63, wid = tid >> 6;
  const int T = layer == 0 ? TTOT : TLAT;
  const float* nw = p.norm2_w + layer * 2048;
  const float* wg = p.w_group + (size_t)layer * 2048 * 4;
  const float* we = p.w_expert + (size_t)layer * 2048 * 32;
  for (int r = blockIdx.x; r < T; r += gridDim.x) {
    const int mi = row_modidx(r);
    const float* mrow = p.modv + (layer * 3 + mi) * 12288;
    const int k0 = tid * 8;
    float v[8]; float ss = 0.f;
#pragma unroll
    for (int hf = 0; hf < 2; ++hf) {
      float4 xv = *(const float4*)(p.X + (size_t)r * 2048 + k0 + hf * 4);
      v[hf * 4 + 0] = xv.x; v[hf * 4 + 1] = xv.y; v[hf * 4 + 2] = xv.z; v[hf * 4 + 3] = xv.w;
      ss += xv.x * xv.x + xv.y * xv.y + xv.z * xv.z + xv.w * xv.w;
    }
    float tot = block_sum(ss, red);
    float rs = rsqrtf(tot * (1.f / 2048.f) + EPSV);
#pragma unroll
    for (int i = 0; i < 8; ++i) {
      int col = k0 + i;
      v[i] = v[i] * rs * nw[col] * (1.f + mrow[4 * 2048 + col]) + mrow[3 * 2048 + col];
    }
    { uint4 hb; hb.x = pack_bf16(v[0], v[1]); hb.y = pack_bf16(v[2], v[3]); hb.z = pack_bf16(v[4], v[5]); hb.w = pack_bf16(v[6], v[7]);
      *(uint4*)(p.H + (size_t)r * 2048 + k0) = hb; }
    float lgt[36];
#pragma unroll
    for (int j = 0; j < 36; ++j) lgt[j] = 0.f;
#pragma unroll
    for (int i = 0; i < 8; ++i) {
      float4 g4 = *(const float4*)(wg + (size_t)(k0 + i) * 4);
      lgt[0] += v[i] * g4.x; lgt[1] += v[i] * g4.y; lgt[2] += v[i] * g4.z; lgt[3] += v[i] * g4.w;
#pragma unroll
      for (int j4 = 0; j4 < 8; ++j4) {
        float4 e4 = *(const float4*)(we + (size_t)(k0 + i) * 32 + j4 * 4);
        lgt[4 + j4 * 4 + 0] += v[i] * e4.x; lgt[4 + j4 * 4 + 1] += v[i] * e4.y;
        lgt[4 + j4 * 4 + 2] += v[i] * e4.z; lgt[4 + j4 * 4 + 3] += v[i] * e4.w;
      }
    }
#pragma unroll
    for (int j = 0; j < 36; ++j) lgt[j] = wave_sum(lgt[j]);
    __syncthreads();
    if (lane == 0) {
#pragma unroll
      for (int j = 0; j < 36; ++j) lred[wid * 36 + j] = lgt[j];
    }
    __syncthreads();
    if (tid < 36) lg[tid] = lred[tid] + lred[36 + tid] + lred[72 + tid] + lred[108 + tid];
    __syncthreads();
    if (tid == 0) {
      int gi = 0; float gm = lg[0];
      for (int j = 1; j < 4; ++j) if (lg[j] > gm) { gm = lg[j]; gi = j; }
      float gs = 0.f;
      for (int j = 0; j < 4; ++j) gs += expf(lg[j] - gm);
      float gw = 1.f / gs;
      const float* el = lg + 4 + gi * 8;
      int i1 = 0; float v1 = el[0];
      for (int j = 1; j < 8; ++j) if (el[j] > v1) { v1 = el[j]; i1 = j; }
      int i2 = -1; float v2 = -INFINITY;
      for (int j = 0; j < 8; ++j) if (j != i1 && el[j] > v2) { v2 = el[j]; i2 = j; }
      float e2 = expf(v2 - v1);
      float w1 = gw / (1.f + e2), w2 = gw * e2 / (1.f + e2);
      int ex1 = gi * 8 + i1, ex2 = gi * 8 + i2;
      int* cnt = p.cnt + layer * 32;
      int p1 = atomicAdd(&cnt[ex1], 1);
      p.list_tok[ex1 * CAPE + p1] = r * 2; p.list_w[ex1 * CAPE + p1] = w1;
      int p2 = atomicAdd(&cnt[ex2], 1);
      p.list_tok[ex2 * CAPE + p2] = r * 2 + 1; p.list_w[ex2 * CAPE + p2] = w2;
    }
  }
}

struct AGather { const bfraw* H; const int* toks; int nvalid;
  __device__ __forceinline__ const bfraw* row(int r) const { return r < nvalid ? H + (size_t)(toks[r] >> 1) * 2048 : nullptr; }
  __device__ __forceinline__ const bfraw* safe() const { return H; } };
struct BGateUp { const float *g, *u; int ldb; int nb;
  __device__ __forceinline__ const float* col(int v) const { int wc = v >> 6, j = (v >> 5) & 1, c = v & 31;
    const float* b = (const float*)((uintptr_t)g + (uintptr_t)j * ((uintptr_t)u - (uintptr_t)g)); return b + nb + wc * 32 + c; }
  __device__ __forceinline__ const float* safe() const { return g; } };

__device__ __forceinline__ void moe_prefix(const P& p, int layer, int* spre) {
  __syncthreads();
  if (threadIdx.x == 0) {
    int acc = 0;
    for (int e = 0; e < 32; ++e) { spre[e] = acc; acc += (p.cnt[layer * 32 + e] + 127) >> 7; }
    spre[32] = acc;
  }
  __syncthreads();
}
__device__ __forceinline__ void ph_moe_up(const P& p, int layer, char* smem) {
  int* spre = (int*)(smem + 40960);
  moe_prefix(p, layer, spre);
  const int ntile = spre[32];
  for (int w = blockIdx.x; w < ntile * 8; w += gridDim.x) {
    const int rbg = w >> 3, nt = w & 7;
    int e = 0;
    while (e < 31 && spre[e + 1] <= rbg) ++e;
    const int rb = rbg - spre[e];
    const int cnt = p.cnt[layer * 32 + e];
    AGather af{p.H, p.list_tok + e * CAPE + rb * 128, cnt - rb * 128};
    const size_t wo = ((size_t)layer * 32 + e) * 2048 * 512;
    BGateUp bf{p.w_gate + wo, p.w_up + wo, 512, nt * 64};
    bfraw* act = p.ACT + (size_t)rbg * 128 * 512 + nt * 64;
    auto ef = [&](const f32x16 (&acc)[2][2], int wr, int wc, int lane) {
#pragma unroll
      for (int i = 0; i < 2; ++i)
#pragma unroll
        for (int r = 0; r < 16; ++r) {
          int row = ACC_ROW(wr, i, r, lane);
          float gv = acc[i][0][r], uv = acc[i][1][r];
          act[(size_t)row * 512 + wc * 32 + (lane & 31)] = to_bf16(siluf_(gv) * uv);
        }
    };
    gemm_tile(af, bf, ef, 2048, smem);
  }
}
__device__ __forceinline__ void ph_moe_down(const P& p, int layer, char* smem) {
  int* spre = (int*)(smem + 40960);
  moe_prefix(p, layer, spre);
  const int ntile = spre[32];
  for (int w = blockIdx.x; w < ntile * 16; w += gridDim.x) {
    const int rbg = w >> 4, nt = w & 15;
    int e = 0;
    while (e < 31 && spre[e + 1] <= rbg) ++e;
    const int rb = rbg - spre[e];
    const int nvalid = p.cnt[layer * 32 + e] - rb * 128;
    ARows af{p.ACT + (size_t)rbg * 128 * 512, 512, 0, 128};
    BPlain bf{p.w_down + ((size_t)layer * 32 + e) * 512 * 2048, 2048, nt * 128, 2048};
    const int* toks = p.list_tok + e * CAPE + rb * 128;
    const float* lw = p.list_w + e * CAPE + rb * 128;
    float* Ys = p.Yslot;
    auto ef = [&](const f32x16 (&acc)[2][2], int wr, int wc, int lane) {
#pragma unroll
      for (int i = 0; i < 2; ++i)
#pragma unroll
        for (int r = 0; r < 16; ++r) {
          int row = ACC_ROW(wr, i, r, lane);
          if (row < nvalid) {
            int ts = toks[row]; float wgt = lw[row];
#pragma unroll
            for (int j = 0; j < 2; ++j) Ys[(size_t)ts * 2048 + nt * 128 + ACC_COL(wc, j, lane)] = wgt * acc[i][j][r];
          }
        }
    };
    gemm_tile(af, bf, ef, 512, smem);
  }
}

__device__ __forceinline__ void ph_out(const P& p, char* smem) {
  float* red = (float*)smem;
  const int tid = threadIdx.x;
  for (int r = blockIdx.x; r < TLAT; r += gridDim.x) {
    const int mi = r >> 12;
    const float* g2 = p.modv + (1 * 3 + mi) * 12288 + 5 * 2048;
    float v[8]; float ss = 0.f;
#pragma unroll
    for (int hf = 0; hf < 2; ++hf) {
      int col = hf * 1024 + tid * 4;
      float4 xv = *(const float4*)(p.X + (size_t)r * 2048 + col);
      float4 gv = *(const float4*)(g2 + col);
      float4 y0 = *(const float4*)(p.Yslot + (size_t)(2 * r) * 2048 + col);
      float4 y1 = *(const float4*)(p.Yslot + (size_t)(2 * r + 1) * 2048 + col);
      xv.x += gv.x * (y0.x + y1.x); xv.y += gv.y * (y0.y + y1.y);
      xv.z += gv.z * (y0.z + y1.z); xv.w += gv.w * (y0.w + y1.w);
      v[hf * 4 + 0] = xv.x; v[hf * 4 + 1] = xv.y; v[hf * 4 + 2] = xv.z; v[hf * 4 + 3] = xv.w;
      ss += xv.x * xv.x + xv.y * xv.y + xv.z * xv.z + xv.w * xv.w;
    }
    float tot = block_sum(ss, red);
    float rs = rsqrtf(tot * (1.f / 2048.f) + EPSV);
#pragma unroll
    for (int hf = 0; hf < 2; ++hf) {
      int col = hf * 1024 + tid * 4;
      float4 w4 = *(const float4*)(p.final_w + col);
      float4 o;
      o.x = v[hf * 4 + 0] * rs * w4.x; o.y = v[hf * 4 + 1] * rs * w4.y;
      o.z = v[hf * 4 + 2] * rs * w4.z; o.w = v[hf * 4 + 3] * rs * w4.w;
      *(float4*)(p.out + (size_t)r * 2048 + col) = o;
    }
  }
}

#define XB_TMO      128
#define XB_XCNT(j)  (256  + 64 * (j))
#define XB_XSUB(j)  (1280 + 64 * (j))
#define XB_XGEN(j)  (2304 + 64 * (j))
#define XB_TOP      3328
#define XB_TOPGEN   3392
#define XCD_BAR_WORDS 3456
#define XB_SPIN_CAP (1u << 22)
#define LAS __attribute__((address_space(3)))
__device__ __forceinline__ unsigned xb_ld(unsigned* p)              { return __hip_atomic_load(p, __ATOMIC_RELAXED, __HIP_MEMORY_SCOPE_AGENT); }
__device__ __forceinline__ unsigned xb_add(unsigned* p, unsigned v) { return __hip_atomic_fetch_add(p, v, __ATOMIC_RELAXED, __HIP_MEMORY_SCOPE_AGENT); }
__device__ __forceinline__ unsigned xb_xcc_id() { return (unsigned)__builtin_amdgcn_s_getreg((3 << 11) | 20) & 0xFu; }
#define XB_SPIN(cond, bar) do { unsigned _sp = 0; while (cond) { __builtin_amdgcn_s_sleep(1); \
    if ((++_sp & 255u) == 0u) { if (xb_ld(&(bar)[XB_TMO])) break; if (_sp > XB_SPIN_CAP) { atomicAdd(&(bar)[XB_TMO], 1u); break; } } } } while (0)
struct XcdBarrier { unsigned* bar; unsigned x; volatile LAS unsigned* st; };
__device__ __forceinline__ XcdBarrier xcd_barrier_post(unsigned* bar, volatile LAS unsigned* st) {
    XcdBarrier b; b.bar = bar; b.x = xb_xcc_id(); b.st = st;
    if (threadIdx.x == 0) (void)xb_add(&bar[XB_XCNT(b.x)], 1u);
    return b;
}
__device__ __forceinline__ void xcd_barrier_complete(unsigned* bar, unsigned x, unsigned& nloc, unsigned& nx) {
    const unsigned G = gridDim.x * gridDim.y * gridDim.z;
    unsigned sum, cnt, mine, sp = 0u;
    for (;;) {
        sum = 0u; cnt = 0u; mine = 0u;
#pragma unroll
        for (unsigned j = 0; j < 16; ++j) { const unsigned c = xb_ld(&bar[XB_XCNT(j)]); sum += c; cnt += (c > 0u) ? 1u : 0u; mine = (j == x) ? c : mine; }
        if (sum == G) break;
        __builtin_amdgcn_s_sleep(1);
        if ((++sp & 255u) == 0u) { if (xb_ld(&bar[XB_TMO])) break; if (sp > XB_SPIN_CAP) { atomicAdd(&bar[XB_TMO], 1u); break; } }
    }
    nloc = mine > 0u ? mine : 1u; nx = cnt > 0u ? cnt : 1u;
}
__device__ __forceinline__ void xcd_barrier(const XcdBarrier& b) {
    asm volatile("s_waitcnt vmcnt(0)" ::: "memory");
    __syncthreads();
    if (threadIdx.x == 0) {
        unsigned* bar = b.bar;
        __builtin_amdgcn_s_waitcnt(0);
        unsigned nloc = b.st[0], nx = b.st[1];
        if (nloc == 0u) { xcd_barrier_complete(bar, b.x, nloc, nx); b.st[0] = nloc; b.st[1] = nx; }
        const unsigned old = xb_add(&bar[XB_XSUB(b.x)], 1u);
        const unsigned gen = old / nloc;
        if (old + 1u == (gen + 1u) * nloc) {
            __builtin_amdgcn_fence(__ATOMIC_RELEASE, "agent");
            asm volatile("s_waitcnt vmcnt(0)" ::: "memory");
            const unsigned og = xb_add(&bar[XB_TOP], 1u);
            const unsigned tg = og / nx;
            if (og + 1u == (tg + 1u) * nx) xb_add(&bar[XB_TOPGEN], 1u);
            else XB_SPIN(xb_ld(&bar[XB_TOPGEN]) == tg, bar);
            __builtin_amdgcn_fence(__ATOMIC_ACQUIRE, "agent");
            xb_add(&bar[XB_XGEN(b.x)], 1u);
            asm volatile("s_waitcnt vmcnt(0)" ::: "memory");
        } else {
            XB_SPIN(xb_ld(&bar[XB_XGEN(b.x)]) == gen, bar);
            __builtin_amdgcn_fence(__ATOMIC_ACQUIRE, "agent");
            asm volatile("s_waitcnt vmcnt(0)" ::: "memory");
        }
    }
    __syncthreads();
}

__global__ void __launch_bounds__(256, 1) k_fused(P p, unsigned* bar) {
  extern __shared__ __attribute__((aligned(16))) char smem_all[];
  char* smem = smem_all + 64;
  if (threadIdx.x == 0) *(uint4*)smem_all = make_uint4(0u, 0u, 0u, 0u);
  __syncthreads();
  XcdBarrier b = xcd_barrier_post(bar, (volatile LAS unsigned*)smem_all);
  ph_mod(p, smem); xcd_barrier(b);
  {
    ph_norm1(p, 0, smem); xcd_barrier(b);
    ph_win(p, 0, smem); xcd_barrier(b);
    ph_prep(p, 0, smem); xcd_barrier(b);
    ph_qkv(p, 0, smem); xcd_barrier(b);
    ph_mlapost(p, 0, smem); xcd_barrier(b);
    ph_mix(p, 0, smem); xcd_barrier(b);
    ph_s5pre(p, 0, smem); xcd_barrier(b);
    ph_glu(p, 0, smem); xcd_barrier(b);
    ph_final_mix(p, 0, smem); xcd_barrier(b);
    ph_wout(p, 0, smem); xcd_barrier(b);
    ph_router(p, 0, smem); xcd_barrier(b);
    ph_moe_up(p, 0, smem); xcd_barrier(b);
    ph_moe_down(p, 0, smem); xcd_barrier(b);
  }
  {
    ph_norm1(p, 1, smem); xcd_barrier(b);
    ph_win(p, 1, smem); xcd_barrier(b);
    ph_prep(p, 1, smem); xcd_barrier(b);
    ph_qkv(p, 1, smem); xcd_barrier(b);
    ph_mlapost(p, 1, smem); xcd_barrier(b);
    ph_mix(p, 1, smem); xcd_barrier(b);
    ph_s5pre(p, 1, smem); xcd_barrier(b);
    ph_glu(p, 1, smem); xcd_barrier(b);
    ph_final_mix(p, 1, smem); xcd_barrier(b);
    ph_wout(p, 1, smem); xcd_barrier(b);
    ph_router(p, 1, smem); xcd_barrier(b);
    ph_moe_up(p, 1, smem); xcd_barrier(b);
    ph_moe_down(p, 1, smem); xcd_barrier(b);
  }
  ph_out(p, smem);
}

#define SMEM_BYTES 49152
template <int PH>
__global__ void __launch_bounds__(256) k_phase(P p, int layer) {
  extern __shared__ __attribute__((aligned(16))) char smem[];
  if (PH == 0) ph_mod(p, smem);
  if (PH == 1) ph_norm1(p, layer, smem);
  if (PH == 2) ph_win(p, layer, smem);
  if (PH == 3) ph_prep(p, layer, smem);
  if (PH == 4) ph_qkv(p, layer, smem);
  if (PH == 5) ph_mlapost(p, layer, smem);
  if (PH == 6) ph_mix(p, layer, smem);
  if (PH == 7) ph_s5pre(p, layer, smem);
  if (PH == 8) ph_glu(p, layer, smem);
  if (PH == 9) ph_final_mix(p, layer, smem);
  if (PH == 10) ph_wout(p, layer, smem);
  if (PH == 11) ph_router(p, layer, smem);
  if (PH == 12) ph_moe_up(p, layer, smem);
  if (PH == 13) ph_moe_down(p, layer, smem);
  if (PH == 14) ph_out(p, smem);
}

extern "C" void kernel_launch(void* const* d_in, const int* in_sizes, int n_in, void* d_out, int out_size, void* d_ws,
                              size_t ws_size, hipStream_t stream) {
  P p{};
  const float* const* in = (const float* const*)d_in;
  p.x = in[0]; p.c = in[1]; p.ctx = in[2]; p.c_ctx = in[3]; p.mod_w = in[4]; p.mod_b = in[5]; p.norm1_w = in[6];
  p.w_in = in[7]; p.q_norm_w = in[8]; p.kv_norm_w = in[9]; p.w_uq = in[10]; p.w_ukv = in[11]; p.conv_w = in[12];
  p.conv_b = in[13]; p.a_log = in[14]; p.dt_bias = in[15]; p.ssd_d = in[16]; p.gate_b = in[17]; p.lam_re = in[18];
  p.lam_im = in[19]; p.log_dt = in[20]; p.b_re = in[21]; p.b_im = in[22]; p.c_re = in[23]; p.c_im = in[24];
  p.s5_d = in[25]; p.glu_w = in[26]; p.glu_b = in[27]; p.out_norm_w = in[28]; p.w_out = in[29]; p.norm2_w = in[30];
  p.w_group = in[31]; p.w_expert = in[32]; p.w_gate = in[33]; p.w_up = in[34]; p.w_down = in[35]; p.final_w = in[36];
  p.out = (float*)d_out;
  float* w = (float*)d_ws;
  size_t off = 0;
  auto take = [&](size_t n) { float* r = w + off; off += (n + 63) & ~(size_t)63; return r; };
  p.cnt = (int*)take(64);
  p.modv = take(2 * 3 * 12288);
  p.H = (bfraw*)take((size_t)TTOT * 1024);
  p.X = take((size_t)TTOT * 2048);
  p.Z = take((size_t)TTOT * NIN);
  p.Aq = (bfraw*)take((size_t)TTOT * 192);
  p.Akv = (bfraw*)take((size_t)TTOT * 64);
  p.qraw = take((size_t)TTOT * 768);
  p.kvraw = take((size_t)TTOT * 1024);
  p.Q = take((size_t)8 * SL * 192);
  p.Qc = take((size_t)8 * CL * 192);
  p.K = take((size_t)8 * NKEY * 192);
  p.V = take((size_t)8 * NKEY * 128);
  p.O = take((size_t)TTOT * 512);
  p.ssd_xs = take((size_t)TTOT * 512);
  p.ssd_B = take((size_t)TTOT * 256);
  p.ssd_C = take((size_t)TTOT * 256);
  p.ssd_dt = take((size_t)TTOT * 16);
  p.ssd_yf = take((size_t)TTOT * 512);
  p.ssd_yb = take((size_t)TTOT * 512);
  p.ml_hf = take((size_t)TTOT * 512);
  p.ml_hb = take((size_t)TTOT * 512);
  p.s5_rf = take((size_t)TTOT * 512);
  p.s5_rb = take((size_t)TTOT * 512);
  p.ydpre = take((size_t)TTOT * 512);
  p.ydg = take((size_t)TTOT * 512);
  p.Y = (bfraw*)take((size_t)TTOT * 1024);
  p.ydpre_bf = (bfraw*)take((size_t)TTOT * 256);
  p.list_tok = (int*)take((size_t)32 * CAPE);
  p.list_w = take((size_t)32 * CAPE);
  p.ACT = (bfraw*)take((size_t)ACT_ROWS * 256);
  p.Yslot = take((size_t)TTOT * 2 * 2048);
  (void)ws_size; (void)in_sizes; (void)n_in; (void)out_size;

#ifdef MULTI_LAUNCH
  const int G = 1024;
#define LAUNCH(PH, grid, layer) hipLaunchKernelGGL((k_phase<PH>), dim3(grid), dim3(256), SMEM_BYTES, stream, p, layer)
  LAUNCH(0, 192, 0);
  for (int l = 0; l < 2; ++l) {
    LAUNCH(1, G, l); LAUNCH(2, G, l); LAUNCH(3, G, l); LAUNCH(4, G, l); LAUNCH(5, G, l); LAUNCH(6, 592, l); LAUNCH(7, G, l);
    LAUNCH(8, G, l); LAUNCH(9, G, l); LAUNCH(10, G, l); LAUNCH(11, G, l); LAUNCH(12, G, l); LAUNCH(13, G, l);
  }
  LAUNCH(14, G, 0);
#else
  unsigned* bar = (unsigned*)take(XCD_BAR_WORDS);
  static int grid = 0;
  if (!grid) {
    int dev = 0, cus = 0, per_cu = 0;
    hipGetDevice(&dev);
    hipDeviceGetAttribute(&cus, hipDeviceAttributeMultiprocessorCount, dev);
    hipOccupancyMaxActiveBlocksPerMultiprocessor(&per_cu, k_fused, 256, SMEM_BYTES + 64);
    if (per_cu < 1) per_cu = 1;
    grid = cus * (per_cu < 1 ? per_cu : 1);
  }
  hipMemsetAsync(bar, 0, XCD_BAR_WORDS * sizeof(unsigned), stream);
  hipLaunchKernelGGL(k_fused, dim3(grid), dim3(256), SMEM_BYTES + 64, stream, p, bar);
#endif
}
```

```cpp
#include <hip/hip_runtime.h>
#include <stdint.h>

#define DM 2048
#define SL 4096
#define CL 256
#define TLAT 8192
#define TCTX 512
#define TTOT 8704
#define NIN 4192
#define NKEY 4352
#define ZC_CQ 0
#define ZC_CKV 384
#define ZC_KR 512
#define ZC_BZ 576
#define ZC_XBC 1088
#define ZC_DT 2112
#define ZC_MQ 2128
#define ZC_MK 2384
#define ZC_MV 2640
#define ZC_MO 3152
#define ZC_MG 3664
#define ZC_U 3680
#define CAPE 8704
#define EPSV 1e-6f
#define ACT_ROWS 21632

typedef float f32x16 __attribute__((ext_vector_type(16)));
typedef short bf16x8 __attribute__((ext_vector_type(8)));
typedef float f32x4v __attribute__((ext_vector_type(4)));
typedef unsigned short bfraw;
__device__ __forceinline__ unsigned pack_bf16(float lo, float hi) {
  typedef __bf16 bf2 __attribute__((ext_vector_type(2)));
  bf2 v; v[0] = (__bf16)lo; v[1] = (__bf16)hi;
  return __builtin_bit_cast(unsigned, v);
}
__device__ __forceinline__ bfraw to_bf16(float x) { __bf16 b = (__bf16)x; return __builtin_bit_cast(unsigned short, b); }
__device__ __forceinline__ float from_bf16(bfraw x) { return __uint_as_float((unsigned)x << 16); }

struct P {
  const float *x, *c, *ctx, *c_ctx, *mod_w, *mod_b, *norm1_w, *w_in, *q_norm_w, *kv_norm_w, *w_uq, *w_ukv;
  const float *conv_w, *conv_b, *a_log, *dt_bias, *ssd_d, *gate_b, *lam_re, *lam_im, *log_dt, *b_re, *b_im;
  const float *c_re, *c_im, *s5_d, *glu_w, *glu_b, *out_norm_w, *w_out, *norm2_w, *w_group, *w_expert;
  const float *w_gate, *w_up, *w_down, *final_w;
  float* out;
  bfraw *H, *Aq, *Akv, *Y, *ACT, *ydpre_bf;
  bfraw *Q, *Qc, *K, *V;
  float *modv, *X, *Z, *qraw, *kvraw, *O;
  float *ssd_xs, *ssd_B, *ssd_C, *ssd_dt, *ssd_y, *ssd_st, *ssd_atot, *ml_h, *ml_st, *ml_nst, *ml_gtot;
  float *s5_rf, *s5_rb, *s5_st, *s5_a, *s5_bb, *ydpre, *ydg;
  float *list_w, *Yslot;
  int *cnt, *list_tok;
};

__device__ __forceinline__ int row_modidx(int r) { return r < TLAT ? (r >> 12) : 2; }
__device__ __forceinline__ float sigmoidf_(float v) { return 1.f / (1.f + expf(-v)); }
__device__ __forceinline__ float siluf_(float v) { return v / (1.f + expf(-v)); }
__device__ __forceinline__ float wave_sum(float v) {
#pragma unroll
  for (int o = 32; o; o >>= 1) v += __shfl_xor(v, o);
  return v;
}
__device__ __forceinline__ float block_sum(float v, float* red) {
  v = wave_sum(v);
  __syncthreads();
  if ((threadIdx.x & 63) == 0) red[threadIdx.x >> 6] = v;
  __syncthreads();
  return red[0] + red[1] + red[2] + red[3];
}

__device__ __forceinline__ void ph_mod(const P& p, char* smem) {
  float* sc = (float*)smem;
  float* red = sc + 3 * 2048;
  const int tid = threadIdx.x;
  if (blockIdx.x == 0 && tid < 64) p.cnt[tid] = 0;
  for (int i = blockIdx.x * 256 + tid; i < 2 * 2 * 32 * 64; i += gridDim.x * 256) {
    const int sp = i & 63, g = (i >> 6) & 31, l = i >> 12;
    const float lr = p.lam_re[i], li = p.lam_im[i];
    const float dt = expf(p.log_dt[i >> 6]);
    const float mag = expf(lr * dt);
    const float ar = mag * cosf(li * dt), ai = mag * sinf(li * dt);
    const float den = lr * lr + li * li;
    const float cr_ = ((ar - 1.f) * lr + ai * li) / den;
    const float ci_ = (ai * lr - (ar - 1.f) * li) / den;
    p.s5_a[i * 2] = ar; p.s5_a[i * 2 + 1] = ai;
    for (int c = 0; c < 16; ++c) {
      float br = p.b_re[((size_t)(l * 32 + g) * 64 + sp) * 16 + c];
      float bim = p.b_im[((size_t)(l * 32 + g) * 64 + sp) * 16 + c];
      p.s5_bb[(size_t)i * 32 + c] = cr_ * br - ci_ * bim;
      p.s5_bb[(size_t)i * 32 + 16 + c] = cr_ * bim + ci_ * br;
    }
  }
  for (int i = tid; i < 3 * 2048; i += 256) {
    int r = i >> 11, k = i & 2047;
    float v = r < 2 ? p.c[r * 2048 + k] : p.c_ctx[k];
    sc[i] = siluf_(v);
  }
  __syncthreads();
  for (int w = blockIdx.x; w < 2 * 96; w += gridDim.x) {
    int l = w / 96, j0 = (w % 96) * 128;
    int cg = tid & 31, ks = tid >> 5;
    const float* W = p.mod_w + (size_t)l * 2048 * 12288 + j0 + cg * 4;
    float acc[3][4];
#pragma unroll
    for (int r = 0; r < 3; ++r)
#pragma unroll
      for (int c = 0; c < 4; ++c) acc[r][c] = 0.f;
#pragma unroll 4
    for (int k = ks * 256; k < ks * 256 + 256; ++k) {
      float4 wv = *(const float4*)(W + (size_t)k * 12288);
      float s0 = sc[k], s1 = sc[2048 + k], s2 = sc[4096 + k];
      acc[0][0] += s0 * wv.x; acc[0][1] += s0 * wv.y; acc[0][2] += s0 * wv.z; acc[0][3] += s0 * wv.w;
      acc[1][0] += s1 * wv.x; acc[1][1] += s1 * wv.y; acc[1][2] += s1 * wv.z; acc[1][3] += s1 * wv.w;
      acc[2][0] += s2 * wv.x; acc[2][1] += s2 * wv.y; acc[2][2] += s2 * wv.z; acc[2][3] += s2 * wv.w;
    }
    __syncthreads();
#pragma unroll
    for (int r = 0; r < 3; ++r)
#pragma unroll
      for (int c = 0; c < 4; ++c) red[(ks * 32 + cg) * 12 + r * 4 + c] = acc[r][c];
    __syncthreads();
    for (int o = tid; o < 384; o += 256) {
      int r = o >> 7, c = o & 127;
      float s = 0.f;
#pragma unroll
      for (int q = 0; q < 8; ++q) s += red[(q * 32 + (c >> 2)) * 12 + r * 4 + (c & 3)];
      s += p.mod_b[l * 12288 + j0 + c];
      p.modv[(l * 3 + r) * 12288 + j0 + c] = s;
    }
    __syncthreads();
  }
}

__device__ __forceinline__ void ph_norm1(const P& p, int layer, char* smem) {
  float* red = (float*)smem;
  const int tid = threadIdx.x;
  const float* nw = p.norm1_w + layer * 2048;
  for (int r = blockIdx.x; r < TTOT; r += gridDim.x) {
    const int mi = row_modidx(r);
    const float* mrow = p.modv + (layer * 3 + mi) * 12288;
    float v[8];
    float ss = 0.f;
#pragma unroll
    for (int hf = 0; hf < 2; ++hf) {
      int col = hf * 1024 + tid * 4;
      float4 xv;
      if (layer == 0) {
        const float* src = r < TLAT ? p.x + (size_t)r * 2048 : p.ctx + (size_t)(r - TLAT) * 2048;
        xv = *(const float4*)(src + col);
      } else {
        xv = *(const float4*)(p.X + (size_t)r * 2048 + col);
        const float* g2 = p.modv + ((layer - 1) * 3 + mi) * 12288 + 5 * 2048;
        float4 gv = *(const float4*)(g2 + col);
        float4 y0 = *(const float4*)(p.Yslot + (size_t)(2 * r) * 2048 + col);
        float4 y1 = *(const float4*)(p.Yslot + (size_t)(2 * r + 1) * 2048 + col);
        xv.x += gv.x * (y0.x + y1.x); xv.y += gv.y * (y0.y + y1.y);
        xv.z += gv.z * (y0.z + y1.z); xv.w += gv.w * (y0.w + y1.w);
        *(float4*)(p.X + (size_t)r * 2048 + col) = xv;
      }
      v[hf * 4 + 0] = xv.x; v[hf * 4 + 1] = xv.y; v[hf * 4 + 2] = xv.z; v[hf * 4 + 3] = xv.w;
      ss += xv.x * xv.x + xv.y * xv.y + xv.z * xv.z + xv.w * xv.w;
    }
    float tot = block_sum(ss, red);
    float rs = rsqrtf(tot * (1.f / 2048.f) + EPSV);
#pragma unroll
    for (int hf = 0; hf < 2; ++hf) {
      int col = hf * 1024 + tid * 4;
      float4 w4 = *(const float4*)(nw + col);
      float4 sh = *(const float4*)(mrow + col);
      float4 scv = *(const float4*)(mrow + 2048 + col);
      float4 o;
      o.x = v[hf * 4 + 0] * rs * w4.x * (1.f + scv.x) + sh.x;
      o.y = v[hf * 4 + 1] * rs * w4.y * (1.f + scv.y) + sh.y;
      o.z = v[hf * 4 + 2] * rs * w4.z * (1.f + scv.z) + sh.z;
      o.w = v[hf * 4 + 3] * rs * w4.w * (1.f + scv.w) + sh.w;
      uint2 ob; ob.x = pack_bf16(o.x, o.y); ob.y = pack_bf16(o.z, o.w);
      *(uint2*)(p.H + (size_t)r * 2048 + col) = ob;
    }
  }
}


template <class AF, class BF, class EF>
__device__ __forceinline__ void gemm_tile(const AF& af, const BF& bf, const EF& ef, int K, char* smem) {
  char* As = smem;
  char* Bs = smem + 16384;
  const int tid = threadIdx.x, lane = tid & 63, wid = tid >> 6, wr = wid >> 1, wc = wid & 1;
  const int l31 = lane & 31, lh = lane >> 5;
  f32x16 acc[2][2];
#pragma unroll
  for (int i = 0; i < 2; ++i)
#pragma unroll
    for (int j = 0; j < 2; ++j)
#pragma unroll
      for (int r = 0; r < 16; ++r) acc[i][j][r] = 0.f;
  const int arl = tid >> 3, ac = tid & 7;
  const bfraw* ar0 = af.row(arl);
  const bfraw* ar1 = af.row(arl + 32);
  const bfraw* ar2 = af.row(arl + 64);
  const bfraw* ar3 = af.row(arl + 96);
  const bool av0 = ar0 != nullptr, av1 = ar1 != nullptr, av2 = ar2 != nullptr, av3 = ar3 != nullptr;
  const bfraw* asafe = af.safe();
  if (!av0) ar0 = asafe; if (!av1) ar1 = asafe; if (!av2) ar2 = asafe; if (!av3) ar3 = asafe;
  const int n4 = tid & 31, kg = tid >> 5;
  const float* bc = bf.col(n4 * 4);
  const bool bv = bc != nullptr;
  if (!bv) bc = bf.safe();
  const int ldb = bf.ldb;
  uint4 ra0, ra1, ra2, ra3;
  f32x4v rb0, rb1, rb2, rb3, rb4, rb5, rb6, rb7;
  const uint4 zu4 = make_uint4(0u, 0u, 0u, 0u);
  const f32x4v zf4 = {0.f, 0.f, 0.f, 0.f};
#define GLOAD(k0)                                                              \
  {                                                                            \
    ra0 = *(const uint4*)(ar0 + (k0) + ac * 8); if (!av0) ra0 = zu4;           \
    ra1 = *(const uint4*)(ar1 + (k0) + ac * 8); if (!av1) ra1 = zu4;           \
    ra2 = *(const uint4*)(ar2 + (k0) + ac * 8); if (!av2) ra2 = zu4;           \
    ra3 = *(const uint4*)(ar3 + (k0) + ac * 8); if (!av3) ra3 = zu4;           \
    const float* bq = bc + (size_t)((k0) + kg * 8) * ldb;                      \
    rb0 = *(const f32x4v*)(bq);                                                \
    rb1 = *(const f32x4v*)(bq + (size_t)ldb);                                  \
    rb2 = *(const f32x4v*)(bq + (size_t)2 * ldb);                              \
    rb3 = *(const f32x4v*)(bq + (size_t)3 * ldb);                              \
    rb4 = *(const f32x4v*)(bq + (size_t)4 * ldb);                              \
    rb5 = *(const f32x4v*)(bq + (size_t)5 * ldb);                              \
    rb6 = *(const f32x4v*)(bq + (size_t)6 * ldb);                              \
    rb7 = *(const f32x4v*)(bq + (size_t)7 * ldb);                              \
    if (!bv) { rb0 = zf4; rb1 = zf4; rb2 = zf4; rb3 = zf4; rb4 = zf4; rb5 = zf4; rb6 = zf4; rb7 = zf4; } \
  }
#define SWRITE_B(i)                                                            \
  {                                                                            \
    const int n = n4 * 4 + (i);                                                \
    uint4 v;                                                                   \
    v.x = pack_bf16(rb0[i], rb1[i]); v.y = pack_bf16(rb2[i], rb3[i]);          \
    v.z = pack_bf16(rb4[i], rb5[i]); v.w = pack_bf16(rb6[i], rb7[i]);          \
    *(uint4*)(Bs + n * 128 + ((kg ^ ((n >> 1) & 7)) << 4)) = v;                \
  }
#define SWRITE()                                                               \
  {                                                                            \
    const int asw = (ac ^ ((arl >> 1) & 7)) << 4;                              \
    *(uint4*)(As + (arl) * 128 + asw) = ra0;                                   \
    *(uint4*)(As + (arl + 32) * 128 + asw) = ra1;                              \
    *(uint4*)(As + (arl + 64) * 128 + asw) = ra2;                              \
    *(uint4*)(As + (arl + 96) * 128 + asw) = ra3;                              \
    SWRITE_B(0) SWRITE_B(1) SWRITE_B(2) SWRITE_B(3)                            \
  }
  __syncthreads();
  GLOAD(0)
  SWRITE()
  __syncthreads();
  const int fsw = (l31 >> 1) & 7;
  const char* ap = As + (wr * 64 + l31) * 128;
  const char* bp = Bs + (wc * 64 + l31) * 128;
  for (int k0 = 0; k0 < K; k0 += 64) {
    const bool more = (k0 + 64) < K;
    if (more) GLOAD(k0 + 64)
#pragma unroll
    for (int kk = 0; kk < 4; ++kk) {
      const int co = ((2 * kk + lh) ^ fsw) << 4;
      bf16x8 a0 = *(const bf16x8*)(ap + co), a1 = *(const bf16x8*)(ap + 32 * 128 + co);
      bf16x8 b0 = *(const bf16x8*)(bp + co), b1 = *(const bf16x8*)(bp + 32 * 128 + co);
      acc[0][0] = __builtin_amdgcn_mfma_f32_32x32x16_bf16(a0, b0, acc[0][0], 0, 0, 0);
      acc[0][1] = __builtin_amdgcn_mfma_f32_32x32x16_bf16(a0, b1, acc[0][1], 0, 0, 0);
      acc[1][0] = __builtin_amdgcn_mfma_f32_32x32x16_bf16(a1, b0, acc[1][0], 0, 0, 0);
      acc[1][1] = __builtin_amdgcn_mfma_f32_32x32x16_bf16(a1, b1, acc[1][1], 0, 0, 0);
    }
    __syncthreads();
    if (more) SWRITE()
    __syncthreads();
  }
  ef(acc, wr, wc, lane);
}
#define ACC_ROW(wr, i, r, lane) ((wr) * 64 + (i) * 32 + ((r) & 3) + 8 * ((r) >> 2) + 4 * ((lane) >> 5))
#define ACC_COL(wc, j, lane) ((wc) * 64 + (j) * 32 + ((lane) & 31))

struct ARows { const bfraw* base; int ld; int m0; int M;
  __device__ __forceinline__ const bfraw* row(int r) const { int g = m0 + r; return g < M ? base + (size_t)g * ld : nullptr; }
  __device__ __forceinline__ const bfraw* safe() const { return base; } };
struct BPlain { const float* B; int ldb; int n0; int N;
  __device__ __forceinline__ const float* col(int v) const { int n = n0 + v; return n < N ? B + n : nullptr; }
  __device__ __forceinline__ const float* safe() const { return B; } };

template <class EPI>
__device__ __forceinline__ void gemm_dense(const bfraw* A, int lda, const float* B, int ldb, int M, int N, int K, const EPI& epi, char* smem) {
  const int mt = (M + 127) >> 7, nt = (N + 127) >> 7;
  for (int w = blockIdx.x; w < mt * nt; w += gridDim.x) {
    const int m0 = (w / nt) * 128, n0 = (w % nt) * 128;
    ARows af{A, lda, m0, M};
    BPlain bf{B, ldb, n0, N};
    auto ef = [&](const f32x16 (&acc)[2][2], int wr, int wc, int lane) {
#pragma unroll
      for (int i = 0; i < 2; ++i)
#pragma unroll
        for (int j = 0; j < 2; ++j)
#pragma unroll
          for (int r = 0; r < 16; ++r) {
            int row = m0 + ACC_ROW(wr, i, r, lane), col = n0 + ACC_COL(wc, j, lane);
            if (row < M && col < N) epi(row, col, acc[i][j][r]);
          }
    };
    gemm_tile(af, bf, ef, K, smem);
  }
}

__device__ __forceinline__ void ph_win(const P& p, int layer, char* smem) {
  float* Z = p.Z;
  auto epi = [=](int row, int col, float v) { Z[(size_t)row * NIN + col] = v; };
  gemm_dense(p.H, 2048, p.w_in + (size_t)layer * 2048 * NIN, NIN, TTOT, NIN, 2048, epi, smem);
}

__device__ __forceinline__ void ph_prep(const P& p, int layer, char* smem) {
  const int tid = threadIdx.x, lane = tid & 63, wid = tid >> 6;
  for (int r = blockIdx.x * 4 + wid; r < TTOT; r += gridDim.x * 4) {
    const float* z = p.Z + (size_t)r * NIN;
    float q[6]; float ss = 0.f;
#pragma unroll
    for (int i = 0; i < 6; ++i) { q[i] = z[ZC_CQ + i * 64 + lane]; ss += q[i] * q[i]; }
    ss = wave_sum(ss);
    float rs = rsqrtf(ss * (1.f / 384.f) + EPSV);
#pragma unroll
    for (int i = 0; i < 6; ++i) p.Aq[(size_t)r * 384 + i * 64 + lane] = to_bf16(q[i] * rs * p.q_norm_w[layer * 384 + i * 64 + lane]);
    float k0 = z[ZC_CKV + lane], k1 = z[ZC_CKV + 64 + lane];
    float s2 = wave_sum(k0 * k0 + k1 * k1);
    float rs2 = rsqrtf(s2 * (1.f / 128.f) + EPSV);
    p.Akv[(size_t)r * 128 + lane] = to_bf16(k0 * rs2 * p.kv_norm_w[layer * 128 + lane]);
    p.Akv[(size_t)r * 128 + 64 + lane] = to_bf16(k1 * rs2 * p.kv_norm_w[layer * 128 + 64 + lane]);
  }
  const float* cw = p.conv_w + layer * 5 * 1024;
  const float* cb = p.conv_b + layer * 1024;
  for (int r = blockIdx.x; r < TTOT; r += gridDim.x) {
    int base, len;
    if (r < TLAT) { base = (r >> 12) << 12; len = SL; } else { base = TLAT + (((r - TLAT) >> 8) << 8); len = CL; }
    const int t = r - base;
    const int ch = tid * 4;
    float4 acc = *(const float4*)(cb + ch);
#pragma unroll
    for (int k = 0; k < 5; ++k) {
      int tt = t + k - 2;
      if (tt >= 0 && tt < len) {
        float4 xv = *(const float4*)(p.Z + (size_t)(base + tt) * NIN + ZC_XBC + ch);
        float4 wv = *(const float4*)(cw + k * 1024 + ch);
        acc.x += xv.x * wv.x; acc.y += xv.y * wv.y; acc.z += xv.z * wv.z; acc.w += xv.w * wv.w;
      }
    }
    acc.x = siluf_(acc.x); acc.y = siluf_(acc.y); acc.z = siluf_(acc.z); acc.w = siluf_(acc.w);
    if (ch < 512) *(float4*)(p.ssd_xs + (size_t)r * 512 + ch) = acc;
    else if (ch < 768) *(float4*)(p.ssd_B + (size_t)r * 256 + (ch - 512)) = acc;
    else *(float4*)(p.ssd_C + (size_t)r * 256 + (ch - 768)) = acc;
    if (tid < 16) {
      float v = p.Z[(size_t)r * NIN + ZC_DT + tid] + p.dt_bias[layer * 16 + tid];
      float sp = v > 20.f ? v : log1pf(expf(v));
      p.ssd_dt[(size_t)r * 16 + tid] = sp;
    }
  }
}

__device__ __forceinline__ void ph_qkv(const P& p, int layer, char* smem) {
  float* qraw = p.qraw; float* kvraw = p.kvraw;
  auto e1 = [=](int row, int col, float v) { qraw[(size_t)row * 768 + col] = v; };
  gemm_dense(p.Aq, 384, p.w_uq + (size_t)layer * 384 * 768, 768, TTOT, 768, 384, e1, smem);
  auto e2 = [=](int row, int col, float v) { kvraw[(size_t)row * 1024 + col] = v; };
  gemm_dense(p.Akv, 128, p.w_ukv + (size_t)layer * 128 * 1024, 1024, TTOT, 1024, 128, e2, smem);
}

__device__ __forceinline__ void ph_mlapost(const P& p, int layer, char* smem) {
  const int tid = threadIdx.x;
  const float qscale = 0.07216878364870322f * 1.4426950408889634f;
  for (int r = blockIdx.x; r < TTOT; r += gridDim.x) {
    const bool lat = r < TLAT;
    int b, pos;
    if (lat) { b = r >> 12; pos = r & 4095; } else { b = (r - TLAT) >> 8; pos = (r - TLAT) & 255; }
    const int kpos = lat ? pos : SL + pos;
    const float* qr = p.qraw + (size_t)r * 768;
    const float* kv = p.kvraw + (size_t)r * 1024;
    const float* zr = p.Z + (size_t)r * NIN + ZC_KR;
    const float frow = (float)(pos >> 6), fcol = (float)(pos & 63);
    for (int i = tid; i < 768; i += 256) {
      int h = i / 192, d = i % 192;
      float v;
      if (d < 128 || !lat) v = qr[i];
      else {
        int e = d - 128, a = e >> 5, half = (e >> 4) & 1, f = e & 15;
        float x1 = qr[h * 192 + 128 + a * 32 + f], x2 = qr[h * 192 + 128 + a * 32 + 16 + f];
        float invf = powf(10000.f, -(float)f * (1.f / 16.f));
        float ang = (a == 0 ? frow : fcol) * invf;
        float cs = cosf(ang), sn = sinf(ang);
        v = half == 0 ? x1 * cs - x2 * sn : x1 * sn + x2 * cs;
      }
      v *= qscale;
      if (lat) p.Q[((size_t)(b * 4 + h) * SL + pos) * 192 + d] = to_bf16(v);
      else p.Qc[((size_t)(b * 4 + h) * CL + pos) * 192 + d] = to_bf16(v);
    }
    for (int i = tid; i < 768; i += 256) {
      int h = i / 192, d = i % 192;
      float v;
      if (d < 128) v = kv[h * 256 + d];
      else {
        int e = d - 128;
        if (!lat) v = zr[e];
        else {
          int a = e >> 5, half = (e >> 4) & 1, f = e & 15;
          float x1 = zr[a * 32 + f], x2 = zr[a * 32 + 16 + f];
          float invf = powf(10000.f, -(float)f * (1.f / 16.f));
          float ang = (a == 0 ? frow : fcol) * invf;
          float cs = cosf(ang), sn = sinf(ang);
          v = half == 0 ? x1 * cs - x2 * sn : x1 * sn + x2 * cs;
        }
      }
      p.K[((size_t)(b * 4 + h) * NKEY + kpos) * 192 + d] = to_bf16(v);
    }
    for (int i = tid; i < 512; i += 256) {
      int h = i >> 7, d = i & 127;
      const int ko = kpos & 15;
      const int kperm = (kpos & ~15) + 8 * ((ko >> 2) & 1) + (ko & 3) + 4 * (ko >> 3);
      p.V[((size_t)(b * 4 + h) * 128 + d) * NKEY + kperm] = to_bf16(kv[h * 256 + 128 + d]);
    }
  }
}

#define ATT_KROW 400
#define ATT_VROW 144
#define MFMA16(a, b, c) __builtin_amdgcn_mfma_f32_32x32x16_bf16(a, b, c, 0, 0, 0)
__device__ __forceinline__ void attn_item(const bfraw* __restrict__ Qp, const bfraw* __restrict__ Kp, const bfraw* __restrict__ Vtp,
                                          int nk, float* __restrict__ Op, char* smem) {
  char* Ks = smem;
  char* Vs = smem + 64 * ATT_KROW;
  const int tid = threadIdx.x, lane = tid & 63, wid = tid >> 6, l31 = lane & 31, lh = lane >> 5;
  bf16x8 qf[12];
  {
    const bfraw* qrow = Qp + (size_t)(wid * 32 + l31) * 192 + lh * 8;
#pragma unroll
    for (int ks = 0; ks < 12; ++ks) qf[ks] = *(const bf16x8*)(qrow + ks * 16);
  }
  f32x16 o[4];
#pragma unroll
  for (int d = 0; d < 4; ++d)
#pragma unroll
    for (int r = 0; r < 16; ++r) o[d][r] = 0.f;
  float m = -INFINITY, l = 0.f;
  uint4 rk0, rk1, rk2, rk3, rk4, rk5, rv0, rv1, rv2, rv3;
#define ATT_KSRC(n, kt) (Kp + (size_t)((kt) + (tid + 256 * (n)) / 24) * 192 + ((tid + 256 * (n)) % 24) * 8)
#define ATT_VSRC(n, kt) (Vtp + (size_t)((tid + 256 * (n)) >> 3) * NKEY + (kt) + ((tid + 256 * (n)) & 7) * 8)
#define ATT_GLOAD(kt)                                                                                        \
  {                                                                                                          \
    rk0 = *(const uint4*)ATT_KSRC(0, kt); rk1 = *(const uint4*)ATT_KSRC(1, kt); rk2 = *(const uint4*)ATT_KSRC(2, kt); \
    rk3 = *(const uint4*)ATT_KSRC(3, kt); rk4 = *(const uint4*)ATT_KSRC(4, kt); rk5 = *(const uint4*)ATT_KSRC(5, kt); \
    rv0 = *(const uint4*)ATT_VSRC(0, kt); rv1 = *(const uint4*)ATT_VSRC(1, kt);                              \
    rv2 = *(const uint4*)ATT_VSRC(2, kt); rv3 = *(const uint4*)ATT_VSRC(3, kt);                              \
  }
#define ATT_KDST(n) (Ks + ((tid + 256 * (n)) / 24) * ATT_KROW + ((tid + 256 * (n)) % 24) * 16)
#define ATT_VDST(n) (Vs + ((tid + 256 * (n)) >> 3) * ATT_VROW + ((tid + 256 * (n)) & 7) * 16)
#define ATT_SWRITE()                                                                                         \
  {                                                                                                          \
    *(uint4*)ATT_KDST(0) = rk0; *(uint4*)ATT_KDST(1) = rk1; *(uint4*)ATT_KDST(2) = rk2;                      \
    *(uint4*)ATT_KDST(3) = rk3; *(uint4*)ATT_KDST(4) = rk4; *(uint4*)ATT_KDST(5) = rk5;                      \
    *(uint4*)ATT_VDST(0) = rv0; *(uint4*)ATT_VDST(1) = rv1; *(uint4*)ATT_VDST(2) = rv2; *(uint4*)ATT_VDST(3) = rv3; \
  }
  __syncthreads();
  ATT_GLOAD(0)
  ATT_SWRITE()
  __syncthreads();
  for (int kt = 0; kt < nk; kt += 64) {
    const bool more = (kt + 64) < nk;
    if (more) ATT_GLOAD(kt + 64)
    f32x16 s0, s1;
#pragma unroll
    for (int r = 0; r < 16; ++r) { s0[r] = 0.f; s1[r] = 0.f; }
    const char* kp = Ks + l31 * ATT_KROW + lh * 16;
#pragma unroll
    for (int ks = 0; ks < 12; ++ks) {
      bf16x8 a0 = *(const bf16x8*)(kp + ks * 32);
      bf16x8 a1 = *(const bf16x8*)(kp + 32 * ATT_KROW + ks * 32);
      s0 = MFMA16(a0, qf[ks], s0);
      s1 = MFMA16(a1, qf[ks], s1);
    }
    float tmax = fmaxf(s0[0], s1[0]);
#pragma unroll
    for (int r = 1; r < 16; ++r) tmax = fmaxf(tmax, fmaxf(s0[r], s1[r]));
    tmax = fmaxf(tmax, __shfl_xor(tmax, 32));
    const float mn = fmaxf(m, tmax);
    const float alpha = exp2f(m - mn);
    float rs = 0.f;
#pragma unroll
    for (int r = 0; r < 16; ++r) { s0[r] = exp2f(s0[r] - mn); s1[r] = exp2f(s1[r] - mn); rs += s0[r] + s1[r]; }
    rs += __shfl_xor(rs, 32);
    l = l * alpha + rs;
    m = mn;
#pragma unroll
    for (int d = 0; d < 4; ++d)
#pragma unroll
      for (int r = 0; r < 16; ++r) o[d][r] *= alpha;
    bf16x8 pf[4];
    {
      uint4 t;
      t.x = pack_bf16(s0[0], s0[1]); t.y = pack_bf16(s0[2], s0[3]); t.z = pack_bf16(s0[4], s0[5]); t.w = pack_bf16(s0[6], s0[7]);
      pf[0] = __builtin_bit_cast(bf16x8, t);
      t.x = pack_bf16(s0[8], s0[9]); t.y = pack_bf16(s0[10], s0[11]); t.z = pack_bf16(s0[12], s0[13]); t.w = pack_bf16(s0[14], s0[15]);
      pf[1] = __builtin_bit_cast(bf16x8, t);
      t.x = pack_bf16(s1[0], s1[1]); t.y = pack_bf16(s1[2], s1[3]); t.z = pack_bf16(s1[4], s1[5]); t.w = pack_bf16(s1[6], s1[7]);
      pf[2] = __builtin_bit_cast(bf16x8, t);
      t.x = pack_bf16(s1[8], s1[9]); t.y = pack_bf16(s1[10], s1[11]); t.z = pack_bf16(s1[12], s1[13]); t.w = pack_bf16(s1[14], s1[15]);
      pf[3] = __builtin_bit_cast(bf16x8, t);
    }
    const char* vp = Vs + l31 * ATT_VROW + lh * 16;
#pragma unroll
    for (int g16 = 0; g16 < 4; ++g16) {
#pragma unroll
      for (int d = 0; d < 4; ++d) {
        bf16x8 a = *(const bf16x8*)(vp + d * 32 * ATT_VROW + g16 * 32);
        o[d] = MFMA16(a, pf[g16], o[d]);
      }
    }
    __syncthreads();
    if (more) ATT_SWRITE()
    __syncthreads();
  }
  const float inv = 1.f / l;
  float* tb = (float*)smem + wid * (32 * 129);
#pragma unroll
  for (int d = 0; d < 4; ++d)
#pragma unroll
    for (int r = 0; r < 16; ++r) tb[l31 * 129 + d * 32 + (r & 3) + 8 * (r >> 2) + 4 * lh] = o[d][r] * inv;
  __syncthreads();
  for (int i = lane; i < 32 * 32; i += 64) {
    const int q = i >> 5, c4 = i & 31;
    const float* s = tb + q * 129 + c4 * 4;
    *(float4*)(Op + (size_t)(wid * 32 + q) * 512 + c4 * 4) = make_float4(s[0], s[1], s[2], s[3]);
  }
  __syncthreads();
}

#define NSTEP 68
__device__ __forceinline__ int chunk_row0(int b, int cid) { return cid < 4 ? TLAT + b * CL + cid * 64 : b * SL + (cid - 4) * 64; }
__device__ __forceinline__ int step_of(int cid, int dir) { return dir == 0 ? cid : (cid < 4 ? 3 - cid : 71 - cid); }
__device__ __forceinline__ int cid_of(int s, int dir) { return dir == 0 ? s : (s < 4 ? 3 - s : 71 - s); }
#define MFMA32(a, b, c) __builtin_amdgcn_mfma_f32_32x32x2f32(a, b, c, 0, 0, 0)
#define ROW16(r, lh) (((r) & 3) + 8 * ((r) >> 2) + 4 * (lh))
__device__ __forceinline__ float wave_incl_scan(float v, int lane) {
#pragma unroll
  for (int o = 1; o < 64; o <<= 1) { float t = __shfl_up(v, o); if (lane >= o) v += t; }
  return v;
}

__device__ __forceinline__ void ssd_local_item(const P& p, int layer, int item, char* smem) {
  const int h = item & 7, cid = (item >> 3) % NSTEP, b = item / (8 * NSTEP);
  float* sx = (float*)smem;
  float* sB = sx + 4096;
  float* swf = sB + 64 * 129;
  float* swb = swf + 64;
  const int tid = threadIdx.x, lane = tid & 63, wid = tid >> 6, l31 = lane & 31, lh = lane >> 5;
  const int row0 = chunk_row0(b, cid), g = h >> 2;
  __syncthreads();
  for (int i = tid; i < 1024; i += 256) {
    int q = i >> 4, c4 = i & 15;
    *(float4*)(sx + q * 64 + c4 * 4) = *(const float4*)(p.ssd_xs + (size_t)(row0 + q) * 512 + h * 64 + c4 * 4);
  }
  for (int i = tid; i < 2048; i += 256) {
    int q = i >> 5, c4 = i & 31;
    float4 v = *(const float4*)(p.ssd_B + (size_t)(row0 + q) * 256 + g * 128 + c4 * 4);
    float* d = sB + q * 129 + c4 * 4;
    d[0] = v.x; d[1] = v.y; d[2] = v.z; d[3] = v.w;
  }
  if (wid < 2) {
    const int dir = wid;
    const float A = -expf(p.a_log[layer * 16 + dir * 8 + h]);
    const int q = dir ? 63 - lane : lane;
    const float dt = p.ssd_dt[(size_t)(row0 + q) * 16 + dir * 8 + h];
    const float ac = wave_incl_scan(dt * A, lane);
    const float tot = __shfl(ac, 63);
    (dir ? swb : swf)[q] = expf(tot - ac) * dt;
    if (lane == 0) p.ssd_atot[((b * 2 + dir) * 8 + h) * NSTEP + step_of(cid, dir)] = tot;
  }
  __syncthreads();
  f32x16 acc[2][2];
#pragma unroll
  for (int d = 0; d < 2; ++d)
#pragma unroll
    for (int t = 0; t < 2; ++t)
#pragma unroll
      for (int r = 0; r < 16; ++r) acc[d][t][r] = 0.f;
  const int pi = wid & 1, jj = wid >> 1;
#pragma unroll 4
  for (int k = 0; k < 64; k += 2) {
    const int q = k + lh;
    const float xa = sx[q * 64 + pi * 32 + l31];
    const float af = xa * swf[q], ab = xa * swb[q];
    const float b0 = sB[q * 129 + (2 * jj) * 32 + l31], b1 = sB[q * 129 + (2 * jj + 1) * 32 + l31];
    acc[0][0] = MFMA32(af, b0, acc[0][0]); acc[0][1] = MFMA32(af, b1, acc[0][1]);
    acc[1][0] = MFMA32(ab, b0, acc[1][0]); acc[1][1] = MFMA32(ab, b1, acc[1][1]);
  }
#pragma unroll
  for (int d = 0; d < 2; ++d) {
    float* dst = p.ssd_st + ((size_t)((b * 2 + d) * 8 + h) * NSTEP + step_of(cid, d)) * 8192;
#pragma unroll
    for (int t = 0; t < 2; ++t)
#pragma unroll
      for (int r = 0; r < 16; ++r) dst[(pi * 32 + ROW16(r, lh)) * 128 + (2 * jj + t) * 32 + l31] = acc[d][t][r];
  }
}

__device__ __forceinline__ void ssd_out_item(const P& p, int layer, int item, char* smem) {
  const int h = item & 7, cid = (item >> 3) % NSTEP, b = item / (8 * NSTEP);
  float* sC = (float*)smem;
  float* sBh = sC + 64 * 129;
  float* sx = sBh + 64 * 129;
  float* sP = sx + 4096;
  float* saf = sP + 64 * 65;
  float* sab = saf + 64;
  float* sdf = sab + 64;
  float* sdb = sdf + 64;
  const int tid = threadIdx.x, lane = tid & 63, wid = tid >> 6, l31 = lane & 31, lh = lane >> 5;
  const int row0 = chunk_row0(b, cid), g = h >> 2;
  __syncthreads();
  for (int i = tid; i < 1024; i += 256) {
    int q = i >> 4, c4 = i & 15;
    *(float4*)(sx + q * 64 + c4 * 4) = *(const float4*)(p.ssd_xs + (size_t)(row0 + q) * 512 + h * 64 + c4 * 4);
  }
  for (int i = tid; i < 2048; i += 256) {
    int q = i >> 5, c4 = i & 31;
    float4 v = *(const float4*)(p.ssd_B + (size_t)(row0 + q) * 256 + g * 128 + c4 * 4);
    float* d = sBh + q * 129 + c4 * 4;
    d[0] = v.x; d[1] = v.y; d[2] = v.z; d[3] = v.w;
    float4 w = *(const float4*)(p.ssd_C + (size_t)(row0 + q) * 256 + g * 128 + c4 * 4);
    float* e = sC + q * 129 + c4 * 4;
    e[0] = w.x; e[1] = w.y; e[2] = w.z; e[3] = w.w;
  }
  if (wid < 2) {
    const int dir = wid;
    const float A = -expf(p.a_log[layer * 16 + dir * 8 + h]);
    const int q = dir ? 63 - lane : lane;
    const float dt = p.ssd_dt[(size_t)(row0 + q) * 16 + dir * 8 + h];
    const float ac = wave_incl_scan(dt * A, lane);
    (dir ? sab : saf)[q] = ac;
    (dir ? sdb : sdf)[q] = dt;
  }
  __syncthreads();
  const int it = wid >> 1, jt = wid & 1;
  {
    f32x16 sa;
#pragma unroll
    for (int r = 0; r < 16; ++r) sa[r] = 0.f;
    const float* ap = sC + (it * 32 + l31) * 129 + lh;
    const float* bp = sBh + (jt * 32 + l31) * 129 + lh;
#pragma unroll 8
    for (int k = 0; k < 128; k += 2) sa = MFMA32(ap[k], bp[k], sa);
    const int j = jt * 32 + l31;
    const float afj = saf[j], abj = sab[j], dfj = sdf[j], dbj = sdb[j];
#pragma unroll
    for (int r = 0; r < 16; ++r) {
      const int i = it * 32 + ROW16(r, lh);
      float wgt = 0.f;
      if (j <= i) wgt += expf(saf[i] - afj) * dfj;
      if (j >= i) wgt += expf(sab[i] - abj) * dbj;
      sP[i * 65 + j] = sa[r] * wgt;
    }
  }
  __syncthreads();
  const float* hf = p.ssd_st + ((size_t)((b * 2 + 0) * 8 + h) * NSTEP + step_of(cid, 0)) * 8192;
  const float* hb = p.ssd_st + ((size_t)((b * 2 + 1) * 8 + h) * NSTEP + step_of(cid, 1)) * 8192;
  for (int i = tid; i < 2048; i += 256) {
    int q = i >> 5, c4 = i & 31;
    float4 v = *(const float4*)(hf + q * 128 + c4 * 4);
    float* d = sBh + q * 129 + c4 * 4;
    d[0] = v.x; d[1] = v.y; d[2] = v.z; d[3] = v.w;
  }
  const int pt = wid & 1;
  f32x16 ya;
#pragma unroll
  for (int r = 0; r < 16; ++r) ya[r] = 0.f;
  {
    const float* ap = sP + (it * 32 + l31) * 65 + lh;
    const float* bp = sx + lh * 64 + pt * 32 + l31;
#pragma unroll 8
    for (int k = 0; k < 64; k += 2) ya = MFMA32(ap[k], bp[k * 64], ya);
  }
  __syncthreads();
  {
    const float ef = expf(saf[it * 32 + l31]);
    const float* ap = sC + (it * 32 + l31) * 129 + lh;
    const float* bp = sBh + (pt * 32 + l31) * 129 + lh;
#pragma unroll 8
    for (int k = 0; k < 128; k += 2) ya = MFMA32(ap[k] * ef, bp[k], ya);
  }
  __syncthreads();
  for (int i = tid; i < 2048; i += 256) {
    int q = i >> 5, c4 = i & 31;
    float4 v = *(const float4*)(hb + q * 128 + c4 * 4);
    float* d = sBh + q * 129 + c4 * 4;
    d[0] = v.x; d[1] = v.y; d[2] = v.z; d[3] = v.w;
  }
  __syncthreads();
  {
    const float eb = expf(sab[it * 32 + l31]);
    const float* ap = sC + (it * 32 + l31) * 129 + lh;
    const float* bp = sBh + (pt * 32 + l31) * 129 + lh;
#pragma unroll 8
    for (int k = 0; k < 128; k += 2) ya = MFMA32(ap[k] * eb, bp[k], ya);
  }
#pragma unroll
  for (int r = 0; r < 16; ++r)
    p.ssd_y[(size_t)(row0 + it * 32 + ROW16(r, lh)) * 512 + h * 64 + pt * 32 + l31] = ya[r];
}

__device__ __forceinline__ void ml_gates(const P& p, int layer, int row0, int h, int dir, int lane, float& bcum, float& li, float& tot) {
  const int j = dir ? 63 - lane : lane;
  const float* z = p.Z + (size_t)(row0 + j) * NIN + ZC_MG + dir * 8;
  li = z[h] + p.gate_b[layer * 16 + dir * 8 + h];
  const float gf = z[4 + h] + p.gate_b[layer * 16 + dir * 8 + 4 + h];
  const float lf = gf >= 0.f ? -log1pf(expf(-gf)) : gf - log1pf(expf(gf));
  bcum = wave_incl_scan(lf, lane);
  tot = __shfl(bcum, 63);
}
__device__ __forceinline__ void ml_local_item(const P& p, int layer, int item, char* smem) {
  const int h = item & 3, cid = (item >> 2) % NSTEP, b = item / (4 * NSTEP);
  float* sv = (float*)smem;
  float* sk = sv + 8192;
  float* swf = sk + 64 * 65;
  float* swb = swf + 64;
  const int tid = threadIdx.x, lane = tid & 63, wid = tid >> 6, l31 = lane & 31, lh = lane >> 5;
  const int row0 = chunk_row0(b, cid);
  __syncthreads();
  for (int i = tid; i < 2048; i += 256) {
    int j = i >> 5, c4 = i & 31;
    *(float4*)(sv + j * 128 + c4 * 4) = *(const float4*)(p.Z + (size_t)(row0 + j) * NIN + ZC_MV + h * 128 + c4 * 4);
  }
  for (int i = tid; i < 1024; i += 256) {
    int j = i >> 4, c4 = i & 15;
    float4 v = *(const float4*)(p.Z + (size_t)(row0 + j) * NIN + ZC_MK + h * 64 + c4 * 4);
    float* d = sk + j * 65 + c4 * 4;
    d[0] = v.x; d[1] = v.y; d[2] = v.z; d[3] = v.w;
  }
  if (wid < 2) {
    const int dir = wid;
    float bc, li, tot;
    ml_gates(p, layer, row0, h, dir, lane, bc, li, tot);
    const int j = dir ? 63 - lane : lane;
    (dir ? swb : swf)[j] = expf(tot - bc + li);
    if (lane == 0) p.ml_gtot[((b * 2 + dir) * 4 + h) * NSTEP + step_of(cid, dir)] = tot;
  }
  __syncthreads();
  f32x16 acc[2][2];
#pragma unroll
  for (int d = 0; d < 2; ++d)
#pragma unroll
    for (int t = 0; t < 2; ++t)
#pragma unroll
      for (int r = 0; r < 16; ++r) acc[d][t][r] = 0.f;
  const int vt = wid;
#pragma unroll 4
  for (int k = 0; k < 64; k += 2) {
    const int j = k + lh;
    const float va = sv[j * 128 + vt * 32 + l31];
    const float af = va * swf[j], ab = va * swb[j];
    const float b0 = sk[j * 65 + l31], b1 = sk[j * 65 + 32 + l31];
    acc[0][0] = MFMA32(af, b0, acc[0][0]); acc[0][1] = MFMA32(af, b1, acc[0][1]);
    acc[1][0] = MFMA32(ab, b0, acc[1][0]); acc[1][1] = MFMA32(ab, b1, acc[1][1]);
  }
#pragma unroll
  for (int d = 0; d < 2; ++d) {
    float* dst = p.ml_st + ((size_t)((b * 2 + d) * 4 + h) * NSTEP + step_of(cid, d)) * 8192;
#pragma unroll
    for (int t = 0; t < 2; ++t)
#pragma unroll
      for (int r = 0; r < 16; ++r) dst[(vt * 32 + ROW16(r, lh)) * 64 + t * 32 + l31] = acc[d][t][r];
  }
  if (tid < 128) {
    const int d = tid >> 6, kk = tid & 63;
    const float* w = d ? swb : swf;
    float sacc = 0.f;
    for (int j = 0; j < 64; ++j) sacc += w[j] * sk[j * 65 + kk];
    p.ml_nst[((size_t)((b * 2 + d) * 4 + h) * NSTEP + step_of(cid, d)) * 64 + kk] = sacc;
  }
}

__device__ __forceinline__ void ml_out_item(const P& p, int layer, int item, char* smem) {
  const int h = item & 3, cid = (item >> 2) % NSTEP, b = item / (4 * NSTEP);
  float* sq = (float*)smem;
  float* sk = sq + 64 * 65;
  float* sv = sk + 64 * 65;
  float* sPf = sv + 128 * 65;
  float* sPb = sPf + 64 * 65;
  float* sbf = sPb + 64 * 65;
  float* sbb = sbf + 64;
  float* slf = sbb + 64;
  float* slb = slf + 64;
  float* sdenf = slb + 64;
  float* sdenb = sdenf + 64;
  float* snf = sdenb + 64;
  float* snb = snf + 64;
  const int tid = threadIdx.x, lane = tid & 63, wid = tid >> 6, l31 = lane & 31, lh = lane >> 5;
  const int row0 = chunk_row0(b, cid);
  const size_t slotf = ((size_t)((b * 2 + 0) * 4 + h) * NSTEP + step_of(cid, 0));
  const size_t slotb = ((size_t)((b * 2 + 1) * 4 + h) * NSTEP + step_of(cid, 1));
  __syncthreads();
  for (int i = tid; i < 2048; i += 256) {
    int j = i >> 5, c4 = i & 31;
    *(float4*)(sv + j * 128 + c4 * 4) = *(const float4*)(p.Z + (size_t)(row0 + j) * NIN + ZC_MV + h * 128 + c4 * 4);
  }
  for (int i = tid; i < 1024; i += 256) {
    int j = i >> 4, c4 = i & 15;
    float4 v = *(const float4*)(p.Z + (size_t)(row0 + j) * NIN + ZC_MK + h * 64 + c4 * 4);
    float* d = sk + j * 65 + c4 * 4;
    d[0] = v.x; d[1] = v.y; d[2] = v.z; d[3] = v.w;
    float4 w = *(const float4*)(p.Z + (size_t)(row0 + j) * NIN + ZC_MQ + h * 64 + c4 * 4);
    float* e = sq + j * 65 + c4 * 4;
    e[0] = w.x * 0.125f; e[1] = w.y * 0.125f; e[2] = w.z * 0.125f; e[3] = w.w * 0.125f;
  }
  if (wid < 2) {
    const int dir = wid;
    float bc, li, tot;
    ml_gates(p, layer, row0, h, dir, lane, bc, li, tot);
    const int j = dir ? 63 - lane : lane;
    (dir ? sbb : sbf)[j] = bc;
    (dir ? slb : slf)[j] = li;
    (dir ? snb : snf)[lane] = p.ml_nst[(dir ? slotb : slotf) * 64 + lane];
  }
  __syncthreads();
  const int it = wid >> 1, jt = wid & 1;
  {
    f32x16 sa;
#pragma unroll
    for (int r = 0; r < 16; ++r) sa[r] = 0.f;
    const float* ap = sq + (it * 32 + l31) * 65 + lh;
    const float* bp = sk + (jt * 32 + l31) * 65 + lh;
#pragma unroll 8
    for (int k = 0; k < 64; k += 2) sa = MFMA32(ap[k], bp[k], sa);
    const int j = jt * 32 + l31;
    const float bfj = sbf[j], bbj = sbb[j], lfj = slf[j], lbj = slb[j];
#pragma unroll
    for (int r = 0; r < 16; ++r) {
      const int i = it * 32 + ROW16(r, lh);
      sPf[i * 65 + j] = j <= i ? sa[r] * expf(sbf[i] - bfj + lfj) : 0.f;
      sPb[i * 65 + j] = j >= i ? sa[r] * expf(sbb[i] - bbj + lbj) : 0.f;
    }
  }
  __syncthreads();
  if (tid < 128) {
    const int d = tid >> 6, i = tid & 63;
    const float* Pm = d ? sPb : sPf;
    const float* ns = d ? snb : snf;
    float rs = 0.f, qn = 0.f;
    for (int j = 0; j < 64; ++j) { rs += Pm[i * 65 + j]; qn += sq[i * 65 + j] * ns[j]; }
    (d ? sdenb : sdenf)[i] = rs + expf((d ? sbb : sbf)[i]) * qn;
  }
  const int v0 = 2 * (wid & 1);
  f32x16 nf[2], nb[2];
#pragma unroll
  for (int t = 0; t < 2; ++t)
#pragma unroll
    for (int r = 0; r < 16; ++r) { nf[t][r] = 0.f; nb[t][r] = 0.f; }
  {
    const float* apf = sPf + (it * 32 + l31) * 65 + lh;
    const float* apb = sPb + (it * 32 + l31) * 65 + lh;
    const float* bp = sv + lh * 128 + v0 * 32 + l31;
#pragma unroll 4
    for (int k = 0; k < 64; k += 2) {
      const float af = apf[k], ab = apb[k], b0 = bp[k * 128], b1 = bp[k * 128 + 32];
      nf[0] = MFMA32(af, b0, nf[0]); nf[1] = MFMA32(af, b1, nf[1]);
      nb[0] = MFMA32(ab, b0, nb[0]); nb[1] = MFMA32(ab, b1, nb[1]);
    }
  }
  __syncthreads();
  {
    const float* cs = p.ml_st + slotf * 8192;
    for (int i = tid; i < 2048; i += 256) {
      int v = i >> 4, c4 = i & 15;
      float4 x4 = *(const float4*)(cs + v * 64 + c4 * 4);
      float* d = sv + v * 65 + c4 * 4;
      d[0] = x4.x; d[1] = x4.y; d[2] = x4.z; d[3] = x4.w;
    }
  }
  __syncthreads();
  {
    const float e = expf(sbf[it * 32 + l31]);
    const float* ap = sq + (it * 32 + l31) * 65 + lh;
    const float* bp = sv + (v0 * 32 + l31) * 65 + lh;
#pragma unroll 4
    for (int k = 0; k < 64; k += 2) {
      const float a = ap[k] * e;
      nf[0] = MFMA32(a, bp[k], nf[0]); nf[1] = MFMA32(a, bp[32 * 65 + k], nf[1]);
    }
  }
  __syncthreads();
  {
    const float* cs = p.ml_st + slotb * 8192;
    for (int i = tid; i < 2048; i += 256) {
      int v = i >> 4, c4 = i & 15;
      float4 x4 = *(const float4*)(cs + v * 64 + c4 * 4);
      float* d = sv + v * 65 + c4 * 4;
      d[0] = x4.x; d[1] = x4.y; d[2] = x4.z; d[3] = x4.w;
    }
  }
  __syncthreads();
  {
    const float e = expf(sbb[it * 32 + l31]);
    const float* ap = sq + (it * 32 + l31) * 65 + lh;
    const float* bp = sv + (v0 * 32 + l31) * 65 + lh;
#pragma unroll 4
    for (int k = 0; k < 64; k += 2) {
      const float a = ap[k] * e;
      nb[0] = MFMA32(a, bp[k], nb[0]); nb[1] = MFMA32(a, bp[32 * 65 + k], nb[1]);
    }
  }
#pragma unroll
  for (int r = 0; r < 16; ++r) {
    const int i = it * 32 + ROW16(r, lh);
    const float idf = 1.f / fmaxf(fabsf(sdenf[i]), 1.f), idb = 1.f / fmaxf(fabsf(sdenb[i]), 1.f);
#pragma unroll
    for (int t = 0; t < 2; ++t)
      p.ml_h[(size_t)(row0 + i) * 512 + h * 128 + (v0 + t) * 32 + l31] = nf[t][r] * idf + nb[t][r] * idb;
  }
}

template <int MODE>
__device__ __forceinline__ void s5_wave_item(const P& p, int layer, int witem, char* smem) {
  const int tid = threadIdx.x, lane = tid & 63, wid = tid >> 6;
  float* su = (float*)smem + wid * 3136;
  float* sX = su + 1024;
  const int g = witem & 31, st = (witem >> 5) % NSTEP, dir = (witem / (32 * NSTEP)) & 1, b = witem / (64 * NSTEP);
  const int cid = cid_of(st, dir), row0 = chunk_row0(b, cid);
  const int dg = (layer * 2 + dir) * 32 + g;
  const float ar = p.s5_a[(dg * 64 + lane) * 2], ai = p.s5_a[(dg * 64 + lane) * 2 + 1];
  float bbr[16], bbi[16];
  {
    const float4* bt = (const float4*)(p.s5_bb + (size_t)(dg * 64 + lane) * 32);
#pragma unroll
    for (int c4 = 0; c4 < 4; ++c4) {
      float4 v = bt[c4]; bbr[c4 * 4] = v.x; bbr[c4 * 4 + 1] = v.y; bbr[c4 * 4 + 2] = v.z; bbr[c4 * 4 + 3] = v.w;
      float4 w = bt[4 + c4]; bbi[c4 * 4] = w.x; bbi[c4 * 4 + 1] = w.y; bbi[c4 * 4 + 2] = w.z; bbi[c4 * 4 + 3] = w.w;
    }
  }
#pragma unroll
  for (int q = 0; q < 4; ++q) {
    const int t = q * 16 + (lane >> 2), c4 = lane & 3;
    const int row = dir ? row0 + 63 - t : row0 + t;
    *(float4*)(su + t * 16 + c4 * 4) = *(const float4*)(p.Z + (size_t)row * NIN + ZC_U + g * 16 + c4 * 4);
  }
  const size_t slot = ((size_t)((b * 2 + dir) * 32 + g) * NSTEP + st);
  float xr = 0.f, xi = 0.f;
  float cm[32];
  if (MODE == 1) {
    xr = p.s5_st[(slot * 64 + lane) * 2]; xi = p.s5_st[(slot * 64 + lane) * 2 + 1];
    const int c = lane & 15, kq = lane >> 4;
#pragma unroll
    for (int ks = 0; ks < 32; ++ks) {
      const int pp = 4 * ks + kq;
      cm[ks] = ks < 16 ? p.c_re[((size_t)(layer * 32 + g) * 16 + c) * 64 + pp] : -p.c_im[((size_t)(layer * 32 + g) * 16 + c) * 64 + pp - 64];
    }
  }
  float* rout = dir ? p.s5_rb : p.s5_rf;
#pragma unroll 1
  for (int sb = 0; sb < 4; ++sb) {
#pragma unroll 4
    for (int tt = 0; tt < 16; ++tt) {
      const int t = sb * 16 + tt;
      float ur = 0.f, ui = 0.f;
#pragma unroll
      for (int c4 = 0; c4 < 4; ++c4) {
        float4 uu = *(const float4*)(su + t * 16 + c4 * 4);
        ur += bbr[c4 * 4] * uu.x + bbr[c4 * 4 + 1] * uu.y + bbr[c4 * 4 + 2] * uu.z + bbr[c4 * 4 + 3] * uu.w;
        ui += bbi[c4 * 4] * uu.x + bbi[c4 * 4 + 1] * uu.y + bbi[c4 * 4 + 2] * uu.z + bbi[c4 * 4 + 3] * uu.w;
      }
      const float nr = ar * xr - ai * xi + ur;
      const float ni = ar * xi + ai * xr + ui;
      xr = nr; xi = ni;
      if (MODE == 1) { sX[tt * 130 + lane] = xr; sX[tt * 130 + 64 + lane] = xi; }
    }
    if (MODE == 1) {
      f32x4v d0 = {0.f, 0.f, 0.f, 0.f}, d1 = {0.f, 0.f, 0.f, 0.f};
      const float* ap = sX + (lane & 15) * 130 + (lane >> 4);
#pragma unroll
      for (int ks = 0; ks < 32; ks += 2) {
        d0 = __builtin_amdgcn_mfma_f32_16x16x4f32(ap[4 * ks], cm[ks], d0, 0, 0, 0);
        d1 = __builtin_amdgcn_mfma_f32_16x16x4f32(ap[4 * ks + 4], cm[ks + 1], d1, 0, 0, 0);
      }
#pragma unroll
      for (int r = 0; r < 4; ++r) {
        const int t = sb * 16 + (lane >> 4) * 4 + r;
        const int row = dir ? row0 + 63 - t : row0 + t;
        rout[(size_t)row * 512 + g * 16 + (lane & 15)] = d0[r] + d1[r];
      }
    }
  }
  if (MODE == 0) { p.s5_st[(slot * 64 + lane) * 2] = xr; p.s5_st[(slot * 64 + lane) * 2 + 1] = xi; }
}

#define N_SSD_CH (2 * NSTEP * 8)
#define N_ML_CH (2 * NSTEP * 4)
#define N_S5_BLK (2 * 2 * NSTEP * 32 / 4)
__device__ __forceinline__ void ph_mixA(const P& p, int layer, char* smem) {
  for (int w = blockIdx.x; w < N_SSD_CH + N_ML_CH + N_S5_BLK; w += gridDim.x) {
    if (w < N_SSD_CH) ssd_local_item(p, layer, w, smem);
    else if (w < N_SSD_CH + N_ML_CH) ml_local_item(p, layer, w - N_SSD_CH, smem);
    else { __syncthreads(); s5_wave_item<0>(p, layer, (w - N_SSD_CH - N_ML_CH) * 4 + (threadIdx.x >> 6), smem); }
  }
}
#define N_ATT_LAT 256
#define N_ATT_CTX 16
__device__ __forceinline__ void ph_mixB(const P& p, int layer, char* smem) {
  const int natt = N_ATT_LAT + (layer == 0 ? N_ATT_CTX : 0);
  const int nitems = natt + 256 + 128 + 4 + 32;
  const int tid = threadIdx.x;
  for (int w = blockIdx.x; w < nitems; w += gridDim.x) {
    int it = w;
    if (it < natt) {
      const bfraw *qp, *kp, *vp; float* op; int nk;
      if (it < N_ATT_LAT) {
        int qb = it & 31, hh = (it >> 5) & 3, b = it >> 7;
        qp = p.Q + ((size_t)(b * 4 + hh) * SL + qb * 128) * 192; kp = p.K + (size_t)(b * 4 + hh) * NKEY * 192;
        vp = p.V + (size_t)(b * 4 + hh) * 128 * NKEY; nk = NKEY; op = p.O + (size_t)(b * SL + qb * 128) * 512 + hh * 128;
      } else {
        it -= N_ATT_LAT;
        int qb = it & 1, hh = (it >> 1) & 3, b = it >> 3;
        qp = p.Qc + ((size_t)(b * 4 + hh) * CL + qb * 128) * 192; kp = p.K + ((size_t)(b * 4 + hh) * NKEY + SL) * 192;
        vp = p.V + (size_t)(b * 4 + hh) * 128 * NKEY + SL; nk = CL; op = p.O + (size_t)(TLAT + b * CL + qb * 128) * 512 + hh * 128;
      }
      attn_item(qp, kp, vp, nk, op, smem);
      continue;
    }
    it -= natt;
    if (it < 256) {
      const int idx = it * 256 + tid, seq = idx >> 11, off = idx & 2047;
      float4* base = (float4*)(p.ssd_st + (size_t)seq * NSTEP * 8192) + off;
      const float* at = p.ssd_atot + seq * NSTEP;
      float4 hh = make_float4(0.f, 0.f, 0.f, 0.f);
#pragma unroll 4
      for (int s2 = 0; s2 < NSTEP; ++s2) {
        float4 t = base[(size_t)s2 * 2048];
        base[(size_t)s2 * 2048] = hh;
        const float e = expf(at[s2]);
        hh.x = e * hh.x + t.x; hh.y = e * hh.y + t.y; hh.z = e * hh.z + t.z; hh.w = e * hh.w + t.w;
      }
      continue;
    }
    it -= 256;
    if (it < 128) {
      const int idx = it * 256 + tid, seq = idx >> 11, off = idx & 2047;
      float4* base = (float4*)(p.ml_st + (size_t)seq * NSTEP * 8192) + off;
      const float* at = p.ml_gtot + seq * NSTEP;
      float4 hh = make_float4(0.f, 0.f, 0.f, 0.f);
#pragma unroll 4
      for (int s2 = 0; s2 < NSTEP; ++s2) {
        float4 t = base[(size_t)s2 * 2048];
        base[(size_t)s2 * 2048] = hh;
        const float e = expf(at[s2]);
        hh.x = e * hh.x + t.x; hh.y = e * hh.y + t.y; hh.z = e * hh.z + t.z; hh.w = e * hh.w + t.w;
      }
      continue;
    }
    it -= 128;
    if (it < 4) {
      const int idx = it * 256 + tid, seq = idx >> 6, off = idx & 63;
      float* base = p.ml_nst + (size_t)seq * NSTEP * 64 + off;
      const float* at = p.ml_gtot + seq * NSTEP;
      float hh = 0.f;
      for (int s2 = 0; s2 < NSTEP; ++s2) {
        float t = base[s2 * 64]; base[s2 * 64] = hh;
        hh = expf(at[s2]) * hh + t;
      }
      continue;
    }
    it -= 4;
    {
      const int idx = it * 256 + tid, seq = idx >> 6, sp = idx & 63;
      const int g = seq & 31, dir = (seq >> 5) & 1;
      const int dg = (layer * 2 + dir) * 32 + g;
      float pr = p.s5_a[(dg * 64 + sp) * 2], pi = p.s5_a[(dg * 64 + sp) * 2 + 1];
#pragma unroll
      for (int q = 0; q < 6; ++q) { float nr = pr * pr - pi * pi, ni = 2.f * pr * pi; pr = nr; pi = ni; }
      float* base = p.s5_st + ((size_t)seq * NSTEP * 64 + sp) * 2;
      float xr = 0.f, xi = 0.f;
      for (int s2 = 0; s2 < NSTEP; ++s2) {
        float tr = base[s2 * 128], ti = base[s2 * 128 + 1];
        base[s2 * 128] = xr; base[s2 * 128 + 1] = xi;
        float nr = pr * xr - pi * xi + tr, ni = pr * xi + pi * xr + ti;
        xr = nr; xi = ni;
      }
    }
  }
}
__device__ __forceinline__ void ph_attn_only(const P& p, int layer, char* smem) {
  const int natt = N_ATT_LAT + (layer == 0 ? N_ATT_CTX : 0);
  for (int w = blockIdx.x; w < natt; w += gridDim.x) {
    int it = w;
    const bfraw *qp, *kp, *vp; float* op; int nk;
    if (it < N_ATT_LAT) {
      int qb = it & 31, hh = (it >> 5) & 3, b = it >> 7;
      qp = p.Q + ((size_t)(b * 4 + hh) * SL + qb * 128) * 192; kp = p.K + (size_t)(b * 4 + hh) * NKEY * 192;
      vp = p.V + (size_t)(b * 4 + hh) * 128 * NKEY; nk = NKEY; op = p.O + (size_t)(b * SL + qb * 128) * 512 + hh * 128;
    } else {
      it -= N_ATT_LAT;
      int qb = it & 1, hh = (it >> 1) & 3, b = it >> 3;
      qp = p.Qc + ((size_t)(b * 4 + hh) * CL + qb * 128) * 192; kp = p.K + ((size_t)(b * 4 + hh) * NKEY + SL) * 192;
      vp = p.V + (size_t)(b * 4 + hh) * 128 * NKEY + SL; nk = CL; op = p.O + (size_t)(TLAT + b * CL + qb * 128) * 512 + hh * 128;
    }
    attn_item(qp, kp, vp, nk, op, smem);
  }
}
__device__ __forceinline__ void ph_mixC(const P& p, int layer, char* smem) {
  for (int w = blockIdx.x; w < N_SSD_CH + N_ML_CH + N_S5_BLK; w += gridDim.x) {
    if (w < N_SSD_CH) ssd_out_item(p, layer, w, smem);
    else if (w < N_SSD_CH + N_ML_CH) ml_out_item(p, layer, w - N_SSD_CH, smem);
    else { __syncthreads(); s5_wave_item<1>(p, layer, (w - N_SSD_CH - N_ML_CH) * 4 + (threadIdx.x >> 6), smem); }
  }
}

__device__ __forceinline__ float gelu_tanh(float x) {
  const float k0 = 0.7978845608028654f;
  return 0.5f * x * (1.f + tanhf(k0 * (x + 0.044715f * x * x * x)));
}
__device__ __forceinline__ void ph_s5pre(const P& p, int layer, char* smem) {
  const size_t n = (size_t)TTOT * 512;
  for (size_t i = (size_t)blockIdx.x * 256 + threadIdx.x; i < n; i += (size_t)gridDim.x * 256) {
    int r = (int)(i >> 9), c = (int)(i & 511);
    float u = p.Z[(size_t)r * NIN + ZC_U + c];
    float y = p.s5_rf[i] + p.s5_rb[i] + p.s5_d[layer * 512 + c] * u;
    float gy = gelu_tanh(y);
    p.ydpre[i] = gy; p.ydpre_bf[i] = to_bf16(gy);
  }
}
__device__ __forceinline__ void ph_glu(const P& p, int layer, char* smem) {
  const float* yp = p.ydpre; float* yg = p.ydg; const float* gb = p.glu_b + layer * 512;
  auto epi = [=](int row, int col, float v) {
    float y = yp[(size_t)row * 512 + col];
    yg[(size_t)row * 512 + col] = y * sigmoidf_(v + gb[col]);
  };
  gemm_dense(p.ydpre_bf, 512, p.glu_w + (size_t)layer * 512 * 512, 512, TTOT, 512, 512, epi, smem);
}

__device__ __forceinline__ void ph_final_mix(const P& p, int layer, char* smem) {
  float* red = (float*)smem;
  const int tid = threadIdx.x;
  const float* onw = p.out_norm_w + layer * 2048;
  for (int r = blockIdx.x; r < TTOT; r += gridDim.x) {
    const int c = tid * 2;
    const float* z = p.Z + (size_t)r * NIN;
    float2 oa = *(const float2*)(p.O + (size_t)r * 512 + c);
    float sa = block_sum(oa.x * oa.x + oa.y * oa.y, red);
    float ra = rsqrtf(sa * (1.f / 512.f) + EPSV);
    float2 yf = *(const float2*)(p.ssd_y + (size_t)r * 512 + c);
    float2 xs = *(const float2*)(p.ssd_xs + (size_t)r * 512 + c);
    float2 zz = *(const float2*)(z + ZC_BZ + c);
    float dsk = p.ssd_d[layer * 8 + (c >> 6)];
    float b0 = (yf.x + dsk * xs.x) * siluf_(zz.x);
    float b1 = (yf.y + dsk * xs.y) * siluf_(zz.y);
    float sb = block_sum(b0 * b0 + b1 * b1, red);
    float rb = rsqrtf(sb * (1.f / 512.f) + EPSV);
    float2 hf = *(const float2*)(p.ml_h + (size_t)r * 512 + c);
    float c0 = hf.x, c1 = hf.y;
    float scs = wave_sum(c0 * c0 + c1 * c1);
    float rc = rsqrtf(scs * (1.f / 128.f) + EPSV);
    float2 og = *(const float2*)(z + ZC_MO + c);
    c0 = c0 * rc * sigmoidf_(og.x); c1 = c1 * rc * sigmoidf_(og.y);
    float2 yd = *(const float2*)(p.ydg + (size_t)r * 512 + c);
    float sd = block_sum(yd.x * yd.x + yd.y * yd.y, red);
    float rd = rsqrtf(sd * (1.f / 512.f) + EPSV);
    bfraw* Y = p.Y + (size_t)r * 2048;
    *(unsigned*)(Y + c) = pack_bf16(oa.x * ra * onw[c], oa.y * ra * onw[c + 1]);
    *(unsigned*)(Y + 512 + c) = pack_bf16(b0 * rb * onw[512 + c], b1 * rb * onw[512 + c + 1]);
    *(unsigned*)(Y + 1024 + c) = pack_bf16(c0 * onw[1024 + c], c1 * onw[1024 + c + 1]);
    *(unsigned*)(Y + 1536 + c) = pack_bf16(yd.x * rd * onw[1536 + c], yd.y * rd * onw[1536 + c + 1]);
  }
}

__device__ __forceinline__ void ph_wout(const P& p, int layer, char* smem) {
  const P pp = p;
  const int M = layer == 0 ? TTOT : TLAT;
  auto epi = [=](int row, int col, float v) {
    const int mi = row_modidx(row);
    const float g1 = pp.modv[(layer * 3 + mi) * 12288 + 2 * 2048 + col];
    float xin;
    if (layer == 0) xin = row < TLAT ? pp.x[(size_t)row * 2048 + col] : pp.ctx[(size_t)(row - TLAT) * 2048 + col];
    else xin = pp.X[(size_t)row * 2048 + col];
    pp.X[(size_t)row * 2048 + col] = xin + g1 * v;
  };
  gemm_dense(p.Y, 2048, p.w_out + (size_t)layer * 2048 * 2048, 2048, M, 2048, 2048, epi, smem);
}

__device__ __forceinline__ void ph_router(const P& p, int layer, char* smem) {
  float* red = (float*)smem;
  float* lred = red + 4;
  float* lg = lred + 4 * 36;
  const int tid = threadIdx.x, lane = tid & 63, wid = tid >> 6;
  const int T = layer == 0 ? TTOT : TLAT;
  const float* nw = p.norm2_w + layer * 2048;
  const float* wg = p.w_group + (size_t)layer * 2048 * 4;
  const float* we = p.w_expert + (size_t)layer * 2048 * 32;
  for (int r = blockIdx.x; r < T; r += gridDim.x) {
    const int mi = row_modidx(r);
    const float* mrow = p.modv + (layer * 3 + mi) * 12288;
    const int k0 = tid * 8;
    float v[8]; float ss = 0.f;
#pragma unroll
    for (int hf = 0; hf < 2; ++hf) {
      float4 xv = *(const float4*)(p.X + (size_t)r * 2048 + k0 + hf * 4);
      v[hf * 4 + 0] = xv.x; v[hf * 4 + 1] = xv.y; v[hf * 4 + 2] = xv.z; v[hf * 4 + 3] = xv.w;
      ss += xv.x * xv.x + xv.y * xv.y + xv.z * xv.z + xv.w * xv.w;
    }
    float tot = block_sum(ss, red);
    float rs = rsqrtf(tot * (1.f / 2048.f) + EPSV);
#pragma unroll
    for (int i = 0; i < 8; ++i) {
      int col = k0 + i;
      v[i] = v[i] * rs * nw[col] * (1.f + mrow[4 * 2048 + col]) + mrow[3 * 2048 + col];
    }
    { uint4 hb; hb.x = pack_bf16(v[0], v[1]); hb.y = pack_bf16(v[2], v[3]); hb.z = pack_bf16(v[4], v[5]); hb.w = pack_bf16(v[6], v[7]);
      *(uint4*)(p.H + (size_t)r * 2048 + k0) = hb; }
    float lgt[36];
#pragma unroll
    for (int j = 0; j < 36; ++j) lgt[j] = 0.f;
#pragma unroll
    for (int i = 0; i < 8; ++i) {
      float4 g4 = *(const float4*)(wg + (size_t)(k0 + i) * 4);
      lgt[0] += v[i] * g4.x; lgt[1] += v[i] * g4.y; lgt[2] += v[i] * g4.z; lgt[3] += v[i] * g4.w;
#pragma unroll
      for (int j4 = 0; j4 < 8; ++j4) {
        float4 e4 = *(const float4*)(we + (size_t)(k0 + i) * 32 + j4 * 4);
        lgt[4 + j4 * 4 + 0] += v[i] * e4.x; lgt[4 + j4 * 4 + 1] += v[i] * e4.y;
        lgt[4 + j4 * 4 + 2] += v[i] * e4.z; lgt[4 + j4 * 4 + 3] += v[i] * e4.w;
      }
    }
#pragma unroll
    for (int j = 0; j < 36; ++j) lgt[j] = wave_sum(lgt[j]);
    __syncthreads();
    if (lane == 0) {
#pragma unroll
      for (int j = 0; j < 36; ++j) lred[wid * 36 + j] = lgt[j];
    }
    __syncthreads();
    if (tid < 36) lg[tid] = lred[tid] + lred[36 + tid] + lred[72 + tid] + lred[108 + tid];
    __syncthreads();
    if (tid == 0) {
      int gi = 0; float gm = lg[0];
      for (int j = 1; j < 4; ++j) if (lg[j] > gm) { gm = lg[j]; gi = j; }
      float gs = 0.f;
      for (int j = 0; j < 4; ++j) gs += expf(lg[j] - gm);
      float gw = 1.f / gs;
      const float* el = lg + 4 + gi * 8;
      int i1 = 0; float v1 = el[0];
      for (int j = 1; j < 8; ++j) if (el[j] > v1) { v1 = el[j]; i1 = j; }
      int i2 = -1; float v2 = -INFINITY;
      for (int j = 0; j < 8; ++j) if (j != i1 && el[j] > v2) { v2 = el[j]; i2 = j; }
      float e2 = expf(v2 - v1);
      float w1 = gw / (1.f + e2), w2 = gw * e2 / (1.f + e2);
      int ex1 = gi * 8 + i1, ex2 = gi * 8 + i2;
      int* cnt = p.cnt + layer * 32;
      int p1 = atomicAdd(&cnt[ex1], 1);
      p.list_tok[ex1 * CAPE + p1] = r * 2; p.list_w[ex1 * CAPE + p1] = w1;
      int p2 = atomicAdd(&cnt[ex2], 1);
      p.list_tok[ex2 * CAPE + p2] = r * 2 + 1; p.list_w[ex2 * CAPE + p2] = w2;
    }
  }
}

struct AGather { const bfraw* H; const int* toks; int nvalid;
  __device__ __forceinline__ const bfraw* row(int r) const { return r < nvalid ? H + (size_t)(toks[r] >> 1) * 2048 : nullptr; }
  __device__ __forceinline__ const bfraw* safe() const { return H; } };
struct BGateUp { const float *g, *u; int ldb; int nb;
  __device__ __forceinline__ const float* col(int v) const { int wc = v >> 6, j = (v >> 5) & 1, c = v & 31;
    const float* b = (const float*)((uintptr_t)g + (uintptr_t)j * ((uintptr_t)u - (uintptr_t)g)); return b + nb + wc * 32 + c; }
  __device__ __forceinline__ const float* safe() const { return g; } };

__device__ __forceinline__ void moe_prefix(const P& p, int layer, int* spre) {
  __syncthreads();
  if (threadIdx.x == 0) {
    int acc = 0;
    for (int e = 0; e < 32; ++e) { spre[e] = acc; acc += (p.cnt[layer * 32 + e] + 127) >> 7; }
    spre[32] = acc;
  }
  __syncthreads();
}
__device__ __forceinline__ void ph_moe_up(const P& p, int layer, char* smem) {
  int* spre = (int*)(smem + 40960);
  moe_prefix(p, layer, spre);
  const int ntile = spre[32];
  for (int w = blockIdx.x; w < ntile * 8; w += gridDim.x) {
    const int rbg = w >> 3, nt = w & 7;
    int e = 0;
    while (e < 31 && spre[e + 1] <= rbg) ++e;
    const int rb = rbg - spre[e];
    const int cnt = p.cnt[layer * 32 + e];
    AGather af{p.H, p.list_tok + e * CAPE + rb * 128, cnt - rb * 128};
    const size_t wo = ((size_t)layer * 32 + e) * 2048 * 512;
    BGateUp bf{p.w_gate + wo, p.w_up + wo, 512, nt * 64};
    bfraw* act = p.ACT + (size_t)rbg * 128 * 512 + nt * 64;
    auto ef = [&](const f32x16 (&acc)[2][2], int wr, int wc, int lane) {
#pragma unroll
      for (int i = 0; i < 2; ++i)
#pragma unroll
        for (int r = 0; r < 16; ++r) {
          int row = ACC_ROW(wr, i, r, lane);
          float gv = acc[i][0][r], uv = acc[i][1][r];
          act[(size_t)row * 512 + wc * 32 + (lane & 31)] = to_bf16(siluf_(gv) * uv);
        }
    };
    gemm_tile(af, bf, ef, 2048, smem);
  }
}
__device__ __forceinline__ void ph_moe_down(const P& p, int layer, char* smem) {
  int* spre = (int*)(smem + 40960);
  moe_prefix(p, layer, spre);
  const int ntile = spre[32];
  for (int w = blockIdx.x; w < ntile * 16; w += gridDim.x) {
    const int rbg = w >> 4, nt = w & 15;
    int e = 0;
    while (e < 31 && spre[e + 1] <= rbg) ++e;
    const int rb = rbg - spre[e];
    const int nvalid = p.cnt[layer * 32 + e] - rb * 128;
    ARows af{p.ACT + (size_t)rbg * 128 * 512, 512, 0, 128};
    BPlain bf{p.w_down + ((size_t)layer * 32 + e) * 512 * 2048, 2048, nt * 128, 2048};
    const int* toks = p.list_tok + e * CAPE + rb * 128;
    const float* lw = p.list_w + e * CAPE + rb * 128;
    float* Ys = p.Yslot;
    auto ef = [&](const f32x16 (&acc)[2][2], int wr, int wc, int lane) {
#pragma unroll
      for (int i = 0; i < 2; ++i)
#pragma unroll
        for (int r = 0; r < 16; ++r) {
          int row = ACC_ROW(wr, i, r, lane);
          if (row < nvalid) {
            int ts = toks[row]; float wgt = lw[row];
#pragma unroll
            for (int j = 0; j < 2; ++j) Ys[(size_t)ts * 2048 + nt * 128 + ACC_COL(wc, j, lane)] = wgt * acc[i][j][r];
          }
        }
    };
    gemm_tile(af, bf, ef, 512, smem);
  }
}

__device__ __forceinline__ void ph_out(const P& p, char* smem) {
  float* red = (float*)smem;
  const int tid = threadIdx.x;
  for (int r = blockIdx.x; r < TLAT; r += gridDim.x) {
    const int mi = r >> 12;
    const float* g2 = p.modv + (1 * 3 + mi) * 12288 + 5 * 2048;
    float v[8]; float ss = 0.f;
#pragma unroll
    for (int hf = 0; hf < 2; ++hf) {
      int col = hf * 1024 + tid * 4;
      float4 xv = *(const float4*)(p.X + (size_t)r * 2048 + col);
      float4 gv = *(const float4*)(g2 + col);
      float4 y0 = *(const float4*)(p.Yslot + (size_t)(2 * r) * 2048 + col);
      float4 y1 = *(const float4*)(p.Yslot + (size_t)(2 * r + 1) * 2048 + col);
      xv.x += gv.x * (y0.x + y1.x); xv.y += gv.y * (y0.y + y1.y);
      xv.z += gv.z * (y0.z + y1.z); xv.w += gv.w * (y0.w + y1.w);
      v[hf * 4 + 0] = xv.x; v[hf * 4 + 1] = xv.y; v[hf * 4 + 2] = xv.z; v[hf * 4 + 3] = xv.w;
      ss += xv.x * xv.x + xv.y * xv.y + xv.z * xv.z + xv.w * xv.w;
    }
    float tot = block_sum(ss, red);
    float rs = rsqrtf(tot * (1.f / 2048.f) + EPSV);
#pragma unroll
    for (int hf = 0; hf < 2; ++hf) {
      int col = hf * 1024 + tid * 4;
      float4 w4 = *(const float4*)(p.final_w + col);
      float4 o;
      o.x = v[hf * 4 + 0] * rs * w4.x; o.y = v[hf * 4 + 1] * rs * w4.y;
      o.z = v[hf * 4 + 2] * rs * w4.z; o.w = v[hf * 4 + 3] * rs * w4.w;
      *(float4*)(p.out + (size_t)r * 2048 + col) = o;
    }
  }
}

#define SMEM_BYTES 102400
#define XB_TMO      128
#define XB_XCNT(j)  (256  + 64 * (j))
#define XB_XSUB(j)  (1280 + 64 * (j))
#define XB_XGEN(j)  (2304 + 64 * (j))
#define XB_TOP      3328
#define XB_TOPGEN   3392
#define XCD_BAR_WORDS 3456
#define XB_SPIN_CAP (1u << 22)
#define LAS __attribute__((address_space(3)))
__device__ __forceinline__ unsigned xb_ld(unsigned* p)              { return __hip_atomic_load(p, __ATOMIC_RELAXED, __HIP_MEMORY_SCOPE_AGENT); }
__device__ __forceinline__ unsigned xb_add(unsigned* p, unsigned v) { return __hip_atomic_fetch_add(p, v, __ATOMIC_RELAXED, __HIP_MEMORY_SCOPE_AGENT); }
__device__ __forceinline__ unsigned xb_xcc_id() { return (unsigned)__builtin_amdgcn_s_getreg((3 << 11) | 20) & 0xFu; }
#define XB_SPIN(cond, bar) do { unsigned _sp = 0; while (cond) { __builtin_amdgcn_s_sleep(1); \
    if ((++_sp & 255u) == 0u) { if (xb_ld(&(bar)[XB_TMO])) break; if (_sp > XB_SPIN_CAP) { atomicAdd(&(bar)[XB_TMO], 1u); break; } } } } while (0)
struct XcdBarrier { unsigned* bar; unsigned x; volatile LAS unsigned* st; };
__device__ __forceinline__ XcdBarrier xcd_barrier_post(unsigned* bar, volatile LAS unsigned* st) {
    XcdBarrier b; b.bar = bar; b.x = xb_xcc_id(); b.st = st;
    if (threadIdx.x == 0) (void)xb_add(&bar[XB_XCNT(b.x)], 1u);
    return b;
}
__device__ __forceinline__ void xcd_barrier_complete(unsigned* bar, unsigned x, unsigned& nloc, unsigned& nx) {
    const unsigned G = gridDim.x * gridDim.y * gridDim.z;
    unsigned sum, cnt, mine, sp = 0u;
    for (;;) {
        sum = 0u; cnt = 0u; mine = 0u;
#pragma unroll
        for (unsigned j = 0; j < 16; ++j) { const unsigned c = xb_ld(&bar[XB_XCNT(j)]); sum += c; cnt += (c > 0u) ? 1u : 0u; mine = (j == x) ? c : mine; }
        if (sum == G) break;
        __builtin_amdgcn_s_sleep(1);
        if ((++sp & 255u) == 0u) { if (xb_ld(&bar[XB_TMO])) break; if (sp > XB_SPIN_CAP) { atomicAdd(&bar[XB_TMO], 1u); break; } }
    }
    nloc = mine > 0u ? mine : 1u; nx = cnt > 0u ? cnt : 1u;
}
__device__ __forceinline__ void xcd_barrier(const XcdBarrier& b) {
    asm volatile("s_waitcnt vmcnt(0)" ::: "memory");
    __syncthreads();
    if (threadIdx.x == 0) {
        unsigned* bar = b.bar;
        __builtin_amdgcn_s_waitcnt(0);
        unsigned nloc = b.st[0], nx = b.st[1];
        if (nloc == 0u) { xcd_barrier_complete(bar, b.x, nloc, nx); b.st[0] = nloc; b.st[1] = nx; }
        const unsigned old = xb_add(&bar[XB_XSUB(b.x)], 1u);
        const unsigned gen = old / nloc;
        if (old + 1u == (gen + 1u) * nloc) {
            __builtin_amdgcn_fence(__ATOMIC_RELEASE, "agent");
            asm volatile("s_waitcnt vmcnt(0)" ::: "memory");
            const unsigned og = xb_add(&bar[XB_TOP], 1u);
            const unsigned tg = og / nx;
            if (og + 1u == (tg + 1u) * nx) xb_add(&bar[XB_TOPGEN], 1u);
            else XB_SPIN(xb_ld(&bar[XB_TOPGEN]) == tg, bar);
            __builtin_amdgcn_fence(__ATOMIC_ACQUIRE, "agent");
            xb_add(&bar[XB_XGEN(b.x)], 1u);
            asm volatile("s_waitcnt vmcnt(0)" ::: "memory");
        } else {
            XB_SPIN(xb_ld(&bar[XB_XGEN(b.x)]) == gen, bar);
            __builtin_amdgcn_fence(__ATOMIC_ACQUIRE, "agent");
            asm volatile("s_waitcnt vmcnt(0)" ::: "memory");
        }
    }
    __syncthreads();
}

__global__ void __launch_bounds__(256, 1) k_fused(P p, unsigned* bar) {
  extern __shared__ __attribute__((aligned(16))) char smem_all[];
  char* smem = smem_all + 64;
  if (threadIdx.x == 0) *(uint4*)smem_all = make_uint4(0u, 0u, 0u, 0u);
  __syncthreads();
  XcdBarrier b = xcd_barrier_post(bar, (volatile LAS unsigned*)smem_all);
#ifndef DUP_GEMM
#define DUP_GEMM 1
#endif
#ifndef DUP_ATT
#define DUP_ATT 1
#endif
#ifndef DUP_MIXAC
#define DUP_MIXAC 1
#endif
#ifndef DUP_ELT
#define DUP_ELT 1
#endif
#define REP(n, call) { call; if ((n) > 1) { call; } if ((n) > 2) { call; } }
#define LAYER_PROGRAM(L)                                                        \
  {                                                                             \
    ph_norm1(p, L, smem); xcd_barrier(b);                                       \
    REP(DUP_GEMM, ph_win(p, L, smem)) xcd_barrier(b);                           \
    REP(DUP_ELT, ph_prep(p, L, smem)) xcd_barrier(b);                           \
    REP(DUP_GEMM, ph_qkv(p, L, smem)) xcd_barrier(b);                           \
    REP(DUP_ELT, ph_mlapost(p, L, smem)) xcd_barrier(b);                        \
    REP(DUP_MIXAC, ph_mixA(p, L, smem)) xcd_barrier(b);                         \
    if (DUP_ATT > 1) { ph_attn_only(p, L, smem); } ph_mixB(p, L, smem); xcd_barrier(b); \
    REP(DUP_MIXAC, ph_mixC(p, L, smem)) xcd_barrier(b);                         \
    REP(DUP_ELT, ph_s5pre(p, L, smem)) xcd_barrier(b);                          \
    REP(DUP_GEMM, ph_glu(p, L, smem)) xcd_barrier(b);                           \
    REP(DUP_ELT, ph_final_mix(p, L, smem)) xcd_barrier(b);                      \
    REP((L == 0 ? DUP_GEMM : 1), ph_wout(p, L, smem)) xcd_barrier(b);           \
    ph_router(p, L, smem); xcd_barrier(b);                                      \
    REP(DUP_GEMM, ph_moe_up(p, L, smem)) xcd_barrier(b);                        \
    REP(DUP_GEMM, ph_moe_down(p, L, smem)) xcd_barrier(b);                      \
  }
  ph_mod(p, smem); xcd_barrier(b);
  LAYER_PROGRAM(0)
  LAYER_PROGRAM(1)
  ph_out(p, smem);
}

extern "C" void kernel_launch(void* const* d_in, const int* in_sizes, int n_in, void* d_out, int out_size, void* d_ws,
                              size_t ws_size, hipStream_t stream) {
  P p{};
  const float* const* in = (const float* const*)d_in;
  p.x = in[0]; p.c = in[1]; p.ctx = in[2]; p.c_ctx = in[3]; p.mod_w = in[4]; p.mod_b = in[5]; p.norm1_w = in[6];
  p.w_in = in[7]; p.q_norm_w = in[8]; p.kv_norm_w = in[9]; p.w_uq = in[10]; p.w_ukv = in[11]; p.conv_w = in[12];
  p.conv_b = in[13]; p.a_log = in[14]; p.dt_bias = in[15]; p.ssd_d = in[16]; p.gate_b = in[17]; p.lam_re = in[18];
  p.lam_im = in[19]; p.log_dt = in[20]; p.b_re = in[21]; p.b_im = in[22]; p.c_re = in[23]; p.c_im = in[24];
  p.s5_d = in[25]; p.glu_w = in[26]; p.glu_b = in[27]; p.out_norm_w = in[28]; p.w_out = in[29]; p.norm2_w = in[30];
  p.w_group = in[31]; p.w_expert = in[32]; p.w_gate = in[33]; p.w_up = in[34]; p.w_down = in[35]; p.final_w = in[36];
  p.out = (float*)d_out;
  float* w = (float*)d_ws;
  size_t off = 0;
  auto take = [&](size_t n) { float* r = w + off; off += (n + 63) & ~(size_t)63; return r; };
  p.cnt = (int*)take(64);
  p.modv = take(2 * 3 * 12288);
  p.H = (bfraw*)take((size_t)TTOT * 1024);
  p.X = take((size_t)TTOT * 2048);
  p.Z = take((size_t)TTOT * NIN);
  p.Aq = (bfraw*)take((size_t)TTOT * 192);
  p.Akv = (bfraw*)take((size_t)TTOT * 64);
  p.qraw = take((size_t)TTOT * 768);
  p.kvraw = take((size_t)TTOT * 1024);
  p.Q = (bfraw*)take((size_t)8 * SL * 96);
  p.Qc = (bfraw*)take((size_t)8 * CL * 96);
  p.K = (bfraw*)take((size_t)8 * NKEY * 96);
  p.V = (bfraw*)take((size_t)8 * NKEY * 64);
  p.O = take((size_t)TTOT * 512);
  p.ssd_xs = take((size_t)TTOT * 512);
  p.ssd_B = take((size_t)TTOT * 256);
  p.ssd_C = take((size_t)TTOT * 256);
  p.ssd_dt = take((size_t)TTOT * 16);
  p.ssd_y = take((size_t)TTOT * 512);
  p.ssd_st = take((size_t)32 * NSTEP * 8192);
  p.ssd_atot = take(32 * NSTEP);
  p.ml_h = take((size_t)TTOT * 512);
  p.ml_st = take((size_t)16 * NSTEP * 8192);
  p.ml_nst = take((size_t)16 * NSTEP * 64);
  p.ml_gtot = take(16 * NSTEP);
  p.s5_st = take((size_t)128 * NSTEP * 128);
  p.s5_a = take(2 * 2 * 32 * 64 * 2);
  p.s5_bb = take((size_t)2 * 2 * 32 * 64 * 32);
  p.s5_rf = take((size_t)TTOT * 512);
  p.s5_rb = take((size_t)TTOT * 512);
  p.ydpre = take((size_t)TTOT * 512);
  p.ydg = take((size_t)TTOT * 512);
  p.Y = (bfraw*)take((size_t)TTOT * 1024);
  p.ydpre_bf = (bfraw*)take((size_t)TTOT * 256);
  p.list_tok = (int*)take((size_t)32 * CAPE);
  p.list_w = take((size_t)32 * CAPE);
  p.ACT = (bfraw*)take((size_t)ACT_ROWS * 256);
  p.Yslot = take((size_t)TTOT * 2 * 2048);
  (void)ws_size; (void)in_sizes; (void)n_in; (void)out_size;

  unsigned* bar = (unsigned*)take(XCD_BAR_WORDS);
  static int grid = 0;
  if (!grid) {
    int dev = 0, cus = 0, per_cu = 0;
    hipGetDevice(&dev);
    hipDeviceGetAttribute(&cus, hipDeviceAttributeMultiprocessorCount, dev);
    (void)hipFuncSetAttribute((const void*)k_fused, hipFuncAttributeMaxDynamicSharedMemorySize, SMEM_BYTES + 64);
    (void)hipOccupancyMaxActiveBlocksPerMultiprocessor(&per_cu, k_fused, 256, SMEM_BYTES + 64);
    if (per_cu < 1) per_cu = 1;
    grid = cus * (per_cu < 1 ? per_cu : 1);
  }
  hipMemsetAsync(bar, 0, XCD_BAR_WORDS * sizeof(unsigned), stream);
  hipLaunchKernelGGL(k_fused, dim3(grid), dim3(256), SMEM_BYTES + 64, stream, p, bar);
}
```

```cpp
#include <hip/hip_runtime.h>
#include <stdint.h>

#define DM 2048
#define SL 4096
#define CL 256
#define TLAT 8192
#define TCTX 512
#define TTOT 8704
#define NIN 4192
#define NKEY 4352
#define ZC_CQ 0
#define ZC_CKV 384
#define ZC_KR 512
#define ZC_BZ 576
#define ZC_XBC 1088
#define ZC_DT 2112
#define ZC_MQ 2128
#define ZC_MK 2384
#define ZC_MV 2640
#define ZC_MO 3152
#define ZC_MG 3664
#define ZC_U 3680
#define CAPE 8704
#define EPSV 1e-6f
#define ACT_ROWS 21632

typedef float f32x16 __attribute__((ext_vector_type(16)));
typedef short bf16x8 __attribute__((ext_vector_type(8)));
typedef float f32x4v __attribute__((ext_vector_type(4)));
typedef unsigned short bfraw;
__device__ __forceinline__ unsigned pack_bf16(float lo, float hi) {
  typedef __bf16 bf2 __attribute__((ext_vector_type(2)));
  bf2 v; v[0] = (__bf16)lo; v[1] = (__bf16)hi;
  return __builtin_bit_cast(unsigned, v);
}
__device__ __forceinline__ bfraw to_bf16(float x) { __bf16 b = (__bf16)x; return __builtin_bit_cast(unsigned short, b); }
__device__ __forceinline__ float from_bf16(bfraw x) { return __uint_as_float((unsigned)x << 16); }

#define NSTEP 68
#define XCD_BAR_WORDS 3456
#define WS_RND(n) (((size_t)(n) + 63) & ~(size_t)63)
constexpr size_t WO_cnt = 0;
constexpr size_t WO_modv = WO_cnt + WS_RND(64);
constexpr size_t WO_H = WO_modv + WS_RND(2 * 3 * 12288);
constexpr size_t WO_X = WO_H + WS_RND((size_t)TTOT * 1024);
constexpr size_t WO_Z = WO_X + WS_RND((size_t)TTOT * 2048);
constexpr size_t WO_Aq = WO_Z + WS_RND((size_t)TTOT * NIN);
constexpr size_t WO_Akv = WO_Aq + WS_RND((size_t)TTOT * 192);
constexpr size_t WO_qraw = WO_Akv + WS_RND((size_t)TTOT * 64);
constexpr size_t WO_kvraw = WO_qraw + WS_RND((size_t)TTOT * 768);
constexpr size_t WO_Q = WO_kvraw + WS_RND((size_t)TTOT * 1024);
constexpr size_t WO_Qc = WO_Q + WS_RND((size_t)8 * SL * 96);
constexpr size_t WO_K = WO_Qc + WS_RND((size_t)8 * CL * 96);
constexpr size_t WO_V = WO_K + WS_RND((size_t)8 * NKEY * 96);
constexpr size_t WO_O = WO_V + WS_RND((size_t)8 * NKEY * 64);
constexpr size_t WO_ssd_xs = WO_O + WS_RND((size_t)TTOT * 512);
constexpr size_t WO_ssd_B = WO_ssd_xs + WS_RND((size_t)TTOT * 512);
constexpr size_t WO_ssd_C = WO_ssd_B + WS_RND((size_t)TTOT * 256);
constexpr size_t WO_ssd_dt = WO_ssd_C + WS_RND((size_t)TTOT * 256);
constexpr size_t WO_ssd_y = WO_ssd_dt + WS_RND((size_t)TTOT * 16);
constexpr size_t WO_ssd_st = WO_ssd_y + WS_RND((size_t)TTOT * 512);
constexpr size_t WO_ssd_atot = WO_ssd_st + WS_RND((size_t)32 * NSTEP * 8192);
constexpr size_t WO_ml_h = WO_ssd_atot + WS_RND(32 * NSTEP);
constexpr size_t WO_ml_st = WO_ml_h + WS_RND((size_t)TTOT * 512);
constexpr size_t WO_ml_nst = WO_ml_st + WS_RND((size_t)16 * NSTEP * 8192);
constexpr size_t WO_ml_gtot = WO_ml_nst + WS_RND((size_t)16 * NSTEP * 64);
constexpr size_t WO_s5_st = WO_ml_gtot + WS_RND(16 * NSTEP);
constexpr size_t WO_s5_a = WO_s5_st + WS_RND((size_t)128 * NSTEP * 128);
constexpr size_t WO_s5_bb = WO_s5_a + WS_RND(2 * 2 * 32 * 64 * 2);
constexpr size_t WO_s5_rf = WO_s5_bb + WS_RND((size_t)2 * 2 * 32 * 64 * 32);
constexpr size_t WO_s5_rb = WO_s5_rf + WS_RND((size_t)TTOT * 512);
constexpr size_t WO_ydpre = WO_s5_rb + WS_RND((size_t)TTOT * 512);
constexpr size_t WO_ydg = WO_ydpre + WS_RND((size_t)TTOT * 512);
constexpr size_t WO_Y = WO_ydg + WS_RND((size_t)TTOT * 512);
constexpr size_t WO_ydpre_bf = WO_Y + WS_RND((size_t)TTOT * 1024);
constexpr size_t WO_list_tok = WO_ydpre_bf + WS_RND((size_t)TTOT * 256);
constexpr size_t WO_list_w = WO_list_tok + WS_RND((size_t)32 * CAPE);
constexpr size_t WO_ACT = WO_list_w + WS_RND((size_t)32 * CAPE);
constexpr size_t WO_Yslot = WO_ACT + WS_RND((size_t)ACT_ROWS * 256);
constexpr size_t WO_bar = WO_Yslot + WS_RND((size_t)TTOT * 2 * 2048);
constexpr size_t WS_TOTAL_FLOATS = WO_bar + 4096;

struct P {
  const float *x, *c, *ctx, *c_ctx, *mod_w, *mod_b, *norm1_w, *w_in, *q_norm_w, *kv_norm_w, *w_uq, *w_ukv;
  const float *conv_w, *conv_b, *a_log, *dt_bias, *ssd_d, *gate_b, *lam_re, *lam_im, *log_dt, *b_re, *b_im;
  const float *c_re, *c_im, *s5_d, *glu_w, *glu_b, *out_norm_w, *w_out, *norm2_w, *w_group, *w_expert;
  const float *w_gate, *w_up, *w_down, *final_w;
  float* out;
  float* ws;
  __device__ __forceinline__ int* cnt() const { return (int*)(ws + WO_cnt); }
  __device__ __forceinline__ float* modv() const { return (float*)(ws + WO_modv); }
  __device__ __forceinline__ bfraw* H() const { return (bfraw*)(ws + WO_H); }
  __device__ __forceinline__ float* X() const { return (float*)(ws + WO_X); }
  __device__ __forceinline__ float* Z() const { return (float*)(ws + WO_Z); }
  __device__ __forceinline__ bfraw* Aq() const { return (bfraw*)(ws + WO_Aq); }
  __device__ __forceinline__ bfraw* Akv() const { return (bfraw*)(ws + WO_Akv); }
  __device__ __forceinline__ float* qraw() const { return (float*)(ws + WO_qraw); }
  __device__ __forceinline__ float* kvraw() const { return (float*)(ws + WO_kvraw); }
  __device__ __forceinline__ bfraw* Q() const { return (bfraw*)(ws + WO_Q); }
  __device__ __forceinline__ bfraw* Qc() const { return (bfraw*)(ws + WO_Qc); }
  __device__ __forceinline__ bfraw* K() const { return (bfraw*)(ws + WO_K); }
  __device__ __forceinline__ bfraw* V() const { return (bfraw*)(ws + WO_V); }
  __device__ __forceinline__ float* O() const { return (float*)(ws + WO_O); }
  __device__ __forceinline__ float* ssd_xs() const { return (float*)(ws + WO_ssd_xs); }
  __device__ __forceinline__ float* ssd_B() const { return (float*)(ws + WO_ssd_B); }
  __device__ __forceinline__ float* ssd_C() const { return (float*)(ws + WO_ssd_C); }
  __device__ __forceinline__ float* ssd_dt() const { return (float*)(ws + WO_ssd_dt); }
  __device__ __forceinline__ float* ssd_y() const { return (float*)(ws + WO_ssd_y); }
  __device__ __forceinline__ float* ssd_st() const { return (float*)(ws + WO_ssd_st); }
  __device__ __forceinline__ float* ssd_atot() const { return (float*)(ws + WO_ssd_atot); }
  __device__ __forceinline__ float* ml_h() const { return (float*)(ws + WO_ml_h); }
  __device__ __forceinline__ float* ml_st() const { return (float*)(ws + WO_ml_st); }
  __device__ __forceinline__ float* ml_nst() const { return (float*)(ws + WO_ml_nst); }
  __device__ __forceinline__ float* ml_gtot() const { return (float*)(ws + WO_ml_gtot); }
  __device__ __forceinline__ float* s5_st() const { return (float*)(ws + WO_s5_st); }
  __device__ __forceinline__ float* s5_a() const { return (float*)(ws + WO_s5_a); }
  __device__ __forceinline__ float* s5_bb() const { return (float*)(ws + WO_s5_bb); }
  __device__ __forceinline__ float* s5_rf() const { return (float*)(ws + WO_s5_rf); }
  __device__ __forceinline__ float* s5_rb() const { return (float*)(ws + WO_s5_rb); }
  __device__ __forceinline__ float* ydpre() const { return (float*)(ws + WO_ydpre); }
  __device__ __forceinline__ float* ydg() const { return (float*)(ws + WO_ydg); }
  __device__ __forceinline__ bfraw* Y() const { return (bfraw*)(ws + WO_Y); }
  __device__ __forceinline__ bfraw* ydpre_bf() const { return (bfraw*)(ws + WO_ydpre_bf); }
  __device__ __forceinline__ int* list_tok() const { return (int*)(ws + WO_list_tok); }
  __device__ __forceinline__ float* list_w() const { return (float*)(ws + WO_list_w); }
  __device__ __forceinline__ bfraw* ACT() const { return (bfraw*)(ws + WO_ACT); }
  __device__ __forceinline__ float* Yslot() const { return (float*)(ws + WO_Yslot); }
};

__device__ __forceinline__ int row_modidx(int r) { return r < TLAT ? (r >> 12) : 2; }
__device__ __forceinline__ float sigmoidf_(float v) { return 1.f / (1.f + expf(-v)); }
__device__ __forceinline__ float siluf_(float v) { return v / (1.f + expf(-v)); }
__device__ __forceinline__ float wave_sum(float v) {
#pragma unroll
  for (int o = 32; o; o >>= 1) v += __shfl_xor(v, o);
  return v;
}
__device__ __forceinline__ float block_sum(float v, float* red) {
  v = wave_sum(v);
  __syncthreads();
  if ((threadIdx.x & 63) == 0) red[threadIdx.x >> 6] = v;
  __syncthreads();
  return red[0] + red[1] + red[2] + red[3];
}

__device__ __forceinline__ void ph_mod(const P& p, char* smem) {
  float* sc = (float*)smem;
  float* red = sc + 3 * 2048;
  const int tid = threadIdx.x;
  if (blockIdx.x == 0 && tid < 64) p.cnt()[tid] = 0;
  for (int i = blockIdx.x * 256 + tid; i < 2 * 2 * 32 * 64; i += gridDim.x * 256) {
    const int sp = i & 63, g = (i >> 6) & 31, l = i >> 12;
    const float lr = p.lam_re[i], li = p.lam_im[i];
    const float dt = expf(p.log_dt[i >> 6]);
    const float mag = expf(lr * dt);
    const float ar = mag * cosf(li * dt), ai = mag * sinf(li * dt);
    const float den = lr * lr + li * li;
    const float cr_ = ((ar - 1.f) * lr + ai * li) / den;
    const float ci_ = (ai * lr - (ar - 1.f) * li) / den;
    p.s5_a()[i * 2] = ar; p.s5_a()[i * 2 + 1] = ai;
    for (int c = 0; c < 16; ++c) {
      float br = p.b_re[((size_t)(l * 32 + g) * 64 + sp) * 16 + c];
      float bim = p.b_im[((size_t)(l * 32 + g) * 64 + sp) * 16 + c];
      p.s5_bb()[(size_t)i * 32 + c] = cr_ * br - ci_ * bim;
      p.s5_bb()[(size_t)i * 32 + 16 + c] = cr_ * bim + ci_ * br;
    }
  }
  for (int i = tid; i < 3 * 2048; i += 256) {
    int r = i >> 11, k = i & 2047;
    float v = r < 2 ? p.c[r * 2048 + k] : p.c_ctx[k];
    sc[i] = siluf_(v);
  }
  __syncthreads();
  for (int w = blockIdx.x; w < 2 * 96; w += gridDim.x) {
    int l = w / 96, j0 = (w % 96) * 128;
    int cg = tid & 31, ks = tid >> 5;
    const float* W = p.mod_w + (size_t)l * 2048 * 12288 + j0 + cg * 4;
    float acc[3][4];
#pragma unroll
    for (int r = 0; r < 3; ++r)
#pragma unroll
      for (int c = 0; c < 4; ++c) acc[r][c] = 0.f;
#pragma unroll 16
    for (int k = ks * 256; k < ks * 256 + 256; ++k) {
      float4 wv = *(const float4*)(W + (size_t)k * 12288);
      float s0 = sc[k], s1 = sc[2048 + k], s2 = sc[4096 + k];
      acc[0][0] += s0 * wv.x; acc[0][1] += s0 * wv.y; acc[0][2] += s0 * wv.z; acc[0][3] += s0 * wv.w;
      acc[1][0] += s1 * wv.x; acc[1][1] += s1 * wv.y; acc[1][2] += s1 * wv.z; acc[1][3] += s1 * wv.w;
      acc[2][0] += s2 * wv.x; acc[2][1] += s2 * wv.y; acc[2][2] += s2 * wv.z; acc[2][3] += s2 * wv.w;
    }
    __syncthreads();
#pragma unroll
    for (int r = 0; r < 3; ++r)
#pragma unroll
      for (int c = 0; c < 4; ++c) red[(ks * 32 + cg) * 12 + r * 4 + c] = acc[r][c];
    __syncthreads();
    for (int o = tid; o < 384; o += 256) {
      int r = o >> 7, c = o & 127;
      float s = 0.f;
#pragma unroll
      for (int q = 0; q < 8; ++q) s += red[(q * 32 + (c >> 2)) * 12 + r * 4 + (c & 3)];
      s += p.mod_b[l * 12288 + j0 + c];
      p.modv()[(l * 3 + r) * 12288 + j0 + c] = s;
    }
    __syncthreads();
  }
}

__device__ __forceinline__ void ph_norm1(const P& p, int layer, int bid, char* smem) {
  float* red = (float*)smem;
  const int tid = threadIdx.x;
  const float* nw = p.norm1_w + layer * 2048;
  for (int r = bid; r < TTOT; r += gridDim.x) {
    const int mi = row_modidx(r);
    const float* mrow = p.modv() + (layer * 3 + mi) * 12288;
    float v[8];
    float ss = 0.f;
#pragma unroll
    for (int hf = 0; hf < 2; ++hf) {
      int col = hf * 1024 + tid * 4;
      float4 xv;
      if (layer == 0) {
        const float* src = r < TLAT ? p.x + (size_t)r * 2048 : p.ctx + (size_t)(r - TLAT) * 2048;
        xv = *(const float4*)(src + col);
      } else {
        xv = *(const float4*)(p.X() + (size_t)r * 2048 + col);
        const float* g2 = p.modv() + ((layer - 1) * 3 + mi) * 12288 + 5 * 2048;
        float4 gv = *(const float4*)(g2 + col);
        float4 y0 = *(const float4*)(p.Yslot() + (size_t)(2 * r) * 2048 + col);
        float4 y1 = *(const float4*)(p.Yslot() + (size_t)(2 * r + 1) * 2048 + col);
        xv.x += gv.x * (y0.x + y1.x); xv.y += gv.y * (y0.y + y1.y);
        xv.z += gv.z * (y0.z + y1.z); xv.w += gv.w * (y0.w + y1.w);
        *(float4*)(p.X() + (size_t)r * 2048 + col) = xv;
      }
      v[hf * 4 + 0] = xv.x; v[hf * 4 + 1] = xv.y; v[hf * 4 + 2] = xv.z; v[hf * 4 + 3] = xv.w;
      ss += xv.x * xv.x + xv.y * xv.y + xv.z * xv.z + xv.w * xv.w;
    }
    float tot = block_sum(ss, red);
    float rs = rsqrtf(tot * (1.f / 2048.f) + EPSV);
#pragma unroll
    for (int hf = 0; hf < 2; ++hf) {
      int col = hf * 1024 + tid * 4;
      float4 w4 = *(const float4*)(nw + col);
      float4 sh = *(const float4*)(mrow + col);
      float4 scv = *(const float4*)(mrow + 2048 + col);
      float4 o;
      o.x = v[hf * 4 + 0] * rs * w4.x * (1.f + scv.x) + sh.x;
      o.y = v[hf * 4 + 1] * rs * w4.y * (1.f + scv.y) + sh.y;
      o.z = v[hf * 4 + 2] * rs * w4.z * (1.f + scv.z) + sh.z;
      o.w = v[hf * 4 + 3] * rs * w4.w * (1.f + scv.w) + sh.w;
      uint2 ob; ob.x = pack_bf16(o.x, o.y); ob.y = pack_bf16(o.z, o.w);
      *(uint2*)(p.H() + (size_t)r * 2048 + col) = ob;
    }
  }
}

template <int MI, class AF, class BF, class EF>
__device__ __forceinline__ void gemm_tile(const AF& af, const BF& bf, const EF& ef, int K, char* smem) {
  constexpr int BM = MI * 64;
  constexpr int NA = MI * 2;
  constexpr int ABYTES = BM * 128, STAGE = ABYTES + 16384;
  const int tid = threadIdx.x, lane = tid & 63, wid = tid >> 6, wr = wid >> 1, wc = wid & 1;
  const int l31 = lane & 31, lh = lane >> 5;
  f32x16 acc[MI][2];
#pragma unroll
  for (int i = 0; i < MI; ++i)
#pragma unroll
    for (int j = 0; j < 2; ++j)
#pragma unroll
      for (int r = 0; r < 16; ++r) acc[i][j][r] = 0.f;
  const int arl = tid >> 3, ac = tid & 7;
  const bfraw* arow[NA];
#pragma unroll
  for (int i = 0; i < NA; ++i) { const bfraw* q = af.row(arl + 32 * i); arow[i] = (q ? q : af.safe()) + ac * 8; }
  const int n4 = tid & 31, kg = tid >> 5;
  const float* bc;
  { const float* q = bf.col(n4 * 4); bc = (q ? q : bf.safe()) + (size_t)(kg * 8) * bf.ldb; }
  const size_t ldb = (size_t)bf.ldb;
  typedef unsigned u32x4v __attribute__((ext_vector_type(4)));
  u32x4v ra[2][NA];
  f32x4v rb[2][8];
#define GM_GL(set, k0)                                                               \
  {                                                                                  \
    _Pragma("unroll") for (int i = 0; i < NA; ++i) ra[set][i] = *(const u32x4v*)(arow[i] + (k0)); \
    const float* bq = bc + (size_t)(k0) * ldb;                                       \
    _Pragma("unroll") for (int j = 0; j < 8; ++j) rb[set][j] = *(const f32x4v*)(bq + (size_t)j * ldb); \
  }
#define GM_SW(set, buf)                                                              \
  {                                                                                  \
    char* Ab = smem + (buf) * STAGE; char* Bb = Ab + ABYTES;                         \
    const int asw = (ac ^ ((arl >> 1) & 7)) << 4;                                    \
    _Pragma("unroll") for (int i = 0; i < NA; ++i) *(u32x4v*)(Ab + (arl + 32 * i) * 128 + asw) = ra[set][i]; \
    _Pragma("unroll") for (int i4 = 0; i4 < 4; ++i4) {                               \
      const int n = n4 * 4 + i4;                                                     \
      u32x4v v;                                                                      \
      v[0] = pack_bf16(rb[set][0][i4], rb[set][1][i4]); v[1] = pack_bf16(rb[set][2][i4], rb[set][3][i4]); \
      v[2] = pack_bf16(rb[set][4][i4], rb[set][5][i4]); v[3] = pack_bf16(rb[set][6][i4], rb[set][7][i4]); \
      *(u32x4v*)(Bb + n * 128 + ((kg ^ ((n >> 1) & 7)) << 4)) = v;                   \
    }                                                                                \
  }
#define GM_COMPUTE(buf)                                                              \
  {                                                                                  \
    const char* ap = smem + (buf) * STAGE + (wr * (BM / 2) + l31) * 128;             \
    const char* bp = smem + (buf) * STAGE + ABYTES + (wc * 64 + l31) * 128;          \
    _Pragma("unroll") for (int kk = 0; kk < 4; ++kk) {                               \
      const int co = ((2 * kk + lh) ^ fsw) << 4;                                     \
      const bf16x8 b0 = *(const bf16x8*)(bp + co), b1 = *(const bf16x8*)(bp + 32 * 128 + co); \
      _Pragma("unroll") for (int i = 0; i < MI; ++i) {                               \
        const bf16x8 a = *(const bf16x8*)(ap + i * 32 * 128 + co);                   \
        acc[i][0] = __builtin_amdgcn_mfma_f32_32x32x16_bf16(a, b0, acc[i][0], 0, 0, 0); \
        acc[i][1] = __builtin_amdgcn_mfma_f32_32x32x16_bf16(a, b1, acc[i][1], 0, 0, 0); \
      }                                                                              \
    }                                                                                \
  }
  const int fsw = (l31 >> 1) & 7;
  const int nsteps = K >> 6;
  __syncthreads();
  GM_GL(0, 0)
  GM_SW(0, 0)
  if (nsteps > 1) GM_GL(1, 64)
  __syncthreads();
  for (int s = 0; s < nsteps; s += 2) {
    if (s + 2 < nsteps) GM_GL(0, (s + 2) * 64)
    GM_COMPUTE(0)
    if (s + 1 < nsteps) GM_SW(1, 1)
    __syncthreads();
    if (s + 1 < nsteps) {
      if (s + 3 < nsteps) GM_GL(1, (s + 3) * 64)
      GM_COMPUTE(1)
      if (s + 2 < nsteps) GM_SW(0, 0)
      __syncthreads();
    }
  }
  ef(acc, wr, wc, lane);
}
#define ACC_ROWM(MI, wr, i, r, lane) ((wr) * ((MI) * 32) + (i) * 32 + ((r) & 3) + 8 * ((r) >> 2) + 4 * ((lane) >> 5))
#define ACC_ROW(wr, i, r, lane) ACC_ROWM(2, wr, i, r, lane)
#define ACC_COL(wc, j, lane) ((wc) * 64 + (j) * 32 + ((lane) & 31))

struct ARows { const bfraw* base; int ld; int m0; int M;
  __device__ __forceinline__ const bfraw* row(int r) const { int g = m0 + r; return g < M ? base + (size_t)g * ld : nullptr; }
  __device__ __forceinline__ const bfraw* safe() const { return base; } };
struct BPlain { const float* B; int ldb; int n0; int N;
  __device__ __forceinline__ const float* col(int v) const { int n = n0 + v; return n < N ? B + n : nullptr; }
  __device__ __forceinline__ const float* safe() const { return B; } };

template <int MI, class EPI>
__device__ __forceinline__ void gemm_dense(const bfraw* A, int lda, const float* B, int ldb, int M, int N, int K, const EPI& epi, int bid, char* smem) {
  constexpr int BM = MI * 64;
  const int mt = (M + BM - 1) / BM, nt = (N + 127) >> 7;
  const int nslots = ((nt + 1) >> 1) * mt * 2;
  for (int w = bid; w < nslots; w += gridDim.x) {
    const int sr = w / (mt * 2), rem = w - sr * (mt * 2);
    const int n_t = sr * 2 + (rem & 1);
    if (n_t >= nt) continue;
    const int m0 = (rem >> 1) * BM, n0 = n_t * 128;
    ARows af{A, lda, m0, M};
    BPlain bf{B, ldb, n0, N};
    auto ef = [&](const f32x16 (&acc)[MI][2], int wr, int wc, int lane) {
#pragma unroll
      for (int i = 0; i < MI; ++i)
#pragma unroll
        for (int j = 0; j < 2; ++j)
#pragma unroll
          for (int r = 0; r < 16; ++r) {
            int row = m0 + ACC_ROWM(MI, wr, i, r, lane), col = n0 + ACC_COL(wc, j, lane);
            if (row < M && col < N) epi(row, col, acc[i][j][r]);
          }
    };
    gemm_tile<MI>(af, bf, ef, K, smem);
  }
}

__device__ __forceinline__ void ph_win(const P& p, int layer, int bid, char* smem) {
  float* Z = p.Z();
  auto epi = [=](int row, int col, float v) { Z[(size_t)row * NIN + col] = v; };
  gemm_dense<4>(p.H(), 2048, p.w_in + (size_t)layer * 2048 * NIN, NIN, TTOT, NIN, 2048, epi, bid, smem);
}

__device__ __forceinline__ void ph_prep(const P& p, int layer, int bid, char* smem) {
  const int tid = threadIdx.x, lane = tid & 63, wid = tid >> 6;
  for (int r = bid * 4 + wid; r < TTOT; r += gridDim.x * 4) {
    const float* z = p.Z() + (size_t)r * NIN;
    float q[6]; float ss = 0.f;
#pragma unroll
    for (int i = 0; i < 6; ++i) { q[i] = z[ZC_CQ + i * 64 + lane]; ss += q[i] * q[i]; }
    ss = wave_sum(ss);
    float rs = rsqrtf(ss * (1.f / 384.f) + EPSV);
#pragma unroll
    for (int i = 0; i < 6; ++i) p.Aq()[(size_t)r * 384 + i * 64 + lane] = to_bf16(q[i] * rs * p.q_norm_w[layer * 384 + i * 64 + lane]);
    float k0 = z[ZC_CKV + lane], k1 = z[ZC_CKV + 64 + lane];
    float s2 = wave_sum(k0 * k0 + k1 * k1);
    float rs2 = rsqrtf(s2 * (1.f / 128.f) + EPSV);
    p.Akv()[(size_t)r * 128 + lane] = to_bf16(k0 * rs2 * p.kv_norm_w[layer * 128 + lane]);
    p.Akv()[(size_t)r * 128 + 64 + lane] = to_bf16(k1 * rs2 * p.kv_norm_w[layer * 128 + 64 + lane]);
  }
  const float* cw = p.conv_w + layer * 5 * 1024;
  const float* cb = p.conv_b + layer * 1024;
  for (int r = bid; r < TTOT; r += gridDim.x) {
    int base, len;
    if (r < TLAT) { base = (r >> 12) << 12; len = SL; } else { base = TLAT + (((r - TLAT) >> 8) << 8); len = CL; }
    const int t = r - base;
    const int ch = tid * 4;
    float4 acc = *(const float4*)(cb + ch);
#pragma unroll
    for (int k = 0; k < 5; ++k) {
      int tt = t + k - 2;
      if (tt >= 0 && tt < len) {
        float4 xv = *(const float4*)(p.Z() + (size_t)(base + tt) * NIN + ZC_XBC + ch);
        float4 wv = *(const float4*)(cw + k * 1024 + ch);
        acc.x += xv.x * wv.x; acc.y += xv.y * wv.y; acc.z += xv.z * wv.z; acc.w += xv.w * wv.w;
      }
    }
    acc.x = siluf_(acc.x); acc.y = siluf_(acc.y); acc.z = siluf_(acc.z); acc.w = siluf_(acc.w);
    if (ch < 512) *(float4*)(p.ssd_xs() + (size_t)r * 512 + ch) = acc;
    else if (ch < 768) *(float4*)(p.ssd_B() + (size_t)r * 256 + (ch - 512)) = acc;
    else *(float4*)(p.ssd_C() + (size_t)r * 256 + (ch - 768)) = acc;
    if (tid < 16) {
      float v = p.Z()[(size_t)r * NIN + ZC_DT + tid] + p.dt_bias[layer * 16 + tid];
      float sp = v > 20.f ? v : log1pf(expf(v));
      p.ssd_dt()[(size_t)r * 16 + tid] = sp;
    }
  }
}

__device__ __forceinline__ void ph_qkv(const P& p, int layer, int bid, char* smem) {
  float* qraw = p.qraw(); float* kvraw = p.kvraw();
  auto e1 = [=](int row, int col, float v) { qraw[(size_t)row * 768 + col] = v; };
  gemm_dense<2>(p.Aq(), 384, p.w_uq + (size_t)layer * 384 * 768, 768, TTOT, 768, 384, e1, bid, smem);
  auto e2 = [=](int row, int col, float v) { kvraw[(size_t)row * 1024 + col] = v; };
  gemm_dense<2>(p.Akv(), 128, p.w_ukv + (size_t)layer * 128 * 1024, 1024, TTOT, 1024, 128, e2, bid, smem);
}

__device__ __forceinline__ void ph_mlapost(const P& p, int layer, int bid, char* smem) {
  const int tid = threadIdx.x;
  const float qscale = 0.07216878364870322f * 1.4426950408889634f;
  for (int r = bid; r < TTOT; r += gridDim.x) {
    const bool lat = r < TLAT;
    int b, pos;
    if (lat) { b = r >> 12; pos = r & 4095; } else { b = (r - TLAT) >> 8; pos = (r - TLAT) & 255; }
    const int kpos = lat ? pos : SL + pos;
    const float* qr = p.qraw() + (size_t)r * 768;
    const float* kv = p.kvraw() + (size_t)r * 1024;
    const float* zr = p.Z() + (size_t)r * NIN + ZC_KR;
    const float frow = (float)(pos >> 6), fcol = (float)(pos & 63);
    for (int i = tid; i < 768; i += 256) {
      int h = i / 192, d = i % 192;
      float v;
      if (d < 128 || !lat) v = qr[i];
      else {
        int e = d - 128, a = e >> 5, half = (e >> 4) & 1, f = e & 15;
        float x1 = qr[h * 192 + 128 + a * 32 + f], x2 = qr[h * 192 + 128 + a * 32 + 16 + f];
        float invf = powf(10000.f, -(float)f * (1.f / 16.f));
        float ang = (a == 0 ? frow : fcol) * invf;
        float cs = cosf(ang), sn = sinf(ang);
        v = half == 0 ? x1 * cs - x2 * sn : x1 * sn + x2 * cs;
      }
      v *= qscale;
      if (lat) p.Q()[((size_t)(b * 4 + h) * SL + pos) * 192 + d] = to_bf16(v);
      else p.Qc()[((size_t)(b * 4 + h) * CL + pos) * 192 + d] = to_bf16(v);
    }
    for (int i = tid; i < 768; i += 256) {
      int h = i / 192, d = i % 192;
      float v;
      if (d < 128) v = kv[h * 256 + d];
      else {
        int e = d - 128;
        if (!lat) v = zr[e];
        else {
          int a = e >> 5, half = (e >> 4) & 1, f = e & 15;
          float x1 = zr[a * 32 + f], x2 = zr[a * 32 + 16 + f];
          float invf = powf(10000.f, -(float)f * (1.f / 16.f));
          float ang = (a == 0 ? frow : fcol) * invf;
          float cs = cosf(ang), sn = sinf(ang);
          v = half == 0 ? x1 * cs - x2 * sn : x1 * sn + x2 * cs;
        }
      }
      p.K()[((size_t)(b * 4 + h) * NKEY + kpos) * 192 + d] = to_bf16(v);
    }
    for (int i = tid; i < 512; i += 256) {
      int h = i >> 7, d = i & 127;
      const int ko = kpos & 15;
      const int kperm = (kpos & ~15) + 8 * ((ko >> 2) & 1) + (ko & 3) + 4 * (ko >> 3);
      p.V()[((size_t)(b * 4 + h) * 128 + d) * NKEY + kperm] = to_bf16(kv[h * 256 + 128 + d]);
    }
  }
}

#define ATT_KROW 400
#define ATT_VROW 144
#define MFMA16(a, b, c) __builtin_amdgcn_mfma_f32_32x32x16_bf16(a, b, c, 0, 0, 0)
__device__ __forceinline__ void attn_item(const bfraw* __restrict__ Qp, const bfraw* __restrict__ Kp, const bfraw* __restrict__ Vtp,
                                          int nk, float* __restrict__ Op, char* smem) {
  char* Ks = smem;
  char* Vs = smem + 64 * ATT_KROW;
  const int tid = threadIdx.x, lane = tid & 63, wid = tid >> 6, l31 = lane & 31, lh = lane >> 5;
  bf16x8 qf[12];
  {
    const bfraw* qrow = Qp + (size_t)(wid * 32 + l31) * 192 + lh * 8;
#pragma unroll
    for (int ks = 0; ks < 12; ++ks) qf[ks] = *(const bf16x8*)(qrow + ks * 16);
  }
  f32x16 o[4];
#pragma unroll
  for (int d = 0; d < 4; ++d)
#pragma unroll
    for (int r = 0; r < 16; ++r) o[d][r] = 0.f;
  float m = -INFINITY, l = 0.f;
  uint4 rk0, rk1, rk2, rk3, rk4, rk5, rv0, rv1, rv2, rv3;
#define ATT_KSRC(n, kt) (Kp + (size_t)((kt) + (tid + 256 * (n)) / 24) * 192 + ((tid + 256 * (n)) % 24) * 8)
#define ATT_VSRC(n, kt) (Vtp + (size_t)((tid + 256 * (n)) >> 3) * NKEY + (kt) + ((tid + 256 * (n)) & 7) * 8)
#define ATT_GLOAD(kt)                                                                                        \
  {                                                                                                          \
    rk0 = *(const uint4*)ATT_KSRC(0, kt); rk1 = *(const uint4*)ATT_KSRC(1, kt); rk2 = *(const uint4*)ATT_KSRC(2, kt); \
    rk3 = *(const uint4*)ATT_KSRC(3, kt); rk4 = *(const uint4*)ATT_KSRC(4, kt); rk5 = *(const uint4*)ATT_KSRC(5, kt); \
    rv0 = *(const uint4*)ATT_VSRC(0, kt); rv1 = *(const uint4*)ATT_VSRC(1, kt);                              \
    rv2 = *(const uint4*)ATT_VSRC(2, kt); rv3 = *(const uint4*)ATT_VSRC(3, kt);                              \
  }
#define ATT_KDST(n) (Ks + ((tid + 256 * (n)) / 24) * ATT_KROW + ((tid + 256 * (n)) % 24) * 16)
#define ATT_VDST(n) (Vs + ((tid + 256 * (n)) >> 3) * ATT_VROW + ((tid + 256 * (n)) & 7) * 16)
#define ATT_SWRITE()                                                                                         \
  {                                                                                                          \
    *(uint4*)ATT_KDST(0) = rk0; *(uint4*)ATT_KDST(1) = rk1; *(uint4*)ATT_KDST(2) = rk2;                      \
    *(uint4*)ATT_KDST(3) = rk3; *(uint4*)ATT_KDST(4) = rk4; *(uint4*)ATT_KDST(5) = rk5;                      \
    *(uint4*)ATT_VDST(0) = rv0; *(uint4*)ATT_VDST(1) = rv1; *(uint4*)ATT_VDST(2) = rv2; *(uint4*)ATT_VDST(3) = rv3; \
  }
  __syncthreads();
  ATT_GLOAD(0)
  ATT_SWRITE()
  __syncthreads();
  for (int kt = 0; kt < nk; kt += 64) {
    const bool more = (kt + 64) < nk;
    if (more) ATT_GLOAD(kt + 64)
    f32x16 s0, s1;
#pragma unroll
    for (int r = 0; r < 16; ++r) { s0[r] = 0.f; s1[r] = 0.f; }
    const char* kp = Ks + l31 * ATT_KROW + lh * 16;
#pragma unroll
    for (int ks = 0; ks < 12; ++ks) {
      bf16x8 a0 = *(const bf16x8*)(kp + ks * 32);
      bf16x8 a1 = *(const bf16x8*)(kp + 32 * ATT_KROW + ks * 32);
      s0 = MFMA16(a0, qf[ks], s0);
      s1 = MFMA16(a1, qf[ks], s1);
    }
    float tmax = fmaxf(s0[0], s1[0]);
#pragma unroll
    for (int r = 1; r < 16; ++r) tmax = fmaxf(tmax, fmaxf(s0[r], s1[r]));
    tmax = fmaxf(tmax, __shfl_xor(tmax, 32));
    const float mn = fmaxf(m, tmax);
    const float alpha = exp2f(m - mn);
    float rs = 0.f;
#pragma unroll
    for (int r = 0; r < 16; ++r) { s0[r] = exp2f(s0[r] - mn); s1[r] = exp2f(s1[r] - mn); rs += s0[r] + s1[r]; }
    rs += __shfl_xor(rs, 32);
    l = l * alpha + rs;
    m = mn;
#pragma unroll
    for (int d = 0; d < 4; ++d)
#pragma unroll
      for (int r = 0; r < 16; ++r) o[d][r] *= alpha;
    bf16x8 pf[4];
    {
      uint4 t;
      t.x = pack_bf16(s0[0], s0[1]); t.y = pack_bf16(s0[2], s0[3]); t.z = pack_bf16(s0[4], s0[5]); t.w = pack_bf16(s0[6], s0[7]);
      pf[0] = __builtin_bit_cast(bf16x8, t);
      t.x = pack_bf16(s0[8], s0[9]); t.y = pack_bf16(s0[10], s0[11]); t.z = pack_bf16(s0[12], s0[13]); t.w = pack_bf16(s0[14], s0[15]);
      pf[1] = __builtin_bit_cast(bf16x8, t);
      t.x = pack_bf16(s1[0], s1[1]); t.y = pack_bf16(s1[2], s1[3]); t.z = pack_bf16(s1[4], s1[5]); t.w = pack_bf16(s1[6], s1[7]);
      pf[2] = __builtin_bit_cast(bf16x8, t);
      t.x = pack_bf16(s1[8], s1[9]); t.y = pack_bf16(s1[10], s1[11]); t.z = pack_bf16(s1[12], s1[13]); t.w = pack_bf16(s1[14], s1[15]);
      pf[3] = __builtin_bit_cast(bf16x8, t);
    }
    const char* vp = Vs + l31 * ATT_VROW + lh * 16;
#pragma unroll
    for (int g16 = 0; g16 < 4; ++g16) {
#pragma unroll
      for (int d = 0; d < 4; ++d) {
        bf16x8 a = *(const bf16x8*)(vp + d * 32 * ATT_VROW + g16 * 32);
        o[d] = MFMA16(a, pf[g16], o[d]);
      }
    }
    __syncthreads();
    if (more) ATT_SWRITE()
    __syncthreads();
  }
  const float inv = 1.f / l;
  float* tb = (float*)smem + wid * (32 * 129);
#pragma unroll
  for (int d = 0; d < 4; ++d)
#pragma unroll
    for (int r = 0; r < 16; ++r) tb[l31 * 129 + d * 32 + (r & 3) + 8 * (r >> 2) + 4 * lh] = o[d][r] * inv;
  __syncthreads();
  for (int i = lane; i < 32 * 32; i += 64) {
    const int q = i >> 5, c4 = i & 31;
    const float* s = tb + q * 129 + c4 * 4;
    *(float4*)(Op + (size_t)(wid * 32 + q) * 512 + c4 * 4) = make_float4(s[0], s[1], s[2], s[3]);
  }
  __syncthreads();
}

__device__ __forceinline__ int chunk_row0(int b, int cid) { return cid < 4 ? TLAT + b * CL + cid * 64 : b * SL + (cid - 4) * 64; }
__device__ __forceinline__ int step_of(int cid, int dir) { return dir == 0 ? cid : (cid < 4 ? 3 - cid : 71 - cid); }
__device__ __forceinline__ int cid_of(int s, int dir) { return dir == 0 ? s : (s < 4 ? 3 - s : 71 - s); }
#define MFMA32(a, b, c) __builtin_amdgcn_mfma_f32_32x32x2f32(a, b, c, 0, 0, 0)
#define ROW16(r, lh) (((r) & 3) + 8 * ((r) >> 2) + 4 * (lh))
__device__ __forceinline__ float wave_incl_scan(float v, int lane) {
#pragma unroll
  for (int o = 1; o < 64; o <<= 1) { float t = __shfl_up(v, o); if (lane >= o) v += t; }
  return v;
}

__device__ __forceinline__ void ssd_local_item(const P& p, int layer, int item, char* smem) {
  const int h = item & 7, cid = (item >> 3) % NSTEP, b = item / (8 * NSTEP);
  float* sx = (float*)smem;
  float* sB = sx + 4096;
  float* swf = sB + 64 * 129;
  float* swb = swf + 64;
  const int tid = threadIdx.x, lane = tid & 63, wid = tid >> 6, l31 = lane & 31, lh = lane >> 5;
  const int row0 = chunk_row0(b, cid), g = h >> 2;
  __syncthreads();
  for (int i = tid; i < 1024; i += 256) {
    int q = i >> 4, c4 = i & 15;
    *(float4*)(sx + q * 64 + c4 * 4) = *(const float4*)(p.ssd_xs() + (size_t)(row0 + q) * 512 + h * 64 + c4 * 4);
  }
  for (int i = tid; i < 2048; i += 256) {
    int q = i >> 5, c4 = i & 31;
    float4 v = *(const float4*)(p.ssd_B() + (size_t)(row0 + q) * 256 + g * 128 + c4 * 4);
    float* d = sB + q * 129 + c4 * 4;
    d[0] = v.x; d[1] = v.y; d[2] = v.z; d[3] = v.w;
  }
  if (wid < 2) {
    const int dir = wid;
    const float A = -expf(p.a_log[layer * 16 + dir * 8 + h]);
    const int q = dir ? 63 - lane : lane;
    const float dt = p.ssd_dt()[(size_t)(row0 + q) * 16 + dir * 8 + h];
    const float ac = wave_incl_scan(dt * A, lane);
    const float tot = __shfl(ac, 63);
    (dir ? swb : swf)[q] = expf(tot - ac) * dt;
    if (lane == 0) p.ssd_atot()[((b * 2 + dir) * 8 + h) * NSTEP + step_of(cid, dir)] = tot;
  }
  __syncthreads();
  f32x16 acc[2][2];
#pragma unroll
  for (int d = 0; d < 2; ++d)
#pragma unroll
    for (int t = 0; t < 2; ++t)
#pragma unroll
      for (int r = 0; r < 16; ++r) acc[d][t][r] = 0.f;
  const int pi = wid & 1, jj = wid >> 1;
#pragma unroll 4
  for (int k = 0; k < 64; k += 2) {
    const int q = k + lh;
    const float xa = sx[q * 64 + pi * 32 + l31];
    const float af = xa * swf[q], ab = xa * swb[q];
    const float b0 = sB[q * 129 + (2 * jj) * 32 + l31], b1 = sB[q * 129 + (2 * jj + 1) * 32 + l31];
    acc[0][0] = MFMA32(af, b0, acc[0][0]); acc[0][1] = MFMA32(af, b1, acc[0][1]);
    acc[1][0] = MFMA32(ab, b0, acc[1][0]); acc[1][1] = MFMA32(ab, b1, acc[1][1]);
  }
#pragma unroll
  for (int d = 0; d < 2; ++d) {
    float* dst = p.ssd_st() + ((size_t)((b * 2 + d) * 8 + h) * NSTEP + step_of(cid, d)) * 8192;
#pragma unroll
    for (int t = 0; t < 2; ++t)
#pragma unroll
      for (int r = 0; r < 16; ++r) dst[(pi * 32 + ROW16(r, lh)) * 128 + (2 * jj + t) * 32 + l31] = acc[d][t][r];
  }
}

__device__ __forceinline__ void ssd_out_item(const P& p, int layer, int item, char* smem) {
  const int h = item & 7, cid = (item >> 3) % NSTEP, b = item / (8 * NSTEP);
  float* sC = (float*)smem;
  float* sBh = sC + 64 * 129;
  float* sx = sBh + 64 * 129;
  float* sP = sx + 4096;
  float* saf = sP + 64 * 65;
  float* sab = saf + 64;
  float* sdf = sab + 64;
  float* sdb = sdf + 64;
  const int tid = threadIdx.x, lane = tid & 63, wid = tid >> 6, l31 = lane & 31, lh = lane >> 5;
  const int row0 = chunk_row0(b, cid), g = h >> 2;
  __syncthreads();
  for (int i = tid; i < 1024; i += 256) {
    int q = i >> 4, c4 = i & 15;
    *(float4*)(sx + q * 64 + c4 * 4) = *(const float4*)(p.ssd_xs() + (size_t)(row0 + q) * 512 + h * 64 + c4 * 4);
  }
  for (int i = tid; i < 2048; i += 256) {
    int q = i >> 5, c4 = i & 31;
    float4 v = *(const float4*)(p.ssd_B() + (size_t)(row0 + q) * 256 + g * 128 + c4 * 4);
    float* d = sBh + q * 129 + c4 * 4;
    d[0] = v.x; d[1] = v.y; d[2] = v.z; d[3] = v.w;
    float4 w = *(const float4*)(p.ssd_C() + (size_t)(row0 + q) * 256 + g * 128 + c4 * 4);
    float* e = sC + q * 129 + c4 * 4;
    e[0] = w.x; e[1] = w.y; e[2] = w.z; e[3] = w.w;
  }
  if (wid < 2) {
    const int dir = wid;
    const float A = -expf(p.a_log[layer * 16 + dir * 8 + h]);
    const int q = dir ? 63 - lane : lane;
    const float dt = p.ssd_dt()[(size_t)(row0 + q) * 16 + dir * 8 + h];
    const float ac = wave_incl_scan(dt * A, lane);
    (dir ? sab : saf)[q] = ac;
    (dir ? sdb : sdf)[q] = dt;
  }
  __syncthreads();
  const int it = wid >> 1, jt = wid & 1;
  {
    f32x16 sa;
#pragma unroll
    for (int r = 0; r < 16; ++r) sa[r] = 0.f;
    const float* ap = sC + (it * 32 + l31) * 129 + lh;
    const float* bp = sBh + (jt * 32 + l31) * 129 + lh;
#pragma unroll 8
    for (int k = 0; k < 128; k += 2) sa = MFMA32(ap[k], bp[k], sa);
    const int j = jt * 32 + l31;
    const float afj = saf[j], abj = sab[j], dfj = sdf[j], dbj = sdb[j];
#pragma unroll
    for (int r = 0; r < 16; ++r) {
      const int i = it * 32 + ROW16(r, lh);
      float wgt = 0.f;
      if (j <= i) wgt += expf(saf[i] - afj) * dfj;
      if (j >= i) wgt += expf(sab[i] - abj) * dbj;
      sP[i * 65 + j] = sa[r] * wgt;
    }
  }
  __syncthreads();
  const float* hf = p.ssd_st() + ((size_t)((b * 2 + 0) * 8 + h) * NSTEP + step_of(cid, 0)) * 8192;
  const float* hb = p.ssd_st() + ((size_t)((b * 2 + 1) * 8 + h) * NSTEP + step_of(cid, 1)) * 8192;
  for (int i = tid; i < 2048; i += 256) {
    int q = i >> 5, c4 = i & 31;
    float4 v = *(const float4*)(hf + q * 128 + c4 * 4);
    float* d = sBh + q * 129 + c4 * 4;
    d[0] = v.x; d[1] = v.y; d[2] = v.z; d[3] = v.w;
  }
  const int pt = wid & 1;
  f32x16 ya;
#pragma unroll
  for (int r = 0; r < 16; ++r) ya[r] = 0.f;
  {
    const float* ap = sP + (it * 32 + l31) * 65 + lh;
    const float* bp = sx + lh * 64 + pt * 32 + l31;
#pragma unroll 8
    for (int k = 0; k < 64; k += 2) ya = MFMA32(ap[k], bp[k * 64], ya);
  }
  __syncthreads();
  {
    const float ef = expf(saf[it * 32 + l31]);
    const float* ap = sC + (it * 32 + l31) * 129 + lh;
    const float* bp = sBh + (pt * 32 + l31) * 129 + lh;
#pragma unroll 8
    for (int k = 0; k < 128; k += 2) ya = MFMA32(ap[k] * ef, bp[k], ya);
  }
  __syncthreads();
  for (int i = tid; i < 2048; i += 256) {
    int q = i >> 5, c4 = i & 31;
    float4 v = *(const float4*)(hb + q * 128 + c4 * 4);
    float* d = sBh + q * 129 + c4 * 4;
    d[0] = v.x; d[1] = v.y; d[2] = v.z; d[3] = v.w;
  }
  __syncthreads();
  {
    const float eb = expf(sab[it * 32 + l31]);
    const float* ap = sC + (it * 32 + l31) * 129 + lh;
    const float* bp = sBh + (pt * 32 + l31) * 129 + lh;
#pragma unroll 8
    for (int k = 0; k < 128; k += 2) ya = MFMA32(ap[k] * eb, bp[k], ya);
  }
#pragma unroll
  for (int r = 0; r < 16; ++r)
    p.ssd_y()[(size_t)(row0 + it * 32 + ROW16(r, lh)) * 512 + h * 64 + pt * 32 + l31] = ya[r];
}

__device__ __forceinline__ void ml_gates(const P& p, int layer, int row0, int h, int dir, int lane, float& bcum, float& li, float& tot) {
  const int j = dir ? 63 - lane : lane;
  const float* z = p.Z() + (size_t)(row0 + j) * NIN + ZC_MG + dir * 8;
  li = z[h] + p.gate_b[layer * 16 + dir * 8 + h];
  const float gf = z[4 + h] + p.gate_b[layer * 16 + dir * 8 + 4 + h];
  const float lf = gf >= 0.f ? -log1pf(expf(-gf)) : gf - log1pf(expf(gf));
  bcum = wave_incl_scan(lf, lane);
  tot = __shfl(bcum, 63);
}
__device__ __forceinline__ void ml_local_item(const P& p, int layer, int item, char* smem) {
  const int h = item & 3, cid = (item >> 2) % NSTEP, b = item / (4 * NSTEP);
  float* sv = (float*)smem;
  float* sk = sv + 8192;
  float* swf = sk + 64 * 65;
  float* swb = swf + 64;
  const int tid = threadIdx.x, lane = tid & 63, wid = tid >> 6, l31 = lane & 31, lh = lane >> 5;
  const int row0 = chunk_row0(b, cid);
  __syncthreads();
  for (int i = tid; i < 2048; i += 256) {
    int j = i >> 5, c4 = i & 31;
    *(float4*)(sv + j * 128 + c4 * 4) = *(const float4*)(p.Z() + (size_t)(row0 + j) * NIN + ZC_MV + h * 128 + c4 * 4);
  }
  for (int i = tid; i < 1024; i += 256) {
    int j = i >> 4, c4 = i & 15;
    float4 v = *(const float4*)(p.Z() + (size_t)(row0 + j) * NIN + ZC_MK + h * 64 + c4 * 4);
    float* d = sk + j * 65 + c4 * 4;
    d[0] = v.x; d[1] = v.y; d[2] = v.z; d[3] = v.w;
  }
  if (wid < 2) {
    const int dir = wid;
    float bc, li, tot;
    ml_gates(p, layer, row0, h, dir, lane, bc, li, tot);
    const int j = dir ? 63 - lane : lane;
    (dir ? swb : swf)[j] = expf(tot - bc + li);
    if (lane == 0) p.ml_gtot()[((b * 2 + dir) * 4 + h) * NSTEP + step_of(cid, dir)] = tot;
  }
  __syncthreads();
  f32x16 acc[2][2];
#pragma unroll
  for (int d = 0; d < 2; ++d)
#pragma unroll
    for (int t = 0; t < 2; ++t)
#pragma unroll
      for (int r = 0; r < 16; ++r) acc[d][t][r] = 0.f;
  const int vt = wid;
#pragma unroll 4
  for (int k = 0; k < 64; k += 2) {
    const int j = k + lh;
    const float va = sv[j * 128 + vt * 32 + l31];
    const float af = va * swf[j], ab = va * swb[j];
    const float b0 = sk[j * 65 + l31], b1 = sk[j * 65 + 32 + l31];
    acc[0][0] = MFMA32(af, b0, acc[0][0]); acc[0][1] = MFMA32(af, b1, acc[0][1]);
    acc[1][0] = MFMA32(ab, b0, acc[1][0]); acc[1][1] = MFMA32(ab, b1, acc[1][1]);
  }
#pragma unroll
  for (int d = 0; d < 2; ++d) {
    float* dst = p.ml_st() + ((size_t)((b * 2 + d) * 4 + h) * NSTEP + step_of(cid, d)) * 8192;
#pragma unroll
    for (int t = 0; t < 2; ++t)
#pragma unroll
      for (int r = 0; r < 16; ++r) dst[(vt * 32 + ROW16(r, lh)) * 64 + t * 32 + l31] = acc[d][t][r];
  }
  if (tid < 128) {
    const int d = tid >> 6, kk = tid & 63;
    const float* w = d ? swb : swf;
    float sacc = 0.f;
    for (int j = 0; j < 64; ++j) sacc += w[j] * sk[j * 65 + kk];
    p.ml_nst()[((size_t)((b * 2 + d) * 4 + h) * NSTEP + step_of(cid, d)) * 64 + kk] = sacc;
  }
}

__device__ __forceinline__ void ml_out_item(const P& p, int layer, int item, char* smem) {
  const int h = item & 3, cid = (item >> 2) % NSTEP, b = item / (4 * NSTEP);
  float* sq = (float*)smem;
  float* sk = sq + 64 * 65;
  float* sv = sk + 64 * 65;
  float* sPf = sv + 128 * 65;
  float* sPb = sPf + 64 * 65;
  float* sbf = sPb + 64 * 65;
  float* sbb = sbf + 64;
  float* slf = sbb + 64;
  float* slb = slf + 64;
  float* sdenf = slb + 64;
  float* sdenb = sdenf + 64;
  float* snf = sdenb + 64;
  float* snb = snf + 64;
  const int tid = threadIdx.x, lane = tid & 63, wid = tid >> 6, l31 = lane & 31, lh = lane >> 5;
  const int row0 = chunk_row0(b, cid);
  const size_t slotf = ((size_t)((b * 2 + 0) * 4 + h) * NSTEP + step_of(cid, 0));
  const size_t slotb = ((size_t)((b * 2 + 1) * 4 + h) * NSTEP + step_of(cid, 1));
  __syncthreads();
  for (int i = tid; i < 2048; i += 256) {
    int j = i >> 5, c4 = i & 31;
    *(float4*)(sv + j * 128 + c4 * 4) = *(const float4*)(p.Z() + (size_t)(row0 + j) * NIN + ZC_MV + h * 128 + c4 * 4);
  }
  for (int i = tid; i < 1024; i += 256) {
    int j = i >> 4, c4 = i & 15;
    float4 v = *(const float4*)(p.Z() + (size_t)(row0 + j) * NIN + ZC_MK + h * 64 + c4 * 4);
    float* d = sk + j * 65 + c4 * 4;
    d[0] = v.x; d[1] = v.y; d[2] = v.z; d[3] = v.w;
    float4 w = *(const float4*)(p.Z() + (size_t)(row0 + j) * NIN + ZC_MQ + h * 64 + c4 * 4);
    float* e = sq + j * 65 + c4 * 4;
    e[0] = w.x * 0.125f; e[1] = w.y * 0.125f; e[2] = w.z * 0.125f; e[3] = w.w * 0.125f;
  }
  if (wid < 2) {
    const int dir = wid;
    float bc, li, tot;
    ml_gates(p, layer, row0, h, dir, lane, bc, li, tot);
    const int j = dir ? 63 - lane : lane;
    (dir ? sbb : sbf)[j] = bc;
    (dir ? slb : slf)[j] = li;
    (dir ? snb : snf)[lane] = p.ml_nst()[(dir ? slotb : slotf) * 64 + lane];
  }
  __syncthreads();
  const int it = wid >> 1, jt = wid & 1;
  {
    f32x16 sa;
#pragma unroll
    for (int r = 0; r < 16; ++r) sa[r] = 0.f;
    const float* ap = sq + (it * 32 + l31) * 65 + lh;
    const float* bp = sk + (jt * 32 + l31) * 65 + lh;
#pragma unroll 8
    for (int k = 0; k < 64; k += 2) sa = MFMA32(ap[k], bp[k], sa);
    const int j = jt * 32 + l31;
    const float bfj = sbf[j], bbj = sbb[j], lfj = slf[j], lbj = slb[j];
#pragma unroll
    for (int r = 0; r < 16; ++r) {
      const int i = it * 32 + ROW16(r, lh);
      sPf[i * 65 + j] = j <= i ? sa[r] * expf(sbf[i] - bfj + lfj) : 0.f;
      sPb[i * 65 + j] = j >= i ? sa[r] * expf(sbb[i] - bbj + lbj) : 0.f;
    }
  }
  __syncthreads();
  if (tid < 128) {
    const int d = tid >> 6, i = tid & 63;
    const float* Pm = d ? sPb : sPf;
    const float* ns = d ? snb : snf;
    float rs = 0.f, qn = 0.f;
    for (int j = 0; j < 64; ++j) { rs += Pm[i * 65 + j]; qn += sq[i * 65 + j] * ns[j]; }
    (d ? sdenb : sdenf)[i] = rs + expf((d ? sbb : sbf)[i]) * qn;
  }
  const int v0 = 2 * (wid & 1);
  f32x16 nf[2], nb[2];
#pragma unroll
  for (int t = 0; t < 2; ++t)
#pragma unroll
    for (int r = 0; r < 16; ++r) { nf[t][r] = 0.f; nb[t][r] = 0.f; }
  {
    const float* apf = sPf + (it * 32 + l31) * 65 + lh;
    const float* apb = sPb + (it * 32 + l31) * 65 + lh;
    const float* bp = sv + lh * 128 + v0 * 32 + l31;
#pragma unroll 4
    for (int k = 0; k < 64; k += 2) {
      const float af = apf[k], ab = apb[k], b0 = bp[k * 128], b1 = bp[k * 128 + 32];
      nf[0] = MFMA32(af, b0, nf[0]); nf[1] = MFMA32(af, b1, nf[1]);
      nb[0] = MFMA32(ab, b0, nb[0]); nb[1] = MFMA32(ab, b1, nb[1]);
    }
  }
  __syncthreads();
  {
    const float* cs = p.ml_st() + slotf * 8192;
    for (int i = tid; i < 2048; i += 256) {
      int v = i >> 4, c4 = i & 15;
      float4 x4 = *(const float4*)(cs + v * 64 + c4 * 4);
      float* d = sv + v * 65 + c4 * 4;
      d[0] = x4.x; d[1] = x4.y; d[2] = x4.z; d[3] = x4.w;
    }
  }
  __syncthreads();
  {
    const float e = expf(sbf[it * 32 + l31]);
    const float* ap = sq + (it * 32 + l31) * 65 + lh;
    const float* bp = sv + (v0 * 32 + l31) * 65 + lh;
#pragma unroll 4
    for (int k = 0; k < 64; k += 2) {
      const float a = ap[k] * e;
      nf[0] = MFMA32(a, bp[k], nf[0]); nf[1] = MFMA32(a, bp[32 * 65 + k], nf[1]);
    }
  }
  __syncthreads();
  {
    const float* cs = p.ml_st() + slotb * 8192;
    for (int i = tid; i < 2048; i += 256) {
      int v = i >> 4, c4 = i & 15;
      float4 x4 = *(const float4*)(cs + v * 64 + c4 * 4);
      float* d = sv + v * 65 + c4 * 4;
      d[0] = x4.x; d[1] = x4.y; d[2] = x4.z; d[3] = x4.w;
    }
  }
  __syncthreads();
  {
    const float e = expf(sbb[it * 32 + l31]);
    const float* ap = sq + (it * 32 + l31) * 65 + lh;
    const float* bp = sv + (v0 * 32 + l31) * 65 + lh;
#pragma unroll 4
    for (int k = 0; k < 64; k += 2) {
      const float a = ap[k] * e;
      nb[0] = MFMA32(a, bp[k], nb[0]); nb[1] = MFMA32(a, bp[32 * 65 + k], nb[1]);
    }
  }
#pragma unroll
  for (int r = 0; r < 16; ++r) {
    const int i = it * 32 + ROW16(r, lh);
    const float idf = 1.f / fmaxf(fabsf(sdenf[i]), 1.f), idb = 1.f / fmaxf(fabsf(sdenb[i]), 1.f);
#pragma unroll
    for (int t = 0; t < 2; ++t)
      p.ml_h()[(size_t)(row0 + i) * 512 + h * 128 + (v0 + t) * 32 + l31] = nf[t][r] * idf + nb[t][r] * idb;
  }
}

template <int MODE>
__device__ __forceinline__ void s5_wave_item(const P& p, int layer, int witem, char* smem) {
  const int tid = threadIdx.x, lane = tid & 63, wid = tid >> 6;
  float* su = (float*)smem + wid * 3136;
  float* sX = su + 1024;
  const int g = witem & 31, st = (witem >> 5) % NSTEP, dir = (witem / (32 * NSTEP)) & 1, b = witem / (64 * NSTEP);
  const int cid = cid_of(st, dir), row0 = chunk_row0(b, cid);
  const int dg = (layer * 2 + dir) * 32 + g;
  const float ar = p.s5_a()[(dg * 64 + lane) * 2], ai = p.s5_a()[(dg * 64 + lane) * 2 + 1];
  float bbr[16], bbi[16];
  {
    const float4* bt = (const float4*)(p.s5_bb() + (size_t)(dg * 64 + lane) * 32);
#pragma unroll
    for (int c4 = 0; c4 < 4; ++c4) {
      float4 v = bt[c4]; bbr[c4 * 4] = v.x; bbr[c4 * 4 + 1] = v.y; bbr[c4 * 4 + 2] = v.z; bbr[c4 * 4 + 3] = v.w;
      float4 w = bt[4 + c4]; bbi[c4 * 4] = w.x; bbi[c4 * 4 + 1] = w.y; bbi[c4 * 4 + 2] = w.z; bbi[c4 * 4 + 3] = w.w;
    }
  }
#pragma unroll
  for (int q = 0; q < 4; ++q) {
    const int t = q * 16 + (lane >> 2), c4 = lane & 3;
    const int row = dir ? row0 + 63 - t : row0 + t;
    *(float4*)(su + t * 16 + c4 * 4) = *(const float4*)(p.Z() + (size_t)row * NIN + ZC_U + g * 16 + c4 * 4);
  }
  const size_t slot = ((size_t)((b * 2 + dir) * 32 + g) * NSTEP + st);
  float xr = 0.f, xi = 0.f;
  float cm[32];
  if (MODE == 1) {
    xr = p.s5_st()[(slot * 64 + lane) * 2]; xi = p.s5_st()[(slot * 64 + lane) * 2 + 1];
    const int c = lane & 15, kq = lane >> 4;
#pragma unroll
    for (int ks = 0; ks < 32; ++ks) {
      const int pp = 4 * ks + kq;
      cm[ks] = ks < 16 ? p.c_re[((size_t)(layer * 32 + g) * 16 + c) * 64 + pp] : -p.c_im[((size_t)(layer * 32 + g) * 16 + c) * 64 + pp - 64];
    }
  }
  float* rout = dir ? p.s5_rb() : p.s5_rf();
#pragma unroll 1
  for (int sb = 0; sb < 4; ++sb) {
#pragma unroll 4
    for (int tt = 0; tt < 16; ++tt) {
      const int t = sb * 16 + tt;
      float ur = 0.f, ui = 0.f;
#pragma unroll
      for (int c4 = 0; c4 < 4; ++c4) {
        float4 uu = *(const float4*)(su + t * 16 + c4 * 4);
        ur += bbr[c4 * 4] * uu.x + bbr[c4 * 4 + 1] * uu.y + bbr[c4 * 4 + 2] * uu.z + bbr[c4 * 4 + 3] * uu.w;
        ui += bbi[c4 * 4] * uu.x + bbi[c4 * 4 + 1] * uu.y + bbi[c4 * 4 + 2] * uu.z + bbi[c4 * 4 + 3] * uu.w;
      }
      const float nr = ar * xr - ai * xi + ur;
      const float ni = ar * xi + ai * xr + ui;
      xr = nr; xi = ni;
      if (MODE == 1) { sX[tt * 130 + lane] = xr; sX[tt * 130 + 64 + lane] = xi; }
    }
    if (MODE == 1) {
      f32x4v d0 = {0.f, 0.f, 0.f, 0.f}, d1 = {0.f, 0.f, 0.f, 0.f};
      const float* ap = sX + (lane & 15) * 130 + (lane >> 4);
#pragma unroll
      for (int ks = 0; ks < 32; ks += 2) {
        d0 = __builtin_amdgcn_mfma_f32_16x16x4f32(ap[4 * ks], cm[ks], d0, 0, 0, 0);
        d1 = __builtin_amdgcn_mfma_f32_16x16x4f32(ap[4 * ks + 4], cm[ks + 1], d1, 0, 0, 0);
      }
#pragma unroll
      for (int r = 0; r < 4; ++r) {
        const int t = sb * 16 + (lane >> 4) * 4 + r;
        const int row = dir ? row0 + 63 - t : row0 + t;
        rout[(size_t)row * 512 + g * 16 + (lane & 15)] = d0[r] + d1[r];
      }
    }
  }
  if (MODE == 0) { p.s5_st()[(slot * 64 + lane) * 2] = xr; p.s5_st()[(slot * 64 + lane) * 2 + 1] = xi; }
}

#define N_SSD_CH (2 * NSTEP * 8)
#define N_ML_CH (2 * NSTEP * 4)
#define N_S5_BLK (2 * 2 * NSTEP * 32 / 4)
__device__ __forceinline__ void ph_mixA(const P& p, int layer, int bid, char* smem) {
  for (int w = bid; w < N_SSD_CH + N_ML_CH + N_S5_BLK; w += gridDim.x) {
    if (w < N_SSD_CH) ssd_local_item(p, layer, w, smem);
    else if (w < N_SSD_CH + N_ML_CH) ml_local_item(p, layer, w - N_SSD_CH, smem);
    else { __syncthreads(); s5_wave_item<0>(p, layer, (w - N_SSD_CH - N_ML_CH) * 4 + (threadIdx.x >> 6), smem); }
  }
}
#define N_ATT_LAT 256
#define N_ATT_CTX 16
__device__ __forceinline__ void ph_mixB(const P& p, int layer, int bid, char* smem) {
  const int natt = N_ATT_LAT + (layer == 0 ? N_ATT_CTX : 0);
  const int nitems = natt + 256 + 128 + 4 + 32;
  const int tid = threadIdx.x;
  for (int w = bid; w < nitems; w += gridDim.x) {
    int it = w;
    if (it < natt) {
      const bfraw *qp, *kp, *vp; float* op; int nk;
      if (it < N_ATT_LAT) {
        int qb = it & 31, hh = (it >> 5) & 3, b = it >> 7;
        qp = p.Q() + ((size_t)(b * 4 + hh) * SL + qb * 128) * 192; kp = p.K() + (size_t)(b * 4 + hh) * NKEY * 192;
        vp = p.V() + (size_t)(b * 4 + hh) * 128 * NKEY; nk = NKEY; op = p.O() + (size_t)(b * SL + qb * 128) * 512 + hh * 128;
      } else {
        it -= N_ATT_LAT;
        int qb = it & 1, hh = (it >> 1) & 3, b = it >> 3;
        qp = p.Qc() + ((size_t)(b * 4 + hh) * CL + qb * 128) * 192; kp = p.K() + ((size_t)(b * 4 + hh) * NKEY + SL) * 192;
        vp = p.V() + (size_t)(b * 4 + hh) * 128 * NKEY + SL; nk = CL; op = p.O() + (size_t)(TLAT + b * CL + qb * 128) * 512 + hh * 128;
      }
      attn_item(qp, kp, vp, nk, op, smem);
      continue;
    }
    it -= natt;
    if (it < 256) {
      const int idx = it * 256 + tid, seq = idx >> 11, off = idx & 2047;
      float4* base = (float4*)(p.ssd_st() + (size_t)seq * NSTEP * 8192) + off;
      const float* at = p.ssd_atot() + seq * NSTEP;
      float4 hh = make_float4(0.f, 0.f, 0.f, 0.f);
#pragma unroll 4
      for (int s2 = 0; s2 < NSTEP; ++s2) {
        float4 t = base[(size_t)s2 * 2048];
        base[(size_t)s2 * 2048] = hh;
        const float e = expf(at[s2]);
        hh.x = e * hh.x + t.x; hh.y = e * hh.y + t.y; hh.z = e * hh.z + t.z; hh.w = e * hh.w + t.w;
      }
      continue;
    }
    it -= 256;
    if (it < 128) {
      const int idx = it * 256 + tid, seq = idx >> 11, off = idx & 2047;
      float4* base = (float4*)(p.ml_st() + (size_t)seq * NSTEP * 8192) + off;
      const float* at = p.ml_gtot() + seq * NSTEP;
      float4 hh = make_float4(0.f, 0.f, 0.f, 0.f);
#pragma unroll 4
      for (int s2 = 0; s2 < NSTEP; ++s2) {
        float4 t = base[(size_t)s2 * 2048];
        base[(size_t)s2 * 2048] = hh;
        const float e = expf(at[s2]);
        hh.x = e * hh.x + t.x; hh.y = e * hh.y + t.y; hh.z = e * hh.z + t.z; hh.w = e * hh.w + t.w;
      }
      continue;
    }
    it -= 128;
    if (it < 4) {
      const int idx = it * 256 + tid, seq = idx >> 6, off = idx & 63;
      float* base = p.ml_nst() + (size_t)seq * NSTEP * 64 + off;
      const float* at = p.ml_gtot() + seq * NSTEP;
      float hh = 0.f;
      for (int s2 = 0; s2 < NSTEP; ++s2) {
        float t = base[s2 * 64]; base[s2 * 64] = hh;
        hh = expf(at[s2]) * hh + t;
      }
      continue;
    }
    it -= 4;
    {
      const int idx = it * 256 + tid, seq = idx >> 6, sp = idx & 63;
      const int g = seq & 31, dir = (seq >> 5) & 1;
      const int dg = (layer * 2 + dir) * 32 + g;
      float pr = p.s5_a()[(dg * 64 + sp) * 2], pi = p.s5_a()[(dg * 64 + sp) * 2 + 1];
#pragma unroll
      for (int q = 0; q < 6; ++q) { float nr = pr * pr - pi * pi, ni = 2.f * pr * pi; pr = nr; pi = ni; }
      float* base = p.s5_st() + ((size_t)seq * NSTEP * 64 + sp) * 2;
      float xr = 0.f, xi = 0.f;
      for (int s2 = 0; s2 < NSTEP; ++s2) {
        float tr = base[s2 * 128], ti = base[s2 * 128 + 1];
        base[s2 * 128] = xr; base[s2 * 128 + 1] = xi;
        float nr = pr * xr - pi * xi + tr, ni = pr * xi + pi * xr + ti;
        xr = nr; xi = ni;
      }
    }
  }
}
__device__ __forceinline__ void ph_attn_only(const P& p, int layer, int bid, char* smem) {
  const int natt = N_ATT_LAT + (layer == 0 ? N_ATT_CTX : 0);
  for (int w = bid; w < natt; w += gridDim.x) {
    int it = w;
    const bfraw *qp, *kp, *vp; float* op; int nk;
    if (it < N_ATT_LAT) {
      int qb = it & 31, hh = (it >> 5) & 3, b = it >> 7;
      qp = p.Q() + ((size_t)(b * 4 + hh) * SL + qb * 128) * 192; kp = p.K() + (size_t)(b * 4 + hh) * NKEY * 192;
      vp = p.V() + (size_t)(b * 4 + hh) * 128 * NKEY; nk = NKEY; op = p.O() + (size_t)(b * SL + qb * 128) * 512 + hh * 128;
    } else {
      it -= N_ATT_LAT;
      int qb = it & 1, hh = (it >> 1) & 3, b = it >> 3;
      qp = p.Qc() + ((size_t)(b * 4 + hh) * CL + qb * 128) * 192; kp = p.K() + ((size_t)(b * 4 + hh) * NKEY + SL) * 192;
      vp = p.V() + (size_t)(b * 4 + hh) * 128 * NKEY + SL; nk = CL; op = p.O() + (size_t)(TLAT + b * CL + qb * 128) * 512 + hh * 128;
    }
    attn_item(qp, kp, vp, nk, op, smem);
  }
}
__device__ __forceinline__ void ph_mixC(const P& p, int layer, int bid, char* smem) {
  for (int w = bid; w < N_SSD_CH + N_ML_CH + N_S5_BLK; w += gridDim.x) {
    if (w < N_SSD_CH) ssd_out_item(p, layer, w, smem);
    else if (w < N_SSD_CH + N_ML_CH) ml_out_item(p, layer, w - N_SSD_CH, smem);
    else { __syncthreads(); s5_wave_item<1>(p, layer, (w - N_SSD_CH - N_ML_CH) * 4 + (threadIdx.x >> 6), smem); }
  }
}

__device__ __forceinline__ float gelu_tanh(float x) {
  const float k0 = 0.7978845608028654f;
  return 0.5f * x * (1.f + tanhf(k0 * (x + 0.044715f * x * x * x)));
}
__device__ __forceinline__ void ph_s5pre(const P& p, int layer, int bid, char* smem) {
  const size_t n = (size_t)TTOT * 512;
  for (size_t i = (size_t)bid * 256 + threadIdx.x; i < n; i += (size_t)gridDim.x * 256) {
    int r = (int)(i >> 9), c = (int)(i & 511);
    float u = p.Z()[(size_t)r * NIN + ZC_U + c];
    float y = p.s5_rf()[i] + p.s5_rb()[i] + p.s5_d[layer * 512 + c] * u;
    float gy = gelu_tanh(y);
    p.ydpre()[i] = gy; p.ydpre_bf()[i] = to_bf16(gy);
  }
}
__device__ __forceinline__ void ph_glu(const P& p, int layer, int bid, char* smem) {
  const float* yp = p.ydpre(); float* yg = p.ydg(); const float* gb = p.glu_b + layer * 512;
  auto epi = [=](int row, int col, float v) {
    float y = yp[(size_t)row * 512 + col];
    yg[(size_t)row * 512 + col] = y * sigmoidf_(v + gb[col]);
  };
  gemm_dense<4>(p.ydpre_bf(), 512, p.glu_w + (size_t)layer * 512 * 512, 512, TTOT, 512, 512, epi, bid, smem);
}

__device__ __forceinline__ void ph_final_mix(const P& p, int layer, int bid, char* smem) {
  float* red = (float*)smem;
  const int tid = threadIdx.x;
  const float* onw = p.out_norm_w + layer * 2048;
  for (int r = bid; r < TTOT; r += gridDim.x) {
    const int c = tid * 2;
    const float* z = p.Z() + (size_t)r * NIN;
    float2 oa = *(const float2*)(p.O() + (size_t)r * 512 + c);
    float sa = block_sum(oa.x * oa.x + oa.y * oa.y, red);
    float ra = rsqrtf(sa * (1.f / 512.f) + EPSV);
    float2 yf = *(const float2*)(p.ssd_y() + (size_t)r * 512 + c);
    float2 xs = *(const float2*)(p.ssd_xs() + (size_t)r * 512 + c);
    float2 zz = *(const float2*)(z + ZC_BZ + c);
    float dsk = p.ssd_d[layer * 8 + (c >> 6)];
    float b0 = (yf.x + dsk * xs.x) * siluf_(zz.x);
    float b1 = (yf.y + dsk * xs.y) * siluf_(zz.y);
    float sb = block_sum(b0 * b0 + b1 * b1, red);
    float rb = rsqrtf(sb * (1.f / 512.f) + EPSV);
    float2 hf = *(const float2*)(p.ml_h() + (size_t)r * 512 + c);
    float c0 = hf.x, c1 = hf.y;
    float scs = wave_sum(c0 * c0 + c1 * c1);
    float rc = rsqrtf(scs * (1.f / 128.f) + EPSV);
    float2 og = *(const float2*)(z + ZC_MO + c);
    c0 = c0 * rc * sigmoidf_(og.x); c1 = c1 * rc * sigmoidf_(og.y);
    float2 yd = *(const float2*)(p.ydg() + (size_t)r * 512 + c);
    float sd = block_sum(yd.x * yd.x + yd.y * yd.y, red);
    float rd = rsqrtf(sd * (1.f / 512.f) + EPSV);
    bfraw* Y = p.Y() + (size_t)r * 2048;
    *(unsigned*)(Y + c) = pack_bf16(oa.x * ra * onw[c], oa.y * ra * onw[c + 1]);
    *(unsigned*)(Y + 512 + c) = pack_bf16(b0 * rb * onw[512 + c], b1 * rb * onw[512 + c + 1]);
    *(unsigned*)(Y + 1024 + c) = pack_bf16(c0 * onw[1024 + c], c1 * onw[1024 + c + 1]);
    *(unsigned*)(Y + 1536 + c) = pack_bf16(yd.x * rd * onw[1536 + c], yd.y * rd * onw[1536 + c + 1]);
  }
}

__device__ __forceinline__ void ph_wout(const P& p, int layer, int bid, char* smem) {
  const P pp = p;
  const int M = layer == 0 ? TTOT : TLAT;
  auto epi = [=](int row, int col, float v) {
    const int mi = row_modidx(row);
    const float g1 = pp.modv()[(layer * 3 + mi) * 12288 + 2 * 2048 + col];
    float xin;
    if (layer == 0) xin = row < TLAT ? pp.x[(size_t)row * 2048 + col] : pp.ctx[(size_t)(row - TLAT) * 2048 + col];
    else xin = pp.X()[(size_t)row * 2048 + col];
    pp.X()[(size_t)row * 2048 + col] = xin + g1 * v;
  };
  gemm_dense<4>(p.Y(), 2048, p.w_out + (size_t)layer * 2048 * 2048, 2048, M, 2048, 2048, epi, bid, smem);
}

__device__ __forceinline__ void ph_router(const P& p, int layer, int bid, char* smem) {
  float* sA = (float*)smem;
  float* sW = sA + 32 * 129;
  float* sNW = sW + 128 * 64;
  float* sSH = sNW + 2048;
  float* srs = sSH + 2048;
  float* sL = srs + 32;
  const int tid = threadIdx.x, lane = tid & 63, wid = tid >> 6, l31 = lane & 31, lh = lane >> 5;
  const int T = layer == 0 ? TTOT : TLAT;
  const float* nw = p.norm2_w + layer * 2048;
  const float* wg = p.w_group + (size_t)layer * 2048 * 4;
  const float* we = p.w_expert + (size_t)layer * 2048 * 32;
  __syncthreads();
  for (int i = tid; i < 128 * 28; i += 256) sW[(i / 28) * 64 + 36 + (i % 28)] = 0.f;
  const int ar = tid >> 3, aks = (tid & 7) * 16;
  const int wk = tid >> 1, whalf = tid & 1;
  for (int item = bid; item < (T >> 5); item += gridDim.x) {
    const int row0 = item * 32;
    const int mi = row_modidx(row0);
    const float* mrow = p.modv() + (layer * 3 + mi) * 12288;
    __syncthreads();
    for (int i = tid; i < 2048; i += 256) { sNW[i] = nw[i] * (1.f + mrow[4 * 2048 + i]); sSH[i] = mrow[3 * 2048 + i]; }
#pragma unroll 2
    for (int rr = 0; rr < 8; ++rr) {
      const float* xr = p.X() + (size_t)(row0 + wid * 8 + rr) * 2048 + lane * 4;
      float ss = 0.f;
#pragma unroll
      for (int i = 0; i < 8; ++i) { float4 v = *(const float4*)(xr + i * 256); ss += v.x * v.x + v.y * v.y + v.z * v.z + v.w * v.w; }
      ss = wave_sum(ss);
      if (lane == 0) srs[wid * 8 + rr] = rsqrtf(ss * (1.f / 2048.f) + EPSV);
    }
    __syncthreads();
    const float rs = srs[ar];
    const float* xrow = p.X() + (size_t)(row0 + ar) * 2048 + aks;
    bfraw* hrow = p.H() + (size_t)(row0 + ar) * 2048 + aks;
    float4 xa0, xa1, xa2, xa3, wv0, wv1, wv2, wv3, wv4;
#define RT_GLOAD(k0)                                                                                   \
    {                                                                                                  \
      xa0 = *(const float4*)(xrow + (k0)); xa1 = *(const float4*)(xrow + (k0) + 4);                    \
      xa2 = *(const float4*)(xrow + (k0) + 8); xa3 = *(const float4*)(xrow + (k0) + 12);               \
      const float* er = we + (size_t)((k0) + wk) * 32 + (whalf ? 12 : 0);                              \
      wv0 = *(const float4*)(er); wv1 = *(const float4*)(er + 4); wv2 = *(const float4*)(er + 8);      \
      wv3 = *(const float4*)(er + 12); wv4 = *(const float4*)(er + 16);                                \
      if (!whalf) wv3 = *(const float4*)(wg + (size_t)((k0) + wk) * 4);                                \
    }
#define RT_A4(q, v)                                                                                    \
    {                                                                                                  \
      const int kq = (k0w) + aks + (q) * 4;                                                            \
      float h0 = v.x * rs * sNW[kq] + sSH[kq], h1 = v.y * rs * sNW[kq + 1] + sSH[kq + 1];              \
      float h2 = v.z * rs * sNW[kq + 2] + sSH[kq + 2], h3 = v.w * rs * sNW[kq + 3] + sSH[kq + 3];      \
      float* d = sA + ar * 129 + aks + (q) * 4; d[0] = h0; d[1] = h1; d[2] = h2; d[3] = h3;            \
      uint2 hb; hb.x = pack_bf16(h0, h1); hb.y = pack_bf16(h2, h3);                                    \
      *(uint2*)(hrow + (k0w) + (q) * 4) = hb;                                                          \
    }
#define RT_SWRITE()                                                                                    \
    {                                                                                                  \
      RT_A4(0, xa0) RT_A4(1, xa1) RT_A4(2, xa2) RT_A4(3, xa3)                                          \
      float* w = sW + wk * 64;                                                                         \
      if (!whalf) {                                                                                    \
        w[0] = wv3.x; w[1] = wv3.y; w[2] = wv3.z; w[3] = wv3.w;                                        \
        w[4] = wv0.x; w[5] = wv0.y; w[6] = wv0.z; w[7] = wv0.w; w[8] = wv1.x; w[9] = wv1.y; w[10] = wv1.z; w[11] = wv1.w; \
        w[12] = wv2.x; w[13] = wv2.y; w[14] = wv2.z; w[15] = wv2.w;                                    \
      } else {                                                                                         \
        w[16] = wv0.x; w[17] = wv0.y; w[18] = wv0.z; w[19] = wv0.w; w[20] = wv1.x; w[21] = wv1.y; w[22] = wv1.z; w[23] = wv1.w; \
        w[24] = wv2.x; w[25] = wv2.y; w[26] = wv2.z; w[27] = wv2.w; w[28] = wv3.x; w[29] = wv3.y; w[30] = wv3.z; w[31] = wv3.w; \
        w[32] = wv4.x; w[33] = wv4.y; w[34] = wv4.z; w[35] = wv4.w;                                    \
      }                                                                                                \
    }
    int k0w = 0;
    RT_GLOAD(0)
    RT_SWRITE()
    __syncthreads();
    f32x16 acc;
#pragma unroll
    for (int r = 0; r < 16; ++r) acc[r] = 0.f;
    const int ct = wid & 1, kh = wid >> 1;
    const float* ap = sA + l31 * 129 + kh * 64 + lh;
    const float* bp = sW + (kh * 64 + lh) * 64 + ct * 32 + l31;
    for (int k0 = 0; k0 < 2048; k0 += 128) {
      const bool more = (k0 + 128) < 2048;
      if (more) RT_GLOAD(k0 + 128)
#pragma unroll 8
      for (int kk = 0; kk < 32; ++kk) acc = MFMA32(ap[2 * kk], bp[2 * kk * 64], acc);
      __syncthreads();
      k0w = k0 + 128;
      if (more) RT_SWRITE()
      __syncthreads();
    }
#pragma unroll
    for (int r = 0; r < 16; ++r) sL[(kh * 32 + ROW16(r, lh)) * 64 + ct * 32 + l31] = acc[r];
    __syncthreads();
    if (tid < 32) {
      const int r = row0 + tid;
      const float* l0 = sL + tid * 64;
      const float* l1 = sL + (32 + tid) * 64;
      int gi = 0; float gm = l0[0] + l1[0];
      float gl[4]; gl[0] = gm;
#pragma unroll
      for (int j = 1; j < 4; ++j) { gl[j] = l0[j] + l1[j]; if (gl[j] > gm) { gm = gl[j]; gi = j; } }
      float gs = 0.f;
#pragma unroll
      for (int j = 0; j < 4; ++j) gs += expf(gl[j] - gm);
      const float gw = 1.f / gs;
      int i1 = 0, i2 = -1; float v1 = -INFINITY, v2 = -INFINITY;
      for (int j = 0; j < 8; ++j) {
        const float e = l0[4 + gi * 8 + j] + l1[4 + gi * 8 + j];
        if (e > v1) { v2 = v1; i2 = i1; v1 = e; i1 = j; }
        else if (e > v2) { v2 = e; i2 = j; }
      }
      const float e2 = expf(v2 - v1);
      const float w1 = gw / (1.f + e2), w2 = gw * e2 / (1.f + e2);
      const int ex1 = gi * 8 + i1, ex2 = gi * 8 + i2;
      int* cnt = p.cnt() + layer * 32;
      const int p1 = atomicAdd(&cnt[ex1], 1);
      p.list_tok()[ex1 * CAPE + p1] = r * 2; p.list_w()[ex1 * CAPE + p1] = w1;
      const int p2 = atomicAdd(&cnt[ex2], 1);
      p.list_tok()[ex2 * CAPE + p2] = r * 2 + 1; p.list_w()[ex2 * CAPE + p2] = w2;
    }
  }
}

struct AGather { const bfraw* H; const int* toks; int nvalid;
  __device__ __forceinline__ const bfraw* row(int r) const { return r < nvalid ? H + (size_t)(toks[r] >> 1) * 2048 : nullptr; }
  __device__ __forceinline__ const bfraw* safe() const { return H; } };
struct BGateUp { const float *g, *u; int ldb; int nb;
  __device__ __forceinline__ const float* col(int v) const { int wc = v >> 6, j = (v >> 5) & 1, c = v & 31;
    const float* b = (const float*)((uintptr_t)g + (uintptr_t)j * ((uintptr_t)u - (uintptr_t)g)); return b + nb + wc * 32 + c; }
  __device__ __forceinline__ const float* safe() const { return g; } };

__device__ __forceinline__ void moe_prefix(const P& p, int layer, int* spre) {
  __syncthreads();
  if (threadIdx.x == 0) {
    int acc = 0;
    for (int e = 0; e < 32; ++e) { spre[e] = acc; acc += (p.cnt()[layer * 32 + e] + 127) >> 7; }
    spre[32] = acc;
  }
  __syncthreads();
}
__device__ __forceinline__ void ph_moe_up(const P& p, int layer, int bid, char* smem) {
  int* spre = (int*)(smem + 98304);
  moe_prefix(p, layer, spre);
  const int ntile = spre[32];
  for (int w = bid; w < ntile * 8; w += gridDim.x) {
    const int rbg = w >> 3, nt = w & 7;
    int e = 0;
    while (e < 31 && spre[e + 1] <= rbg) ++e;
    const int rb = rbg - spre[e];
    const int cnt = p.cnt()[layer * 32 + e];
    AGather af{p.H(), p.list_tok() + e * CAPE + rb * 128, cnt - rb * 128};
    const size_t wo = ((size_t)layer * 32 + e) * 2048 * 512;
    BGateUp bf{p.w_gate + wo, p.w_up + wo, 512, nt * 64};
    bfraw* act = p.ACT() + (size_t)rbg * 128 * 512 + nt * 64;
    auto ef = [&](const f32x16 (&acc)[2][2], int wr, int wc, int lane) {
#pragma unroll
      for (int i = 0; i < 2; ++i)
#pragma unroll
        for (int r = 0; r < 16; ++r) {
          int row = ACC_ROW(wr, i, r, lane);
          float gv = acc[i][0][r], uv = acc[i][1][r];
          act[(size_t)row * 512 + wc * 32 + (lane & 31)] = to_bf16(siluf_(gv) * uv);
        }
    };
    gemm_tile<2>(af, bf, ef, 2048, smem);
  }
}
__device__ __forceinline__ void ph_moe_down(const P& p, int layer, int bid, char* smem) {
  int* spre = (int*)(smem + 98304);
  moe_prefix(p, layer, spre);
  const int ntile = spre[32];
  for (int w = bid; w < ntile * 16; w += gridDim.x) {
    const int rbg = w >> 4, nt = w & 15;
    int e = 0;
    while (e < 31 && spre[e + 1] <= rbg) ++e;
    const int rb = rbg - spre[e];
    const int nvalid = p.cnt()[layer * 32 + e] - rb * 128;
    ARows af{p.ACT() + (size_t)rbg * 128 * 512, 512, 0, 128};
    BPlain bf{p.w_down + ((size_t)layer * 32 + e) * 512 * 2048, 2048, nt * 128, 2048};
    const int* toks = p.list_tok() + e * CAPE + rb * 128;
    const float* lw = p.list_w() + e * CAPE + rb * 128;
    float* Ys = p.Yslot();
    auto ef = [&](const f32x16 (&acc)[2][2], int wr, int wc, int lane) {
#pragma unroll
      for (int i = 0; i < 2; ++i)
#pragma unroll
        for (int r = 0; r < 16; ++r) {
          int row = ACC_ROW(wr, i, r, lane);
          if (row < nvalid) {
            int ts = toks[row]; float wgt = lw[row];
#pragma unroll
            for (int j = 0; j < 2; ++j) Ys[(size_t)ts * 2048 + nt * 128 + ACC_COL(wc, j, lane)] = wgt * acc[i][j][r];
          }
        }
    };
    gemm_tile<2>(af, bf, ef, 512, smem);
  }
}

__device__ __forceinline__ void ph_out(const P& p, int bid, char* smem) {
  float* red = (float*)smem;
  const int tid = threadIdx.x;
  for (int r = bid; r < TLAT; r += gridDim.x) {
    const int mi = r >> 12;
    const float* g2 = p.modv() + (1 * 3 + mi) * 12288 + 5 * 2048;
    float v[8]; float ss = 0.f;
#pragma unroll
    for (int hf = 0; hf < 2; ++hf) {
      int col = hf * 1024 + tid * 4;
      float4 xv = *(const float4*)(p.X() + (size_t)r * 2048 + col);
      float4 gv = *(const float4*)(g2 + col);
      float4 y0 = *(const float4*)(p.Yslot() + (size_t)(2 * r) * 2048 + col);
      float4 y1 = *(const float4*)(p.Yslot() + (size_t)(2 * r + 1) * 2048 + col);
      xv.x += gv.x * (y0.x + y1.x); xv.y += gv.y * (y0.y + y1.y);
      xv.z += gv.z * (y0.z + y1.z); xv.w += gv.w * (y0.w + y1.w);
      v[hf * 4 + 0] = xv.x; v[hf * 4 + 1] = xv.y; v[hf * 4 + 2] = xv.z; v[hf * 4 + 3] = xv.w;
      ss += xv.x * xv.x + xv.y * xv.y + xv.z * xv.z + xv.w * xv.w;
    }
    float tot = block_sum(ss, red);
    float rs = rsqrtf(tot * (1.f / 2048.f) + EPSV);
#pragma unroll
    for (int hf = 0; hf < 2; ++hf) {
      int col = hf * 1024 + tid * 4;
      float4 w4 = *(const float4*)(p.final_w + col);
      float4 o;
      o.x = v[hf * 4 + 0] * rs * w4.x; o.y = v[hf * 4 + 1] * rs * w4.y;
      o.z = v[hf * 4 + 2] * rs * w4.z; o.w = v[hf * 4 + 3] * rs * w4.w;
      *(float4*)(p.out + (size_t)r * 2048 + col) = o;
    }
  }
}

#define SMEM_BYTES 102400
#define XB_TMO      128
#define XB_XCNT(j)  (256  + 64 * (j))
#define XB_XSUB(j)  (1280 + 64 * (j))
#define XB_XGEN(j)  (2304 + 64 * (j))
#define XB_TOP      3328
#define XB_TOPGEN   3392
#define XB_SPIN_CAP (1u << 22)
#define LAS __attribute__((address_space(3)))
__device__ __forceinline__ unsigned xb_ld(unsigned* p)              { return __hip_atomic_load(p, __ATOMIC_RELAXED, __HIP_MEMORY_SCOPE_AGENT); }
__device__ __forceinline__ unsigned xb_add(unsigned* p, unsigned v) { return __hip_atomic_fetch_add(p, v, __ATOMIC_RELAXED, __HIP_MEMORY_SCOPE_AGENT); }
__device__ __forceinline__ unsigned xb_xcc_id() { return (unsigned)__builtin_amdgcn_s_getreg((3 << 11) | 20) & 0xFu; }
#define XB_SPIN(cond, bar) do { unsigned _sp = 0; while (cond) { __builtin_amdgcn_s_sleep(1); \
    if ((++_sp & 255u) == 0u) { if (xb_ld(&(bar)[XB_TMO])) break; if (_sp > XB_SPIN_CAP) { atomicAdd(&(bar)[XB_TMO], 1u); break; } } } } while (0)
struct XcdBarrier { unsigned* bar; unsigned x; unsigned rank; volatile LAS unsigned* st; };
__device__ __forceinline__ XcdBarrier xcd_barrier_post(unsigned* bar, volatile LAS unsigned* st) {
    XcdBarrier b; b.bar = bar; b.x = xb_xcc_id(); b.st = st;
    b.rank = 0u;
    if (threadIdx.x == 0) b.rank = xb_add(&bar[XB_XCNT(b.x)], 1u);
    return b;
}
__device__ __forceinline__ void xcd_barrier_complete(unsigned* bar, unsigned x, unsigned& nloc, unsigned& nx) {
    const unsigned G = gridDim.x * gridDim.y * gridDim.z;
    unsigned sum, cnt, mine, sp = 0u;
    for (;;) {
        sum = 0u; cnt = 0u; mine = 0u;
#pragma unroll
        for (unsigned j = 0; j < 16; ++j) { const unsigned c = xb_ld(&bar[XB_XCNT(j)]); sum += c; cnt += (c > 0u) ? 1u : 0u; mine = (j == x) ? c : mine; }
        if (sum == G) break;
        __builtin_amdgcn_s_sleep(1);
        if ((++sp & 255u) == 0u) { if (xb_ld(&bar[XB_TMO])) break; if (sp > XB_SPIN_CAP) { atomicAdd(&bar[XB_TMO], 1u); break; } }
    }
    nloc = mine > 0u ? mine : 1u; nx = cnt > 0u ? cnt : 1u;
}
__device__ __forceinline__ void xcd_barrier(const XcdBarrier& b) {
    asm volatile("s_waitcnt vmcnt(0)" ::: "memory");
    __syncthreads();
    if (threadIdx.x == 0) {
        unsigned* bar = b.bar;
        __builtin_amdgcn_s_waitcnt(0);
        unsigned nloc = b.st[0], nx = b.st[1];
        if (nloc == 0u) { xcd_barrier_complete(bar, b.x, nloc, nx); b.st[0] = nloc; b.st[1] = nx; }
        const unsigned old = xb_add(&bar[XB_XSUB(b.x)], 1u);
        const unsigned gen = old / nloc;
        if (old + 1u == (gen + 1u) * nloc) {
            __builtin_amdgcn_fence(__ATOMIC_RELEASE, "agent");
            asm volatile("s_waitcnt vmcnt(0)" ::: "memory");
            const unsigned og = xb_add(&bar[XB_TOP], 1u);
            const unsigned tg = og / nx;
            if (og + 1u == (tg + 1u) * nx) xb_add(&bar[XB_TOPGEN], 1u);
            else XB_SPIN(xb_ld(&bar[XB_TOPGEN]) == tg, bar);
            __builtin_amdgcn_fence(__ATOMIC_ACQUIRE, "agent");
            xb_add(&bar[XB_XGEN(b.x)], 1u);
            asm volatile("s_waitcnt vmcnt(0)" ::: "memory");
        } else {
            XB_SPIN(xb_ld(&bar[XB_XGEN(b.x)]) == gen, bar);
            __builtin_amdgcn_fence(__ATOMIC_ACQUIRE, "agent");
            asm volatile("s_waitcnt vmcnt(0)" ::: "memory");
        }
    }
    __syncthreads();
}

__global__ void __launch_bounds__(256, 1) k_fused(P p, unsigned* bar) {
  extern __shared__ __attribute__((aligned(16))) char smem_all[];
  char* smem = smem_all + 64;
  if (threadIdx.x == 0) *(uint4*)smem_all = make_uint4(0u, 0u, 0u, 0u);
  __syncthreads();
  XcdBarrier b = xcd_barrier_post(bar, (volatile LAS unsigned*)smem_all);
#ifndef DUP_GEMM
#define DUP_GEMM 1
#endif
#ifndef DUP_ATT
#define DUP_ATT 1
#endif
#ifndef DUP_MIXAC
#define DUP_MIXAC 1
#endif
#ifndef DUP_ELT
#define DUP_ELT 1
#endif
#define REP(n, call) { call; if ((n) > 1) { call; } if ((n) > 2) { call; } }
#define LAYER_PROGRAM(L)                                                        \
  {                                                                             \
    ph_norm1(p, L, bid, smem); xcd_barrier(b);                                       \
    REP(DUP_GEMM, ph_win(p, L, bid, smem)) xcd_barrier(b);                           \
    REP(DUP_ELT, ph_prep(p, L, bid, smem)) xcd_barrier(b);                           \
    REP(DUP_GEMM, ph_qkv(p, L, bid, smem)) xcd_barrier(b);                           \
    REP(DUP_ELT, ph_mlapost(p, L, bid, smem)) xcd_barrier(b);                        \
    REP(DUP_MIXAC, ph_mixA(p, L, bid, smem)) xcd_barrier(b);                         \
    if (DUP_ATT > 1) { ph_attn_only(p, L, bid, smem); } ph_mixB(p, L, bid, smem); xcd_barrier(b); \
    REP(DUP_MIXAC, ph_mixC(p, L, bid, smem)) xcd_barrier(b);                         \
    REP(DUP_ELT, ph_s5pre(p, L, bid, smem)) xcd_barrier(b);                          \
    REP(DUP_GEMM, ph_glu(p, L, bid, smem)) xcd_barrier(b);                           \
    REP(DUP_ELT, ph_final_mix(p, L, bid, smem)) xcd_barrier(b);                      \
    REP((L == 0 ? DUP_GEMM : 1), ph_wout(p, L, bid, smem)) xcd_barrier(b);           \
    ph_router(p, L, bid, smem); xcd_barrier(b);                                      \
    REP(DUP_GEMM, ph_moe_up(p, L, bid, smem)) xcd_barrier(b);                        \
    REP(DUP_GEMM, ph_moe_down(p, L, bid, smem)) xcd_barrier(b);                      \
  }
  ph_mod(p, smem); xcd_barrier(b);
  if (threadIdx.x == 0) {
    unsigned pre = 0u;
    for (unsigned j = 0; j < 16; ++j) { const unsigned c = xb_ld(&bar[XB_XCNT(j)]); if (j < b.x) pre += c; }
    ((volatile LAS unsigned*)smem_all)[2] = pre + b.rank;
  }
  __syncthreads();
  const int bid = (int)((volatile LAS unsigned*)smem_all)[2];
  LAYER_PROGRAM(0)
  LAYER_PROGRAM(1)
  ph_out(p, bid, smem);
}

extern "C" void kernel_launch(void* const* d_in, const int* in_sizes, int n_in, void* d_out, int out_size, void* d_ws,
                              size_t ws_size, hipStream_t stream) {
  P p{};
  const float* const* in = (const float* const*)d_in;
  p.x = in[0]; p.c = in[1]; p.ctx = in[2]; p.c_ctx = in[3]; p.mod_w = in[4]; p.mod_b = in[5]; p.norm1_w = in[6];
  p.w_in = in[7]; p.q_norm_w = in[8]; p.kv_norm_w = in[9]; p.w_uq = in[10]; p.w_ukv = in[11]; p.conv_w = in[12];
  p.conv_b = in[13]; p.a_log = in[14]; p.dt_bias = in[15]; p.ssd_d = in[16]; p.gate_b = in[17]; p.lam_re = in[18];
  p.lam_im = in[19]; p.log_dt = in[20]; p.b_re = in[21]; p.b_im = in[22]; p.c_re = in[23]; p.c_im = in[24];
  p.s5_d = in[25]; p.glu_w = in[26]; p.glu_b = in[27]; p.out_norm_w = in[28]; p.w_out = in[29]; p.norm2_w = in[30];
  p.w_group = in[31]; p.w_expert = in[32]; p.w_gate = in[33]; p.w_up = in[34]; p.w_down = in[35]; p.final_w = in[36];
  p.out = (float*)d_out;
  p.ws = (float*)d_ws;
  (void)ws_size; (void)in_sizes; (void)n_in; (void)out_size;

  unsigned* bar = (unsigned*)((float*)d_ws + WO_bar);
  static int grid = 0;
  if (!grid) {
    int dev = 0, cus = 0, per_cu = 0;
    hipGetDevice(&dev);
    hipDeviceGetAttribute(&cus, hipDeviceAttributeMultiprocessorCount, dev);
    (void)hipFuncSetAttribute((const void*)k_fused, hipFuncAttributeMaxDynamicSharedMemorySize, SMEM_BYTES + 64);
    (void)hipOccupancyMaxActiveBlocksPerMultiprocessor(&per_cu, k_fused, 256, SMEM_BYTES + 64);
    if (per_cu < 1) per_cu = 1;
    grid = cus * (per_cu < 1 ? per_cu : 1);
  }
  hipMemsetAsync(bar, 0, XCD_BAR_WORDS * sizeof(unsigned), stream);
  hipLaunchKernelGGL(k_fused, dim3(grid), dim3(256), SMEM_BYTES + 64, stream, p, bar);
}
```

```cpp
#include <hip/hip_runtime.h>
#include <stdint.h>

#define DM 2048
#define SL 4096
#define CL 256
#define TLAT 8192
#define TCTX 512
#define TTOT 8704
#define NIN 4192
#define NKEY 4352
#define ZC_CQ 0
#define ZC_CKV 384
#define ZC_KR 512
#define ZC_BZ 576
#define ZC_XBC 1088
#define ZC_DT 2112
#define ZC_MQ 2128
#define ZC_MK 2384
#define ZC_MV 2640
#define ZC_MO 3152
#define ZC_MG 3664
#define ZC_U 3680
#define CAPE 8704
#define EPSV 1e-6f
#define ACT_ROWS 21632

typedef float f32x16 __attribute__((ext_vector_type(16)));
typedef short bf16x8 __attribute__((ext_vector_type(8)));
typedef float f32x4v __attribute__((ext_vector_type(4)));
typedef unsigned short bfraw;
__device__ __forceinline__ unsigned pack_bf16(float lo, float hi) {
  typedef __bf16 bf2 __attribute__((ext_vector_type(2)));
  bf2 v; v[0] = (__bf16)lo; v[1] = (__bf16)hi;
  return __builtin_bit_cast(unsigned, v);
}
__device__ __forceinline__ bfraw to_bf16(float x) { __bf16 b = (__bf16)x; return __builtin_bit_cast(unsigned short, b); }
__device__ __forceinline__ float from_bf16(bfraw x) { return __uint_as_float((unsigned)x << 16); }

#define NSTEP 68
#define LDH 2112
#define LDACT 576
#define XCD_BAR_WORDS 3456
#define WS_RND(n) (((size_t)(n) + 63) & ~(size_t)63)
constexpr size_t WO_cnt = 0;
constexpr size_t WO_modv = WO_cnt + WS_RND(64);
constexpr size_t WO_H = WO_modv + WS_RND(2 * 3 * 12288);
constexpr size_t WO_X = WO_H + WS_RND((size_t)TTOT * (LDH / 2));
constexpr size_t WO_Z = WO_X + WS_RND((size_t)TTOT * 2048);
constexpr size_t WO_Aq = WO_Z + WS_RND((size_t)TTOT * NIN);
constexpr size_t WO_Akv = WO_Aq + WS_RND((size_t)TTOT * 192);
constexpr size_t WO_qraw = WO_Akv + WS_RND((size_t)TTOT * 64);
constexpr size_t WO_kvraw = WO_qraw + WS_RND((size_t)TTOT * 768);
constexpr size_t WO_Q = WO_kvraw + WS_RND((size_t)TTOT * 1024);
constexpr size_t WO_Qc = WO_Q + WS_RND((size_t)8 * SL * 96);
constexpr size_t WO_K = WO_Qc + WS_RND((size_t)8 * CL * 96);
constexpr size_t WO_V = WO_K + WS_RND((size_t)8 * NKEY * 96);
constexpr size_t WO_O = WO_V + WS_RND((size_t)8 * NKEY * 64);
constexpr size_t WO_ssd_xs = WO_O + WS_RND((size_t)TTOT * 512);
constexpr size_t WO_ssd_B = WO_ssd_xs + WS_RND((size_t)TTOT * 512);
constexpr size_t WO_ssd_C = WO_ssd_B + WS_RND((size_t)TTOT * 256);
constexpr size_t WO_ssd_dt = WO_ssd_C + WS_RND((size_t)TTOT * 256);
constexpr size_t WO_ssd_y = WO_ssd_dt + WS_RND((size_t)TTOT * 16);
constexpr size_t WO_ssd_st = WO_ssd_y + WS_RND((size_t)TTOT * 512);
constexpr size_t WO_ssd_atot = WO_ssd_st + WS_RND((size_t)32 * NSTEP * 8192);
constexpr size_t WO_ml_h = WO_ssd_atot + WS_RND(32 * NSTEP);
constexpr size_t WO_ml_st = WO_ml_h + WS_RND((size_t)TTOT * 512);
constexpr size_t WO_ml_nst = WO_ml_st + WS_RND((size_t)16 * NSTEP * 8192);
constexpr size_t WO_ml_gtot = WO_ml_nst + WS_RND((size_t)16 * NSTEP * 64);
constexpr size_t WO_s5_st = WO_ml_gtot + WS_RND(16 * NSTEP);
constexpr size_t WO_s5_a = WO_s5_st + WS_RND((size_t)128 * NSTEP * 128);
constexpr size_t WO_s5_bb = WO_s5_a + WS_RND(2 * 2 * 32 * 64 * 2);
constexpr size_t WO_s5_rf = WO_s5_bb + WS_RND((size_t)2 * 2 * 32 * 64 * 32);
constexpr size_t WO_s5_rb = WO_s5_rf + WS_RND((size_t)TTOT * 512);
constexpr size_t WO_ydpre = WO_s5_rb + WS_RND((size_t)TTOT * 512);
constexpr size_t WO_ydg = WO_ydpre + WS_RND((size_t)TTOT * 512);
constexpr size_t WO_Y = WO_ydg + WS_RND((size_t)TTOT * 512);
constexpr size_t WO_ydpre_bf = WO_Y + WS_RND((size_t)TTOT * (LDH / 2));
constexpr size_t WO_list_tok = WO_ydpre_bf + WS_RND((size_t)TTOT * 256);
constexpr size_t WO_list_w = WO_list_tok + WS_RND((size_t)32 * CAPE);
constexpr size_t WO_ACT = WO_list_w + WS_RND((size_t)32 * CAPE);
constexpr size_t WO_Yslot = WO_ACT + WS_RND((size_t)ACT_ROWS * (LDACT / 2));
constexpr size_t WO_rope_cs = WO_Yslot + WS_RND((size_t)TTOT * 2 * 2048);
constexpr size_t WO_bar_old = WO_Yslot + WS_RND((size_t)TTOT * 2 * 2048);
constexpr size_t WO_bar = WO_rope_cs + WS_RND(64 * 16 * 2);
constexpr size_t WS_TOTAL_FLOATS = WO_bar + 4096;

struct P {
  const float *x, *c, *ctx, *c_ctx, *mod_w, *mod_b, *norm1_w, *w_in, *q_norm_w, *kv_norm_w, *w_uq, *w_ukv;
  const float *conv_w, *conv_b, *a_log, *dt_bias, *ssd_d, *gate_b, *lam_re, *lam_im, *log_dt, *b_re, *b_im;
  const float *c_re, *c_im, *s5_d, *glu_w, *glu_b, *out_norm_w, *w_out, *norm2_w, *w_group, *w_expert;
  const float *w_gate, *w_up, *w_down, *final_w;
  float* out;
  float* ws;
  int dup[16];
  __device__ __forceinline__ int* cnt() const { return (int*)(ws + WO_cnt); }
  __device__ __forceinline__ float* modv() const { return (float*)(ws + WO_modv); }
  __device__ __forceinline__ bfraw* H() const { return (bfraw*)(ws + WO_H); }
  __device__ __forceinline__ float* X() const { return (float*)(ws + WO_X); }
  __device__ __forceinline__ float* Z() const { return (float*)(ws + WO_Z); }
  __device__ __forceinline__ bfraw* Aq() const { return (bfraw*)(ws + WO_Aq); }
  __device__ __forceinline__ bfraw* Akv() const { return (bfraw*)(ws + WO_Akv); }
  __device__ __forceinline__ float* qraw() const { return (float*)(ws + WO_qraw); }
  __device__ __forceinline__ float* kvraw() const { return (float*)(ws + WO_kvraw); }
  __device__ __forceinline__ bfraw* Q() const { return (bfraw*)(ws + WO_Q); }
  __device__ __forceinline__ bfraw* Qc() const { return (bfraw*)(ws + WO_Qc); }
  __device__ __forceinline__ bfraw* K() const { return (bfraw*)(ws + WO_K); }
  __device__ __forceinline__ bfraw* V() const { return (bfraw*)(ws + WO_V); }
  __device__ __forceinline__ float* O() const { return (float*)(ws + WO_O); }
  __device__ __forceinline__ float* ssd_xs() const { return (float*)(ws + WO_ssd_xs); }
  __device__ __forceinline__ float* ssd_B() const { return (float*)(ws + WO_ssd_B); }
  __device__ __forceinline__ float* ssd_C() const { return (float*)(ws + WO_ssd_C); }
  __device__ __forceinline__ float* ssd_dt() const { return (float*)(ws + WO_ssd_dt); }
  __device__ __forceinline__ float* ssd_y() const { return (float*)(ws + WO_ssd_y); }
  __device__ __forceinline__ float* ssd_st() const { return (float*)(ws + WO_ssd_st); }
  __device__ __forceinline__ float* ssd_atot() const { return (float*)(ws + WO_ssd_atot); }
  __device__ __forceinline__ float* ml_h() const { return (float*)(ws + WO_ml_h); }
  __device__ __forceinline__ float* ml_st() const { return (float*)(ws + WO_ml_st); }
  __device__ __forceinline__ float* ml_nst() const { return (float*)(ws + WO_ml_nst); }
  __device__ __forceinline__ float* ml_gtot() const { return (float*)(ws + WO_ml_gtot); }
  __device__ __forceinline__ float* s5_st() const { return (float*)(ws + WO_s5_st); }
  __device__ __forceinline__ float* s5_a() const { return (float*)(ws + WO_s5_a); }
  __device__ __forceinline__ float* s5_bb() const { return (float*)(ws + WO_s5_bb); }
  __device__ __forceinline__ float* s5_rf() const { return (float*)(ws + WO_s5_rf); }
  __device__ __forceinline__ float* s5_rb() const { return (float*)(ws + WO_s5_rb); }
  __device__ __forceinline__ float* ydpre() const { return (float*)(ws + WO_ydpre); }
  __device__ __forceinline__ float* ydg() const { return (float*)(ws + WO_ydg); }
  __device__ __forceinline__ bfraw* Y() const { return (bfraw*)(ws + WO_Y); }
  __device__ __forceinline__ bfraw* ydpre_bf() const { return (bfraw*)(ws + WO_ydpre_bf); }
  __device__ __forceinline__ int* list_tok() const { return (int*)(ws + WO_list_tok); }
  __device__ __forceinline__ float* list_w() const { return (float*)(ws + WO_list_w); }
  __device__ __forceinline__ bfraw* ACT() const { return (bfraw*)(ws + WO_ACT); }
  __device__ __forceinline__ float* Yslot() const { return (float*)(ws + WO_Yslot); }
  __device__ __forceinline__ float* rope_cs() const { return (float*)(ws + WO_rope_cs); }
};

__device__ __forceinline__ int row_modidx(int r) { return r < TLAT ? (r >> 12) : 2; }
__device__ __forceinline__ float sigmoidf_(float v) { return 1.f / (1.f + expf(-v)); }
__device__ __forceinline__ float siluf_(float v) { return v / (1.f + expf(-v)); }
__device__ __forceinline__ float wave_sum(float v) {
#pragma unroll
  for (int o = 32; o; o >>= 1) v += __shfl_xor(v, o);
  return v;
}
__device__ __forceinline__ float block_sum(float v, float* red) {
  v = wave_sum(v);
  __syncthreads();
  if ((threadIdx.x & 63) == 0) red[threadIdx.x >> 6] = v;
  __syncthreads();
  return red[0] + red[1] + red[2] + red[3];
}

__device__ __forceinline__ void ph_mod(const P& p, char* smem) {
  float* sc = (float*)smem;
  float* red = sc + 3 * 2048;
  const int tid = threadIdx.x;
  if (blockIdx.x == 0 && tid < 64) p.cnt()[tid] = 0;
  if (blockIdx.x == 1) {
    for (int i = tid; i < 64 * 16; i += 256) {
      const int idx = i >> 4, f = i & 15;
      const float ang = (float)idx * powf(10000.f, -(float)f * (1.f / 16.f));
      p.rope_cs()[i * 2] = cosf(ang); p.rope_cs()[i * 2 + 1] = sinf(ang);
    }
  }
  for (int i = blockIdx.x * 256 + tid; i < 2 * 2 * 32 * 64; i += gridDim.x * 256) {
    const int sp = i & 63, g = (i >> 6) & 31, l = i >> 12;
    const float lr = p.lam_re[i], li = p.lam_im[i];
    const float dt = expf(p.log_dt[i >> 6]);
    const float mag = expf(lr * dt);
    const float ar = mag * cosf(li * dt), ai = mag * sinf(li * dt);
    const float den = lr * lr + li * li;
    const float cr_ = ((ar - 1.f) * lr + ai * li) / den;
    const float ci_ = (ai * lr - (ar - 1.f) * li) / den;
    p.s5_a()[i * 2] = ar; p.s5_a()[i * 2 + 1] = ai;
    for (int c = 0; c < 16; ++c) {
      float br = p.b_re[((size_t)(l * 32 + g) * 64 + sp) * 16 + c];
      float bim = p.b_im[((size_t)(l * 32 + g) * 64 + sp) * 16 + c];
      p.s5_bb()[(size_t)i * 32 + c] = cr_ * br - ci_ * bim;
      p.s5_bb()[(size_t)i * 32 + 16 + c] = cr_ * bim + ci_ * br;
    }
  }
  for (int i = tid; i < 3 * 2048; i += 256) {
    int r = i >> 11, k = i & 2047;
    float v = r < 2 ? p.c[r * 2048 + k] : p.c_ctx[k];
    sc[i] = siluf_(v);
  }
  __syncthreads();
  for (int w = blockIdx.x; w < 2 * 96; w += gridDim.x) {
    int l = w / 96, j0 = (w % 96) * 128;
    int cg = tid & 31, ks = tid >> 5;
    const float* W = p.mod_w + (size_t)l * 2048 * 12288 + j0 + cg * 4;
    float acc[3][4];
#pragma unroll
    for (int r = 0; r < 3; ++r)
#pragma unroll
      for (int c = 0; c < 4; ++c) acc[r][c] = 0.f;
#pragma unroll 16
    for (int k = ks * 256; k < ks * 256 + 256; ++k) {
      float4 wv = *(const float4*)(W + (size_t)k * 12288);
      float s0 = sc[k], s1 = sc[2048 + k], s2 = sc[4096 + k];
      acc[0][0] += s0 * wv.x; acc[0][1] += s0 * wv.y; acc[0][2] += s0 * wv.z; acc[0][3] += s0 * wv.w;
      acc[1][0] += s1 * wv.x; acc[1][1] += s1 * wv.y; acc[1][2] += s1 * wv.z; acc[1][3] += s1 * wv.w;
      acc[2][0] += s2 * wv.x; acc[2][1] += s2 * wv.y; acc[2][2] += s2 * wv.z; acc[2][3] += s2 * wv.w;
    }
    __syncthreads();
#pragma unroll
    for (int r = 0; r < 3; ++r)
#pragma unroll
      for (int c = 0; c < 4; ++c) red[(ks * 32 + cg) * 12 + r * 4 + c] = acc[r][c];
    __syncthreads();
    for (int o = tid; o < 384; o += 256) {
      int r = o >> 7, c = o & 127;
      float s = 0.f;
#pragma unroll
      for (int q = 0; q < 8; ++q) s += red[(q * 32 + (c >> 2)) * 12 + r * 4 + (c & 3)];
      s += p.mod_b[l * 12288 + j0 + c];
      p.modv()[(l * 3 + r) * 12288 + j0 + c] = s;
    }
    __syncthreads();
  }
}

__device__ __forceinline__ void ph_norm1(const P& p, int layer, int bid, char* smem) {
  const int tid = threadIdx.x, lane = tid & 63, wid = tid >> 6;
  const float* nw = p.norm1_w + layer * 2048;
  for (int r = bid * 4 + wid; r < TTOT; r += gridDim.x * 4) {
    const int mi = row_modidx(r);
    const float* mrow = p.modv() + (layer * 3 + mi) * 12288;
    f32x4v v[8];
    float ss = 0.f;
#pragma unroll
    for (int q = 0; q < 8; ++q) {
      const int col = q * 256 + lane * 4;
      f32x4v xv;
      if (layer == 0) {
        const float* src = r < TLAT ? p.x + (size_t)r * 2048 : p.ctx + (size_t)(r - TLAT) * 2048;
        xv = *(const f32x4v*)(src + col);
      } else {
        xv = *(const f32x4v*)(p.X() + (size_t)r * 2048 + col);
        const float* g2 = p.modv() + ((layer - 1) * 3 + mi) * 12288 + 5 * 2048;
        const f32x4v gv = *(const f32x4v*)(g2 + col);
        const f32x4v y0 = *(const f32x4v*)(p.Yslot() + (size_t)(2 * r) * 2048 + col);
        const f32x4v y1 = *(const f32x4v*)(p.Yslot() + (size_t)(2 * r + 1) * 2048 + col);
        xv += gv * (y0 + y1);
        *(f32x4v*)(p.X() + (size_t)r * 2048 + col) = xv;
      }
      v[q] = xv;
      ss += xv[0] * xv[0] + xv[1] * xv[1] + xv[2] * xv[2] + xv[3] * xv[3];
    }
    ss = wave_sum(ss);
    const float rs = rsqrtf(ss * (1.f / 2048.f) + EPSV);
#pragma unroll
    for (int q = 0; q < 8; ++q) {
      const int col = q * 256 + lane * 4;
      const f32x4v w4 = *(const f32x4v*)(nw + col);
      const f32x4v sh = *(const f32x4v*)(mrow + col);
      const f32x4v scv = *(const f32x4v*)(mrow + 2048 + col);
      const f32x4v o = v[q] * rs * w4 * (1.f + scv) + sh;
      uint2 ob; ob.x = pack_bf16(o[0], o[1]); ob.y = pack_bf16(o[2], o[3]);
      *(uint2*)(p.H() + (size_t)r * LDH + col) = ob;
    }
  }
}

template <int MI, class AF, class BF, class EF>
__device__ __forceinline__ void gemm_tile(const AF& af, const BF& bf, const EF& ef, int K, char* smem) {
  constexpr int BM = MI * 64;
  constexpr int NA = MI * 2;
  constexpr int ABYTES = BM * 128, STAGE = ABYTES + 16384;
  const int tid = threadIdx.x, lane = tid & 63, wid = tid >> 6, wr = wid >> 1, wc = wid & 1;
  const int l31 = lane & 31, lh = lane >> 5;
  f32x16 acc[MI][2];
#pragma unroll
  for (int i = 0; i < MI; ++i)
#pragma unroll
    for (int j = 0; j < 2; ++j)
#pragma unroll
      for (int r = 0; r < 16; ++r) acc[i][j][r] = 0.f;
  const int arl = tid >> 3, ac = tid & 7;
  const bfraw* arow[NA];
#pragma unroll
  for (int i = 0; i < NA; ++i) { const bfraw* q = af.row(arl + 32 * i); arow[i] = (q ? q : af.safe()) + ac * 8; }
  const int n4 = tid & 31, kg = tid >> 5;
  const float* bc;
  { const float* q = bf.col(n4 * 4); bc = (q ? q : bf.safe()) + (size_t)(kg * 8) * bf.ldb; }
  const size_t ldb = (size_t)bf.ldb;
  typedef unsigned u32x4v __attribute__((ext_vector_type(4)));
  u32x4v ra[2][NA];
  f32x4v rb[2][8];
#define GM_GL(set, k0)                                                               \
  {                                                                                  \
    _Pragma("unroll") for (int i = 0; i < NA; ++i) ra[set][i] = *(const u32x4v*)(arow[i] + (k0)); \
    const float* bq = bc + (size_t)(k0) * ldb;                                       \
    _Pragma("unroll") for (int j = 0; j < 8; ++j) rb[set][j] = *(const f32x4v*)(bq + (size_t)j * ldb); \
  }
#define GM_SW(set, buf)                                                              \
  {                                                                                  \
    char* Ab = smem + (buf) * STAGE; char* Bb = Ab + ABYTES;                         \
    const int asw = (ac ^ ((arl >> 1) & 7)) << 4;                                    \
    _Pragma("unroll") for (int i = 0; i < NA; ++i) *(u32x4v*)(Ab + (arl + 32 * i) * 128 + asw) = ra[set][i]; \
    _Pragma("unroll") for (int i4 = 0; i4 < 4; ++i4) {                               \
      const int n = n4 * 4 + i4;                                                     \
      u32x4v v;                                                                      \
      v[0] = pack_bf16(rb[set][0][i4], rb[set][1][i4]); v[1] = pack_bf16(rb[set][2][i4], rb[set][3][i4]); \
      v[2] = pack_bf16(rb[set][4][i4], rb[set][5][i4]); v[3] = pack_bf16(rb[set][6][i4], rb[set][7][i4]); \
      *(u32x4v*)(Bb + n * 128 + ((kg ^ ((n >> 1) & 7)) << 4)) = v;                   \
    }                                                                                \
  }
#define GM_COMPUTE(buf, KK0, KK1)                                                    \
  {                                                                                  \
    const char* ap = smem + (buf) * STAGE + (wr * (BM / 2) + l31) * 128;             \
    const char* bp = smem + (buf) * STAGE + ABYTES + (wc * 64 + l31) * 128;          \
    _Pragma("unroll") for (int kk = KK0; kk < KK1; ++kk) {                           \
      const int co = ((2 * kk + lh) ^ fsw) << 4;                                     \
      const bf16x8 b0 = *(const bf16x8*)(bp + co), b1 = *(const bf16x8*)(bp + 32 * 128 + co); \
      _Pragma("unroll") for (int i = 0; i < MI; ++i) {                               \
        const bf16x8 a = *(const bf16x8*)(ap + i * 32 * 128 + co);                   \
        acc[i][0] = __builtin_amdgcn_mfma_f32_32x32x16_bf16(a, b0, acc[i][0], 0, 0, 0); \
        acc[i][1] = __builtin_amdgcn_mfma_f32_32x32x16_bf16(a, b1, acc[i][1], 0, 0, 0); \
      }                                                                              \
    }                                                                                \
  }
  const int fsw = (l31 >> 1) & 7;
  const int nsteps = K >> 6;
  __syncthreads();
  const int klast = (nsteps - 1) * 64;
  GM_GL(0, 0)
  GM_SW(0, 0)
  GM_GL(1, 64)
  __syncthreads();
  for (int s = 0; s < nsteps; s += 2) {
    { const int kn = min((s + 2) * 64, klast); GM_GL(0, kn) }
    GM_COMPUTE(0, 0, 2)
    __builtin_amdgcn_sched_barrier(0);
    GM_SW(1, 1)
    __builtin_amdgcn_sched_barrier(0);
    GM_COMPUTE(0, 2, 4)
    __syncthreads();
    { const int kn = min((s + 3) * 64, klast); GM_GL(1, kn) }
    GM_COMPUTE(1, 0, 2)
    __builtin_amdgcn_sched_barrier(0);
    GM_SW(0, 0)
    __builtin_amdgcn_sched_barrier(0);
    GM_COMPUTE(1, 2, 4)
    __syncthreads();
  }
  ef(acc, wr, wc, lane);
}
#define ACC_ROWM(MI, wr, i, r, lane) ((wr) * ((MI) * 32) + (i) * 32 + ((r) & 3) + 8 * ((r) >> 2) + 4 * ((lane) >> 5))
#define ACC_ROW(wr, i, r, lane) ACC_ROWM(2, wr, i, r, lane)
#define ACC_COL(wc, j, lane) ((wc) * 64 + (j) * 32 + ((lane) & 31))

struct ARows { const bfraw* base; int ld; int m0; int M;
  __device__ __forceinline__ const bfraw* row(int r) const { int g = m0 + r; return g < M ? base + (size_t)g * ld : nullptr; }
  __device__ __forceinline__ const bfraw* safe() const { return base; } };
struct BPlain { const float* B; int ldb; int n0; int N;
  __device__ __forceinline__ const float* col(int v) const { int n = n0 + v; return n < N ? B + n : nullptr; }
  __device__ __forceinline__ const float* safe() const { return B; } };

template <int MI, class EPI>
__device__ __forceinline__ void gemm_dense(const bfraw* A, int lda, const float* B, int ldb, int M, int N, int K, const EPI& epi, int bid, char* smem) {
  constexpr int BM = MI * 64;
  const int mt = (M + BM - 1) / BM, nt = (N + 127) >> 7;
  const int nslots = ((nt + 1) >> 1) * mt * 2;
  for (int w = bid; w < nslots; w += gridDim.x) {
    const int sr = w / (mt * 2), rem = w - sr * (mt * 2);
    const int n_t = sr * 2 + (rem & 1);
    if (n_t >= nt) continue;
    const int m0 = (rem >> 1) * BM, n0 = n_t * 128;
    ARows af{A, lda, m0, M};
    BPlain bf{B, ldb, n0, N};
    auto ef = [&](const f32x16 (&acc)[MI][2], int wr, int wc, int lane) {
#pragma unroll
      for (int i = 0; i < MI; ++i)
#pragma unroll
        for (int j = 0; j < 2; ++j)
#pragma unroll
          for (int r = 0; r < 16; ++r) {
            int row = m0 + ACC_ROWM(MI, wr, i, r, lane), col = n0 + ACC_COL(wc, j, lane);
            if (row < M && col < N) epi(row, col, acc[i][j][r]);
          }
    };
    gemm_tile<MI>(af, bf, ef, K, smem);
  }
}

__device__ __forceinline__ void ph_win(const P& p, int layer, int bid, char* smem) {
  float* Z = p.Z();
  auto epi = [=](int row, int col, float v) { Z[(size_t)row * NIN + col] = v; };
  gemm_dense<4>(p.H(), LDH, p.w_in + (size_t)layer * 2048 * NIN, NIN, TTOT, NIN, 2048, epi, bid, smem);
}

__device__ __forceinline__ void ph_prep(const P& p, int layer, int bid, char* smem) {
  const int tid = threadIdx.x, lane = tid & 63, wid = tid >> 6;
  for (int r = bid * 4 + wid; r < TTOT; r += gridDim.x * 4) {
    const float* z = p.Z() + (size_t)r * NIN;
    float q[6]; float ss = 0.f;
#pragma unroll
    for (int i = 0; i < 6; ++i) { q[i] = z[ZC_CQ + i * 64 + lane]; ss += q[i] * q[i]; }
    ss = wave_sum(ss);
    float rs = rsqrtf(ss * (1.f / 384.f) + EPSV);
#pragma unroll
    for (int i = 0; i < 6; ++i) p.Aq()[(size_t)r * 384 + i * 64 + lane] = to_bf16(q[i] * rs * p.q_norm_w[layer * 384 + i * 64 + lane]);
    float k0 = z[ZC_CKV + lane], k1 = z[ZC_CKV + 64 + lane];
    float s2 = wave_sum(k0 * k0 + k1 * k1);
    float rs2 = rsqrtf(s2 * (1.f / 128.f) + EPSV);
    p.Akv()[(size_t)r * 128 + lane] = to_bf16(k0 * rs2 * p.kv_norm_w[layer * 128 + lane]);
    p.Akv()[(size_t)r * 128 + 64 + lane] = to_bf16(k1 * rs2 * p.kv_norm_w[layer * 128 + 64 + lane]);
  }
  const float* cw = p.conv_w + layer * 5 * 1024;
  const float* cb = p.conv_b + layer * 1024;
  const int ch = tid * 4;
  const f32x4v bias = *(const f32x4v*)(cb + ch);
  f32x4v wk[5];
#pragma unroll
  for (int k = 0; k < 5; ++k) wk[k] = *(const f32x4v*)(cw + k * 1024 + ch);
  for (int rb = bid; rb < TTOT / 8; rb += gridDim.x) {
    const int r0 = rb * 8;
    int base, len;
    if (r0 < TLAT) { base = (r0 >> 12) << 12; len = SL; } else { base = TLAT + (((r0 - TLAT) >> 8) << 8); len = CL; }
    const int t0 = r0 - base;
    f32x4v xw[12];
#pragma unroll
    for (int u = 0; u < 12; ++u) {
      const int tt = t0 + u - 2;
      const f32x4v zero = {0.f, 0.f, 0.f, 0.f};
      xw[u] = (tt >= 0 && tt < len) ? *(const f32x4v*)(p.Z() + (size_t)(base + tt) * NIN + ZC_XBC + ch) : zero;
    }
#pragma unroll
    for (int j = 0; j < 8; ++j) {
      f32x4v acc = bias;
#pragma unroll
      for (int k = 0; k < 5; ++k) acc += xw[j + k] * wk[k];
      acc[0] = siluf_(acc[0]); acc[1] = siluf_(acc[1]); acc[2] = siluf_(acc[2]); acc[3] = siluf_(acc[3]);
      const int r = r0 + j;
      if (ch < 512) *(f32x4v*)(p.ssd_xs() + (size_t)r * 512 + ch) = acc;
      else if (ch < 768) *(f32x4v*)(p.ssd_B() + (size_t)r * 256 + (ch - 512)) = acc;
      else *(f32x4v*)(p.ssd_C() + (size_t)r * 256 + (ch - 768)) = acc;
    }
    if (tid < 128) {
      const int r = r0 + (tid >> 4), c = tid & 15;
      float v = p.Z()[(size_t)r * NIN + ZC_DT + c] + p.dt_bias[layer * 16 + c];
      p.ssd_dt()[(size_t)r * 16 + c] = v > 20.f ? v : log1pf(expf(v));
    }
  }
}

__device__ __forceinline__ void ph_qkv(const P& p, int layer, int bid, char* smem) {
  const int tid = threadIdx.x;
  const float qscale = 0.07216878364870322f * 1.4426950408889634f;
  const float* rope = p.rope_cs();
  for (int r = bid; r < TTOT; r += gridDim.x) {
    const bool lat = r < TLAT;
    int b, pos;
    if (lat) { b = r >> 12; pos = r & 4095; } else { b = (r - TLAT) >> 8; pos = (r - TLAT) & 255; }
    const int kpos = lat ? pos : SL + pos;
    const float* zr = p.Z() + (size_t)r * NIN + ZC_KR;
    const int h = tid >> 6, e = tid & 63;
    float v;
    if (!lat) v = zr[e];
    else {
      const int a = e >> 5, half = (e >> 4) & 1, f = e & 15;
      const float x1 = zr[a * 32 + f], x2 = zr[a * 32 + 16 + f];
      const int idx = a == 0 ? (pos >> 6) : (pos & 63);
      const float cs = rope[(idx * 16 + f) * 2], sn = rope[(idx * 16 + f) * 2 + 1];
      v = half == 0 ? x1 * cs - x2 * sn : x1 * sn + x2 * cs;
    }
    p.K()[((size_t)(b * 4 + h) * NKEY + kpos) * 192 + 128 + e] = to_bf16(v);
  }
  {
    const float* B = p.w_uq + (size_t)layer * 384 * 768;
    for (int w = bid; w < 68 * 6; w += gridDim.x) {
      const int n_t = w / 68, m_t = w - n_t * 68;
      const int m0 = m_t * 128, n0 = n_t * 128;
      ARows af{p.Aq(), 384, m0, TTOT};
      BPlain bf{B, 768, n0, 768};
      const bool lat = m0 < TLAT;
      const int b = lat ? (m0 >> 12) : ((m0 - TLAT) >> 8);
      const int pos0 = lat ? (m0 & 4095) : ((m0 - TLAT) & 255);
      auto ef = [&](const f32x16 (&acc)[2][2], int wr, int wc, int lane) {
        const int l31 = lane & 31;
#pragma unroll
        for (int j = 0; j < 2; ++j) {
          const int col = n0 + wc * 64 + j * 32;
          const int h = col / 192, d0 = col - h * 192;
          const bool isrope = lat && d0 >= 128;
          const int f = l31 & 15;
#pragma unroll
          for (int i = 0; i < 2; ++i)
#pragma unroll
            for (int r = 0; r < 16; ++r) {
              const int pos = pos0 + ACC_ROW(wr, i, r, lane);
              float v = acc[i][j][r];
              const float pv = __shfl_xor(v, 16);
              if (isrope) {
                const int idx = d0 == 128 ? (pos >> 6) : (pos & 63);
                const float cs = rope[(idx * 16 + f) * 2], sn = rope[(idx * 16 + f) * 2 + 1];
                v = (l31 < 16) ? v * cs - pv * sn : pv * sn + v * cs;
              }
              bfraw* dst = lat ? p.Q() + ((size_t)(b * 4 + h) * SL + pos) * 192 : p.Qc() + ((size_t)(b * 4 + h) * CL + pos) * 192;
              dst[d0 + l31] = to_bf16(v * qscale);
            }
        }
      };
      gemm_tile<2>(af, bf, ef, 384, smem);
    }
  }
  {
    const float* B = p.w_ukv + (size_t)layer * 128 * 1024;
    for (int w = bid; w < 68 * 8; w += gridDim.x) {
      const int n_t = w / 68, m_t = w - n_t * 68;
      const int m0 = m_t * 128, n0 = n_t * 128;
      ARows af{p.Akv(), 128, m0, TTOT};
      BPlain bf{B, 1024, n0, 1024};
      const bool lat = m0 < TLAT;
      const int b = lat ? (m0 >> 12) : ((m0 - TLAT) >> 8);
      const int kpos0 = lat ? (m0 & 4095) : SL + ((m0 - TLAT) & 255);
      const int h = n_t >> 1;
      const bool isv = n_t & 1;
      auto ef = [&](const f32x16 (&acc)[2][2], int wr, int wc, int lane) {
        const int l31 = lane & 31, lh = lane >> 5;
        if (!isv) {
#pragma unroll
          for (int i = 0; i < 2; ++i)
#pragma unroll
            for (int j = 0; j < 2; ++j)
#pragma unroll
              for (int r = 0; r < 16; ++r) {
                const int kpos = kpos0 + ACC_ROW(wr, i, r, lane);
                p.K()[((size_t)(b * 4 + h) * NKEY + kpos) * 192 + wc * 64 + j * 32 + l31] = to_bf16(acc[i][j][r]);
              }
        } else {
#pragma unroll
          for (int i = 0; i < 2; ++i)
#pragma unroll
            for (int j = 0; j < 2; ++j) {
              const int d = wc * 64 + j * 32 + l31;
              bfraw* vrow = p.V() + ((size_t)(b * 4 + h) * 128 + d) * NKEY + kpos0 + wr * 64 + i * 32;
#pragma unroll
              for (int s = 0; s < 2; ++s) {
                uint4 t;
                t.x = pack_bf16(acc[i][j][8 * s + 0], acc[i][j][8 * s + 1]); t.y = pack_bf16(acc[i][j][8 * s + 2], acc[i][j][8 * s + 3]);
                t.z = pack_bf16(acc[i][j][8 * s + 4], acc[i][j][8 * s + 5]); t.w = pack_bf16(acc[i][j][8 * s + 6], acc[i][j][8 * s + 7]);
                *(uint4*)(vrow + 16 * s + 8 * lh) = t;
              }
            }
        }
      };
      gemm_tile<2>(af, bf, ef, 128, smem);
    }
  }
}

#define ATT_KROW 400
#define ATT_VROW 144
#define MFMA16(a, b, c) __builtin_amdgcn_mfma_f32_32x32x16_bf16(a, b, c, 0, 0, 0)
__device__ __forceinline__ void attn_item(const bfraw* __restrict__ Qp, const bfraw* __restrict__ Kp, const bfraw* __restrict__ Vtp,
                                          int nk, float* __restrict__ Op, char* smem) {
  char* Ks = smem;
  char* Vs = smem + 64 * ATT_KROW;
  const int tid = threadIdx.x, lane = tid & 63, wid = tid >> 6, l31 = lane & 31, lh = lane >> 5;
  bf16x8 qf[12];
  {
    const bfraw* qrow = Qp + (size_t)(wid * 32 + l31) * 192 + lh * 8;
#pragma unroll
    for (int ks = 0; ks < 12; ++ks) qf[ks] = *(const bf16x8*)(qrow + ks * 16);
  }
  f32x16 o[4];
#pragma unroll
  for (int d = 0; d < 4; ++d)
#pragma unroll
    for (int r = 0; r < 16; ++r) o[d][r] = 0.f;
  float m = -INFINITY, l = 0.f;
  uint4 rk0, rk1, rk2, rk3, rk4, rk5, rv0, rv1, rv2, rv3;
#define ATT_KSRC(n, kt) (Kp + (size_t)((kt) + (tid + 256 * (n)) / 24) * 192 + ((tid + 256 * (n)) % 24) * 8)
#define ATT_VSRC(n, kt) (Vtp + (size_t)((tid + 256 * (n)) >> 3) * NKEY + (kt) + ((tid + 256 * (n)) & 7) * 8)
#define ATT_GLOAD(kt)                                                                                        \
  {                                                                                                          \
    rk0 = *(const uint4*)ATT_KSRC(0, kt); rk1 = *(const uint4*)ATT_KSRC(1, kt); rk2 = *(const uint4*)ATT_KSRC(2, kt); \
    rk3 = *(const uint4*)ATT_KSRC(3, kt); rk4 = *(const uint4*)ATT_KSRC(4, kt); rk5 = *(const uint4*)ATT_KSRC(5, kt); \
    rv0 = *(const uint4*)ATT_VSRC(0, kt); rv1 = *(const uint4*)ATT_VSRC(1, kt);                              \
    rv2 = *(const uint4*)ATT_VSRC(2, kt); rv3 = *(const uint4*)ATT_VSRC(3, kt);                              \
  }
#define ATT_KDST(n) (Ks + ((tid + 256 * (n)) / 24) * ATT_KROW + ((tid + 256 * (n)) % 24) * 16)
#define ATT_VDST(n) (Vs + ((tid + 256 * (n)) >> 3) * ATT_VROW + ((tid + 256 * (n)) & 7) * 16)
#define ATT_SWRITE()                                                                                         \
  {                                                                                                          \
    *(uint4*)ATT_KDST(0) = rk0; *(uint4*)ATT_KDST(1) = rk1; *(uint4*)ATT_KDST(2) = rk2;                      \
    *(uint4*)ATT_KDST(3) = rk3; *(uint4*)ATT_KDST(4) = rk4; *(uint4*)ATT_KDST(5) = rk5;                      \
    *(uint4*)ATT_VDST(0) = rv0; *(uint4*)ATT_VDST(1) = rv1; *(uint4*)ATT_VDST(2) = rv2; *(uint4*)ATT_VDST(3) = rv3; \
  }
  __syncthreads();
  ATT_GLOAD(0)
  ATT_SWRITE()
  __syncthreads();
  for (int kt = 0; kt < nk; kt += 64) {
    const bool more = (kt + 64) < nk;
    if (more) ATT_GLOAD(kt + 64)
    f32x16 s0, s1;
#pragma unroll
    for (int r = 0; r < 16; ++r) { s0[r] = 0.f; s1[r] = 0.f; }
    const char* kp = Ks + l31 * ATT_KROW + lh * 16;
#pragma unroll
    for (int ks = 0; ks < 12; ++ks) {
      bf16x8 a0 = *(const bf16x8*)(kp + ks * 32);
      bf16x8 a1 = *(const bf16x8*)(kp + 32 * ATT_KROW + ks * 32);
      s0 = MFMA16(a0, qf[ks], s0);
      s1 = MFMA16(a1, qf[ks], s1);
    }
    float tmax = fmaxf(s0[0], s1[0]);
#pragma unroll
    for (int r = 1; r < 16; ++r) tmax = fmaxf(tmax, fmaxf(s0[r], s1[r]));
    tmax = fmaxf(tmax, __shfl_xor(tmax, 32));
    const float mn = fmaxf(m, tmax);
    const float alpha = exp2f(m - mn);
    float rs = 0.f;
#pragma unroll
    for (int r = 0; r < 16; ++r) { s0[r] = exp2f(s0[r] - mn); s1[r] = exp2f(s1[r] - mn); rs += s0[r] + s1[r]; }
    rs += __shfl_xor(rs, 32);
    l = l * alpha + rs;
    m = mn;
#pragma unroll
    for (int d = 0; d < 4; ++d)
#pragma unroll
      for (int r = 0; r < 16; ++r) o[d][r] *= alpha;
    bf16x8 pf[4];
    {
      uint4 t;
      t.x = pack_bf16(s0[0], s0[1]); t.y = pack_bf16(s0[2], s0[3]); t.z = pack_bf16(s0[4], s0[5]); t.w = pack_bf16(s0[6], s0[7]);
      pf[0] = __builtin_bit_cast(bf16x8, t);
      t.x = pack_bf16(s0[8], s0[9]); t.y = pack_bf16(s0[10], s0[11]); t.z = pack_bf16(s0[12], s0[13]); t.w = pack_bf16(s0[14], s0[15]);
      pf[1] = __builtin_bit_cast(bf16x8, t);
      t.x = pack_bf16(s1[0], s1[1]); t.y = pack_bf16(s1[2], s1[3]); t.z = pack_bf16(s1[4], s1[5]); t.w = pack_bf16(s1[6], s1[7]);
      pf[2] = __builtin_bit_cast(bf16x8, t);
      t.x = pack_bf16(s1[8], s1[9]); t.y = pack_bf16(s1[10], s1[11]); t.z = pack_bf16(s1[12], s1[13]); t.w = pack_bf16(s1[14], s1[15]);
      pf[3] = __builtin_bit_cast(bf16x8, t);
    }
    const char* vp = Vs + l31 * ATT_VROW + lh * 16;
#pragma unroll
    for (int g16 = 0; g16 < 4; ++g16) {
#pragma unroll
      for (int d = 0; d < 4; ++d) {
        bf16x8 a = *(const bf16x8*)(vp + d * 32 * ATT_VROW + g16 * 32);
        o[d] = MFMA16(a, pf[g16], o[d]);
      }
    }
    __syncthreads();
    if (more) ATT_SWRITE()
    __syncthreads();
  }
  const float inv = 1.f / l;
  float* tb = (float*)smem + wid * (32 * 129);
#pragma unroll
  for (int d = 0; d < 4; ++d)
#pragma unroll
    for (int r = 0; r < 16; ++r) tb[l31 * 129 + d * 32 + (r & 3) + 8 * (r >> 2) + 4 * lh] = o[d][r] * inv;
  __syncthreads();
  for (int i = lane; i < 32 * 32; i += 64) {
    const int q = i >> 5, c4 = i & 31;
    const float* s = tb + q * 129 + c4 * 4;
    *(float4*)(Op + (size_t)(wid * 32 + q) * 512 + c4 * 4) = make_float4(s[0], s[1], s[2], s[3]);
  }
  __syncthreads();
}

__device__ __forceinline__ int chunk_row0(int b, int cid) { return cid < 4 ? TLAT + b * CL + cid * 64 : b * SL + (cid - 4) * 64; }
__device__ __forceinline__ int step_of(int cid, int dir) { return dir == 0 ? cid : (cid < 4 ? 3 - cid : 71 - cid); }
__device__ __forceinline__ int cid_of(int s, int dir) { return dir == 0 ? s : (s < 4 ? 3 - s : 71 - s); }
#define MFMA32(a, b, c) __builtin_amdgcn_mfma_f32_32x32x2f32(a, b, c, 0, 0, 0)
#define ROW16(r, lh) (((r) & 3) + 8 * ((r) >> 2) + 4 * (lh))
__device__ __forceinline__ float wave_incl_scan(float v, int lane) {
#pragma unroll
  for (int o = 1; o < 64; o <<= 1) { float t = __shfl_up(v, o); if (lane >= o) v += t; }
  return v;
}

__device__ __forceinline__ void ssd_local_item(const P& p, int layer, int item, char* smem) {
  const int h = item & 7, cid = (item >> 3) % NSTEP, b = item / (8 * NSTEP);
  float* sx = (float*)smem;
  float* sB = sx + 4096;
  float* swf = sB + 64 * 129;
  float* swb = swf + 64;
  const int tid = threadIdx.x, lane = tid & 63, wid = tid >> 6, l31 = lane & 31, lh = lane >> 5;
  const int row0 = chunk_row0(b, cid), g = h >> 2;
  __syncthreads();
  for (int i = tid; i < 1024; i += 256) {
    int q = i >> 4, c4 = i & 15;
    *(float4*)(sx + q * 64 + c4 * 4) = *(const float4*)(p.ssd_xs() + (size_t)(row0 + q) * 512 + h * 64 + c4 * 4);
  }
  for (int i = tid; i < 2048; i += 256) {
    int q = i >> 5, c4 = i & 31;
    float4 v = *(const float4*)(p.ssd_B() + (size_t)(row0 + q) * 256 + g * 128 + c4 * 4);
    float* d = sB + q * 129 + c4 * 4;
    d[0] = v.x; d[1] = v.y; d[2] = v.z; d[3] = v.w;
  }
  if (wid < 2) {
    const int dir = wid;
    const float A = -expf(p.a_log[layer * 16 + dir * 8 + h]);
    const int q = dir ? 63 - lane : lane;
    const float dt = p.ssd_dt()[(size_t)(row0 + q) * 16 + dir * 8 + h];
    const float ac = wave_incl_scan(dt * A, lane);
    const float tot = __shfl(ac, 63);
    (dir ? swb : swf)[q] = expf(tot - ac) * dt;
    if (lane == 0) p.ssd_atot()[((b * 2 + dir) * 8 + h) * NSTEP + step_of(cid, dir)] = tot;
  }
  __syncthreads();
  f32x16 acc[2][2];
#pragma unroll
  for (int d = 0; d < 2; ++d)
#pragma unroll
    for (int t = 0; t < 2; ++t)
#pragma unroll
      for (int r = 0; r < 16; ++r) acc[d][t][r] = 0.f;
  const int pi = wid & 1, jj = wid >> 1;
#pragma unroll 4
  for (int k = 0; k < 64; k += 2) {
    const int q = k + lh;
    const float xa = sx[q * 64 + pi * 32 + l31];
    const float af = xa * swf[q], ab = xa * swb[q];
    const float b0 = sB[q * 129 + (2 * jj) * 32 + l31], b1 = sB[q * 129 + (2 * jj + 1) * 32 + l31];
    acc[0][0] = MFMA32(af, b0, acc[0][0]); acc[0][1] = MFMA32(af, b1, acc[0][1]);
    acc[1][0] = MFMA32(ab, b0, acc[1][0]); acc[1][1] = MFMA32(ab, b1, acc[1][1]);
  }
#pragma unroll
  for (int d = 0; d < 2; ++d) {
    float* dst = p.ssd_st() + ((size_t)((b * 2 + d) * 8 + h) * NSTEP + step_of(cid, d)) * 8192;
#pragma unroll
    for (int t = 0; t < 2; ++t)
#pragma unroll
      for (int r = 0; r < 16; ++r) dst[(pi * 32 + ROW16(r, lh)) * 128 + (2 * jj + t) * 32 + l31] = acc[d][t][r];
  }
}

__device__ __forceinline__ void ssd_out_item(const P& p, int layer, int item, char* smem) {
  const int h = item & 7, cid = (item >> 3) % NSTEP, b = item / (8 * NSTEP);
  float* sC = (float*)smem;
  float* sBh = sC + 64 * 129;
  float* sx = sBh + 64 * 129;
  float* sP = sx + 4096;
  float* saf = sP + 64 * 65;
  float* sab = saf + 64;
  float* sdf = sab + 64;
  float* sdb = sdf + 64;
  const int tid = threadIdx.x, lane = tid & 63, wid = tid >> 6, l31 = lane & 31, lh = lane >> 5;
  const int row0 = chunk_row0(b, cid), g = h >> 2;
  const float* hf = p.ssd_st() + ((size_t)((b * 2 + 0) * 8 + h) * NSTEP + step_of(cid, 0)) * 8192;
  const float* hb = p.ssd_st() + ((size_t)((b * 2 + 1) * 8 + h) * NSTEP + step_of(cid, 1)) * 8192;
  f32x4v hreg[8];
#pragma unroll
  for (int u = 0; u < 8; ++u) { const int i = tid + 256 * u; hreg[u] = *(const f32x4v*)(hf + (i >> 5) * 128 + (i & 31) * 4); }
  __syncthreads();
  for (int i = tid; i < 1024; i += 256) {
    int q = i >> 4, c4 = i & 15;
    *(float4*)(sx + q * 64 + c4 * 4) = *(const float4*)(p.ssd_xs() + (size_t)(row0 + q) * 512 + h * 64 + c4 * 4);
  }
  for (int i = tid; i < 2048; i += 256) {
    int q = i >> 5, c4 = i & 31;
    float4 v = *(const float4*)(p.ssd_B() + (size_t)(row0 + q) * 256 + g * 128 + c4 * 4);
    float* d = sBh + q * 129 + c4 * 4;
    d[0] = v.x; d[1] = v.y; d[2] = v.z; d[3] = v.w;
    float4 w = *(const float4*)(p.ssd_C() + (size_t)(row0 + q) * 256 + g * 128 + c4 * 4);
    float* e = sC + q * 129 + c4 * 4;
    e[0] = w.x; e[1] = w.y; e[2] = w.z; e[3] = w.w;
  }
  if (wid < 2) {
    const int dir = wid;
    const float A = -expf(p.a_log[layer * 16 + dir * 8 + h]);
    const int q = dir ? 63 - lane : lane;
    const float dt = p.ssd_dt()[(size_t)(row0 + q) * 16 + dir * 8 + h];
    const float ac = wave_incl_scan(dt * A, lane);
    (dir ? sab : saf)[q] = ac;
    (dir ? sdb : sdf)[q] = dt;
  }
  __syncthreads();
  const int it = wid >> 1, jt = wid & 1;
  {
    f32x16 sa;
#pragma unroll
    for (int r = 0; r < 16; ++r) sa[r] = 0.f;
    const float* ap = sC + (it * 32 + l31) * 129 + lh;
    const float* bp = sBh + (jt * 32 + l31) * 129 + lh;
#pragma unroll 8
    for (int k = 0; k < 128; k += 2) sa = MFMA32(ap[k], bp[k], sa);
    const int j = jt * 32 + l31;
    const float afj = saf[j], abj = sab[j], dfj = sdf[j], dbj = sdb[j];
#pragma unroll
    for (int r = 0; r < 16; ++r) {
      const int i = it * 32 + ROW16(r, lh);
      float wgt = 0.f;
      if (j <= i) wgt += expf(saf[i] - afj) * dfj;
      if (j >= i) wgt += expf(sab[i] - abj) * dbj;
      sP[i * 65 + j] = sa[r] * wgt;
    }
  }
  __syncthreads();
#pragma unroll
  for (int u = 0; u < 8; ++u) {
    const int i = tid + 256 * u, q = i >> 5, c4 = i & 31;
    float* d = sBh + q * 129 + c4 * 4;
    d[0] = hreg[u][0]; d[1] = hreg[u][1]; d[2] = hreg[u][2]; d[3] = hreg[u][3];
  }
#pragma unroll
  for (int u = 0; u < 8; ++u) { const int i = tid + 256 * u; hreg[u] = *(const f32x4v*)(hb + (i >> 5) * 128 + (i & 31) * 4); }
  const int pt = wid & 1;
  f32x16 ya;
#pragma unroll
  for (int r = 0; r < 16; ++r) ya[r] = 0.f;
  {
    const float* ap = sP + (it * 32 + l31) * 65 + lh;
    const float* bp = sx + lh * 64 + pt * 32 + l31;
#pragma unroll 8
    for (int k = 0; k < 64; k += 2) ya = MFMA32(ap[k], bp[k * 64], ya);
  }
  __syncthreads();
  {
    const float ef = expf(saf[it * 32 + l31]);
    const float* ap = sC + (it * 32 + l31) * 129 + lh;
    const float* bp = sBh + (pt * 32 + l31) * 129 + lh;
#pragma unroll 8
    for (int k = 0; k < 128; k += 2) ya = MFMA32(ap[k] * ef, bp[k], ya);
  }
  __syncthreads();
#pragma unroll
  for (int u = 0; u < 8; ++u) {
    const int i = tid + 256 * u, q = i >> 5, c4 = i & 31;
    float* d = sBh + q * 129 + c4 * 4;
    d[0] = hreg[u][0]; d[1] = hreg[u][1]; d[2] = hreg[u][2]; d[3] = hreg[u][3];
  }
  __syncthreads();
  {
    const float eb = expf(sab[it * 32 + l31]);
    const float* ap = sC + (it * 32 + l31) * 129 + lh;
    const float* bp = sBh + (pt * 32 + l31) * 129 + lh;
#pragma unroll 8
    for (int k = 0; k < 128; k += 2) ya = MFMA32(ap[k] * eb, bp[k], ya);
  }
#pragma unroll
  for (int r = 0; r < 16; ++r)
    p.ssd_y()[(size_t)(row0 + it * 32 + ROW16(r, lh)) * 512 + h * 64 + pt * 32 + l31] = ya[r];
}

__device__ __forceinline__ void ml_gates(const P& p, int layer, int row0, int h, int dir, int lane, float& bcum, float& li, float& tot) {
  const int j = dir ? 63 - lane : lane;
  const float* z = p.Z() + (size_t)(row0 + j) * NIN + ZC_MG + dir * 8;
  li = z[h] + p.gate_b[layer * 16 + dir * 8 + h];
  const float gf = z[4 + h] + p.gate_b[layer * 16 + dir * 8 + 4 + h];
  const float lf = gf >= 0.f ? -log1pf(expf(-gf)) : gf - log1pf(expf(gf));
  bcum = wave_incl_scan(lf, lane);
  tot = __shfl(bcum, 63);
}
__device__ __forceinline__ void ml_local_item(const P& p, int layer, int item, char* smem) {
  const int h = item & 3, cid = (item >> 2) % NSTEP, b = item / (4 * NSTEP);
  float* sv = (float*)smem;
  float* sk = sv + 8192;
  float* swf = sk + 64 * 65;
  float* swb = swf + 64;
  const int tid = threadIdx.x, lane = tid & 63, wid = tid >> 6, l31 = lane & 31, lh = lane >> 5;
  const int row0 = chunk_row0(b, cid);
  __syncthreads();
  for (int i = tid; i < 2048; i += 256) {
    int j = i >> 5, c4 = i & 31;
    *(float4*)(sv + j * 128 + c4 * 4) = *(const float4*)(p.Z() + (size_t)(row0 + j) * NIN + ZC_MV + h * 128 + c4 * 4);
  }
  for (int i = tid; i < 1024; i += 256) {
    int j = i >> 4, c4 = i & 15;
    float4 v = *(const float4*)(p.Z() + (size_t)(row0 + j) * NIN + ZC_MK + h * 64 + c4 * 4);
    float* d = sk + j * 65 + c4 * 4;
    d[0] = v.x; d[1] = v.y; d[2] = v.z; d[3] = v.w;
  }
  if (wid < 2) {
    const int dir = wid;
    float bc, li, tot;
    ml_gates(p, layer, row0, h, dir, lane, bc, li, tot);
    const int j = dir ? 63 - lane : lane;
    (dir ? swb : swf)[j] = expf(tot - bc + li);
    if (lane == 0) p.ml_gtot()[((b * 2 + dir) * 4 + h) * NSTEP + step_of(cid, dir)] = tot;
  }
  __syncthreads();
  f32x16 acc[2][2];
#pragma unroll
  for (int d = 0; d < 2; ++d)
#pragma unroll
    for (int t = 0; t < 2; ++t)
#pragma unroll
      for (int r = 0; r < 16; ++r) acc[d][t][r] = 0.f;
  const int vt = wid;
#pragma unroll 4
  for (int k = 0; k < 64; k += 2) {
    const int j = k + lh;
    const float va = sv[j * 128 + vt * 32 + l31];
    const float af = va * swf[j], ab = va * swb[j];
    const float b0 = sk[j * 65 + l31], b1 = sk[j * 65 + 32 + l31];
    acc[0][0] = MFMA32(af, b0, acc[0][0]); acc[0][1] = MFMA32(af, b1, acc[0][1]);
    acc[1][0] = MFMA32(ab, b0, acc[1][0]); acc[1][1] = MFMA32(ab, b1, acc[1][1]);
  }
#pragma unroll
  for (int d = 0; d < 2; ++d) {
    float* dst = p.ml_st() + ((size_t)((b * 2 + d) * 4 + h) * NSTEP + step_of(cid, d)) * 8192;
#pragma unroll
    for (int t = 0; t < 2; ++t)
#pragma unroll
      for (int r = 0; r < 16; ++r) dst[(vt * 32 + ROW16(r, lh)) * 64 + t * 32 + l31] = acc[d][t][r];
  }
  if (tid < 128) {
    const int d = tid >> 6, kk = tid & 63;
    const float* w = d ? swb : swf;
    float sacc = 0.f;
    for (int j = 0; j < 64; ++j) sacc += w[j] * sk[j * 65 + kk];
    p.ml_nst()[((size_t)((b * 2 + d) * 4 + h) * NSTEP + step_of(cid, d)) * 64 + kk] = sacc;
  }
}

__device__ __forceinline__ void ml_out_item(const P& p, int layer, int item, char* smem) {
  const int h = item & 3, cid = (item >> 2) % NSTEP, b = item / (4 * NSTEP);
  float* sq = (float*)smem;
  float* sk = sq + 64 * 65;
  float* sv = sk + 64 * 65;
  float* sPf = sv + 128 * 65;
  float* sPb = sPf + 64 * 65;
  float* sbf = sPb + 64 * 65;
  float* sbb = sbf + 64;
  float* slf = sbb + 64;
  float* slb = slf + 64;
  float* sdenf = slb + 64;
  float* sdenb = sdenf + 64;
  float* snf = sdenb + 64;
  float* snb = snf + 64;
  const int tid = threadIdx.x, lane = tid & 63, wid = tid >> 6, l31 = lane & 31, lh = lane >> 5;
  const int row0 = chunk_row0(b, cid);
  const size_t slotf = ((size_t)((b * 2 + 0) * 4 + h) * NSTEP + step_of(cid, 0));
  const size_t slotb = ((size_t)((b * 2 + 1) * 4 + h) * NSTEP + step_of(cid, 1));
  const float* csf = p.ml_st() + slotf * 8192;
  const float* csb = p.ml_st() + slotb * 8192;
  f32x4v creg[8];
#pragma unroll
  for (int u = 0; u < 8; ++u) { const int i = tid + 256 * u; creg[u] = *(const f32x4v*)(csf + (i >> 4) * 64 + (i & 15) * 4); }
  __syncthreads();
  for (int i = tid; i < 2048; i += 256) {
    int j = i >> 5, c4 = i & 31;
    *(float4*)(sv + j * 128 + c4 * 4) = *(const float4*)(p.Z() + (size_t)(row0 + j) * NIN + ZC_MV + h * 128 + c4 * 4);
  }
  for (int i = tid; i < 1024; i += 256) {
    int j = i >> 4, c4 = i & 15;
    float4 v = *(const float4*)(p.Z() + (size_t)(row0 + j) * NIN + ZC_MK + h * 64 + c4 * 4);
    float* d = sk + j * 65 + c4 * 4;
    d[0] = v.x; d[1] = v.y; d[2] = v.z; d[3] = v.w;
    float4 w = *(const float4*)(p.Z() + (size_t)(row0 + j) * NIN + ZC_MQ + h * 64 + c4 * 4);
    float* e = sq + j * 65 + c4 * 4;
    e[0] = w.x * 0.125f; e[1] = w.y * 0.125f; e[2] = w.z * 0.125f; e[3] = w.w * 0.125f;
  }
  if (wid < 2) {
    const int dir = wid;
    float bc, li, tot;
    ml_gates(p, layer, row0, h, dir, lane, bc, li, tot);
    const int j = dir ? 63 - lane : lane;
    (dir ? sbb : sbf)[j] = bc;
    (dir ? slb : slf)[j] = li;
    (dir ? snb : snf)[lane] = p.ml_nst()[(dir ? slotb : slotf) * 64 + lane];
  }
  __syncthreads();
  const int it = wid >> 1, jt = wid & 1;
  {
    f32x16 sa;
#pragma unroll
    for (int r = 0; r < 16; ++r) sa[r] = 0.f;
    const float* ap = sq + (it * 32 + l31) * 65 + lh;
    const float* bp = sk + (jt * 32 + l31) * 65 + lh;
#pragma unroll 8
    for (int k = 0; k < 64; k += 2) sa = MFMA32(ap[k], bp[k], sa);
    const int j = jt * 32 + l31;
    const float bfj = sbf[j], bbj = sbb[j], lfj = slf[j], lbj = slb[j];
#pragma unroll
    for (int r = 0; r < 16; ++r) {
      const int i = it * 32 + ROW16(r, lh);
      sPf[i * 65 + j] = j <= i ? sa[r] * expf(sbf[i] - bfj + lfj) : 0.f;
      sPb[i * 65 + j] = j >= i ? sa[r] * expf(sbb[i] - bbj + lbj) : 0.f;
    }
  }
  __syncthreads();
  if (tid < 128) {
    const int d = tid >> 6, i = tid & 63;
    const float* Pm = d ? sPb : sPf;
    const float* ns = d ? snb : snf;
    float rs = 0.f, qn = 0.f;
    for (int j = 0; j < 64; ++j) { rs += Pm[i * 65 + j]; qn += sq[i * 65 + j] * ns[j]; }
    (d ? sdenb : sdenf)[i] = rs + expf((d ? sbb : sbf)[i]) * qn;
  }
  const int v0 = 2 * (wid & 1);
  f32x16 nf[2], nb[2];
#pragma unroll
  for (int t = 0; t < 2; ++t)
#pragma unroll
    for (int r = 0; r < 16; ++r) { nf[t][r] = 0.f; nb[t][r] = 0.f; }
  {
    const float* apf = sPf + (it * 32 + l31) * 65 + lh;
    const float* apb = sPb + (it * 32 + l31) * 65 + lh;
    const float* bp = sv + lh * 128 + v0 * 32 + l31;
#pragma unroll 4
    for (int k = 0; k < 64; k += 2) {
      const float af = apf[k], ab = apb[k], b0 = bp[k * 128], b1 = bp[k * 128 + 32];
      nf[0] = MFMA32(af, b0, nf[0]); nf[1] = MFMA32(af, b1, nf[1]);
      nb[0] = MFMA32(ab, b0, nb[0]); nb[1] = MFMA32(ab, b1, nb[1]);
    }
  }
  __syncthreads();
#pragma unroll
  for (int u = 0; u < 8; ++u) {
    const int i = tid + 256 * u, v = i >> 4, c4 = i & 15;
    float* d = sv + v * 65 + c4 * 4;
    d[0] = creg[u][0]; d[1] = creg[u][1]; d[2] = creg[u][2]; d[3] = creg[u][3];
  }
#pragma unroll
  for (int u = 0; u < 8; ++u) { const int i = tid + 256 * u; creg[u] = *(const f32x4v*)(csb + (i >> 4) * 64 + (i & 15) * 4); }
  __syncthreads();
  {
    const float e = expf(sbf[it * 32 + l31]);
    const float* ap = sq + (it * 32 + l31) * 65 + lh;
    const float* bp = sv + (v0 * 32 + l31) * 65 + lh;
#pragma unroll 4
    for (int k = 0; k < 64; k += 2) {
      const float a = ap[k] * e;
      nf[0] = MFMA32(a, bp[k], nf[0]); nf[1] = MFMA32(a, bp[32 * 65 + k], nf[1]);
    }
  }
  __syncthreads();
#pragma unroll
  for (int u = 0; u < 8; ++u) {
    const int i = tid + 256 * u, v = i >> 4, c4 = i & 15;
    float* d = sv + v * 65 + c4 * 4;
    d[0] = creg[u][0]; d[1] = creg[u][1]; d[2] = creg[u][2]; d[3] = creg[u][3];
  }
  __syncthreads();
  {
    const float e = expf(sbb[it * 32 + l31]);
    const float* ap = sq + (it * 32 + l31) * 65 + lh;
    const float* bp = sv + (v0 * 32 + l31) * 65 + lh;
#pragma unroll 4
    for (int k = 0; k < 64; k += 2) {
      const float a = ap[k] * e;
      nb[0] = MFMA32(a, bp[k], nb[0]); nb[1] = MFMA32(a, bp[32 * 65 + k], nb[1]);
    }
  }
#pragma unroll
  for (int r = 0; r < 16; ++r) {
    const int i = it * 32 + ROW16(r, lh);
    const float idf = 1.f / fmaxf(fabsf(sdenf[i]), 1.f), idb = 1.f / fmaxf(fabsf(sdenb[i]), 1.f);
#pragma unroll
    for (int t = 0; t < 2; ++t)
      p.ml_h()[(size_t)(row0 + i) * 512 + h * 128 + (v0 + t) * 32 + l31] = nf[t][r] * idf + nb[t][r] * idb;
  }
}

template <int MODE>
__device__ __forceinline__ void s5_wave_item(const P& p, int layer, int witem, char* smem) {
  const int tid = threadIdx.x, lane = tid & 63, wid = tid >> 6;
  float* su = (float*)smem + wid * 3136;
  float* sX = su + 1024;
  const int g = witem & 31, st = (witem >> 5) % NSTEP, dir = (witem / (32 * NSTEP)) & 1, b = witem / (64 * NSTEP);
  const int cid = cid_of(st, dir), row0 = chunk_row0(b, cid);
  const int dg = (layer * 2 + dir) * 32 + g;
  const float ar = p.s5_a()[(dg * 64 + lane) * 2], ai = p.s5_a()[(dg * 64 + lane) * 2 + 1];
  float bbr[16], bbi[16];
  {
    const float4* bt = (const float4*)(p.s5_bb() + (size_t)(dg * 64 + lane) * 32);
#pragma unroll
    for (int c4 = 0; c4 < 4; ++c4) {
      float4 v = bt[c4]; bbr[c4 * 4] = v.x; bbr[c4 * 4 + 1] = v.y; bbr[c4 * 4 + 2] = v.z; bbr[c4 * 4 + 3] = v.w;
      float4 w = bt[4 + c4]; bbi[c4 * 4] = w.x; bbi[c4 * 4 + 1] = w.y; bbi[c4 * 4 + 2] = w.z; bbi[c4 * 4 + 3] = w.w;
    }
  }
#pragma unroll
  for (int q = 0; q < 4; ++q) {
    const int t = q * 16 + (lane >> 2), c4 = lane & 3;
    const int row = dir ? row0 + 63 - t : row0 + t;
    *(float4*)(su + t * 16 + c4 * 4) = *(const float4*)(p.Z() + (size_t)row * NIN + ZC_U + g * 16 + c4 * 4);
  }
  const size_t slot = ((size_t)((b * 2 + dir) * 32 + g) * NSTEP + st);
  float xr = 0.f, xi = 0.f;
  float cm[32];
  if (MODE == 1) {
    xr = p.s5_st()[(slot * 64 + lane) * 2]; xi = p.s5_st()[(slot * 64 + lane) * 2 + 1];
    const int c = lane & 15, kq = lane >> 4;
#pragma unroll
    for (int ks = 0; ks < 32; ++ks) {
      const int pp = 4 * ks + kq;
      cm[ks] = ks < 16 ? p.c_re[((size_t)(layer * 32 + g) * 16 + c) * 64 + pp] : -p.c_im[((size_t)(layer * 32 + g) * 16 + c) * 64 + pp - 64];
    }
  }
  float* rout = dir ? p.s5_rb() : p.s5_rf();
#pragma unroll 1
  for (int sb = 0; sb < 4; ++sb) {
#pragma unroll 4
    for (int tt = 0; tt < 16; ++tt) {
      const int t = sb * 16 + tt;
      float ur = 0.f, ui = 0.f;
#pragma unroll
      for (int c4 = 0; c4 < 4; ++c4) {
        float4 uu = *(const float4*)(su + t * 16 + c4 * 4);
        ur += bbr[c4 * 4] * uu.x + bbr[c4 * 4 + 1] * uu.y + bbr[c4 * 4 + 2] * uu.z + bbr[c4 * 4 + 3] * uu.w;
        ui += bbi[c4 * 4] * uu.x + bbi[c4 * 4 + 1] * uu.y + bbi[c4 * 4 + 2] * uu.z + bbi[c4 * 4 + 3] * uu.w;
      }
      const float nr = ar * xr - ai * xi + ur;
      const float ni = ar * xi + ai * xr + ui;
      xr = nr; xi = ni;
      if (MODE == 1) { sX[tt * 130 + lane] = xr; sX[tt * 130 + 64 + lane] = xi; }
    }
    if (MODE == 1) {
      f32x4v d0 = {0.f, 0.f, 0.f, 0.f}, d1 = {0.f, 0.f, 0.f, 0.f};
      const float* ap = sX + (lane & 15) * 130 + (lane >> 4);
#pragma unroll
      for (int ks = 0; ks < 32; ks += 2) {
        d0 = __builtin_amdgcn_mfma_f32_16x16x4f32(ap[4 * ks], cm[ks], d0, 0, 0, 0);
        d1 = __builtin_amdgcn_mfma_f32_16x16x4f32(ap[4 * ks + 4], cm[ks + 1], d1, 0, 0, 0);
      }
#pragma unroll
      for (int r = 0; r < 4; ++r) {
        const int t = sb * 16 + (lane >> 4) * 4 + r;
        const int row = dir ? row0 + 63 - t : row0 + t;
        rout[(size_t)row * 512 + g * 16 + (lane & 15)] = d0[r] + d1[r];
      }
    }
  }
  if (MODE == 0) { p.s5_st()[(slot * 64 + lane) * 2] = xr; p.s5_st()[(slot * 64 + lane) * 2 + 1] = xi; }
}

#define N_SSD_CH (2 * NSTEP * 8)
#define N_ML_CH (2 * NSTEP * 4)
#define N_S5_BLK (2 * 2 * NSTEP * 32 / 4)
__device__ __forceinline__ void ph_mixA(const P& p, int layer, int bid, char* smem) {
  for (int w = bid; w < N_SSD_CH + N_ML_CH + N_S5_BLK; w += gridDim.x) {
    if (w < N_SSD_CH) ssd_local_item(p, layer, w, smem);
    else if (w < N_SSD_CH + N_ML_CH) ml_local_item(p, layer, w - N_SSD_CH, smem);
    else { __syncthreads(); s5_wave_item<0>(p, layer, (w - N_SSD_CH - N_ML_CH) * 4 + (threadIdx.x >> 6), smem); }
  }
}
#define N_ATT_LAT 256
#define N_ATT_CTX 16
__device__ __forceinline__ void ph_mixB(const P& p, int layer, int bid, char* smem) {
  const int natt = 0;
  const int nitems = natt + 256 + 128 + 4 + 32;
  const int tid = threadIdx.x;
  for (int w = bid; w < nitems; w += gridDim.x) {
    int it = w;
    if (it < natt) {
      const bfraw *qp, *kp, *vp; float* op; int nk;
      if (it < N_ATT_LAT) {
        int qb = it & 31, hh = (it >> 5) & 3, b = it >> 7;
        qp = p.Q() + ((size_t)(b * 4 + hh) * SL + qb * 128) * 192; kp = p.K() + (size_t)(b * 4 + hh) * NKEY * 192;
        vp = p.V() + (size_t)(b * 4 + hh) * 128 * NKEY; nk = NKEY; op = p.O() + (size_t)(b * SL + qb * 128) * 512 + hh * 128;
      } else {
        it -= N_ATT_LAT;
        int qb = it & 1, hh = (it >> 1) & 3, b = it >> 3;
        qp = p.Qc() + ((size_t)(b * 4 + hh) * CL + qb * 128) * 192; kp = p.K() + ((size_t)(b * 4 + hh) * NKEY + SL) * 192;
        vp = p.V() + (size_t)(b * 4 + hh) * 128 * NKEY + SL; nk = CL; op = p.O() + (size_t)(TLAT + b * CL + qb * 128) * 512 + hh * 128;
      }
      attn_item(qp, kp, vp, nk, op, smem);
      continue;
    }
    it -= natt;
    if (it < 256) {
      const int idx = it * 256 + tid, seq = idx >> 11, off = idx & 2047;
      float4* base = (float4*)(p.ssd_st() + (size_t)seq * NSTEP * 8192) + off;
      const float* at = p.ssd_atot() + seq * NSTEP;
      float4 hh = make_float4(0.f, 0.f, 0.f, 0.f);
#pragma unroll 4
      for (int s2 = 0; s2 < NSTEP; ++s2) {
        float4 t = base[(size_t)s2 * 2048];
        base[(size_t)s2 * 2048] = hh;
        const float e = expf(at[s2]);
        hh.x = e * hh.x + t.x; hh.y = e * hh.y + t.y; hh.z = e * hh.z + t.z; hh.w = e * hh.w + t.w;
      }
      continue;
    }
    it -= 256;
    if (it < 128) {
      const int idx = it * 256 + tid, seq = idx >> 11, off = idx & 2047;
      float4* base = (float4*)(p.ml_st() + (size_t)seq * NSTEP * 8192) + off;
      const float* at = p.ml_gtot() + seq * NSTEP;
      float4 hh = make_float4(0.f, 0.f, 0.f, 0.f);
#pragma unroll 4
      for (int s2 = 0; s2 < NSTEP; ++s2) {
        float4 t = base[(size_t)s2 * 2048];
        base[(size_t)s2 * 2048] = hh;
        const float e = expf(at[s2]);
        hh.x = e * hh.x + t.x; hh.y = e * hh.y + t.y; hh.z = e * hh.z + t.z; hh.w = e * hh.w + t.w;
      }
      continue;
    }
    it -= 128;
    if (it < 4) {
      const int idx = it * 256 + tid, seq = idx >> 6, off = idx & 63;
      float* base = p.ml_nst() + (size_t)seq * NSTEP * 64 + off;
      const float* at = p.ml_gtot() + seq * NSTEP;
      float hh = 0.f;
      for (int s2 = 0; s2 < NSTEP; ++s2) {
        float t = base[s2 * 64]; base[s2 * 64] = hh;
        hh = expf(at[s2]) * hh + t;
      }
      continue;
    }
    it -= 4;
    {
      const int idx = it * 256 + tid, seq = idx >> 6, sp = idx & 63;
      const int g = seq & 31, dir = (seq >> 5) & 1;
      const int dg = (layer * 2 + dir) * 32 + g;
      float pr = p.s5_a()[(dg * 64 + sp) * 2], pi = p.s5_a()[(dg * 64 + sp) * 2 + 1];
#pragma unroll
      for (int q = 0; q < 6; ++q) { float nr = pr * pr - pi * pi, ni = 2.f * pr * pi; pr = nr; pi = ni; }
      float* base = p.s5_st() + ((size_t)seq * NSTEP * 64 + sp) * 2;
      float xr = 0.f, xi = 0.f;
      for (int s2 = 0; s2 < NSTEP; ++s2) {
        float tr = base[s2 * 128], ti = base[s2 * 128 + 1];
        base[s2 * 128] = xr; base[s2 * 128 + 1] = xi;
        float nr = pr * xr - pi * xi + tr, ni = pr * xi + pi * xr + ti;
        xr = nr; xi = ni;
      }
    }
  }
}
__device__ __forceinline__ void ph_attn_only(const P& p, int layer, int bid, char* smem) {
  const int natt = N_ATT_LAT + (layer == 0 ? N_ATT_CTX : 0);
  for (int w = bid; w < natt; w += gridDim.x) {
    int it = w;
    const bfraw *qp, *kp, *vp; float* op; int nk;
    if (it < N_ATT_LAT) {
      int qb = it & 31, hh = (it >> 5) & 3, b = it >> 7;
      qp = p.Q() + ((size_t)(b * 4 + hh) * SL + qb * 128) * 192; kp = p.K() + (size_t)(b * 4 + hh) * NKEY * 192;
      vp = p.V() + (size_t)(b * 4 + hh) * 128 * NKEY; nk = NKEY; op = p.O() + (size_t)(b * SL + qb * 128) * 512 + hh * 128;
    } else {
      it -= N_ATT_LAT;
      int qb = it & 1, hh = (it >> 1) & 3, b = it >> 3;
      qp = p.Qc() + ((size_t)(b * 4 + hh) * CL + qb * 128) * 192; kp = p.K() + ((size_t)(b * 4 + hh) * NKEY + SL) * 192;
      vp = p.V() + (size_t)(b * 4 + hh) * 128 * NKEY + SL; nk = CL; op = p.O() + (size_t)(TLAT + b * CL + qb * 128) * 512 + hh * 128;
    }
    attn_item(qp, kp, vp, nk, op, smem);
  }
}
__device__ __forceinline__ void ph_mixC(const P& p, int layer, int bid, char* smem) {
  for (int w = bid; w < N_SSD_CH + N_ML_CH + N_S5_BLK; w += gridDim.x) {
    if (w < N_SSD_CH) ssd_out_item(p, layer, w, smem);
    else if (w < N_SSD_CH + N_ML_CH) ml_out_item(p, layer, w - N_SSD_CH, smem);
    else { __syncthreads(); s5_wave_item<1>(p, layer, (w - N_SSD_CH - N_ML_CH) * 4 + (threadIdx.x >> 6), smem); }
  }
}

__device__ __forceinline__ float gelu_tanh(float x) {
  const float k0 = 0.7978845608028654f;
  return 0.5f * x * (1.f + tanhf(k0 * (x + 0.044715f * x * x * x)));
}
__device__ __forceinline__ void ph_s5pre(const P& p, int layer, int bid, char* smem) {
  const int n4 = TTOT * 128;
  for (int i = bid * 256 + threadIdx.x; i < n4; i += gridDim.x * 256) {
    const int r = i >> 7, c = (i & 127) * 4;
    const f32x4v u = *(const f32x4v*)(p.Z() + (size_t)r * NIN + ZC_U + c);
    const f32x4v rf = *(const f32x4v*)(p.s5_rf() + (size_t)i * 4), rb = *(const f32x4v*)(p.s5_rb() + (size_t)i * 4);
    const f32x4v d = *(const f32x4v*)(p.s5_d + layer * 512 + c);
    const f32x4v y = rf + rb + d * u;
    f32x4v g; g[0] = gelu_tanh(y[0]); g[1] = gelu_tanh(y[1]); g[2] = gelu_tanh(y[2]); g[3] = gelu_tanh(y[3]);
    *(f32x4v*)(p.ydpre() + (size_t)i * 4) = g;
    uint2 gb; gb.x = pack_bf16(g[0], g[1]); gb.y = pack_bf16(g[2], g[3]);
    *(uint2*)(p.ydpre_bf() + (size_t)i * 4) = gb;
  }
}
__device__ __forceinline__ void ph_glu(const P& p, int layer, int bid, char* smem) {
  const float* yp = p.ydpre(); float* yg = p.ydg(); const float* gb = p.glu_b + layer * 512;
  auto epi = [=](int row, int col, float v) {
    float y = yp[(size_t)row * 512 + col];
    yg[(size_t)row * 512 + col] = y * sigmoidf_(v + gb[col]);
  };
  gemm_dense<4>(p.ydpre_bf(), 512, p.glu_w + (size_t)layer * 512 * 512, 512, TTOT, 512, 512, epi, bid, smem);
}

__device__ __forceinline__ void ph_final_mix(const P& p, int layer, int bid, char* smem) {
  const int tid = threadIdx.x, lane = tid & 63, wid = tid >> 6;
  const float* onw = p.out_norm_w + layer * 2048;
  for (int r = bid * 4 + wid; r < TTOT; r += gridDim.x * 4) {
    const float* z = p.Z() + (size_t)r * NIN;
    bfraw* Y = p.Y() + (size_t)r * LDH;
    const int c = lane * 8;
    f32x4v a0 = *(const f32x4v*)(p.O() + (size_t)r * 512 + c), a1 = *(const f32x4v*)(p.O() + (size_t)r * 512 + c + 4);
    f32x4v y0 = *(const f32x4v*)(p.ssd_y() + (size_t)r * 512 + c), y1 = *(const f32x4v*)(p.ssd_y() + (size_t)r * 512 + c + 4);
    f32x4v x0 = *(const f32x4v*)(p.ssd_xs() + (size_t)r * 512 + c), x1 = *(const f32x4v*)(p.ssd_xs() + (size_t)r * 512 + c + 4);
    f32x4v g0 = *(const f32x4v*)(z + ZC_BZ + c), g1 = *(const f32x4v*)(z + ZC_BZ + c + 4);
    f32x4v h0 = *(const f32x4v*)(p.ml_h() + (size_t)r * 512 + c), h1 = *(const f32x4v*)(p.ml_h() + (size_t)r * 512 + c + 4);
    f32x4v o0 = *(const f32x4v*)(z + ZC_MO + c), o1 = *(const f32x4v*)(z + ZC_MO + c + 4);
    f32x4v d0 = *(const f32x4v*)(p.ydg() + (size_t)r * 512 + c), d1 = *(const f32x4v*)(p.ydg() + (size_t)r * 512 + c + 4);
    const float dsk = p.ssd_d[layer * 8 + (c >> 6)];
    float sa = 0.f, sb = 0.f, sc = 0.f, sd = 0.f;
    float bv[8], av[8], cv[8], dv[8];
#pragma unroll
    for (int i = 0; i < 4; ++i) {
      av[i] = a0[i]; av[4 + i] = a1[i];
      bv[i] = (y0[i] + dsk * x0[i]) * siluf_(g0[i]); bv[4 + i] = (y1[i] + dsk * x1[i]) * siluf_(g1[i]);
      cv[i] = h0[i]; cv[4 + i] = h1[i];
      dv[i] = d0[i]; dv[4 + i] = d1[i];
    }
#pragma unroll
    for (int i = 0; i < 8; ++i) { sa += av[i] * av[i]; sb += bv[i] * bv[i]; sc += cv[i] * cv[i]; sd += dv[i] * dv[i]; }
    sa = wave_sum(sa); sb = wave_sum(sb); sd = wave_sum(sd);
    sc += __shfl_xor(sc, 1); sc += __shfl_xor(sc, 2); sc += __shfl_xor(sc, 4); sc += __shfl_xor(sc, 8);
    const float ra = rsqrtf(sa * (1.f / 512.f) + EPSV), rb = rsqrtf(sb * (1.f / 512.f) + EPSV);
    const float rc = rsqrtf(sc * (1.f / 128.f) + EPSV), rd = rsqrtf(sd * (1.f / 512.f) + EPSV);
    float ogv[8];
#pragma unroll
    for (int i = 0; i < 4; ++i) { ogv[i] = sigmoidf_(o0[i]); ogv[4 + i] = sigmoidf_(o1[i]); }
    uint4 ua, ub, uc, ud;
    const float* w = onw + c;
    ua.x = pack_bf16(av[0] * ra * w[0], av[1] * ra * w[1]); ua.y = pack_bf16(av[2] * ra * w[2], av[3] * ra * w[3]);
    ua.z = pack_bf16(av[4] * ra * w[4], av[5] * ra * w[5]); ua.w = pack_bf16(av[6] * ra * w[6], av[7] * ra * w[7]);
    w = onw + 512 + c;
    ub.x = pack_bf16(bv[0] * rb * w[0], bv[1] * rb * w[1]); ub.y = pack_bf16(bv[2] * rb * w[2], bv[3] * rb * w[3]);
    ub.z = pack_bf16(bv[4] * rb * w[4], bv[5] * rb * w[5]); ub.w = pack_bf16(bv[6] * rb * w[6], bv[7] * rb * w[7]);
    w = onw + 1024 + c;
    uc.x = pack_bf16(cv[0] * rc * ogv[0] * w[0], cv[1] * rc * ogv[1] * w[1]); uc.y = pack_bf16(cv[2] * rc * ogv[2] * w[2], cv[3] * rc * ogv[3] * w[3]);
    uc.z = pack_bf16(cv[4] * rc * ogv[4] * w[4], cv[5] * rc * ogv[5] * w[5]); uc.w = pack_bf16(cv[6] * rc * ogv[6] * w[6], cv[7] * rc * ogv[7] * w[7]);
    w = onw + 1536 + c;
    ud.x = pack_bf16(dv[0] * rd * w[0], dv[1] * rd * w[1]); ud.y = pack_bf16(dv[2] * rd * w[2], dv[3] * rd * w[3]);
    ud.z = pack_bf16(dv[4] * rd * w[4], dv[5] * rd * w[5]); ud.w = pack_bf16(dv[6] * rd * w[6], dv[7] * rd * w[7]);
    *(uint4*)(Y + c) = ua; *(uint4*)(Y + 512 + c) = ub; *(uint4*)(Y + 1024 + c) = uc; *(uint4*)(Y + 1536 + c) = ud;
  }
}

__device__ __forceinline__ void ph_wout(const P& p, int layer, int bid, char* smem) {
  const P pp = p;
  const int M = layer == 0 ? TTOT : TLAT;
  auto epi = [=](int row, int col, float v) {
    const int mi = row_modidx(row);
    const float g1 = pp.modv()[(layer * 3 + mi) * 12288 + 2 * 2048 + col];
    float xin;
    if (layer == 0) xin = row < TLAT ? pp.x[(size_t)row * 2048 + col] : pp.ctx[(size_t)(row - TLAT) * 2048 + col];
    else xin = pp.X()[(size_t)row * 2048 + col];
    pp.X()[(size_t)row * 2048 + col] = xin + g1 * v;
  };
  gemm_dense<4>(p.Y(), LDH, p.w_out + (size_t)layer * 2048 * 2048, 2048, M, 2048, 2048, epi, bid, smem);
}

__device__ __forceinline__ void ph_router(const P& p, int layer, int bid, char* smem) {
  float* sA = (float*)smem;
  float* sW = sA + 32 * 129;
  float* sNW = sW + 128 * 64;
  float* sSH = sNW + 2048;
  float* srs = sSH + 2048;
  float* sL = srs + 32;
  const int tid = threadIdx.x, lane = tid & 63, wid = tid >> 6, l31 = lane & 31, lh = lane >> 5;
  const int T = layer == 0 ? TTOT : TLAT;
  const float* nw = p.norm2_w + layer * 2048;
  const float* wg = p.w_group + (size_t)layer * 2048 * 4;
  const float* we = p.w_expert + (size_t)layer * 2048 * 32;
  __syncthreads();
  for (int i = tid; i < 128 * 28; i += 256) sW[(i / 28) * 64 + 36 + (i % 28)] = 0.f;
  const int ar = tid >> 3, aks = (tid & 7) * 16;
  const int wk = tid >> 1, whalf = tid & 1;
  for (int item = bid; item < (T >> 5); item += gridDim.x) {
    const int row0 = item * 32;
    const int mi = row_modidx(row0);
    const float* mrow = p.modv() + (layer * 3 + mi) * 12288;
    __syncthreads();
    for (int i = tid; i < 2048; i += 256) { sNW[i] = nw[i] * (1.f + mrow[4 * 2048 + i]); sSH[i] = mrow[3 * 2048 + i]; }
#pragma unroll 2
    for (int rr = 0; rr < 8; ++rr) {
      const float* xr = p.X() + (size_t)(row0 + wid * 8 + rr) * 2048 + lane * 4;
      float ss = 0.f;
#pragma unroll
      for (int i = 0; i < 8; ++i) { float4 v = *(const float4*)(xr + i * 256); ss += v.x * v.x + v.y * v.y + v.z * v.z + v.w * v.w; }
      ss = wave_sum(ss);
      if (lane == 0) srs[wid * 8 + rr] = rsqrtf(ss * (1.f / 2048.f) + EPSV);
    }
    __syncthreads();
    const float rs = srs[ar];
    const float* xrow = p.X() + (size_t)(row0 + ar) * 2048 + aks;
    bfraw* hrow = p.H() + (size_t)(row0 + ar) * LDH + aks;
    float4 xa0, xa1, xa2, xa3, wv0, wv1, wv2, wv3, wv4;
#define RT_GLOAD(k0)                                                                                   \
    {                                                                                                  \
      xa0 = *(const float4*)(xrow + (k0)); xa1 = *(const float4*)(xrow + (k0) + 4);                    \
      xa2 = *(const float4*)(xrow + (k0) + 8); xa3 = *(const float4*)(xrow + (k0) + 12);               \
      const float* er = we + (size_t)((k0) + wk) * 32 + (whalf ? 12 : 0);                              \
      wv0 = *(const float4*)(er); wv1 = *(const float4*)(er + 4); wv2 = *(const float4*)(er + 8);      \
      wv3 = *(const float4*)(er + 12); wv4 = *(const float4*)(er + 16);                                \
      if (!whalf) wv3 = *(const float4*)(wg + (size_t)((k0) + wk) * 4);                                \
    }
#define RT_A4(q, v)                                                                                    \
    {                                                                                                  \
      const int kq = (k0w) + aks + (q) * 4;                                                            \
      float h0 = v.x * rs * sNW[kq] + sSH[kq], h1 = v.y * rs * sNW[kq + 1] + sSH[kq + 1];              \
      float h2 = v.z * rs * sNW[kq + 2] + sSH[kq + 2], h3 = v.w * rs * sNW[kq + 3] + sSH[kq + 3];      \
      float* d = sA + ar * 129 + aks + (q) * 4; d[0] = h0; d[1] = h1; d[2] = h2; d[3] = h3;            \
      uint2 hb; hb.x = pack_bf16(h0, h1); hb.y = pack_bf16(h2, h3);                                    \
      *(uint2*)(hrow + (k0w) + (q) * 4) = hb;                                                          \
    }
#define RT_SWRITE()                                                                                    \
    {                                                                                                  \
      RT_A4(0, xa0) RT_A4(1, xa1) RT_A4(2, xa2) RT_A4(3, xa3)                                          \
      float* w = sW + wk * 64;                                                                         \
      if (!whalf) {                                                                                    \
        w[0] = wv3.x; w[1] = wv3.y; w[2] = wv3.z; w[3] = wv3.w;                                        \
        w[4] = wv0.x; w[5] = wv0.y; w[6] = wv0.z; w[7] = wv0.w; w[8] = wv1.x; w[9] = wv1.y; w[10] = wv1.z; w[11] = wv1.w; \
        w[12] = wv2.x; w[13] = wv2.y; w[14] = wv2.z; w[15] = wv2.w;                                    \
      } else {                                                                                         \
        w[16] = wv0.x; w[17] = wv0.y; w[18] = wv0.z; w[19] = wv0.w; w[20] = wv1.x; w[21] = wv1.y; w[22] = wv1.z; w[23] = wv1.w; \
        w[24] = wv2.x; w[25] = wv2.y; w[26] = wv2.z; w[27] = wv2.w; w[28] = wv3.x; w[29] = wv3.y; w[30] = wv3.z; w[31] = wv3.w; \
        w[32] = wv4.x; w[33] = wv4.y; w[34] = wv4.z; w[35] = wv4.w;                                    \
      }                                                                                                \
    }
    int k0w = 0;
    RT_GLOAD(0)
    RT_SWRITE()
    __syncthreads();
    f32x16 acc;
#pragma unroll
    for (int r = 0; r < 16; ++r) acc[r] = 0.f;
    const int ct = wid & 1, kh = wid >> 1;
    const float* ap = sA + l31 * 129 + kh * 64 + lh;
    const float* bp = sW + (kh * 64 + lh) * 64 + ct * 32 + l31;
    for (int k0 = 0; k0 < 2048; k0 += 128) {
      const bool more = (k0 + 128) < 2048;
      if (more) RT_GLOAD(k0 + 128)
#pragma unroll 8
      for (int kk = 0; kk < 32; ++kk) acc = MFMA32(ap[2 * kk], bp[2 * kk * 64], acc);
      __syncthreads();
      k0w = k0 + 128;
      if (more) RT_SWRITE()
      __syncthreads();
    }
#pragma unroll
    for (int r = 0; r < 16; ++r) sL[(kh * 32 + ROW16(r, lh)) * 64 + ct * 32 + l31] = acc[r];
    __syncthreads();
    if (tid < 32) {
      const int r = row0 + tid;
      const float* l0 = sL + tid * 64;
      const float* l1 = sL + (32 + tid) * 64;
      int gi = 0; float gm = l0[0] + l1[0];
      float gl[4]; gl[0] = gm;
#pragma unroll
      for (int j = 1; j < 4; ++j) { gl[j] = l0[j] + l1[j]; if (gl[j] > gm) { gm = gl[j]; gi = j; } }
      float gs = 0.f;
#pragma unroll
      for (int j = 0; j < 4; ++j) gs += expf(gl[j] - gm);
      const float gw = 1.f / gs;
      int i1 = 0, i2 = -1; float v1 = -INFINITY, v2 = -INFINITY;
      for (int j = 0; j < 8; ++j) {
        const float e = l0[4 + gi * 8 + j] + l1[4 + gi * 8 + j];
        if (e > v1) { v2 = v1; i2 = i1; v1 = e; i1 = j; }
        else if (e > v2) { v2 = e; i2 = j; }
      }
      const float e2 = expf(v2 - v1);
      const float w1 = gw / (1.f + e2), w2 = gw * e2 / (1.f + e2);
      const int ex1 = gi * 8 + i1, ex2 = gi * 8 + i2;
      int* cnt = p.cnt() + layer * 32;
      const int p1 = atomicAdd(&cnt[ex1], 1);
      p.list_tok()[ex1 * CAPE + p1] = r * 2; p.list_w()[ex1 * CAPE + p1] = w1;
      const int p2 = atomicAdd(&cnt[ex2], 1);
      p.list_tok()[ex2 * CAPE + p2] = r * 2 + 1; p.list_w()[ex2 * CAPE + p2] = w2;
    }
  }
}

struct AGather { const bfraw* H; const int* toks; int nvalid;
  __device__ __forceinline__ const bfraw* row(int r) const { return r < nvalid ? H + (size_t)(toks[r] >> 1) * LDH : nullptr; }
  __device__ __forceinline__ const bfraw* safe() const { return H; } };
struct BGateUp { const float *g, *u; int ldb; int nb;
  __device__ __forceinline__ const float* col(int v) const { int wc = v >> 6, j = (v >> 5) & 1, c = v & 31;
    const float* b = g + (ptrdiff_t)j * (u - g); return b + nb + wc * 32 + c; }
  __device__ __forceinline__ const float* safe() const { return g; } };

__device__ __forceinline__ void moe_prefix(const P& p, int layer, int* spre) {
  __syncthreads();
  if (threadIdx.x == 0) {
    int acc = 0;
    for (int e = 0; e < 32; ++e) { spre[e] = acc; acc += (p.cnt()[layer * 32 + e] + 127) >> 7; }
    spre[32] = acc;
  }
  __syncthreads();
}
__device__ __forceinline__ void ph_moe_up(const P& p, int layer, int bid, char* smem) {
  int* spre = (int*)(smem + 98304);
  moe_prefix(p, layer, spre);
  const int ntile = spre[32];
  for (int w = bid; w < ntile * 8; w += gridDim.x) {
    const int rbg = w >> 3, nt = w & 7;
    const int e = __builtin_amdgcn_readfirstlane(__popcll(__ballot((threadIdx.x & 63) < 31 && spre[(threadIdx.x & 63) + 1] <= rbg)));
    const int rb = rbg - spre[e];
    const int cnt = p.cnt()[layer * 32 + e];
    AGather af{p.H(), p.list_tok() + e * CAPE + rb * 128, cnt - rb * 128};
    const size_t wo = ((size_t)layer * 32 + e) * 2048 * 512;
    BGateUp bf{p.w_gate + wo, p.w_up + wo, 512, nt * 64};
    bfraw* act = p.ACT() + (size_t)rbg * 128 * LDACT + nt * 64;
    auto ef = [&](const f32x16 (&acc)[2][2], int wr, int wc, int lane) {
#pragma unroll
      for (int i = 0; i < 2; ++i)
#pragma unroll
        for (int r = 0; r < 16; ++r) {
          int row = ACC_ROW(wr, i, r, lane);
          float gv = acc[i][0][r], uv = acc[i][1][r];
          act[(size_t)row * LDACT + wc * 32 + (lane & 31)] = to_bf16(siluf_(gv) * uv);
        }
    };
    gemm_tile<2>(af, bf, ef, 2048, smem);
  }
}
__device__ __forceinline__ void ph_moe_down(const P& p, int layer, int bid, char* smem) {
  int* spre = (int*)(smem + 98304);
  moe_prefix(p, layer, spre);
  const int ntile = spre[32];
  for (int w = bid; w < ntile * 16; w += gridDim.x) {
    const int rbg = w >> 4, nt = w & 15;
    const int e = __builtin_amdgcn_readfirstlane(__popcll(__ballot((threadIdx.x & 63) < 31 && spre[(threadIdx.x & 63) + 1] <= rbg)));
    const int rb = rbg - spre[e];
    const int nvalid = p.cnt()[layer * 32 + e] - rb * 128;
    ARows af{p.ACT() + (size_t)rbg * 128 * LDACT, LDACT, 0, 128};
    BPlain bf{p.w_down + ((size_t)layer * 32 + e) * 512 * 2048, 2048, nt * 128, 2048};
    const int* toks = p.list_tok() + e * CAPE + rb * 128;
    const float* lw = p.list_w() + e * CAPE + rb * 128;
    float* Ys = p.Yslot();
    auto ef = [&](const f32x16 (&acc)[2][2], int wr, int wc, int lane) {
#pragma unroll
      for (int i = 0; i < 2; ++i)
#pragma unroll
        for (int r = 0; r < 16; ++r) {
          int row = ACC_ROW(wr, i, r, lane);
          if (row < nvalid) {
            int ts = toks[row]; float wgt = lw[row];
#pragma unroll
            for (int j = 0; j < 2; ++j) Ys[(size_t)ts * 2048 + nt * 128 + ACC_COL(wc, j, lane)] = wgt * acc[i][j][r];
          }
        }
    };
    gemm_tile<2>(af, bf, ef, 512, smem);
  }
}

__device__ __forceinline__ void ph_out(const P& p, int bid, char* smem) {
  const int tid = threadIdx.x, lane = tid & 63, wid = tid >> 6;
  for (int r = bid * 4 + wid; r < TLAT; r += gridDim.x * 4) {
    const int mi = r >> 12;
    const float* g2 = p.modv() + (1 * 3 + mi) * 12288 + 5 * 2048;
    f32x4v v[8];
    float ss = 0.f;
#pragma unroll
    for (int q = 0; q < 8; ++q) {
      const int col = q * 256 + lane * 4;
      f32x4v xv = *(const f32x4v*)(p.X() + (size_t)r * 2048 + col);
      const f32x4v gv = *(const f32x4v*)(g2 + col);
      const f32x4v y0 = *(const f32x4v*)(p.Yslot() + (size_t)(2 * r) * 2048 + col);
      const f32x4v y1 = *(const f32x4v*)(p.Yslot() + (size_t)(2 * r + 1) * 2048 + col);
      xv += gv * (y0 + y1);
      v[q] = xv;
      ss += xv[0] * xv[0] + xv[1] * xv[1] + xv[2] * xv[2] + xv[3] * xv[3];
    }
    ss = wave_sum(ss);
    const float rs = rsqrtf(ss * (1.f / 2048.f) + EPSV);
#pragma unroll
    for (int q = 0; q < 8; ++q) {
      const int col = q * 256 + lane * 4;
      const f32x4v w4 = *(const f32x4v*)(p.final_w + col);
      *(f32x4v*)(p.out + (size_t)r * 2048 + col) = v[q] * rs * w4;
    }
  }
}

#define SMEM_BYTES 102400
#define XB_TMO      128
#define XB_XCNT(j)  (256  + 64 * (j))
#define XB_XSUB(j)  (1280 + 64 * (j))
#define XB_XGEN(j)  (2304 + 64 * (j))
#define XB_TOP      3328
#define XB_TOPGEN   3392
#define XB_SPIN_CAP (1u << 22)
#define LAS __attribute__((address_space(3)))
__device__ __forceinline__ unsigned xb_ld(unsigned* p)              { return __hip_atomic_load(p, __ATOMIC_RELAXED, __HIP_MEMORY_SCOPE_AGENT); }
__device__ __forceinline__ unsigned xb_add(unsigned* p, unsigned v) { return __hip_atomic_fetch_add(p, v, __ATOMIC_RELAXED, __HIP_MEMORY_SCOPE_AGENT); }
__device__ __forceinline__ unsigned xb_xcc_id() { return (unsigned)__builtin_amdgcn_s_getreg((3 << 11) | 20) & 0xFu; }
#define XB_SPIN(cond, bar) do { unsigned _sp = 0; while (cond) { __builtin_amdgcn_s_sleep(1); \
    if ((++_sp & 255u) == 0u) { if (xb_ld(&(bar)[XB_TMO])) break; if (_sp > XB_SPIN_CAP) { atomicAdd(&(bar)[XB_TMO], 1u); break; } } } } while (0)
struct XcdBarrier { unsigned* bar; unsigned x; unsigned rank; volatile LAS unsigned* st; };
__device__ __forceinline__ XcdBarrier xcd_barrier_post(unsigned* bar, volatile LAS unsigned* st) {
    XcdBarrier b; b.bar = bar; b.x = xb_xcc_id(); b.st = st;
    b.rank = 0u;
    if (threadIdx.x == 0) b.rank = xb_add(&bar[XB_XCNT(b.x)], 1u);
    return b;
}
__device__ __forceinline__ void xcd_barrier_complete(unsigned* bar, unsigned x, unsigned& nloc, unsigned& nx) {
    const unsigned G = gridDim.x * gridDim.y * gridDim.z;
    unsigned sum, cnt, mine, sp = 0u;
    for (;;) {
        sum = 0u; cnt = 0u; mine = 0u;
#pragma unroll
        for (unsigned j = 0; j < 16; ++j) { const unsigned c = xb_ld(&bar[XB_XCNT(j)]); sum += c; cnt += (c > 0u) ? 1u : 0u; mine = (j == x) ? c : mine; }
        if (sum == G) break;
        __builtin_amdgcn_s_sleep(1);
        if ((++sp & 255u) == 0u) { if (xb_ld(&bar[XB_TMO])) break; if (sp > XB_SPIN_CAP) { atomicAdd(&bar[XB_TMO], 1u); break; } }
    }
    nloc = mine > 0u ? mine : 1u; nx = cnt > 0u ? cnt : 1u;
}
__device__ __forceinline__ void xcd_barrier(const XcdBarrier& b) {
    asm volatile("s_waitcnt vmcnt(0)" ::: "memory");
    __syncthreads();
    if (threadIdx.x == 0) {
        unsigned* bar = b.bar;
        __builtin_amdgcn_s_waitcnt(0);
        unsigned nloc = b.st[0], nx = b.st[1];
        if (nloc == 0u) { xcd_barrier_complete(bar, b.x, nloc, nx); b.st[0] = nloc; b.st[1] = nx; }
        const unsigned old = xb_add(&bar[XB_XSUB(b.x)], 1u);
        const unsigned gen = old / nloc;
        if (old + 1u == (gen + 1u) * nloc) {
            __builtin_amdgcn_fence(__ATOMIC_RELEASE, "agent");
            asm volatile("s_waitcnt vmcnt(0)" ::: "memory");
            const unsigned og = xb_add(&bar[XB_TOP], 1u);
            const unsigned tg = og / nx;
            if (og + 1u == (tg + 1u) * nx) xb_add(&bar[XB_TOPGEN], 1u);
            else XB_SPIN(xb_ld(&bar[XB_TOPGEN]) == tg, bar);
            __builtin_amdgcn_fence(__ATOMIC_ACQUIRE, "agent");
            xb_add(&bar[XB_XGEN(b.x)], 1u);
            asm volatile("s_waitcnt vmcnt(0)" ::: "memory");
        } else {
            XB_SPIN(xb_ld(&bar[XB_XGEN(b.x)]) == gen, bar);
            __builtin_amdgcn_fence(__ATOMIC_ACQUIRE, "agent");
            asm volatile("s_waitcnt vmcnt(0)" ::: "memory");
        }
    }
    __syncthreads();
}

__global__ void __launch_bounds__(256, 1) k_fused(P p, unsigned* bar) {
  extern __shared__ __attribute__((aligned(16))) char smem_all[];
  char* smem = smem_all + 64;
  if (threadIdx.x == 0) *(uint4*)smem_all = make_uint4(0u, 0u, 0u, 0u);
  __syncthreads();
  XcdBarrier b = xcd_barrier_post(bar, (volatile LAS unsigned*)smem_all);
#define RUNP(k, call) for (int r_ = 0; r_ < p.dup[k]; ++r_) { call; }
#define LAYER_PROGRAM(L)                                                        \
  {                                                                             \
    RUNP((L) == 0 ? 0 : 15, ph_norm1(p, L, bid, smem)) xcd_barrier(b);          \
    RUNP(1, ph_win(p, L, bid, smem)) xcd_barrier(b);                            \
    RUNP(2, ph_prep(p, L, bid, smem)) xcd_barrier(b);                           \
    RUNP(3, ph_qkv(p, L, bid, smem)) RUNP(5, ph_mixA(p, L, bid, smem)) xcd_barrier(b);   \
    RUNP(6, ph_attn_only(p, L, bid, smem)) ph_mixB(p, L, bid, smem); xcd_barrier(b); \
    RUNP(7, ph_mixC(p, L, bid, smem)) xcd_barrier(b);                           \
    RUNP(8, ph_s5pre(p, L, bid, smem)) xcd_barrier(b);                          \
    RUNP(9, ph_glu(p, L, bid, smem)) xcd_barrier(b);                            \
    RUNP(10, ph_final_mix(p, L, bid, smem)) xcd_barrier(b);                     \
    RUNP((L) == 0 ? 11 : 15, ph_wout(p, L, bid, smem)) xcd_barrier(b);          \
    ph_router(p, L, bid, smem); xcd_barrier(b);                                 \
    RUNP(12, ph_moe_up(p, L, bid, smem)) xcd_barrier(b);                        \
    RUNP(13, ph_moe_down(p, L, bid, smem)) xcd_barrier(b);                      \
  }
  ph_mod(p, smem); xcd_barrier(b);
  if (threadIdx.x == 0) {
    unsigned pre = 0u;
    for (unsigned j = 0; j < 16; ++j) { const unsigned c = xb_ld(&bar[XB_XCNT(j)]); if (j < b.x) pre += c; }
    ((volatile LAS unsigned*)smem_all)[2] = pre + b.rank;
  }
  __syncthreads();
  const int bid = (int)((volatile LAS unsigned*)smem_all)[2];
  LAYER_PROGRAM(0)
  LAYER_PROGRAM(1)
  ph_out(p, bid, smem);
}

extern "C" void kernel_launch(void* const* d_in, const int* in_sizes, int n_in, void* d_out, int out_size, void* d_ws,
                              size_t ws_size, hipStream_t stream) {
  P p{};
  const float* const* in = (const float* const*)d_in;
  p.x = in[0]; p.c = in[1]; p.ctx = in[2]; p.c_ctx = in[3]; p.mod_w = in[4]; p.mod_b = in[5]; p.norm1_w = in[6];
  p.w_in = in[7]; p.q_norm_w = in[8]; p.kv_norm_w = in[9]; p.w_uq = in[10]; p.w_ukv = in[11]; p.conv_w = in[12];
  p.conv_b = in[13]; p.a_log = in[14]; p.dt_bias = in[15]; p.ssd_d = in[16]; p.gate_b = in[17]; p.lam_re = in[18];
  p.lam_im = in[19]; p.log_dt = in[20]; p.b_re = in[21]; p.b_im = in[22]; p.c_re = in[23]; p.c_im = in[24];
  p.s5_d = in[25]; p.glu_w = in[26]; p.glu_b = in[27]; p.out_norm_w = in[28]; p.w_out = in[29]; p.norm2_w = in[30];
  p.w_group = in[31]; p.w_expert = in[32]; p.w_gate = in[33]; p.w_up = in[34]; p.w_down = in[35]; p.final_w = in[36];
  p.out = (float*)d_out;
  p.ws = (float*)d_ws;
  for (int i = 0; i < 16; ++i) p.dup[i] = 1;
#ifdef EXP_DUP_IDX
  p.dup[EXP_DUP_IDX] = 2;
#endif
  (void)ws_size; (void)in_sizes; (void)n_in; (void)out_size;

  unsigned* bar = (unsigned*)((float*)d_ws + WO_bar);
  static int grid = 0;
  if (!grid) {
    int dev = 0, cus = 0, per_cu = 0;
    hipGetDevice(&dev);
    hipDeviceGetAttribute(&cus, hipDeviceAttributeMultiprocessorCount, dev);
    (void)hipFuncSetAttribute((const void*)k_fused, hipFuncAttributeMaxDynamicSharedMemorySize, SMEM_BYTES + 64);
    (void)hipOccupancyMaxActiveBlocksPerMultiprocessor(&per_cu, k_fused, 256, SMEM_BYTES + 64);
    if (per_cu < 1) per_cu = 1;
    grid = cus * (per_cu < 1 ? per_cu : 1);
  }
  hipMemsetAsync(bar, 0, XCD_BAR_WORDS * sizeof(unsigned), stream);
  hipLaunchKernelGGL(k_fused, dim3(grid), dim3(256), SMEM_BYTES + 64, stream, p, bar);
}
```

```cpp
#include <hip/hip_runtime.h>
#include <stdint.h>

#define DM 2048
#define SL 4096
#define CL 256
#define TLAT 8192
#define TCTX 512
#define TTOT 8704
#define NIN 4192
#define NKEY 4352
#define ZC_CQ 0
#define ZC_CKV 384
#define ZC_KR 512
#define ZC_BZ 576
#define ZC_XBC 1088
#define ZC_DT 2112
#define ZC_MQ 2128
#define ZC_MK 2384
#define ZC_MV 2640
#define ZC_MO 3152
#define ZC_MG 3664
#define ZC_U 3680
#define CAPE 8704
#define EPSV 1e-6f
#define ACT_ROWS 21632

typedef float f32x16 __attribute__((ext_vector_type(16)));
typedef short bf16x8 __attribute__((ext_vector_type(8)));
typedef float f32x4v __attribute__((ext_vector_type(4)));
typedef unsigned short bfraw;
__device__ __forceinline__ unsigned pack_bf16(float lo, float hi) {
  typedef __bf16 bf2 __attribute__((ext_vector_type(2)));
  bf2 v; v[0] = (__bf16)lo; v[1] = (__bf16)hi;
  return __builtin_bit_cast(unsigned, v);
}
__device__ __forceinline__ bfraw to_bf16(float x) { __bf16 b = (__bf16)x; return __builtin_bit_cast(unsigned short, b); }
__device__ __forceinline__ float from_bf16(bfraw x) { return __uint_as_float((unsigned)x << 16); }

#define NSTEP 68
#define LDH 2112
#define LDACT 576
#define XCD_BAR_WORDS 3456
#define WS_RND(n) (((size_t)(n) + 63) & ~(size_t)63)
constexpr size_t WO_cnt = 0;
constexpr size_t WO_modv = WO_cnt + WS_RND(64);
constexpr size_t WO_H = WO_modv + WS_RND(2 * 3 * 12288);
constexpr size_t WO_X = WO_H + WS_RND((size_t)TTOT * (LDH / 2));
constexpr size_t WO_Z = WO_X + WS_RND((size_t)TTOT * 2048);
constexpr size_t WO_Aq = WO_Z + WS_RND((size_t)TTOT * NIN);
constexpr size_t WO_Akv = WO_Aq + WS_RND((size_t)TTOT * 192);
constexpr size_t WO_qraw = WO_Akv + WS_RND((size_t)TTOT * 64);
constexpr size_t WO_kvraw = WO_qraw + WS_RND((size_t)TTOT * 768);
constexpr size_t WO_Q = WO_kvraw + WS_RND((size_t)TTOT * 1024);
constexpr size_t WO_Qc = WO_Q + WS_RND((size_t)8 * SL * 96);
constexpr size_t WO_K = WO_Qc + WS_RND((size_t)8 * CL * 96);
constexpr size_t WO_V = WO_K + WS_RND((size_t)8 * NKEY * 96);
constexpr size_t WO_O = WO_V + WS_RND((size_t)8 * NKEY * 64);
constexpr size_t WO_ssd_xs = WO_O + WS_RND((size_t)TTOT * 512);
constexpr size_t WO_ssd_B = WO_ssd_xs + WS_RND((size_t)TTOT * 512);
constexpr size_t WO_ssd_C = WO_ssd_B + WS_RND((size_t)TTOT * 256);
constexpr size_t WO_ssd_dt = WO_ssd_C + WS_RND((size_t)TTOT * 256);
constexpr size_t WO_ssd_y = WO_ssd_dt + WS_RND((size_t)TTOT * 16);
constexpr size_t WO_ssd_st = WO_ssd_y + WS_RND((size_t)TTOT * 512);
constexpr size_t WO_ssd_atot = WO_ssd_st + WS_RND((size_t)32 * NSTEP * 8192);
constexpr size_t WO_ml_h = WO_ssd_atot + WS_RND(32 * NSTEP);
constexpr size_t WO_ml_st = WO_ml_h + WS_RND((size_t)TTOT * 512);
constexpr size_t WO_ml_nst = WO_ml_st + WS_RND((size_t)16 * NSTEP * 8192);
constexpr size_t WO_ml_gtot = WO_ml_nst + WS_RND((size_t)16 * NSTEP * 64);
constexpr size_t WO_s5_st = WO_ml_gtot + WS_RND(16 * NSTEP);
constexpr size_t WO_s5_a = WO_s5_st + WS_RND((size_t)128 * NSTEP * 128);
constexpr size_t WO_s5_bb = WO_s5_a + WS_RND(2 * 2 * 32 * 64 * 2);
constexpr size_t WO_s5_rf = WO_s5_bb + WS_RND((size_t)2 * 2 * 32 * 64 * 32);
constexpr size_t WO_s5_rb = WO_s5_rf + WS_RND((size_t)TTOT * 512);
constexpr size_t WO_ydpre = WO_s5_rb + WS_RND((size_t)TTOT * 512);
constexpr size_t WO_ydg = WO_ydpre + WS_RND((size_t)TTOT * 512);
constexpr size_t WO_Y = WO_ydg + WS_RND((size_t)TTOT * 512);
constexpr size_t WO_ydpre_bf = WO_Y + WS_RND((size_t)TTOT * (LDH / 2));
constexpr size_t WO_list_tok = WO_ydpre_bf + WS_RND((size_t)TTOT * 256);
constexpr size_t WO_list_w = WO_list_tok + WS_RND((size_t)32 * CAPE);
constexpr size_t WO_ACT = WO_list_w + WS_RND((size_t)32 * CAPE);
constexpr size_t WO_Yslot = WO_ACT + WS_RND((size_t)ACT_ROWS * (LDACT / 2));
constexpr size_t WO_rope_cs = WO_Yslot + WS_RND((size_t)TTOT * 2 * 2048);
constexpr size_t WO_bar_old = WO_Yslot + WS_RND((size_t)TTOT * 2 * 2048);
constexpr size_t WO_bar = WO_rope_cs + WS_RND(64 * 16 * 2);
constexpr size_t WS_TOTAL_FLOATS = WO_bar + 4096;

struct P {
  const float *x, *c, *ctx, *c_ctx, *mod_w, *mod_b, *norm1_w, *w_in, *q_norm_w, *kv_norm_w, *w_uq, *w_ukv;
  const float *conv_w, *conv_b, *a_log, *dt_bias, *ssd_d, *gate_b, *lam_re, *lam_im, *log_dt, *b_re, *b_im;
  const float *c_re, *c_im, *s5_d, *glu_w, *glu_b, *out_norm_w, *w_out, *norm2_w, *w_group, *w_expert;
  const float *w_gate, *w_up, *w_down, *final_w;
  float* out;
  float* ws;
  __device__ __forceinline__ int* cnt() const { return (int*)(ws + WO_cnt); }
  __device__ __forceinline__ float* modv() const { return (float*)(ws + WO_modv); }
  __device__ __forceinline__ bfraw* H() const { return (bfraw*)(ws + WO_H); }
  __device__ __forceinline__ float* X() const { return (float*)(ws + WO_X); }
  __device__ __forceinline__ float* Z() const { return (float*)(ws + WO_Z); }
  __device__ __forceinline__ bfraw* Aq() const { return (bfraw*)(ws + WO_Aq); }
  __device__ __forceinline__ bfraw* Akv() const { return (bfraw*)(ws + WO_Akv); }
  __device__ __forceinline__ float* qraw() const { return (float*)(ws + WO_qraw); }
  __device__ __forceinline__ float* kvraw() const { return (float*)(ws + WO_kvraw); }
  __device__ __forceinline__ bfraw* Q() const { return (bfraw*)(ws + WO_Q); }
  __device__ __forceinline__ bfraw* Qc() const { return (bfraw*)(ws + WO_Qc); }
  __device__ __forceinline__ bfraw* K() const { return (bfraw*)(ws + WO_K); }
  __device__ __forceinline__ bfraw* V() const { return (bfraw*)(ws + WO_V); }
  __device__ __forceinline__ float* O() const { return (float*)(ws + WO_O); }
  __device__ __forceinline__ float* ssd_xs() const { return (float*)(ws + WO_ssd_xs); }
  __device__ __forceinline__ float* ssd_B() const { return (float*)(ws + WO_ssd_B); }
  __device__ __forceinline__ float* ssd_C() const { return (float*)(ws + WO_ssd_C); }
  __device__ __forceinline__ float* ssd_dt() const { return (float*)(ws + WO_ssd_dt); }
  __device__ __forceinline__ float* ssd_y() const { return (float*)(ws + WO_ssd_y); }
  __device__ __forceinline__ float* ssd_st() const { return (float*)(ws + WO_ssd_st); }
  __device__ __forceinline__ float* ssd_atot() const { return (float*)(ws + WO_ssd_atot); }
  __device__ __forceinline__ float* ml_h() const { return (float*)(ws + WO_ml_h); }
  __device__ __forceinline__ float* ml_st() const { return (float*)(ws + WO_ml_st); }
  __device__ __forceinline__ float* ml_nst() const { return (float*)(ws + WO_ml_nst); }
  __device__ __forceinline__ float* ml_gtot() const { return (float*)(ws + WO_ml_gtot); }
  __device__ __forceinline__ float* s5_st() const { return (float*)(ws + WO_s5_st); }
  __device__ __forceinline__ float* s5_a() const { return (float*)(ws + WO_s5_a); }
  __device__ __forceinline__ float* s5_bb() const { return (float*)(ws + WO_s5_bb); }
  __device__ __forceinline__ float* s5_rf() const { return (float*)(ws + WO_s5_rf); }
  __device__ __forceinline__ float* s5_rb() const { return (float*)(ws + WO_s5_rb); }
  __device__ __forceinline__ float* ydpre() const { return (float*)(ws + WO_ydpre); }
  __device__ __forceinline__ float* ydg() const { return (float*)(ws + WO_ydg); }
  __device__ __forceinline__ bfraw* Y() const { return (bfraw*)(ws + WO_Y); }
  __device__ __forceinline__ bfraw* ydpre_bf() const { return (bfraw*)(ws + WO_ydpre_bf); }
  __device__ __forceinline__ int* list_tok() const { return (int*)(ws + WO_list_tok); }
  __device__ __forceinline__ float* list_w() const { return (float*)(ws + WO_list_w); }
  __device__ __forceinline__ bfraw* ACT() const { return (bfraw*)(ws + WO_ACT); }
  __device__ __forceinline__ float* Yslot() const { return (float*)(ws + WO_Yslot); }
  __device__ __forceinline__ float* rope_cs() const { return (float*)(ws + WO_rope_cs); }
};

__device__ __forceinline__ int row_modidx(int r) { return r < TLAT ? (r >> 12) : 2; }
__device__ __forceinline__ float sigmoidf_(float v) { return 1.f / (1.f + expf(-v)); }
__device__ __forceinline__ float siluf_(float v) { return v / (1.f + expf(-v)); }
__device__ __forceinline__ float wave_sum(float v) {
#pragma unroll
  for (int o = 32; o; o >>= 1) v += __shfl_xor(v, o);
  return v;
}
__device__ __forceinline__ float block_sum(float v, float* red) {
  v = wave_sum(v);
  __syncthreads();
  if ((threadIdx.x & 63) == 0) red[threadIdx.x >> 6] = v;
  __syncthreads();
  return red[0] + red[1] + red[2] + red[3];
}

__device__ __forceinline__ void ph_mod(const P& p, char* smem) {
  float* sc = (float*)smem;
  float* red = sc + 3 * 2048;
  const int tid = threadIdx.x;
  if (blockIdx.x == 0 && tid < 64) p.cnt()[tid] = 0;
  if (blockIdx.x == 1) {
    for (int i = tid; i < 64 * 16; i += 256) {
      const int idx = i >> 4, f = i & 15;
      const float ang = (float)idx * powf(10000.f, -(float)f * (1.f / 16.f));
      p.rope_cs()[i * 2] = cosf(ang); p.rope_cs()[i * 2 + 1] = sinf(ang);
    }
  }
  for (int i = blockIdx.x * 256 + tid; i < 2 * 2 * 32 * 64; i += gridDim.x * 256) {
    const int sp = i & 63, g = (i >> 6) & 31, l = i >> 12;
    const float lr = p.lam_re[i], li = p.lam_im[i];
    const float dt = expf(p.log_dt[i >> 6]);
    const float mag = expf(lr * dt);
    const float ar = mag * cosf(li * dt), ai = mag * sinf(li * dt);
    const float den = lr * lr + li * li;
    const float cr_ = ((ar - 1.f) * lr + ai * li) / den;
    const float ci_ = (ai * lr - (ar - 1.f) * li) / den;
    p.s5_a()[i * 2] = ar; p.s5_a()[i * 2 + 1] = ai;
    for (int c = 0; c < 16; ++c) {
      float br = p.b_re[((size_t)(l * 32 + g) * 64 + sp) * 16 + c];
      float bim = p.b_im[((size_t)(l * 32 + g) * 64 + sp) * 16 + c];
      p.s5_bb()[(size_t)i * 32 + c] = cr_ * br - ci_ * bim;
      p.s5_bb()[(size_t)i * 32 + 16 + c] = cr_ * bim + ci_ * br;
    }
  }
  for (int i = tid; i < 3 * 2048; i += 256) {
    int r = i >> 11, k = i & 2047;
    float v = r < 2 ? p.c[r * 2048 + k] : p.c_ctx[k];
    sc[i] = siluf_(v);
  }
  __syncthreads();
  for (int w = blockIdx.x; w < 2 * 96; w += gridDim.x) {
    int l = w / 96, j0 = (w % 96) * 128;
    int cg = tid & 31, ks = tid >> 5;
    const float* W = p.mod_w + (size_t)l * 2048 * 12288 + j0 + cg * 4;
    float acc[3][4];
#pragma unroll
    for (int r = 0; r < 3; ++r)
#pragma unroll
      for (int c = 0; c < 4; ++c) acc[r][c] = 0.f;
#pragma unroll 16
    for (int k = ks * 256; k < ks * 256 + 256; ++k) {
      float4 wv = *(const float4*)(W + (size_t)k * 12288);
      float s0 = sc[k], s1 = sc[2048 + k], s2 = sc[4096 + k];
      acc[0][0] += s0 * wv.x; acc[0][1] += s0 * wv.y; acc[0][2] += s0 * wv.z; acc[0][3] += s0 * wv.w;
      acc[1][0] += s1 * wv.x; acc[1][1] += s1 * wv.y; acc[1][2] += s1 * wv.z; acc[1][3] += s1 * wv.w;
      acc[2][0] += s2 * wv.x; acc[2][1] += s2 * wv.y; acc[2][2] += s2 * wv.z; acc[2][3] += s2 * wv.w;
    }
    __syncthreads();
#pragma unroll
    for (int r = 0; r < 3; ++r)
#pragma unroll
      for (int c = 0; c < 4; ++c) red[(ks * 32 + cg) * 12 + r * 4 + c] = acc[r][c];
    __syncthreads();
    for (int o = tid; o < 384; o += 256) {
      int r = o >> 7, c = o & 127;
      float s = 0.f;
#pragma unroll
      for (int q = 0; q < 8; ++q) s += red[(q * 32 + (c >> 2)) * 12 + r * 4 + (c & 3)];
      s += p.mod_b[l * 12288 + j0 + c];
      p.modv()[(l * 3 + r) * 12288 + j0 + c] = s;
    }
    __syncthreads();
  }
}

__device__ __forceinline__ void ph_norm1(const P& p, int layer, int bid, char* smem) {
  const int tid = threadIdx.x, lane = tid & 63, wid = tid >> 6;
  const float* nw = p.norm1_w + layer * 2048;
  for (int r = bid * 4 + wid; r < TTOT; r += gridDim.x * 4) {
    const int mi = row_modidx(r);
    const float* mrow = p.modv() + (layer * 3 + mi) * 12288;
    f32x4v v[8];
    float ss = 0.f;
#pragma unroll
    for (int q = 0; q < 8; ++q) {
      const int col = q * 256 + lane * 4;
      f32x4v xv;
      if (layer == 0) {
        const float* src = r < TLAT ? p.x + (size_t)r * 2048 : p.ctx + (size_t)(r - TLAT) * 2048;
        xv = *(const f32x4v*)(src + col);
      } else {
        xv = *(const f32x4v*)(p.X() + (size_t)r * 2048 + col);
        const float* g2 = p.modv() + ((layer - 1) * 3 + mi) * 12288 + 5 * 2048;
        const f32x4v gv = *(const f32x4v*)(g2 + col);
        const f32x4v y0 = *(const f32x4v*)(p.Yslot() + (size_t)(2 * r) * 2048 + col);
        const f32x4v y1 = *(const f32x4v*)(p.Yslot() + (size_t)(2 * r + 1) * 2048 + col);
        xv += gv * (y0 + y1);
        *(f32x4v*)(p.X() + (size_t)r * 2048 + col) = xv;
      }
      v[q] = xv;
      ss += xv[0] * xv[0] + xv[1] * xv[1] + xv[2] * xv[2] + xv[3] * xv[3];
    }
    ss = wave_sum(ss);
    const float rs = rsqrtf(ss * (1.f / 2048.f) + EPSV);
#pragma unroll
    for (int q = 0; q < 8; ++q) {
      const int col = q * 256 + lane * 4;
      const f32x4v w4 = *(const f32x4v*)(nw + col);
      const f32x4v sh = *(const f32x4v*)(mrow + col);
      const f32x4v scv = *(const f32x4v*)(mrow + 2048 + col);
      const f32x4v o = v[q] * rs * w4 * (1.f + scv) + sh;
      uint2 ob; ob.x = pack_bf16(o[0], o[1]); ob.y = pack_bf16(o[2], o[3]);
      *(uint2*)(p.H() + (size_t)r * LDH + col) = ob;
    }
  }
}

template <int MI, class AF, class BF, class EF>
__device__ __forceinline__ void gemm_tile(const AF& af, const BF& bf, const EF& ef, int K, char* smem) {
  constexpr int BM = MI * 64;
  constexpr int NA = MI * 2;
  constexpr int ABYTES = BM * 128, STAGE = ABYTES + 16384;
  int tid_ = threadIdx.x; asm volatile("" : "+v"(tid_));
  const int tid = tid_, lane = tid & 63, wid = tid >> 6, wr = wid >> 1, wc = wid & 1;
  const int l31 = lane & 31, lh = lane >> 5;
  f32x16 acc[MI][2];
#pragma unroll
  for (int i = 0; i < MI; ++i)
#pragma unroll
    for (int j = 0; j < 2; ++j)
#pragma unroll
      for (int r = 0; r < 16; ++r) acc[i][j][r] = 0.f;
  const int arl = tid >> 3, ac = tid & 7;
  const bfraw* arow[NA];
#pragma unroll
  for (int i = 0; i < NA; ++i) { const bfraw* q = af.row(arl + 32 * i); arow[i] = (q ? q : af.safe()) + ac * 8; }
  const int n4 = tid & 31, kg = tid >> 5;
  const float* bc;
  { const float* q = bf.col(n4 * 4); bc = (q ? q : bf.safe()) + (size_t)(kg * 8) * bf.ldb; }
  const size_t ldb = (size_t)bf.ldb;
  typedef unsigned u32x4v __attribute__((ext_vector_type(4)));
  u32x4v ra[2][NA];
  f32x4v rb[2][8];
#define GM_GL(set, k0)                                                               \
  {                                                                                  \
    _Pragma("unroll") for (int i = 0; i < NA; ++i) ra[set][i] = *(const u32x4v*)(arow[i] + (k0)); \
    const float* bq = bc + (size_t)(k0) * ldb;                                       \
    _Pragma("unroll") for (int j = 0; j < 8; ++j) rb[set][j] = *(const f32x4v*)(bq + (size_t)j * ldb); \
  }
#define GM_SW(set, buf)                                                              \
  {                                                                                  \
    char* Ab = smem + (buf) * STAGE; char* Bb = Ab + ABYTES;                         \
    const int asw = (ac ^ ((arl >> 1) & 7)) << 4;                                    \
    _Pragma("unroll") for (int i = 0; i < NA; ++i) *(u32x4v*)(Ab + (arl + 32 * i) * 128 + asw) = ra[set][i]; \
    _Pragma("unroll") for (int i4 = 0; i4 < 4; ++i4) {                               \
      const int n = n4 * 4 + i4;                                                     \
      u32x4v v;                                                                      \
      v[0] = pack_bf16(rb[set][0][i4], rb[set][1][i4]); v[1] = pack_bf16(rb[set][2][i4], rb[set][3][i4]); \
      v[2] = pack_bf16(rb[set][4][i4], rb[set][5][i4]); v[3] = pack_bf16(rb[set][6][i4], rb[set][7][i4]); \
      *(u32x4v*)(Bb + n * 128 + ((kg ^ ((n >> 1) & 7)) << 4)) = v;                   \
    }                                                                                \
  }
#define GM_COMPUTE(buf, KK0, KK1)                                                    \
  {                                                                                  \
    const char* ap = smem + (buf) * STAGE + (wr * (BM / 2) + l31) * 128;             \
    const char* bp = smem + (buf) * STAGE + ABYTES + (wc * 64 + l31) * 128;          \
    _Pragma("unroll") for (int kk = KK0; kk < KK1; ++kk) {                           \
      const int co = ((2 * kk + lh) ^ fsw) << 4;                                     \
      const bf16x8 b0 = *(const bf16x8*)(bp + co), b1 = *(const bf16x8*)(bp + 32 * 128 + co); \
      _Pragma("unroll") for (int i = 0; i < MI; ++i) {                               \
        const bf16x8 a = *(const bf16x8*)(ap + i * 32 * 128 + co);                   \
        acc[i][0] = __builtin_amdgcn_mfma_f32_32x32x16_bf16(a, b0, acc[i][0], 0, 0, 0); \
        acc[i][1] = __builtin_amdgcn_mfma_f32_32x32x16_bf16(a, b1, acc[i][1], 0, 0, 0); \
      }                                                                              \
    }                                                                                \
  }
  const int fsw = (l31 >> 1) & 7;
  const int nsteps = K >> 6;
  __syncthreads();
  const int klast = (nsteps - 1) * 64;
  GM_GL(0, 0)
  GM_SW(0, 0)
  GM_GL(1, 64)
  __syncthreads();
  for (int s = 0; s < nsteps; s += 2) {
    { const int kn = min((s + 2) * 64, klast); GM_GL(0, kn) }
    GM_COMPUTE(0, 0, 2)
    __builtin_amdgcn_sched_barrier(0);
    GM_SW(1, 1)
    __builtin_amdgcn_sched_barrier(0);
    GM_COMPUTE(0, 2, 4)
    __syncthreads();
    { const int kn = min((s + 3) * 64, klast); GM_GL(1, kn) }
    GM_COMPUTE(1, 0, 2)
    __builtin_amdgcn_sched_barrier(0);
    GM_SW(0, 0)
    __builtin_amdgcn_sched_barrier(0);
    GM_COMPUTE(1, 2, 4)
    __syncthreads();
  }
  ef(acc, wr, wc, lane);
}
#define ACC_ROWM(MI, wr, i, r, lane) ((wr) * ((MI) * 32) + (i) * 32 + ((r) & 3) + 8 * ((r) >> 2) + 4 * ((lane) >> 5))
#define ACC_ROW(wr, i, r, lane) ACC_ROWM(2, wr, i, r, lane)
#define ACC_COL(wc, j, lane) ((wc) * 64 + (j) * 32 + ((lane) & 31))

struct ARows { const bfraw* base; int ld; int m0; int M;
  __device__ __forceinline__ const bfraw* row(int r) const { int g = m0 + r; return g < M ? base + (size_t)g * ld : nullptr; }
  __device__ __forceinline__ const bfraw* safe() const { return base; } };
struct BPlain { const float* B; int ldb; int n0; int N;
  __device__ __forceinline__ const float* col(int v) const { int n = n0 + v; return n < N ? B + n : nullptr; }
  __device__ __forceinline__ const float* safe() const { return B; } };

template <int MI, class EPI>
__device__ __forceinline__ void gemm_dense(const bfraw* A, int lda, const float* B, int ldb, int M, int N, int K, const EPI& epi, int bid, char* smem) {
  constexpr int BM = MI * 64;
  const int mt = (M + BM - 1) / BM, nt = (N + 127) >> 7;
  const int nslots = ((nt + 1) >> 1) * mt * 2;
  for (int w = bid; w < nslots; w += gridDim.x) {
    const int sr = w / (mt * 2), rem = w - sr * (mt * 2);
    const int n_t = sr * 2 + (rem & 1);
    if (n_t >= nt) continue;
    const int m0 = (rem >> 1) * BM, n0 = n_t * 128;
    ARows af{A, lda, m0, M};
    BPlain bf{B, ldb, n0, N};
    auto ef = [&](const f32x16 (&acc)[MI][2], int wr, int wc, int lane) {
#pragma unroll
      for (int i = 0; i < MI; ++i)
#pragma unroll
        for (int j = 0; j < 2; ++j)
#pragma unroll
          for (int r = 0; r < 16; ++r) {
            int row = m0 + ACC_ROWM(MI, wr, i, r, lane), col = n0 + ACC_COL(wc, j, lane);
            if (row < M && col < N) epi(row, col, acc[i][j][r]);
          }
    };
    gemm_tile<MI>(af, bf, ef, K, smem);
  }
}


template <class EPI>
__device__ __forceinline__ void gemm_dense_hybrid(const bfraw* A, int lda, const float* B, int ldb, int M, int N, int K, const EPI& epi, int bid, char* smem) {
  const int mt = M / 256, nt = (N + 127) >> 7;
  const int npair = (nt >> 1) * mt * 2, ntiles = mt * nt;
  const int G = gridDim.x;
  const int nfull = (ntiles / G) * G, rem = ntiles - nfull;
  auto tile_of = [&](int w, int& m_t, int& n_t) {
    if (w < npair) { const int sr = w / (mt * 2), r2 = w - sr * (mt * 2); m_t = r2 >> 1; n_t = sr * 2 + (r2 & 1); }
    else { m_t = w - npair; n_t = nt - 1; }
  };
  for (int w = bid; w < nfull; w += G) {
    int m_t, n_t; tile_of(w, m_t, n_t);
    const int m0 = m_t * 256, n0 = n_t * 128;
    ARows af{A, lda, m0, M};
    BPlain bf{B, ldb, n0, N};
    auto ef = [&](const f32x16 (&acc)[4][2], int wr, int wc, int lane) {
#pragma unroll
      for (int i = 0; i < 4; ++i)
#pragma unroll
        for (int j = 0; j < 2; ++j)
#pragma unroll
          for (int r = 0; r < 16; ++r) {
            int row = m0 + ACC_ROWM(4, wr, i, r, lane), col = n0 + ACC_COL(wc, j, lane);
            if (col < N) epi(row, col, acc[i][j][r]);
          }
    };
    gemm_tile<4>(af, bf, ef, K, smem);
  }
  for (int w = bid; w < 2 * rem; w += G) {
    int m_t, n_t; tile_of(nfull + (w >> 1), m_t, n_t);
    const int m0 = m_t * 256 + (w & 1) * 128, n0 = n_t * 128;
    ARows af{A, lda, m0, M};
    BPlain bf{B, ldb, n0, N};
    auto ef = [&](const f32x16 (&acc)[2][2], int wr, int wc, int lane) {
#pragma unroll
      for (int i = 0; i < 2; ++i)
#pragma unroll
        for (int j = 0; j < 2; ++j)
#pragma unroll
          for (int r = 0; r < 16; ++r) {
            int row = m0 + ACC_ROWM(2, wr, i, r, lane), col = n0 + ACC_COL(wc, j, lane);
            if (col < N) epi(row, col, acc[i][j][r]);
          }
    };
    gemm_tile<2>(af, bf, ef, K, smem);
  }
}

__device__ __forceinline__ void ph_win(const P& p, int layer, int bid, char* smem) {
  float* Z = p.Z();
  auto epi = [=](int row, int col, float v) { Z[(size_t)row * NIN + col] = v; };
  gemm_dense_hybrid(p.H(), LDH, p.w_in + (size_t)layer * 2048 * NIN, NIN, TTOT, NIN, 2048, epi, bid, smem);
}

__device__ __forceinline__ void ph_prep(const P& p, int layer, int bid, char* smem) {
  const int tid = threadIdx.x, lane = tid & 63, wid = tid >> 6;
  for (int r = bid * 4 + wid; r < TTOT; r += gridDim.x * 4) {
    const float* z = p.Z() + (size_t)r * NIN;
    float q[6]; float ss = 0.f;
#pragma unroll
    for (int i = 0; i < 6; ++i) { q[i] = z[ZC_CQ + i * 64 + lane]; ss += q[i] * q[i]; }
    ss = wave_sum(ss);
    float rs = rsqrtf(ss * (1.f / 384.f) + EPSV);
#pragma unroll
    for (int i = 0; i < 6; ++i) p.Aq()[(size_t)r * 384 + i * 64 + lane] = to_bf16(q[i] * rs * p.q_norm_w[layer * 384 + i * 64 + lane]);
    float k0 = z[ZC_CKV + lane], k1 = z[ZC_CKV + 64 + lane];
    float s2 = wave_sum(k0 * k0 + k1 * k1);
    float rs2 = rsqrtf(s2 * (1.f / 128.f) + EPSV);
    p.Akv()[(size_t)r * 128 + lane] = to_bf16(k0 * rs2 * p.kv_norm_w[layer * 128 + lane]);
    p.Akv()[(size_t)r * 128 + 64 + lane] = to_bf16(k1 * rs2 * p.kv_norm_w[layer * 128 + 64 + lane]);
  }
  const float* cw = p.conv_w + layer * 5 * 1024;
  const float* cb = p.conv_b + layer * 1024;
  const int ch = tid * 4;
  const f32x4v bias = *(const f32x4v*)(cb + ch);
  f32x4v wk[5];
#pragma unroll
  for (int k = 0; k < 5; ++k) wk[k] = *(const f32x4v*)(cw + k * 1024 + ch);
  for (int rb = bid; rb < TTOT / 8; rb += gridDim.x) {
    const int r0 = rb * 8;
    int base, len;
    if (r0 < TLAT) { base = (r0 >> 12) << 12; len = SL; } else { base = TLAT + (((r0 - TLAT) >> 8) << 8); len = CL; }
    const int t0 = r0 - base;
    f32x4v xw[12];
#pragma unroll
    for (int u = 0; u < 12; ++u) {
      const int tt = t0 + u - 2;
      const f32x4v zero = {0.f, 0.f, 0.f, 0.f};
      xw[u] = (tt >= 0 && tt < len) ? *(const f32x4v*)(p.Z() + (size_t)(base + tt) * NIN + ZC_XBC + ch) : zero;
    }
#pragma unroll
    for (int j = 0; j < 8; ++j) {
      f32x4v acc = bias;
#pragma unroll
      for (int k = 0; k < 5; ++k) acc += xw[j + k] * wk[k];
      acc[0] = siluf_(acc[0]); acc[1] = siluf_(acc[1]); acc[2] = siluf_(acc[2]); acc[3] = siluf_(acc[3]);
      const int r = r0 + j;
      if (ch < 512) *(f32x4v*)(p.ssd_xs() + (size_t)r * 512 + ch) = acc;
      else if (ch < 768) *(f32x4v*)(p.ssd_B() + (size_t)r * 256 + (ch - 512)) = acc;
      else *(f32x4v*)(p.ssd_C() + (size_t)r * 256 + (ch - 768)) = acc;
    }
    if (tid < 128) {
      const int r = r0 + (tid >> 4), c = tid & 15;
      float v = p.Z()[(size_t)r * NIN + ZC_DT + c] + p.dt_bias[layer * 16 + c];
      p.ssd_dt()[(size_t)r * 16 + c] = v > 20.f ? v : log1pf(expf(v));
    }
  }
}

__device__ __forceinline__ void ph_qkv(const P& p, int layer, int bid, char* smem) {
  const int tid = threadIdx.x;
  const float qscale = 0.07216878364870322f * 1.4426950408889634f;
  const float* rope = p.rope_cs();
  for (int r = bid; r < TTOT; r += gridDim.x) {
    const bool lat = r < TLAT;
    int b, pos;
    if (lat) { b = r >> 12; pos = r & 4095; } else { b = (r - TLAT) >> 8; pos = (r - TLAT) & 255; }
    const int kpos = lat ? pos : SL + pos;
    const float* zr = p.Z() + (size_t)r * NIN + ZC_KR;
    const int h = tid >> 6, e = tid & 63;
    float v;
    if (!lat) v = zr[e];
    else {
      const int a = e >> 5, half = (e >> 4) & 1, f = e & 15;
      const float x1 = zr[a * 32 + f], x2 = zr[a * 32 + 16 + f];
      const int idx = a == 0 ? (pos >> 6) : (pos & 63);
      const float cs = rope[(idx * 16 + f) * 2], sn = rope[(idx * 16 + f) * 2 + 1];
      v = half == 0 ? x1 * cs - x2 * sn : x1 * sn + x2 * cs;
    }
    p.K()[((size_t)(b * 4 + h) * NKEY + kpos) * 192 + 128 + e] = to_bf16(v);
  }
  {
    const float* B = p.w_uq + (size_t)layer * 384 * 768;
    for (int w = bid; w < 68 * 6; w += gridDim.x) {
      const int n_t = w / 68, m_t = w - n_t * 68;
      const int m0 = m_t * 128, n0 = n_t * 128;
      ARows af{p.Aq(), 384, m0, TTOT};
      BPlain bf{B, 768, n0, 768};
      const bool lat = m0 < TLAT;
      const int b = lat ? (m0 >> 12) : ((m0 - TLAT) >> 8);
      const int pos0 = lat ? (m0 & 4095) : ((m0 - TLAT) & 255);
      auto ef = [&](const f32x16 (&acc)[2][2], int wr, int wc, int lane) {
        const int l31 = lane & 31;
#pragma unroll
        for (int j = 0; j < 2; ++j) {
          const int col = n0 + wc * 64 + j * 32;
          const int h = col / 192, d0 = col - h * 192;
          const bool isrope = lat && d0 >= 128;
          const int f = l31 & 15;
#pragma unroll
          for (int i = 0; i < 2; ++i)
#pragma unroll
            for (int r = 0; r < 16; ++r) {
              const int pos = pos0 + ACC_ROW(wr, i, r, lane);
              float v = acc[i][j][r];
              const float pv = __shfl_xor(v, 16);
              if (isrope) {
                const int idx = d0 == 128 ? (pos >> 6) : (pos & 63);
                const float cs = rope[(idx * 16 + f) * 2], sn = rope[(idx * 16 + f) * 2 + 1];
                v = (l31 < 16) ? v * cs - pv * sn : pv * sn + v * cs;
              }
              bfraw* dst = lat ? p.Q() + ((size_t)(b * 4 + h) * SL + pos) * 192 : p.Qc() + ((size_t)(b * 4 + h) * CL + pos) * 192;
              dst[d0 + l31] = to_bf16(v * qscale);
            }
        }
      };
      gemm_tile<2>(af, bf, ef, 384, smem);
    }
  }
  {
    const float* B = p.w_ukv + (size_t)layer * 128 * 1024;
    for (int w = bid; w < 68 * 8; w += gridDim.x) {
      const int n_t = w / 68, m_t = w - n_t * 68;
      const int m0 = m_t * 128, n0 = n_t * 128;
      ARows af{p.Akv(), 128, m0, TTOT};
      BPlain bf{B, 1024, n0, 1024};
      const bool lat = m0 < TLAT;
      const int b = lat ? (m0 >> 12) : ((m0 - TLAT) >> 8);
      const int kpos0 = lat ? (m0 & 4095) : SL + ((m0 - TLAT) & 255);
      const int h = n_t >> 1;
      const bool isv = n_t & 1;
      auto ef = [&](const f32x16 (&acc)[2][2], int wr, int wc, int lane) {
        const int l31 = lane & 31, lh = lane >> 5;
        if (!isv) {
#pragma unroll
          for (int i = 0; i < 2; ++i)
#pragma unroll
            for (int j = 0; j < 2; ++j)
#pragma unroll
              for (int r = 0; r < 16; ++r) {
                const int kpos = kpos0 + ACC_ROW(wr, i, r, lane);
                p.K()[((size_t)(b * 4 + h) * NKEY + kpos) * 192 + wc * 64 + j * 32 + l31] = to_bf16(acc[i][j][r]);
              }
        } else {
#pragma unroll
          for (int i = 0; i < 2; ++i)
#pragma unroll
            for (int j = 0; j < 2; ++j) {
              const int d = wc * 64 + j * 32 + l31;
              bfraw* vrow = p.V() + ((size_t)(b * 4 + h) * 128 + d) * NKEY + kpos0 + wr * 64 + i * 32;
#pragma unroll
              for (int s = 0; s < 2; ++s) {
                uint4 t;
                t.x = pack_bf16(acc[i][j][8 * s + 0], acc[i][j][8 * s + 1]); t.y = pack_bf16(acc[i][j][8 * s + 2], acc[i][j][8 * s + 3]);
                t.z = pack_bf16(acc[i][j][8 * s + 4], acc[i][j][8 * s + 5]); t.w = pack_bf16(acc[i][j][8 * s + 6], acc[i][j][8 * s + 7]);
                *(uint4*)(vrow + 16 * s + 8 * lh) = t;
              }
            }
        }
      };
      gemm_tile<2>(af, bf, ef, 128, smem);
    }
  }
}

#define ATT_KROW 400
#define ATT_VROW 144
#define MFMA16(a, b, c) __builtin_amdgcn_mfma_f32_32x32x16_bf16(a, b, c, 0, 0, 0)
__device__ __forceinline__ void attn_item(const bfraw* __restrict__ Qp, const bfraw* __restrict__ Kp, const bfraw* __restrict__ Vtp,
                                          int nk, float* __restrict__ Op, char* smem) {
  char* Ks = smem;
  char* Vs = smem + 64 * ATT_KROW;
  int tid_ = threadIdx.x; asm volatile("" : "+v"(tid_));
  const int tid = tid_, lane = tid & 63, wid = tid >> 6, l31 = lane & 31, lh = lane >> 5;
  bf16x8 qf[12];
  {
    const bfraw* qrow = Qp + (size_t)(wid * 32 + l31) * 192 + lh * 8;
#pragma unroll
    for (int ks = 0; ks < 12; ++ks) qf[ks] = *(const bf16x8*)(qrow + ks * 16);
  }
  f32x16 o[4];
#pragma unroll
  for (int d = 0; d < 4; ++d)
#pragma unroll
    for (int r = 0; r < 16; ++r) o[d][r] = 0.f;
  float m = -INFINITY, l = 0.f;
  uint4 rk0, rk1, rk2, rk3, rk4, rk5, rv0, rv1, rv2, rv3;
#define ATT_KSRC(n, kt) (Kp + (size_t)((kt) + (tid + 256 * (n)) / 24) * 192 + ((tid + 256 * (n)) % 24) * 8)
#define ATT_VSRC(n, kt) (Vtp + (size_t)((tid + 256 * (n)) >> 3) * NKEY + (kt) + ((tid + 256 * (n)) & 7) * 8)
#define ATT_GLOAD(kt)                                                                                        \
  {                                                                                                          \
    rk0 = *(const uint4*)ATT_KSRC(0, kt); rk1 = *(const uint4*)ATT_KSRC(1, kt); rk2 = *(const uint4*)ATT_KSRC(2, kt); \
    rk3 = *(const uint4*)ATT_KSRC(3, kt); rk4 = *(const uint4*)ATT_KSRC(4, kt); rk5 = *(const uint4*)ATT_KSRC(5, kt); \
    rv0 = *(const uint4*)ATT_VSRC(0, kt); rv1 = *(const uint4*)ATT_VSRC(1, kt);                              \
    rv2 = *(const uint4*)ATT_VSRC(2, kt); rv3 = *(const uint4*)ATT_VSRC(3, kt);                              \
  }
#define ATT_KDST(n) (Ks + ((tid + 256 * (n)) / 24) * ATT_KROW + ((tid + 256 * (n)) % 24) * 16)
#define ATT_VDST(n) (Vs + ((tid + 256 * (n)) >> 3) * ATT_VROW + ((tid + 256 * (n)) & 7) * 16)
#define ATT_SWRITE()                                                                                         \
  {                                                                                                          \
    *(uint4*)ATT_KDST(0) = rk0; *(uint4*)ATT_KDST(1) = rk1; *(uint4*)ATT_KDST(2) = rk2;                      \
    *(uint4*)ATT_KDST(3) = rk3; *(uint4*)ATT_KDST(4) = rk4; *(uint4*)ATT_KDST(5) = rk5;                      \
    *(uint4*)ATT_VDST(0) = rv0; *(uint4*)ATT_VDST(1) = rv1; *(uint4*)ATT_VDST(2) = rv2; *(uint4*)ATT_VDST(3) = rv3; \
  }
  __syncthreads();
  ATT_GLOAD(0)
  ATT_SWRITE()
  __syncthreads();
  for (int kt = 0; kt < nk; kt += 64) {
    const bool more = (kt + 64) < nk;
    if (more) ATT_GLOAD(kt + 64)
    f32x16 s0, s1;
#pragma unroll
    for (int r = 0; r < 16; ++r) { s0[r] = 0.f; s1[r] = 0.f; }
    const char* kp = Ks + l31 * ATT_KROW + lh * 16;
#pragma unroll
    for (int ks = 0; ks < 12; ++ks) {
      bf16x8 a0 = *(const bf16x8*)(kp + ks * 32);
      bf16x8 a1 = *(const bf16x8*)(kp + 32 * ATT_KROW + ks * 32);
      s0 = MFMA16(a0, qf[ks], s0);
      s1 = MFMA16(a1, qf[ks], s1);
    }
    float tmax = fmaxf(s0[0], s1[0]);
#pragma unroll
    for (int r = 1; r < 16; ++r) tmax = fmaxf(tmax, fmaxf(s0[r], s1[r]));
    tmax = fmaxf(tmax, __shfl_xor(tmax, 32));
    const float mn = fmaxf(m, tmax);
    const float alpha = __builtin_amdgcn_exp2f(m - mn);
    float rs = 0.f;
#pragma unroll
    for (int r = 0; r < 16; ++r) { s0[r] = __builtin_amdgcn_exp2f(s0[r] - mn); s1[r] = __builtin_amdgcn_exp2f(s1[r] - mn); rs += s0[r] + s1[r]; }
    rs += __shfl_xor(rs, 32);
    l = l * alpha + rs;
    m = mn;
    if (__any(alpha != 1.f)) {
#pragma unroll
      for (int d = 0; d < 4; ++d)
#pragma unroll
        for (int r = 0; r < 16; ++r) o[d][r] *= alpha;
    }
    bf16x8 pf[4];
    {
      uint4 t;
      t.x = pack_bf16(s0[0], s0[1]); t.y = pack_bf16(s0[2], s0[3]); t.z = pack_bf16(s0[4], s0[5]); t.w = pack_bf16(s0[6], s0[7]);
      pf[0] = __builtin_bit_cast(bf16x8, t);
      t.x = pack_bf16(s0[8], s0[9]); t.y = pack_bf16(s0[10], s0[11]); t.z = pack_bf16(s0[12], s0[13]); t.w = pack_bf16(s0[14], s0[15]);
      pf[1] = __builtin_bit_cast(bf16x8, t);
      t.x = pack_bf16(s1[0], s1[1]); t.y = pack_bf16(s1[2], s1[3]); t.z = pack_bf16(s1[4], s1[5]); t.w = pack_bf16(s1[6], s1[7]);
      pf[2] = __builtin_bit_cast(bf16x8, t);
      t.x = pack_bf16(s1[8], s1[9]); t.y = pack_bf16(s1[10], s1[11]); t.z = pack_bf16(s1[12], s1[13]); t.w = pack_bf16(s1[14], s1[15]);
      pf[3] = __builtin_bit_cast(bf16x8, t);
    }
    const char* vp = Vs + l31 * ATT_VROW + lh * 16;
#pragma unroll
    for (int g16 = 0; g16 < 4; ++g16) {
#pragma unroll
      for (int d = 0; d < 4; ++d) {
        bf16x8 a = *(const bf16x8*)(vp + d * 32 * ATT_VROW + g16 * 32);
        o[d] = MFMA16(a, pf[g16], o[d]);
      }
    }
    __syncthreads();
    if (more) ATT_SWRITE()
    __syncthreads();
  }
  const float inv = 1.f / l;
  float* tb = (float*)smem + wid * (32 * 129);
#pragma unroll
  for (int d = 0; d < 4; ++d)
#pragma unroll
    for (int r = 0; r < 16; ++r) tb[l31 * 129 + d * 32 + (r & 3) + 8 * (r >> 2) + 4 * lh] = o[d][r] * inv;
  __syncthreads();
  for (int i = lane; i < 32 * 32; i += 64) {
    const int q = i >> 5, c4 = i & 31;
    const float* s = tb + q * 129 + c4 * 4;
    *(float4*)(Op + (size_t)(wid * 32 + q) * 512 + c4 * 4) = make_float4(s[0], s[1], s[2], s[3]);
  }
  __syncthreads();
}

__device__ __forceinline__ int chunk_row0(int b, int cid) { return cid < 4 ? TLAT + b * CL + cid * 64 : b * SL + (cid - 4) * 64; }
__device__ __forceinline__ int step_of(int cid, int dir) { return dir == 0 ? cid : (cid < 4 ? 3 - cid : 71 - cid); }
__device__ __forceinline__ int cid_of(int s, int dir) { return dir == 0 ? s : (s < 4 ? 3 - s : 71 - s); }
#define MFMA32(a, b, c) __builtin_amdgcn_mfma_f32_32x32x2f32(a, b, c, 0, 0, 0)
#define ROW16(r, lh) (((r) & 3) + 8 * ((r) >> 2) + 4 * (lh))
__device__ __forceinline__ float wave_incl_scan(float v, int lane) {
#pragma unroll
  for (int o = 1; o < 64; o <<= 1) { float t = __shfl_up(v, o); if (lane >= o) v += t; }
  return v;
}

__device__ __forceinline__ void ssd_local_item(const P& p, int layer, int item, char* smem) {
  const int h = item & 7, cid = (item >> 3) % NSTEP, b = item / (8 * NSTEP);
  float* sx = (float*)smem;
  float* sB = sx + 4096;
  float* swf = sB + 64 * 129;
  float* swb = swf + 64;
  int tid_ = threadIdx.x; asm volatile("" : "+v"(tid_));
  const int tid = tid_, lane = tid & 63, wid = tid >> 6, l31 = lane & 31, lh = lane >> 5;
  const int row0 = chunk_row0(b, cid), g = h >> 2;
  __syncthreads();
  for (int i = tid; i < 1024; i += 256) {
    int q = i >> 4, c4 = i & 15;
    *(float4*)(sx + q * 64 + c4 * 4) = *(const float4*)(p.ssd_xs() + (size_t)(row0 + q) * 512 + h * 64 + c4 * 4);
  }
  for (int i = tid; i < 2048; i += 256) {
    int q = i >> 5, c4 = i & 31;
    float4 v = *(const float4*)(p.ssd_B() + (size_t)(row0 + q) * 256 + g * 128 + c4 * 4);
    float* d = sB + q * 129 + c4 * 4;
    d[0] = v.x; d[1] = v.y; d[2] = v.z; d[3] = v.w;
  }
  if (wid < 2) {
    const int dir = wid;
    const float A = -__expf(p.a_log[layer * 16 + dir * 8 + h]);
    const int q = dir ? 63 - lane : lane;
    const float dt = p.ssd_dt()[(size_t)(row0 + q) * 16 + dir * 8 + h];
    const float ac = wave_incl_scan(dt * A, lane);
    const float tot = __shfl(ac, 63);
    (dir ? swb : swf)[q] = __expf(tot - ac) * dt;
    if (lane == 0) p.ssd_atot()[((b * 2 + dir) * 8 + h) * NSTEP + step_of(cid, dir)] = tot;
  }
  __syncthreads();
  f32x16 acc[2][2];
#pragma unroll
  for (int d = 0; d < 2; ++d)
#pragma unroll
    for (int t = 0; t < 2; ++t)
#pragma unroll
      for (int r = 0; r < 16; ++r) acc[d][t][r] = 0.f;
  const int pi = wid & 1, jj = wid >> 1;
#pragma unroll 4
  for (int k = 0; k < 64; k += 2) {
    const int q = k + lh;
    const float xa = sx[q * 64 + pi * 32 + l31];
    const float af = xa * swf[q], ab = xa * swb[q];
    const float b0 = sB[q * 129 + (2 * jj) * 32 + l31], b1 = sB[q * 129 + (2 * jj + 1) * 32 + l31];
    acc[0][0] = MFMA32(af, b0, acc[0][0]); acc[0][1] = MFMA32(af, b1, acc[0][1]);
    acc[1][0] = MFMA32(ab, b0, acc[1][0]); acc[1][1] = MFMA32(ab, b1, acc[1][1]);
  }
#pragma unroll
  for (int d = 0; d < 2; ++d) {
    float* dst = p.ssd_st() + ((size_t)((b * 2 + d) * 8 + h) * NSTEP + step_of(cid, d)) * 8192;
#pragma unroll
    for (int t = 0; t < 2; ++t)
#pragma unroll
      for (int r = 0; r < 16; ++r) dst[(pi * 32 + ROW16(r, lh)) * 128 + (2 * jj + t) * 32 + l31] = acc[d][t][r];
  }
}

__device__ __forceinline__ void ssd_out_item(const P& p, int layer, int item, char* smem) {
  const int h = item & 7, cid = (item >> 3) % NSTEP, b = item / (8 * NSTEP);
  float* sC = (float*)smem;
  float* sBh = sC + 64 * 129;
  float* sx = sBh + 64 * 129;
  float* sP = sx + 4096;
  float* saf = sP + 64 * 65;
  float* sab = saf + 64;
  float* sdf = sab + 64;
  float* sdb = sdf + 64;
  int tid_ = threadIdx.x; asm volatile("" : "+v"(tid_));
  const int tid = tid_, lane = tid & 63, wid = tid >> 6, l31 = lane & 31, lh = lane >> 5;
  const int row0 = chunk_row0(b, cid), g = h >> 2;
  const float* hf = p.ssd_st() + ((size_t)((b * 2 + 0) * 8 + h) * NSTEP + step_of(cid, 0)) * 8192;
  const float* hb = p.ssd_st() + ((size_t)((b * 2 + 1) * 8 + h) * NSTEP + step_of(cid, 1)) * 8192;
  f32x4v hreg[8];
#pragma unroll
  for (int u = 0; u < 8; ++u) { const int i = tid + 256 * u; hreg[u] = *(const f32x4v*)(hf + (i >> 5) * 128 + (i & 31) * 4); }
  __syncthreads();
  for (int i = tid; i < 1024; i += 256) {
    int q = i >> 4, c4 = i & 15;
    *(float4*)(sx + q * 64 + c4 * 4) = *(const float4*)(p.ssd_xs() + (size_t)(row0 + q) * 512 + h * 64 + c4 * 4);
  }
  for (int i = tid; i < 2048; i += 256) {
    int q = i >> 5, c4 = i & 31;
    float4 v = *(const float4*)(p.ssd_B() + (size_t)(row0 + q) * 256 + g * 128 + c4 * 4);
    float* d = sBh + q * 129 + c4 * 4;
    d[0] = v.x; d[1] = v.y; d[2] = v.z; d[3] = v.w;
    float4 w = *(const float4*)(p.ssd_C() + (size_t)(row0 + q) * 256 + g * 128 + c4 * 4);
    float* e = sC + q * 129 + c4 * 4;
    e[0] = w.x; e[1] = w.y; e[2] = w.z; e[3] = w.w;
  }
  if (wid < 2) {
    const int dir = wid;
    const float A = -__expf(p.a_log[layer * 16 + dir * 8 + h]);
    const int q = dir ? 63 - lane : lane;
    const float dt = p.ssd_dt()[(size_t)(row0 + q) * 16 + dir * 8 + h];
    const float ac = wave_incl_scan(dt * A, lane);
    (dir ? sab : saf)[q] = ac;
    (dir ? sdb : sdf)[q] = dt;
  }
  __syncthreads();
  const int it = wid >> 1, jt = wid & 1;
  {
    f32x16 sa;
#pragma unroll
    for (int r = 0; r < 16; ++r) sa[r] = 0.f;
    const float* ap = sC + (it * 32 + l31) * 129 + lh;
    const float* bp = sBh + (jt * 32 + l31) * 129 + lh;
#pragma unroll 8
    for (int k = 0; k < 128; k += 2) sa = MFMA32(ap[k], bp[k], sa);
    const int j = jt * 32 + l31;
    const float afj = saf[j], abj = sab[j], dfj = sdf[j], dbj = sdb[j];
#pragma unroll
    for (int r = 0; r < 16; ++r) {
      const int i = it * 32 + ROW16(r, lh);
      float wgt = 0.f;
      if (j <= i) wgt += __expf(saf[i] - afj) * dfj;
      if (j >= i) wgt += __expf(sab[i] - abj) * dbj;
      sP[i * 65 + j] = sa[r] * wgt;
    }
  }
  __syncthreads();
#pragma unroll
  for (int u = 0; u < 8; ++u) {
    const int i = tid + 256 * u, q = i >> 5, c4 = i & 31;
    float* d = sBh + q * 129 + c4 * 4;
    d[0] = hreg[u][0]; d[1] = hreg[u][1]; d[2] = hreg[u][2]; d[3] = hreg[u][3];
  }
#pragma unroll
  for (int u = 0; u < 8; ++u) { const int i = tid + 256 * u; hreg[u] = *(const f32x4v*)(hb + (i >> 5) * 128 + (i & 31) * 4); }
  const int pt = wid & 1;
  f32x16 ya;
#pragma unroll
  for (int r = 0; r < 16; ++r) ya[r] = 0.f;
  {
    const float* ap = sP + (it * 32 + l31) * 65 + lh;
    const float* bp = sx + lh * 64 + pt * 32 + l31;
#pragma unroll 8
    for (int k = 0; k < 64; k += 2) ya = MFMA32(ap[k], bp[k * 64], ya);
  }
  __syncthreads();
  {
    const float ef = __expf(saf[it * 32 + l31]);
    const float* ap = sC + (it * 32 + l31) * 129 + lh;
    const float* bp = sBh + (pt * 32 + l31) * 129 + lh;
#pragma unroll 8
    for (int k = 0; k < 128; k += 2) ya = MFMA32(ap[k] * ef, bp[k], ya);
  }
  __syncthreads();
#pragma unroll
  for (int u = 0; u < 8; ++u) {
    const int i = tid + 256 * u, q = i >> 5, c4 = i & 31;
    float* d = sBh + q * 129 + c4 * 4;
    d[0] = hreg[u][0]; d[1] = hreg[u][1]; d[2] = hreg[u][2]; d[3] = hreg[u][3];
  }
  __syncthreads();
  {
    const float eb = __expf(sab[it * 32 + l31]);
    const float* ap = sC + (it * 32 + l31) * 129 + lh;
    const float* bp = sBh + (pt * 32 + l31) * 129 + lh;
#pragma unroll 8
    for (int k = 0; k < 128; k += 2) ya = MFMA32(ap[k] * eb, bp[k], ya);
  }
#pragma unroll
  for (int r = 0; r < 16; ++r)
    p.ssd_y()[(size_t)(row0 + it * 32 + ROW16(r, lh)) * 512 + h * 64 + pt * 32 + l31] = ya[r];
}

__device__ __forceinline__ void ml_gates(const P& p, int layer, int row0, int h, int dir, int lane, float& bcum, float& li, float& tot) {
  const int j = dir ? 63 - lane : lane;
  const float* z = p.Z() + (size_t)(row0 + j) * NIN + ZC_MG + dir * 8;
  li = z[h] + p.gate_b[layer * 16 + dir * 8 + h];
  const float gf = z[4 + h] + p.gate_b[layer * 16 + dir * 8 + 4 + h];
  const float lf = gf >= 0.f ? -log1pf(expf(-gf)) : gf - log1pf(expf(gf));
  bcum = wave_incl_scan(lf, lane);
  tot = __shfl(bcum, 63);
}
__device__ __forceinline__ void ml_local_item(const P& p, int layer, int item, char* smem) {
  const int h = item & 3, cid = (item >> 2) % NSTEP, b = item / (4 * NSTEP);
  float* sv = (float*)smem;
  float* sk = sv + 8192;
  float* swf = sk + 64 * 65;
  float* swb = swf + 64;
  int tid_ = threadIdx.x; asm volatile("" : "+v"(tid_));
  const int tid = tid_, lane = tid & 63, wid = tid >> 6, l31 = lane & 31, lh = lane >> 5;
  const int row0 = chunk_row0(b, cid);
  __syncthreads();
  for (int i = tid; i < 2048; i += 256) {
    int j = i >> 5, c4 = i & 31;
    *(float4*)(sv + j * 128 + c4 * 4) = *(const float4*)(p.Z() + (size_t)(row0 + j) * NIN + ZC_MV + h * 128 + c4 * 4);
  }
  for (int i = tid; i < 1024; i += 256) {
    int j = i >> 4, c4 = i & 15;
    float4 v = *(const float4*)(p.Z() + (size_t)(row0 + j) * NIN + ZC_MK + h * 64 + c4 * 4);
    float* d = sk + j * 65 + c4 * 4;
    d[0] = v.x; d[1] = v.y; d[2] = v.z; d[3] = v.w;
  }
  if (wid < 2) {
    const int dir = wid;
    float bc, li, tot;
    ml_gates(p, layer, row0, h, dir, lane, bc, li, tot);
    const int j = dir ? 63 - lane : lane;
    (dir ? swb : swf)[j] = __expf(tot - bc + li);
    if (lane == 0) p.ml_gtot()[((b * 2 + dir) * 4 + h) * NSTEP + step_of(cid, dir)] = tot;
  }
  __syncthreads();
  f32x16 acc[2][2];
#pragma unroll
  for (int d = 0; d < 2; ++d)
#pragma unroll
    for (int t = 0; t < 2; ++t)
#pragma unroll
      for (int r = 0; r < 16; ++r) acc[d][t][r] = 0.f;
  const int vt = wid;
#pragma unroll 4
  for (int k = 0; k < 64; k += 2) {
    const int j = k + lh;
    const float va = sv[j * 128 + vt * 32 + l31];
    const float af = va * swf[j], ab = va * swb[j];
    const float b0 = sk[j * 65 + l31], b1 = sk[j * 65 + 32 + l31];
    acc[0][0] = MFMA32(af, b0, acc[0][0]); acc[0][1] = MFMA32(af, b1, acc[0][1]);
    acc[1][0] = MFMA32(ab, b0, acc[1][0]); acc[1][1] = MFMA32(ab, b1, acc[1][1]);
  }
#pragma unroll
  for (int d = 0; d < 2; ++d) {
    float* dst = p.ml_st() + ((size_t)((b * 2 + d) * 4 + h) * NSTEP + step_of(cid, d)) * 8192;
#pragma unroll
    for (int t = 0; t < 2; ++t)
#pragma unroll
      for (int r = 0; r < 16; ++r) dst[(vt * 32 + ROW16(r, lh)) * 64 + t * 32 + l31] = acc[d][t][r];
  }
  if (tid < 128) {
    const int d = tid >> 6, kk = tid & 63;
    const float* w = d ? swb : swf;
    float sacc = 0.f;
    for (int j = 0; j < 64; ++j) sacc += w[j] * sk[j * 65 + kk];
    p.ml_nst()[((size_t)((b * 2 + d) * 4 + h) * NSTEP + step_of(cid, d)) * 64 + kk] = sacc;
  }
}

__device__ __forceinline__ void ml_out_item(const P& p, int layer, int item, char* smem) {
  const int h = item & 3, cid = (item >> 2) % NSTEP, b = item / (4 * NSTEP);
  float* sq = (float*)smem;
  float* sk = sq + 64 * 65;
  float* sv = sk + 64 * 65;
  float* sPf = sv + 128 * 65;
  float* sPb = sPf + 64 * 65;
  float* sbf = sPb + 64 * 65;
  float* sbb = sbf + 64;
  float* slf = sbb + 64;
  float* slb = slf + 64;
  float* sdenf = slb + 64;
  float* sdenb = sdenf + 64;
  float* snf = sdenb + 64;
  float* snb = snf + 64;
  int tid_ = threadIdx.x; asm volatile("" : "+v"(tid_));
  const int tid = tid_, lane = tid & 63, wid = tid >> 6, l31 = lane & 31, lh = lane >> 5;
  const int row0 = chunk_row0(b, cid);
  const size_t slotf = ((size_t)((b * 2 + 0) * 4 + h) * NSTEP + step_of(cid, 0));
  const size_t slotb = ((size_t)((b * 2 + 1) * 4 + h) * NSTEP + step_of(cid, 1));
  const float* csf = p.ml_st() + slotf * 8192;
  const float* csb = p.ml_st() + slotb * 8192;
  f32x4v creg[8];
#pragma unroll
  for (int u = 0; u < 8; ++u) { const int i = tid + 256 * u; creg[u] = *(const f32x4v*)(csf + (i >> 4) * 64 + (i & 15) * 4); }
  __syncthreads();
  for (int i = tid; i < 2048; i += 256) {
    int j = i >> 5, c4 = i & 31;
    *(float4*)(sv + j * 128 + c4 * 4) = *(const float4*)(p.Z() + (size_t)(row0 + j) * NIN + ZC_MV + h * 128 + c4 * 4);
  }
  for (int i = tid; i < 1024; i += 256) {
    int j = i >> 4, c4 = i & 15;
    float4 v = *(const float4*)(p.Z() + (size_t)(row0 + j) * NIN + ZC_MK + h * 64 + c4 * 4);
    float* d = sk + j * 65 + c4 * 4;
    d[0] = v.x; d[1] = v.y; d[2] = v.z; d[3] = v.w;
    float4 w = *(const float4*)(p.Z() + (size_t)(row0 + j) * NIN + ZC_MQ + h * 64 + c4 * 4);
    float* e = sq + j * 65 + c4 * 4;
    e[0] = w.x * 0.125f; e[1] = w.y * 0.125f; e[2] = w.z * 0.125f; e[3] = w.w * 0.125f;
  }
  if (wid < 2) {
    const int dir = wid;
    float bc, li, tot;
    ml_gates(p, layer, row0, h, dir, lane, bc, li, tot);
    const int j = dir ? 63 - lane : lane;
    (dir ? sbb : sbf)[j] = bc;
    (dir ? slb : slf)[j] = li;
    (dir ? snb : snf)[lane] = p.ml_nst()[(dir ? slotb : slotf) * 64 + lane];
  }
  __syncthreads();
  const int it = wid >> 1, jt = wid & 1;
  {
    f32x16 sa;
#pragma unroll
    for (int r = 0; r < 16; ++r) sa[r] = 0.f;
    const float* ap = sq + (it * 32 + l31) * 65 + lh;
    const float* bp = sk + (jt * 32 + l31) * 65 + lh;
#pragma unroll 8
    for (int k = 0; k < 64; k += 2) sa = MFMA32(ap[k], bp[k], sa);
    const int j = jt * 32 + l31;
    const float bfj = sbf[j], bbj = sbb[j], lfj = slf[j], lbj = slb[j];
#pragma unroll
    for (int r = 0; r < 16; ++r) {
      const int i = it * 32 + ROW16(r, lh);
      sPf[i * 65 + j] = j <= i ? sa[r] * __expf(sbf[i] - bfj + lfj) : 0.f;
      sPb[i * 65 + j] = j >= i ? sa[r] * __expf(sbb[i] - bbj + lbj) : 0.f;
    }
  }
  __syncthreads();
  if (tid < 128) {
    const int d = tid >> 6, i = tid & 63;
    const float* Pm = d ? sPb : sPf;
    const float* ns = d ? snb : snf;
    float rs = 0.f, qn = 0.f;
    for (int j = 0; j < 64; ++j) { rs += Pm[i * 65 + j]; qn += sq[i * 65 + j] * ns[j]; }
    (d ? sdenb : sdenf)[i] = rs + __expf((d ? sbb : sbf)[i]) * qn;
  }
  const int v0 = 2 * (wid & 1);
  f32x16 nf[2], nb[2];
#pragma unroll
  for (int t = 0; t < 2; ++t)
#pragma unroll
    for (int r = 0; r < 16; ++r) { nf[t][r] = 0.f; nb[t][r] = 0.f; }
  {
    const float* apf = sPf + (it * 32 + l31) * 65 + lh;
    const float* apb = sPb + (it * 32 + l31) * 65 + lh;
    const float* bp = sv + lh * 128 + v0 * 32 + l31;
#pragma unroll 4
    for (int k = 0; k < 64; k += 2) {
      const float af = apf[k], ab = apb[k], b0 = bp[k * 128], b1 = bp[k * 128 + 32];
      nf[0] = MFMA32(af, b0, nf[0]); nf[1] = MFMA32(af, b1, nf[1]);
      nb[0] = MFMA32(ab, b0, nb[0]); nb[1] = MFMA32(ab, b1, nb[1]);
    }
  }
  __syncthreads();
#pragma unroll
  for (int u = 0; u < 8; ++u) {
    const int i = tid + 256 * u, v = i >> 4, c4 = i & 15;
    float* d = sv + v * 65 + c4 * 4;
    d[0] = creg[u][0]; d[1] = creg[u][1]; d[2] = creg[u][2]; d[3] = creg[u][3];
  }
#pragma unroll
  for (int u = 0; u < 8; ++u) { const int i = tid + 256 * u; creg[u] = *(const f32x4v*)(csb + (i >> 4) * 64 + (i & 15) * 4); }
  __syncthreads();
  {
    const float e = __expf(sbf[it * 32 + l31]);
    const float* ap = sq + (it * 32 + l31) * 65 + lh;
    const float* bp = sv + (v0 * 32 + l31) * 65 + lh;
#pragma unroll 4
    for (int k = 0; k < 64; k += 2) {
      const float a = ap[k] * e;
      nf[0] = MFMA32(a, bp[k], nf[0]); nf[1] = MFMA32(a, bp[32 * 65 + k], nf[1]);
    }
  }
  __syncthreads();
#pragma unroll
  for (int u = 0; u < 8; ++u) {
    const int i = tid + 256 * u, v = i >> 4, c4 = i & 15;
    float* d = sv + v * 65 + c4 * 4;
    d[0] = creg[u][0]; d[1] = creg[u][1]; d[2] = creg[u][2]; d[3] = creg[u][3];
  }
  __syncthreads();
  {
    const float e = __expf(sbb[it * 32 + l31]);
    const float* ap = sq + (it * 32 + l31) * 65 + lh;
    const float* bp = sv + (v0 * 32 + l31) * 65 + lh;
#pragma unroll 4
    for (int k = 0; k < 64; k += 2) {
      const float a = ap[k] * e;
      nb[0] = MFMA32(a, bp[k], nb[0]); nb[1] = MFMA32(a, bp[32 * 65 + k], nb[1]);
    }
  }
#pragma unroll
  for (int r = 0; r < 16; ++r) {
    const int i = it * 32 + ROW16(r, lh);
    const float idf = 1.f / fmaxf(fabsf(sdenf[i]), 1.f), idb = 1.f / fmaxf(fabsf(sdenb[i]), 1.f);
#pragma unroll
    for (int t = 0; t < 2; ++t)
      p.ml_h()[(size_t)(row0 + i) * 512 + h * 128 + (v0 + t) * 32 + l31] = nf[t][r] * idf + nb[t][r] * idb;
  }
}

template <int MODE>
__device__ __forceinline__ void s5_wave_item(const P& p, int layer, int witem, char* smem) {
  int tid_ = threadIdx.x; asm volatile("" : "+v"(tid_));
  const int tid = tid_, lane = tid & 63, wid = tid >> 6;
  float* su = (float*)smem + wid * 3136;
  float* sX = su + 1024;
  const int g = witem & 31, st = (witem >> 5) % NSTEP, dir = (witem / (32 * NSTEP)) & 1, b = witem / (64 * NSTEP);
  const int cid = cid_of(st, dir), row0 = chunk_row0(b, cid);
  const int dg = (layer * 2 + dir) * 32 + g;
  const float ar = p.s5_a()[(dg * 64 + lane) * 2], ai = p.s5_a()[(dg * 64 + lane) * 2 + 1];
  float bbr[16], bbi[16];
  {
    const float4* bt = (const float4*)(p.s5_bb() + (size_t)(dg * 64 + lane) * 32);
#pragma unroll
    for (int c4 = 0; c4 < 4; ++c4) {
      float4 v = bt[c4]; bbr[c4 * 4] = v.x; bbr[c4 * 4 + 1] = v.y; bbr[c4 * 4 + 2] = v.z; bbr[c4 * 4 + 3] = v.w;
      float4 w = bt[4 + c4]; bbi[c4 * 4] = w.x; bbi[c4 * 4 + 1] = w.y; bbi[c4 * 4 + 2] = w.z; bbi[c4 * 4 + 3] = w.w;
    }
  }
#pragma unroll
  for (int q = 0; q < 4; ++q) {
    const int t = q * 16 + (lane >> 2), c4 = lane & 3;
    const int row = dir ? row0 + 63 - t : row0 + t;
    *(float4*)(su + t * 16 + c4 * 4) = *(const float4*)(p.Z() + (size_t)row * NIN + ZC_U + g * 16 + c4 * 4);
  }
  const size_t slot = ((size_t)((b * 2 + dir) * 32 + g) * NSTEP + st);
  float xr = 0.f, xi = 0.f;
  float cm[32];
  if (MODE == 1) {
    xr = p.s5_st()[(slot * 64 + lane) * 2]; xi = p.s5_st()[(slot * 64 + lane) * 2 + 1];
    const int c = lane & 15, kq = lane >> 4;
#pragma unroll
    for (int ks = 0; ks < 32; ++ks) {
      const int pp = 4 * ks + kq;
      cm[ks] = ks < 16 ? p.c_re[((size_t)(layer * 32 + g) * 16 + c) * 64 + pp] : -p.c_im[((size_t)(layer * 32 + g) * 16 + c) * 64 + pp - 64];
    }
  }
  float* rout = dir ? p.s5_rb() : p.s5_rf();
#pragma unroll 1
  for (int sb = 0; sb < 4; ++sb) {
#pragma unroll 4
    for (int tt = 0; tt < 16; ++tt) {
      const int t = sb * 16 + tt;
      float ur = 0.f, ui = 0.f;
#pragma unroll
      for (int c4 = 0; c4 < 4; ++c4) {
        float4 uu = *(const float4*)(su + t * 16 + c4 * 4);
        ur += bbr[c4 * 4] * uu.x + bbr[c4 * 4 + 1] * uu.y + bbr[c4 * 4 + 2] * uu.z + bbr[c4 * 4 + 3] * uu.w;
        ui += bbi[c4 * 4] * uu.x + bbi[c4 * 4 + 1] * uu.y + bbi[c4 * 4 + 2] * uu.z + bbi[c4 * 4 + 3] * uu.w;
      }
      const float nr = ar * xr - ai * xi + ur;
      const float ni = ar * xi + ai * xr + ui;
      xr = nr; xi = ni;
      if (MODE == 1) { sX[tt * 130 + lane] = xr; sX[tt * 130 + 64 + lane] = xi; }
    }
    if (MODE == 1) {
      f32x4v d0 = {0.f, 0.f, 0.f, 0.f}, d1 = {0.f, 0.f, 0.f, 0.f};
      const float* ap = sX + (lane & 15) * 130 + (lane >> 4);
#pragma unroll
      for (int ks = 0; ks < 32; ks += 2) {
        d0 = __builtin_amdgcn_mfma_f32_16x16x4f32(ap[4 * ks], cm[ks], d0, 0, 0, 0);
        d1 = __builtin_amdgcn_mfma_f32_16x16x4f32(ap[4 * ks + 4], cm[ks + 1], d1, 0, 0, 0);
      }
#pragma unroll
      for (int r = 0; r < 4; ++r) {
        const int t = sb * 16 + (lane >> 4) * 4 + r;
        const int row = dir ? row0 + 63 - t : row0 + t;
        rout[(size_t)row * 512 + g * 16 + (lane & 15)] = d0[r] + d1[r];
      }
    }
  }
  if (MODE == 0) { p.s5_st()[(slot * 64 + lane) * 2] = xr; p.s5_st()[(slot * 64 + lane) * 2 + 1] = xi; }
}

__device__ __forceinline__ float gelu_tanh(float x) {
  const float k0 = 0.7978845608028654f;
  return 0.5f * x * (1.f + tanhf(k0 * (x + 0.044715f * x * x * x)));
}
__device__ __forceinline__ void s5_out_item(const P& p, int layer, int witem, char* smem) {
  int tid_ = threadIdx.x; asm volatile("" : "+v"(tid_));
  const int tid = tid_, lane = tid & 63, wid = tid >> 6;
  float* su = (float*)smem + wid * 3136;
  float* sX = su + 1024;
  const int g = witem & 31, cid = (witem >> 5) % NSTEP, b = witem / (32 * NSTEP);
  const int row0 = chunk_row0(b, cid);
#pragma unroll
  for (int q = 0; q < 4; ++q) {
    const int t = q * 16 + (lane >> 2), c4 = lane & 3;
    *(float4*)(su + t * 16 + c4 * 4) = *(const float4*)(p.Z() + (size_t)(row0 + t) * NIN + ZC_U + g * 16 + c4 * 4);
  }
  float cm[32];
  {
    const int c = lane & 15, kq = lane >> 4;
#pragma unroll
    for (int ks = 0; ks < 32; ++ks) {
      const int pp = 4 * ks + kq;
      cm[ks] = ks < 16 ? p.c_re[((size_t)(layer * 32 + g) * 16 + c) * 64 + pp] : -p.c_im[((size_t)(layer * 32 + g) * 16 + c) * 64 + pp - 64];
    }
  }
  f32x4v ydf[4], ydb[4];
#pragma unroll
  for (int sb = 0; sb < 4; ++sb) { ydf[sb] = (f32x4v){0.f, 0.f, 0.f, 0.f}; ydb[sb] = ydf[sb]; }
#pragma unroll 1
  for (int dir = 0; dir < 2; ++dir) {
    const int st = step_of(cid, dir);
    const int dg = (layer * 2 + dir) * 32 + g;
    const size_t slot = ((size_t)((b * 2 + dir) * 32 + g) * NSTEP + st);
    const float ar = p.s5_a()[(dg * 64 + lane) * 2], ai = p.s5_a()[(dg * 64 + lane) * 2 + 1];
    float xr = p.s5_st()[(slot * 64 + lane) * 2], xi = p.s5_st()[(slot * 64 + lane) * 2 + 1];
    float bbr[16], bbi[16];
    {
      const float4* bt = (const float4*)(p.s5_bb() + (size_t)(dg * 64 + lane) * 32);
#pragma unroll
      for (int c4 = 0; c4 < 4; ++c4) {
        float4 v = bt[c4]; bbr[c4 * 4] = v.x; bbr[c4 * 4 + 1] = v.y; bbr[c4 * 4 + 2] = v.z; bbr[c4 * 4 + 3] = v.w;
        float4 w = bt[4 + c4]; bbi[c4 * 4] = w.x; bbi[c4 * 4 + 1] = w.y; bbi[c4 * 4 + 2] = w.z; bbi[c4 * 4 + 3] = w.w;
      }
    }
#pragma unroll
    for (int sb = 0; sb < 4; ++sb) {
#pragma unroll 4
      for (int tt = 0; tt < 16; ++tt) {
        const int tp = sb * 16 + tt;
        const int t = dir ? 63 - tp : tp;
        float ur = 0.f, ui = 0.f;
#pragma unroll
        for (int c4 = 0; c4 < 4; ++c4) {
          float4 uu = *(const float4*)(su + t * 16 + c4 * 4);
          ur += bbr[c4 * 4] * uu.x + bbr[c4 * 4 + 1] * uu.y + bbr[c4 * 4 + 2] * uu.z + bbr[c4 * 4 + 3] * uu.w;
          ui += bbi[c4 * 4] * uu.x + bbi[c4 * 4 + 1] * uu.y + bbi[c4 * 4 + 2] * uu.z + bbi[c4 * 4 + 3] * uu.w;
        }
        const float nr = ar * xr - ai * xi + ur;
        const float ni = ar * xi + ai * xr + ui;
        xr = nr; xi = ni;
        sX[tt * 130 + lane] = xr; sX[tt * 130 + 64 + lane] = xi;
      }
      f32x4v d0 = {0.f, 0.f, 0.f, 0.f}, d1 = {0.f, 0.f, 0.f, 0.f};
      const float* ap = sX + (lane & 15) * 130 + (lane >> 4);
#pragma unroll
      for (int ks = 0; ks < 32; ks += 2) {
        d0 = __builtin_amdgcn_mfma_f32_16x16x4f32(ap[4 * ks], cm[ks], d0, 0, 0, 0);
        d1 = __builtin_amdgcn_mfma_f32_16x16x4f32(ap[4 * ks + 4], cm[ks + 1], d1, 0, 0, 0);
      }
      if (dir == 0) ydf[sb] = d0 + d1; else ydb[sb] = d0 + d1;
    }
  }
  const int c = lane & 15, q = lane >> 4;
  const float dsk = p.s5_d[layer * 512 + g * 16 + c];
  const int src = c + 16 * (3 - q);
#pragma unroll
  for (int sbo = 0; sbo < 4; ++sbo)
#pragma unroll
    for (int r = 0; r < 4; ++r) {
      const float yb = __shfl(ydb[3 - sbo][3 - r], src);
      const int t = 16 * sbo + 4 * q + r;
      const float y = ydf[sbo][r] + yb + dsk * su[t * 16 + c];
      const float gy = gelu_tanh(y);
      const size_t o = (size_t)(row0 + t) * 512 + g * 16 + c;
      p.ydpre()[o] = gy;
      p.ydpre_bf()[o] = to_bf16(gy);
    }
}


#define N_SSD_CH (2 * NSTEP * 8)
#define N_ML_CH (2 * NSTEP * 4)
#define N_S5_BLK (2 * 2 * NSTEP * 32 / 4)
__device__ __forceinline__ void ph_mixA(const P& p, int layer, int bid, char* smem) {
  for (int w = bid; w < N_SSD_CH + N_ML_CH + N_S5_BLK; w += gridDim.x) {
    if (w < N_SSD_CH) ssd_local_item(p, layer, w, smem);
    else if (w < N_SSD_CH + N_ML_CH) ml_local_item(p, layer, w - N_SSD_CH, smem);
    else { __syncthreads(); s5_wave_item<0>(p, layer, (w - N_SSD_CH - N_ML_CH) * 4 + (threadIdx.x >> 6), smem); }
  }
}
#define N_ATT_LAT 256
#define N_ATT_CTX 16
__device__ __forceinline__ void ph_scan(const P& p, int layer, int bid, char* smem) {
  const int nitems = 256 + 128 + 4 + 32;
  const int tid = threadIdx.x;
  for (int w = bid; w < nitems; w += gridDim.x) {
    int it = w;
    if (it < 256) {
      const int idx = it * 256 + tid, seq = idx >> 11, off = idx & 2047;
      float4* base = (float4*)(p.ssd_st() + (size_t)seq * NSTEP * 8192) + off;
      const float* at = p.ssd_atot() + seq * NSTEP;
      float4 hh = make_float4(0.f, 0.f, 0.f, 0.f);
#pragma unroll 4
      for (int s2 = 0; s2 < NSTEP; ++s2) {
        float4 t = base[(size_t)s2 * 2048];
        base[(size_t)s2 * 2048] = hh;
        const float e = expf(at[s2]);
        hh.x = e * hh.x + t.x; hh.y = e * hh.y + t.y; hh.z = e * hh.z + t.z; hh.w = e * hh.w + t.w;
      }
      continue;
    }
    it -= 256;
    if (it < 128) {
      const int idx = it * 256 + tid, seq = idx >> 11, off = idx & 2047;
      float4* base = (float4*)(p.ml_st() + (size_t)seq * NSTEP * 8192) + off;
      const float* at = p.ml_gtot() + seq * NSTEP;
      float4 hh = make_float4(0.f, 0.f, 0.f, 0.f);
#pragma unroll 4
      for (int s2 = 0; s2 < NSTEP; ++s2) {
        float4 t = base[(size_t)s2 * 2048];
        base[(size_t)s2 * 2048] = hh;
        const float e = expf(at[s2]);
        hh.x = e * hh.x + t.x; hh.y = e * hh.y + t.y; hh.z = e * hh.z + t.z; hh.w = e * hh.w + t.w;
      }
      continue;
    }
    it -= 128;
    if (it < 4) {
      const int idx = it * 256 + tid, seq = idx >> 6, off = idx & 63;
      float* base = p.ml_nst() + (size_t)seq * NSTEP * 64 + off;
      const float* at = p.ml_gtot() + seq * NSTEP;
      float hh = 0.f;
      for (int s2 = 0; s2 < NSTEP; ++s2) {
        float t = base[s2 * 64]; base[s2 * 64] = hh;
        hh = expf(at[s2]) * hh + t;
      }
      continue;
    }
    it -= 4;
    {
      const int idx = it * 256 + tid, seq = idx >> 6, sp = idx & 63;
      const int g = seq & 31, dir = (seq >> 5) & 1;
      const int dg = (layer * 2 + dir) * 32 + g;
      float pr = p.s5_a()[(dg * 64 + sp) * 2], pi = p.s5_a()[(dg * 64 + sp) * 2 + 1];
#pragma unroll
      for (int q = 0; q < 6; ++q) { float nr = pr * pr - pi * pi, ni = 2.f * pr * pi; pr = nr; pi = ni; }
      float* base = p.s5_st() + ((size_t)seq * NSTEP * 64 + sp) * 2;
      float xr = 0.f, xi = 0.f;
      for (int s2 = 0; s2 < NSTEP; ++s2) {
        float tr = base[s2 * 128], ti = base[s2 * 128 + 1];
        base[s2 * 128] = xr; base[s2 * 128 + 1] = xi;
        float nr = pr * xr - pi * xi + tr, ni = pr * xi + pi * xr + ti;
        xr = nr; xi = ni;
      }
    }
  }
}
__device__ __forceinline__ void ph_attn(const P& p, int layer, int bid, char* smem) {
  const int natt = N_ATT_LAT + (layer == 0 ? N_ATT_CTX : 0);
  for (int w = bid; w < natt; w += gridDim.x) {
    int it = w;
    const bfraw *qp, *kp, *vp; float* op; int nk;
    if (it < N_ATT_LAT) {
      int qb = it & 31, hh = (it >> 5) & 3, b = it >> 7;
      qp = p.Q() + ((size_t)(b * 4 + hh) * SL + qb * 128) * 192; kp = p.K() + (size_t)(b * 4 + hh) * NKEY * 192;
      vp = p.V() + (size_t)(b * 4 + hh) * 128 * NKEY; nk = NKEY; op = p.O() + (size_t)(b * SL + qb * 128) * 512 + hh * 128;
    } else {
      it -= N_ATT_LAT;
      int qb = it & 1, hh = (it >> 1) & 3, b = it >> 3;
      qp = p.Qc() + ((size_t)(b * 4 + hh) * CL + qb * 128) * 192; kp = p.K() + ((size_t)(b * 4 + hh) * NKEY + SL) * 192;
      vp = p.V() + (size_t)(b * 4 + hh) * 128 * NKEY + SL; nk = CL; op = p.O() + (size_t)(TLAT + b * CL + qb * 128) * 512 + hh * 128;
    }
    attn_item(qp, kp, vp, nk, op, smem);
  }
}
__device__ __forceinline__ void ph_mixC(const P& p, int layer, int bid, char* smem) {
  for (int w = bid; w < N_SSD_CH + N_ML_CH + N_S5_BLK / 2; w += gridDim.x) {
    if (w < N_SSD_CH) ssd_out_item(p, layer, w, smem);
    else if (w < N_SSD_CH + N_ML_CH) ml_out_item(p, layer, w - N_SSD_CH, smem);
    else { __syncthreads(); s5_out_item(p, layer, (w - N_SSD_CH - N_ML_CH) * 4 + (threadIdx.x >> 6), smem); }
  }
}

__device__ __forceinline__ void ph_glu(const P& p, int layer, int bid, char* smem) {
  const float* yp = p.ydpre(); float* yg = p.ydg(); const float* gb = p.glu_b + layer * 512;
  auto epi = [=](int row, int col, float v) {
    float y = yp[(size_t)row * 512 + col];
    yg[(size_t)row * 512 + col] = y * sigmoidf_(v + gb[col]);
  };
  gemm_dense<4>(p.ydpre_bf(), 512, p.glu_w + (size_t)layer * 512 * 512, 512, TTOT, 512, 512, epi, bid, smem);
}

__device__ __forceinline__ void ph_final_mix(const P& p, int layer, int bid, char* smem) {
  const int tid = threadIdx.x, lane = tid & 63, wid = tid >> 6;
  const float* onw = p.out_norm_w + layer * 2048;
  for (int r = bid * 4 + wid; r < TTOT; r += gridDim.x * 4) {
    const float* z = p.Z() + (size_t)r * NIN;
    bfraw* Y = p.Y() + (size_t)r * LDH;
    const int c = lane * 8;
    f32x4v a0 = *(const f32x4v*)(p.O() + (size_t)r * 512 + c), a1 = *(const f32x4v*)(p.O() + (size_t)r * 512 + c + 4);
    f32x4v y0 = *(const f32x4v*)(p.ssd_y() + (size_t)r * 512 + c), y1 = *(const f32x4v*)(p.ssd_y() + (size_t)r * 512 + c + 4);
    f32x4v x0 = *(const f32x4v*)(p.ssd_xs() + (size_t)r * 512 + c), x1 = *(const f32x4v*)(p.ssd_xs() + (size_t)r * 512 + c + 4);
    f32x4v g0 = *(const f32x4v*)(z + ZC_BZ + c), g1 = *(const f32x4v*)(z + ZC_BZ + c + 4);
    f32x4v h0 = *(const f32x4v*)(p.ml_h() + (size_t)r * 512 + c), h1 = *(const f32x4v*)(p.ml_h() + (size_t)r * 512 + c + 4);
    f32x4v o0 = *(const f32x4v*)(z + ZC_MO + c), o1 = *(const f32x4v*)(z + ZC_MO + c + 4);
    f32x4v d0 = *(const f32x4v*)(p.ydg() + (size_t)r * 512 + c), d1 = *(const f32x4v*)(p.ydg() + (size_t)r * 512 + c + 4);
    const float dsk = p.ssd_d[layer * 8 + (c >> 6)];
    float sa = 0.f, sb = 0.f, sc = 0.f, sd = 0.f;
    float bv[8], av[8], cv[8], dv[8];
#pragma unroll
    for (int i = 0; i < 4; ++i) {
      av[i] = a0[i]; av[4 + i] = a1[i];
      bv[i] = (y0[i] + dsk * x0[i]) * siluf_(g0[i]); bv[4 + i] = (y1[i] + dsk * x1[i]) * siluf_(g1[i]);
      cv[i] = h0[i]; cv[4 + i] = h1[i];
      dv[i] = d0[i]; dv[4 + i] = d1[i];
    }
#pragma unroll
    for (int i = 0; i < 8; ++i) { sa += av[i] * av[i]; sb += bv[i] * bv[i]; sc += cv[i] * cv[i]; sd += dv[i] * dv[i]; }
    sa = wave_sum(sa); sb = wave_sum(sb); sd = wave_sum(sd);
    sc += __shfl_xor(sc, 1); sc += __shfl_xor(sc, 2); sc += __shfl_xor(sc, 4); sc += __shfl_xor(sc, 8);
    const float ra = rsqrtf(sa * (1.f / 512.f) + EPSV), rb = rsqrtf(sb * (1.f / 512.f) + EPSV);
    const float rc = rsqrtf(sc * (1.f / 128.f) + EPSV), rd = rsqrtf(sd * (1.f / 512.f) + EPSV);
    float ogv[8];
#pragma unroll
    for (int i = 0; i < 4; ++i) { ogv[i] = sigmoidf_(o0[i]); ogv[4 + i] = sigmoidf_(o1[i]); }
    uint4 ua, ub, uc, ud;
    const float* w = onw + c;
    ua.x = pack_bf16(av[0] * ra * w[0], av[1] * ra * w[1]); ua.y = pack_bf16(av[2] * ra * w[2], av[3] * ra * w[3]);
    ua.z = pack_bf16(av[4] * ra * w[4], av[5] * ra * w[5]); ua.w = pack_bf16(av[6] * ra * w[6], av[7] * ra * w[7]);
    w = onw + 512 + c;
    ub.x = pack_bf16(bv[0] * rb * w[0], bv[1] * rb * w[1]); ub.y = pack_bf16(bv[2] * rb * w[2], bv[3] * rb * w[3]);
    ub.z = pack_bf16(bv[4] * rb * w[4], bv[5] * rb * w[5]); ub.w = pack_bf16(bv[6] * rb * w[6], bv[7] * rb * w[7]);
    w = onw + 1024 + c;
    uc.x = pack_bf16(cv[0] * rc * ogv[0] * w[0], cv[1] * rc * ogv[1] * w[1]); uc.y = pack_bf16(cv[2] * rc * ogv[2] * w[2], cv[3] * rc * ogv[3] * w[3]);
    uc.z = pack_bf16(cv[4] * rc * ogv[4] * w[4], cv[5] * rc * ogv[5] * w[5]); uc.w = pack_bf16(cv[6] * rc * ogv[6] * w[6], cv[7] * rc * ogv[7] * w[7]);
    w = onw + 1536 + c;
    ud.x = pack_bf16(dv[0] * rd * w[0], dv[1] * rd * w[1]); ud.y = pack_bf16(dv[2] * rd * w[2], dv[3] * rd * w[3]);
    ud.z = pack_bf16(dv[4] * rd * w[4], dv[5] * rd * w[5]); ud.w = pack_bf16(dv[6] * rd * w[6], dv[7] * rd * w[7]);
    *(uint4*)(Y + c) = ua; *(uint4*)(Y + 512 + c) = ub; *(uint4*)(Y + 1024 + c) = uc; *(uint4*)(Y + 1536 + c) = ud;
  }
}

__device__ __forceinline__ void ph_wout(const P& p, int layer, int bid, char* smem) {
  const P pp = p;
  const int M = layer == 0 ? TTOT : TLAT;
  auto epi = [=](int row, int col, float v) {
    const int mi = row_modidx(row);
    const float g1 = pp.modv()[(layer * 3 + mi) * 12288 + 2 * 2048 + col];
    float xin;
    if (layer == 0) xin = row < TLAT ? pp.x[(size_t)row * 2048 + col] : pp.ctx[(size_t)(row - TLAT) * 2048 + col];
    else xin = pp.X()[(size_t)row * 2048 + col];
    pp.X()[(size_t)row * 2048 + col] = xin + g1 * v;
  };
  gemm_dense_hybrid(p.Y(), LDH, p.w_out + (size_t)layer * 2048 * 2048, 2048, M, 2048, 2048, epi, bid, smem);
}

__device__ __forceinline__ void ph_router(const P& p, int layer, int bid, char* smem) {
  float* sA = (float*)smem;
  float* sW = sA + 32 * 129;
  float* sNW = sW + 128 * 64;
  float* sSH = sNW + 2048;
  float* srs = sSH + 2048;
  float* sL = srs + 32;
  const int tid = threadIdx.x, lane = tid & 63, wid = tid >> 6, l31 = lane & 31, lh = lane >> 5;
  const int T = layer == 0 ? TTOT : TLAT;
  const float* nw = p.norm2_w + layer * 2048;
  const float* wg = p.w_group + (size_t)layer * 2048 * 4;
  const float* we = p.w_expert + (size_t)layer * 2048 * 32;
  __syncthreads();
  for (int i = tid; i < 128 * 28; i += 256) sW[(i / 28) * 64 + 36 + (i % 28)] = 0.f;
  const int ar = tid >> 3, aks = (tid & 7) * 16;
  const int wk = tid >> 1, whalf = tid & 1;
  for (int item = bid; item < (T >> 5); item += gridDim.x) {
    const int row0 = item * 32;
    const int mi = row_modidx(row0);
    const float* mrow = p.modv() + (layer * 3 + mi) * 12288;
    __syncthreads();
    for (int i = tid; i < 2048; i += 256) { sNW[i] = nw[i] * (1.f + mrow[4 * 2048 + i]); sSH[i] = mrow[3 * 2048 + i]; }
#pragma unroll 2
    for (int rr = 0; rr < 8; ++rr) {
      const float* xr = p.X() + (size_t)(row0 + wid * 8 + rr) * 2048 + lane * 4;
      float ss = 0.f;
#pragma unroll
      for (int i = 0; i < 8; ++i) { float4 v = *(const float4*)(xr + i * 256); ss += v.x * v.x + v.y * v.y + v.z * v.z + v.w * v.w; }
      ss = wave_sum(ss);
      if (lane == 0) srs[wid * 8 + rr] = rsqrtf(ss * (1.f / 2048.f) + EPSV);
    }
    __syncthreads();
    const float rs = srs[ar];
    const float* xrow = p.X() + (size_t)(row0 + ar) * 2048 + aks;
    bfraw* hrow = p.H() + (size_t)(row0 + ar) * LDH + aks;
    float4 xa0, xa1, xa2, xa3, wv0, wv1, wv2, wv3, wv4;
#define RT_GLOAD(k0)                                                                                   \
    {                                                                                                  \
      xa0 = *(const float4*)(xrow + (k0)); xa1 = *(const float4*)(xrow + (k0) + 4);                    \
      xa2 = *(const float4*)(xrow + (k0) + 8); xa3 = *(const float4*)(xrow + (k0) + 12);               \
      const float* er = we + (size_t)((k0) + wk) * 32 + (whalf ? 12 : 0);                              \
      wv0 = *(const float4*)(er); wv1 = *(const float4*)(er + 4); wv2 = *(const float4*)(er + 8);      \
      wv3 = *(const float4*)(er + 12); wv4 = *(const float4*)(er + 16);                                \
      if (!whalf) wv3 = *(const float4*)(wg + (size_t)((k0) + wk) * 4);                                \
    }
#define RT_A4(q, v)                                                                                    \
    {                                                                                                  \
      const int kq = (k0w) + aks + (q) * 4;                                                            \
      float h0 = v.x * rs * sNW[kq] + sSH[kq], h1 = v.y * rs * sNW[kq + 1] + sSH[kq + 1];              \
      float h2 = v.z * rs * sNW[kq + 2] + sSH[kq + 2], h3 = v.w * rs * sNW[kq + 3] + sSH[kq + 3];      \
      float* d = sA + ar * 129 + aks + (q) * 4; d[0] = h0; d[1] = h1; d[2] = h2; d[3] = h3;            \
      uint2 hb; hb.x = pack_bf16(h0, h1); hb.y = pack_bf16(h2, h3);                                    \
      *(uint2*)(hrow + (k0w) + (q) * 4) = hb;                                                          \
    }
#define RT_SWRITE()                                                                                    \
    {                                                                                                  \
      RT_A4(0, xa0) RT_A4(1, xa1) RT_A4(2, xa2) RT_A4(3, xa3)                                          \
      float* w = sW + wk * 64;                                                                         \
      if (!whalf) {                                                                                    \
        w[0] = wv3.x; w[1] = wv3.y; w[2] = wv3.z; w[3] = wv3.w;                                        \
        w[4] = wv0.x; w[5] = wv0.y; w[6] = wv0.z; w[7] = wv0.w; w[8] = wv1.x; w[9] = wv1.y; w[10] = wv1.z; w[11] = wv1.w; \
        w[12] = wv2.x; w[13] = wv2.y; w[14] = wv2.z; w[15] = wv2.w;                                    \
      } else {                                                                                         \
        w[16] = wv0.x; w[17] = wv0.y; w[18] = wv0.z; w[19] = wv0.w; w[20] = wv1.x; w[21] = wv1.y; w[22] = wv1.z; w[23] = wv1.w; \
        w[24] = wv2.x; w[25] = wv2.y; w[26] = wv2.z; w[27] = wv2.w; w[28] = wv3.x; w[29] = wv3.y; w[30] = wv3.z; w[31] = wv3.w; \
        w[32] = wv4.x; w[33] = wv4.y; w[34] = wv4.z; w[35] = wv4.w;                                    \
      }                                                                                                \
    }
    int k0w = 0;
    RT_GLOAD(0)
    RT_SWRITE()
    __syncthreads();
    f32x16 acc;
#pragma unroll
    for (int r = 0; r < 16; ++r) acc[r] = 0.f;
    const int ct = wid & 1, kh = wid >> 1;
    const float* ap = sA + l31 * 129 + kh * 64 + lh;
    const float* bp = sW + (kh * 64 + lh) * 64 + ct * 32 + l31;
    for (int k0 = 0; k0 < 2048; k0 += 128) {
      const bool more = (k0 + 128) < 2048;
      if (more) RT_GLOAD(k0 + 128)
#pragma unroll 8
      for (int kk = 0; kk < 32; ++kk) acc = MFMA32(ap[2 * kk], bp[2 * kk * 64], acc);
      __syncthreads();
      k0w = k0 + 128;
      if (more) RT_SWRITE()
      __syncthreads();
    }
#pragma unroll
    for (int r = 0; r < 16; ++r) sL[(kh * 32 + ROW16(r, lh)) * 64 + ct * 32 + l31] = acc[r];
    __syncthreads();
    if (tid < 32) {
      const int r = row0 + tid;
      const float* l0 = sL + tid * 64;
      const float* l1 = sL + (32 + tid) * 64;
      int gi = 0; float gm = l0[0] + l1[0];
      float gl[4]; gl[0] = gm;
#pragma unroll
      for (int j = 1; j < 4; ++j) { gl[j] = l0[j] + l1[j]; if (gl[j] > gm) { gm = gl[j]; gi = j; } }
      float gs = 0.f;
#pragma unroll
      for (int j = 0; j < 4; ++j) gs += expf(gl[j] - gm);
      const float gw = 1.f / gs;
      int i1 = 0, i2 = -1; float v1 = -INFINITY, v2 = -INFINITY;
      for (int j = 0; j < 8; ++j) {
        const float e = l0[4 + gi * 8 + j] + l1[4 + gi * 8 + j];
        if (e > v1) { v2 = v1; i2 = i1; v1 = e; i1 = j; }
        else if (e > v2) { v2 = e; i2 = j; }
      }
      const float e2 = expf(v2 - v1);
      const float w1 = gw / (1.f + e2), w2 = gw * e2 / (1.f + e2);
      const int ex1 = gi * 8 + i1, ex2 = gi * 8 + i2;
      int* cnt = p.cnt() + layer * 32;
      const int p1 = atomicAdd(&cnt[ex1], 1);
      p.list_tok()[ex1 * CAPE + p1] = r * 2; p.list_w()[ex1 * CAPE + p1] = w1;
      const int p2 = atomicAdd(&cnt[ex2], 1);
      p.list_tok()[ex2 * CAPE + p2] = r * 2 + 1; p.list_w()[ex2 * CAPE + p2] = w2;
    }
  }
}

struct AGather { const bfraw* H; const int* toks; int nvalid;
  __device__ __forceinline__ const bfraw* row(int r) const { return r < nvalid ? H + (size_t)(toks[r] >> 1) * LDH : nullptr; }
  __device__ __forceinline__ const bfraw* safe() const { return H; } };
struct BGateUp { const float *g, *u; int ldb; int nb;
  __device__ __forceinline__ const float* col(int v) const { int wc = v >> 6, j = (v >> 5) & 1, c = v & 31;
    const float* b = g + (ptrdiff_t)j * (u - g); return b + nb + wc * 32 + c; }
  __device__ __forceinline__ const float* safe() const { return g; } };

__device__ __forceinline__ void moe_prefix(const P& p, int layer, int* spre) {
  __syncthreads();
  if (threadIdx.x == 0) {
    int acc = 0;
    for (int e = 0; e < 32; ++e) { spre[e] = acc; acc += (p.cnt()[layer * 32 + e] + 127) >> 7; }
    spre[32] = acc;
  }
  __syncthreads();
}
__device__ __forceinline__ void ph_moe_up(const P& p, int layer, int bid, char* smem) {
  int* spre = (int*)(smem + 98304);
  moe_prefix(p, layer, spre);
  const int ntile = spre[32];
  for (int w = bid; w < ntile * 8; w += gridDim.x) {
    const int rbg = w >> 3, nt = w & 7;
    const int e = __builtin_amdgcn_readfirstlane(__popcll(__ballot((threadIdx.x & 63) < 31 && spre[(threadIdx.x & 63) + 1] <= rbg)));
    const int rb = rbg - spre[e];
    const int cnt = p.cnt()[layer * 32 + e];
    AGather af{p.H(), p.list_tok() + e * CAPE + rb * 128, cnt - rb * 128};
    const size_t wo = ((size_t)layer * 32 + e) * 2048 * 512;
    BGateUp bf{p.w_gate + wo, p.w_up + wo, 512, nt * 64};
    bfraw* act = p.ACT() + (size_t)rbg * 128 * LDACT + nt * 64;
    auto ef = [&](const f32x16 (&acc)[2][2], int wr, int wc, int lane) {
#pragma unroll
      for (int i = 0; i < 2; ++i)
#pragma unroll
        for (int r = 0; r < 16; ++r) {
          int row = ACC_ROW(wr, i, r, lane);
          float gv = acc[i][0][r], uv = acc[i][1][r];
          act[(size_t)row * LDACT + wc * 32 + (lane & 31)] = to_bf16(siluf_(gv) * uv);
        }
    };
    gemm_tile<2>(af, bf, ef, 2048, smem);
  }
}
__device__ __forceinline__ void ph_moe_down(const P& p, int layer, int bid, char* smem) {
  int* spre = (int*)(smem + 98304);
  moe_prefix(p, layer, spre);
  const int ntile = spre[32];
  for (int w = bid; w < ntile * 16; w += gridDim.x) {
    const int rbg = w >> 4, nt = w & 15;
    const int e = __builtin_amdgcn_readfirstlane(__popcll(__ballot((threadIdx.x & 63) < 31 && spre[(threadIdx.x & 63) + 1] <= rbg)));
    const int rb = rbg - spre[e];
    const int nvalid = p.cnt()[layer * 32 + e] - rb * 128;
    ARows af{p.ACT() + (size_t)rbg * 128 * LDACT, LDACT, 0, 128};
    BPlain bf{p.w_down + ((size_t)layer * 32 + e) * 512 * 2048, 2048, nt * 128, 2048};
    const int* toks = p.list_tok() + e * CAPE + rb * 128;
    const float* lw = p.list_w() + e * CAPE + rb * 128;
    float* Ys = p.Yslot();
    auto ef = [&](const f32x16 (&acc)[2][2], int wr, int wc, int lane) {
#pragma unroll
      for (int i = 0; i < 2; ++i)
#pragma unroll
        for (int r = 0; r < 16; ++r) {
          int row = ACC_ROW(wr, i, r, lane);
          if (row < nvalid) {
            int ts = toks[row]; float wgt = lw[row];
#pragma unroll
            for (int j = 0; j < 2; ++j) Ys[(size_t)ts * 2048 + nt * 128 + ACC_COL(wc, j, lane)] = wgt * acc[i][j][r];
          }
        }
    };
    gemm_tile<2>(af, bf, ef, 512, smem);
  }
}

__device__ __forceinline__ void ph_out(const P& p, int bid, char* smem) {
  const int tid = threadIdx.x, lane = tid & 63, wid = tid >> 6;
  for (int r = bid * 4 + wid; r < TLAT; r += gridDim.x * 4) {
    const int mi = r >> 12;
    const float* g2 = p.modv() + (1 * 3 + mi) * 12288 + 5 * 2048;
    f32x4v v[8];
    float ss = 0.f;
#pragma unroll
    for (int q = 0; q < 8; ++q) {
      const int col = q * 256 + lane * 4;
      f32x4v xv = *(const f32x4v*)(p.X() + (size_t)r * 2048 + col);
      const f32x4v gv = *(const f32x4v*)(g2 + col);
      const f32x4v y0 = *(const f32x4v*)(p.Yslot() + (size_t)(2 * r) * 2048 + col);
      const f32x4v y1 = *(const f32x4v*)(p.Yslot() + (size_t)(2 * r + 1) * 2048 + col);
      xv += gv * (y0 + y1);
      v[q] = xv;
      ss += xv[0] * xv[0] + xv[1] * xv[1] + xv[2] * xv[2] + xv[3] * xv[3];
    }
    ss = wave_sum(ss);
    const float rs = rsqrtf(ss * (1.f / 2048.f) + EPSV);
#pragma unroll
    for (int q = 0; q < 8; ++q) {
      const int col = q * 256 + lane * 4;
      const f32x4v w4 = *(const f32x4v*)(p.final_w + col);
      *(f32x4v*)(p.out + (size_t)r * 2048 + col) = v[q] * rs * w4;
    }
  }
}

#define SMEM_BYTES 102400
#define XB_TMO      128
#define XB_XCNT(j)  (256  + 64 * (j))
#define XB_XSUB(j)  (1280 + 64 * (j))
#define XB_XGEN(j)  (2304 + 64 * (j))
#define XB_TOP      3328
#define XB_TOPGEN   3392
#define XB_SPIN_CAP (1u << 22)
#define LAS __attribute__((address_space(3)))
__device__ __forceinline__ unsigned xb_ld(unsigned* p)              { return __hip_atomic_load(p, __ATOMIC_RELAXED, __HIP_MEMORY_SCOPE_AGENT); }
__device__ __forceinline__ unsigned xb_add(unsigned* p, unsigned v) { return __hip_atomic_fetch_add(p, v, __ATOMIC_RELAXED, __HIP_MEMORY_SCOPE_AGENT); }
__device__ __forceinline__ unsigned xb_xcc_id() { return (unsigned)__builtin_amdgcn_s_getreg((3 << 11) | 20) & 0xFu; }
#define XB_SPIN(cond, bar) do { unsigned _sp = 0; while (cond) { __builtin_amdgcn_s_sleep(1); \
    if ((++_sp & 255u) == 0u) { if (xb_ld(&(bar)[XB_TMO])) break; if (_sp > XB_SPIN_CAP) { atomicAdd(&(bar)[XB_TMO], 1u); break; } } } } while (0)
struct XcdBarrier { unsigned* bar; unsigned x; unsigned rank; volatile LAS unsigned* st; };
__device__ __forceinline__ XcdBarrier xcd_barrier_post(unsigned* bar, volatile LAS unsigned* st) {
    XcdBarrier b; b.bar = bar; b.x = xb_xcc_id(); b.st = st;
    b.rank = 0u;
    if (threadIdx.x == 0) b.rank = xb_add(&bar[XB_XCNT(b.x)], 1u);
    return b;
}
__device__ __forceinline__ void xcd_barrier_complete(unsigned* bar, unsigned x, unsigned& nloc, unsigned& nx) {
    const unsigned G = gridDim.x * gridDim.y * gridDim.z;
    unsigned sum, cnt, mine, sp = 0u;
    for (;;) {
        sum = 0u; cnt = 0u; mine = 0u;
#pragma unroll
        for (unsigned j = 0; j < 16; ++j) { const unsigned c = xb_ld(&bar[XB_XCNT(j)]); sum += c; cnt += (c > 0u) ? 1u : 0u; mine = (j == x) ? c : mine; }
        if (sum == G) break;
        __builtin_amdgcn_s_sleep(1);
        if ((++sp & 255u) == 0u) { if (xb_ld(&bar[XB_TMO])) break; if (sp > XB_SPIN_CAP) { atomicAdd(&bar[XB_TMO], 1u); break; } }
    }
    nloc = mine > 0u ? mine : 1u; nx = cnt > 0u ? cnt : 1u;
}
__device__ __forceinline__ void xcd_barrier(const XcdBarrier& b) {
    asm volatile("s_waitcnt vmcnt(0)" ::: "memory");
    __syncthreads();
    if (threadIdx.x == 0) {
        unsigned* bar = b.bar;
        __builtin_amdgcn_s_waitcnt(0);
        unsigned nloc = b.st[0], nx = b.st[1];
        if (nloc == 0u) { xcd_barrier_complete(bar, b.x, nloc, nx); b.st[0] = nloc; b.st[1] = nx; }
        const unsigned old = xb_add(&bar[XB_XSUB(b.x)], 1u);
        const unsigned gen = old / nloc;
        if (old + 1u == (gen + 1u) * nloc) {
            __builtin_amdgcn_fence(__ATOMIC_RELEASE, "agent");
            asm volatile("s_waitcnt vmcnt(0)" ::: "memory");
            const unsigned og = xb_add(&bar[XB_TOP], 1u);
            const unsigned tg = og / nx;
            if (og + 1u == (tg + 1u) * nx) xb_add(&bar[XB_TOPGEN], 1u);
            else XB_SPIN(xb_ld(&bar[XB_TOPGEN]) == tg, bar);
            __builtin_amdgcn_fence(__ATOMIC_ACQUIRE, "agent");
            xb_add(&bar[XB_XGEN(b.x)], 1u);
            asm volatile("s_waitcnt vmcnt(0)" ::: "memory");
        } else {
            XB_SPIN(xb_ld(&bar[XB_XGEN(b.x)]) == gen, bar);
            __builtin_amdgcn_fence(__ATOMIC_ACQUIRE, "agent");
            asm volatile("s_waitcnt vmcnt(0)" ::: "memory");
        }
    }
    __syncthreads();
}

__global__ void __launch_bounds__(256, 1) k_fused(P p, unsigned* bar) {
  extern __shared__ __attribute__((aligned(16))) char smem_all[];
  char* smem = smem_all + 64;
  if (threadIdx.x == 0) *(uint4*)smem_all = make_uint4(0u, 0u, 0u, 0u);
  __syncthreads();
  XcdBarrier b = xcd_barrier_post(bar, (volatile LAS unsigned*)smem_all);
#define LAYER_PROGRAM(L)                                                              \
  {                                                                                   \
    ph_norm1(p, L, bid, smem); xcd_barrier(b);          \
    ph_win(p, L, bid, smem); xcd_barrier(b);                          \
    ph_prep(p, L, bid, smem); xcd_barrier(b);           \
    ph_qkv(p, L, bid, smem); ph_mixA(p, L, bid, smem); xcd_barrier(b);     \
    ph_attn(p, L, bid, smem); ph_scan(p, L, bid, smem); xcd_barrier(b);    \
    ph_mixC(p, L, bid, smem); xcd_barrier(b);             \
    ph_glu(p, L, bid, smem); xcd_barrier(b);                                \
    ph_final_mix(p, L, bid, smem); xcd_barrier(b);      \
    ph_wout(p, L, bid, smem); xcd_barrier(b);                \
    ph_router(p, L, bid, smem); xcd_barrier(b);         \
    ph_moe_up(p, L, bid, smem); xcd_barrier(b);                    \
    ph_moe_down(p, L, bid, smem); xcd_barrier(b);       \
  }
  ph_mod(p, smem); xcd_barrier(b);
  if (threadIdx.x == 0) {
    unsigned pre = 0u;
    for (unsigned j = 0; j < 16; ++j) { const unsigned c = xb_ld(&bar[XB_XCNT(j)]); if (j < b.x) pre += c; }
    ((volatile LAS unsigned*)smem_all)[2] = pre + b.rank;
  }
  __syncthreads();
  const int bid = (int)((volatile LAS unsigned*)smem_all)[2];
  LAYER_PROGRAM(0)
  LAYER_PROGRAM(1)
  ph_out(p, bid, smem);
}

extern "C" void kernel_launch(void* const* d_in, const int* in_sizes, int n_in, void* d_out, int out_size, void* d_ws,
                              size_t ws_size, hipStream_t stream) {
  P p{};
  const float* const* in = (const float* const*)d_in;
  p.x = in[0]; p.c = in[1]; p.ctx = in[2]; p.c_ctx = in[3]; p.mod_w = in[4]; p.mod_b = in[5]; p.norm1_w = in[6];
  p.w_in = in[7]; p.q_norm_w = in[8]; p.kv_norm_w = in[9]; p.w_uq = in[10]; p.w_ukv = in[11]; p.conv_w = in[12];
  p.conv_b = in[13]; p.a_log = in[14]; p.dt_bias = in[15]; p.ssd_d = in[16]; p.gate_b = in[17]; p.lam_re = in[18];
  p.lam_im = in[19]; p.log_dt = in[20]; p.b_re = in[21]; p.b_im = in[22]; p.c_re = in[23]; p.c_im = in[24];
  p.s5_d = in[25]; p.glu_w = in[26]; p.glu_b = in[27]; p.out_norm_w = in[28]; p.w_out = in[29]; p.norm2_w = in[30];
  p.w_group = in[31]; p.w_expert = in[32]; p.w_gate = in[33]; p.w_up = in[34]; p.w_down = in[35]; p.final_w = in[36];
  p.out = (float*)d_out;
  p.ws = (float*)d_ws;
  (void)ws_size; (void)in_sizes; (void)n_in; (void)out_size;

  unsigned* bar = (unsigned*)((float*)d_ws + WO_bar);
  static int grid = 0;
  if (!grid) {
    int dev = 0, cus = 0, per_cu = 0;
    hipGetDevice(&dev);
    hipDeviceGetAttribute(&cus, hipDeviceAttributeMultiprocessorCount, dev);
    (void)hipFuncSetAttribute((const void*)k_fused, hipFuncAttributeMaxDynamicSharedMemorySize, SMEM_BYTES + 64);
    (void)hipOccupancyMaxActiveBlocksPerMultiprocessor(&per_cu, k_fused, 256, SMEM_BYTES + 64);
    if (per_cu < 1) per_cu = 1;
    grid = cus * (per_cu < 1 ? per_cu : 1);
  }
  hipMemsetAsync(bar, 0, XCD_BAR_WORDS * sizeof(unsigned), stream);
  hipLaunchKernelGGL(k_fused, dim3(grid), dim3(256), SMEM_BYTES + 64, stream, p, bar);
}
```

```cpp
#include <hip/hip_runtime.h>
#include <stdint.h>

#define DM 2048
#define SL 4096
#define CL 256
#define TLAT 8192
#define TCTX 512
#define TTOT 8704
#define NIN 4192
#define NKEY 4352
#define ZC_CQ 0
#define ZC_CKV 384
#define ZC_KR 512
#define ZC_BZ 576
#define ZC_XBC 1088
#define ZC_DT 2112
#define ZC_MQ 2128
#define ZC_MK 2384
#define ZC_MV 2640
#define ZC_MO 3152
#define ZC_MG 3664
#define ZC_U 3680
#define CAPE 8704
#define EPSV 1e-6f
#define ACT_ROWS 21632

typedef float f32x16 __attribute__((ext_vector_type(16)));
typedef short bf16x8 __attribute__((ext_vector_type(8)));
typedef float f32x4v __attribute__((ext_vector_type(4)));
typedef unsigned short bfraw;
__device__ __forceinline__ unsigned pack_bf16(float lo, float hi) {
  typedef __bf16 bf2 __attribute__((ext_vector_type(2)));
  bf2 v; v[0] = (__bf16)lo; v[1] = (__bf16)hi;
  return __builtin_bit_cast(unsigned, v);
}
__device__ __forceinline__ bfraw to_bf16(float x) { __bf16 b = (__bf16)x; return __builtin_bit_cast(unsigned short, b); }
__device__ __forceinline__ f32x4v ld_bf16x4(const bfraw* q) {
  const uint2 t = *(const uint2*)q;
  f32x4v r; r[0] = __uint_as_float(t.x << 16); r[1] = __uint_as_float(t.x & 0xffff0000u); r[2] = __uint_as_float(t.y << 16); r[3] = __uint_as_float(t.y & 0xffff0000u);
  return r;
}
__device__ __forceinline__ float from_bf16(bfraw x) { return __uint_as_float((unsigned)x << 16); }

#define NSTEP 68
#define LDH 2112
#define LDACT 576
#define XCD_BAR_WORDS 3456
#define WS_RND(n) (((size_t)(n) + 63) & ~(size_t)63)
constexpr size_t WO_cnt = 0;
constexpr size_t WO_modv = WO_cnt + WS_RND(64);
constexpr size_t WO_H = WO_modv + WS_RND(2 * 3 * 12288);
constexpr size_t WO_X = WO_H + WS_RND((size_t)TTOT * (LDH / 2));
constexpr size_t WO_Z = WO_X + WS_RND((size_t)TTOT * 2048);
constexpr size_t WO_Aq = WO_Z + WS_RND((size_t)TTOT * NIN);
constexpr size_t WO_Akv = WO_Aq + WS_RND((size_t)TTOT * 192);
constexpr size_t WO_qraw = WO_Akv + WS_RND((size_t)TTOT * 64);
constexpr size_t WO_kvraw = WO_qraw + WS_RND((size_t)TTOT * 768);
constexpr size_t WO_Q = WO_kvraw + WS_RND((size_t)TTOT * 1024);
constexpr size_t WO_Qc = WO_Q + WS_RND((size_t)8 * SL * 96);
constexpr size_t WO_K = WO_Qc + WS_RND((size_t)8 * CL * 96);
constexpr size_t WO_V = WO_K + WS_RND((size_t)8 * NKEY * 96);
constexpr size_t WO_O = WO_V + WS_RND((size_t)8 * NKEY * 64);
constexpr size_t WO_ssd_xs = WO_O + WS_RND((size_t)TTOT * 512);
constexpr size_t WO_ssd_B = WO_ssd_xs + WS_RND((size_t)TTOT * 512);
constexpr size_t WO_ssd_C = WO_ssd_B + WS_RND((size_t)TTOT * 256);
constexpr size_t WO_ssd_dt = WO_ssd_C + WS_RND((size_t)TTOT * 256);
constexpr size_t WO_ssd_y = WO_ssd_dt + WS_RND((size_t)TTOT * 16);
constexpr size_t WO_ssd_st = WO_ssd_y + WS_RND((size_t)TTOT * 512);
constexpr size_t WO_ssd_atot = WO_ssd_st + WS_RND((size_t)32 * NSTEP * 8192);
constexpr size_t WO_ml_h = WO_ssd_atot + WS_RND(32 * NSTEP);
constexpr size_t WO_ml_st = WO_ml_h + WS_RND((size_t)TTOT * 512);
constexpr size_t WO_ml_nst = WO_ml_st + WS_RND((size_t)16 * NSTEP * 8192);
constexpr size_t WO_ml_gtot = WO_ml_nst + WS_RND((size_t)16 * NSTEP * 64);
constexpr size_t WO_s5_st = WO_ml_gtot + WS_RND(16 * NSTEP);
constexpr size_t WO_s5_a = WO_s5_st + WS_RND((size_t)128 * NSTEP * 128);
constexpr size_t WO_s5_bb = WO_s5_a + WS_RND(2 * 2 * 32 * 64 * 2);
constexpr size_t WO_s5_rf = WO_s5_bb + WS_RND((size_t)2 * 2 * 32 * 64 * 32);
constexpr size_t WO_s5_rb = WO_s5_rf + WS_RND((size_t)TTOT * 512);
constexpr size_t WO_ydpre = WO_s5_rb + WS_RND((size_t)TTOT * 512);
constexpr size_t WO_ydg = WO_ydpre + WS_RND((size_t)TTOT * 512);
constexpr size_t WO_Y = WO_ydg + WS_RND((size_t)TTOT * 512);
constexpr size_t WO_ydpre_bf = WO_Y + WS_RND((size_t)TTOT * (LDH / 2));
constexpr size_t WO_list_tok = WO_ydpre_bf + WS_RND((size_t)TTOT * 256);
constexpr size_t WO_list_w = WO_list_tok + WS_RND((size_t)32 * CAPE);
constexpr size_t WO_ACT = WO_list_w + WS_RND((size_t)32 * CAPE);
constexpr size_t WO_Yslot = WO_ACT + WS_RND((size_t)ACT_ROWS * (LDACT / 2));
constexpr size_t WO_rope_cs = WO_Yslot + WS_RND((size_t)TTOT * 2 * 2048);
constexpr size_t WO_s5_bbh = WO_rope_cs + WS_RND(64 * 16 * 2);
constexpr size_t WO_s5_cmh = WO_s5_bbh + WS_RND(128 * 128 * 16 / 2);
constexpr size_t WO_bar_old = WO_Yslot + WS_RND((size_t)TTOT * 2 * 2048);
constexpr size_t WO_bar = WO_s5_cmh + WS_RND(64 * 32 * 128 / 2);
constexpr size_t WS_TOTAL_FLOATS = WO_bar + 4096;

struct P {
  const float *x, *c, *ctx, *c_ctx, *mod_w, *mod_b, *norm1_w, *w_in, *q_norm_w, *kv_norm_w, *w_uq, *w_ukv;
  const float *conv_w, *conv_b, *a_log, *dt_bias, *ssd_d, *gate_b, *lam_re, *lam_im, *log_dt, *b_re, *b_im;
  const float *c_re, *c_im, *s5_d, *glu_w, *glu_b, *out_norm_w, *w_out, *norm2_w, *w_group, *w_expert;
  const float *w_gate, *w_up, *w_down, *final_w;
  float* out;
  float* ws;
  __device__ __forceinline__ int* cnt() const { return (int*)(ws + WO_cnt); }
  __device__ __forceinline__ float* modv() const { return (float*)(ws + WO_modv); }
  __device__ __forceinline__ bfraw* H() const { return (bfraw*)(ws + WO_H); }
  __device__ __forceinline__ float* X() const { return (float*)(ws + WO_X); }
  __device__ __forceinline__ float* Z() const { return (float*)(ws + WO_Z); }
  __device__ __forceinline__ bfraw* Aq() const { return (bfraw*)(ws + WO_Aq); }
  __device__ __forceinline__ bfraw* Akv() const { return (bfraw*)(ws + WO_Akv); }
  __device__ __forceinline__ float* qraw() const { return (float*)(ws + WO_qraw); }
  __device__ __forceinline__ float* kvraw() const { return (float*)(ws + WO_kvraw); }
  __device__ __forceinline__ bfraw* Q() const { return (bfraw*)(ws + WO_Q); }
  __device__ __forceinline__ bfraw* Qc() const { return (bfraw*)(ws + WO_Qc); }
  __device__ __forceinline__ bfraw* K() const { return (bfraw*)(ws + WO_K); }
  __device__ __forceinline__ bfraw* V() const { return (bfraw*)(ws + WO_V); }
  __device__ __forceinline__ float* O() const { return (float*)(ws + WO_O); }
  __device__ __forceinline__ float* ssd_xs() const { return (float*)(ws + WO_ssd_xs); }
  __device__ __forceinline__ float* ssd_B() const { return (float*)(ws + WO_ssd_B); }
  __device__ __forceinline__ float* ssd_C() const { return (float*)(ws + WO_ssd_C); }
  __device__ __forceinline__ float* ssd_dt() const { return (float*)(ws + WO_ssd_dt); }
  __device__ __forceinline__ float* ssd_y() const { return (float*)(ws + WO_ssd_y); }
  __device__ __forceinline__ bfraw* ssd_st() const { return (bfraw*)(ws + WO_ssd_st); }
  __device__ __forceinline__ float* ssd_atot() const { return (float*)(ws + WO_ssd_atot); }
  __device__ __forceinline__ float* ml_h() const { return (float*)(ws + WO_ml_h); }
  __device__ __forceinline__ bfraw* ml_st() const { return (bfraw*)(ws + WO_ml_st); }
  __device__ __forceinline__ float* ml_nst() const { return (float*)(ws + WO_ml_nst); }
  __device__ __forceinline__ float* ml_gtot() const { return (float*)(ws + WO_ml_gtot); }
  __device__ __forceinline__ float* s5_st() const { return (float*)(ws + WO_s5_st); }
  __device__ __forceinline__ float* s5_a() const { return (float*)(ws + WO_s5_a); }
  __device__ __forceinline__ float* s5_bb() const { return (float*)(ws + WO_s5_bb); }
  __device__ __forceinline__ float* s5_rf() const { return (float*)(ws + WO_s5_rf); }
  __device__ __forceinline__ float* s5_rb() const { return (float*)(ws + WO_s5_rb); }
  __device__ __forceinline__ float* ydpre() const { return (float*)(ws + WO_ydpre); }
  __device__ __forceinline__ float* ydg() const { return (float*)(ws + WO_ydg); }
  __device__ __forceinline__ bfraw* Y() const { return (bfraw*)(ws + WO_Y); }
  __device__ __forceinline__ bfraw* ydpre_bf() const { return (bfraw*)(ws + WO_ydpre_bf); }
  __device__ __forceinline__ int* list_tok() const { return (int*)(ws + WO_list_tok); }
  __device__ __forceinline__ float* list_w() const { return (float*)(ws + WO_list_w); }
  __device__ __forceinline__ bfraw* ACT() const { return (bfraw*)(ws + WO_ACT); }
  __device__ __forceinline__ bfraw* Yslot() const { return (bfraw*)(ws + WO_Yslot); }
  __device__ __forceinline__ float* rope_cs() const { return (float*)(ws + WO_rope_cs); }
  __device__ __forceinline__ bfraw* s5_bbh() const { return (bfraw*)(ws + WO_s5_bbh); }
  __device__ __forceinline__ bfraw* s5_cmh() const { return (bfraw*)(ws + WO_s5_cmh); }
};

__device__ __forceinline__ int row_modidx(int r) { return r < TLAT ? (r >> 12) : 2; }
__device__ __forceinline__ float sigmoidf_(float v) { return 1.f / (1.f + expf(-v)); }
__device__ __forceinline__ float siluf_(float v) { return v / (1.f + expf(-v)); }
__device__ __forceinline__ float wave_sum(float v) {
#pragma unroll
  for (int o = 32; o; o >>= 1) v += __shfl_xor(v, o);
  return v;
}
__device__ __forceinline__ float block_sum(float v, float* red) {
  v = wave_sum(v);
  __syncthreads();
  if ((threadIdx.x & 63) == 0) red[threadIdx.x >> 6] = v;
  __syncthreads();
  return red[0] + red[1] + red[2] + red[3];
}

__device__ __forceinline__ void ph_mod(const P& p, char* smem) {
  float* sc = (float*)smem;
  float* red = sc + 3 * 2048;
  const int tid = threadIdx.x;
  if (blockIdx.x == 0 && tid < 64) p.cnt()[tid] = 0;
  if (blockIdx.x == 1) {
    for (int i = tid; i < 64 * 16; i += 256) {
      const int idx = i >> 4, f = i & 15;
      const float ang = (float)idx * powf(10000.f, -(float)f * (1.f / 16.f));
      p.rope_cs()[i * 2] = cosf(ang); p.rope_cs()[i * 2 + 1] = sinf(ang);
    }
  }
  for (int i = blockIdx.x * 256 + tid; i < 64 * 32 * 128; i += gridDim.x * 256) {
    const int pp = i & 127, c = (i >> 7) & 31, lg = i >> 12;
    float v = 0.f;
    if (c < 16) v = pp < 64 ? p.c_re[((size_t)lg * 16 + c) * 64 + pp] : -p.c_im[((size_t)lg * 16 + c) * 64 + pp - 64];
    p.s5_cmh()[i] = to_bf16(v);
  }
  for (int i = blockIdx.x * 256 + tid; i < 2 * 2 * 32 * 64; i += gridDim.x * 256) {
    const int sp = i & 63, g = (i >> 6) & 31, l = i >> 12;
    const float lr = p.lam_re[i], li = p.lam_im[i];
    const float dt = expf(p.log_dt[i >> 6]);
    const float mag = expf(lr * dt);
    const float ar = mag * cosf(li * dt), ai = mag * sinf(li * dt);
    const float den = lr * lr + li * li;
    const float cr_ = ((ar - 1.f) * lr + ai * li) / den;
    const float ci_ = (ai * lr - (ar - 1.f) * li) / den;
    p.s5_a()[i * 2] = ar; p.s5_a()[i * 2 + 1] = ai;
    for (int c = 0; c < 16; ++c) {
      float br = p.b_re[((size_t)(l * 32 + g) * 64 + sp) * 16 + c];
      float bim = p.b_im[((size_t)(l * 32 + g) * 64 + sp) * 16 + c];
      p.s5_bb()[(size_t)i * 32 + c] = cr_ * br - ci_ * bim;
      p.s5_bb()[(size_t)i * 32 + 16 + c] = cr_ * bim + ci_ * br;
      p.s5_bbh()[((size_t)(i >> 6) * 128 + sp) * 16 + c] = to_bf16(cr_ * br - ci_ * bim);
      p.s5_bbh()[((size_t)(i >> 6) * 128 + 64 + sp) * 16 + c] = to_bf16(cr_ * bim + ci_ * br);
    }
  }
  for (int i = tid; i < 3 * 2048; i += 256) {
    int r = i >> 11, k = i & 2047;
    float v = r < 2 ? p.c[r * 2048 + k] : p.c_ctx[k];
    sc[i] = siluf_(v);
  }
  __syncthreads();
  for (int w = blockIdx.x; w < 2 * 96; w += gridDim.x) {
    int l = w / 96, j0 = (w % 96) * 128;
    int cg = tid & 31, ks = tid >> 5;
    const float* W = p.mod_w + (size_t)l * 2048 * 12288 + j0 + cg * 4;
    float acc[3][4];
#pragma unroll
    for (int r = 0; r < 3; ++r)
#pragma unroll
      for (int c = 0; c < 4; ++c) acc[r][c] = 0.f;
#pragma unroll 16
    for (int k = ks * 256; k < ks * 256 + 256; ++k) {
      float4 wv = *(const float4*)(W + (size_t)k * 12288);
      float s0 = sc[k], s1 = sc[2048 + k], s2 = sc[4096 + k];
      acc[0][0] += s0 * wv.x; acc[0][1] += s0 * wv.y; acc[0][2] += s0 * wv.z; acc[0][3] += s0 * wv.w;
      acc[1][0] += s1 * wv.x; acc[1][1] += s1 * wv.y; acc[1][2] += s1 * wv.z; acc[1][3] += s1 * wv.w;
      acc[2][0] += s2 * wv.x; acc[2][1] += s2 * wv.y; acc[2][2] += s2 * wv.z; acc[2][3] += s2 * wv.w;
    }
    __syncthreads();
#pragma unroll
    for (int r = 0; r < 3; ++r)
#pragma unroll
      for (int c = 0; c < 4; ++c) red[(ks * 32 + cg) * 12 + r * 4 + c] = acc[r][c];
    __syncthreads();
    for (int o = tid; o < 384; o += 256) {
      int r = o >> 7, c = o & 127;
      float s = 0.f;
#pragma unroll
      for (int q = 0; q < 8; ++q) s += red[(q * 32 + (c >> 2)) * 12 + r * 4 + (c & 3)];
      s += p.mod_b[l * 12288 + j0 + c];
      p.modv()[(l * 3 + r) * 12288 + j0 + c] = s;
    }
    __syncthreads();
  }
}

__device__ __forceinline__ void ph_norm1(const P& p, int layer, int bid, char* smem) {
  const int tid = threadIdx.x, lane = tid & 63, wid = tid >> 6;
  const float* nw = p.norm1_w + layer * 2048;
  for (int r = bid * 4 + wid; r < TTOT; r += gridDim.x * 4) {
    const int mi = row_modidx(r);
    const float* mrow = p.modv() + (layer * 3 + mi) * 12288;
    f32x4v v[8];
    float ss = 0.f;
#pragma unroll
    for (int q = 0; q < 8; ++q) {
      const int col = q * 256 + lane * 4;
      f32x4v xv;
      if (layer == 0) {
        const float* src = r < TLAT ? p.x + (size_t)r * 2048 : p.ctx + (size_t)(r - TLAT) * 2048;
        xv = *(const f32x4v*)(src + col);
      } else {
        xv = *(const f32x4v*)(p.X() + (size_t)r * 2048 + col);
        const float* g2 = p.modv() + ((layer - 1) * 3 + mi) * 12288 + 5 * 2048;
        const f32x4v gv = *(const f32x4v*)(g2 + col);
        const f32x4v y0 = ld_bf16x4(p.Yslot() + (size_t)(2 * r) * 2048 + col);
        const f32x4v y1 = ld_bf16x4(p.Yslot() + (size_t)(2 * r + 1) * 2048 + col);
        xv += gv * (y0 + y1);
        *(f32x4v*)(p.X() + (size_t)r * 2048 + col) = xv;
      }
      v[q] = xv;
      ss += xv[0] * xv[0] + xv[1] * xv[1] + xv[2] * xv[2] + xv[3] * xv[3];
    }
    ss = wave_sum(ss);
    const float rs = rsqrtf(ss * (1.f / 2048.f) + EPSV);
#pragma unroll
    for (int q = 0; q < 8; ++q) {
      const int col = q * 256 + lane * 4;
      const f32x4v w4 = *(const f32x4v*)(nw + col);
      const f32x4v sh = *(const f32x4v*)(mrow + col);
      const f32x4v scv = *(const f32x4v*)(mrow + 2048 + col);
      const f32x4v o = v[q] * rs * w4 * (1.f + scv) + sh;
      uint2 ob; ob.x = pack_bf16(o[0], o[1]); ob.y = pack_bf16(o[2], o[3]);
      *(uint2*)(p.H() + (size_t)r * LDH + col) = ob;
    }
  }
}

template <int MI, class AF, class BF, class EF>
__device__ __forceinline__ void gemm_tile(const AF& af, const BF& bf, const EF& ef, int K, char* smem) {
  constexpr int BM = MI * 64;
  constexpr int NA = MI * 2;
  constexpr int ABYTES = BM * 128, STAGE = ABYTES + 16384;
  int tid_ = threadIdx.x; asm volatile("" : "+v"(tid_));
  const int tid = tid_, lane = tid & 63, wid = tid >> 6, wr = wid >> 1, wc = wid & 1;
  const int l31 = lane & 31, lh = lane >> 5;
  f32x16 acc[MI][2];
#pragma unroll
  for (int i = 0; i < MI; ++i)
#pragma unroll
    for (int j = 0; j < 2; ++j)
#pragma unroll
      for (int r = 0; r < 16; ++r) acc[i][j][r] = 0.f;
  const int arl = tid >> 3, ac = tid & 7;
  const bfraw* arow[NA];
#pragma unroll
  for (int i = 0; i < NA; ++i) { const bfraw* q = af.row(arl + 32 * i); arow[i] = (q ? q : af.safe()) + ac * 8; }
  const int n4 = tid & 31, kg = tid >> 5;
  const float* bc;
  { const float* q = bf.col(n4 * 4); bc = (q ? q : bf.safe()) + (size_t)(kg * 8) * bf.ldb; }
  const size_t ldb = (size_t)bf.ldb;
  typedef unsigned u32x4v __attribute__((ext_vector_type(4)));
  u32x4v ra[2][NA];
  f32x4v rb[2][8];
#define GM_GL(set, k0)                                                               \
  {                                                                                  \
    _Pragma("unroll") for (int i = 0; i < NA; ++i) ra[set][i] = *(const u32x4v*)(arow[i] + (k0)); \
    const float* bq = bc + (size_t)(k0) * ldb;                                       \
    _Pragma("unroll") for (int j = 0; j < 8; ++j) rb[set][j] = *(const f32x4v*)(bq + (size_t)j * ldb); \
  }
#define GM_SW(set, buf)                                                              \
  {                                                                                  \
    char* Ab = smem + (buf) * STAGE; char* Bb = Ab + ABYTES;                         \
    const int asw = (ac ^ ((arl >> 1) & 7)) << 4;                                    \
    _Pragma("unroll") for (int i = 0; i < NA; ++i) *(u32x4v*)(Ab + (arl + 32 * i) * 128 + asw) = ra[set][i]; \
    _Pragma("unroll") for (int i4 = 0; i4 < 4; ++i4) {                               \
      const int n = n4 * 4 + i4;                                                     \
      u32x4v v;                                                                      \
      v[0] = pack_bf16(rb[set][0][i4], rb[set][1][i4]); v[1] = pack_bf16(rb[set][2][i4], rb[set][3][i4]); \
      v[2] = pack_bf16(rb[set][4][i4], rb[set][5][i4]); v[3] = pack_bf16(rb[set][6][i4], rb[set][7][i4]); \
      *(u32x4v*)(Bb + n * 128 + ((kg ^ ((n >> 1) & 7)) << 4)) = v;                   \
    }                                                                                \
  }
#define GM_COMPUTE(buf, KK0, KK1)                                                    \
  {                                                                                  \
    const char* ap = smem + (buf) * STAGE + (wr * (BM / 2) + l31) * 128;             \
    const char* bp = smem + (buf) * STAGE + ABYTES + (wc * 64 + l31) * 128;          \
    _Pragma("unroll") for (int kk = KK0; kk < KK1; ++kk) {                           \
      const int co = ((2 * kk + lh) ^ fsw) << 4;                                     \
      const bf16x8 b0 = *(const bf16x8*)(bp + co), b1 = *(const bf16x8*)(bp + 32 * 128 + co); \
      _Pragma("unroll") for (int i = 0; i < MI; ++i) {                               \
        const bf16x8 a = *(const bf16x8*)(ap + i * 32 * 128 + co);                   \
        acc[i][0] = __builtin_amdgcn_mfma_f32_32x32x16_bf16(a, b0, acc[i][0], 0, 0, 0); \
        acc[i][1] = __builtin_amdgcn_mfma_f32_32x32x16_bf16(a, b1, acc[i][1], 0, 0, 0); \
      }                                                                              \
    }                                                                                \
  }
  const int fsw = (l31 >> 1) & 7;
  const int nsteps = K >> 6;
  __syncthreads();
  const int klast = (nsteps - 1) * 64;
  GM_GL(0, 0)
  GM_SW(0, 0)
  GM_GL(1, 64)
  __syncthreads();
  for (int s = 0; s < nsteps; s += 2) {
    { const int kn = min((s + 2) * 64, klast); GM_GL(0, kn) }
    GM_COMPUTE(0, 0, 2)
    __builtin_amdgcn_sched_barrier(0);
    GM_SW(1, 1)
    __builtin_amdgcn_sched_barrier(0);
    GM_COMPUTE(0, 2, 4)
    __syncthreads();
    { const int kn = min((s + 3) * 64, klast); GM_GL(1, kn) }
    GM_COMPUTE(1, 0, 2)
    __builtin_amdgcn_sched_barrier(0);
    GM_SW(0, 0)
    __builtin_amdgcn_sched_barrier(0);
    GM_COMPUTE(1, 2, 4)
    __syncthreads();
  }
  ef(acc, wr, wc, lane);
}
#define ACC_ROWM(MI, wr, i, r, lane) ((wr) * ((MI) * 32) + (i) * 32 + ((r) & 3) + 8 * ((r) >> 2) + 4 * ((lane) >> 5))
#define ACC_ROW(wr, i, r, lane) ACC_ROWM(2, wr, i, r, lane)
#define ACC_COL(wc, j, lane) ((wc) * 64 + (j) * 32 + ((lane) & 31))

struct ARows { const bfraw* base; int ld; int m0; int M;
  __device__ __forceinline__ const bfraw* row(int r) const { int g = m0 + r; return g < M ? base + (size_t)g * ld : nullptr; }
  __device__ __forceinline__ const bfraw* safe() const { return base; } };
struct BPlain { const float* B; int ldb; int n0; int N;
  __device__ __forceinline__ const float* col(int v) const { int n = n0 + v; return n < N ? B + n : nullptr; }
  __device__ __forceinline__ const float* safe() const { return B; } };

template <int MI, class EPI>
__device__ __forceinline__ void gemm_dense(const bfraw* A, int lda, const float* B, int ldb, int M, int N, int K, const EPI& epi, int bid, char* smem) {
  constexpr int BM = MI * 64;
  const int mt = (M + BM - 1) / BM, nt = (N + 127) >> 7;
  const int nslots = ((nt + 1) >> 1) * mt * 2;
  for (int w = bid; w < nslots; w += gridDim.x) {
    const int sr = w / (mt * 2), rem = w - sr * (mt * 2);
    const int n_t = sr * 2 + (rem & 1);
    if (n_t >= nt) continue;
    const int m0 = (rem >> 1) * BM, n0 = n_t * 128;
    ARows af{A, lda, m0, M};
    BPlain bf{B, ldb, n0, N};
    auto ef = [&](const f32x16 (&acc)[MI][2], int wr, int wc, int lane) {
#pragma unroll
      for (int i = 0; i < MI; ++i)
#pragma unroll
        for (int j = 0; j < 2; ++j)
#pragma unroll
          for (int r = 0; r < 16; ++r) {
            int row = m0 + ACC_ROWM(MI, wr, i, r, lane), col = n0 + ACC_COL(wc, j, lane);
            if (row < M && col < N) epi(row, col, acc[i][j][r]);
          }
    };
    gemm_tile<MI>(af, bf, ef, K, smem);
  }
}


template <class EPI>
__device__ __forceinline__ void gemm_dense_hybrid(const bfraw* A, int lda, const float* B, int ldb, int M, int N, int K, const EPI& epi, int bid, char* smem) {
  const int mt = M / 256, nt = (N + 127) >> 7;
  const int npair = (nt >> 1) * mt * 2, ntiles = mt * nt;
  const int G = gridDim.x;
  const int nfull = (ntiles / G) * G, rem = ntiles - nfull;
  auto tile_of = [&](int w, int& m_t, int& n_t) {
    if (w < npair) { const int sr = w / (mt * 2), r2 = w - sr * (mt * 2); m_t = r2 >> 1; n_t = sr * 2 + (r2 & 1); }
    else { m_t = w - npair; n_t = nt - 1; }
  };
  for (int w = bid; w < nfull; w += G) {
    int m_t, n_t; tile_of(w, m_t, n_t);
    const int m0 = m_t * 256, n0 = n_t * 128;
    ARows af{A, lda, m0, M};
    BPlain bf{B, ldb, n0, N};
    auto ef = [&](const f32x16 (&acc)[4][2], int wr, int wc, int lane) {
#pragma unroll
      for (int i = 0; i < 4; ++i)
#pragma unroll
        for (int j = 0; j < 2; ++j)
#pragma unroll
          for (int r = 0; r < 16; ++r) {
            int row = m0 + ACC_ROWM(4, wr, i, r, lane), col = n0 + ACC_COL(wc, j, lane);
            if (col < N) epi(row, col, acc[i][j][r]);
          }
    };
    gemm_tile<4>(af, bf, ef, K, smem);
  }
  for (int w = bid; w < 2 * rem; w += G) {
    int m_t, n_t; tile_of(nfull + (w >> 1), m_t, n_t);
    const int m0 = m_t * 256 + (w & 1) * 128, n0 = n_t * 128;
    ARows af{A, lda, m0, M};
    BPlain bf{B, ldb, n0, N};
    auto ef = [&](const f32x16 (&acc)[2][2], int wr, int wc, int lane) {
#pragma unroll
      for (int i = 0; i < 2; ++i)
#pragma unroll
        for (int j = 0; j < 2; ++j)
#pragma unroll
          for (int r = 0; r < 16; ++r) {
            int row = m0 + ACC_ROWM(2, wr, i, r, lane), col = n0 + ACC_COL(wc, j, lane);
            if (col < N) epi(row, col, acc[i][j][r]);
          }
    };
    gemm_tile<2>(af, bf, ef, K, smem);
  }
}

__device__ __forceinline__ void ph_win(const P& p, int layer, int bid, char* smem) {
  float* Z = p.Z();
  auto epi = [=](int row, int col, float v) { Z[(size_t)row * NIN + col] = v; };
  gemm_dense_hybrid(p.H(), LDH, p.w_in + (size_t)layer * 2048 * NIN, NIN, TTOT, NIN, 2048, epi, bid, smem);
}

__device__ __forceinline__ void ph_prep(const P& p, int layer, int bid, char* smem) {
  const int tid = threadIdx.x, lane = tid & 63, wid = tid >> 6;
  for (int r = bid * 4 + wid; r < TTOT; r += gridDim.x * 4) {
    const float* z = p.Z() + (size_t)r * NIN;
    float q[6]; float ss = 0.f;
#pragma unroll
    for (int i = 0; i < 6; ++i) { q[i] = z[ZC_CQ + i * 64 + lane]; ss += q[i] * q[i]; }
    ss = wave_sum(ss);
    float rs = rsqrtf(ss * (1.f / 384.f) + EPSV);
#pragma unroll
    for (int i = 0; i < 6; ++i) p.Aq()[(size_t)r * 384 + i * 64 + lane] = to_bf16(q[i] * rs * p.q_norm_w[layer * 384 + i * 64 + lane]);
    float k0 = z[ZC_CKV + lane], k1 = z[ZC_CKV + 64 + lane];
    float s2 = wave_sum(k0 * k0 + k1 * k1);
    float rs2 = rsqrtf(s2 * (1.f / 128.f) + EPSV);
    p.Akv()[(size_t)r * 128 + lane] = to_bf16(k0 * rs2 * p.kv_norm_w[layer * 128 + lane]);
    p.Akv()[(size_t)r * 128 + 64 + lane] = to_bf16(k1 * rs2 * p.kv_norm_w[layer * 128 + 64 + lane]);
  }
  const float* cw = p.conv_w + layer * 5 * 1024;
  const float* cb = p.conv_b + layer * 1024;
  const int ch = tid * 4;
  const f32x4v bias = *(const f32x4v*)(cb + ch);
  f32x4v wk[5];
#pragma unroll
  for (int k = 0; k < 5; ++k) wk[k] = *(const f32x4v*)(cw + k * 1024 + ch);
  for (int rb = bid; rb < TTOT / 8; rb += gridDim.x) {
    const int r0 = rb * 8;
    int base, len;
    if (r0 < TLAT) { base = (r0 >> 12) << 12; len = SL; } else { base = TLAT + (((r0 - TLAT) >> 8) << 8); len = CL; }
    const int t0 = r0 - base;
    f32x4v xw[12];
#pragma unroll
    for (int u = 0; u < 12; ++u) {
      const int tt = t0 + u - 2;
      const f32x4v zero = {0.f, 0.f, 0.f, 0.f};
      xw[u] = (tt >= 0 && tt < len) ? *(const f32x4v*)(p.Z() + (size_t)(base + tt) * NIN + ZC_XBC + ch) : zero;
    }
#pragma unroll
    for (int j = 0; j < 8; ++j) {
      f32x4v acc = bias;
#pragma unroll
      for (int k = 0; k < 5; ++k) acc += xw[j + k] * wk[k];
      acc[0] = siluf_(acc[0]); acc[1] = siluf_(acc[1]); acc[2] = siluf_(acc[2]); acc[3] = siluf_(acc[3]);
      const int r = r0 + j;
      if (ch < 512) *(f32x4v*)(p.ssd_xs() + (size_t)r * 512 + ch) = acc;
      else if (ch < 768) *(f32x4v*)(p.ssd_B() + (size_t)r * 256 + (ch - 512)) = acc;
      else *(f32x4v*)(p.ssd_C() + (size_t)r * 256 + (ch - 768)) = acc;
    }
    if (tid < 128) {
      const int r = r0 + (tid >> 4), c = tid & 15;
      float v = p.Z()[(size_t)r * NIN + ZC_DT + c] + p.dt_bias[layer * 16 + c];
      p.ssd_dt()[(size_t)r * 16 + c] = v > 20.f ? v : log1pf(expf(v));
    }
  }
}

__device__ __forceinline__ void ph_qkv(const P& p, int layer, int bid, char* smem) {
  const int tid = threadIdx.x;
  const float qscale = 0.07216878364870322f * 1.4426950408889634f;
  const float* rope = p.rope_cs();
  for (int r = bid; r < TTOT; r += gridDim.x) {
    const bool lat = r < TLAT;
    int b, pos;
    if (lat) { b = r >> 12; pos = r & 4095; } else { b = (r - TLAT) >> 8; pos = (r - TLAT) & 255; }
    const int kpos = lat ? pos : SL + pos;
    const float* zr = p.Z() + (size_t)r * NIN + ZC_KR;
    const int h = tid >> 6, e = tid & 63;
    float v;
    if (!lat) v = zr[e];
    else {
      const int a = e >> 5, half = (e >> 4) & 1, f = e & 15;
      const float x1 = zr[a * 32 + f], x2 = zr[a * 32 + 16 + f];
      const int idx = a == 0 ? (pos >> 6) : (pos & 63);
      const float cs = rope[(idx * 16 + f) * 2], sn = rope[(idx * 16 + f) * 2 + 1];
      v = half == 0 ? x1 * cs - x2 * sn : x1 * sn + x2 * cs;
    }
    p.K()[((size_t)(b * 4 + h) * NKEY + kpos) * 192 + 128 + e] = to_bf16(v);
  }
  {
    const float* B = p.w_uq + (size_t)layer * 384 * 768;
    for (int w = bid; w < 68 * 6; w += gridDim.x) {
      const int n_t = w / 68, m_t = w - n_t * 68;
      const int m0 = m_t * 128, n0 = n_t * 128;
      ARows af{p.Aq(), 384, m0, TTOT};
      BPlain bf{B, 768, n0, 768};
      const bool lat = m0 < TLAT;
      const int b = lat ? (m0 >> 12) : ((m0 - TLAT) >> 8);
      const int pos0 = lat ? (m0 & 4095) : ((m0 - TLAT) & 255);
      auto ef = [&](const f32x16 (&acc)[2][2], int wr, int wc, int lane) {
        const int l31 = lane & 31;
#pragma unroll
        for (int j = 0; j < 2; ++j) {
          const int col = n0 + wc * 64 + j * 32;
          const int h = col / 192, d0 = col - h * 192;
          const bool isrope = lat && d0 >= 128;
          const int f = l31 & 15;
#pragma unroll
          for (int i = 0; i < 2; ++i)
#pragma unroll
            for (int r = 0; r < 16; ++r) {
              const int pos = pos0 + ACC_ROW(wr, i, r, lane);
              float v = acc[i][j][r];
              const float pv = __shfl_xor(v, 16);
              if (isrope) {
                const int idx = d0 == 128 ? (pos >> 6) : (pos & 63);
                const float cs = rope[(idx * 16 + f) * 2], sn = rope[(idx * 16 + f) * 2 + 1];
                v = (l31 < 16) ? v * cs - pv * sn : pv * sn + v * cs;
              }
              bfraw* dst = lat ? p.Q() + ((size_t)(b * 4 + h) * SL + pos) * 192 : p.Qc() + ((size_t)(b * 4 + h) * CL + pos) * 192;
              dst[d0 + l31] = to_bf16(v * qscale);
            }
        }
      };
      gemm_tile<2>(af, bf, ef, 384, smem);
    }
  }
  {
    const float* B = p.w_ukv + (size_t)layer * 128 * 1024;
    for (int w = bid; w < 68 * 8; w += gridDim.x) {
      const int n_t = w / 68, m_t = w - n_t * 68;
      const int m0 = m_t * 128, n0 = n_t * 128;
      ARows af{p.Akv(), 128, m0, TTOT};
      BPlain bf{B, 1024, n0, 1024};
      const bool lat = m0 < TLAT;
      const int b = lat ? (m0 >> 12) : ((m0 - TLAT) >> 8);
      const int kpos0 = lat ? (m0 & 4095) : SL + ((m0 - TLAT) & 255);
      const int h = n_t >> 1;
      const bool isv = n_t & 1;
      auto ef = [&](const f32x16 (&acc)[2][2], int wr, int wc, int lane) {
        const int l31 = lane & 31, lh = lane >> 5;
        if (!isv) {
#pragma unroll
          for (int i = 0; i < 2; ++i)
#pragma unroll
            for (int j = 0; j < 2; ++j)
#pragma unroll
              for (int r = 0; r < 16; ++r) {
                const int kpos = kpos0 + ACC_ROW(wr, i, r, lane);
                p.K()[((size_t)(b * 4 + h) * NKEY + kpos) * 192 + wc * 64 + j * 32 + l31] = to_bf16(acc[i][j][r]);
              }
        } else {
#pragma unroll
          for (int i = 0; i < 2; ++i)
#pragma unroll
            for (int j = 0; j < 2; ++j) {
              const int d = wc * 64 + j * 32 + l31;
              bfraw* vrow = p.V() + ((size_t)(b * 4 + h) * 128 + d) * NKEY + kpos0 + wr * 64 + i * 32;
#pragma unroll
              for (int s = 0; s < 2; ++s) {
                uint4 t;
                t.x = pack_bf16(acc[i][j][8 * s + 0], acc[i][j][8 * s + 1]); t.y = pack_bf16(acc[i][j][8 * s + 2], acc[i][j][8 * s + 3]);
                t.z = pack_bf16(acc[i][j][8 * s + 4], acc[i][j][8 * s + 5]); t.w = pack_bf16(acc[i][j][8 * s + 6], acc[i][j][8 * s + 7]);
                *(uint4*)(vrow + 16 * s + 8 * lh) = t;
              }
            }
        }
      };
      gemm_tile<2>(af, bf, ef, 128, smem);
    }
  }
}

#define ATT_KROW 400
#define ATT_VROW 144
#define MFMA16(a, b, c) __builtin_amdgcn_mfma_f32_32x32x16_bf16(a, b, c, 0, 0, 0)
__device__ __forceinline__ void attn_item(const bfraw* __restrict__ Qp, const bfraw* __restrict__ Kp, const bfraw* __restrict__ Vtp,
                                          int nk, float* __restrict__ Op, char* smem) {
  char* Ks = smem;
  char* Vs = smem + 64 * ATT_KROW;
  int tid_ = threadIdx.x; asm volatile("" : "+v"(tid_));
  const int tid = tid_, lane = tid & 63, wid = tid >> 6, l31 = lane & 31, lh = lane >> 5;
  bf16x8 qf[12];
  {
    const bfraw* qrow = Qp + (size_t)(wid * 32 + l31) * 192 + lh * 8;
#pragma unroll
    for (int ks = 0; ks < 12; ++ks) qf[ks] = *(const bf16x8*)(qrow + ks * 16);
  }
  f32x16 o[4];
#pragma unroll
  for (int d = 0; d < 4; ++d)
#pragma unroll
    for (int r = 0; r < 16; ++r) o[d][r] = 0.f;
  float m = -INFINITY, l = 0.f;
  uint4 rk0, rk1, rk2, rk3, rk4, rk5, rv0, rv1, rv2, rv3;
#define ATT_KSRC(n, kt) (Kp + (size_t)((kt) + (tid + 256 * (n)) / 24) * 192 + ((tid + 256 * (n)) % 24) * 8)
#define ATT_VSRC(n, kt) (Vtp + (size_t)((tid + 256 * (n)) >> 3) * NKEY + (kt) + ((tid + 256 * (n)) & 7) * 8)
#define ATT_GLOAD(kt)                                                                                        \
  {                                                                                                          \
    rk0 = *(const uint4*)ATT_KSRC(0, kt); rk1 = *(const uint4*)ATT_KSRC(1, kt); rk2 = *(const uint4*)ATT_KSRC(2, kt); \
    rk3 = *(const uint4*)ATT_KSRC(3, kt); rk4 = *(const uint4*)ATT_KSRC(4, kt); rk5 = *(const uint4*)ATT_KSRC(5, kt); \
    rv0 = *(const uint4*)ATT_VSRC(0, kt); rv1 = *(const uint4*)ATT_VSRC(1, kt);                              \
    rv2 = *(const uint4*)ATT_VSRC(2, kt); rv3 = *(const uint4*)ATT_VSRC(3, kt);                              \
  }
#define ATT_KDST(n) (Ks + ((tid + 256 * (n)) / 24) * ATT_KROW + ((tid + 256 * (n)) % 24) * 16)
#define ATT_VDST(n) (Vs + ((tid + 256 * (n)) >> 3) * ATT_VROW + ((tid + 256 * (n)) & 7) * 16)
#define ATT_SWRITE()                                                                                         \
  {                                                                                                          \
    *(uint4*)ATT_KDST(0) = rk0; *(uint4*)ATT_KDST(1) = rk1; *(uint4*)ATT_KDST(2) = rk2;                      \
    *(uint4*)ATT_KDST(3) = rk3; *(uint4*)ATT_KDST(4) = rk4; *(uint4*)ATT_KDST(5) = rk5;                      \
    *(uint4*)ATT_VDST(0) = rv0; *(uint4*)ATT_VDST(1) = rv1; *(uint4*)ATT_VDST(2) = rv2; *(uint4*)ATT_VDST(3) = rv3; \
  }
  __syncthreads();
  ATT_GLOAD(0)
  ATT_SWRITE()
  __syncthreads();
  for (int kt = 0; kt < nk; kt += 64) {
    const bool more = (kt + 64) < nk;
    if (more) ATT_GLOAD(kt + 64)
    f32x16 s0, s1;
#pragma unroll
    for (int r = 0; r < 16; ++r) { s0[r] = 0.f; s1[r] = 0.f; }
    const char* kp = Ks + l31 * ATT_KROW + lh * 16;
#pragma unroll
    for (int ks = 0; ks < 12; ++ks) {
      bf16x8 a0 = *(const bf16x8*)(kp + ks * 32);
      bf16x8 a1 = *(const bf16x8*)(kp + 32 * ATT_KROW + ks * 32);
      s0 = MFMA16(a0, qf[ks], s0);
      s1 = MFMA16(a1, qf[ks], s1);
    }
    float tmax = fmaxf(s0[0], s1[0]);
#pragma unroll
    for (int r = 1; r < 16; ++r) tmax = fmaxf(tmax, fmaxf(s0[r], s1[r]));
    tmax = fmaxf(tmax, __shfl_xor(tmax, 32));
    const float mn = fmaxf(m, tmax);
    const float alpha = __builtin_amdgcn_exp2f(m - mn);
    float rs = 0.f;
#pragma unroll
    for (int r = 0; r < 16; ++r) { s0[r] = __builtin_amdgcn_exp2f(s0[r] - mn); s1[r] = __builtin_amdgcn_exp2f(s1[r] - mn); rs += s0[r] + s1[r]; }
    rs += __shfl_xor(rs, 32);
    l = l * alpha + rs;
    m = mn;
    if (__any(alpha != 1.f)) {
#pragma unroll
      for (int d = 0; d < 4; ++d)
#pragma unroll
        for (int r = 0; r < 16; ++r) o[d][r] *= alpha;
    }
    bf16x8 pf[4];
    {
      uint4 t;
      t.x = pack_bf16(s0[0], s0[1]); t.y = pack_bf16(s0[2], s0[3]); t.z = pack_bf16(s0[4], s0[5]); t.w = pack_bf16(s0[6], s0[7]);
      pf[0] = __builtin_bit_cast(bf16x8, t);
      t.x = pack_bf16(s0[8], s0[9]); t.y = pack_bf16(s0[10], s0[11]); t.z = pack_bf16(s0[12], s0[13]); t.w = pack_bf16(s0[14], s0[15]);
      pf[1] = __builtin_bit_cast(bf16x8, t);
      t.x = pack_bf16(s1[0], s1[1]); t.y = pack_bf16(s1[2], s1[3]); t.z = pack_bf16(s1[4], s1[5]); t.w = pack_bf16(s1[6], s1[7]);
      pf[2] = __builtin_bit_cast(bf16x8, t);
      t.x = pack_bf16(s1[8], s1[9]); t.y = pack_bf16(s1[10], s1[11]); t.z = pack_bf16(s1[12], s1[13]); t.w = pack_bf16(s1[14], s1[15]);
      pf[3] = __builtin_bit_cast(bf16x8, t);
    }
    const char* vp = Vs + l31 * ATT_VROW + lh * 16;
#pragma unroll
    for (int g16 = 0; g16 < 4; ++g16) {
#pragma unroll
      for (int d = 0; d < 4; ++d) {
        bf16x8 a = *(const bf16x8*)(vp + d * 32 * ATT_VROW + g16 * 32);
        o[d] = MFMA16(a, pf[g16], o[d]);
      }
    }
    __syncthreads();
    if (more) ATT_SWRITE()
    __syncthreads();
  }
  const float inv = 1.f / l;
  float* tb = (float*)smem + wid * (32 * 129);
#pragma unroll
  for (int d = 0; d < 4; ++d)
#pragma unroll
    for (int r = 0; r < 16; ++r) tb[l31 * 129 + d * 32 + (r & 3) + 8 * (r >> 2) + 4 * lh] = o[d][r] * inv;
  __syncthreads();
  for (int i = lane; i < 32 * 32; i += 64) {
    const int q = i >> 5, c4 = i & 31;
    const float* s = tb + q * 129 + c4 * 4;
    *(float4*)(Op + (size_t)(wid * 32 + q) * 512 + c4 * 4) = make_float4(s[0], s[1], s[2], s[3]);
  }
  __syncthreads();
}

__device__ __forceinline__ int chunk_row0(int b, int cid) { return cid < 4 ? TLAT + b * CL + cid * 64 : b * SL + (cid - 4) * 64; }
__device__ __forceinline__ int step_of(int cid, int dir) { return dir == 0 ? cid : (cid < 4 ? 3 - cid : 71 - cid); }
__device__ __forceinline__ int cid_of(int s, int dir) { return dir == 0 ? s : (s < 4 ? 3 - s : 71 - s); }
#define MFMA32(a, b, c) __builtin_amdgcn_mfma_f32_32x32x2f32(a, b, c, 0, 0, 0)
#define ROW16(r, lh) (((r) & 3) + 8 * ((r) >> 2) + 4 * (lh))
__device__ __forceinline__ float wave_incl_scan(float v, int lane) {
#pragma unroll
  for (int o = 1; o < 64; o <<= 1) { float t = __shfl_up(v, o); if (lane >= o) v += t; }
  return v;
}

__device__ __forceinline__ void ssd_local_item(const P& p, int layer, int item, char* smem) {
  const int h = item & 7, cid = (item >> 3) % NSTEP, b = item / (8 * NSTEP);
  float* sx = (float*)smem;
  float* sB = sx + 4096;
  float* swf = sB + 64 * 129;
  float* swb = swf + 64;
  int tid_ = threadIdx.x; asm volatile("" : "+v"(tid_));
  const int tid = tid_, lane = tid & 63, wid = tid >> 6, l31 = lane & 31, lh = lane >> 5;
  const int row0 = chunk_row0(b, cid), g = h >> 2;
  __syncthreads();
  for (int i = tid; i < 1024; i += 256) {
    int q = i >> 4, c4 = i & 15;
    *(float4*)(sx + q * 64 + c4 * 4) = *(const float4*)(p.ssd_xs() + (size_t)(row0 + q) * 512 + h * 64 + c4 * 4);
  }
  for (int i = tid; i < 2048; i += 256) {
    int q = i >> 5, c4 = i & 31;
    float4 v = *(const float4*)(p.ssd_B() + (size_t)(row0 + q) * 256 + g * 128 + c4 * 4);
    float* d = sB + q * 129 + c4 * 4;
    d[0] = v.x; d[1] = v.y; d[2] = v.z; d[3] = v.w;
  }
  if (wid < 2) {
    const int dir = wid;
    const float A = -__expf(p.a_log[layer * 16 + dir * 8 + h]);
    const int q = dir ? 63 - lane : lane;
    const float dt = p.ssd_dt()[(size_t)(row0 + q) * 16 + dir * 8 + h];
    const float ac = wave_incl_scan(dt * A, lane);
    const float tot = __shfl(ac, 63);
    (dir ? swb : swf)[q] = __expf(tot - ac) * dt;
    if (lane == 0) p.ssd_atot()[((b * 2 + dir) * 8 + h) * NSTEP + step_of(cid, dir)] = tot;
  }
  __syncthreads();
  f32x16 acc[2][2];
#pragma unroll
  for (int d = 0; d < 2; ++d)
#pragma unroll
    for (int t = 0; t < 2; ++t)
#pragma unroll
      for (int r = 0; r < 16; ++r) acc[d][t][r] = 0.f;
  const int pi = wid & 1, jj = wid >> 1;
#pragma unroll 4
  for (int k = 0; k < 64; k += 2) {
    const int q = k + lh;
    const float xa = sx[q * 64 + pi * 32 + l31];
    const float af = xa * swf[q], ab = xa * swb[q];
    const float b0 = sB[q * 129 + (2 * jj) * 32 + l31], b1 = sB[q * 129 + (2 * jj + 1) * 32 + l31];
    acc[0][0] = MFMA32(af, b0, acc[0][0]); acc[0][1] = MFMA32(af, b1, acc[0][1]);
    acc[1][0] = MFMA32(ab, b0, acc[1][0]); acc[1][1] = MFMA32(ab, b1, acc[1][1]);
  }
#pragma unroll
  for (int d = 0; d < 2; ++d) {
    bfraw* dst = p.ssd_st() + ((size_t)((b * 2 + d) * 8 + h) * NSTEP + step_of(cid, d)) * 8192;
#pragma unroll
    for (int t = 0; t < 2; ++t)
#pragma unroll
      for (int r = 0; r < 16; ++r) dst[(pi * 32 + ROW16(r, lh)) * 128 + (2 * jj + t) * 32 + l31] = to_bf16(acc[d][t][r]);
  }
}

__device__ __forceinline__ void ssd_out_item(const P& p, int layer, int item, char* smem) {
  const int h = item & 7, cid = (item >> 3) % NSTEP, b = item / (8 * NSTEP);
  float* sC = (float*)smem;
  float* sBh = sC + 64 * 129;
  float* sx = sBh + 64 * 129;
  float* sP = sx + 4096;
  float* saf = sP + 64 * 65;
  float* sab = saf + 64;
  float* sdf = sab + 64;
  float* sdb = sdf + 64;
  int tid_ = threadIdx.x; asm volatile("" : "+v"(tid_));
  const int tid = tid_, lane = tid & 63, wid = tid >> 6, l31 = lane & 31, lh = lane >> 5;
  const int row0 = chunk_row0(b, cid), g = h >> 2;
  const bfraw* hf = p.ssd_st() + ((size_t)((b * 2 + 0) * 8 + h) * NSTEP + step_of(cid, 0)) * 8192;
  const bfraw* hb = p.ssd_st() + ((size_t)((b * 2 + 1) * 8 + h) * NSTEP + step_of(cid, 1)) * 8192;
  uint4 hreg[4];
#pragma unroll
  for (int u = 0; u < 4; ++u) { const int i = tid + 256 * u; hreg[u] = *(const uint4*)(hf + (i >> 4) * 128 + (i & 15) * 8); }
  __syncthreads();
  for (int i = tid; i < 1024; i += 256) {
    int q = i >> 4, c4 = i & 15;
    *(float4*)(sx + q * 64 + c4 * 4) = *(const float4*)(p.ssd_xs() + (size_t)(row0 + q) * 512 + h * 64 + c4 * 4);
  }
  for (int i = tid; i < 2048; i += 256) {
    int q = i >> 5, c4 = i & 31;
    float4 v = *(const float4*)(p.ssd_B() + (size_t)(row0 + q) * 256 + g * 128 + c4 * 4);
    float* d = sBh + q * 129 + c4 * 4;
    d[0] = v.x; d[1] = v.y; d[2] = v.z; d[3] = v.w;
    float4 w = *(const float4*)(p.ssd_C() + (size_t)(row0 + q) * 256 + g * 128 + c4 * 4);
    float* e = sC + q * 129 + c4 * 4;
    e[0] = w.x; e[1] = w.y; e[2] = w.z; e[3] = w.w;
  }
  if (wid < 2) {
    const int dir = wid;
    const float A = -__expf(p.a_log[layer * 16 + dir * 8 + h]);
    const int q = dir ? 63 - lane : lane;
    const float dt = p.ssd_dt()[(size_t)(row0 + q) * 16 + dir * 8 + h];
    const float ac = wave_incl_scan(dt * A, lane);
    (dir ? sab : saf)[q] = ac;
    (dir ? sdb : sdf)[q] = dt;
  }
  __syncthreads();
  const int it = wid >> 1, jt = wid & 1;
  {
    f32x16 sa;
#pragma unroll
    for (int r = 0; r < 16; ++r) sa[r] = 0.f;
    const float* ap = sC + (it * 32 + l31) * 129 + lh;
    const float* bp = sBh + (jt * 32 + l31) * 129 + lh;
#pragma unroll 8
    for (int k = 0; k < 128; k += 2) sa = MFMA32(ap[k], bp[k], sa);
    const int j = jt * 32 + l31;
    const float afj = saf[j], abj = sab[j], dfj = sdf[j], dbj = sdb[j];
#pragma unroll
    for (int r = 0; r < 16; ++r) {
      const int i = it * 32 + ROW16(r, lh);
      float wgt = 0.f;
      if (j <= i) wgt += __expf(saf[i] - afj) * dfj;
      if (j >= i) wgt += __expf(sab[i] - abj) * dbj;
      sP[i * 65 + j] = sa[r] * wgt;
    }
  }
  __syncthreads();
#pragma unroll
  for (int u = 0; u < 4; ++u) {
    const int i = tid + 256 * u, q = i >> 4, c8 = i & 15;
    float* d = sBh + q * 129 + c8 * 8;
    d[0] = __uint_as_float(hreg[u].x << 16); d[1] = __uint_as_float(hreg[u].x & 0xffff0000u);
    d[2] = __uint_as_float(hreg[u].y << 16); d[3] = __uint_as_float(hreg[u].y & 0xffff0000u);
    d[4] = __uint_as_float(hreg[u].z << 16); d[5] = __uint_as_float(hreg[u].z & 0xffff0000u);
    d[6] = __uint_as_float(hreg[u].w << 16); d[7] = __uint_as_float(hreg[u].w & 0xffff0000u);
  }
#pragma unroll
  for (int u = 0; u < 4; ++u) { const int i = tid + 256 * u; hreg[u] = *(const uint4*)(hb + (i >> 4) * 128 + (i & 15) * 8); }
  const int pt = wid & 1;
  f32x16 ya;
#pragma unroll
  for (int r = 0; r < 16; ++r) ya[r] = 0.f;
  {
    const float* ap = sP + (it * 32 + l31) * 65 + lh;
    const float* bp = sx + lh * 64 + pt * 32 + l31;
#pragma unroll 8
    for (int k = 0; k < 64; k += 2) ya = MFMA32(ap[k], bp[k * 64], ya);
  }
  __syncthreads();
  {
    const float ef = __expf(saf[it * 32 + l31]);
    const float* ap = sC + (it * 32 + l31) * 129 + lh;
    const float* bp = sBh + (pt * 32 + l31) * 129 + lh;
#pragma unroll 8
    for (int k = 0; k < 128; k += 2) ya = MFMA32(ap[k] * ef, bp[k], ya);
  }
  __syncthreads();
#pragma unroll
  for (int u = 0; u < 4; ++u) {
    const int i = tid + 256 * u, q = i >> 4, c8 = i & 15;
    float* d = sBh + q * 129 + c8 * 8;
    d[0] = __uint_as_float(hreg[u].x << 16); d[1] = __uint_as_float(hreg[u].x & 0xffff0000u);
    d[2] = __uint_as_float(hreg[u].y << 16); d[3] = __uint_as_float(hreg[u].y & 0xffff0000u);
    d[4] = __uint_as_float(hreg[u].z << 16); d[5] = __uint_as_float(hreg[u].z & 0xffff0000u);
    d[6] = __uint_as_float(hreg[u].w << 16); d[7] = __uint_as_float(hreg[u].w & 0xffff0000u);
  }
  __syncthreads();
  {
    const float eb = __expf(sab[it * 32 + l31]);
    const float* ap = sC + (it * 32 + l31) * 129 + lh;
    const float* bp = sBh + (pt * 32 + l31) * 129 + lh;
#pragma unroll 8
    for (int k = 0; k < 128; k += 2) ya = MFMA32(ap[k] * eb, bp[k], ya);
  }
#pragma unroll
  for (int r = 0; r < 16; ++r)
    p.ssd_y()[(size_t)(row0 + it * 32 + ROW16(r, lh)) * 512 + h * 64 + pt * 32 + l31] = ya[r];
}

__device__ __forceinline__ void ml_gates(const P& p, int layer, int row0, int h, int dir, int lane, float& bcum, float& li, float& tot) {
  const int j = dir ? 63 - lane : lane;
  const float* z = p.Z() + (size_t)(row0 + j) * NIN + ZC_MG + dir * 8;
  li = z[h] + p.gate_b[layer * 16 + dir * 8 + h];
  const float gf = z[4 + h] + p.gate_b[layer * 16 + dir * 8 + 4 + h];
  const float lf = gf >= 0.f ? -log1pf(expf(-gf)) : gf - log1pf(expf(gf));
  bcum = wave_incl_scan(lf, lane);
  tot = __shfl(bcum, 63);
}
__device__ __forceinline__ void ml_local_item(const P& p, int layer, int item, char* smem) {
  const int h = item & 3, cid = (item >> 2) % NSTEP, b = item / (4 * NSTEP);
  float* sv = (float*)smem;
  float* sk = sv + 8192;
  float* swf = sk + 64 * 65;
  float* swb = swf + 64;
  int tid_ = threadIdx.x; asm volatile("" : "+v"(tid_));
  const int tid = tid_, lane = tid & 63, wid = tid >> 6, l31 = lane & 31, lh = lane >> 5;
  const int row0 = chunk_row0(b, cid);
  __syncthreads();
  for (int i = tid; i < 2048; i += 256) {
    int j = i >> 5, c4 = i & 31;
    *(float4*)(sv + j * 128 + c4 * 4) = *(const float4*)(p.Z() + (size_t)(row0 + j) * NIN + ZC_MV + h * 128 + c4 * 4);
  }
  for (int i = tid; i < 1024; i += 256) {
    int j = i >> 4, c4 = i & 15;
    float4 v = *(const float4*)(p.Z() + (size_t)(row0 + j) * NIN + ZC_MK + h * 64 + c4 * 4);
    float* d = sk + j * 65 + c4 * 4;
    d[0] = v.x; d[1] = v.y; d[2] = v.z; d[3] = v.w;
  }
  if (wid < 2) {
    const int dir = wid;
    float bc, li, tot;
    ml_gates(p, layer, row0, h, dir, lane, bc, li, tot);
    const int j = dir ? 63 - lane : lane;
    (dir ? swb : swf)[j] = __expf(tot - bc + li);
    if (lane == 0) p.ml_gtot()[((b * 2 + dir) * 4 + h) * NSTEP + step_of(cid, dir)] = tot;
  }
  __syncthreads();
  f32x16 acc[2][2];
#pragma unroll
  for (int d = 0; d < 2; ++d)
#pragma unroll
    for (int t = 0; t < 2; ++t)
#pragma unroll
      for (int r = 0; r < 16; ++r) acc[d][t][r] = 0.f;
  const int vt = wid;
#pragma unroll 4
  for (int k = 0; k < 64; k += 2) {
    const int j = k + lh;
    const float va = sv[j * 128 + vt * 32 + l31];
    const float af = va * swf[j], ab = va * swb[j];
    const float b0 = sk[j * 65 + l31], b1 = sk[j * 65 + 32 + l31];
    acc[0][0] = MFMA32(af, b0, acc[0][0]); acc[0][1] = MFMA32(af, b1, acc[0][1]);
    acc[1][0] = MFMA32(ab, b0, acc[1][0]); acc[1][1] = MFMA32(ab, b1, acc[1][1]);
  }
#pragma unroll
  for (int d = 0; d < 2; ++d) {
    bfraw* dst = p.ml_st() + ((size_t)((b * 2 + d) * 4 + h) * NSTEP + step_of(cid, d)) * 8192;
#pragma unroll
    for (int t = 0; t < 2; ++t)
#pragma unroll
      for (int r = 0; r < 16; ++r) dst[(vt * 32 + ROW16(r, lh)) * 64 + t * 32 + l31] = to_bf16(acc[d][t][r]);
  }
  if (tid < 128) {
    const int d = tid >> 6, kk = tid & 63;
    const float* w = d ? swb : swf;
    float sacc = 0.f;
    for (int j = 0; j < 64; ++j) sacc += w[j] * sk[j * 65 + kk];
    p.ml_nst()[((size_t)((b * 2 + d) * 4 + h) * NSTEP + step_of(cid, d)) * 64 + kk] = sacc;
  }
}

__device__ __forceinline__ void ml_out_item(const P& p, int layer, int item, char* smem) {
  const int h = item & 3, cid = (item >> 2) % NSTEP, b = item / (4 * NSTEP);
  float* sq = (float*)smem;
  float* sk = sq + 64 * 65;
  float* sv = sk + 64 * 65;
  float* sPf = sv + 128 * 65;
  float* sPb = sPf + 64 * 65;
  float* sbf = sPb + 64 * 65;
  float* sbb = sbf + 64;
  float* slf = sbb + 64;
  float* slb = slf + 64;
  float* sdenf = slb + 64;
  float* sdenb = sdenf + 64;
  float* snf = sdenb + 64;
  float* snb = snf + 64;
  int tid_ = threadIdx.x; asm volatile("" : "+v"(tid_));
  const int tid = tid_, lane = tid & 63, wid = tid >> 6, l31 = lane & 31, lh = lane >> 5;
  const int row0 = chunk_row0(b, cid);
  const size_t slotf = ((size_t)((b * 2 + 0) * 4 + h) * NSTEP + step_of(cid, 0));
  const size_t slotb = ((size_t)((b * 2 + 1) * 4 + h) * NSTEP + step_of(cid, 1));
  const bfraw* csf = p.ml_st() + slotf * 8192;
  const bfraw* csb = p.ml_st() + slotb * 8192;
  uint4 creg[4];
#pragma unroll
  for (int u = 0; u < 4; ++u) { const int i = tid + 256 * u; creg[u] = *(const uint4*)(csf + (i >> 3) * 64 + (i & 7) * 8); }
  __syncthreads();
  for (int i = tid; i < 2048; i += 256) {
    int j = i >> 5, c4 = i & 31;
    *(float4*)(sv + j * 128 + c4 * 4) = *(const float4*)(p.Z() + (size_t)(row0 + j) * NIN + ZC_MV + h * 128 + c4 * 4);
  }
  for (int i = tid; i < 1024; i += 256) {
    int j = i >> 4, c4 = i & 15;
    float4 v = *(const float4*)(p.Z() + (size_t)(row0 + j) * NIN + ZC_MK + h * 64 + c4 * 4);
    float* d = sk + j * 65 + c4 * 4;
    d[0] = v.x; d[1] = v.y; d[2] = v.z; d[3] = v.w;
    float4 w = *(const float4*)(p.Z() + (size_t)(row0 + j) * NIN + ZC_MQ + h * 64 + c4 * 4);
    float* e = sq + j * 65 + c4 * 4;
    e[0] = w.x * 0.125f; e[1] = w.y * 0.125f; e[2] = w.z * 0.125f; e[3] = w.w * 0.125f;
  }
  if (wid < 2) {
    const int dir = wid;
    float bc, li, tot;
    ml_gates(p, layer, row0, h, dir, lane, bc, li, tot);
    const int j = dir ? 63 - lane : lane;
    (dir ? sbb : sbf)[j] = bc;
    (dir ? slb : slf)[j] = li;
    (dir ? snb : snf)[lane] = p.ml_nst()[(dir ? slotb : slotf) * 64 + lane];
  }
  __syncthreads();
  const int it = wid >> 1, jt = wid & 1;
  {
    f32x16 sa;
#pragma unroll
    for (int r = 0; r < 16; ++r) sa[r] = 0.f;
    const float* ap = sq + (it * 32 + l31) * 65 + lh;
    const float* bp = sk + (jt * 32 + l31) * 65 + lh;
#pragma unroll 8
    for (int k = 0; k < 64; k += 2) sa = MFMA32(ap[k], bp[k], sa);
    const int j = jt * 32 + l31;
    const float bfj = sbf[j], bbj = sbb[j], lfj = slf[j], lbj = slb[j];
#pragma unroll
    for (int r = 0; r < 16; ++r) {
      const int i = it * 32 + ROW16(r, lh);
      sPf[i * 65 + j] = j <= i ? sa[r] * __expf(sbf[i] - bfj + lfj) : 0.f;
      sPb[i * 65 + j] = j >= i ? sa[r] * __expf(sbb[i] - bbj + lbj) : 0.f;
    }
  }
  __syncthreads();
  if (tid < 128) {
    const int d = tid >> 6, i = tid & 63;
    const float* Pm = d ? sPb : sPf;
    const float* ns = d ? snb : snf;
    float rs = 0.f, qn = 0.f;
    for (int j = 0; j < 64; ++j) { rs += Pm[i * 65 + j]; qn += sq[i * 65 + j] * ns[j]; }
    (d ? sdenb : sdenf)[i] = rs + __expf((d ? sbb : sbf)[i]) * qn;
  }
  const int v0 = 2 * (wid & 1);
  f32x16 nf[2], nb[2];
#pragma unroll
  for (int t = 0; t < 2; ++t)
#pragma unroll
    for (int r = 0; r < 16; ++r) { nf[t][r] = 0.f; nb[t][r] = 0.f; }
  {
    const float* apf = sPf + (it * 32 + l31) * 65 + lh;
    const float* apb = sPb + (it * 32 + l31) * 65 + lh;
    const float* bp = sv + lh * 128 + v0 * 32 + l31;
#pragma unroll 4
    for (int k = 0; k < 64; k += 2) {
      const float af = apf[k], ab = apb[k], b0 = bp[k * 128], b1 = bp[k * 128 + 32];
      nf[0] = MFMA32(af, b0, nf[0]); nf[1] = MFMA32(af, b1, nf[1]);
      nb[0] = MFMA32(ab, b0, nb[0]); nb[1] = MFMA32(ab, b1, nb[1]);
    }
  }
  __syncthreads();
#pragma unroll
  for (int u = 0; u < 4; ++u) {
    const int i = tid + 256 * u, v = i >> 3, c8 = i & 7;
    float* d = sv + v * 65 + c8 * 8;
    d[0] = __uint_as_float(creg[u].x << 16); d[1] = __uint_as_float(creg[u].x & 0xffff0000u);
    d[2] = __uint_as_float(creg[u].y << 16); d[3] = __uint_as_float(creg[u].y & 0xffff0000u);
    d[4] = __uint_as_float(creg[u].z << 16); d[5] = __uint_as_float(creg[u].z & 0xffff0000u);
    d[6] = __uint_as_float(creg[u].w << 16); d[7] = __uint_as_float(creg[u].w & 0xffff0000u);
  }
#pragma unroll
  for (int u = 0; u < 4; ++u) { const int i = tid + 256 * u; creg[u] = *(const uint4*)(csb + (i >> 3) * 64 + (i & 7) * 8); }
  __syncthreads();
  {
    const float e = __expf(sbf[it * 32 + l31]);
    const float* ap = sq + (it * 32 + l31) * 65 + lh;
    const float* bp = sv + (v0 * 32 + l31) * 65 + lh;
#pragma unroll 4
    for (int k = 0; k < 64; k += 2) {
      const float a = ap[k] * e;
      nf[0] = MFMA32(a, bp[k], nf[0]); nf[1] = MFMA32(a, bp[32 * 65 + k], nf[1]);
    }
  }
  __syncthreads();
#pragma unroll
  for (int u = 0; u < 4; ++u) {
    const int i = tid + 256 * u, v = i >> 3, c8 = i & 7;
    float* d = sv + v * 65 + c8 * 8;
    d[0] = __uint_as_float(creg[u].x << 16); d[1] = __uint_as_float(creg[u].x & 0xffff0000u);
    d[2] = __uint_as_float(creg[u].y << 16); d[3] = __uint_as_float(creg[u].y & 0xffff0000u);
    d[4] = __uint_as_float(creg[u].z << 16); d[5] = __uint_as_float(creg[u].z & 0xffff0000u);
    d[6] = __uint_as_float(creg[u].w << 16); d[7] = __uint_as_float(creg[u].w & 0xffff0000u);
  }
  __syncthreads();
  {
    const float e = __expf(sbb[it * 32 + l31]);
    const float* ap = sq + (it * 32 + l31) * 65 + lh;
    const float* bp = sv + (v0 * 32 + l31) * 65 + lh;
#pragma unroll 4
    for (int k = 0; k < 64; k += 2) {
      const float a = ap[k] * e;
      nb[0] = MFMA32(a, bp[k], nb[0]); nb[1] = MFMA32(a, bp[32 * 65 + k], nb[1]);
    }
  }
#pragma unroll
  for (int r = 0; r < 16; ++r) {
    const int i = it * 32 + ROW16(r, lh);
    const float idf = 1.f / fmaxf(fabsf(sdenf[i]), 1.f), idb = 1.f / fmaxf(fabsf(sdenb[i]), 1.f);
#pragma unroll
    for (int t = 0; t < 2; ++t)
      p.ml_h()[(size_t)(row0 + i) * 512 + h * 128 + (v0 + t) * 32 + l31] = nf[t][r] * idf + nb[t][r] * idb;
  }
}

__device__ __forceinline__ float gelu_tanh(float x) {
  const float k0 = 0.7978845608028654f;
  return 0.5f * x * (1.f + tanhf(k0 * (x + 0.044715f * x * x * x)));
}
__device__ __forceinline__ void s5_drive(const P& p, int dg, int row0, int dir, int g, int lane, float (&sre)[64], float (&sim)[64]) {
  const int l31 = lane & 31, lh = lane >> 5;
  bf16x8 ua[2];
#pragma unroll
  for (int tt = 0; tt < 2; ++tt) {
    const int tp = 32 * tt + l31;
    const int row = dir ? row0 + 63 - tp : row0 + tp;
    const float* zp = p.Z() + (size_t)row * NIN + ZC_U + g * 16 + 8 * lh;
    const float4 a = *(const float4*)zp, b = *(const float4*)(zp + 4);
    uint4 t; t.x = pack_bf16(a.x, a.y); t.y = pack_bf16(a.z, a.w); t.z = pack_bf16(b.x, b.y); t.w = pack_bf16(b.z, b.w);
    ua[tt] = __builtin_bit_cast(bf16x8, t);
  }
  bf16x8 bfr[4];
#pragma unroll
  for (int pt = 0; pt < 4; ++pt) bfr[pt] = *(const bf16x8*)(p.s5_bbh() + ((size_t)dg * 128 + 32 * pt + l31) * 16 + 8 * lh);
  f32x16 d[2][4];
#pragma unroll
  for (int tt = 0; tt < 2; ++tt)
#pragma unroll
    for (int pt = 0; pt < 4; ++pt) {
      f32x16 z;
#pragma unroll
      for (int r = 0; r < 16; ++r) z[r] = 0.f;
      d[tt][pt] = __builtin_amdgcn_mfma_f32_32x32x16_bf16(ua[tt], bfr[pt], z, 0, 0, 0);
    }
#pragma unroll
  for (int tt = 0; tt < 2; ++tt)
#pragma unroll
    for (int r = 0; r < 16; ++r) {
      const float myre = lh ? d[tt][1][r] : d[tt][0][r];
      const float myim = lh ? d[tt][3][r] : d[tt][2][r];
      const float gre = lh ? d[tt][0][r] : d[tt][1][r];
      const float gim = lh ? d[tt][2][r] : d[tt][3][r];
      const float ore = __shfl_xor(gre, 32), oim = __shfl_xor(gim, 32);
      const int tb = 32 * tt + 8 * (r >> 2) + (r & 3);
      sre[tb] = lh ? ore : myre; sre[tb + 4] = lh ? myre : ore;
      sim[tb] = lh ? oim : myim; sim[tb + 4] = lh ? myim : oim;
    }
}

__device__ __forceinline__ void s5_local_item(const P& p, int layer, int witem, char* smem) {
  int tid_ = threadIdx.x; asm volatile("" : "+v"(tid_));
  const int lane = tid_ & 63;
  const int g = witem & 31, st = (witem >> 5) % NSTEP, dir = (witem / (32 * NSTEP)) & 1, b = witem / (64 * NSTEP);
  const int cid = cid_of(st, dir), row0 = chunk_row0(b, cid);
  const int dg = (layer * 2 + dir) * 32 + g;
  float sre[64], sim[64];
  s5_drive(p, dg, row0, dir, g, lane, sre, sim);
  const float ar = p.s5_a()[(dg * 64 + lane) * 2], ai = p.s5_a()[(dg * 64 + lane) * 2 + 1];
  float xr = 0.f, xi = 0.f;
#pragma unroll
  for (int t = 0; t < 64; ++t) {
    const float nr = ar * xr - ai * xi + sre[t];
    const float ni = ar * xi + ai * xr + sim[t];
    xr = nr; xi = ni;
  }
  const size_t slot = ((size_t)((b * 2 + dir) * 32 + g) * NSTEP + st);
  p.s5_st()[(slot * 64 + lane) * 2] = xr; p.s5_st()[(slot * 64 + lane) * 2 + 1] = xi;
}

#define S5_XROW 272
__device__ __forceinline__ void s5_out_item(const P& p, int layer, int witem, char* smem) {
  int tid_ = threadIdx.x; asm volatile("" : "+v"(tid_));
  const int lane = tid_ & 63, wid = tid_ >> 6, l31 = lane & 31, lh = lane >> 5;
  char* sX = smem + wid * (64 * S5_XROW);
  const int g = witem & 31, cid = (witem >> 5) % NSTEP, b = witem / (32 * NSTEP);
  const int row0 = chunk_row0(b, cid);
  bf16x8 cfr[8];
#pragma unroll
  for (int ks = 0; ks < 8; ++ks) cfr[ks] = *(const bf16x8*)(p.s5_cmh() + ((size_t)(layer * 32 + g) * 32 + l31) * 128 + 16 * ks + 8 * lh);
  f32x16 yf[2], yb[2];
#pragma unroll 1
  for (int dir = 0; dir < 2; ++dir) {
    const int st = step_of(cid, dir);
    const int dg = (layer * 2 + dir) * 32 + g;
    const size_t slot = ((size_t)((b * 2 + dir) * 32 + g) * NSTEP + st);
    float sre[64], sim[64];
    s5_drive(p, dg, row0, dir, g, lane, sre, sim);
    const float ar = p.s5_a()[(dg * 64 + lane) * 2], ai = p.s5_a()[(dg * 64 + lane) * 2 + 1];
    float xr = p.s5_st()[(slot * 64 + lane) * 2], xi = p.s5_st()[(slot * 64 + lane) * 2 + 1];
#pragma unroll
    for (int t = 0; t < 64; ++t) {
      const float nr = ar * xr - ai * xi + sre[t];
      const float ni = ar * xi + ai * xr + sim[t];
      xr = nr; xi = ni;
      *(bfraw*)(sX + t * S5_XROW + lane * 2) = to_bf16(xr);
      *(bfraw*)(sX + t * S5_XROW + 128 + lane * 2) = to_bf16(xi);
    }
    f32x16 y0, y1;
#pragma unroll
    for (int r = 0; r < 16; ++r) { y0[r] = 0.f; y1[r] = 0.f; }
    const char* ap = sX + l31 * S5_XROW + lh * 16;
#pragma unroll
    for (int ks = 0; ks < 8; ++ks) {
      const bf16x8 a0 = *(const bf16x8*)(ap + ks * 32);
      const bf16x8 a1 = *(const bf16x8*)(ap + 32 * S5_XROW + ks * 32);
      y0 = __builtin_amdgcn_mfma_f32_32x32x16_bf16(a0, cfr[ks], y0, 0, 0, 0);
      y1 = __builtin_amdgcn_mfma_f32_32x32x16_bf16(a1, cfr[ks], y1, 0, 0, 0);
    }
    if (dir == 0) { yf[0] = y0; yf[1] = y1; } else { yb[0] = y0; yb[1] = y1; }
  }
  const float dsk = p.s5_d[layer * 512 + g * 16 + (l31 & 15)];
#pragma unroll
  for (int tt = 0; tt < 2; ++tt)
#pragma unroll
    for (int r = 0; r < 16; ++r) {
      const float ybv = __shfl_xor(yb[1 - tt][15 - r], 32);
      if (l31 < 16) {
        const int t = 32 * tt + ROW16(r, lh);
        const float u = p.Z()[(size_t)(row0 + t) * NIN + ZC_U + g * 16 + l31];
        const float gy = gelu_tanh(yf[tt][r] + ybv + dsk * u);
        const size_t o = (size_t)(row0 + t) * 512 + g * 16 + l31;
        p.ydpre()[o] = gy;
        p.ydpre_bf()[o] = to_bf16(gy);
      }
    }
}

#define N_SSD_CH (2 * NSTEP * 8)
#define N_ML_CH (2 * NSTEP * 4)
#define N_S5_BLK (2 * 2 * NSTEP * 32 / 4)
__device__ __forceinline__ void ph_mixA(const P& p, int layer, int bid, char* smem) {
  for (int w = bid; w < N_SSD_CH + N_ML_CH + N_S5_BLK; w += gridDim.x) {
    if (w < N_SSD_CH) ssd_local_item(p, layer, w, smem);
    else if (w < N_SSD_CH + N_ML_CH) ml_local_item(p, layer, w - N_SSD_CH, smem);
    else { __syncthreads(); s5_local_item(p, layer, (w - N_SSD_CH - N_ML_CH) * 4 + (threadIdx.x >> 6), smem); }
  }
}
#define N_ATT_LAT 256
#define N_ATT_CTX 16
__device__ __forceinline__ void ph_scan(const P& p, int layer, int bid, char* smem) {
  const int nitems = 256 + 128 + 4 + 32;
  const int tid = threadIdx.x;
  for (int w = bid; w < nitems; w += gridDim.x) {
    int it = w;
    if (it < 256) {
      const int idx = it * 256 + tid, seq = idx >> 11, off = idx & 2047;
      uint2* base = (uint2*)(p.ssd_st() + (size_t)seq * NSTEP * 8192) + off;
      const float* at = p.ssd_atot() + seq * NSTEP;
      float4 hh = make_float4(0.f, 0.f, 0.f, 0.f);
#pragma unroll 4
      for (int s2 = 0; s2 < NSTEP; ++s2) {
        const uint2 tb = base[(size_t)s2 * 2048];
        uint2 ob; ob.x = pack_bf16(hh.x, hh.y); ob.y = pack_bf16(hh.z, hh.w);
        base[(size_t)s2 * 2048] = ob;
        const float e = expf(at[s2]);
        hh.x = e * hh.x + __uint_as_float(tb.x << 16); hh.y = e * hh.y + __uint_as_float(tb.x & 0xffff0000u);
        hh.z = e * hh.z + __uint_as_float(tb.y << 16); hh.w = e * hh.w + __uint_as_float(tb.y & 0xffff0000u);
      }
      continue;
    }
    it -= 256;
    if (it < 128) {
      const int idx = it * 256 + tid, seq = idx >> 11, off = idx & 2047;
      uint2* base = (uint2*)(p.ml_st() + (size_t)seq * NSTEP * 8192) + off;
      const float* at = p.ml_gtot() + seq * NSTEP;
      float4 hh = make_float4(0.f, 0.f, 0.f, 0.f);
#pragma unroll 4
      for (int s2 = 0; s2 < NSTEP; ++s2) {
        const uint2 tb = base[(size_t)s2 * 2048];
        uint2 ob; ob.x = pack_bf16(hh.x, hh.y); ob.y = pack_bf16(hh.z, hh.w);
        base[(size_t)s2 * 2048] = ob;
        const float e = expf(at[s2]);
        hh.x = e * hh.x + __uint_as_float(tb.x << 16); hh.y = e * hh.y + __uint_as_float(tb.x & 0xffff0000u);
        hh.z = e * hh.z + __uint_as_float(tb.y << 16); hh.w = e * hh.w + __uint_as_float(tb.y & 0xffff0000u);
      }
      continue;
    }
    it -= 128;
    if (it < 4) {
      const int idx = it * 256 + tid, seq = idx >> 6, off = idx & 63;
      float* base = p.ml_nst() + (size_t)seq * NSTEP * 64 + off;
      const float* at = p.ml_gtot() + seq * NSTEP;
      float hh = 0.f;
      for (int s2 = 0; s2 < NSTEP; ++s2) {
        float t = base[s2 * 64]; base[s2 * 64] = hh;
        hh = expf(at[s2]) * hh + t;
      }
      continue;
    }
    it -= 4;
    {
      const int idx = it * 256 + tid, seq = idx >> 6, sp = idx & 63;
      const int g = seq & 31, dir = (seq >> 5) & 1;
      const int dg = (layer * 2 + dir) * 32 + g;
      float pr = p.s5_a()[(dg * 64 + sp) * 2], pi = p.s5_a()[(dg * 64 + sp) * 2 + 1];
#pragma unroll
      for (int q = 0; q < 6; ++q) { float nr = pr * pr - pi * pi, ni = 2.f * pr * pi; pr = nr; pi = ni; }
      float* base = p.s5_st() + ((size_t)seq * NSTEP * 64 + sp) * 2;
      float xr = 0.f, xi = 0.f;
      for (int s2 = 0; s2 < NSTEP; ++s2) {
        float tr = base[s2 * 128], ti = base[s2 * 128 + 1];
        base[s2 * 128] = xr; base[s2 * 128 + 1] = xi;
        float nr = pr * xr - pi * xi + tr, ni = pr * xi + pi * xr + ti;
        xr = nr; xi = ni;
      }
    }
  }
}
__device__ __forceinline__ void ph_attn(const P& p, int layer, int bid, char* smem) {
  const int natt = N_ATT_LAT + (layer == 0 ? N_ATT_CTX : 0);
  for (int w = bid; w < natt; w += gridDim.x) {
    int it = w;
    const bfraw *qp, *kp, *vp; float* op; int nk;
    if (it < N_ATT_LAT) {
      int qb = it & 31, hh = (it >> 5) & 3, b = it >> 7;
      qp = p.Q() + ((size_t)(b * 4 + hh) * SL + qb * 128) * 192; kp = p.K() + (size_t)(b * 4 + hh) * NKEY * 192;
      vp = p.V() + (size_t)(b * 4 + hh) * 128 * NKEY; nk = NKEY; op = p.O() + (size_t)(b * SL + qb * 128) * 512 + hh * 128;
    } else {
      it -= N_ATT_LAT;
      int qb = it & 1, hh = (it >> 1) & 3, b = it >> 3;
      qp = p.Qc() + ((size_t)(b * 4 + hh) * CL + qb * 128) * 192; kp = p.K() + ((size_t)(b * 4 + hh) * NKEY + SL) * 192;
      vp = p.V() + (size_t)(b * 4 + hh) * 128 * NKEY + SL; nk = CL; op = p.O() + (size_t)(TLAT + b * CL + qb * 128) * 512 + hh * 128;
    }
    attn_item(qp, kp, vp, nk, op, smem);
  }
}
__device__ __forceinline__ void ph_mixC(const P& p, int layer, int bid, char* smem) {
  for (int w = bid; w < N_SSD_CH + N_ML_CH + N_S5_BLK / 2; w += gridDim.x) {
    if (w < N_SSD_CH) ssd_out_item(p, layer, w, smem);
    else if (w < N_SSD_CH + N_ML_CH) ml_out_item(p, layer, w - N_SSD_CH, smem);
    else { __syncthreads(); s5_out_item(p, layer, (w - N_SSD_CH - N_ML_CH) * 4 + (threadIdx.x >> 6), smem); }
  }
}

__device__ __forceinline__ void ph_glu(const P& p, int layer, int bid, char* smem) {
  const float* yp = p.ydpre(); float* yg = p.ydg(); const float* gb = p.glu_b + layer * 512;
  auto epi = [=](int row, int col, float v) {
    float y = yp[(size_t)row * 512 + col];
    yg[(size_t)row * 512 + col] = y * sigmoidf_(v + gb[col]);
  };
  gemm_dense<4>(p.ydpre_bf(), 512, p.glu_w + (size_t)layer * 512 * 512, 512, TTOT, 512, 512, epi, bid, smem);
}

__device__ __forceinline__ void ph_final_mix(const P& p, int layer, int bid, char* smem) {
  const int tid = threadIdx.x, lane = tid & 63, wid = tid >> 6;
  const float* onw = p.out_norm_w + layer * 2048;
  for (int r = bid * 4 + wid; r < TTOT; r += gridDim.x * 4) {
    const float* z = p.Z() + (size_t)r * NIN;
    bfraw* Y = p.Y() + (size_t)r * LDH;
    const int c = lane * 8;
    f32x4v a0 = *(const f32x4v*)(p.O() + (size_t)r * 512 + c), a1 = *(const f32x4v*)(p.O() + (size_t)r * 512 + c + 4);
    f32x4v y0 = *(const f32x4v*)(p.ssd_y() + (size_t)r * 512 + c), y1 = *(const f32x4v*)(p.ssd_y() + (size_t)r * 512 + c + 4);
    f32x4v x0 = *(const f32x4v*)(p.ssd_xs() + (size_t)r * 512 + c), x1 = *(const f32x4v*)(p.ssd_xs() + (size_t)r * 512 + c + 4);
    f32x4v g0 = *(const f32x4v*)(z + ZC_BZ + c), g1 = *(const f32x4v*)(z + ZC_BZ + c + 4);
    f32x4v h0 = *(const f32x4v*)(p.ml_h() + (size_t)r * 512 + c), h1 = *(const f32x4v*)(p.ml_h() + (size_t)r * 512 + c + 4);
    f32x4v o0 = *(const f32x4v*)(z + ZC_MO + c), o1 = *(const f32x4v*)(z + ZC_MO + c + 4);
    f32x4v d0 = *(const f32x4v*)(p.ydg() + (size_t)r * 512 + c), d1 = *(const f32x4v*)(p.ydg() + (size_t)r * 512 + c + 4);
    const float dsk = p.ssd_d[layer * 8 + (c >> 6)];
    float sa = 0.f, sb = 0.f, sc = 0.f, sd = 0.f;
    float bv[8], av[8], cv[8], dv[8];
#pragma unroll
    for (int i = 0; i < 4; ++i) {
      av[i] = a0[i]; av[4 + i] = a1[i];
      bv[i] = (y0[i] + dsk * x0[i]) * siluf_(g0[i]); bv[4 + i] = (y1[i] + dsk * x1[i]) * siluf_(g1[i]);
      cv[i] = h0[i]; cv[4 + i] = h1[i];
      dv[i] = d0[i]; dv[4 + i] = d1[i];
    }
#pragma unroll
    for (int i = 0; i < 8; ++i) { sa += av[i] * av[i]; sb += bv[i] * bv[i]; sc += cv[i] * cv[i]; sd += dv[i] * dv[i]; }
    sa = wave_sum(sa); sb = wave_sum(sb); sd = wave_sum(sd);
    sc += __shfl_xor(sc, 1); sc += __shfl_xor(sc, 2); sc += __shfl_xor(sc, 4); sc += __shfl_xor(sc, 8);
    const float ra = rsqrtf(sa * (1.f / 512.f) + EPSV), rb = rsqrtf(sb * (1.f / 512.f) + EPSV);
    const float rc = rsqrtf(sc * (1.f / 128.f) + EPSV), rd = rsqrtf(sd * (1.f / 512.f) + EPSV);
    float ogv[8];
#pragma unroll
    for (int i = 0; i < 4; ++i) { ogv[i] = sigmoidf_(o0[i]); ogv[4 + i] = sigmoidf_(o1[i]); }
    uint4 ua, ub, uc, ud;
    const float* w = onw + c;
    ua.x = pack_bf16(av[0] * ra * w[0], av[1] * ra * w[1]); ua.y = pack_bf16(av[2] * ra * w[2], av[3] * ra * w[3]);
    ua.z = pack_bf16(av[4] * ra * w[4], av[5] * ra * w[5]); ua.w = pack_bf16(av[6] * ra * w[6], av[7] * ra * w[7]);
    w = onw + 512 + c;
    ub.x = pack_bf16(bv[0] * rb * w[0], bv[1] * rb * w[1]); ub.y = pack_bf16(bv[2] * rb * w[2], bv[3] * rb * w[3]);
    ub.z = pack_bf16(bv[4] * rb * w[4], bv[5] * rb * w[5]); ub.w = pack_bf16(bv[6] * rb * w[6], bv[7] * rb * w[7]);
    w = onw + 1024 + c;
    uc.x = pack_bf16(cv[0] * rc * ogv[0] * w[0], cv[1] * rc * ogv[1] * w[1]); uc.y = pack_bf16(cv[2] * rc * ogv[2] * w[2], cv[3] * rc * ogv[3] * w[3]);
    uc.z = pack_bf16(cv[4] * rc * ogv[4] * w[4], cv[5] * rc * ogv[5] * w[5]); uc.w = pack_bf16(cv[6] * rc * ogv[6] * w[6], cv[7] * rc * ogv[7] * w[7]);
    w = onw + 1536 + c;
    ud.x = pack_bf16(dv[0] * rd * w[0], dv[1] * rd * w[1]); ud.y = pack_bf16(dv[2] * rd * w[2], dv[3] * rd * w[3]);
    ud.z = pack_bf16(dv[4] * rd * w[4], dv[5] * rd * w[5]); ud.w = pack_bf16(dv[6] * rd * w[6], dv[7] * rd * w[7]);
    *(uint4*)(Y + c) = ua; *(uint4*)(Y + 512 + c) = ub; *(uint4*)(Y + 1024 + c) = uc; *(uint4*)(Y + 1536 + c) = ud;
  }
}

__device__ __forceinline__ void ph_wout(const P& p, int layer, int bid, char* smem) {
  const P pp = p;
  const int M = layer == 0 ? TTOT : TLAT;
  auto epi = [=](int row, int col, float v) {
    const int mi = row_modidx(row);
    const float g1 = pp.modv()[(layer * 3 + mi) * 12288 + 2 * 2048 + col];
    float xin;
    if (layer == 0) xin = row < TLAT ? pp.x[(size_t)row * 2048 + col] : pp.ctx[(size_t)(row - TLAT) * 2048 + col];
    else xin = pp.X()[(size_t)row * 2048 + col];
    pp.X()[(size_t)row * 2048 + col] = xin + g1 * v;
  };
  gemm_dense_hybrid(p.Y(), LDH, p.w_out + (size_t)layer * 2048 * 2048, 2048, M, 2048, 2048, epi, bid, smem);
}

__device__ __forceinline__ void ph_router(const P& p, int layer, int bid, char* smem) {
  float* sA = (float*)smem;
  float* sW = sA + 32 * 129;
  float* sNW = sW + 128 * 64;
  float* sSH = sNW + 2048;
  float* srs = sSH + 2048;
  float* sL = srs + 32;
  const int tid = threadIdx.x, lane = tid & 63, wid = tid >> 6, l31 = lane & 31, lh = lane >> 5;
  const int T = layer == 0 ? TTOT : TLAT;
  const float* nw = p.norm2_w + layer * 2048;
  const float* wg = p.w_group + (size_t)layer * 2048 * 4;
  const float* we = p.w_expert + (size_t)layer * 2048 * 32;
  __syncthreads();
  for (int i = tid; i < 128 * 28; i += 256) sW[(i / 28) * 64 + 36 + (i % 28)] = 0.f;
  const int ar = tid >> 3, aks = (tid & 7) * 16;
  const int wk = tid >> 1, whalf = tid & 1;
  for (int item = bid; item < (T >> 5); item += gridDim.x) {
    const int row0 = item * 32;
    const int mi = row_modidx(row0);
    const float* mrow = p.modv() + (layer * 3 + mi) * 12288;
    __syncthreads();
    for (int i = tid; i < 2048; i += 256) { sNW[i] = nw[i] * (1.f + mrow[4 * 2048 + i]); sSH[i] = mrow[3 * 2048 + i]; }
#pragma unroll 2
    for (int rr = 0; rr < 8; ++rr) {
      const float* xr = p.X() + (size_t)(row0 + wid * 8 + rr) * 2048 + lane * 4;
      float ss = 0.f;
#pragma unroll
      for (int i = 0; i < 8; ++i) { float4 v = *(const float4*)(xr + i * 256); ss += v.x * v.x + v.y * v.y + v.z * v.z + v.w * v.w; }
      ss = wave_sum(ss);
      if (lane == 0) srs[wid * 8 + rr] = rsqrtf(ss * (1.f / 2048.f) + EPSV);
    }
    __syncthreads();
    const float rs = srs[ar];
    const float* xrow = p.X() + (size_t)(row0 + ar) * 2048 + aks;
    bfraw* hrow = p.H() + (size_t)(row0 + ar) * LDH + aks;
    float4 xa0, xa1, xa2, xa3, wv0, wv1, wv2, wv3, wv4;
#define RT_GLOAD(k0)                                                                                   \
    {                                                                                                  \
      xa0 = *(const float4*)(xrow + (k0)); xa1 = *(const float4*)(xrow + (k0) + 4);                    \
      xa2 = *(const float4*)(xrow + (k0) + 8); xa3 = *(const float4*)(xrow + (k0) + 12);               \
      const float* er = we + (size_t)((k0) + wk) * 32 + (whalf ? 12 : 0);                              \
      wv0 = *(const float4*)(er); wv1 = *(const float4*)(er + 4); wv2 = *(const float4*)(er + 8);      \
      wv3 = *(const float4*)(er + 12); wv4 = *(const float4*)(er + 16);                                \
      if (!whalf) wv3 = *(const float4*)(wg + (size_t)((k0) + wk) * 4);                                \
    }
#define RT_A4(q, v)                                                                                    \
    {                                                                                                  \
      const int kq = (k0w) + aks + (q) * 4;                                                            \
      float h0 = v.x * rs * sNW[kq] + sSH[kq], h1 = v.y * rs * sNW[kq + 1] + sSH[kq + 1];              \
      float h2 = v.z * rs * sNW[kq + 2] + sSH[kq + 2], h3 = v.w * rs * sNW[kq + 3] + sSH[kq + 3];      \
      float* d = sA + ar * 129 + aks + (q) * 4; d[0] = h0; d[1] = h1; d[2] = h2; d[3] = h3;            \
      uint2 hb; hb.x = pack_bf16(h0, h1); hb.y = pack_bf16(h2, h3);                                    \
      *(uint2*)(hrow + (k0w) + (q) * 4) = hb;                                                          \
    }
#define RT_SWRITE()                                                                                    \
    {                                                                                                  \
      RT_A4(0, xa0) RT_A4(1, xa1) RT_A4(2, xa2) RT_A4(3, xa3)                                          \
      float* w = sW + wk * 64;                                                                         \
      if (!whalf) {                                                                                    \
        w[0] = wv3.x; w[1] = wv3.y; w[2] = wv3.z; w[3] = wv3.w;                                        \
        w[4] = wv0.x; w[5] = wv0.y; w[6] = wv0.z; w[7] = wv0.w; w[8] = wv1.x; w[9] = wv1.y; w[10] = wv1.z; w[11] = wv1.w; \
        w[12] = wv2.x; w[13] = wv2.y; w[14] = wv2.z; w[15] = wv2.w;                                    \
      } else {                                                                                         \
        w[16] = wv0.x; w[17] = wv0.y; w[18] = wv0.z; w[19] = wv0.w; w[20] = wv1.x; w[21] = wv1.y; w[22] = wv1.z; w[23] = wv1.w; \
        w[24] = wv2.x; w[25] = wv2.y; w[26] = wv2.z; w[27] = wv2.w; w[28] = wv3.x; w[29] = wv3.y; w[30] = wv3.z; w[31] = wv3.w; \
        w[32] = wv4.x; w[33] = wv4.y; w[34] = wv4.z; w[35] = wv4.w;                                    \
      }                                                                                                \
    }
    int k0w = 0;
    RT_GLOAD(0)
    RT_SWRITE()
    __syncthreads();
    f32x16 acc;
#pragma unroll
    for (int r = 0; r < 16; ++r) acc[r] = 0.f;
    const int ct = wid & 1, kh = wid >> 1;
    const float* ap = sA + l31 * 129 + kh * 64 + lh;
    const float* bp = sW + (kh * 64 + lh) * 64 + ct * 32 + l31;
    for (int k0 = 0; k0 < 2048; k0 += 128) {
      const bool more = (k0 + 128) < 2048;
      if (more) RT_GLOAD(k0 + 128)
#pragma unroll 8
      for (int kk = 0; kk < 32; ++kk) acc = MFMA32(ap[2 * kk], bp[2 * kk * 64], acc);
      __syncthreads();
      k0w = k0 + 128;
      if (more) RT_SWRITE()
      __syncthreads();
    }
#pragma unroll
    for (int r = 0; r < 16; ++r) sL[(kh * 32 + ROW16(r, lh)) * 64 + ct * 32 + l31] = acc[r];
    __syncthreads();
    if (tid < 32) {
      const int r = row0 + tid;
      const float* l0 = sL + tid * 64;
      const float* l1 = sL + (32 + tid) * 64;
      int gi = 0; float gm = l0[0] + l1[0];
      float gl[4]; gl[0] = gm;
#pragma unroll
      for (int j = 1; j < 4; ++j) { gl[j] = l0[j] + l1[j]; if (gl[j] > gm) { gm = gl[j]; gi = j; } }
      float gs = 0.f;
#pragma unroll
      for (int j = 0; j < 4; ++j) gs += expf(gl[j] - gm);
      const float gw = 1.f / gs;
      int i1 = 0, i2 = -1; float v1 = -INFINITY, v2 = -INFINITY;
      for (int j = 0; j < 8; ++j) {
        const float e = l0[4 + gi * 8 + j] + l1[4 + gi * 8 + j];
        if (e > v1) { v2 = v1; i2 = i1; v1 = e; i1 = j; }
        else if (e > v2) { v2 = e; i2 = j; }
      }
      const float e2 = expf(v2 - v1);
      const float w1 = gw / (1.f + e2), w2 = gw * e2 / (1.f + e2);
      const int ex1 = gi * 8 + i1, ex2 = gi * 8 + i2;
      int* cnt = p.cnt() + layer * 32;
      const int p1 = atomicAdd(&cnt[ex1], 1);
      p.list_tok()[ex1 * CAPE + p1] = r * 2; p.list_w()[ex1 * CAPE + p1] = w1;
      const int p2 = atomicAdd(&cnt[ex2], 1);
      p.list_tok()[ex2 * CAPE + p2] = r * 2 + 1; p.list_w()[ex2 * CAPE + p2] = w2;
    }
  }
}

struct AGather { const bfraw* H; const int* toks; int nvalid;
  __device__ __forceinline__ const bfraw* row(int r) const { return r < nvalid ? H + (size_t)(toks[r] >> 1) * LDH : nullptr; }
  __device__ __forceinline__ const bfraw* safe() const { return H; } };
struct BGateUp { const float *g, *u; int ldb; int nb;
  __device__ __forceinline__ const float* col(int v) const { int wc = v >> 6, j = (v >> 5) & 1, c = v & 31;
    const float* b = g + (ptrdiff_t)j * (u - g); return b + nb + wc * 32 + c; }
  __device__ __forceinline__ const float* safe() const { return g; } };

__device__ __forceinline__ void moe_prefix(const P& p, int layer, int* spre) {
  __syncthreads();
  if (threadIdx.x == 0) {
    int acc = 0;
    for (int e = 0; e < 32; ++e) { spre[e] = acc; acc += (p.cnt()[layer * 32 + e] + 127) >> 7; }
    spre[32] = acc;
  }
  __syncthreads();
}
__device__ __forceinline__ void ph_moe_up(const P& p, int layer, int bid, char* smem) {
  int* spre = (int*)(smem + 98304);
  moe_prefix(p, layer, spre);
  const int ntile = spre[32];
  for (int w = bid; w < ntile * 8; w += gridDim.x) {
    const int rbg = w >> 3, nt = w & 7;
    const int e = __builtin_amdgcn_readfirstlane(__popcll(__ballot((threadIdx.x & 63) < 31 && spre[(threadIdx.x & 63) + 1] <= rbg)));
    const int rb = rbg - spre[e];
    const int cnt = p.cnt()[layer * 32 + e];
    AGather af{p.H(), p.list_tok() + e * CAPE + rb * 128, cnt - rb * 128};
    const size_t wo = ((size_t)layer * 32 + e) * 2048 * 512;
    BGateUp bf{p.w_gate + wo, p.w_up + wo, 512, nt * 64};
    bfraw* act = p.ACT() + (size_t)rbg * 128 * LDACT + nt * 64;
    auto ef = [&](const f32x16 (&acc)[2][2], int wr, int wc, int lane) {
#pragma unroll
      for (int i = 0; i < 2; ++i)
#pragma unroll
        for (int r = 0; r < 16; ++r) {
          int row = ACC_ROW(wr, i, r, lane);
          float gv = acc[i][0][r], uv = acc[i][1][r];
          act[(size_t)row * LDACT + wc * 32 + (lane & 31)] = to_bf16(siluf_(gv) * uv);
        }
    };
    gemm_tile<2>(af, bf, ef, 2048, smem);
  }
}
__device__ __forceinline__ void ph_moe_down(const P& p, int layer, int bid, char* smem) {
  int* spre = (int*)(smem + 98304);
  moe_prefix(p, layer, spre);
  const int ntile = spre[32];
  for (int w = bid; w < ntile * 16; w += gridDim.x) {
    const int rbg = w >> 4, nt = w & 15;
    const int e = __builtin_amdgcn_readfirstlane(__popcll(__ballot((threadIdx.x & 63) < 31 && spre[(threadIdx.x & 63) + 1] <= rbg)));
    const int rb = rbg - spre[e];
    const int nvalid = p.cnt()[layer * 32 + e] - rb * 128;
    ARows af{p.ACT() + (size_t)rbg * 128 * LDACT, LDACT, 0, 128};
    BPlain bf{p.w_down + ((size_t)layer * 32 + e) * 512 * 2048, 2048, nt * 128, 2048};
    const int* toks = p.list_tok() + e * CAPE + rb * 128;
    const float* lw = p.list_w() + e * CAPE + rb * 128;
    bfraw* Ys = p.Yslot();
    auto ef = [&](const f32x16 (&acc)[2][2], int wr, int wc, int lane) {
#pragma unroll
      for (int i = 0; i < 2; ++i)
#pragma unroll
        for (int r = 0; r < 16; ++r) {
          int row = ACC_ROW(wr, i, r, lane);
          if (row < nvalid) {
            int ts = toks[row]; float wgt = lw[row];
#pragma unroll
            for (int j = 0; j < 2; ++j) Ys[(size_t)ts * 2048 + nt * 128 + ACC_COL(wc, j, lane)] = to_bf16(wgt * acc[i][j][r]);
          }
        }
    };
    gemm_tile<2>(af, bf, ef, 512, smem);
  }
}

__device__ __forceinline__ void ph_out(const P& p, int bid, char* smem) {
  const int tid = threadIdx.x, lane = tid & 63, wid = tid >> 6;
  for (int r = bid * 4 + wid; r < TLAT; r += gridDim.x * 4) {
    const int mi = r >> 12;
    const float* g2 = p.modv() + (1 * 3 + mi) * 12288 + 5 * 2048;
    f32x4v v[8];
    float ss = 0.f;
#pragma unroll
    for (int q = 0; q < 8; ++q) {
      const int col = q * 256 + lane * 4;
      f32x4v xv = *(const f32x4v*)(p.X() + (size_t)r * 2048 + col);
      const f32x4v gv = *(const f32x4v*)(g2 + col);
      const f32x4v y0 = ld_bf16x4(p.Yslot() + (size_t)(2 * r) * 2048 + col);
      const f32x4v y1 = ld_bf16x4(p.Yslot() + (size_t)(2 * r + 1) * 2048 + col);
      xv += gv * (y0 + y1);
      v[q] = xv;
      ss += xv[0] * xv[0] + xv[1] * xv[1] + xv[2] * xv[2] + xv[3] * xv[3];
    }
    ss = wave_sum(ss);
    const float rs = rsqrtf(ss * (1.f / 2048.f) + EPSV);
#pragma unroll
    for (int q = 0; q < 8; ++q) {
      const int col = q * 256 + lane * 4;
      const f32x4v w4 = *(const f32x4v*)(p.final_w + col);
      *(f32x4v*)(p.out + (size_t)r * 2048 + col) = v[q] * rs * w4;
    }
  }
}

#define SMEM_BYTES 102400
#define XB_TMO      128
#define XB_XCNT(j)  (256  + 64 * (j))
#define XB_XSUB(j)  (1280 + 64 * (j))
#define XB_XGEN(j)  (2304 + 64 * (j))
#define XB_TOP      3328
#define XB_TOPGEN   3392
#define XB_SPIN_CAP (1u << 22)
#define LAS __attribute__((address_space(3)))
__device__ __forceinline__ unsigned xb_ld(unsigned* p)              { return __hip_atomic_load(p, __ATOMIC_RELAXED, __HIP_MEMORY_SCOPE_AGENT); }
__device__ __forceinline__ unsigned xb_add(unsigned* p, unsigned v) { return __hip_atomic_fetch_add(p, v, __ATOMIC_RELAXED, __HIP_MEMORY_SCOPE_AGENT); }
__device__ __forceinline__ unsigned xb_xcc_id() { return (unsigned)__builtin_amdgcn_s_getreg((3 << 11) | 20) & 0xFu; }
#define XB_SPIN(cond, bar) do { unsigned _sp = 0; while (cond) { __builtin_amdgcn_s_sleep(1); \
    if ((++_sp & 255u) == 0u) { if (xb_ld(&(bar)[XB_TMO])) break; if (_sp > XB_SPIN_CAP) { atomicAdd(&(bar)[XB_TMO], 1u); break; } } } } while (0)
struct XcdBarrier { unsigned* bar; unsigned x; unsigned rank; volatile LAS unsigned* st; };
__device__ __forceinline__ XcdBarrier xcd_barrier_post(unsigned* bar, volatile LAS unsigned* st) {
    XcdBarrier b; b.bar = bar; b.x = xb_xcc_id(); b.st = st;
    b.rank = 0u;
    if (threadIdx.x == 0) b.rank = xb_add(&bar[XB_XCNT(b.x)], 1u);
    return b;
}
__device__ __forceinline__ void xcd_barrier_complete(unsigned* bar, unsigned x, unsigned& nloc, unsigned& nx) {
    const unsigned G = gridDim.x * gridDim.y * gridDim.z;
    unsigned sum, cnt, mine, sp = 0u;
    for (;;) {
        sum = 0u; cnt = 0u; mine = 0u;
#pragma unroll
        for (unsigned j = 0; j < 16; ++j) { const unsigned c = xb_ld(&bar[XB_XCNT(j)]); sum += c; cnt += (c > 0u) ? 1u : 0u; mine = (j == x) ? c : mine; }
        if (sum == G) break;
        __builtin_amdgcn_s_sleep(1);
        if ((++sp & 255u) == 0u) { if (xb_ld(&bar[XB_TMO])) break; if (sp > XB_SPIN_CAP) { atomicAdd(&bar[XB_TMO], 1u); break; } }
    }
    nloc = mine > 0u ? mine : 1u; nx = cnt > 0u ? cnt : 1u;
}
__device__ __forceinline__ void xcd_barrier(const XcdBarrier& b) {
    asm volatile("s_waitcnt vmcnt(0)" ::: "memory");
    __syncthreads();
    if (threadIdx.x == 0) {
        unsigned* bar = b.bar;
        __builtin_amdgcn_s_waitcnt(0);
        unsigned nloc = b.st[0], nx = b.st[1];
        if (nloc == 0u) { xcd_barrier_complete(bar, b.x, nloc, nx); b.st[0] = nloc; b.st[1] = nx; }
        const unsigned old = xb_add(&bar[XB_XSUB(b.x)], 1u);
        const unsigned gen = old / nloc;
        if (old + 1u == (gen + 1u) * nloc) {
            __builtin_amdgcn_fence(__ATOMIC_RELEASE, "agent");
            asm volatile("s_waitcnt vmcnt(0)" ::: "memory");
            const unsigned og = xb_add(&bar[XB_TOP], 1u);
            const unsigned tg = og / nx;
            if (og + 1u == (tg + 1u) * nx) xb_add(&bar[XB_TOPGEN], 1u);
            else XB_SPIN(xb_ld(&bar[XB_TOPGEN]) == tg, bar);
            __builtin_amdgcn_fence(__ATOMIC_ACQUIRE, "agent");
            xb_add(&bar[XB_XGEN(b.x)], 1u);
            asm volatile("s_waitcnt vmcnt(0)" ::: "memory");
        } else {
            XB_SPIN(xb_ld(&bar[XB_XGEN(b.x)]) == gen, bar);
            __builtin_amdgcn_fence(__ATOMIC_ACQUIRE, "agent");
            asm volatile("s_waitcnt vmcnt(0)" ::: "memory");
        }
    }
    __syncthreads();
}

__global__ void __launch_bounds__(256, 1) k_fused(P p, unsigned* bar) {
  extern __shared__ __attribute__((aligned(16))) char smem_all[];
  char* smem = smem_all + 64;
  if (threadIdx.x == 0) *(uint4*)smem_all = make_uint4(0u, 0u, 0u, 0u);
  __syncthreads();
  XcdBarrier b = xcd_barrier_post(bar, (volatile LAS unsigned*)smem_all);
#define LAYER_PROGRAM(L)                                                              \
  {                                                                                   \
    ph_norm1(p, L, bid, smem); xcd_barrier(b);          \
    ph_win(p, L, bid, smem); xcd_barrier(b);                          \
    ph_prep(p, L, bid, smem); xcd_barrier(b);           \
    ph_qkv(p, L, bid, smem); ph_mixA(p, L, bid, smem); xcd_barrier(b);     \
    ph_attn(p, L, bid, smem); ph_scan(p, L, bid, smem); xcd_barrier(b);    \
    ph_mixC(p, L, bid, smem); xcd_barrier(b);             \
    ph_glu(p, L, bid, smem); xcd_barrier(b);                                \
    ph_final_mix(p, L, bid, smem); xcd_barrier(b);      \
    ph_wout(p, L, bid, smem); xcd_barrier(b);                \
    ph_router(p, L, bid, smem); xcd_barrier(b);         \
    ph_moe_up(p, L, bid, smem); xcd_barrier(b);                    \
    ph_moe_down(p, L, bid, smem); xcd_barrier(b);       \
  }
  ph_mod(p, smem); xcd_barrier(b);
  if (threadIdx.x == 0) {
    unsigned pre = 0u;
    for (unsigned j = 0; j < 16; ++j) { const unsigned c = xb_ld(&bar[XB_XCNT(j)]); if (j < b.x) pre += c; }
    ((volatile LAS unsigned*)smem_all)[2] = pre + b.rank;
  }
  __syncthreads();
  const int bid = (int)((volatile LAS unsigned*)smem_all)[2];
  LAYER_PROGRAM(0)
  LAYER_PROGRAM(1)
  ph_out(p, bid, smem);
}

extern "C" void kernel_launch(void* const* d_in, const int* in_sizes, int n_in, void* d_out, int out_size, void* d_ws,
                              size_t ws_size, hipStream_t stream) {
  P p{};
  const float* const* in = (const float* const*)d_in;
  p.x = in[0]; p.c = in[1]; p.ctx = in[2]; p.c_ctx = in[3]; p.mod_w = in[4]; p.mod_b = in[5]; p.norm1_w = in[6];
  p.w_in = in[7]; p.q_norm_w = in[8]; p.kv_norm_w = in[9]; p.w_uq = in[10]; p.w_ukv = in[11]; p.conv_w = in[12];
  p.conv_b = in[13]; p.a_log = in[14]; p.dt_bias = in[15]; p.ssd_d = in[16]; p.gate_b = in[17]; p.lam_re = in[18];
  p.lam_im = in[19]; p.log_dt = in[20]; p.b_re = in[21]; p.b_im = in[22]; p.c_re = in[23]; p.c_im = in[24];
  p.s5_d = in[25]; p.glu_w = in[26]; p.glu_b = in[27]; p.out_norm_w = in[28]; p.w_out = in[29]; p.norm2_w = in[30];
  p.w_group = in[31]; p.w_expert = in[32]; p.w_gate = in[33]; p.w_up = in[34]; p.w_down = in[35]; p.final_w = in[36];
  p.out = (float*)d_out;
  p.ws = (float*)d_ws;
  (void)ws_size; (void)in_sizes; (void)n_in; (void)out_size;

  unsigned* bar = (unsigned*)((float*)d_ws + WO_bar);
  static int grid = 0;
  if (!grid) {
    int dev = 0, cus = 0, per_cu = 0;
    hipGetDevice(&dev);
    hipDeviceGetAttribute(&cus, hipDeviceAttributeMultiprocessorCount, dev);
    (void)hipFuncSetAttribute((const void*)k_fused, hipFuncAttributeMaxDynamicSharedMemorySize, SMEM_BYTES + 64);
    (void)hipOccupancyMaxActiveBlocksPerMultiprocessor(&per_cu, k_fused, 256, SMEM_BYTES + 64);
    if (per_cu < 1) per_cu = 1;
    grid = cus * (per_cu < 1 ? per_cu : 1);
  }
  hipMemsetAsync(bar, 0, XCD_BAR_WORDS * sizeof(unsigned), stream);
  hipLaunchKernelGGL(k_fused, dim3(grid), dim3(256), SMEM_BYTES + 64, stream, p, bar);
}
```

```cpp
#include <hip/hip_runtime.h>
#include <stdint.h>

#define DM 2048
#define SL 4096
#define CL 256
#define TLAT 8192
#define TCTX 512
#define TTOT 8704
#define NIN 4192
#define NKEY 4352
#define ZC_CQ 0
#define ZC_CKV 384
#define ZC_KR 512
#define ZC_BZ 576
#define ZC_XBC 1088
#define ZC_DT 2112
#define ZC_MQ 2128
#define ZC_MK 2384
#define ZC_MV 2640
#define ZC_MO 3152
#define ZC_MG 3664
#define ZC_U 3680
#define CAPE 8704
#define EPSV 1e-6f
#define ACT_ROWS 21632

typedef float f32x16 __attribute__((ext_vector_type(16)));
typedef short bf16x8 __attribute__((ext_vector_type(8)));
typedef float f32x4v __attribute__((ext_vector_type(4)));
typedef unsigned u32x4g __attribute__((ext_vector_type(4)));
typedef unsigned short bfraw;
__device__ __forceinline__ unsigned pack_bf16(float lo, float hi) {
  typedef __bf16 bf2 __attribute__((ext_vector_type(2)));
  bf2 v; v[0] = (__bf16)lo; v[1] = (__bf16)hi;
  return __builtin_bit_cast(unsigned, v);
}
__device__ __forceinline__ bfraw to_bf16(float x) { __bf16 b = (__bf16)x; return __builtin_bit_cast(unsigned short, b); }
__device__ __forceinline__ f32x4v ld_bf16x4(const bfraw* q) {
  const uint2 t = *(const uint2*)q;
  f32x4v r; r[0] = __uint_as_float(t.x << 16); r[1] = __uint_as_float(t.x & 0xffff0000u); r[2] = __uint_as_float(t.y << 16); r[3] = __uint_as_float(t.y & 0xffff0000u);
  return r;
}
__device__ __forceinline__ float from_bf16(bfraw x) { return __uint_as_float((unsigned)x << 16); }

#define NSTEP 68
#define LDH 2112
#define LDACT 576
#define XCD_BAR_WORDS 3456
#define WS_RND(n) (((size_t)(n) + 63) & ~(size_t)63)
constexpr size_t WO_cnt = 0;
constexpr size_t WO_modv = WO_cnt + WS_RND(64);
constexpr size_t WO_H = WO_modv + WS_RND(2 * 3 * 12288);
constexpr size_t WO_X = WO_H + WS_RND((size_t)TTOT * (LDH / 2));
constexpr size_t WO_Z = WO_X + WS_RND((size_t)TTOT * 2048);
constexpr size_t WO_Aq = WO_Z + WS_RND((size_t)TTOT * NIN);
constexpr size_t WO_Akv = WO_Aq + WS_RND((size_t)TTOT * 192);
constexpr size_t WO_qraw = WO_Akv + WS_RND((size_t)TTOT * 64);
constexpr size_t WO_kvraw = WO_qraw + WS_RND((size_t)TTOT * 768);
constexpr size_t WO_Q = WO_kvraw + WS_RND((size_t)TTOT * 1024);
constexpr size_t WO_Qc = WO_Q + WS_RND((size_t)8 * SL * 96);
constexpr size_t WO_K = WO_Qc + WS_RND((size_t)8 * CL * 96);
constexpr size_t WO_V = WO_K + WS_RND((size_t)8 * NKEY * 96);
constexpr size_t WO_O = WO_V + WS_RND((size_t)8 * NKEY * 64);
constexpr size_t WO_ssd_xs = WO_O + WS_RND((size_t)TTOT * 512);
constexpr size_t WO_ssd_B = WO_ssd_xs + WS_RND((size_t)TTOT * 512);
constexpr size_t WO_ssd_C = WO_ssd_B + WS_RND((size_t)TTOT * 256);
constexpr size_t WO_ssd_dt = WO_ssd_C + WS_RND((size_t)TTOT * 256);
constexpr size_t WO_ssd_y = WO_ssd_dt + WS_RND((size_t)TTOT * 16);
constexpr size_t WO_ssd_st = WO_ssd_y + WS_RND((size_t)TTOT * 512);
constexpr size_t WO_ssd_atot = WO_ssd_st + WS_RND((size_t)32 * NSTEP * 8192);
constexpr size_t WO_ml_h = WO_ssd_atot + WS_RND(32 * NSTEP);
constexpr size_t WO_ml_st = WO_ml_h + WS_RND((size_t)TTOT * 512);
constexpr size_t WO_ml_nst = WO_ml_st + WS_RND((size_t)16 * NSTEP * 8192);
constexpr size_t WO_ml_gtot = WO_ml_nst + WS_RND((size_t)16 * NSTEP * 64);
constexpr size_t WO_s5_st = WO_ml_gtot + WS_RND(16 * NSTEP);
constexpr size_t WO_s5_a = WO_s5_st + WS_RND((size_t)128 * NSTEP * 128);
constexpr size_t WO_s5_bb = WO_s5_a + WS_RND(2 * 2 * 32 * 64 * 2);
constexpr size_t WO_s5_rf = WO_s5_bb + WS_RND((size_t)2 * 2 * 32 * 64 * 32);
constexpr size_t WO_s5_rb = WO_s5_rf + WS_RND((size_t)TTOT * 512);
constexpr size_t WO_ydpre = WO_s5_rb + WS_RND((size_t)TTOT * 512);
constexpr size_t WO_ydg = WO_ydpre + WS_RND((size_t)TTOT * 512);
constexpr size_t WO_Y = WO_ydg + WS_RND((size_t)TTOT * 512);
constexpr size_t WO_ydpre_bf = WO_Y + WS_RND((size_t)TTOT * (LDH / 2));
constexpr size_t WO_list_tok = WO_ydpre_bf + WS_RND((size_t)TTOT * 256);
constexpr size_t WO_list_w = WO_list_tok + WS_RND((size_t)32 * CAPE);
constexpr size_t WO_ACT = WO_list_w + WS_RND((size_t)32 * CAPE);
constexpr size_t WO_Yslot = WO_ACT + WS_RND((size_t)ACT_ROWS * (LDACT / 2));
constexpr size_t WO_rope_cs = WO_Yslot + WS_RND((size_t)TTOT * 2 * 2048);
constexpr size_t WO_s5_bbh = WO_rope_cs + WS_RND(64 * 16 * 2);
constexpr size_t WO_s5_cmh = WO_s5_bbh + WS_RND(128 * 128 * 16 / 2);
constexpr size_t WO_bar_old = WO_Yslot + WS_RND((size_t)TTOT * 2 * 2048);
constexpr size_t WO_bar = WO_s5_cmh + WS_RND(64 * 32 * 128 / 2);
constexpr size_t WS_TOTAL_FLOATS = WO_bar + 4096;

struct P {
  const float *x, *c, *ctx, *c_ctx, *mod_w, *mod_b, *norm1_w, *w_in, *q_norm_w, *kv_norm_w, *w_uq, *w_ukv;
  const float *conv_w, *conv_b, *a_log, *dt_bias, *ssd_d, *gate_b, *lam_re, *lam_im, *log_dt, *b_re, *b_im;
  const float *c_re, *c_im, *s5_d, *glu_w, *glu_b, *out_norm_w, *w_out, *norm2_w, *w_group, *w_expert;
  const float *w_gate, *w_up, *w_down, *final_w;
  float* out;
  float* ws;
  __device__ __forceinline__ int* cnt() const { return (int*)(ws + WO_cnt); }
  __device__ __forceinline__ float* modv() const { return (float*)(ws + WO_modv); }
  __device__ __forceinline__ bfraw* H() const { return (bfraw*)(ws + WO_H); }
  __device__ __forceinline__ float* X() const { return (float*)(ws + WO_X); }
  __device__ __forceinline__ float* Z() const { return (float*)(ws + WO_Z); }
  __device__ __forceinline__ bfraw* Aq() const { return (bfraw*)(ws + WO_Aq); }
  __device__ __forceinline__ bfraw* Akv() const { return (bfraw*)(ws + WO_Akv); }
  __device__ __forceinline__ float* qraw() const { return (float*)(ws + WO_qraw); }
  __device__ __forceinline__ float* kvraw() const { return (float*)(ws + WO_kvraw); }
  __device__ __forceinline__ bfraw* Q() const { return (bfraw*)(ws + WO_Q); }
  __device__ __forceinline__ bfraw* Qc() const { return (bfraw*)(ws + WO_Qc); }
  __device__ __forceinline__ bfraw* K() const { return (bfraw*)(ws + WO_K); }
  __device__ __forceinline__ bfraw* V() const { return (bfraw*)(ws + WO_V); }
  __device__ __forceinline__ float* O() const { return (float*)(ws + WO_O); }
  __device__ __forceinline__ float* ssd_xs() const { return (float*)(ws + WO_ssd_xs); }
  __device__ __forceinline__ float* ssd_B() const { return (float*)(ws + WO_ssd_B); }
  __device__ __forceinline__ float* ssd_C() const { return (float*)(ws + WO_ssd_C); }
  __device__ __forceinline__ float* ssd_dt() const { return (float*)(ws + WO_ssd_dt); }
  __device__ __forceinline__ float* ssd_y() const { return (float*)(ws + WO_ssd_y); }
  __device__ __forceinline__ bfraw* ssd_st() const { return (bfraw*)(ws + WO_ssd_st); }
  __device__ __forceinline__ float* ssd_atot() const { return (float*)(ws + WO_ssd_atot); }
  __device__ __forceinline__ float* ml_h() const { return (float*)(ws + WO_ml_h); }
  __device__ __forceinline__ bfraw* ml_st() const { return (bfraw*)(ws + WO_ml_st); }
  __device__ __forceinline__ float* ml_nst() const { return (float*)(ws + WO_ml_nst); }
  __device__ __forceinline__ float* ml_gtot() const { return (float*)(ws + WO_ml_gtot); }
  __device__ __forceinline__ float* s5_st() const { return (float*)(ws + WO_s5_st); }
  __device__ __forceinline__ float* s5_a() const { return (float*)(ws + WO_s5_a); }
  __device__ __forceinline__ float* s5_bb() const { return (float*)(ws + WO_s5_bb); }
  __device__ __forceinline__ float* s5_rf() const { return (float*)(ws + WO_s5_rf); }
  __device__ __forceinline__ float* s5_rb() const { return (float*)(ws + WO_s5_rb); }
  __device__ __forceinline__ float* ydpre() const { return (float*)(ws + WO_ydpre); }
  __device__ __forceinline__ float* ydg() const { return (float*)(ws + WO_ydg); }
  __device__ __forceinline__ bfraw* Y() const { return (bfraw*)(ws + WO_Y); }
  __device__ __forceinline__ bfraw* ydpre_bf() const { return (bfraw*)(ws + WO_ydpre_bf); }
  __device__ __forceinline__ int* list_tok() const { return (int*)(ws + WO_list_tok); }
  __device__ __forceinline__ float* list_w() const { return (float*)(ws + WO_list_w); }
  __device__ __forceinline__ bfraw* ACT() const { return (bfraw*)(ws + WO_ACT); }
  __device__ __forceinline__ bfraw* Yslot() const { return (bfraw*)(ws + WO_Yslot); }
  __device__ __forceinline__ float* rope_cs() const { return (float*)(ws + WO_rope_cs); }
  __device__ __forceinline__ bfraw* s5_bbh() const { return (bfraw*)(ws + WO_s5_bbh); }
  __device__ __forceinline__ bfraw* s5_cmh() const { return (bfraw*)(ws + WO_s5_cmh); }
};

__device__ __forceinline__ int row_modidx(int r) { return r < TLAT ? (r >> 12) : 2; }
__device__ __forceinline__ float sigmoidf_(float v) { return 1.f / (1.f + expf(-v)); }
__device__ __forceinline__ float siluf_(float v) { return v / (1.f + expf(-v)); }
__device__ __forceinline__ float wave_sum(float v) {
#pragma unroll
  for (int o = 32; o; o >>= 1) v += __shfl_xor(v, o);
  return v;
}
__device__ __forceinline__ float block_sum(float v, float* red) {
  v = wave_sum(v);
  __syncthreads();
  if ((threadIdx.x & 63) == 0) red[threadIdx.x >> 6] = v;
  __syncthreads();
  return red[0] + red[1] + red[2] + red[3];
}

__device__ __forceinline__ void ph_mod(const P& p, char* smem) {
  float* sc = (float*)smem;
  float* red = sc + 3 * 2048;
  const int tid = threadIdx.x;
  if (blockIdx.x == 0 && tid < 64) p.cnt()[tid] = 0;
  if (blockIdx.x == 1) {
    for (int i = tid; i < 64 * 16; i += 256) {
      const int idx = i >> 4, f = i & 15;
      const float ang = (float)idx * powf(10000.f, -(float)f * (1.f / 16.f));
      p.rope_cs()[i * 2] = cosf(ang); p.rope_cs()[i * 2 + 1] = sinf(ang);
    }
  }
  for (int i = blockIdx.x * 256 + tid; i < 64 * 32 * 128; i += gridDim.x * 256) {
    const int pp = i & 127, c = (i >> 7) & 31, lg = i >> 12;
    float v = 0.f;
    if (c < 16) v = pp < 64 ? p.c_re[((size_t)lg * 16 + c) * 64 + pp] : -p.c_im[((size_t)lg * 16 + c) * 64 + pp - 64];
    p.s5_cmh()[i] = to_bf16(v);
  }
  for (int i = blockIdx.x * 256 + tid; i < 2 * 2 * 32 * 64; i += gridDim.x * 256) {
    const int sp = i & 63, g = (i >> 6) & 31, l = i >> 12;
    const float lr = p.lam_re[i], li = p.lam_im[i];
    const float dt = expf(p.log_dt[i >> 6]);
    const float mag = expf(lr * dt);
    const float ar = mag * cosf(li * dt), ai = mag * sinf(li * dt);
    const float den = lr * lr + li * li;
    const float cr_ = ((ar - 1.f) * lr + ai * li) / den;
    const float ci_ = (ai * lr - (ar - 1.f) * li) / den;
    p.s5_a()[i * 2] = ar; p.s5_a()[i * 2 + 1] = ai;
    for (int c = 0; c < 16; ++c) {
      float br = p.b_re[((size_t)(l * 32 + g) * 64 + sp) * 16 + c];
      float bim = p.b_im[((size_t)(l * 32 + g) * 64 + sp) * 16 + c];
      p.s5_bb()[(size_t)i * 32 + c] = cr_ * br - ci_ * bim;
      p.s5_bb()[(size_t)i * 32 + 16 + c] = cr_ * bim + ci_ * br;
      p.s5_bbh()[((size_t)(i >> 6) * 128 + sp) * 16 + c] = to_bf16(cr_ * br - ci_ * bim);
      p.s5_bbh()[((size_t)(i >> 6) * 128 + 64 + sp) * 16 + c] = to_bf16(cr_ * bim + ci_ * br);
    }
  }
  for (int i = tid; i < 3 * 2048; i += 256) {
    int r = i >> 11, k = i & 2047;
    float v = r < 2 ? p.c[r * 2048 + k] : p.c_ctx[k];
    sc[i] = siluf_(v);
  }
  __syncthreads();
  for (int w = blockIdx.x; w < 2 * 96; w += gridDim.x) {
    int l = w / 96, j0 = (w % 96) * 128;
    int cg = tid & 31, ks = tid >> 5;
    const float* W = p.mod_w + (size_t)l * 2048 * 12288 + j0 + cg * 4;
    float acc[3][4];
#pragma unroll
    for (int r = 0; r < 3; ++r)
#pragma unroll
      for (int c = 0; c < 4; ++c) acc[r][c] = 0.f;
#pragma unroll 16
    for (int k = ks * 256; k < ks * 256 + 256; ++k) {
      float4 wv = *(const float4*)(W + (size_t)k * 12288);
      float s0 = sc[k], s1 = sc[2048 + k], s2 = sc[4096 + k];
      acc[0][0] += s0 * wv.x; acc[0][1] += s0 * wv.y; acc[0][2] += s0 * wv.z; acc[0][3] += s0 * wv.w;
      acc[1][0] += s1 * wv.x; acc[1][1] += s1 * wv.y; acc[1][2] += s1 * wv.z; acc[1][3] += s1 * wv.w;
      acc[2][0] += s2 * wv.x; acc[2][1] += s2 * wv.y; acc[2][2] += s2 * wv.z; acc[2][3] += s2 * wv.w;
    }
    __syncthreads();
#pragma unroll
    for (int r = 0; r < 3; ++r)
#pragma unroll
      for (int c = 0; c < 4; ++c) red[(ks * 32 + cg) * 12 + r * 4 + c] = acc[r][c];
    __syncthreads();
    for (int o = tid; o < 384; o += 256) {
      int r = o >> 7, c = o & 127;
      float s = 0.f;
#pragma unroll
      for (int q = 0; q < 8; ++q) s += red[(q * 32 + (c >> 2)) * 12 + r * 4 + (c & 3)];
      s += p.mod_b[l * 12288 + j0 + c];
      p.modv()[(l * 3 + r) * 12288 + j0 + c] = s;
    }
    __syncthreads();
  }
}

__device__ __forceinline__ void ph_norm1(const P& p, int layer, int bid, char* smem) {
  const int tid = threadIdx.x, lane = tid & 63, wid = tid >> 6;
  const float* nw = p.norm1_w + layer * 2048;
  for (int r = bid * 4 + wid; r < TTOT; r += gridDim.x * 4) {
    const int mi = row_modidx(r);
    const float* mrow = p.modv() + (layer * 3 + mi) * 12288;
    f32x4v v[8];
    float ss = 0.f;
#pragma unroll
    for (int q = 0; q < 8; ++q) {
      const int col = q * 256 + lane * 4;
      f32x4v xv;
      if (layer == 0) {
        const float* src = r < TLAT ? p.x + (size_t)r * 2048 : p.ctx + (size_t)(r - TLAT) * 2048;
        xv = *(const f32x4v*)(src + col);
      } else {
        xv = *(const f32x4v*)(p.X() + (size_t)r * 2048 + col);
        const float* g2 = p.modv() + ((layer - 1) * 3 + mi) * 12288 + 5 * 2048;
        const f32x4v gv = *(const f32x4v*)(g2 + col);
        const f32x4v y0 = ld_bf16x4(p.Yslot() + (size_t)(2 * r) * 2048 + col);
        const f32x4v y1 = ld_bf16x4(p.Yslot() + (size_t)(2 * r + 1) * 2048 + col);
        xv += gv * (y0 + y1);
        *(f32x4v*)(p.X() + (size_t)r * 2048 + col) = xv;
      }
      v[q] = xv;
      ss += xv[0] * xv[0] + xv[1] * xv[1] + xv[2] * xv[2] + xv[3] * xv[3];
    }
    ss = wave_sum(ss);
    const float rs = rsqrtf(ss * (1.f / 2048.f) + EPSV);
#pragma unroll
    for (int q = 0; q < 8; ++q) {
      const int col = q * 256 + lane * 4;
      const f32x4v w4 = *(const f32x4v*)(nw + col);
      const f32x4v sh = *(const f32x4v*)(mrow + col);
      const f32x4v scv = *(const f32x4v*)(mrow + 2048 + col);
      const f32x4v o = v[q] * rs * w4 * (1.f + scv) + sh;
      uint2 ob; ob.x = pack_bf16(o[0], o[1]); ob.y = pack_bf16(o[2], o[3]);
      *(uint2*)(p.H() + (size_t)r * LDH + col) = ob;
    }
  }
}

template <int MI, class AF, class BF, class EF>
__device__ __forceinline__ void gemm_tile(const AF& af, const BF& bf, const EF& ef, int K, char* smem) {
  constexpr int BM = MI * 64;
  constexpr int NA = MI * 2;
  constexpr int ABYTES = BM * 128, STAGE = ABYTES + 16384;
  int tid_ = threadIdx.x; asm volatile("" : "+v"(tid_));
  const int tid = tid_, lane = tid & 63, wid = tid >> 6, wr = wid >> 1, wc = wid & 1;
  const int l31 = lane & 31, lh = lane >> 5;
  f32x16 acc[MI][2];
#pragma unroll
  for (int i = 0; i < MI; ++i)
#pragma unroll
    for (int j = 0; j < 2; ++j)
#pragma unroll
      for (int r = 0; r < 16; ++r) acc[i][j][r] = 0.f;
  const int arl = tid >> 3, ac = tid & 7;
  const bfraw* arow[NA];
#pragma unroll
  for (int i = 0; i < NA; ++i) { const bfraw* q = af.row(arl + 32 * i); arow[i] = (q ? q : af.safe()) + ac * 8; }
  const int n4 = tid & 31, kg = tid >> 5;
  const float* bc;
  { const float* q = bf.col(n4 * 4); bc = (q ? q : bf.safe()) + (size_t)(kg * 8) * bf.ldb; }
  const size_t ldb = (size_t)bf.ldb;
  typedef unsigned u32x4v __attribute__((ext_vector_type(4)));
  u32x4v ra[2][NA];
  f32x4v rb[2][8];
#define GM_GL(set, k0)                                                               \
  {                                                                                  \
    _Pragma("unroll") for (int i = 0; i < NA; ++i) ra[set][i] = *(const u32x4v*)(arow[i] + (k0)); \
    const float* bq = bc + (size_t)(k0) * ldb;                                       \
    _Pragma("unroll") for (int j = 0; j < 8; ++j) rb[set][j] = *(const f32x4v*)(bq + (size_t)j * ldb); \
  }
#define GM_SW(set, buf)                                                              \
  {                                                                                  \
    char* Ab = smem + (buf) * STAGE; char* Bb = Ab + ABYTES;                         \
    const int asw = (ac ^ ((arl >> 1) & 7)) << 4;                                    \
    _Pragma("unroll") for (int i = 0; i < NA; ++i) *(u32x4v*)(Ab + (arl + 32 * i) * 128 + asw) = ra[set][i]; \
    _Pragma("unroll") for (int i4 = 0; i4 < 4; ++i4) {                               \
      const int n = n4 * 4 + i4;                                                     \
      u32x4v v;                                                                      \
      v[0] = pack_bf16(rb[set][0][i4], rb[set][1][i4]); v[1] = pack_bf16(rb[set][2][i4], rb[set][3][i4]); \
      v[2] = pack_bf16(rb[set][4][i4], rb[set][5][i4]); v[3] = pack_bf16(rb[set][6][i4], rb[set][7][i4]); \
      *(u32x4v*)(Bb + n * 128 + ((kg ^ ((n >> 1) & 7)) << 4)) = v;                   \
    }                                                                                \
  }
#define GM_COMPUTE(buf, KK0, KK1)                                                    \
  {                                                                                  \
    const char* ap = smem + (buf) * STAGE + (wr * (BM / 2) + l31) * 128;             \
    const char* bp = smem + (buf) * STAGE + ABYTES + (wc * 64 + l31) * 128;          \
    _Pragma("unroll") for (int kk = KK0; kk < KK1; ++kk) {                           \
      const int co = ((2 * kk + lh) ^ fsw) << 4;                                     \
      const bf16x8 b0 = *(const bf16x8*)(bp + co), b1 = *(const bf16x8*)(bp + 32 * 128 + co); \
      _Pragma("unroll") for (int i = 0; i < MI; ++i) {                               \
        const bf16x8 a = *(const bf16x8*)(ap + i * 32 * 128 + co);                   \
        acc[i][0] = __builtin_amdgcn_mfma_f32_32x32x16_bf16(a, b0, acc[i][0], 0, 0, 0); \
        acc[i][1] = __builtin_amdgcn_mfma_f32_32x32x16_bf16(a, b1, acc[i][1], 0, 0, 0); \
      }                                                                              \
    }                                                                                \
  }
  const int fsw = (l31 >> 1) & 7;
  const int nsteps = K >> 6;
  __syncthreads();
  const int klast = (nsteps - 1) * 64;
  GM_GL(0, 0)
  GM_SW(0, 0)
  GM_GL(1, 64)
  __syncthreads();
  for (int s = 0; s < nsteps; s += 2) {
    { const int kn = min((s + 2) * 64, klast); GM_GL(0, kn) }
    GM_COMPUTE(0, 0, 2)
    __builtin_amdgcn_sched_barrier(0);
    GM_SW(1, 1)
    __builtin_amdgcn_sched_barrier(0);
    GM_COMPUTE(0, 2, 4)
    __syncthreads();
    { const int kn = min((s + 3) * 64, klast); GM_GL(1, kn) }
    GM_COMPUTE(1, 0, 2)
    __builtin_amdgcn_sched_barrier(0);
    GM_SW(0, 0)
    __builtin_amdgcn_sched_barrier(0);
    GM_COMPUTE(1, 2, 4)
    __syncthreads();
  }
  ef(acc, wr, wc, lane);
}
#define ACC_ROWM(MI, wr, i, r, lane) ((wr) * ((MI) * 32) + (i) * 32 + ((r) & 3) + 8 * ((r) >> 2) + 4 * ((lane) >> 5))
#define ACC_ROW(wr, i, r, lane) ACC_ROWM(2, wr, i, r, lane)
#define ACC_COL(wc, j, lane) ((wc) * 64 + (j) * 32 + ((lane) & 31))

struct ARows { const bfraw* base; int ld; int m0; int M;
  __device__ __forceinline__ const bfraw* row(int r) const { int g = m0 + r; return g < M ? base + (size_t)g * ld : nullptr; }
  __device__ __forceinline__ const bfraw* safe() const { return base; } };
struct BPlain { const float* B; int ldb; int n0; int N;
  __device__ __forceinline__ const float* col(int v) const { int n = n0 + v; return n < N ? B + n : nullptr; }
  __device__ __forceinline__ const float* safe() const { return B; } };

template <int MI, class EPI>
__device__ __forceinline__ void gemm_dense(const bfraw* A, int lda, const float* B, int ldb, int M, int N, int K, const EPI& epi, int bid, char* smem) {
  constexpr int BM = MI * 64;
  const int mt = (M + BM - 1) / BM, nt = (N + 127) >> 7;
  const int nslots = ((nt + 1) >> 1) * mt * 2;
  for (int w = bid; w < nslots; w += gridDim.x) {
    const int sr = w / (mt * 2), rem = w - sr * (mt * 2);
    const int n_t = sr * 2 + (rem & 1);
    if (n_t >= nt) continue;
    const int m0 = (rem >> 1) * BM, n0 = n_t * 128;
    ARows af{A, lda, m0, M};
    BPlain bf{B, ldb, n0, N};
    auto ef = [&](const f32x16 (&acc)[MI][2], int wr, int wc, int lane) {
#pragma unroll
      for (int i = 0; i < MI; ++i)
#pragma unroll
        for (int j = 0; j < 2; ++j)
#pragma unroll
          for (int r = 0; r < 16; ++r) {
            int row = m0 + ACC_ROWM(MI, wr, i, r, lane), col = n0 + ACC_COL(wc, j, lane);
            if (row < M && col < N) epi(row, col, acc[i][j][r]);
          }
    };
    gemm_tile<MI>(af, bf, ef, K, smem);
  }
}


template <class EPI>
__device__ __forceinline__ void gemm_dense_hybrid(const bfraw* A, int lda, const float* B, int ldb, int M, int N, int K, const EPI& epi, int bid, char* smem) {
  const int mt = M / 256, nt = (N + 127) >> 7;
  const int npair = (nt >> 1) * mt * 2, ntiles = mt * nt;
  const int G = gridDim.x;
  const int nfull = (ntiles / G) * G, rem = ntiles - nfull;
  auto tile_of = [&](int w, int& m_t, int& n_t) {
    if (w < npair) { const int sr = w / (mt * 2), r2 = w - sr * (mt * 2); m_t = r2 >> 1; n_t = sr * 2 + (r2 & 1); }
    else { m_t = w - npair; n_t = nt - 1; }
  };
  for (int w = bid; w < nfull; w += G) {
    int m_t, n_t; tile_of(w, m_t, n_t);
    const int m0 = m_t * 256, n0 = n_t * 128;
    ARows af{A, lda, m0, M};
    BPlain bf{B, ldb, n0, N};
    auto ef = [&](const f32x16 (&acc)[4][2], int wr, int wc, int lane) {
#pragma unroll
      for (int i = 0; i < 4; ++i)
#pragma unroll
        for (int j = 0; j < 2; ++j)
#pragma unroll
          for (int r = 0; r < 16; ++r) {
            int row = m0 + ACC_ROWM(4, wr, i, r, lane), col = n0 + ACC_COL(wc, j, lane);
            if (col < N) epi(row, col, acc[i][j][r]);
          }
    };
    gemm_tile<4>(af, bf, ef, K, smem);
  }
  for (int w = bid; w < 2 * rem; w += G) {
    int m_t, n_t; tile_of(nfull + (w >> 1), m_t, n_t);
    const int m0 = m_t * 256 + (w & 1) * 128, n0 = n_t * 128;
    ARows af{A, lda, m0, M};
    BPlain bf{B, ldb, n0, N};
    auto ef = [&](const f32x16 (&acc)[2][2], int wr, int wc, int lane) {
#pragma unroll
      for (int i = 0; i < 2; ++i)
#pragma unroll
        for (int j = 0; j < 2; ++j)
#pragma unroll
          for (int r = 0; r < 16; ++r) {
            int row = m0 + ACC_ROWM(2, wr, i, r, lane), col = n0 + ACC_COL(wc, j, lane);
            if (col < N) epi(row, col, acc[i][j][r]);
          }
    };
    gemm_tile<2>(af, bf, ef, K, smem);
  }
}

__device__ __forceinline__ void ph_win(const P& p, int layer, int bid, char* smem) {
  float* Z = p.Z();
  auto epi = [=](int row, int col, float v) { Z[(size_t)row * NIN + col] = v; };
  gemm_dense_hybrid(p.H(), LDH, p.w_in + (size_t)layer * 2048 * NIN, NIN, TTOT, NIN, 2048, epi, bid, smem);
}

__device__ __forceinline__ void ph_prep(const P& p, int layer, int bid, char* smem) {
  const int tid = threadIdx.x, lane = tid & 63, wid = tid >> 6;
  for (int r = bid * 4 + wid; r < TTOT; r += gridDim.x * 4) {
    const float* z = p.Z() + (size_t)r * NIN;
    float q[6]; float ss = 0.f;
#pragma unroll
    for (int i = 0; i < 6; ++i) { q[i] = z[ZC_CQ + i * 64 + lane]; ss += q[i] * q[i]; }
    ss = wave_sum(ss);
    float rs = rsqrtf(ss * (1.f / 384.f) + EPSV);
#pragma unroll
    for (int i = 0; i < 6; ++i) p.Aq()[(size_t)r * 384 + i * 64 + lane] = to_bf16(q[i] * rs * p.q_norm_w[layer * 384 + i * 64 + lane]);
    float k0 = z[ZC_CKV + lane], k1 = z[ZC_CKV + 64 + lane];
    float s2 = wave_sum(k0 * k0 + k1 * k1);
    float rs2 = rsqrtf(s2 * (1.f / 128.f) + EPSV);
    p.Akv()[(size_t)r * 128 + lane] = to_bf16(k0 * rs2 * p.kv_norm_w[layer * 128 + lane]);
    p.Akv()[(size_t)r * 128 + 64 + lane] = to_bf16(k1 * rs2 * p.kv_norm_w[layer * 128 + 64 + lane]);
  }
  const float* cw = p.conv_w + layer * 5 * 1024;
  const float* cb = p.conv_b + layer * 1024;
  const int ch = tid * 4;
  const f32x4v bias = *(const f32x4v*)(cb + ch);
  f32x4v wk[5];
#pragma unroll
  for (int k = 0; k < 5; ++k) wk[k] = *(const f32x4v*)(cw + k * 1024 + ch);
  for (int rb = bid; rb < TTOT / 8; rb += gridDim.x) {
    const int r0 = rb * 8;
    int base, len;
    if (r0 < TLAT) { base = (r0 >> 12) << 12; len = SL; } else { base = TLAT + (((r0 - TLAT) >> 8) << 8); len = CL; }
    const int t0 = r0 - base;
    f32x4v xw[12];
#pragma unroll
    for (int u = 0; u < 12; ++u) {
      const int tt = t0 + u - 2;
      const f32x4v zero = {0.f, 0.f, 0.f, 0.f};
      xw[u] = (tt >= 0 && tt < len) ? *(const f32x4v*)(p.Z() + (size_t)(base + tt) * NIN + ZC_XBC + ch) : zero;
    }
#pragma unroll
    for (int j = 0; j < 8; ++j) {
      f32x4v acc = bias;
#pragma unroll
      for (int k = 0; k < 5; ++k) acc += xw[j + k] * wk[k];
      acc[0] = siluf_(acc[0]); acc[1] = siluf_(acc[1]); acc[2] = siluf_(acc[2]); acc[3] = siluf_(acc[3]);
      const int r = r0 + j;
      if (ch < 512) *(f32x4v*)(p.ssd_xs() + (size_t)r * 512 + ch) = acc;
      else if (ch < 768) *(f32x4v*)(p.ssd_B() + (size_t)r * 256 + (ch - 512)) = acc;
      else *(f32x4v*)(p.ssd_C() + (size_t)r * 256 + (ch - 768)) = acc;
    }
    if (tid < 128) {
      const int r = r0 + (tid >> 4), c = tid & 15;
      float v = p.Z()[(size_t)r * NIN + ZC_DT + c] + p.dt_bias[layer * 16 + c];
      p.ssd_dt()[(size_t)r * 16 + c] = v > 20.f ? v : log1pf(expf(v));
    }
  }
}

__device__ __forceinline__ void ph_qkv(const P& p, int layer, int bid, char* smem) {
  const int tid = threadIdx.x;
  const float qscale = 0.07216878364870322f * 1.4426950408889634f;
  const float* rope = p.rope_cs();
  for (int r = bid; r < TTOT; r += gridDim.x) {
    const bool lat = r < TLAT;
    int b, pos;
    if (lat) { b = r >> 12; pos = r & 4095; } else { b = (r - TLAT) >> 8; pos = (r - TLAT) & 255; }
    const int kpos = lat ? pos : SL + pos;
    const float* zr = p.Z() + (size_t)r * NIN + ZC_KR;
    const int h = tid >> 6, e = tid & 63;
    float v;
    if (!lat) v = zr[e];
    else {
      const int a = e >> 5, half = (e >> 4) & 1, f = e & 15;
      const float x1 = zr[a * 32 + f], x2 = zr[a * 32 + 16 + f];
      const int idx = a == 0 ? (pos >> 6) : (pos & 63);
      const float cs = rope[(idx * 16 + f) * 2], sn = rope[(idx * 16 + f) * 2 + 1];
      v = half == 0 ? x1 * cs - x2 * sn : x1 * sn + x2 * cs;
    }
    p.K()[((size_t)(b * 4 + h) * NKEY + kpos) * 192 + 128 + e] = to_bf16(v);
  }
  {
    const float* B = p.w_uq + (size_t)layer * 384 * 768;
    for (int w = bid; w < 68 * 6; w += gridDim.x) {
      const int n_t = w / 68, m_t = w - n_t * 68;
      const int m0 = m_t * 128, n0 = n_t * 128;
      ARows af{p.Aq(), 384, m0, TTOT};
      BPlain bf{B, 768, n0, 768};
      const bool lat = m0 < TLAT;
      const int b = lat ? (m0 >> 12) : ((m0 - TLAT) >> 8);
      const int pos0 = lat ? (m0 & 4095) : ((m0 - TLAT) & 255);
      auto ef = [&](const f32x16 (&acc)[2][2], int wr, int wc, int lane) {
        const int l31 = lane & 31;
#pragma unroll
        for (int j = 0; j < 2; ++j) {
          const int col = n0 + wc * 64 + j * 32;
          const int h = col / 192, d0 = col - h * 192;
          const bool isrope = lat && d0 >= 128;
          const int f = l31 & 15;
#pragma unroll
          for (int i = 0; i < 2; ++i)
#pragma unroll
            for (int r = 0; r < 16; ++r) {
              const int pos = pos0 + ACC_ROW(wr, i, r, lane);
              float v = acc[i][j][r];
              const float pv = __shfl_xor(v, 16);
              if (isrope) {
                const int idx = d0 == 128 ? (pos >> 6) : (pos & 63);
                const float cs = rope[(idx * 16 + f) * 2], sn = rope[(idx * 16 + f) * 2 + 1];
                v = (l31 < 16) ? v * cs - pv * sn : pv * sn + v * cs;
              }
              bfraw* dst = lat ? p.Q() + ((size_t)(b * 4 + h) * SL + pos) * 192 : p.Qc() + ((size_t)(b * 4 + h) * CL + pos) * 192;
              dst[d0 + l31] = to_bf16(v * qscale);
            }
        }
      };
      gemm_tile<2>(af, bf, ef, 384, smem);
    }
  }
  {
    const float* B = p.w_ukv + (size_t)layer * 128 * 1024;
    for (int w = bid; w < 68 * 8; w += gridDim.x) {
      const int n_t = w / 68, m_t = w - n_t * 68;
      const int m0 = m_t * 128, n0 = n_t * 128;
      ARows af{p.Akv(), 128, m0, TTOT};
      BPlain bf{B, 1024, n0, 1024};
      const bool lat = m0 < TLAT;
      const int b = lat ? (m0 >> 12) : ((m0 - TLAT) >> 8);
      const int kpos0 = lat ? (m0 & 4095) : SL + ((m0 - TLAT) & 255);
      const int h = n_t >> 1;
      const bool isv = n_t & 1;
      auto ef = [&](const f32x16 (&acc)[2][2], int wr, int wc, int lane) {
        const int l31 = lane & 31, lh = lane >> 5;
        if (!isv) {
#pragma unroll
          for (int i = 0; i < 2; ++i)
#pragma unroll
            for (int j = 0; j < 2; ++j)
#pragma unroll
              for (int r = 0; r < 16; ++r) {
                const int kpos = kpos0 + ACC_ROW(wr, i, r, lane);
                p.K()[((size_t)(b * 4 + h) * NKEY + kpos) * 192 + wc * 64 + j * 32 + l31] = to_bf16(acc[i][j][r]);
              }
        } else {
#pragma unroll
          for (int i = 0; i < 2; ++i)
#pragma unroll
            for (int j = 0; j < 2; ++j) {
              const int d = wc * 64 + j * 32 + l31;
              bfraw* vrow = p.V() + ((size_t)(b * 4 + h) * 128 + d) * NKEY + kpos0 + wr * 64 + i * 32;
#pragma unroll
              for (int s = 0; s < 2; ++s) {
                uint4 t;
                t.x = pack_bf16(acc[i][j][8 * s + 0], acc[i][j][8 * s + 1]); t.y = pack_bf16(acc[i][j][8 * s + 2], acc[i][j][8 * s + 3]);
                t.z = pack_bf16(acc[i][j][8 * s + 4], acc[i][j][8 * s + 5]); t.w = pack_bf16(acc[i][j][8 * s + 6], acc[i][j][8 * s + 7]);
                *(uint4*)(vrow + 16 * s + 8 * lh) = t;
              }
            }
        }
      };
      gemm_tile<2>(af, bf, ef, 128, smem);
    }
  }
}

#define ATT_KROW 400
#define ATT_VROW 144
#define MFMA16(a, b, c) __builtin_amdgcn_mfma_f32_32x32x16_bf16(a, b, c, 0, 0, 0)
__device__ __forceinline__ void attn_item(const bfraw* __restrict__ Qp, const bfraw* __restrict__ Kp, const bfraw* __restrict__ Vtp,
                                          int nk, float* __restrict__ Op, char* smem) {
  char* Ks = smem;
  char* Vs = smem + 64 * ATT_KROW;
  int tid_ = threadIdx.x; asm volatile("" : "+v"(tid_));
  const int tid = tid_, lane = tid & 63, wid = tid >> 6, l31 = lane & 31, lh = lane >> 5;
  bf16x8 qf[12];
  {
    const bfraw* qrow = Qp + (size_t)(wid * 32 + l31) * 192 + lh * 8;
#pragma unroll
    for (int ks = 0; ks < 12; ++ks) qf[ks] = *(const bf16x8*)(qrow + ks * 16);
  }
  f32x16 o[4];
#pragma unroll
  for (int d = 0; d < 4; ++d)
#pragma unroll
    for (int r = 0; r < 16; ++r) o[d][r] = 0.f;
  float m = -INFINITY, l = 0.f;
  uint4 rk0, rk1, rk2, rk3, rk4, rk5, rv0, rv1, rv2, rv3;
#define ATT_KSRC(n, kt) (Kp + (size_t)((kt) + (tid + 256 * (n)) / 24) * 192 + ((tid + 256 * (n)) % 24) * 8)
#define ATT_VSRC(n, kt) (Vtp + (size_t)((tid + 256 * (n)) >> 3) * NKEY + (kt) + ((tid + 256 * (n)) & 7) * 8)
#define ATT_GLOAD(kt)                                                                                        \
  {                                                                                                          \
    rk0 = *(const uint4*)ATT_KSRC(0, kt); rk1 = *(const uint4*)ATT_KSRC(1, kt); rk2 = *(const uint4*)ATT_KSRC(2, kt); \
    rk3 = *(const uint4*)ATT_KSRC(3, kt); rk4 = *(const uint4*)ATT_KSRC(4, kt); rk5 = *(const uint4*)ATT_KSRC(5, kt); \
    rv0 = *(const uint4*)ATT_VSRC(0, kt); rv1 = *(const uint4*)ATT_VSRC(1, kt);                              \
    rv2 = *(const uint4*)ATT_VSRC(2, kt); rv3 = *(const uint4*)ATT_VSRC(3, kt);                              \
  }
#define ATT_KDST(n) (Ks + ((tid + 256 * (n)) / 24) * ATT_KROW + ((tid + 256 * (n)) % 24) * 16)
#define ATT_VDST(n) (Vs + ((tid + 256 * (n)) >> 3) * ATT_VROW + ((tid + 256 * (n)) & 7) * 16)
#define ATT_SWRITE()                                                                                         \
  {                                                                                                          \
    *(uint4*)ATT_KDST(0) = rk0; *(uint4*)ATT_KDST(1) = rk1; *(uint4*)ATT_KDST(2) = rk2;                      \
    *(uint4*)ATT_KDST(3) = rk3; *(uint4*)ATT_KDST(4) = rk4; *(uint4*)ATT_KDST(5) = rk5;                      \
    *(uint4*)ATT_VDST(0) = rv0; *(uint4*)ATT_VDST(1) = rv1; *(uint4*)ATT_VDST(2) = rv2; *(uint4*)ATT_VDST(3) = rv3; \
  }
  __syncthreads();
  ATT_GLOAD(0)
  ATT_SWRITE()
  __syncthreads();
  for (int kt = 0; kt < nk; kt += 64) {
    const bool more = (kt + 64) < nk;
    if (more) ATT_GLOAD(kt + 64)
    f32x16 s0, s1;
#pragma unroll
    for (int r = 0; r < 16; ++r) { s0[r] = 0.f; s1[r] = 0.f; }
    const char* kp = Ks + l31 * ATT_KROW + lh * 16;
#pragma unroll
    for (int ks = 0; ks < 12; ++ks) {
      bf16x8 a0 = *(const bf16x8*)(kp + ks * 32);
      bf16x8 a1 = *(const bf16x8*)(kp + 32 * ATT_KROW + ks * 32);
      s0 = MFMA16(a0, qf[ks], s0);
      s1 = MFMA16(a1, qf[ks], s1);
    }
    float tmax = fmaxf(s0[0], s1[0]);
#pragma unroll
    for (int r = 1; r < 16; ++r) tmax = fmaxf(tmax, fmaxf(s0[r], s1[r]));
    tmax = fmaxf(tmax, __shfl_xor(tmax, 32));
    const float mn = fmaxf(m, tmax);
    const float alpha = __builtin_amdgcn_exp2f(m - mn);
    float rs = 0.f;
#pragma unroll
    for (int r = 0; r < 16; ++r) { s0[r] = __builtin_amdgcn_exp2f(s0[r] - mn); s1[r] = __builtin_amdgcn_exp2f(s1[r] - mn); rs += s0[r] + s1[r]; }
    rs += __shfl_xor(rs, 32);
    l = l * alpha + rs;
    m = mn;
    if (__any(alpha != 1.f)) {
#pragma unroll
      for (int d = 0; d < 4; ++d)
#pragma unroll
        for (int r = 0; r < 16; ++r) o[d][r] *= alpha;
    }
    bf16x8 pf[4];
    {
      uint4 t;
      t.x = pack_bf16(s0[0], s0[1]); t.y = pack_bf16(s0[2], s0[3]); t.z = pack_bf16(s0[4], s0[5]); t.w = pack_bf16(s0[6], s0[7]);
      pf[0] = __builtin_bit_cast(bf16x8, t);
      t.x = pack_bf16(s0[8], s0[9]); t.y = pack_bf16(s0[10], s0[11]); t.z = pack_bf16(s0[12], s0[13]); t.w = pack_bf16(s0[14], s0[15]);
      pf[1] = __builtin_bit_cast(bf16x8, t);
      t.x = pack_bf16(s1[0], s1[1]); t.y = pack_bf16(s1[2], s1[3]); t.z = pack_bf16(s1[4], s1[5]); t.w = pack_bf16(s1[6], s1[7]);
      pf[2] = __builtin_bit_cast(bf16x8, t);
      t.x = pack_bf16(s1[8], s1[9]); t.y = pack_bf16(s1[10], s1[11]); t.z = pack_bf16(s1[12], s1[13]); t.w = pack_bf16(s1[14], s1[15]);
      pf[3] = __builtin_bit_cast(bf16x8, t);
    }
    const char* vp = Vs + l31 * ATT_VROW + lh * 16;
#pragma unroll
    for (int g16 = 0; g16 < 4; ++g16) {
#pragma unroll
      for (int d = 0; d < 4; ++d) {
        bf16x8 a = *(const bf16x8*)(vp + d * 32 * ATT_VROW + g16 * 32);
        o[d] = MFMA16(a, pf[g16], o[d]);
      }
    }
    __syncthreads();
    if (more) ATT_SWRITE()
    __syncthreads();
  }
  const float inv = 1.f / l;
  float* tb = (float*)smem + wid * (32 * 129);
#pragma unroll
  for (int d = 0; d < 4; ++d)
#pragma unroll
    for (int r = 0; r < 16; ++r) tb[l31 * 129 + d * 32 + (r & 3) + 8 * (r >> 2) + 4 * lh] = o[d][r] * inv;
  __syncthreads();
  for (int i = lane; i < 32 * 32; i += 64) {
    const int q = i >> 5, c4 = i & 31;
    const float* s = tb + q * 129 + c4 * 4;
    *(float4*)(Op + (size_t)(wid * 32 + q) * 512 + c4 * 4) = make_float4(s[0], s[1], s[2], s[3]);
  }
  __syncthreads();
}

__device__ __forceinline__ int chunk_row0(int b, int cid) { return cid < 4 ? TLAT + b * CL + cid * 64 : b * SL + (cid - 4) * 64; }
__device__ __forceinline__ int step_of(int cid, int dir) { return dir == 0 ? cid : (cid < 4 ? 3 - cid : 71 - cid); }
__device__ __forceinline__ int cid_of(int s, int dir) { return dir == 0 ? s : (s < 4 ? 3 - s : 71 - s); }
#define MFMA32(a, b, c) __builtin_amdgcn_mfma_f32_32x32x2f32(a, b, c, 0, 0, 0)
#define ROW16(r, lh) (((r) & 3) + 8 * ((r) >> 2) + 4 * (lh))
__device__ __forceinline__ float wave_incl_scan(float v, int lane) {
#pragma unroll
  for (int o = 1; o < 64; o <<= 1) { float t = __shfl_up(v, o); if (lane >= o) v += t; }
  return v;
}

#define SSD_R256 272
#define SSD_R128 144
__device__ __forceinline__ void ssd_local_item(const P& p, int layer, int item, char* smem) {
  const int h = item & 7, cid = (item >> 3) % NSTEP, b = item / (8 * NSTEP);
  char* sBT = smem;
  char* sxf = sBT + 128 * SSD_R128;
  char* sxb = sxf + 64 * SSD_R128;
  float* swf = (float*)(sxb + 64 * SSD_R128);
  float* swb = swf + 64;
  int tid_ = threadIdx.x; asm volatile("" : "+v"(tid_));
  const int tid = tid_, lane = tid & 63, wid = tid >> 6, l31 = lane & 31, lh = lane >> 5;
  const int row0 = chunk_row0(b, cid), g = h >> 2;
  __syncthreads();
  if (wid < 2) {
    const int dir = wid;
    const float A = -__expf(p.a_log[layer * 16 + dir * 8 + h]);
    const int q = dir ? 63 - lane : lane;
    const float dt = p.ssd_dt()[(size_t)(row0 + q) * 16 + dir * 8 + h];
    const float ac = wave_incl_scan(dt * A, lane);
    const float tot = __shfl(ac, 63);
    (dir ? swb : swf)[q] = __expf(tot - ac) * dt;
    if (lane == 0) p.ssd_atot()[((b * 2 + dir) * 8 + h) * NSTEP + step_of(cid, dir)] = tot;
  }
#pragma unroll
  for (int u = 0; u < 8; ++u) {
    const int i = tid + 256 * u, q = i >> 5, c4 = i & 31;
    const float4 v = *(const float4*)(p.ssd_B() + (size_t)(row0 + q) * 256 + g * 128 + c4 * 4);
    *(bfraw*)(sBT + (c4 * 4 + 0) * SSD_R128 + q * 2) = to_bf16(v.x);
    *(bfraw*)(sBT + (c4 * 4 + 1) * SSD_R128 + q * 2) = to_bf16(v.y);
    *(bfraw*)(sBT + (c4 * 4 + 2) * SSD_R128 + q * 2) = to_bf16(v.z);
    *(bfraw*)(sBT + (c4 * 4 + 3) * SSD_R128 + q * 2) = to_bf16(v.w);
  }
  __syncthreads();
#pragma unroll
  for (int u = 0; u < 4; ++u) {
    const int i = tid + 256 * u, q = i >> 4, c4 = i & 15;
    const float4 v = *(const float4*)(p.ssd_xs() + (size_t)(row0 + q) * 512 + h * 64 + c4 * 4);
    const float wf = swf[q], wb = swb[q];
    *(bfraw*)(sxf + (c4 * 4 + 0) * SSD_R128 + q * 2) = to_bf16(v.x * wf); *(bfraw*)(sxb + (c4 * 4 + 0) * SSD_R128 + q * 2) = to_bf16(v.x * wb);
    *(bfraw*)(sxf + (c4 * 4 + 1) * SSD_R128 + q * 2) = to_bf16(v.y * wf); *(bfraw*)(sxb + (c4 * 4 + 1) * SSD_R128 + q * 2) = to_bf16(v.y * wb);
    *(bfraw*)(sxf + (c4 * 4 + 2) * SSD_R128 + q * 2) = to_bf16(v.z * wf); *(bfraw*)(sxb + (c4 * 4 + 2) * SSD_R128 + q * 2) = to_bf16(v.z * wb);
    *(bfraw*)(sxf + (c4 * 4 + 3) * SSD_R128 + q * 2) = to_bf16(v.w * wf); *(bfraw*)(sxb + (c4 * 4 + 3) * SSD_R128 + q * 2) = to_bf16(v.w * wb);
  }
  __syncthreads();
  f32x16 acc[2][2];
#pragma unroll
  for (int d = 0; d < 2; ++d)
#pragma unroll
    for (int t = 0; t < 2; ++t)
#pragma unroll
      for (int r = 0; r < 16; ++r) acc[d][t][r] = 0.f;
  const int pi = wid & 1, jj = wid >> 1;
  {
    const char* af = sxf + (pi * 32 + l31) * SSD_R128 + lh * 16;
    const char* ab = sxb + (pi * 32 + l31) * SSD_R128 + lh * 16;
    const char* bp = sBT + ((2 * jj) * 32 + l31) * SSD_R128 + lh * 16;
#pragma unroll
    for (int ks = 0; ks < 4; ++ks) {
      const bf16x8 a0 = *(const bf16x8*)(af + ks * 32), a1 = *(const bf16x8*)(ab + ks * 32);
      const bf16x8 b0 = *(const bf16x8*)(bp + ks * 32), b1 = *(const bf16x8*)(bp + 32 * SSD_R128 + ks * 32);
      acc[0][0] = MFMA16(a0, b0, acc[0][0]); acc[0][1] = MFMA16(a0, b1, acc[0][1]);
      acc[1][0] = MFMA16(a1, b0, acc[1][0]); acc[1][1] = MFMA16(a1, b1, acc[1][1]);
    }
  }
#pragma unroll
  for (int d = 0; d < 2; ++d) {
    bfraw* dst = p.ssd_st() + ((size_t)((b * 2 + d) * 8 + h) * NSTEP + step_of(cid, d)) * 8192;
#pragma unroll
    for (int t = 0; t < 2; ++t)
#pragma unroll
      for (int r = 0; r < 16; ++r) dst[(pi * 32 + ROW16(r, lh)) * 128 + (2 * jj + t) * 32 + l31] = to_bf16(acc[d][t][r]);
  }
}

__device__ __forceinline__ void ssd_out_item(const P& p, int layer, int item, char* smem) {
  const int h = item & 7, cid = (item >> 3) % NSTEP, b = item / (8 * NSTEP);
  char* sC = smem;
  char* sB = sC + 64 * SSD_R256;
  char* sxT = sB + 64 * SSD_R256;
  char* sP = sxT + 64 * SSD_R128;
  float* saf = (float*)(sP + 64 * SSD_R128);
  float* sab = saf + 64;
  float* sdf = sab + 64;
  float* sdb = sdf + 64;
  int tid_ = threadIdx.x; asm volatile("" : "+v"(tid_));
  const int tid = tid_, lane = tid & 63, wid = tid >> 6, l31 = lane & 31, lh = lane >> 5;
  const int row0 = chunk_row0(b, cid), g = h >> 2;
  const bfraw* hf = p.ssd_st() + ((size_t)((b * 2 + 0) * 8 + h) * NSTEP + step_of(cid, 0)) * 8192;
  const bfraw* hb = p.ssd_st() + ((size_t)((b * 2 + 1) * 8 + h) * NSTEP + step_of(cid, 1)) * 8192;
  u32x4g hreg[4];
#pragma unroll
  for (int u = 0; u < 4; ++u) { const int i = tid + 256 * u; hreg[u] = *(const u32x4g*)(hf + (i >> 4) * 128 + (i & 15) * 8); }
  __syncthreads();
#pragma unroll
  for (int u = 0; u < 4; ++u) {
    const int i = tid + 256 * u, q = i >> 4, c8 = i & 15;
    const float* cs = p.ssd_C() + (size_t)(row0 + q) * 256 + g * 128 + c8 * 8;
    const float* bs = p.ssd_B() + (size_t)(row0 + q) * 256 + g * 128 + c8 * 8;
    const float4 c0 = *(const float4*)cs, c1 = *(const float4*)(cs + 4), b0 = *(const float4*)bs, b1 = *(const float4*)(bs + 4);
    uint4 t;
    t.x = pack_bf16(c0.x, c0.y); t.y = pack_bf16(c0.z, c0.w); t.z = pack_bf16(c1.x, c1.y); t.w = pack_bf16(c1.z, c1.w);
    *(uint4*)(sC + q * SSD_R256 + c8 * 16) = t;
    t.x = pack_bf16(b0.x, b0.y); t.y = pack_bf16(b0.z, b0.w); t.z = pack_bf16(b1.x, b1.y); t.w = pack_bf16(b1.z, b1.w);
    *(uint4*)(sB + q * SSD_R256 + c8 * 16) = t;
  }
#pragma unroll
  for (int u = 0; u < 4; ++u) {
    const int i = tid + 256 * u, j = i >> 4, c4 = i & 15;
    const float4 xv = *(const float4*)(p.ssd_xs() + (size_t)(row0 + j) * 512 + h * 64 + c4 * 4);
    *(bfraw*)(sxT + (c4 * 4 + 0) * SSD_R128 + j * 2) = to_bf16(xv.x);
    *(bfraw*)(sxT + (c4 * 4 + 1) * SSD_R128 + j * 2) = to_bf16(xv.y);
    *(bfraw*)(sxT + (c4 * 4 + 2) * SSD_R128 + j * 2) = to_bf16(xv.z);
    *(bfraw*)(sxT + (c4 * 4 + 3) * SSD_R128 + j * 2) = to_bf16(xv.w);
  }
  if (wid < 2) {
    const int dir = wid;
    const float A = -__expf(p.a_log[layer * 16 + dir * 8 + h]);
    const int q = dir ? 63 - lane : lane;
    const float dt = p.ssd_dt()[(size_t)(row0 + q) * 16 + dir * 8 + h];
    const float ac = wave_incl_scan(dt * A, lane);
    (dir ? sab : saf)[q] = ac;
    (dir ? sdb : sdf)[q] = dt;
  }
  __syncthreads();
  const int it = wid >> 1, jt = wid & 1;
  {
    f32x16 sa;
#pragma unroll
    for (int r = 0; r < 16; ++r) sa[r] = 0.f;
    const char* ap = sC + (it * 32 + l31) * SSD_R256 + lh * 16;
    const char* bp = sB + (jt * 32 + l31) * SSD_R256 + lh * 16;
#pragma unroll
    for (int ks = 0; ks < 8; ++ks) sa = MFMA16(*(const bf16x8*)(ap + ks * 32), *(const bf16x8*)(bp + ks * 32), sa);
    const int j = jt * 32 + l31;
    const float afj = saf[j], abj = sab[j], dfj = sdf[j], dbj = sdb[j];
#pragma unroll
    for (int r = 0; r < 16; ++r) {
      const int i = it * 32 + ROW16(r, lh);
      float wgt = 0.f;
      if (j <= i) wgt += __expf(saf[i] - afj) * dfj;
      if (j >= i) wgt += __expf(sab[i] - abj) * dbj;
      *(bfraw*)(sP + i * SSD_R128 + j * 2) = to_bf16(sa[r] * wgt);
    }
  }
  __syncthreads();
#pragma unroll
  for (int u = 0; u < 4; ++u) { const int i = tid + 256 * u; *(u32x4g*)(sB + (i >> 4) * SSD_R256 + (i & 15) * 16) = hreg[u]; }
#pragma unroll
  for (int u = 0; u < 4; ++u) { const int i = tid + 256 * u; hreg[u] = *(const u32x4g*)(hb + (i >> 4) * 128 + (i & 15) * 8); }
  const int pt = wid & 1;
  f32x16 ya, gf, gb;
#pragma unroll
  for (int r = 0; r < 16; ++r) { ya[r] = 0.f; gf[r] = 0.f; gb[r] = 0.f; }
  {
    const char* ap = sP + (it * 32 + l31) * SSD_R128 + lh * 16;
    const char* bp = sxT + (pt * 32 + l31) * SSD_R128 + lh * 16;
#pragma unroll
    for (int ks = 0; ks < 4; ++ks) ya = MFMA16(*(const bf16x8*)(ap + ks * 32), *(const bf16x8*)(bp + ks * 32), ya);
  }
  __syncthreads();
  {
    const char* ap = sC + (it * 32 + l31) * SSD_R256 + lh * 16;
    const char* bp = sB + (pt * 32 + l31) * SSD_R256 + lh * 16;
#pragma unroll
    for (int ks = 0; ks < 8; ++ks) gf = MFMA16(*(const bf16x8*)(ap + ks * 32), *(const bf16x8*)(bp + ks * 32), gf);
  }
  __syncthreads();
#pragma unroll
  for (int u = 0; u < 4; ++u) { const int i = tid + 256 * u; *(u32x4g*)(sB + (i >> 4) * SSD_R256 + (i & 15) * 16) = hreg[u]; }
  __syncthreads();
  {
    const char* ap = sC + (it * 32 + l31) * SSD_R256 + lh * 16;
    const char* bp = sB + (pt * 32 + l31) * SSD_R256 + lh * 16;
#pragma unroll
    for (int ks = 0; ks < 8; ++ks) gb = MFMA16(*(const bf16x8*)(ap + ks * 32), *(const bf16x8*)(bp + ks * 32), gb);
  }
#pragma unroll
  for (int r = 0; r < 16; ++r) {
    const int i = it * 32 + ROW16(r, lh);
    p.ssd_y()[(size_t)(row0 + i) * 512 + h * 64 + pt * 32 + l31] = ya[r] + __expf(saf[i]) * gf[r] + __expf(sab[i]) * gb[r];
  }
}

__device__ __forceinline__ void ml_gates(const P& p, int layer, int row0, int h, int dir, int lane, float& bcum, float& li, float& tot) {
  const int j = dir ? 63 - lane : lane;
  const float* z = p.Z() + (size_t)(row0 + j) * NIN + ZC_MG + dir * 8;
  li = z[h] + p.gate_b[layer * 16 + dir * 8 + h];
  const float gf = z[4 + h] + p.gate_b[layer * 16 + dir * 8 + 4 + h];
  const float lf = gf >= 0.f ? -log1pf(expf(-gf)) : gf - log1pf(expf(gf));
  bcum = wave_incl_scan(lf, lane);
  tot = __shfl(bcum, 63);
}
__device__ __forceinline__ void ml_local_item(const P& p, int layer, int item, char* smem) {
  const int h = item & 3, cid = (item >> 2) % NSTEP, b = item / (4 * NSTEP);
  char* svf = smem;
  char* svb = svf + 128 * SSD_R128;
  char* skT = svb + 128 * SSD_R128;
  float* swf = (float*)(skT + 64 * SSD_R128);
  float* swb = swf + 64;
  int tid_ = threadIdx.x; asm volatile("" : "+v"(tid_));
  const int tid = tid_, lane = tid & 63, wid = tid >> 6, l31 = lane & 31, lh = lane >> 5;
  const int row0 = chunk_row0(b, cid);
  __syncthreads();
  if (wid < 2) {
    const int dir = wid;
    float bc, li, tot;
    ml_gates(p, layer, row0, h, dir, lane, bc, li, tot);
    const int j = dir ? 63 - lane : lane;
    (dir ? swb : swf)[j] = __expf(tot - bc + li);
    if (lane == 0) p.ml_gtot()[((b * 2 + dir) * 4 + h) * NSTEP + step_of(cid, dir)] = tot;
  }
#pragma unroll
  for (int u = 0; u < 4; ++u) {
    const int i = tid + 256 * u, j = i >> 4, c4 = i & 15;
    const float4 v = *(const float4*)(p.Z() + (size_t)(row0 + j) * NIN + ZC_MK + h * 64 + c4 * 4);
    *(bfraw*)(skT + (c4 * 4 + 0) * SSD_R128 + j * 2) = to_bf16(v.x);
    *(bfraw*)(skT + (c4 * 4 + 1) * SSD_R128 + j * 2) = to_bf16(v.y);
    *(bfraw*)(skT + (c4 * 4 + 2) * SSD_R128 + j * 2) = to_bf16(v.z);
    *(bfraw*)(skT + (c4 * 4 + 3) * SSD_R128 + j * 2) = to_bf16(v.w);
  }
  __syncthreads();
#pragma unroll
  for (int u = 0; u < 8; ++u) {
    const int i = tid + 256 * u, j = i >> 5, c4 = i & 31;
    const float4 v = *(const float4*)(p.Z() + (size_t)(row0 + j) * NIN + ZC_MV + h * 128 + c4 * 4);
    const float wf = swf[j], wb = swb[j];
    *(bfraw*)(svf + (c4 * 4 + 0) * SSD_R128 + j * 2) = to_bf16(v.x * wf); *(bfraw*)(svb + (c4 * 4 + 0) * SSD_R128 + j * 2) = to_bf16(v.x * wb);
    *(bfraw*)(svf + (c4 * 4 + 1) * SSD_R128 + j * 2) = to_bf16(v.y * wf); *(bfraw*)(svb + (c4 * 4 + 1) * SSD_R128 + j * 2) = to_bf16(v.y * wb);
    *(bfraw*)(svf + (c4 * 4 + 2) * SSD_R128 + j * 2) = to_bf16(v.z * wf); *(bfraw*)(svb + (c4 * 4 + 2) * SSD_R128 + j * 2) = to_bf16(v.z * wb);
    *(bfraw*)(svf + (c4 * 4 + 3) * SSD_R128 + j * 2) = to_bf16(v.w * wf); *(bfraw*)(svb + (c4 * 4 + 3) * SSD_R128 + j * 2) = to_bf16(v.w * wb);
  }
  __syncthreads();
  f32x16 acc[2][2];
#pragma unroll
  for (int d = 0; d < 2; ++d)
#pragma unroll
    for (int t = 0; t < 2; ++t)
#pragma unroll
      for (int r = 0; r < 16; ++r) acc[d][t][r] = 0.f;
  const int vt = wid;
  {
    const char* af = svf + (vt * 32 + l31) * SSD_R128 + lh * 16;
    const char* ab = svb + (vt * 32 + l31) * SSD_R128 + lh * 16;
    const char* bp = skT + l31 * SSD_R128 + lh * 16;
#pragma unroll
    for (int ks = 0; ks < 4; ++ks) {
      const bf16x8 a0 = *(const bf16x8*)(af + ks * 32), a1 = *(const bf16x8*)(ab + ks * 32);
      const bf16x8 b0 = *(const bf16x8*)(bp + ks * 32), b1 = *(const bf16x8*)(bp + 32 * SSD_R128 + ks * 32);
      acc[0][0] = MFMA16(a0, b0, acc[0][0]); acc[0][1] = MFMA16(a0, b1, acc[0][1]);
      acc[1][0] = MFMA16(a1, b0, acc[1][0]); acc[1][1] = MFMA16(a1, b1, acc[1][1]);
    }
  }
#pragma unroll
  for (int d = 0; d < 2; ++d) {
    bfraw* dst = p.ml_st() + ((size_t)((b * 2 + d) * 4 + h) * NSTEP + step_of(cid, d)) * 8192;
#pragma unroll
    for (int t = 0; t < 2; ++t)
#pragma unroll
      for (int r = 0; r < 16; ++r) dst[(vt * 32 + ROW16(r, lh)) * 64 + t * 32 + l31] = to_bf16(acc[d][t][r]);
  }
  if (tid < 128) {
    const int d = tid >> 6, kk = tid & 63;
    const float* w = d ? swb : swf;
    const char* kr = skT + kk * SSD_R128;
    float sacc = 0.f;
    for (int j = 0; j < 64; ++j) sacc += w[j] * from_bf16(*(const bfraw*)(kr + j * 2));
    p.ml_nst()[((size_t)((b * 2 + d) * 4 + h) * NSTEP + step_of(cid, d)) * 64 + kk] = sacc;
  }
}

__device__ __forceinline__ void ml_out_item(const P& p, int layer, int item, char* smem) {
  const int h = item & 3, cid = (item >> 2) % NSTEP, b = item / (4 * NSTEP);
  char* sq = smem;
  char* sk = sq + 64 * SSD_R128;
  char* svT = sk + 64 * SSD_R128;
  char* sPf = svT + 128 * SSD_R128;
  char* sPb = sPf + 64 * SSD_R128;
  char* sCs = sPb + 64 * SSD_R128;
  float* sbf = (float*)(sCs + 128 * SSD_R128);
  float* sbb = sbf + 64;
  float* slf = sbb + 64;
  float* slb = slf + 64;
  float* sdenf = slb + 64;
  float* sdenb = sdenf + 64;
  float* snf = sdenb + 64;
  float* snb = snf + 64;
  int tid_ = threadIdx.x; asm volatile("" : "+v"(tid_));
  const int tid = tid_, lane = tid & 63, wid = tid >> 6, l31 = lane & 31, lh = lane >> 5;
  const int row0 = chunk_row0(b, cid);
  const size_t slotf = ((size_t)((b * 2 + 0) * 4 + h) * NSTEP + step_of(cid, 0));
  const size_t slotb = ((size_t)((b * 2 + 1) * 4 + h) * NSTEP + step_of(cid, 1));
  const bfraw* csf = p.ml_st() + slotf * 8192;
  const bfraw* csb = p.ml_st() + slotb * 8192;
  u32x4g creg[4];
#pragma unroll
  for (int u = 0; u < 4; ++u) { const int i = tid + 256 * u; creg[u] = *(const u32x4g*)(csf + (i >> 3) * 64 + (i & 7) * 8); }
  __syncthreads();
#pragma unroll
  for (int u = 0; u < 4; ++u) {
    const int i = tid + 256 * u, j = i >> 4, c4 = i & 15;
    const float4 kv = *(const float4*)(p.Z() + (size_t)(row0 + j) * NIN + ZC_MK + h * 64 + c4 * 4);
    const float4 qv = *(const float4*)(p.Z() + (size_t)(row0 + j) * NIN + ZC_MQ + h * 64 + c4 * 4);
    uint2 t;
    t.x = pack_bf16(kv.x, kv.y); t.y = pack_bf16(kv.z, kv.w);
    *(uint2*)(sk + j * SSD_R128 + c4 * 8) = t;
    t.x = pack_bf16(qv.x * 0.125f, qv.y * 0.125f); t.y = pack_bf16(qv.z * 0.125f, qv.w * 0.125f);
    *(uint2*)(sq + j * SSD_R128 + c4 * 8) = t;
  }
#pragma unroll
  for (int u = 0; u < 8; ++u) {
    const int i = tid + 256 * u, j = i >> 5, c4 = i & 31;
    const float4 vv = *(const float4*)(p.Z() + (size_t)(row0 + j) * NIN + ZC_MV + h * 128 + c4 * 4);
    *(bfraw*)(svT + (c4 * 4 + 0) * SSD_R128 + j * 2) = to_bf16(vv.x);
    *(bfraw*)(svT + (c4 * 4 + 1) * SSD_R128 + j * 2) = to_bf16(vv.y);
    *(bfraw*)(svT + (c4 * 4 + 2) * SSD_R128 + j * 2) = to_bf16(vv.z);
    *(bfraw*)(svT + (c4 * 4 + 3) * SSD_R128 + j * 2) = to_bf16(vv.w);
  }
#pragma unroll
  for (int u = 0; u < 4; ++u) { const int i = tid + 256 * u; *(u32x4g*)(sCs + (i >> 3) * SSD_R128 + (i & 7) * 16) = creg[u]; }
#pragma unroll
  for (int u = 0; u < 4; ++u) { const int i = tid + 256 * u; creg[u] = *(const u32x4g*)(csb + (i >> 3) * 64 + (i & 7) * 8); }
  if (wid < 2) {
    const int dir = wid;
    float bc, li, tot;
    ml_gates(p, layer, row0, h, dir, lane, bc, li, tot);
    const int j = dir ? 63 - lane : lane;
    (dir ? sbb : sbf)[j] = bc;
    (dir ? slb : slf)[j] = li;
    (dir ? snb : snf)[lane] = p.ml_nst()[(dir ? slotb : slotf) * 64 + lane];
  }
  __syncthreads();
  const int it = wid >> 1, jt = wid & 1;
  {
    f32x16 sa;
#pragma unroll
    for (int r = 0; r < 16; ++r) sa[r] = 0.f;
    const char* ap = sq + (it * 32 + l31) * SSD_R128 + lh * 16;
    const char* bp = sk + (jt * 32 + l31) * SSD_R128 + lh * 16;
#pragma unroll
    for (int ks = 0; ks < 4; ++ks) sa = MFMA16(*(const bf16x8*)(ap + ks * 32), *(const bf16x8*)(bp + ks * 32), sa);
    const int j = jt * 32 + l31;
    const float bfj = sbf[j], bbj = sbb[j], lfj = slf[j], lbj = slb[j];
#pragma unroll
    for (int r = 0; r < 16; ++r) {
      const int i = it * 32 + ROW16(r, lh);
      *(bfraw*)(sPf + i * SSD_R128 + j * 2) = to_bf16(j <= i ? sa[r] * __expf(sbf[i] - bfj + lfj) : 0.f);
      *(bfraw*)(sPb + i * SSD_R128 + j * 2) = to_bf16(j >= i ? sa[r] * __expf(sbb[i] - bbj + lbj) : 0.f);
    }
  }
  __syncthreads();
  if (tid < 128) {
    const int d = tid >> 6, i = tid & 63;
    const char* Pm = (d ? sPb : sPf) + i * SSD_R128;
    const char* qr = sq + i * SSD_R128;
    const float* ns = d ? snb : snf;
    float rs = 0.f, qn = 0.f;
    for (int j = 0; j < 64; ++j) { rs += from_bf16(*(const bfraw*)(Pm + j * 2)); qn += from_bf16(*(const bfraw*)(qr + j * 2)) * ns[j]; }
    (d ? sdenb : sdenf)[i] = rs + __expf((d ? sbb : sbf)[i]) * qn;
  }
  const int v0 = 2 * (wid & 1);
  f32x16 nf[2], nb[2], gf[2], gb[2];
#pragma unroll
  for (int t = 0; t < 2; ++t)
#pragma unroll
    for (int r = 0; r < 16; ++r) { nf[t][r] = 0.f; nb[t][r] = 0.f; gf[t][r] = 0.f; gb[t][r] = 0.f; }
  {
    const char* apf = sPf + (it * 32 + l31) * SSD_R128 + lh * 16;
    const char* apb = sPb + (it * 32 + l31) * SSD_R128 + lh * 16;
    const char* aq = sq + (it * 32 + l31) * SSD_R128 + lh * 16;
    const char* bv = svT + (v0 * 32 + l31) * SSD_R128 + lh * 16;
    const char* bc = sCs + (v0 * 32 + l31) * SSD_R128 + lh * 16;
#pragma unroll
    for (int ks = 0; ks < 4; ++ks) {
      const bf16x8 af = *(const bf16x8*)(apf + ks * 32), ab = *(const bf16x8*)(apb + ks * 32), qa = *(const bf16x8*)(aq + ks * 32);
      const bf16x8 b0 = *(const bf16x8*)(bv + ks * 32), b1 = *(const bf16x8*)(bv + 32 * SSD_R128 + ks * 32);
      const bf16x8 c0 = *(const bf16x8*)(bc + ks * 32), c1 = *(const bf16x8*)(bc + 32 * SSD_R128 + ks * 32);
      nf[0] = MFMA16(af, b0, nf[0]); nf[1] = MFMA16(af, b1, nf[1]);
      nb[0] = MFMA16(ab, b0, nb[0]); nb[1] = MFMA16(ab, b1, nb[1]);
      gf[0] = MFMA16(qa, c0, gf[0]); gf[1] = MFMA16(qa, c1, gf[1]);
    }
  }
  __syncthreads();
#pragma unroll
  for (int u = 0; u < 4; ++u) { const int i = tid + 256 * u; *(u32x4g*)(sCs + (i >> 3) * SSD_R128 + (i & 7) * 16) = creg[u]; }
  __syncthreads();
  {
    const char* aq = sq + (it * 32 + l31) * SSD_R128 + lh * 16;
    const char* bc = sCs + (v0 * 32 + l31) * SSD_R128 + lh * 16;
#pragma unroll
    for (int ks = 0; ks < 4; ++ks) {
      const bf16x8 qa = *(const bf16x8*)(aq + ks * 32);
      gb[0] = MFMA16(qa, *(const bf16x8*)(bc + ks * 32), gb[0]);
      gb[1] = MFMA16(qa, *(const bf16x8*)(bc + 32 * SSD_R128 + ks * 32), gb[1]);
    }
  }
#pragma unroll
  for (int r = 0; r < 16; ++r) {
    const int i = it * 32 + ROW16(r, lh);
    const float ef = __expf(sbf[i]), eb = __expf(sbb[i]);
    const float idf = 1.f / fmaxf(fabsf(sdenf[i]), 1.f), idb = 1.f / fmaxf(fabsf(sdenb[i]), 1.f);
#pragma unroll
    for (int t = 0; t < 2; ++t)
      p.ml_h()[(size_t)(row0 + i) * 512 + h * 128 + (v0 + t) * 32 + l31] = (nf[t][r] + ef * gf[t][r]) * idf + (nb[t][r] + eb * gb[t][r]) * idb;
  }
}

__device__ __forceinline__ float gelu_tanh(float x) {
  const float k0 = 0.7978845608028654f;
  return 0.5f * x * (1.f + tanhf(k0 * (x + 0.044715f * x * x * x)));
}
__device__ __forceinline__ void s5_drive(const P& p, int dg, int row0, int dir, int g, int lane, float (&sre)[64], float (&sim)[64]) {
  const int l31 = lane & 31, lh = lane >> 5;
  bf16x8 ua[2];
#pragma unroll
  for (int tt = 0; tt < 2; ++tt) {
    const int tp = 32 * tt + l31;
    const int row = dir ? row0 + 63 - tp : row0 + tp;
    const float* zp = p.Z() + (size_t)row * NIN + ZC_U + g * 16 + 8 * lh;
    const float4 a = *(const float4*)zp, b = *(const float4*)(zp + 4);
    uint4 t; t.x = pack_bf16(a.x, a.y); t.y = pack_bf16(a.z, a.w); t.z = pack_bf16(b.x, b.y); t.w = pack_bf16(b.z, b.w);
    ua[tt] = __builtin_bit_cast(bf16x8, t);
  }
  bf16x8 bfr[4];
#pragma unroll
  for (int pt = 0; pt < 4; ++pt) bfr[pt] = *(const bf16x8*)(p.s5_bbh() + ((size_t)dg * 128 + 32 * pt + l31) * 16 + 8 * lh);
  f32x16 d[2][4];
#pragma unroll
  for (int tt = 0; tt < 2; ++tt)
#pragma unroll
    for (int pt = 0; pt < 4; ++pt) {
      f32x16 z;
#pragma unroll
      for (int r = 0; r < 16; ++r) z[r] = 0.f;
      d[tt][pt] = __builtin_amdgcn_mfma_f32_32x32x16_bf16(ua[tt], bfr[pt], z, 0, 0, 0);
    }
#pragma unroll
  for (int tt = 0; tt < 2; ++tt)
#pragma unroll
    for (int r = 0; r < 16; ++r) {
      const float myre = lh ? d[tt][1][r] : d[tt][0][r];
      const float myim = lh ? d[tt][3][r] : d[tt][2][r];
      const float gre = lh ? d[tt][0][r] : d[tt][1][r];
      const float gim = lh ? d[tt][2][r] : d[tt][3][r];
      const float ore = __shfl_xor(gre, 32), oim = __shfl_xor(gim, 32);
      const int tb = 32 * tt + 8 * (r >> 2) + (r & 3);
      sre[tb] = lh ? ore : myre; sre[tb + 4] = lh ? myre : ore;
      sim[tb] = lh ? oim : myim; sim[tb + 4] = lh ? myim : oim;
    }
}

__device__ __forceinline__ void s5_local_item(const P& p, int layer, int witem, char* smem) {
  int tid_ = threadIdx.x; asm volatile("" : "+v"(tid_));
  const int lane = tid_ & 63;
  const int g = witem & 31, st = (witem >> 5) % NSTEP, dir = (witem / (32 * NSTEP)) & 1, b = witem / (64 * NSTEP);
  const int cid = cid_of(st, dir), row0 = chunk_row0(b, cid);
  const int dg = (layer * 2 + dir) * 32 + g;
  float sre[64], sim[64];
  s5_drive(p, dg, row0, dir, g, lane, sre, sim);
  const float ar = p.s5_a()[(dg * 64 + lane) * 2], ai = p.s5_a()[(dg * 64 + lane) * 2 + 1];
  float xr = 0.f, xi = 0.f;
#pragma unroll
  for (int t = 0; t < 64; ++t) {
    const float nr = ar * xr - ai * xi + sre[t];
    const float ni = ar * xi + ai * xr + sim[t];
    xr = nr; xi = ni;
  }
  const size_t slot = ((size_t)((b * 2 + dir) * 32 + g) * NSTEP + st);
  p.s5_st()[(slot * 64 + lane) * 2] = xr; p.s5_st()[(slot * 64 + lane) * 2 + 1] = xi;
}

#define S5_XROW 272
__device__ __forceinline__ void s5_out_item(const P& p, int layer, int witem, char* smem) {
  int tid_ = threadIdx.x; asm volatile("" : "+v"(tid_));
  const int lane = tid_ & 63, wid = tid_ >> 6, l31 = lane & 31, lh = lane >> 5;
  char* sX = smem + wid * (64 * S5_XROW);
  const int g = witem & 31, cid = (witem >> 5) % NSTEP, b = witem / (32 * NSTEP);
  const int row0 = chunk_row0(b, cid);
  bf16x8 cfr[8];
#pragma unroll
  for (int ks = 0; ks < 8; ++ks) cfr[ks] = *(const bf16x8*)(p.s5_cmh() + ((size_t)(layer * 32 + g) * 32 + l31) * 128 + 16 * ks + 8 * lh);
  f32x16 yf[2], yb[2];
#pragma unroll 1
  for (int dir = 0; dir < 2; ++dir) {
    const int st = step_of(cid, dir);
    const int dg = (layer * 2 + dir) * 32 + g;
    const size_t slot = ((size_t)((b * 2 + dir) * 32 + g) * NSTEP + st);
    float sre[64], sim[64];
    s5_drive(p, dg, row0, dir, g, lane, sre, sim);
    const float ar = p.s5_a()[(dg * 64 + lane) * 2], ai = p.s5_a()[(dg * 64 + lane) * 2 + 1];
    float xr = p.s5_st()[(slot * 64 + lane) * 2], xi = p.s5_st()[(slot * 64 + lane) * 2 + 1];
#pragma unroll
    for (int t = 0; t < 64; ++t) {
      const float nr = ar * xr - ai * xi + sre[t];
      const float ni = ar * xi + ai * xr + sim[t];
      xr = nr; xi = ni;
      *(bfraw*)(sX + t * S5_XROW + lane * 2) = to_bf16(xr);
      *(bfraw*)(sX + t * S5_XROW + 128 + lane * 2) = to_bf16(xi);
    }
    f32x16 y0, y1;
#pragma unroll
    for (int r = 0; r < 16; ++r) { y0[r] = 0.f; y1[r] = 0.f; }
    const char* ap = sX + l31 * S5_XROW + lh * 16;
#pragma unroll
    for (int ks = 0; ks < 8; ++ks) {
      const bf16x8 a0 = *(const bf16x8*)(ap + ks * 32);
      const bf16x8 a1 = *(const bf16x8*)(ap + 32 * S5_XROW + ks * 32);
      y0 = __builtin_amdgcn_mfma_f32_32x32x16_bf16(a0, cfr[ks], y0, 0, 0, 0);
      y1 = __builtin_amdgcn_mfma_f32_32x32x16_bf16(a1, cfr[ks], y1, 0, 0, 0);
    }
    if (dir == 0) { yf[0] = y0; yf[1] = y1; } else { yb[0] = y0; yb[1] = y1; }
  }
  const float dsk = p.s5_d[layer * 512 + g * 16 + (l31 & 15)];
#pragma unroll
  for (int tt = 0; tt < 2; ++tt)
#pragma unroll
    for (int r = 0; r < 16; ++r) {
      const float ybv = __shfl_xor(yb[1 - tt][15 - r], 32);
      if (l31 < 16) {
        const int t = 32 * tt + ROW16(r, lh);
        const float u = p.Z()[(size_t)(row0 + t) * NIN + ZC_U + g * 16 + l31];
        const float gy = gelu_tanh(yf[tt][r] + ybv + dsk * u);
        const size_t o = (size_t)(row0 + t) * 512 + g * 16 + l31;
        p.ydpre()[o] = gy;
        p.ydpre_bf()[o] = to_bf16(gy);
      }
    }
}

#define N_SSD_CH (2 * NSTEP * 8)
#define N_ML_CH (2 * NSTEP * 4)
#define N_S5_BLK (2 * 2 * NSTEP * 32 / 4)
__device__ __forceinline__ void ph_mixA(const P& p, int layer, int bid, char* smem) {
  for (int w = bid; w < N_SSD_CH + N_ML_CH + N_S5_BLK; w += gridDim.x) {
    if (w < N_SSD_CH) ssd_local_item(p, layer, w, smem);
    else if (w < N_SSD_CH + N_ML_CH) ml_local_item(p, layer, w - N_SSD_CH, smem);
    else { __syncthreads(); s5_local_item(p, layer, (w - N_SSD_CH - N_ML_CH) * 4 + (threadIdx.x >> 6), smem); }
  }
}
#define N_ATT_LAT 256
#define N_ATT_CTX 16
__device__ __forceinline__ void ph_scan(const P& p, int layer, int bid, char* smem) {
  const int nitems = 256 + 128 + 4 + 32;
  const int tid = threadIdx.x;
  for (int w = bid; w < nitems; w += gridDim.x) {
    int it = w;
    if (it < 256) {
      const int idx = it * 256 + tid, seq = idx >> 11, off = idx & 2047;
      uint2* base = (uint2*)(p.ssd_st() + (size_t)seq * NSTEP * 8192) + off;
      const float* at = p.ssd_atot() + seq * NSTEP;
      float4 hh = make_float4(0.f, 0.f, 0.f, 0.f);
#pragma unroll 4
      for (int s2 = 0; s2 < NSTEP; ++s2) {
        const uint2 tb = base[(size_t)s2 * 2048];
        uint2 ob; ob.x = pack_bf16(hh.x, hh.y); ob.y = pack_bf16(hh.z, hh.w);
        base[(size_t)s2 * 2048] = ob;
        const float e = expf(at[s2]);
        hh.x = e * hh.x + __uint_as_float(tb.x << 16); hh.y = e * hh.y + __uint_as_float(tb.x & 0xffff0000u);
        hh.z = e * hh.z + __uint_as_float(tb.y << 16); hh.w = e * hh.w + __uint_as_float(tb.y & 0xffff0000u);
      }
      continue;
    }
    it -= 256;
    if (it < 128) {
      const int idx = it * 256 + tid, seq = idx >> 11, off = idx & 2047;
      uint2* base = (uint2*)(p.ml_st() + (size_t)seq * NSTEP * 8192) + off;
      const float* at = p.ml_gtot() + seq * NSTEP;
      float4 hh = make_float4(0.f, 0.f, 0.f, 0.f);
#pragma unroll 4
      for (int s2 = 0; s2 < NSTEP; ++s2) {
        const uint2 tb = base[(size_t)s2 * 2048];
        uint2 ob; ob.x = pack_bf16(hh.x, hh.y); ob.y = pack_bf16(hh.z, hh.w);
        base[(size_t)s2 * 2048] = ob;
        const float e = expf(at[s2]);
        hh.x = e * hh.x + __uint_as_float(tb.x << 16); hh.y = e * hh.y + __uint_as_float(tb.x & 0xffff0000u);
        hh.z = e * hh.z + __uint_as_float(tb.y << 16); hh.w = e * hh.w + __uint_as_float(tb.y & 0xffff0000u);
      }
      continue;
    }
    it -= 128;
    if (it < 4) {
      const int idx = it * 256 + tid, seq = idx >> 6, off = idx & 63;
      float* base = p.ml_nst() + (size_t)seq * NSTEP * 64 + off;
      const float* at = p.ml_gtot() + seq * NSTEP;
      float hh = 0.f;
      for (int s2 = 0; s2 < NSTEP; ++s2) {
        float t = base[s2 * 64]; base[s2 * 64] = hh;
        hh = expf(at[s2]) * hh + t;
      }
      continue;
    }
    it -= 4;
    {
      const int idx = it * 256 + tid, seq = idx >> 6, sp = idx & 63;
      const int g = seq & 31, dir = (seq >> 5) & 1;
      const int dg = (layer * 2 + dir) * 32 + g;
      float pr = p.s5_a()[(dg * 64 + sp) * 2], pi = p.s5_a()[(dg * 64 + sp) * 2 + 1];
#pragma unroll
      for (int q = 0; q < 6; ++q) { float nr = pr * pr - pi * pi, ni = 2.f * pr * pi; pr = nr; pi = ni; }
      float* base = p.s5_st() + ((size_t)seq * NSTEP * 64 + sp) * 2;
      float xr = 0.f, xi = 0.f;
      for (int s2 = 0; s2 < NSTEP; ++s2) {
        float tr = base[s2 * 128], ti = base[s2 * 128 + 1];
        base[s2 * 128] = xr; base[s2 * 128 + 1] = xi;
        float nr = pr * xr - pi * xi + tr, ni = pr * xi + pi * xr + ti;
        xr = nr; xi = ni;
      }
    }
  }
}
__device__ __forceinline__ void ph_attn(const P& p, int layer, int bid, char* smem) {
  const int natt = N_ATT_LAT + (layer == 0 ? N_ATT_CTX : 0);
  for (int w = bid; w < natt; w += gridDim.x) {
    int it = w;
    const bfraw *qp, *kp, *vp; float* op; int nk;
    if (it < N_ATT_LAT) {
      int qb = it & 31, hh = (it >> 5) & 3, b = it >> 7;
      qp = p.Q() + ((size_t)(b * 4 + hh) * SL + qb * 128) * 192; kp = p.K() + (size_t)(b * 4 + hh) * NKEY * 192;
      vp = p.V() + (size_t)(b * 4 + hh) * 128 * NKEY; nk = NKEY; op = p.O() + (size_t)(b * SL + qb * 128) * 512 + hh * 128;
    } else {
      it -= N_ATT_LAT;
      int qb = it & 1, hh = (it >> 1) & 3, b = it >> 3;
      qp = p.Qc() + ((size_t)(b * 4 + hh) * CL + qb * 128) * 192; kp = p.K() + ((size_t)(b * 4 + hh) * NKEY + SL) * 192;
      vp = p.V() + (size_t)(b * 4 + hh) * 128 * NKEY + SL; nk = CL; op = p.O() + (size_t)(TLAT + b * CL + qb * 128) * 512 + hh * 128;
    }
    attn_item(qp, kp, vp, nk, op, smem);
  }
}
__device__ __forceinline__ void ph_mixC(const P& p, int layer, int bid, char* smem) {
  for (int w = bid; w < N_SSD_CH + N_ML_CH + N_S5_BLK / 2; w += gridDim.x) {
    if (w < N_SSD_CH) ssd_out_item(p, layer, w, smem);
    else if (w < N_SSD_CH + N_ML_CH) ml_out_item(p, layer, w - N_SSD_CH, smem);
    else { __syncthreads(); s5_out_item(p, layer, (w - N_SSD_CH - N_ML_CH) * 4 + (threadIdx.x >> 6), smem); }
  }
}

__device__ __forceinline__ void ph_glu(const P& p, int layer, int bid, char* smem) {
  const float* yp = p.ydpre(); float* yg = p.ydg(); const float* gb = p.glu_b + layer * 512;
  auto epi = [=](int row, int col, float v) {
    float y = yp[(size_t)row * 512 + col];
    yg[(size_t)row * 512 + col] = y * sigmoidf_(v + gb[col]);
  };
  gemm_dense<4>(p.ydpre_bf(), 512, p.glu_w + (size_t)layer * 512 * 512, 512, TTOT, 512, 512, epi, bid, smem);
}

__device__ __forceinline__ void ph_final_mix(const P& p, int layer, int bid, char* smem) {
  const int tid = threadIdx.x, lane = tid & 63, wid = tid >> 6;
  const float* onw = p.out_norm_w + layer * 2048;
  for (int r = bid * 4 + wid; r < TTOT; r += gridDim.x * 4) {
    const float* z = p.Z() + (size_t)r * NIN;
    bfraw* Y = p.Y() + (size_t)r * LDH;
    const int c = lane * 8;
    f32x4v a0 = *(const f32x4v*)(p.O() + (size_t)r * 512 + c), a1 = *(const f32x4v*)(p.O() + (size_t)r * 512 + c + 4);
    f32x4v y0 = *(const f32x4v*)(p.ssd_y() + (size_t)r * 512 + c), y1 = *(const f32x4v*)(p.ssd_y() + (size_t)r * 512 + c + 4);
    f32x4v x0 = *(const f32x4v*)(p.ssd_xs() + (size_t)r * 512 + c), x1 = *(const f32x4v*)(p.ssd_xs() + (size_t)r * 512 + c + 4);
    f32x4v g0 = *(const f32x4v*)(z + ZC_BZ + c), g1 = *(const f32x4v*)(z + ZC_BZ + c + 4);
    f32x4v h0 = *(const f32x4v*)(p.ml_h() + (size_t)r * 512 + c), h1 = *(const f32x4v*)(p.ml_h() + (size_t)r * 512 + c + 4);
    f32x4v o0 = *(const f32x4v*)(z + ZC_MO + c), o1 = *(const f32x4v*)(z + ZC_MO + c + 4);
    f32x4v d0 = *(const f32x4v*)(p.ydg() + (size_t)r * 512 + c), d1 = *(const f32x4v*)(p.ydg() + (size_t)r * 512 + c + 4);
    const float dsk = p.ssd_d[layer * 8 + (c >> 6)];
    float sa = 0.f, sb = 0.f, sc = 0.f, sd = 0.f;
    float bv[8], av[8], cv[8], dv[8];
#pragma unroll
    for (int i = 0; i < 4; ++i) {
      av[i] = a0[i]; av[4 + i] = a1[i];
      bv[i] = (y0[i] + dsk * x0[i]) * siluf_(g0[i]); bv[4 + i] = (y1[i] + dsk * x1[i]) * siluf_(g1[i]);
      cv[i] = h0[i]; cv[4 + i] = h1[i];
      dv[i] = d0[i]; dv[4 + i] = d1[i];
    }
#pragma unroll
    for (int i = 0; i < 8; ++i) { sa += av[i] * av[i]; sb += bv[i] * bv[i]; sc += cv[i] * cv[i]; sd += dv[i] * dv[i]; }
    sa = wave_sum(sa); sb = wave_sum(sb); sd = wave_sum(sd);
    sc += __shfl_xor(sc, 1); sc += __shfl_xor(sc, 2); sc += __shfl_xor(sc, 4); sc += __shfl_xor(sc, 8);
    const float ra = rsqrtf(sa * (1.f / 512.f) + EPSV), rb = rsqrtf(sb * (1.f / 512.f) + EPSV);
    const float rc = rsqrtf(sc * (1.f / 128.f) + EPSV), rd = rsqrtf(sd * (1.f / 512.f) + EPSV);
    float ogv[8];
#pragma unroll
    for (int i = 0; i < 4; ++i) { ogv[i] = sigmoidf_(o0[i]); ogv[4 + i] = sigmoidf_(o1[i]); }
    uint4 ua, ub, uc, ud;
    const float* w = onw + c;
    ua.x = pack_bf16(av[0] * ra * w[0], av[1] * ra * w[1]); ua.y = pack_bf16(av[2] * ra * w[2], av[3] * ra * w[3]);
    ua.z = pack_bf16(av[4] * ra * w[4], av[5] * ra * w[5]); ua.w = pack_bf16(av[6] * ra * w[6], av[7] * ra * w[7]);
    w = onw + 512 + c;
    ub.x = pack_bf16(bv[0] * rb * w[0], bv[1] * rb * w[1]); ub.y = pack_bf16(bv[2] * rb * w[2], bv[3] * rb * w[3]);
    ub.z = pack_bf16(bv[4] * rb * w[4], bv[5] * rb * w[5]); ub.w = pack_bf16(bv[6] * rb * w[6], bv[7] * rb * w[7]);
    w = onw + 1024 + c;
    uc.x = pack_bf16(cv[0] * rc * ogv[0] * w[0], cv[1] * rc * ogv[1] * w[1]); uc.y = pack_bf16(cv[2] * rc * ogv[2] * w[2], cv[3] * rc * ogv[3] * w[3]);
    uc.z = pack_bf16(cv[4] * rc * ogv[4] * w[4], cv[5] * rc * ogv[5] * w[5]); uc.w = pack_bf16(cv[6] * rc * ogv[6] * w[6], cv[7] * rc * ogv[7] * w[7]);
    w = onw + 1536 + c;
    ud.x = pack_bf16(dv[0] * rd * w[0], dv[1] * rd * w[1]); ud.y = pack_bf16(dv[2] * rd * w[2], dv[3] * rd * w[3]);
    ud.z = pack_bf16(dv[4] * rd * w[4], dv[5] * rd * w[5]); ud.w = pack_bf16(dv[6] * rd * w[6], dv[7] * rd * w[7]);
    *(uint4*)(Y + c) = ua; *(uint4*)(Y + 512 + c) = ub; *(uint4*)(Y + 1024 + c) = uc; *(uint4*)(Y + 1536 + c) = ud;
  }
}

__device__ __forceinline__ void ph_wout(const P& p, int layer, int bid, char* smem) {
  const P pp = p;
  const int M = layer == 0 ? TTOT : TLAT;
  auto epi = [=](int row, int col, float v) {
    const int mi = row_modidx(row);
    const float g1 = pp.modv()[(layer * 3 + mi) * 12288 + 2 * 2048 + col];
    float xin;
    if (layer == 0) xin = row < TLAT ? pp.x[(size_t)row * 2048 + col] : pp.ctx[(size_t)(row - TLAT) * 2048 + col];
    else xin = pp.X()[(size_t)row * 2048 + col];
    pp.X()[(size_t)row * 2048 + col] = xin + g1 * v;
  };
  gemm_dense_hybrid(p.Y(), LDH, p.w_out + (size_t)layer * 2048 * 2048, 2048, M, 2048, 2048, epi, bid, smem);
}

__device__ __forceinline__ void ph_router(const P& p, int layer, int bid, char* smem) {
  float* sA = (float*)smem;
  float* sW = sA + 32 * 129;
  float* sNW = sW + 128 * 64;
  float* sSH = sNW + 2048;
  float* srs = sSH + 2048;
  float* sL = srs + 32;
  const int tid = threadIdx.x, lane = tid & 63, wid = tid >> 6, l31 = lane & 31, lh = lane >> 5;
  const int T = layer == 0 ? TTOT : TLAT;
  const float* nw = p.norm2_w + layer * 2048;
  const float* wg = p.w_group + (size_t)layer * 2048 * 4;
  const float* we = p.w_expert + (size_t)layer * 2048 * 32;
  __syncthreads();
  for (int i = tid; i < 128 * 28; i += 256) sW[(i / 28) * 64 + 36 + (i % 28)] = 0.f;
  const int ar = tid >> 3, aks = (tid & 7) * 16;
  const int wk = tid >> 1, whalf = tid & 1;
  for (int item = bid; item < (T >> 5); item += gridDim.x) {
    const int row0 = item * 32;
    const int mi = row_modidx(row0);
    const float* mrow = p.modv() + (layer * 3 + mi) * 12288;
    __syncthreads();
    for (int i = tid; i < 2048; i += 256) { sNW[i] = nw[i] * (1.f + mrow[4 * 2048 + i]); sSH[i] = mrow[3 * 2048 + i]; }
#pragma unroll 2
    for (int rr = 0; rr < 8; ++rr) {
      const float* xr = p.X() + (size_t)(row0 + wid * 8 + rr) * 2048 + lane * 4;
      float ss = 0.f;
#pragma unroll
      for (int i = 0; i < 8; ++i) { float4 v = *(const float4*)(xr + i * 256); ss += v.x * v.x + v.y * v.y + v.z * v.z + v.w * v.w; }
      ss = wave_sum(ss);
      if (lane == 0) srs[wid * 8 + rr] = rsqrtf(ss * (1.f / 2048.f) + EPSV);
    }
    __syncthreads();
    const float rs = srs[ar];
    const float* xrow = p.X() + (size_t)(row0 + ar) * 2048 + aks;
    bfraw* hrow = p.H() + (size_t)(row0 + ar) * LDH + aks;
    float4 xa0, xa1, xa2, xa3, wv0, wv1, wv2, wv3, wv4;
#define RT_GLOAD(k0)                                                                                   \
    {                                                                                                  \
      xa0 = *(const float4*)(xrow + (k0)); xa1 = *(const float4*)(xrow + (k0) + 4);                    \
      xa2 = *(const float4*)(xrow + (k0) + 8); xa3 = *(const float4*)(xrow + (k0) + 12);               \
      const float* er = we + (size_t)((k0) + wk) * 32 + (whalf ? 12 : 0);                              \
      wv0 = *(const float4*)(er); wv1 = *(const float4*)(er + 4); wv2 = *(const float4*)(er + 8);      \
      wv3 = *(const float4*)(er + 12); wv4 = *(const float4*)(er + 16);                                \
      if (!whalf) wv3 = *(const float4*)(wg + (size_t)((k0) + wk) * 4);                                \
    }
#define RT_A4(q, v)                                                                                    \
    {                                                                                                  \
      const int kq = (k0w) + aks + (q) * 4;                                                            \
      float h0 = v.x * rs * sNW[kq] + sSH[kq], h1 = v.y * rs * sNW[kq + 1] + sSH[kq + 1];              \
      float h2 = v.z * rs * sNW[kq + 2] + sSH[kq + 2], h3 = v.w * rs * sNW[kq + 3] + sSH[kq + 3];      \
      float* d = sA + ar * 129 + aks + (q) * 4; d[0] = h0; d[1] = h1; d[2] = h2; d[3] = h3;            \
      uint2 hb; hb.x = pack_bf16(h0, h1); hb.y = pack_bf16(h2, h3);                                    \
      *(uint2*)(hrow + (k0w) + (q) * 4) = hb;                                                          \
    }
#define RT_SWRITE()                                                                                    \
    {                                                                                                  \
      RT_A4(0, xa0) RT_A4(1, xa1) RT_A4(2, xa2) RT_A4(3, xa3)                                          \
      float* w = sW + wk * 64;                                                                         \
      if (!whalf) {                                                                                    \
        w[0] = wv3.x; w[1] = wv3.y; w[2] = wv3.z; w[3] = wv3.w;                                        \
        w[4] = wv0.x; w[5] = wv0.y; w[6] = wv0.z; w[7] = wv0.w; w[8] = wv1.x; w[9] = wv1.y; w[10] = wv1.z; w[11] = wv1.w; \
        w[12] = wv2.x; w[13] = wv2.y; w[14] = wv2.z; w[15] = wv2.w;                                    \
      } else {                                                                                         \
        w[16] = wv0.x; w[17] = wv0.y; w[18] = wv0.z; w[19] = wv0.w; w[20] = wv1.x; w[21] = wv1.y; w[22] = wv1.z; w[23] = wv1.w; \
        w[24] = wv2.x; w[25] = wv2.y; w[26] = wv2.z; w[27] = wv2.w; w[28] = wv3.x; w[29] = wv3.y; w[30] = wv3.z; w[31] = wv3.w; \
        w[32] = wv4.x; w[33] = wv4.y; w[34] = wv4.z; w[35] = wv4.w;                                    \
      }                                                                                                \
    }
    int k0w = 0;
    RT_GLOAD(0)
    RT_SWRITE()
    __syncthreads();
    f32x16 acc;
#pragma unroll
    for (int r = 0; r < 16; ++r) acc[r] = 0.f;
    const int ct = wid & 1, kh = wid >> 1;
    const float* ap = sA + l31 * 129 + kh * 64 + lh;
    const float* bp = sW + (kh * 64 + lh) * 64 + ct * 32 + l31;
    for (int k0 = 0; k0 < 2048; k0 += 128) {
      const bool more = (k0 + 128) < 2048;
      if (more) RT_GLOAD(k0 + 128)
#pragma unroll 8
      for (int kk = 0; kk < 32; ++kk) acc = MFMA32(ap[2 * kk], bp[2 * kk * 64], acc);
      __syncthreads();
      k0w = k0 + 128;
      if (more) RT_SWRITE()
      __syncthreads();
    }
#pragma unroll
    for (int r = 0; r < 16; ++r) sL[(kh * 32 + ROW16(r, lh)) * 64 + ct * 32 + l31] = acc[r];
    __syncthreads();
    if (tid < 32) {
      const int r = row0 + tid;
      const float* l0 = sL + tid * 64;
      const float* l1 = sL + (32 + tid) * 64;
      int gi = 0; float gm = l0[0] + l1[0];
      float gl[4]; gl[0] = gm;
#pragma unroll
      for (int j = 1; j < 4; ++j) { gl[j] = l0[j] + l1[j]; if (gl[j] > gm) { gm = gl[j]; gi = j; } }
      float gs = 0.f;
#pragma unroll
      for (int j = 0; j < 4; ++j) gs += expf(gl[j] - gm);
      const float gw = 1.f / gs;
      int i1 = 0, i2 = -1; float v1 = -INFINITY, v2 = -INFINITY;
      for (int j = 0; j < 8; ++j) {
        const float e = l0[4 + gi * 8 + j] + l1[4 + gi * 8 + j];
        if (e > v1) { v2 = v1; i2 = i1; v1 = e; i1 = j; }
        else if (e > v2) { v2 = e; i2 = j; }
      }
      const float e2 = expf(v2 - v1);
      const float w1 = gw / (1.f + e2), w2 = gw * e2 / (1.f + e2);
      const int ex1 = gi * 8 + i1, ex2 = gi * 8 + i2;
      int* cnt = p.cnt() + layer * 32;
      const int p1 = atomicAdd(&cnt[ex1], 1);
      p.list_tok()[ex1 * CAPE + p1] = r * 2; p.list_w()[ex1 * CAPE + p1] = w1;
      const int p2 = atomicAdd(&cnt[ex2], 1);
      p.list_tok()[ex2 * CAPE + p2] = r * 2 + 1; p.list_w()[ex2 * CAPE + p2] = w2;
    }
  }
}

struct AGather { const bfraw* H; const int* toks; int nvalid;
  __device__ __forceinline__ const bfraw* row(int r) const { return r < nvalid ? H + (size_t)(toks[r] >> 1) * LDH : nullptr; }
  __device__ __forceinline__ const bfraw* safe() const { return H; } };
struct BGateUp { const float *g, *u; int ldb; int nb;
  __device__ __forceinline__ const float* col(int v) const { int wc = v >> 6, j = (v >> 5) & 1, c = v & 31;
    const float* b = g + (ptrdiff_t)j * (u - g); return b + nb + wc * 32 + c; }
  __device__ __forceinline__ const float* safe() const { return g; } };

__device__ __forceinline__ void moe_prefix(const P& p, int layer, int* spre) {
  __syncthreads();
  if (threadIdx.x == 0) {
    int acc = 0;
    for (int e = 0; e < 32; ++e) { spre[e] = acc; acc += (p.cnt()[layer * 32 + e] + 127) >> 7; }
    spre[32] = acc;
  }
  __syncthreads();
}
__device__ __forceinline__ void ph_moe_up(const P& p, int layer, int bid, char* smem) {
  int* spre = (int*)(smem + 98304);
  moe_prefix(p, layer, spre);
  const int ntile = spre[32];
  for (int w = bid; w < ntile * 8; w += gridDim.x) {
    const int rbg = w >> 3, nt = w & 7;
    const int e = __builtin_amdgcn_readfirstlane(__popcll(__ballot((threadIdx.x & 63) < 31 && spre[(threadIdx.x & 63) + 1] <= rbg)));
    const int rb = rbg - spre[e];
    const int cnt = p.cnt()[layer * 32 + e];
    AGather af{p.H(), p.list_tok() + e * CAPE + rb * 128, cnt - rb * 128};
    const size_t wo = ((size_t)layer * 32 + e) * 2048 * 512;
    BGateUp bf{p.w_gate + wo, p.w_up + wo, 512, nt * 64};
    bfraw* act = p.ACT() + (size_t)rbg * 128 * LDACT + nt * 64;
    auto ef = [&](const f32x16 (&acc)[2][2], int wr, int wc, int lane) {
#pragma unroll
      for (int i = 0; i < 2; ++i)
#pragma unroll
        for (int r = 0; r < 16; ++r) {
          int row = ACC_ROW(wr, i, r, lane);
          float gv = acc[i][0][r], uv = acc[i][1][r];
          act[(size_t)row * LDACT + wc * 32 + (lane & 31)] = to_bf16(siluf_(gv) * uv);
        }
    };
    gemm_tile<2>(af, bf, ef, 2048, smem);
  }
}
__device__ __forceinline__ void ph_moe_down(const P& p, int layer, int bid, char* smem) {
  int* spre = (int*)(smem + 98304);
  moe_prefix(p, layer, spre);
  const int ntile = spre[32];
  for (int w = bid; w < ntile * 16; w += gridDim.x) {
    const int rbg = w >> 4, nt = w & 15;
    const int e = __builtin_amdgcn_readfirstlane(__popcll(__ballot((threadIdx.x & 63) < 31 && spre[(threadIdx.x & 63) + 1] <= rbg)));
    const int rb = rbg - spre[e];
    const int nvalid = p.cnt()[layer * 32 + e] - rb * 128;
    ARows af{p.ACT() + (size_t)rbg * 128 * LDACT, LDACT, 0, 128};
    BPlain bf{p.w_down + ((size_t)layer * 32 + e) * 512 * 2048, 2048, nt * 128, 2048};
    const int* toks = p.list_tok() + e * CAPE + rb * 128;
    const float* lw = p.list_w() + e * CAPE + rb * 128;
    bfraw* Ys = p.Yslot();
    auto ef = [&](const f32x16 (&acc)[2][2], int wr, int wc, int lane) {
#pragma unroll
      for (int i = 0; i < 2; ++i)
#pragma unroll
        for (int r = 0; r < 16; ++r) {
          int row = ACC_ROW(wr, i, r, lane);
          if (row < nvalid) {
            int ts = toks[row]; float wgt = lw[row];
#pragma unroll
            for (int j = 0; j < 2; ++j) Ys[(size_t)ts * 2048 + nt * 128 + ACC_COL(wc, j, lane)] = to_bf16(wgt * acc[i][j][r]);
          }
        }
    };
    gemm_tile<2>(af, bf, ef, 512, smem);
  }
}

__device__ __forceinline__ void ph_out(const P& p, int bid, char* smem) {
  const int tid = threadIdx.x, lane = tid & 63, wid = tid >> 6;
  for (int r = bid * 4 + wid; r < TLAT; r += gridDim.x * 4) {
    const int mi = r >> 12;
    const float* g2 = p.modv() + (1 * 3 + mi) * 12288 + 5 * 2048;
    f32x4v v[8];
    float ss = 0.f;
#pragma unroll
    for (int q = 0; q < 8; ++q) {
      const int col = q * 256 + lane * 4;
      f32x4v xv = *(const f32x4v*)(p.X() + (size_t)r * 2048 + col);
      const f32x4v gv = *(const f32x4v*)(g2 + col);
      const f32x4v y0 = ld_bf16x4(p.Yslot() + (size_t)(2 * r) * 2048 + col);
      const f32x4v y1 = ld_bf16x4(p.Yslot() + (size_t)(2 * r + 1) * 2048 + col);
      xv += gv * (y0 + y1);
      v[q] = xv;
      ss += xv[0] * xv[0] + xv[1] * xv[1] + xv[2] * xv[2] + xv[3] * xv[3];
    }
    ss = wave_sum(ss);
    const float rs = rsqrtf(ss * (1.f / 2048.f) + EPSV);
#pragma unroll
    for (int q = 0; q < 8; ++q) {
      const int col = q * 256 + lane * 4;
      const f32x4v w4 = *(const f32x4v*)(p.final_w + col);
      *(f32x4v*)(p.out + (size_t)r * 2048 + col) = v[q] * rs * w4;
    }
  }
}

#define SMEM_BYTES 102400
#define XB_TMO      128
#define XB_XCNT(j)  (256  + 64 * (j))
#define XB_XSUB(j)  (1280 + 64 * (j))
#define XB_XGEN(j)  (2304 + 64 * (j))
#define XB_TOP      3328
#define XB_TOPGEN   3392
#define XB_SPIN_CAP (1u << 22)
#define LAS __attribute__((address_space(3)))
__device__ __forceinline__ unsigned xb_ld(unsigned* p)              { return __hip_atomic_load(p, __ATOMIC_RELAXED, __HIP_MEMORY_SCOPE_AGENT); }
__device__ __forceinline__ unsigned xb_add(unsigned* p, unsigned v) { return __hip_atomic_fetch_add(p, v, __ATOMIC_RELAXED, __HIP_MEMORY_SCOPE_AGENT); }
__device__ __forceinline__ unsigned xb_xcc_id() { return (unsigned)__builtin_amdgcn_s_getreg((3 << 11) | 20) & 0xFu; }
#define XB_SPIN(cond, bar) do { unsigned _sp = 0; while (cond) { __builtin_amdgcn_s_sleep(1); \
    if ((++_sp & 255u) == 0u) { if (xb_ld(&(bar)[XB_TMO])) break; if (_sp > XB_SPIN_CAP) { atomicAdd(&(bar)[XB_TMO], 1u); break; } } } } while (0)
struct XcdBarrier { unsigned* bar; unsigned x; unsigned rank; volatile LAS unsigned* st; };
__device__ __forceinline__ XcdBarrier xcd_barrier_post(unsigned* bar, volatile LAS unsigned* st) {
    XcdBarrier b; b.bar = bar; b.x = xb_xcc_id(); b.st = st;
    b.rank = 0u;
    if (threadIdx.x == 0) b.rank = xb_add(&bar[XB_XCNT(b.x)], 1u);
    return b;
}
__device__ __forceinline__ void xcd_barrier_complete(unsigned* bar, unsigned x, unsigned& nloc, unsigned& nx) {
    const unsigned G = gridDim.x * gridDim.y * gridDim.z;
    unsigned sum, cnt, mine, sp = 0u;
    for (;;) {
        sum = 0u; cnt = 0u; mine = 0u;
#pragma unroll
        for (unsigned j = 0; j < 16; ++j) { const unsigned c = xb_ld(&bar[XB_XCNT(j)]); sum += c; cnt += (c > 0u) ? 1u : 0u; mine = (j == x) ? c : mine; }
        if (sum == G) break;
        __builtin_amdgcn_s_sleep(1);
        if ((++sp & 255u) == 0u) { if (xb_ld(&bar[XB_TMO])) break; if (sp > XB_SPIN_CAP) { atomicAdd(&bar[XB_TMO], 1u); break; } }
    }
    nloc = mine > 0u ? mine : 1u; nx = cnt > 0u ? cnt : 1u;
}
__device__ __forceinline__ void xcd_barrier(const XcdBarrier& b) {
    asm volatile("s_waitcnt vmcnt(0)" ::: "memory");
    __syncthreads();
    if (threadIdx.x == 0) {
        unsigned* bar = b.bar;
        __builtin_amdgcn_s_waitcnt(0);
        unsigned nloc = b.st[0], nx = b.st[1];
        if (nloc == 0u) { xcd_barrier_complete(bar, b.x, nloc, nx); b.st[0] = nloc; b.st[1] = nx; }
        const unsigned old = xb_add(&bar[XB_XSUB(b.x)], 1u);
        const unsigned gen = old / nloc;
        if (old + 1u == (gen + 1u) * nloc) {
            __builtin_amdgcn_fence(__ATOMIC_RELEASE, "agent");
            asm volatile("s_waitcnt vmcnt(0)" ::: "memory");
            const unsigned og = xb_add(&bar[XB_TOP], 1u);
            const unsigned tg = og / nx;
            if (og + 1u == (tg + 1u) * nx) xb_add(&bar[XB_TOPGEN], 1u);
            else XB_SPIN(xb_ld(&bar[XB_TOPGEN]) == tg, bar);
            __builtin_amdgcn_fence(__ATOMIC_ACQUIRE, "agent");
            xb_add(&bar[XB_XGEN(b.x)], 1u);
            asm volatile("s_waitcnt vmcnt(0)" ::: "memory");
        } else {
            XB_SPIN(xb_ld(&bar[XB_XGEN(b.x)]) == gen, bar);
            __builtin_amdgcn_fence(__ATOMIC_ACQUIRE, "agent");
            asm volatile("s_waitcnt vmcnt(0)" ::: "memory");
        }
    }
    __syncthreads();
}

__global__ void __launch_bounds__(256, 1) k_fused(P p, unsigned* bar) {
  extern __shared__ __attribute__((aligned(16))) char smem_all[];
  char* smem = smem_all + 64;
  if (threadIdx.x == 0) *(uint4*)smem_all = make_uint4(0u, 0u, 0u, 0u);
  __syncthreads();
  XcdBarrier b = xcd_barrier_post(bar, (volatile LAS unsigned*)smem_all);
#define LAYER_PROGRAM(L)                                                              \
  {                                                                                   \
    ph_norm1(p, L, bid, smem); xcd_barrier(b);          \
    ph_win(p, L, bid, smem); xcd_barrier(b);                          \
    ph_prep(p, L, bid, smem); xcd_barrier(b);           \
    ph_qkv(p, L, bid, smem); ph_mixA(p, L, bid, smem); xcd_barrier(b);     \
    ph_attn(p, L, bid, smem); ph_scan(p, L, bid, smem); xcd_barrier(b);    \
    ph_mixC(p, L, bid, smem); xcd_barrier(b);             \
    ph_glu(p, L, bid, smem); xcd_barrier(b);                                \
    ph_final_mix(p, L, bid, smem); xcd_barrier(b);      \
    ph_wout(p, L, bid, smem); xcd_barrier(b);                \
    ph_router(p, L, bid, smem); xcd_barrier(b);         \
    ph_moe_up(p, L, bid, smem); xcd_barrier(b);                    \
    ph_moe_down(p, L, bid, smem); xcd_barrier(b);       \
  }
  ph_mod(p, smem); xcd_barrier(b);
  if (threadIdx.x == 0) {
    unsigned pre = 0u;
    for (unsigned j = 0; j < 16; ++j) { const unsigned c = xb_ld(&bar[XB_XCNT(j)]); if (j < b.x) pre += c; }
    ((volatile LAS unsigned*)smem_all)[2] = pre + b.rank;
  }
  __syncthreads();
  const int bid = (int)((volatile LAS unsigned*)smem_all)[2];
  LAYER_PROGRAM(0)
  LAYER_PROGRAM(1)
  ph_out(p, bid, smem);
}

extern "C" void kernel_launch(void* const* d_in, const int* in_sizes, int n_in, void* d_out, int out_size, void* d_ws,
                              size_t ws_size, hipStream_t stream) {
  P p{};
  const float* const* in = (const float* const*)d_in;
  p.x = in[0]; p.c = in[1]; p.ctx = in[2]; p.c_ctx = in[3]; p.mod_w = in[4]; p.mod_b = in[5]; p.norm1_w = in[6];
  p.w_in = in[7]; p.q_norm_w = in[8]; p.kv_norm_w = in[9]; p.w_uq = in[10]; p.w_ukv = in[11]; p.conv_w = in[12];
  p.conv_b = in[13]; p.a_log = in[14]; p.dt_bias = in[15]; p.ssd_d = in[16]; p.gate_b = in[17]; p.lam_re = in[18];
  p.lam_im = in[19]; p.log_dt = in[20]; p.b_re = in[21]; p.b_im = in[22]; p.c_re = in[23]; p.c_im = in[24];
  p.s5_d = in[25]; p.glu_w = in[26]; p.glu_b = in[27]; p.out_norm_w = in[28]; p.w_out = in[29]; p.norm2_w = in[30];
  p.w_group = in[31]; p.w_expert = in[32]; p.w_gate = in[33]; p.w_up = in[34]; p.w_down = in[35]; p.final_w = in[36];
  p.out = (float*)d_out;
  p.ws = (float*)d_ws;
  (void)ws_size; (void)in_sizes; (void)n_in; (void)out_size;

  unsigned* bar = (unsigned*)((float*)d_ws + WO_bar);
  static int grid = 0;
  if (!grid) {
    int dev = 0, cus = 0, per_cu = 0;
    hipGetDevice(&dev);
    hipDeviceGetAttribute(&cus, hipDeviceAttributeMultiprocessorCount, dev);
    (void)hipFuncSetAttribute((const void*)k_fused, hipFuncAttributeMaxDynamicSharedMemorySize, SMEM_BYTES + 64);
    (void)hipOccupancyMaxActiveBlocksPerMultiprocessor(&per_cu, k_fused, 256, SMEM_BYTES + 64);
    if (per_cu < 1) per_cu = 1;
    grid = cus * (per_cu < 1 ? per_cu : 1);
  }
  hipMemsetAsync(bar, 0, XCD_BAR_WORDS * sizeof(unsigned), stream);
  hipLaunchKernelGGL(k_fused, dim3(grid), dim3(256), SMEM_BYTES + 64, stream, p, bar);
}
```

```cpp
#include <hip/hip_runtime.h>
#include <stdint.h>

#define DM 2048
#define SL 4096
#define CL 256
#define TLAT 8192
#define TCTX 512
#define TTOT 8704
#define NIN 4192
#define NKEY 4352
#define ZC_CQ 0
#define ZC_CKV 384
#define ZC_KR 512
#define ZC_BZ 576
#define ZC_XBC 1088
#define ZC_DT 2112
#define ZC_MQ 2128
#define ZC_MK 2384
#define ZC_MV 2640
#define ZC_MO 3152
#define ZC_MG 3664
#define ZC_U 3680
#define CAPE 8704
#define EPSV 1e-6f
#define ACT_ROWS 21632

typedef float f32x16 __attribute__((ext_vector_type(16)));
typedef short bf16x8 __attribute__((ext_vector_type(8)));
typedef float f32x4v __attribute__((ext_vector_type(4)));
typedef unsigned u32x4g __attribute__((ext_vector_type(4)));
typedef unsigned short bfraw;
__device__ __forceinline__ unsigned pack_bf16(float lo, float hi) {
  typedef __bf16 bf2 __attribute__((ext_vector_type(2)));
  bf2 v; v[0] = (__bf16)lo; v[1] = (__bf16)hi;
  return __builtin_bit_cast(unsigned, v);
}
__device__ __forceinline__ bfraw to_bf16(float x) { __bf16 b = (__bf16)x; return __builtin_bit_cast(unsigned short, b); }
__device__ __forceinline__ f32x4v ld_bf16x4(const bfraw* q) {
  const uint2 t = *(const uint2*)q;
  f32x4v r; r[0] = __uint_as_float(t.x << 16); r[1] = __uint_as_float(t.x & 0xffff0000u); r[2] = __uint_as_float(t.y << 16); r[3] = __uint_as_float(t.y & 0xffff0000u);
  return r;
}
__device__ __forceinline__ float from_bf16(bfraw x) { return __uint_as_float((unsigned)x << 16); }

#define NSTEP 68
#define LDH 2112
#define LDACT 576
#define XCD_BAR_WORDS 3456
#define WS_RND(n) (((size_t)(n) + 63) & ~(size_t)63)
constexpr size_t WO_cnt = 0;
constexpr size_t WO_modv = WO_cnt + WS_RND(64);
constexpr size_t WO_H = WO_modv + WS_RND(2 * 3 * 12288);
constexpr size_t WO_X = WO_H + WS_RND((size_t)TTOT * (LDH / 2));
constexpr size_t WO_Z = WO_X + WS_RND((size_t)TTOT * 2048);
constexpr size_t WO_Aq = WO_Z + WS_RND((size_t)TTOT * NIN);
constexpr size_t WO_Akv = WO_Aq + WS_RND((size_t)TTOT * 192);
constexpr size_t WO_qraw = WO_Akv + WS_RND((size_t)TTOT * 64);
constexpr size_t WO_kvraw = WO_qraw + WS_RND((size_t)TTOT * 768);
constexpr size_t WO_Q = WO_kvraw + WS_RND((size_t)TTOT * 1024);
constexpr size_t WO_Qc = WO_Q + WS_RND((size_t)8 * SL * 96);
constexpr size_t WO_K = WO_Qc + WS_RND((size_t)8 * CL * 96);
constexpr size_t WO_V = WO_K + WS_RND((size_t)8 * NKEY * 96);
constexpr size_t WO_O = WO_V + WS_RND((size_t)8 * NKEY * 64);
constexpr size_t WO_ssd_xs = WO_O + WS_RND((size_t)TTOT * 512);
constexpr size_t WO_ssd_B = WO_ssd_xs + WS_RND((size_t)TTOT * 512);
constexpr size_t WO_ssd_C = WO_ssd_B + WS_RND((size_t)TTOT * 256);
constexpr size_t WO_ssd_dt = WO_ssd_C + WS_RND((size_t)TTOT * 256);
constexpr size_t WO_ssd_y = WO_ssd_dt + WS_RND((size_t)TTOT * 16);
constexpr size_t WO_ssd_st = WO_ssd_y + WS_RND((size_t)TTOT * 512);
constexpr size_t WO_ssd_atot = WO_ssd_st + WS_RND((size_t)32 * NSTEP * 8192);
constexpr size_t WO_ml_h = WO_ssd_atot + WS_RND(32 * NSTEP);
constexpr size_t WO_ml_st = WO_ml_h + WS_RND((size_t)TTOT * 512);
constexpr size_t WO_ml_nst = WO_ml_st + WS_RND((size_t)16 * NSTEP * 8192);
constexpr size_t WO_ml_gtot = WO_ml_nst + WS_RND((size_t)16 * NSTEP * 64);
constexpr size_t WO_s5_st = WO_ml_gtot + WS_RND(16 * NSTEP);
constexpr size_t WO_s5_a = WO_s5_st + WS_RND((size_t)128 * NSTEP * 128);
constexpr size_t WO_s5_bb = WO_s5_a + WS_RND(2 * 2 * 32 * 64 * 2);
constexpr size_t WO_s5_rf = WO_s5_bb + WS_RND((size_t)2 * 2 * 32 * 64 * 32);
constexpr size_t WO_s5_rb = WO_s5_rf + WS_RND((size_t)TTOT * 512);
constexpr size_t WO_ydpre = WO_s5_rb + WS_RND((size_t)TTOT * 512);
constexpr size_t WO_ydg = WO_ydpre + WS_RND((size_t)TTOT * 512);
constexpr size_t WO_Y = WO_ydg + WS_RND((size_t)TTOT * 512);
constexpr size_t WO_ydpre_bf = WO_Y + WS_RND((size_t)TTOT * (LDH / 2));
constexpr size_t WO_list_tok = WO_ydpre_bf + WS_RND((size_t)TTOT * 256);
constexpr size_t WO_list_w = WO_list_tok + WS_RND((size_t)32 * CAPE);
constexpr size_t WO_ACT = WO_list_w + WS_RND((size_t)32 * CAPE);
constexpr size_t WO_Yslot = WO_ACT + WS_RND((size_t)ACT_ROWS * (LDACT / 2));
constexpr size_t WO_rope_cs = WO_Yslot + WS_RND((size_t)TTOT * 2 * 2048);
constexpr size_t WO_s5_bbh = WO_rope_cs + WS_RND(64 * 16 * 2);
constexpr size_t WO_s5_cmh = WO_s5_bbh + WS_RND(128 * 128 * 16 / 2);
constexpr size_t WO_bar_old = WO_Yslot + WS_RND((size_t)TTOT * 2 * 2048);
constexpr size_t WO_winT = WO_s5_cmh + WS_RND(64 * 32 * 128 / 2);
constexpr size_t WO_woutT = WO_winT + WS_RND((size_t)2 * 4224 * 1024);
constexpr size_t WO_wuqT = WO_woutT + WS_RND((size_t)2 * 2048 * 1024);
constexpr size_t WO_wukvT = WO_wuqT + WS_RND((size_t)2 * 768 * 192);
constexpr size_t WO_wgluT = WO_wukvT + WS_RND((size_t)2 * 1024 * 64);
constexpr size_t WO_bar = WO_wgluT + WS_RND((size_t)2 * 512 * 256);
constexpr size_t WS_TOTAL_FLOATS = WO_bar + 4096;

struct P {
  const float *x, *c, *ctx, *c_ctx, *mod_w, *mod_b, *norm1_w, *w_in, *q_norm_w, *kv_norm_w, *w_uq, *w_ukv;
  const float *conv_w, *conv_b, *a_log, *dt_bias, *ssd_d, *gate_b, *lam_re, *lam_im, *log_dt, *b_re, *b_im;
  const float *c_re, *c_im, *s5_d, *glu_w, *glu_b, *out_norm_w, *w_out, *norm2_w, *w_group, *w_expert;
  const float *w_gate, *w_up, *w_down, *final_w;
  float* out;
  float* ws;
  __device__ __forceinline__ int* cnt() const { return (int*)(ws + WO_cnt); }
  __device__ __forceinline__ float* modv() const { return (float*)(ws + WO_modv); }
  __device__ __forceinline__ bfraw* H() const { return (bfraw*)(ws + WO_H); }
  __device__ __forceinline__ float* X() const { return (float*)(ws + WO_X); }
  __device__ __forceinline__ float* Z() const { return (float*)(ws + WO_Z); }
  __device__ __forceinline__ bfraw* Aq() const { return (bfraw*)(ws + WO_Aq); }
  __device__ __forceinline__ bfraw* Akv() const { return (bfraw*)(ws + WO_Akv); }
  __device__ __forceinline__ float* qraw() const { return (float*)(ws + WO_qraw); }
  __device__ __forceinline__ float* kvraw() const { return (float*)(ws + WO_kvraw); }
  __device__ __forceinline__ bfraw* Q() const { return (bfraw*)(ws + WO_Q); }
  __device__ __forceinline__ bfraw* Qc() const { return (bfraw*)(ws + WO_Qc); }
  __device__ __forceinline__ bfraw* K() const { return (bfraw*)(ws + WO_K); }
  __device__ __forceinline__ bfraw* V() const { return (bfraw*)(ws + WO_V); }
  __device__ __forceinline__ float* O() const { return (float*)(ws + WO_O); }
  __device__ __forceinline__ float* ssd_xs() const { return (float*)(ws + WO_ssd_xs); }
  __device__ __forceinline__ float* ssd_B() const { return (float*)(ws + WO_ssd_B); }
  __device__ __forceinline__ float* ssd_C() const { return (float*)(ws + WO_ssd_C); }
  __device__ __forceinline__ float* ssd_dt() const { return (float*)(ws + WO_ssd_dt); }
  __device__ __forceinline__ float* ssd_y() const { return (float*)(ws + WO_ssd_y); }
  __device__ __forceinline__ bfraw* ssd_st() const { return (bfraw*)(ws + WO_ssd_st); }
  __device__ __forceinline__ float* ssd_atot() const { return (float*)(ws + WO_ssd_atot); }
  __device__ __forceinline__ float* ml_h() const { return (float*)(ws + WO_ml_h); }
  __device__ __forceinline__ bfraw* ml_st() const { return (bfraw*)(ws + WO_ml_st); }
  __device__ __forceinline__ float* ml_nst() const { return (float*)(ws + WO_ml_nst); }
  __device__ __forceinline__ float* ml_gtot() const { return (float*)(ws + WO_ml_gtot); }
  __device__ __forceinline__ float* s5_st() const { return (float*)(ws + WO_s5_st); }
  __device__ __forceinline__ float* s5_a() const { return (float*)(ws + WO_s5_a); }
  __device__ __forceinline__ float* s5_bb() const { return (float*)(ws + WO_s5_bb); }
  __device__ __forceinline__ float* s5_rf() const { return (float*)(ws + WO_s5_rf); }
  __device__ __forceinline__ float* s5_rb() const { return (float*)(ws + WO_s5_rb); }
  __device__ __forceinline__ float* ydpre() const { return (float*)(ws + WO_ydpre); }
  __device__ __forceinline__ float* ydg() const { return (float*)(ws + WO_ydg); }
  __device__ __forceinline__ bfraw* Y() const { return (bfraw*)(ws + WO_Y); }
  __device__ __forceinline__ bfraw* ydpre_bf() const { return (bfraw*)(ws + WO_ydpre_bf); }
  __device__ __forceinline__ int* list_tok() const { return (int*)(ws + WO_list_tok); }
  __device__ __forceinline__ float* list_w() const { return (float*)(ws + WO_list_w); }
  __device__ __forceinline__ bfraw* ACT() const { return (bfraw*)(ws + WO_ACT); }
  __device__ __forceinline__ bfraw* Yslot() const { return (bfraw*)(ws + WO_Yslot); }
  __device__ __forceinline__ float* rope_cs() const { return (float*)(ws + WO_rope_cs); }
  __device__ __forceinline__ bfraw* s5_bbh() const { return (bfraw*)(ws + WO_s5_bbh); }
  __device__ __forceinline__ bfraw* s5_cmh() const { return (bfraw*)(ws + WO_s5_cmh); }
  __device__ __forceinline__ bfraw* winT() const { return (bfraw*)(ws + WO_winT); }
  __device__ __forceinline__ bfraw* woutT() const { return (bfraw*)(ws + WO_woutT); }
  __device__ __forceinline__ bfraw* wuqT() const { return (bfraw*)(ws + WO_wuqT); }
  __device__ __forceinline__ bfraw* wukvT() const { return (bfraw*)(ws + WO_wukvT); }
  __device__ __forceinline__ bfraw* wgluT() const { return (bfraw*)(ws + WO_wgluT); }
};

__device__ __forceinline__ int row_modidx(int r) { return r < TLAT ? (r >> 12) : 2; }
__device__ __forceinline__ float sigmoidf_(float v) { return 1.f / (1.f + expf(-v)); }
__device__ __forceinline__ float siluf_(float v) { return v / (1.f + expf(-v)); }
__device__ __forceinline__ float wave_sum(float v) {
#pragma unroll
  for (int o = 32; o; o >>= 1) v += __shfl_xor(v, o);
  return v;
}
__device__ __forceinline__ float block_sum(float v, float* red) {
  v = wave_sum(v);
  __syncthreads();
  if ((threadIdx.x & 63) == 0) red[threadIdx.x >> 6] = v;
  __syncthreads();
  return red[0] + red[1] + red[2] + red[3];
}

__device__ __forceinline__ void ph_mod(const P& p, char* smem) {
  float* sc = (float*)smem;
  float* red = sc + 3 * 2048;
  const int tid = threadIdx.x;
  if (blockIdx.x == 0 && tid < 64) p.cnt()[tid] = 0;
  if (blockIdx.x == 1) {
    for (int i = tid; i < 64 * 16; i += 256) {
      const int idx = i >> 4, f = i & 15;
      const float ang = (float)idx * powf(10000.f, -(float)f * (1.f / 16.f));
      p.rope_cs()[i * 2] = cosf(ang); p.rope_cs()[i * 2 + 1] = sinf(ang);
    }
  }
  for (int i = blockIdx.x * 256 + tid; i < 64 * 32 * 128; i += gridDim.x * 256) {
    const int pp = i & 127, c = (i >> 7) & 31, lg = i >> 12;
    float v = 0.f;
    if (c < 16) v = pp < 64 ? p.c_re[((size_t)lg * 16 + c) * 64 + pp] : -p.c_im[((size_t)lg * 16 + c) * 64 + pp - 64];
    p.s5_cmh()[i] = to_bf16(v);
  }
  for (int i = blockIdx.x * 256 + tid; i < 2 * 2 * 32 * 64; i += gridDim.x * 256) {
    const int sp = i & 63, g = (i >> 6) & 31, l = i >> 12;
    const float lr = p.lam_re[i], li = p.lam_im[i];
    const float dt = expf(p.log_dt[i >> 6]);
    const float mag = expf(lr * dt);
    const float ar = mag * cosf(li * dt), ai = mag * sinf(li * dt);
    const float den = lr * lr + li * li;
    const float cr_ = ((ar - 1.f) * lr + ai * li) / den;
    const float ci_ = (ai * lr - (ar - 1.f) * li) / den;
    p.s5_a()[i * 2] = ar; p.s5_a()[i * 2 + 1] = ai;
    for (int c = 0; c < 16; ++c) {
      float br = p.b_re[((size_t)(l * 32 + g) * 64 + sp) * 16 + c];
      float bim = p.b_im[((size_t)(l * 32 + g) * 64 + sp) * 16 + c];
      p.s5_bb()[(size_t)i * 32 + c] = cr_ * br - ci_ * bim;
      p.s5_bb()[(size_t)i * 32 + 16 + c] = cr_ * bim + ci_ * br;
      p.s5_bbh()[((size_t)(i >> 6) * 128 + sp) * 16 + c] = to_bf16(cr_ * br - ci_ * bim);
      p.s5_bbh()[((size_t)(i >> 6) * 128 + 64 + sp) * 16 + c] = to_bf16(cr_ * bim + ci_ * br);
    }
  }
  for (int i = tid; i < 3 * 2048; i += 256) {
    int r = i >> 11, k = i & 2047;
    float v = r < 2 ? p.c[r * 2048 + k] : p.c_ctx[k];
    sc[i] = siluf_(v);
  }
  __syncthreads();
  for (int w = blockIdx.x; w < 2 * 96; w += gridDim.x) {
    int l = w / 96, j0 = (w % 96) * 128;
    int cg = tid & 31, ks = tid >> 5;
    const float* W = p.mod_w + (size_t)l * 2048 * 12288 + j0 + cg * 4;
    float acc[3][4];
#pragma unroll
    for (int r = 0; r < 3; ++r)
#pragma unroll
      for (int c = 0; c < 4; ++c) acc[r][c] = 0.f;
#pragma unroll 16
    for (int k = ks * 256; k < ks * 256 + 256; ++k) {
      float4 wv = *(const float4*)(W + (size_t)k * 12288);
      float s0 = sc[k], s1 = sc[2048 + k], s2 = sc[4096 + k];
      acc[0][0] += s0 * wv.x; acc[0][1] += s0 * wv.y; acc[0][2] += s0 * wv.z; acc[0][3] += s0 * wv.w;
      acc[1][0] += s1 * wv.x; acc[1][1] += s1 * wv.y; acc[1][2] += s1 * wv.z; acc[1][3] += s1 * wv.w;
      acc[2][0] += s2 * wv.x; acc[2][1] += s2 * wv.y; acc[2][2] += s2 * wv.z; acc[2][3] += s2 * wv.w;
    }
    __syncthreads();
#pragma unroll
    for (int r = 0; r < 3; ++r)
#pragma unroll
      for (int c = 0; c < 4; ++c) red[(ks * 32 + cg) * 12 + r * 4 + c] = acc[r][c];
    __syncthreads();
    for (int o = tid; o < 384; o += 256) {
      int r = o >> 7, c = o & 127;
      float s = 0.f;
#pragma unroll
      for (int q = 0; q < 8; ++q) s += red[(q * 32 + (c >> 2)) * 12 + r * 4 + (c & 3)];
      s += p.mod_b[l * 12288 + j0 + c];
      p.modv()[(l * 3 + r) * 12288 + j0 + c] = s;
    }
    __syncthreads();
  }
}

__device__ __forceinline__ void wprep_matrix(const float* src, bfraw* dst, int K, int N, int Npad, int& base, int bid, char* smem) {
  const int tid = threadIdx.x;
  const int tk = K >> 6, tn = Npad >> 6, nt = tk * tn;
  int first = bid - (base % (int)gridDim.x); if (first < 0) first += gridDim.x;
  for (int t = first; t < nt; t += gridDim.x) {
    const int k0 = (t % tk) * 64, n0 = (t / tk) * 64;
    __syncthreads();
#pragma unroll
    for (int u = 0; u < 4; ++u) {
      const int i = tid + 256 * u, kr = i >> 4, c4 = i & 15;
      const int n = n0 + c4 * 4;
      float4 v = make_float4(0.f, 0.f, 0.f, 0.f);
      if (n < N) v = *(const float4*)(src + (size_t)(k0 + kr) * N + n);
      *(bfraw*)(smem + (c4 * 4 + 0) * 144 + kr * 2) = to_bf16(v.x);
      *(bfraw*)(smem + (c4 * 4 + 1) * 144 + kr * 2) = to_bf16(v.y);
      *(bfraw*)(smem + (c4 * 4 + 2) * 144 + kr * 2) = to_bf16(v.z);
      *(bfraw*)(smem + (c4 * 4 + 3) * 144 + kr * 2) = to_bf16(v.w);
    }
    __syncthreads();
#pragma unroll
    for (int u = 0; u < 2; ++u) {
      const int i = tid + 256 * u, nr = i >> 3, c = i & 7;
      *(uint4*)(dst + (size_t)(n0 + nr) * K + k0 + c * 8) = *(const uint4*)(smem + nr * 144 + c * 16);
    }
  }
  base += nt;
}
__device__ __forceinline__ void ph_wprep(const P& p, int bid, char* smem) {
  int base = 0;
  for (int l = 0; l < 2; ++l) {
    wprep_matrix(p.w_in + (size_t)l * 2048 * NIN, p.winT() + (size_t)l * 4224 * 2048, 2048, NIN, 4224, base, bid, smem);
    wprep_matrix(p.w_out + (size_t)l * 2048 * 2048, p.woutT() + (size_t)l * 2048 * 2048, 2048, 2048, 2048, base, bid, smem);
    wprep_matrix(p.w_uq + (size_t)l * 384 * 768, p.wuqT() + (size_t)l * 768 * 384, 384, 768, 768, base, bid, smem);
    wprep_matrix(p.w_ukv + (size_t)l * 128 * 1024, p.wukvT() + (size_t)l * 1024 * 128, 128, 1024, 1024, base, bid, smem);
    wprep_matrix(p.glu_w + (size_t)l * 512 * 512, p.wgluT() + (size_t)l * 512 * 512, 512, 512, 512, base, bid, smem);
  }
}

__device__ __forceinline__ void ph_norm1(const P& p, int layer, int bid, char* smem) {
  const int tid = threadIdx.x, lane = tid & 63, wid = tid >> 6;
  const float* nw = p.norm1_w + layer * 2048;
  for (int r = bid * 4 + wid; r < TTOT; r += gridDim.x * 4) {
    const int mi = row_modidx(r);
    const float* mrow = p.modv() + (layer * 3 + mi) * 12288;
    f32x4v v[8];
    float ss = 0.f;
#pragma unroll
    for (int q = 0; q < 8; ++q) {
      const int col = q * 256 + lane * 4;
      f32x4v xv;
      if (layer == 0) {
        const float* src = r < TLAT ? p.x + (size_t)r * 2048 : p.ctx + (size_t)(r - TLAT) * 2048;
        xv = *(const f32x4v*)(src + col);
      } else {
        xv = *(const f32x4v*)(p.X() + (size_t)r * 2048 + col);
        const float* g2 = p.modv() + ((layer - 1) * 3 + mi) * 12288 + 5 * 2048;
        const f32x4v gv = *(const f32x4v*)(g2 + col);
        const f32x4v y0 = ld_bf16x4(p.Yslot() + (size_t)(2 * r) * 2048 + col);
        const f32x4v y1 = ld_bf16x4(p.Yslot() + (size_t)(2 * r + 1) * 2048 + col);
        xv += gv * (y0 + y1);
        *(f32x4v*)(p.X() + (size_t)r * 2048 + col) = xv;
      }
      v[q] = xv;
      ss += xv[0] * xv[0] + xv[1] * xv[1] + xv[2] * xv[2] + xv[3] * xv[3];
    }
    ss = wave_sum(ss);
    const float rs = rsqrtf(ss * (1.f / 2048.f) + EPSV);
#pragma unroll
    for (int q = 0; q < 8; ++q) {
      const int col = q * 256 + lane * 4;
      const f32x4v w4 = *(const f32x4v*)(nw + col);
      const f32x4v sh = *(const f32x4v*)(mrow + col);
      const f32x4v scv = *(const f32x4v*)(mrow + 2048 + col);
      const f32x4v o = v[q] * rs * w4 * (1.f + scv) + sh;
      uint2 ob; ob.x = pack_bf16(o[0], o[1]); ob.y = pack_bf16(o[2], o[3]);
      *(uint2*)(p.H() + (size_t)r * LDH + col) = ob;
    }
  }
}

template <int MI, class AF, class BF, class EF>
__device__ __forceinline__ void gemm_tile(const AF& af, const BF& bf, const EF& ef, int K, char* smem) {
  constexpr int BM = MI * 64;
  constexpr int NA = MI * 2;
  constexpr int ABYTES = BM * 128, STAGE = ABYTES + 16384;
  int tid_ = threadIdx.x; asm volatile("" : "+v"(tid_));
  const int tid = tid_, lane = tid & 63, wid = tid >> 6, wr = wid >> 1, wc = wid & 1;
  const int l31 = lane & 31, lh = lane >> 5;
  f32x16 acc[MI][2];
#pragma unroll
  for (int i = 0; i < MI; ++i)
#pragma unroll
    for (int j = 0; j < 2; ++j)
#pragma unroll
      for (int r = 0; r < 16; ++r) acc[i][j][r] = 0.f;
  const int arl = tid >> 3, ac = tid & 7;
  const bfraw* arow[NA];
#pragma unroll
  for (int i = 0; i < NA; ++i) { const bfraw* q = af.row(arl + 32 * i); arow[i] = (q ? q : af.safe()) + ac * 8; }
  const int n4 = tid & 31, kg = tid >> 5;
  const float* bc = nullptr;
  size_t ldb = 0;
  const bfraw* brow[4] = {nullptr, nullptr, nullptr, nullptr};
  if constexpr (BF::kT) {
#pragma unroll
    for (int i = 0; i < 4; ++i) brow[i] = bf.nrow(arl + 32 * i) + ac * 8;
  } else {
    const float* q = bf.col(n4 * 4); bc = (q ? q : bf.safe()) + (size_t)(kg * 8) * bf.ldb;
    ldb = (size_t)bf.ldb;
  }
  typedef unsigned u32x4v __attribute__((ext_vector_type(4)));
  u32x4v ra[2][NA];
  f32x4v rb[2][8];
  u32x4v rbt[2][4];
#define GM_GL(set, k0)                                                               \
  {                                                                                  \
    _Pragma("unroll") for (int i = 0; i < NA; ++i) ra[set][i] = *(const u32x4v*)(arow[i] + (k0)); \
    if constexpr (BF::kT) {                                                          \
      _Pragma("unroll") for (int i = 0; i < 4; ++i) rbt[set][i] = *(const u32x4v*)(brow[i] + (k0)); \
    } else {                                                                         \
      const float* bq = bc + (size_t)(k0) * ldb;                                     \
      _Pragma("unroll") for (int j = 0; j < 8; ++j) rb[set][j] = *(const f32x4v*)(bq + (size_t)j * ldb); \
    }                                                                                \
  }
#define GM_SW(set, buf)                                                              \
  {                                                                                  \
    char* Ab = smem + (buf) * STAGE; char* Bb = Ab + ABYTES;                         \
    const int asw = (ac ^ ((arl >> 1) & 7)) << 4;                                    \
    _Pragma("unroll") for (int i = 0; i < NA; ++i) *(u32x4v*)(Ab + (arl + 32 * i) * 128 + asw) = ra[set][i]; \
    if constexpr (BF::kT) {                                                          \
      _Pragma("unroll") for (int i = 0; i < 4; ++i) *(u32x4v*)(Bb + (arl + 32 * i) * 128 + asw) = rbt[set][i]; \
    } else                                                                           \
    _Pragma("unroll") for (int i4 = 0; i4 < 4; ++i4) {                               \
      const int n = n4 * 4 + i4;                                                     \
      u32x4v v;                                                                      \
      v[0] = pack_bf16(rb[set][0][i4], rb[set][1][i4]); v[1] = pack_bf16(rb[set][2][i4], rb[set][3][i4]); \
      v[2] = pack_bf16(rb[set][4][i4], rb[set][5][i4]); v[3] = pack_bf16(rb[set][6][i4], rb[set][7][i4]); \
      *(u32x4v*)(Bb + n * 128 + ((kg ^ ((n >> 1) & 7)) << 4)) = v;                   \
    }                                                                                \
  }
#define GM_COMPUTE(buf, KK0, KK1)                                                    \
  {                                                                                  \
    const char* ap = smem + (buf) * STAGE + (wr * (BM / 2) + l31) * 128;             \
    const char* bp = smem + (buf) * STAGE + ABYTES + (wc * 64 + l31) * 128;          \
    _Pragma("unroll") for (int kk = KK0; kk < KK1; ++kk) {                           \
      const int co = ((2 * kk + lh) ^ fsw) << 4;                                     \
      const bf16x8 b0 = *(const bf16x8*)(bp + co), b1 = *(const bf16x8*)(bp + 32 * 128 + co); \
      _Pragma("unroll") for (int i = 0; i < MI; ++i) {                               \
        const bf16x8 a = *(const bf16x8*)(ap + i * 32 * 128 + co);                   \
        acc[i][0] = __builtin_amdgcn_mfma_f32_32x32x16_bf16(a, b0, acc[i][0], 0, 0, 0); \
        acc[i][1] = __builtin_amdgcn_mfma_f32_32x32x16_bf16(a, b1, acc[i][1], 0, 0, 0); \
      }                                                                              \
    }                                                                                \
  }
  const int fsw = (l31 >> 1) & 7;
  const int nsteps = K >> 6;
  __syncthreads();
  const int klast = (nsteps - 1) * 64;
  GM_GL(0, 0)
  GM_SW(0, 0)
  GM_GL(1, 64)
  __syncthreads();
  for (int s = 0; s < nsteps; s += 2) {
    { const int kn = min((s + 2) * 64, klast); GM_GL(0, kn) }
    GM_COMPUTE(0, 0, 2)
    __builtin_amdgcn_sched_barrier(0);
    GM_SW(1, 1)
    __builtin_amdgcn_sched_barrier(0);
    GM_COMPUTE(0, 2, 4)
    __syncthreads();
    { const int kn = min((s + 3) * 64, klast); GM_GL(1, kn) }
    GM_COMPUTE(1, 0, 2)
    __builtin_amdgcn_sched_barrier(0);
    GM_SW(0, 0)
    __builtin_amdgcn_sched_barrier(0);
    GM_COMPUTE(1, 2, 4)
    __syncthreads();
  }
  ef(acc, wr, wc, lane);
}
#define ACC_ROWM(MI, wr, i, r, lane) ((wr) * ((MI) * 32) + (i) * 32 + ((r) & 3) + 8 * ((r) >> 2) + 4 * ((lane) >> 5))
#define ACC_ROW(wr, i, r, lane) ACC_ROWM(2, wr, i, r, lane)
#define ACC_COL(wc, j, lane) ((wc) * 64 + (j) * 32 + ((lane) & 31))

struct ARows { const bfraw* base; int ld; int m0; int M;
  __device__ __forceinline__ const bfraw* row(int r) const { int g = m0 + r; return g < M ? base + (size_t)g * ld : nullptr; }
  __device__ __forceinline__ const bfraw* safe() const { return base; } };
struct BPlain { static constexpr bool kT = false; const float* B; int ldb; int n0; int N;
  __device__ __forceinline__ const float* col(int v) const { int n = n0 + v; return n < N ? B + n : nullptr; }
  __device__ __forceinline__ const float* safe() const { return B; } };

struct BTrans { static constexpr bool kT = true; const bfraw* Bt; int ldk; int n0;
  __device__ __forceinline__ const bfraw* nrow(int v) const { return Bt + (size_t)(n0 + v) * ldk; } };

template <int MI, class EPI>
__device__ __forceinline__ void gemm_dense(const bfraw* A, int lda, const bfraw* Bt, int M, int N, int K, const EPI& epi, int bid, char* smem) {
  constexpr int BM = MI * 64;
  const int mt = (M + BM - 1) / BM, nt = (N + 127) >> 7;
  const int nslots = ((nt + 1) >> 1) * mt * 2;
  for (int w = bid; w < nslots; w += gridDim.x) {
    const int sr = w / (mt * 2), rem = w - sr * (mt * 2);
    const int n_t = sr * 2 + (rem & 1);
    if (n_t >= nt) continue;
    const int m0 = (rem >> 1) * BM, n0 = n_t * 128;
    ARows af{A, lda, m0, M};
    BTrans bf{Bt, K, n0};
    auto ef = [&](const f32x16 (&acc)[MI][2], int wr, int wc, int lane) {
#pragma unroll
      for (int i = 0; i < MI; ++i)
#pragma unroll
        for (int j = 0; j < 2; ++j)
#pragma unroll
          for (int r = 0; r < 16; ++r) {
            int row = m0 + ACC_ROWM(MI, wr, i, r, lane), col = n0 + ACC_COL(wc, j, lane);
            if (row < M && col < N) epi(row, col, acc[i][j][r]);
          }
    };
    gemm_tile<MI>(af, bf, ef, K, smem);
  }
}


template <class EPI>
__device__ __forceinline__ void gemm_dense_hybrid(const bfraw* A, int lda, const bfraw* Bt, int M, int N, int K, const EPI& epi, int bid, char* smem) {
  const int mt = M / 256, nt = (N + 127) >> 7;
  const int npair = (nt >> 1) * mt * 2, ntiles = mt * nt;
  const int G = gridDim.x;
  const int nfull = (ntiles / G) * G, rem = ntiles - nfull;
  auto tile_of = [&](int w, int& m_t, int& n_t) {
    if (w < npair) { const int sr = w / (mt * 2), r2 = w - sr * (mt * 2); m_t = r2 >> 1; n_t = sr * 2 + (r2 & 1); }
    else { m_t = w - npair; n_t = nt - 1; }
  };
  for (int w = bid; w < nfull; w += G) {
    int m_t, n_t; tile_of(w, m_t, n_t);
    const int m0 = m_t * 256, n0 = n_t * 128;
    ARows af{A, lda, m0, M};
    BTrans bf{Bt, K, n0};
    auto ef = [&](const f32x16 (&acc)[4][2], int wr, int wc, int lane) {
#pragma unroll
      for (int i = 0; i < 4; ++i)
#pragma unroll
        for (int j = 0; j < 2; ++j)
#pragma unroll
          for (int r = 0; r < 16; ++r) {
            int row = m0 + ACC_ROWM(4, wr, i, r, lane), col = n0 + ACC_COL(wc, j, lane);
            if (col < N) epi(row, col, acc[i][j][r]);
          }
    };
    gemm_tile<4>(af, bf, ef, K, smem);
  }
  for (int w = bid; w < 2 * rem; w += G) {
    int m_t, n_t; tile_of(nfull + (w >> 1), m_t, n_t);
    const int m0 = m_t * 256 + (w & 1) * 128, n0 = n_t * 128;
    ARows af{A, lda, m0, M};
    BTrans bf{Bt, K, n0};
    auto ef = [&](const f32x16 (&acc)[2][2], int wr, int wc, int lane) {
#pragma unroll
      for (int i = 0; i < 2; ++i)
#pragma unroll
        for (int j = 0; j < 2; ++j)
#pragma unroll
          for (int r = 0; r < 16; ++r) {
            int row = m0 + ACC_ROWM(2, wr, i, r, lane), col = n0 + ACC_COL(wc, j, lane);
            if (col < N) epi(row, col, acc[i][j][r]);
          }
    };
    gemm_tile<2>(af, bf, ef, K, smem);
  }
}

__device__ __forceinline__ void ph_win(const P& p, int layer, int bid, char* smem) {
  float* Z = p.Z();
  auto epi = [=](int row, int col, float v) { Z[(size_t)row * NIN + col] = v; };
  gemm_dense_hybrid(p.H(), LDH, p.winT() + (size_t)layer * 4224 * 2048, TTOT, NIN, 2048, epi, bid, smem);
}

__device__ __forceinline__ void ph_prep(const P& p, int layer, int bid, char* smem) {
  const int tid = threadIdx.x, lane = tid & 63, wid = tid >> 6;
  for (int r = bid * 4 + wid; r < TTOT; r += gridDim.x * 4) {
    const float* z = p.Z() + (size_t)r * NIN;
    float q[6]; float ss = 0.f;
#pragma unroll
    for (int i = 0; i < 6; ++i) { q[i] = z[ZC_CQ + i * 64 + lane]; ss += q[i] * q[i]; }
    ss = wave_sum(ss);
    float rs = rsqrtf(ss * (1.f / 384.f) + EPSV);
#pragma unroll
    for (int i = 0; i < 6; ++i) p.Aq()[(size_t)r * 384 + i * 64 + lane] = to_bf16(q[i] * rs * p.q_norm_w[layer * 384 + i * 64 + lane]);
    float k0 = z[ZC_CKV + lane], k1 = z[ZC_CKV + 64 + lane];
    float s2 = wave_sum(k0 * k0 + k1 * k1);
    float rs2 = rsqrtf(s2 * (1.f / 128.f) + EPSV);
    p.Akv()[(size_t)r * 128 + lane] = to_bf16(k0 * rs2 * p.kv_norm_w[layer * 128 + lane]);
    p.Akv()[(size_t)r * 128 + 64 + lane] = to_bf16(k1 * rs2 * p.kv_norm_w[layer * 128 + 64 + lane]);
  }
  const float* cw = p.conv_w + layer * 5 * 1024;
  const float* cb = p.conv_b + layer * 1024;
  const int ch = tid * 4;
  const f32x4v bias = *(const f32x4v*)(cb + ch);
  f32x4v wk[5];
#pragma unroll
  for (int k = 0; k < 5; ++k) wk[k] = *(const f32x4v*)(cw + k * 1024 + ch);
  for (int rb = bid; rb < TTOT / 8; rb += gridDim.x) {
    const int r0 = rb * 8;
    int base, len;
    if (r0 < TLAT) { base = (r0 >> 12) << 12; len = SL; } else { base = TLAT + (((r0 - TLAT) >> 8) << 8); len = CL; }
    const int t0 = r0 - base;
    f32x4v xw[12];
#pragma unroll
    for (int u = 0; u < 12; ++u) {
      const int tt = t0 + u - 2;
      const f32x4v zero = {0.f, 0.f, 0.f, 0.f};
      xw[u] = (tt >= 0 && tt < len) ? *(const f32x4v*)(p.Z() + (size_t)(base + tt) * NIN + ZC_XBC + ch) : zero;
    }
#pragma unroll
    for (int j = 0; j < 8; ++j) {
      f32x4v acc = bias;
#pragma unroll
      for (int k = 0; k < 5; ++k) acc += xw[j + k] * wk[k];
      acc[0] = siluf_(acc[0]); acc[1] = siluf_(acc[1]); acc[2] = siluf_(acc[2]); acc[3] = siluf_(acc[3]);
      const int r = r0 + j;
      if (ch < 512) *(f32x4v*)(p.ssd_xs() + (size_t)r * 512 + ch) = acc;
      else if (ch < 768) *(f32x4v*)(p.ssd_B() + (size_t)r * 256 + (ch - 512)) = acc;
      else *(f32x4v*)(p.ssd_C() + (size_t)r * 256 + (ch - 768)) = acc;
    }
    if (tid < 128) {
      const int r = r0 + (tid >> 4), c = tid & 15;
      float v = p.Z()[(size_t)r * NIN + ZC_DT + c] + p.dt_bias[layer * 16 + c];
      p.ssd_dt()[(size_t)r * 16 + c] = v > 20.f ? v : log1pf(expf(v));
    }
  }
}

__device__ __forceinline__ void ph_qkv(const P& p, int layer, int bid, char* smem) {
  const int tid = threadIdx.x;
  const float qscale = 0.07216878364870322f * 1.4426950408889634f;
  const float* rope = p.rope_cs();
  for (int r = bid; r < TTOT; r += gridDim.x) {
    const bool lat = r < TLAT;
    int b, pos;
    if (lat) { b = r >> 12; pos = r & 4095; } else { b = (r - TLAT) >> 8; pos = (r - TLAT) & 255; }
    const int kpos = lat ? pos : SL + pos;
    const float* zr = p.Z() + (size_t)r * NIN + ZC_KR;
    const int h = tid >> 6, e = tid & 63;
    float v;
    if (!lat) v = zr[e];
    else {
      const int a = e >> 5, half = (e >> 4) & 1, f = e & 15;
      const float x1 = zr[a * 32 + f], x2 = zr[a * 32 + 16 + f];
      const int idx = a == 0 ? (pos >> 6) : (pos & 63);
      const float cs = rope[(idx * 16 + f) * 2], sn = rope[(idx * 16 + f) * 2 + 1];
      v = half == 0 ? x1 * cs - x2 * sn : x1 * sn + x2 * cs;
    }
    p.K()[((size_t)(b * 4 + h) * NKEY + kpos) * 192 + 128 + e] = to_bf16(v);
  }
  {
    const bfraw* Bt = p.wuqT() + (size_t)layer * 768 * 384;
    for (int w = bid; w < 68 * 6; w += gridDim.x) {
      const int n_t = w / 68, m_t = w - n_t * 68;
      const int m0 = m_t * 128, n0 = n_t * 128;
      ARows af{p.Aq(), 384, m0, TTOT};
      BTrans bf{Bt, 384, n0};
      const bool lat = m0 < TLAT;
      const int b = lat ? (m0 >> 12) : ((m0 - TLAT) >> 8);
      const int pos0 = lat ? (m0 & 4095) : ((m0 - TLAT) & 255);
      auto ef = [&](const f32x16 (&acc)[2][2], int wr, int wc, int lane) {
        const int l31 = lane & 31;
#pragma unroll
        for (int j = 0; j < 2; ++j) {
          const int col = n0 + wc * 64 + j * 32;
          const int h = col / 192, d0 = col - h * 192;
          const bool isrope = lat && d0 >= 128;
          const int f = l31 & 15;
#pragma unroll
          for (int i = 0; i < 2; ++i)
#pragma unroll
            for (int r = 0; r < 16; ++r) {
              const int pos = pos0 + ACC_ROW(wr, i, r, lane);
              float v = acc[i][j][r];
              const float pv = __shfl_xor(v, 16);
              if (isrope) {
                const int idx = d0 == 128 ? (pos >> 6) : (pos & 63);
                const float cs = rope[(idx * 16 + f) * 2], sn = rope[(idx * 16 + f) * 2 + 1];
                v = (l31 < 16) ? v * cs - pv * sn : pv * sn + v * cs;
              }
              bfraw* dst = lat ? p.Q() + ((size_t)(b * 4 + h) * SL + pos) * 192 : p.Qc() + ((size_t)(b * 4 + h) * CL + pos) * 192;
              dst[d0 + l31] = to_bf16(v * qscale);
            }
        }
      };
      gemm_tile<2>(af, bf, ef, 384, smem);
    }
  }
  {
    const bfraw* Bt = p.wukvT() + (size_t)layer * 1024 * 128;
    for (int w = bid; w < 68 * 8; w += gridDim.x) {
      const int n_t = w / 68, m_t = w - n_t * 68;
      const int m0 = m_t * 128, n0 = n_t * 128;
      ARows af{p.Akv(), 128, m0, TTOT};
      BTrans bf{Bt, 128, n0};
      const bool lat = m0 < TLAT;
      const int b = lat ? (m0 >> 12) : ((m0 - TLAT) >> 8);
      const int kpos0 = lat ? (m0 & 4095) : SL + ((m0 - TLAT) & 255);
      const int h = n_t >> 1;
      const bool isv = n_t & 1;
      auto ef = [&](const f32x16 (&acc)[2][2], int wr, int wc, int lane) {
        const int l31 = lane & 31, lh = lane >> 5;
        if (!isv) {
#pragma unroll
          for (int i = 0; i < 2; ++i)
#pragma unroll
            for (int j = 0; j < 2; ++j)
#pragma unroll
              for (int r = 0; r < 16; ++r) {
                const int kpos = kpos0 + ACC_ROW(wr, i, r, lane);
                p.K()[((size_t)(b * 4 + h) * NKEY + kpos) * 192 + wc * 64 + j * 32 + l31] = to_bf16(acc[i][j][r]);
              }
        } else {
#pragma unroll
          for (int i = 0; i < 2; ++i)
#pragma unroll
            for (int j = 0; j < 2; ++j) {
              const int d = wc * 64 + j * 32 + l31;
              bfraw* vrow = p.V() + ((size_t)(b * 4 + h) * 128 + d) * NKEY + kpos0 + wr * 64 + i * 32;
#pragma unroll
              for (int s = 0; s < 2; ++s) {
                uint4 t;
                t.x = pack_bf16(acc[i][j][8 * s + 0], acc[i][j][8 * s + 1]); t.y = pack_bf16(acc[i][j][8 * s + 2], acc[i][j][8 * s + 3]);
                t.z = pack_bf16(acc[i][j][8 * s + 4], acc[i][j][8 * s + 5]); t.w = pack_bf16(acc[i][j][8 * s + 6], acc[i][j][8 * s + 7]);
                *(uint4*)(vrow + 16 * s + 8 * lh) = t;
              }
            }
        }
      };
      gemm_tile<2>(af, bf, ef, 128, smem);
    }
  }
}

#define ATT_KROW 400
#define ATT_VROW 144
#define MFMA16(a, b, c) __builtin_amdgcn_mfma_f32_32x32x16_bf16(a, b, c, 0, 0, 0)
__device__ __forceinline__ void attn_item(const bfraw* __restrict__ Qp, const bfraw* __restrict__ Kp, const bfraw* __restrict__ Vtp,
                                          int nk, float* __restrict__ Op, char* smem) {
  char* Ks = smem;
  char* Vs = smem + 64 * ATT_KROW;
  int tid_ = threadIdx.x; asm volatile("" : "+v"(tid_));
  const int tid = tid_, lane = tid & 63, wid = tid >> 6, l31 = lane & 31, lh = lane >> 5;
  bf16x8 qf[12];
  {
    const bfraw* qrow = Qp + (size_t)(wid * 32 + l31) * 192 + lh * 8;
#pragma unroll
    for (int ks = 0; ks < 12; ++ks) qf[ks] = *(const bf16x8*)(qrow + ks * 16);
  }
  f32x16 o[4];
#pragma unroll
  for (int d = 0; d < 4; ++d)
#pragma unroll
    for (int r = 0; r < 16; ++r) o[d][r] = 0.f;
  float m = -INFINITY, l = 0.f;
  uint4 rk0, rk1, rk2, rk3, rk4, rk5, rv0, rv1, rv2, rv3;
#define ATT_KSRC(n, kt) (Kp + (size_t)((kt) + (tid + 256 * (n)) / 24) * 192 + ((tid + 256 * (n)) % 24) * 8)
#define ATT_VSRC(n, kt) (Vtp + (size_t)((tid + 256 * (n)) >> 3) * NKEY + (kt) + ((tid + 256 * (n)) & 7) * 8)
#define ATT_GLOAD(kt)                                                                                        \
  {                                                                                                          \
    rk0 = *(const uint4*)ATT_KSRC(0, kt); rk1 = *(const uint4*)ATT_KSRC(1, kt); rk2 = *(const uint4*)ATT_KSRC(2, kt); \
    rk3 = *(const uint4*)ATT_KSRC(3, kt); rk4 = *(const uint4*)ATT_KSRC(4, kt); rk5 = *(const uint4*)ATT_KSRC(5, kt); \
    rv0 = *(const uint4*)ATT_VSRC(0, kt); rv1 = *(const uint4*)ATT_VSRC(1, kt);                              \
    rv2 = *(const uint4*)ATT_VSRC(2, kt); rv3 = *(const uint4*)ATT_VSRC(3, kt);                              \
  }
#define ATT_KDST(n) (Ks + ((tid + 256 * (n)) / 24) * ATT_KROW + ((tid + 256 * (n)) % 24) * 16)
#define ATT_VDST(n) (Vs + ((tid + 256 * (n)) >> 3) * ATT_VROW + ((tid + 256 * (n)) & 7) * 16)
#define ATT_SWRITE()                                                                                         \
  {                                                                                                          \
    *(uint4*)ATT_KDST(0) = rk0; *(uint4*)ATT_KDST(1) = rk1; *(uint4*)ATT_KDST(2) = rk2;                      \
    *(uint4*)ATT_KDST(3) = rk3; *(uint4*)ATT_KDST(4) = rk4; *(uint4*)ATT_KDST(5) = rk5;                      \
    *(uint4*)ATT_VDST(0) = rv0; *(uint4*)ATT_VDST(1) = rv1; *(uint4*)ATT_VDST(2) = rv2; *(uint4*)ATT_VDST(3) = rv3; \
  }
  __syncthreads();
  ATT_GLOAD(0)
  ATT_SWRITE()
  __syncthreads();
  for (int kt = 0; kt < nk; kt += 64) {
    const bool more = (kt + 64) < nk;
    if (more) ATT_GLOAD(kt + 64)
    f32x16 s0, s1;
#pragma unroll
    for (int r = 0; r < 16; ++r) { s0[r] = 0.f; s1[r] = 0.f; }
    const char* kp = Ks + l31 * ATT_KROW + lh * 16;
#pragma unroll
    for (int ks = 0; ks < 12; ++ks) {
      bf16x8 a0 = *(const bf16x8*)(kp + ks * 32);
      bf16x8 a1 = *(const bf16x8*)(kp + 32 * ATT_KROW + ks * 32);
      s0 = MFMA16(a0, qf[ks], s0);
      s1 = MFMA16(a1, qf[ks], s1);
    }
    float tmax = fmaxf(s0[0], s1[0]);
#pragma unroll
    for (int r = 1; r < 16; ++r) tmax = fmaxf(tmax, fmaxf(s0[r], s1[r]));
    tmax = fmaxf(tmax, __shfl_xor(tmax, 32));
    const float mn = fmaxf(m, tmax);
    const float alpha = __builtin_amdgcn_exp2f(m - mn);
    float rs = 0.f;
#pragma unroll
    for (int r = 0; r < 16; ++r) { s0[r] = __builtin_amdgcn_exp2f(s0[r] - mn); s1[r] = __builtin_amdgcn_exp2f(s1[r] - mn); rs += s0[r] + s1[r]; }
    rs += __shfl_xor(rs, 32);
    l = l * alpha + rs;
    m = mn;
    if (__any(alpha != 1.f)) {
#pragma unroll
      for (int d = 0; d < 4; ++d)
#pragma unroll
        for (int r = 0; r < 16; ++r) o[d][r] *= alpha;
    }
    bf16x8 pf[4];
    {
      uint4 t;
      t.x = pack_bf16(s0[0], s0[1]); t.y = pack_bf16(s0[2], s0[3]); t.z = pack_bf16(s0[4], s0[5]); t.w = pack_bf16(s0[6], s0[7]);
      pf[0] = __builtin_bit_cast(bf16x8, t);
      t.x = pack_bf16(s0[8], s0[9]); t.y = pack_bf16(s0[10], s0[11]); t.z = pack_bf16(s0[12], s0[13]); t.w = pack_bf16(s0[14], s0[15]);
      pf[1] = __builtin_bit_cast(bf16x8, t);
      t.x = pack_bf16(s1[0], s1[1]); t.y = pack_bf16(s1[2], s1[3]); t.z = pack_bf16(s1[4], s1[5]); t.w = pack_bf16(s1[6], s1[7]);
      pf[2] = __builtin_bit_cast(bf16x8, t);
      t.x = pack_bf16(s1[8], s1[9]); t.y = pack_bf16(s1[10], s1[11]); t.z = pack_bf16(s1[12], s1[13]); t.w = pack_bf16(s1[14], s1[15]);
      pf[3] = __builtin_bit_cast(bf16x8, t);
    }
    const char* vp = Vs + l31 * ATT_VROW + lh * 16;
#pragma unroll
    for (int g16 = 0; g16 < 4; ++g16) {
#pragma unroll
      for (int d = 0; d < 4; ++d) {
        bf16x8 a = *(const bf16x8*)(vp + d * 32 * ATT_VROW + g16 * 32);
        o[d] = MFMA16(a, pf[g16], o[d]);
      }
    }
    __syncthreads();
    if (more) ATT_SWRITE()
    __syncthreads();
  }
  const float inv = 1.f / l;
  float* tb = (float*)smem + wid * (32 * 129);
#pragma unroll
  for (int d = 0; d < 4; ++d)
#pragma unroll
    for (int r = 0; r < 16; ++r) tb[l31 * 129 + d * 32 + (r & 3) + 8 * (r >> 2) + 4 * lh] = o[d][r] * inv;
  __syncthreads();
  for (int i = lane; i < 32 * 32; i += 64) {
    const int q = i >> 5, c4 = i & 31;
    const float* s = tb + q * 129 + c4 * 4;
    *(float4*)(Op + (size_t)(wid * 32 + q) * 512 + c4 * 4) = make_float4(s[0], s[1], s[2], s[3]);
  }
  __syncthreads();
}

__device__ __forceinline__ int chunk_row0(int b, int cid) { return cid < 4 ? TLAT + b * CL + cid * 64 : b * SL + (cid - 4) * 64; }
__device__ __forceinline__ int step_of(int cid, int dir) { return dir == 0 ? cid : (cid < 4 ? 3 - cid : 71 - cid); }
__device__ __forceinline__ int cid_of(int s, int dir) { return dir == 0 ? s : (s < 4 ? 3 - s : 71 - s); }
#define MFMA32(a, b, c) __builtin_amdgcn_mfma_f32_32x32x2f32(a, b, c, 0, 0, 0)
#define ROW16(r, lh) (((r) & 3) + 8 * ((r) >> 2) + 4 * (lh))
__device__ __forceinline__ float wave_incl_scan(float v, int lane) {
#pragma unroll
  for (int o = 1; o < 64; o <<= 1) { float t = __shfl_up(v, o); if (lane >= o) v += t; }
  return v;
}

#define SSD_R256 272
#define SSD_R128 144
__device__ __forceinline__ void ssd_local_item(const P& p, int layer, int item, char* smem) {
  const int h = item & 7, cid = (item >> 3) % NSTEP, b = item / (8 * NSTEP);
  char* sBT = smem;
  char* sxf = sBT + 128 * SSD_R128;
  char* sxb = sxf + 64 * SSD_R128;
  float* swf = (float*)(sxb + 64 * SSD_R128);
  float* swb = swf + 64;
  int tid_ = threadIdx.x; asm volatile("" : "+v"(tid_));
  const int tid = tid_, lane = tid & 63, wid = tid >> 6, l31 = lane & 31, lh = lane >> 5;
  const int row0 = chunk_row0(b, cid), g = h >> 2;
  __syncthreads();
  if (wid < 2) {
    const int dir = wid;
    const float A = -__expf(p.a_log[layer * 16 + dir * 8 + h]);
    const int q = dir ? 63 - lane : lane;
    const float dt = p.ssd_dt()[(size_t)(row0 + q) * 16 + dir * 8 + h];
    const float ac = wave_incl_scan(dt * A, lane);
    const float tot = __shfl(ac, 63);
    (dir ? swb : swf)[q] = __expf(tot - ac) * dt;
    if (lane == 0) p.ssd_atot()[((b * 2 + dir) * 8 + h) * NSTEP + step_of(cid, dir)] = tot;
  }
#pragma unroll
  for (int u = 0; u < 8; ++u) {
    const int i = tid + 256 * u, q = i >> 5, c4 = i & 31;
    const float4 v = *(const float4*)(p.ssd_B() + (size_t)(row0 + q) * 256 + g * 128 + c4 * 4);
    *(bfraw*)(sBT + (c4 * 4 + 0) * SSD_R128 + q * 2) = to_bf16(v.x);
    *(bfraw*)(sBT + (c4 * 4 + 1) * SSD_R128 + q * 2) = to_bf16(v.y);
    *(bfraw*)(sBT + (c4 * 4 + 2) * SSD_R128 + q * 2) = to_bf16(v.z);
    *(bfraw*)(sBT + (c4 * 4 + 3) * SSD_R128 + q * 2) = to_bf16(v.w);
  }
  __syncthreads();
#pragma unroll
  for (int u = 0; u < 4; ++u) {
    const int i = tid + 256 * u, q = i >> 4, c4 = i & 15;
    const float4 v = *(const float4*)(p.ssd_xs() + (size_t)(row0 + q) * 512 + h * 64 + c4 * 4);
    const float wf = swf[q], wb = swb[q];
    *(bfraw*)(sxf + (c4 * 4 + 0) * SSD_R128 + q * 2) = to_bf16(v.x * wf); *(bfraw*)(sxb + (c4 * 4 + 0) * SSD_R128 + q * 2) = to_bf16(v.x * wb);
    *(bfraw*)(sxf + (c4 * 4 + 1) * SSD_R128 + q * 2) = to_bf16(v.y * wf); *(bfraw*)(sxb + (c4 * 4 + 1) * SSD_R128 + q * 2) = to_bf16(v.y * wb);
    *(bfraw*)(sxf + (c4 * 4 + 2) * SSD_R128 + q * 2) = to_bf16(v.z * wf); *(bfraw*)(sxb + (c4 * 4 + 2) * SSD_R128 + q * 2) = to_bf16(v.z * wb);
    *(bfraw*)(sxf + (c4 * 4 + 3) * SSD_R128 + q * 2) = to_bf16(v.w * wf); *(bfraw*)(sxb + (c4 * 4 + 3) * SSD_R128 + q * 2) = to_bf16(v.w * wb);
  }
  __syncthreads();
  f32x16 acc[2][2];
#pragma unroll
  for (int d = 0; d < 2; ++d)
#pragma unroll
    for (int t = 0; t < 2; ++t)
#pragma unroll
      for (int r = 0; r < 16; ++r) acc[d][t][r] = 0.f;
  const int pi = wid & 1, jj = wid >> 1;
  {
    const char* af = sxf + (pi * 32 + l31) * SSD_R128 + lh * 16;
    const char* ab = sxb + (pi * 32 + l31) * SSD_R128 + lh * 16;
    const char* bp = sBT + ((2 * jj) * 32 + l31) * SSD_R128 + lh * 16;
#pragma unroll
    for (int ks = 0; ks < 4; ++ks) {
      const bf16x8 a0 = *(const bf16x8*)(af + ks * 32), a1 = *(const bf16x8*)(ab + ks * 32);
      const bf16x8 b0 = *(const bf16x8*)(bp + ks * 32), b1 = *(const bf16x8*)(bp + 32 * SSD_R128 + ks * 32);
      acc[0][0] = MFMA16(a0, b0, acc[0][0]); acc[0][1] = MFMA16(a0, b1, acc[0][1]);
      acc[1][0] = MFMA16(a1, b0, acc[1][0]); acc[1][1] = MFMA16(a1, b1, acc[1][1]);
    }
  }
#pragma unroll
  for (int d = 0; d < 2; ++d) {
    bfraw* dst = p.ssd_st() + ((size_t)((b * 2 + d) * 8 + h) * NSTEP + step_of(cid, d)) * 8192;
#pragma unroll
    for (int t = 0; t < 2; ++t)
#pragma unroll
      for (int r = 0; r < 16; ++r) dst[(pi * 32 + ROW16(r, lh)) * 128 + (2 * jj + t) * 32 + l31] = to_bf16(acc[d][t][r]);
  }
}

__device__ __forceinline__ void ssd_out_item(const P& p, int layer, int item, char* smem) {
  const int h = item & 7, cid = (item >> 3) % NSTEP, b = item / (8 * NSTEP);
  char* sC = smem;
  char* sB = sC + 64 * SSD_R256;
  char* sxT = sB + 64 * SSD_R256;
  char* sP = sxT + 64 * SSD_R128;
  float* saf = (float*)(sP + 64 * SSD_R128);
  float* sab = saf + 64;
  float* sdf = sab + 64;
  float* sdb = sdf + 64;
  int tid_ = threadIdx.x; asm volatile("" : "+v"(tid_));
  const int tid = tid_, lane = tid & 63, wid = tid >> 6, l31 = lane & 31, lh = lane >> 5;
  const int row0 = chunk_row0(b, cid), g = h >> 2;
  const bfraw* hf = p.ssd_st() + ((size_t)((b * 2 + 0) * 8 + h) * NSTEP + step_of(cid, 0)) * 8192;
  const bfraw* hb = p.ssd_st() + ((size_t)((b * 2 + 1) * 8 + h) * NSTEP + step_of(cid, 1)) * 8192;
  u32x4g hreg[4];
#pragma unroll
  for (int u = 0; u < 4; ++u) { const int i = tid + 256 * u; hreg[u] = *(const u32x4g*)(hf + (i >> 4) * 128 + (i & 15) * 8); }
  __syncthreads();
#pragma unroll
  for (int u = 0; u < 4; ++u) {
    const int i = tid + 256 * u, q = i >> 4, c8 = i & 15;
    const float* cs = p.ssd_C() + (size_t)(row0 + q) * 256 + g * 128 + c8 * 8;
    const float* bs = p.ssd_B() + (size_t)(row0 + q) * 256 + g * 128 + c8 * 8;
    const float4 c0 = *(const float4*)cs, c1 = *(const float4*)(cs + 4), b0 = *(const float4*)bs, b1 = *(const float4*)(bs + 4);
    uint4 t;
    t.x = pack_bf16(c0.x, c0.y); t.y = pack_bf16(c0.z, c0.w); t.z = pack_bf16(c1.x, c1.y); t.w = pack_bf16(c1.z, c1.w);
    *(uint4*)(sC + q * SSD_R256 + c8 * 16) = t;
    t.x = pack_bf16(b0.x, b0.y); t.y = pack_bf16(b0.z, b0.w); t.z = pack_bf16(b1.x, b1.y); t.w = pack_bf16(b1.z, b1.w);
    *(uint4*)(sB + q * SSD_R256 + c8 * 16) = t;
  }
#pragma unroll
  for (int u = 0; u < 4; ++u) {
    const int i = tid + 256 * u, j = i >> 4, c4 = i & 15;
    const float4 xv = *(const float4*)(p.ssd_xs() + (size_t)(row0 + j) * 512 + h * 64 + c4 * 4);
    *(bfraw*)(sxT + (c4 * 4 + 0) * SSD_R128 + j * 2) = to_bf16(xv.x);
    *(bfraw*)(sxT + (c4 * 4 + 1) * SSD_R128 + j * 2) = to_bf16(xv.y);
    *(bfraw*)(sxT + (c4 * 4 + 2) * SSD_R128 + j * 2) = to_bf16(xv.z);
    *(bfraw*)(sxT + (c4 * 4 + 3) * SSD_R128 + j * 2) = to_bf16(xv.w);
  }
  if (wid < 2) {
    const int dir = wid;
    const float A = -__expf(p.a_log[layer * 16 + dir * 8 + h]);
    const int q = dir ? 63 - lane : lane;
    const float dt = p.ssd_dt()[(size_t)(row0 + q) * 16 + dir * 8 + h];
    const float ac = wave_incl_scan(dt * A, lane);
    (dir ? sab : saf)[q] = ac;
    (dir ? sdb : sdf)[q] = dt;
  }
  __syncthreads();
  const int it = wid >> 1, jt = wid & 1;
  {
    f32x16 sa;
#pragma unroll
    for (int r = 0; r < 16; ++r) sa[r] = 0.f;
    const char* ap = sC + (it * 32 + l31) * SSD_R256 + lh * 16;
    const char* bp = sB + (jt * 32 + l31) * SSD_R256 + lh * 16;
#pragma unroll
    for (int ks = 0; ks < 8; ++ks) sa = MFMA16(*(const bf16x8*)(ap + ks * 32), *(const bf16x8*)(bp + ks * 32), sa);
    const int j = jt * 32 + l31;
    const float afj = saf[j], abj = sab[j], dfj = sdf[j], dbj = sdb[j];
#pragma unroll
    for (int r = 0; r < 16; ++r) {
      const int i = it * 32 + ROW16(r, lh);
      float wgt = 0.f;
      if (j <= i) wgt += __expf(saf[i] - afj) * dfj;
      if (j >= i) wgt += __expf(sab[i] - abj) * dbj;
      *(bfraw*)(sP + i * SSD_R128 + j * 2) = to_bf16(sa[r] * wgt);
    }
  }
  __syncthreads();
#pragma unroll
  for (int u = 0; u < 4; ++u) { const int i = tid + 256 * u; *(u32x4g*)(sB + (i >> 4) * SSD_R256 + (i & 15) * 16) = hreg[u]; }
#pragma unroll
  for (int u = 0; u < 4; ++u) { const int i = tid + 256 * u; hreg[u] = *(const u32x4g*)(hb + (i >> 4) * 128 + (i & 15) * 8); }
  const int pt = wid & 1;
  f32x16 ya, gf, gb;
#pragma unroll
  for (int r = 0; r < 16; ++r) { ya[r] = 0.f; gf[r] = 0.f; gb[r] = 0.f; }
  {
    const char* ap = sP + (it * 32 + l31) * SSD_R128 + lh * 16;
    const char* bp = sxT + (pt * 32 + l31) * SSD_R128 + lh * 16;
#pragma unroll
    for (int ks = 0; ks < 4; ++ks) ya = MFMA16(*(const bf16x8*)(ap + ks * 32), *(const bf16x8*)(bp + ks * 32), ya);
  }
  __syncthreads();
  {
    const char* ap = sC + (it * 32 + l31) * SSD_R256 + lh * 16;
    const char* bp = sB + (pt * 32 + l31) * SSD_R256 + lh * 16;
#pragma unroll
    for (int ks = 0; ks < 8; ++ks) gf = MFMA16(*(const bf16x8*)(ap + ks * 32), *(const bf16x8*)(bp + ks * 32), gf);
  }
  __syncthreads();
#pragma unroll
  for (int u = 0; u < 4; ++u) { const int i = tid + 256 * u; *(u32x4g*)(sB + (i >> 4) * SSD_R256 + (i & 15) * 16) = hreg[u]; }
  __syncthreads();
  {
    const char* ap = sC + (it * 32 + l31) * SSD_R256 + lh * 16;
    const char* bp = sB + (pt * 32 + l31) * SSD_R256 + lh * 16;
#pragma unroll
    for (int ks = 0; ks < 8; ++ks) gb = MFMA16(*(const bf16x8*)(ap + ks * 32), *(const bf16x8*)(bp + ks * 32), gb);
  }
#pragma unroll
  for (int r = 0; r < 16; ++r) {
    const int i = it * 32 + ROW16(r, lh);
    p.ssd_y()[(size_t)(row0 + i) * 512 + h * 64 + pt * 32 + l31] = ya[r] + __expf(saf[i]) * gf[r] + __expf(sab[i]) * gb[r];
  }
}

__device__ __forceinline__ void ml_gates(const P& p, int layer, int row0, int h, int dir, int lane, float& bcum, float& li, float& tot) {
  const int j = dir ? 63 - lane : lane;
  const float* z = p.Z() + (size_t)(row0 + j) * NIN + ZC_MG + dir * 8;
  li = z[h] + p.gate_b[layer * 16 + dir * 8 + h];
  const float gf = z[4 + h] + p.gate_b[layer * 16 + dir * 8 + 4 + h];
  const float lf = gf >= 0.f ? -log1pf(expf(-gf)) : gf - log1pf(expf(gf));
  bcum = wave_incl_scan(lf, lane);
  tot = __shfl(bcum, 63);
}
__device__ __forceinline__ void ml_local_item(const P& p, int layer, int item, char* smem) {
  const int h = item & 3, cid = (item >> 2) % NSTEP, b = item / (4 * NSTEP);
  char* svf = smem;
  char* svb = svf + 128 * SSD_R128;
  char* skT = svb + 128 * SSD_R128;
  float* swf = (float*)(skT + 64 * SSD_R128);
  float* swb = swf + 64;
  int tid_ = threadIdx.x; asm volatile("" : "+v"(tid_));
  const int tid = tid_, lane = tid & 63, wid = tid >> 6, l31 = lane & 31, lh = lane >> 5;
  const int row0 = chunk_row0(b, cid);
  __syncthreads();
  if (wid < 2) {
    const int dir = wid;
    float bc, li, tot;
    ml_gates(p, layer, row0, h, dir, lane, bc, li, tot);
    const int j = dir ? 63 - lane : lane;
    (dir ? swb : swf)[j] = __expf(tot - bc + li);
    if (lane == 0) p.ml_gtot()[((b * 2 + dir) * 4 + h) * NSTEP + step_of(cid, dir)] = tot;
  }
#pragma unroll
  for (int u = 0; u < 4; ++u) {
    const int i = tid + 256 * u, j = i >> 4, c4 = i & 15;
    const float4 v = *(const float4*)(p.Z() + (size_t)(row0 + j) * NIN + ZC_MK + h * 64 + c4 * 4);
    *(bfraw*)(skT + (c4 * 4 + 0) * SSD_R128 + j * 2) = to_bf16(v.x);
    *(bfraw*)(skT + (c4 * 4 + 1) * SSD_R128 + j * 2) = to_bf16(v.y);
    *(bfraw*)(skT + (c4 * 4 + 2) * SSD_R128 + j * 2) = to_bf16(v.z);
    *(bfraw*)(skT + (c4 * 4 + 3) * SSD_R128 + j * 2) = to_bf16(v.w);
  }
  __syncthreads();
#pragma unroll
  for (int u = 0; u < 8; ++u) {
    const int i = tid + 256 * u, j = i >> 5, c4 = i & 31;
    const float4 v = *(const float4*)(p.Z() + (size_t)(row0 + j) * NIN + ZC_MV + h * 128 + c4 * 4);
    const float wf = swf[j], wb = swb[j];
    *(bfraw*)(svf + (c4 * 4 + 0) * SSD_R128 + j * 2) = to_bf16(v.x * wf); *(bfraw*)(svb + (c4 * 4 + 0) * SSD_R128 + j * 2) = to_bf16(v.x * wb);
    *(bfraw*)(svf + (c4 * 4 + 1) * SSD_R128 + j * 2) = to_bf16(v.y * wf); *(bfraw*)(svb + (c4 * 4 + 1) * SSD_R128 + j * 2) = to_bf16(v.y * wb);
    *(bfraw*)(svf + (c4 * 4 + 2) * SSD_R128 + j * 2) = to_bf16(v.z * wf); *(bfraw*)(svb + (c4 * 4 + 2) * SSD_R128 + j * 2) = to_bf16(v.z * wb);
    *(bfraw*)(svf + (c4 * 4 + 3) * SSD_R128 + j * 2) = to_bf16(v.w * wf); *(bfraw*)(svb + (c4 * 4 + 3) * SSD_R128 + j * 2) = to_bf16(v.w * wb);
  }
  __syncthreads();
  f32x16 acc[2][2];
#pragma unroll
  for (int d = 0; d < 2; ++d)
#pragma unroll
    for (int t = 0; t < 2; ++t)
#pragma unroll
      for (int r = 0; r < 16; ++r) acc[d][t][r] = 0.f;
  const int vt = wid;
  {
    const char* af = svf + (vt * 32 + l31) * SSD_R128 + lh * 16;
    const char* ab = svb + (vt * 32 + l31) * SSD_R128 + lh * 16;
    const char* bp = skT + l31 * SSD_R128 + lh * 16;
#pragma unroll
    for (int ks = 0; ks < 4; ++ks) {
      const bf16x8 a0 = *(const bf16x8*)(af + ks * 32), a1 = *(const bf16x8*)(ab + ks * 32);
      const bf16x8 b0 = *(const bf16x8*)(bp + ks * 32), b1 = *(const bf16x8*)(bp + 32 * SSD_R128 + ks * 32);
      acc[0][0] = MFMA16(a0, b0, acc[0][0]); acc[0][1] = MFMA16(a0, b1, acc[0][1]);
      acc[1][0] = MFMA16(a1, b0, acc[1][0]); acc[1][1] = MFMA16(a1, b1, acc[1][1]);
    }
  }
#pragma unroll
  for (int d = 0; d < 2; ++d) {
    bfraw* dst = p.ml_st() + ((size_t)((b * 2 + d) * 4 + h) * NSTEP + step_of(cid, d)) * 8192;
#pragma unroll
    for (int t = 0; t < 2; ++t)
#pragma unroll
      for (int r = 0; r < 16; ++r) dst[(vt * 32 + ROW16(r, lh)) * 64 + t * 32 + l31] = to_bf16(acc[d][t][r]);
  }
  if (tid < 128) {
    const int d = tid >> 6, kk = tid & 63;
    const float* w = d ? swb : swf;
    const char* kr = skT + kk * SSD_R128;
    float sacc = 0.f;
    for (int j = 0; j < 64; ++j) sacc += w[j] * from_bf16(*(const bfraw*)(kr + j * 2));
    p.ml_nst()[((size_t)((b * 2 + d) * 4 + h) * NSTEP + step_of(cid, d)) * 64 + kk] = sacc;
  }
}

__device__ __forceinline__ void ml_out_item(const P& p, int layer, int item, char* smem) {
  const int h = item & 3, cid = (item >> 2) % NSTEP, b = item / (4 * NSTEP);
  char* sq = smem;
  char* sk = sq + 64 * SSD_R128;
  char* svT = sk + 64 * SSD_R128;
  char* sPf = svT + 128 * SSD_R128;
  char* sPb = sPf + 64 * SSD_R128;
  char* sCs = sPb + 64 * SSD_R128;
  float* sbf = (float*)(sCs + 128 * SSD_R128);
  float* sbb = sbf + 64;
  float* slf = sbb + 64;
  float* slb = slf + 64;
  float* sdenf = slb + 64;
  float* sdenb = sdenf + 64;
  float* snf = sdenb + 64;
  float* snb = snf + 64;
  int tid_ = threadIdx.x; asm volatile("" : "+v"(tid_));
  const int tid = tid_, lane = tid & 63, wid = tid >> 6, l31 = lane & 31, lh = lane >> 5;
  const int row0 = chunk_row0(b, cid);
  const size_t slotf = ((size_t)((b * 2 + 0) * 4 + h) * NSTEP + step_of(cid, 0));
  const size_t slotb = ((size_t)((b * 2 + 1) * 4 + h) * NSTEP + step_of(cid, 1));
  const bfraw* csf = p.ml_st() + slotf * 8192;
  const bfraw* csb = p.ml_st() + slotb * 8192;
  u32x4g creg[4];
#pragma unroll
  for (int u = 0; u < 4; ++u) { const int i = tid + 256 * u; creg[u] = *(const u32x4g*)(csf + (i >> 3) * 64 + (i & 7) * 8); }
  __syncthreads();
#pragma unroll
  for (int u = 0; u < 4; ++u) {
    const int i = tid + 256 * u, j = i >> 4, c4 = i & 15;
    const float4 kv = *(const float4*)(p.Z() + (size_t)(row0 + j) * NIN + ZC_MK + h * 64 + c4 * 4);
    const float4 qv = *(const float4*)(p.Z() + (size_t)(row0 + j) * NIN + ZC_MQ + h * 64 + c4 * 4);
    uint2 t;
    t.x = pack_bf16(kv.x, kv.y); t.y = pack_bf16(kv.z, kv.w);
    *(uint2*)(sk + j * SSD_R128 + c4 * 8) = t;
    t.x = pack_bf16(qv.x * 0.125f, qv.y * 0.125f); t.y = pack_bf16(qv.z * 0.125f, qv.w * 0.125f);
    *(uint2*)(sq + j * SSD_R128 + c4 * 8) = t;
  }
#pragma unroll
  for (int u = 0; u < 8; ++u) {
    const int i = tid + 256 * u, j = i >> 5, c4 = i & 31;
    const float4 vv = *(const float4*)(p.Z() + (size_t)(row0 + j) * NIN + ZC_MV + h * 128 + c4 * 4);
    *(bfraw*)(svT + (c4 * 4 + 0) * SSD_R128 + j * 2) = to_bf16(vv.x);
    *(bfraw*)(svT + (c4 * 4 + 1) * SSD_R128 + j * 2) = to_bf16(vv.y);
    *(bfraw*)(svT + (c4 * 4 + 2) * SSD_R128 + j * 2) = to_bf16(vv.z);
    *(bfraw*)(svT + (c4 * 4 + 3) * SSD_R128 + j * 2) = to_bf16(vv.w);
  }
#pragma unroll
  for (int u = 0; u < 4; ++u) { const int i = tid + 256 * u; *(u32x4g*)(sCs + (i >> 3) * SSD_R128 + (i & 7) * 16) = creg[u]; }
#pragma unroll
  for (int u = 0; u < 4; ++u) { const int i = tid + 256 * u; creg[u] = *(const u32x4g*)(csb + (i >> 3) * 64 + (i & 7) * 8); }
  if (wid < 2) {
    const int dir = wid;
    float bc, li, tot;
    ml_gates(p, layer, row0, h, dir, lane, bc, li, tot);
    const int j = dir ? 63 - lane : lane;
    (dir ? sbb : sbf)[j] = bc;
    (dir ? slb : slf)[j] = li;
    (dir ? snb : snf)[lane] = p.ml_nst()[(dir ? slotb : slotf) * 64 + lane];
  }
  __syncthreads();
  const int it = wid >> 1, jt = wid & 1;
  {
    f32x16 sa;
#pragma unroll
    for (int r = 0; r < 16; ++r) sa[r] = 0.f;
    const char* ap = sq + (it * 32 + l31) * SSD_R128 + lh * 16;
    const char* bp = sk + (jt * 32 + l31) * SSD_R128 + lh * 16;
#pragma unroll
    for (int ks = 0; ks < 4; ++ks) sa = MFMA16(*(const bf16x8*)(ap + ks * 32), *(const bf16x8*)(bp + ks * 32), sa);
    const int j = jt * 32 + l31;
    const float bfj = sbf[j], bbj = sbb[j], lfj = slf[j], lbj = slb[j];
#pragma unroll
    for (int r = 0; r < 16; ++r) {
      const int i = it * 32 + ROW16(r, lh);
      *(bfraw*)(sPf + i * SSD_R128 + j * 2) = to_bf16(j <= i ? sa[r] * __expf(sbf[i] - bfj + lfj) : 0.f);
      *(bfraw*)(sPb + i * SSD_R128 + j * 2) = to_bf16(j >= i ? sa[r] * __expf(sbb[i] - bbj + lbj) : 0.f);
    }
  }
  __syncthreads();
  if (tid < 128) {
    const int d = tid >> 6, i = tid & 63;
    const char* Pm = (d ? sPb : sPf) + i * SSD_R128;
    const char* qr = sq + i * SSD_R128;
    const float* ns = d ? snb : snf;
    float rs = 0.f, qn = 0.f;
    for (int j = 0; j < 64; ++j) { rs += from_bf16(*(const bfraw*)(Pm + j * 2)); qn += from_bf16(*(const bfraw*)(qr + j * 2)) * ns[j]; }
    (d ? sdenb : sdenf)[i] = rs + __expf((d ? sbb : sbf)[i]) * qn;
  }
  const int v0 = 2 * (wid & 1);
  f32x16 nf[2], nb[2], gf[2], gb[2];
#pragma unroll
  for (int t = 0; t < 2; ++t)
#pragma unroll
    for (int r = 0; r < 16; ++r) { nf[t][r] = 0.f; nb[t][r] = 0.f; gf[t][r] = 0.f; gb[t][r] = 0.f; }
  {
    const char* apf = sPf + (it * 32 + l31) * SSD_R128 + lh * 16;
    const char* apb = sPb + (it * 32 + l31) * SSD_R128 + lh * 16;
    const char* aq = sq + (it * 32 + l31) * SSD_R128 + lh * 16;
    const char* bv = svT + (v0 * 32 + l31) * SSD_R128 + lh * 16;
    const char* bc = sCs + (v0 * 32 + l31) * SSD_R128 + lh * 16;
#pragma unroll
    for (int ks = 0; ks < 4; ++ks) {
      const bf16x8 af = *(const bf16x8*)(apf + ks * 32), ab = *(const bf16x8*)(apb + ks * 32), qa = *(const bf16x8*)(aq + ks * 32);
      const bf16x8 b0 = *(const bf16x8*)(bv + ks * 32), b1 = *(const bf16x8*)(bv + 32 * SSD_R128 + ks * 32);
      const bf16x8 c0 = *(const bf16x8*)(bc + ks * 32), c1 = *(const bf16x8*)(bc + 32 * SSD_R128 + ks * 32);
      nf[0] = MFMA16(af, b0, nf[0]); nf[1] = MFMA16(af, b1, nf[1]);
      nb[0] = MFMA16(ab, b0, nb[0]); nb[1] = MFMA16(ab, b1, nb[1]);
      gf[0] = MFMA16(qa, c0, gf[0]); gf[1] = MFMA16(qa, c1, gf[1]);
    }
  }
  __syncthreads();
#pragma unroll
  for (int u = 0; u < 4; ++u) { const int i = tid + 256 * u; *(u32x4g*)(sCs + (i >> 3) * SSD_R128 + (i & 7) * 16) = creg[u]; }
  __syncthreads();
  {
    const char* aq = sq + (it * 32 + l31) * SSD_R128 + lh * 16;
    const char* bc = sCs + (v0 * 32 + l31) * SSD_R128 + lh * 16;
#pragma unroll
    for (int ks = 0; ks < 4; ++ks) {
      const bf16x8 qa = *(const bf16x8*)(aq + ks * 32);
      gb[0] = MFMA16(qa, *(const bf16x8*)(bc + ks * 32), gb[0]);
      gb[1] = MFMA16(qa, *(const bf16x8*)(bc + 32 * SSD_R128 + ks * 32), gb[1]);
    }
  }
#pragma unroll
  for (int r = 0; r < 16; ++r) {
    const int i = it * 32 + ROW16(r, lh);
    const float ef = __expf(sbf[i]), eb = __expf(sbb[i]);
    const float idf = 1.f / fmaxf(fabsf(sdenf[i]), 1.f), idb = 1.f / fmaxf(fabsf(sdenb[i]), 1.f);
#pragma unroll
    for (int t = 0; t < 2; ++t)
      p.ml_h()[(size_t)(row0 + i) * 512 + h * 128 + (v0 + t) * 32 + l31] = (nf[t][r] + ef * gf[t][r]) * idf + (nb[t][r] + eb * gb[t][r]) * idb;
  }
}

__device__ __forceinline__ float gelu_tanh(float x) {
  const float k0 = 0.7978845608028654f;
  return 0.5f * x * (1.f + tanhf(k0 * (x + 0.044715f * x * x * x)));
}
__device__ __forceinline__ void s5_drive(const P& p, int dg, int row0, int dir, int g, int lane, float (&sre)[64], float (&sim)[64]) {
  const int l31 = lane & 31, lh = lane >> 5;
  bf16x8 ua[2];
#pragma unroll
  for (int tt = 0; tt < 2; ++tt) {
    const int tp = 32 * tt + l31;
    const int row = dir ? row0 + 63 - tp : row0 + tp;
    const float* zp = p.Z() + (size_t)row * NIN + ZC_U + g * 16 + 8 * lh;
    const float4 a = *(const float4*)zp, b = *(const float4*)(zp + 4);
    uint4 t; t.x = pack_bf16(a.x, a.y); t.y = pack_bf16(a.z, a.w); t.z = pack_bf16(b.x, b.y); t.w = pack_bf16(b.z, b.w);
    ua[tt] = __builtin_bit_cast(bf16x8, t);
  }
  bf16x8 bfr[4];
#pragma unroll
  for (int pt = 0; pt < 4; ++pt) bfr[pt] = *(const bf16x8*)(p.s5_bbh() + ((size_t)dg * 128 + 32 * pt + l31) * 16 + 8 * lh);
  f32x16 d[2][4];
#pragma unroll
  for (int tt = 0; tt < 2; ++tt)
#pragma unroll
    for (int pt = 0; pt < 4; ++pt) {
      f32x16 z;
#pragma unroll
      for (int r = 0; r < 16; ++r) z[r] = 0.f;
      d[tt][pt] = __builtin_amdgcn_mfma_f32_32x32x16_bf16(ua[tt], bfr[pt], z, 0, 0, 0);
    }
#pragma unroll
  for (int tt = 0; tt < 2; ++tt)
#pragma unroll
    for (int r = 0; r < 16; ++r) {
      const float myre = lh ? d[tt][1][r] : d[tt][0][r];
      const float myim = lh ? d[tt][3][r] : d[tt][2][r];
      const float gre = lh ? d[tt][0][r] : d[tt][1][r];
      const float gim = lh ? d[tt][2][r] : d[tt][3][r];
      const float ore = __shfl_xor(gre, 32), oim = __shfl_xor(gim, 32);
      const int tb = 32 * tt + 8 * (r >> 2) + (r & 3);
      sre[tb] = lh ? ore : myre; sre[tb + 4] = lh ? myre : ore;
      sim[tb] = lh ? oim : myim; sim[tb + 4] = lh ? myim : oim;
    }
}

__device__ __forceinline__ void s5_local_item(const P& p, int layer, int witem, char* smem) {
  int tid_ = threadIdx.x; asm volatile("" : "+v"(tid_));
  const int lane = tid_ & 63;
  const int g = witem & 31, st = (witem >> 5) % NSTEP, dir = (witem / (32 * NSTEP)) & 1, b = witem / (64 * NSTEP);
  const int cid = cid_of(st, dir), row0 = chunk_row0(b, cid);
  const int dg = (layer * 2 + dir) * 32 + g;
  float sre[64], sim[64];
  s5_drive(p, dg, row0, dir, g, lane, sre, sim);
  const float ar = p.s5_a()[(dg * 64 + lane) * 2], ai = p.s5_a()[(dg * 64 + lane) * 2 + 1];
  float xr = 0.f, xi = 0.f;
#pragma unroll
  for (int t = 0; t < 64; ++t) {
    const float nr = ar * xr - ai * xi + sre[t];
    const float ni = ar * xi + ai * xr + sim[t];
    xr = nr; xi = ni;
  }
  const size_t slot = ((size_t)((b * 2 + dir) * 32 + g) * NSTEP + st);
  p.s5_st()[(slot * 64 + lane) * 2] = xr; p.s5_st()[(slot * 64 + lane) * 2 + 1] = xi;
}

#define S5_XROW 272
__device__ __forceinline__ void s5_out_item(const P& p, int layer, int witem, char* smem) {
  int tid_ = threadIdx.x; asm volatile("" : "+v"(tid_));
  const int lane = tid_ & 63, wid = tid_ >> 6, l31 = lane & 31, lh = lane >> 5;
  char* sX = smem + wid * (64 * S5_XROW);
  const int g = witem & 31, cid = (witem >> 5) % NSTEP, b = witem / (32 * NSTEP);
  const int row0 = chunk_row0(b, cid);
  bf16x8 cfr[8];
#pragma unroll
  for (int ks = 0; ks < 8; ++ks) cfr[ks] = *(const bf16x8*)(p.s5_cmh() + ((size_t)(layer * 32 + g) * 32 + l31) * 128 + 16 * ks + 8 * lh);
  f32x16 yf[2], yb[2];
#pragma unroll 1
  for (int dir = 0; dir < 2; ++dir) {
    const int st = step_of(cid, dir);
    const int dg = (layer * 2 + dir) * 32 + g;
    const size_t slot = ((size_t)((b * 2 + dir) * 32 + g) * NSTEP + st);
    float sre[64], sim[64];
    s5_drive(p, dg, row0, dir, g, lane, sre, sim);
    const float ar = p.s5_a()[(dg * 64 + lane) * 2], ai = p.s5_a()[(dg * 64 + lane) * 2 + 1];
    float xr = p.s5_st()[(slot * 64 + lane) * 2], xi = p.s5_st()[(slot * 64 + lane) * 2 + 1];
#pragma unroll
    for (int t = 0; t < 64; ++t) {
      const float nr = ar * xr - ai * xi + sre[t];
      const float ni = ar * xi + ai * xr + sim[t];
      xr = nr; xi = ni;
      *(bfraw*)(sX + t * S5_XROW + lane * 2) = to_bf16(xr);
      *(bfraw*)(sX + t * S5_XROW + 128 + lane * 2) = to_bf16(xi);
    }
    f32x16 y0, y1;
#pragma unroll
    for (int r = 0; r < 16; ++r) { y0[r] = 0.f; y1[r] = 0.f; }
    const char* ap = sX + l31 * S5_XROW + lh * 16;
#pragma unroll
    for (int ks = 0; ks < 8; ++ks) {
      const bf16x8 a0 = *(const bf16x8*)(ap + ks * 32);
      const bf16x8 a1 = *(const bf16x8*)(ap + 32 * S5_XROW + ks * 32);
      y0 = __builtin_amdgcn_mfma_f32_32x32x16_bf16(a0, cfr[ks], y0, 0, 0, 0);
      y1 = __builtin_amdgcn_mfma_f32_32x32x16_bf16(a1, cfr[ks], y1, 0, 0, 0);
    }
    if (dir == 0) { yf[0] = y0; yf[1] = y1; } else { yb[0] = y0; yb[1] = y1; }
  }
  const float dsk = p.s5_d[layer * 512 + g * 16 + (l31 & 15)];
#pragma unroll
  for (int tt = 0; tt < 2; ++tt)
#pragma unroll
    for (int r = 0; r < 16; ++r) {
      const float ybv = __shfl_xor(yb[1 - tt][15 - r], 32);
      if (l31 < 16) {
        const int t = 32 * tt + ROW16(r, lh);
        const float u = p.Z()[(size_t)(row0 + t) * NIN + ZC_U + g * 16 + l31];
        const float gy = gelu_tanh(yf[tt][r] + ybv + dsk * u);
        const size_t o = (size_t)(row0 + t) * 512 + g * 16 + l31;
        p.ydpre()[o] = gy;
        p.ydpre_bf()[o] = to_bf16(gy);
      }
    }
}

#define N_SSD_CH (2 * NSTEP * 8)
#define N_ML_CH (2 * NSTEP * 4)
#define N_S5_BLK (2 * 2 * NSTEP * 32 / 4)
__device__ __forceinline__ void ph_mixA(const P& p, int layer, int bid, char* smem) {
  for (int w = bid; w < N_SSD_CH + N_ML_CH + N_S5_BLK; w += gridDim.x) {
    if (w < N_SSD_CH) ssd_local_item(p, layer, w, smem);
    else if (w < N_SSD_CH + N_ML_CH) ml_local_item(p, layer, w - N_SSD_CH, smem);
    else { __syncthreads(); s5_local_item(p, layer, (w - N_SSD_CH - N_ML_CH) * 4 + (threadIdx.x >> 6), smem); }
  }
}
#define N_ATT_LAT 256
#define N_ATT_CTX 16
__device__ __forceinline__ void ph_scan(const P& p, int layer, int bid, char* smem) {
  const int nitems = 256 + 128 + 4 + 32;
  const int tid = threadIdx.x;
  for (int w = bid; w < nitems; w += gridDim.x) {
    int it = w;
    if (it < 256) {
      const int idx = it * 256 + tid, seq = idx >> 11, off = idx & 2047;
      uint2* base = (uint2*)(p.ssd_st() + (size_t)seq * NSTEP * 8192) + off;
      const float* at = p.ssd_atot() + seq * NSTEP;
      float4 hh = make_float4(0.f, 0.f, 0.f, 0.f);
#pragma unroll 4
      for (int s2 = 0; s2 < NSTEP; ++s2) {
        const uint2 tb = base[(size_t)s2 * 2048];
        uint2 ob; ob.x = pack_bf16(hh.x, hh.y); ob.y = pack_bf16(hh.z, hh.w);
        base[(size_t)s2 * 2048] = ob;
        const float e = expf(at[s2]);
        hh.x = e * hh.x + __uint_as_float(tb.x << 16); hh.y = e * hh.y + __uint_as_float(tb.x & 0xffff0000u);
        hh.z = e * hh.z + __uint_as_float(tb.y << 16); hh.w = e * hh.w + __uint_as_float(tb.y & 0xffff0000u);
      }
      continue;
    }
    it -= 256;
    if (it < 128) {
      const int idx = it * 256 + tid, seq = idx >> 11, off = idx & 2047;
      uint2* base = (uint2*)(p.ml_st() + (size_t)seq * NSTEP * 8192) + off;
      const float* at = p.ml_gtot() + seq * NSTEP;
      float4 hh = make_float4(0.f, 0.f, 0.f, 0.f);
#pragma unroll 4
      for (int s2 = 0; s2 < NSTEP; ++s2) {
        const uint2 tb = base[(size_t)s2 * 2048];
        uint2 ob; ob.x = pack_bf16(hh.x, hh.y); ob.y = pack_bf16(hh.z, hh.w);
        base[(size_t)s2 * 2048] = ob;
        const float e = expf(at[s2]);
        hh.x = e * hh.x + __uint_as_float(tb.x << 16); hh.y = e * hh.y + __uint_as_float(tb.x & 0xffff0000u);
        hh.z = e * hh.z + __uint_as_float(tb.y << 16); hh.w = e * hh.w + __uint_as_float(tb.y & 0xffff0000u);
      }
      continue;
    }
    it -= 128;
    if (it < 4) {
      const int idx = it * 256 + tid, seq = idx >> 6, off = idx & 63;
      float* base = p.ml_nst() + (size_t)seq * NSTEP * 64 + off;
      const float* at = p.ml_gtot() + seq * NSTEP;
      float hh = 0.f;
      for (int s2 = 0; s2 < NSTEP; ++s2) {
        float t = base[s2 * 64]; base[s2 * 64] = hh;
        hh = expf(at[s2]) * hh + t;
      }
      continue;
    }
    it -= 4;
    {
      const int idx = it * 256 + tid, seq = idx >> 6, sp = idx & 63;
      const int g = seq & 31, dir = (seq >> 5) & 1;
      const int dg = (layer * 2 + dir) * 32 + g;
      float pr = p.s5_a()[(dg * 64 + sp) * 2], pi = p.s5_a()[(dg * 64 + sp) * 2 + 1];
#pragma unroll
      for (int q = 0; q < 6; ++q) { float nr = pr * pr - pi * pi, ni = 2.f * pr * pi; pr = nr; pi = ni; }
      float* base = p.s5_st() + ((size_t)seq * NSTEP * 64 + sp) * 2;
      float xr = 0.f, xi = 0.f;
      for (int s2 = 0; s2 < NSTEP; ++s2) {
        float tr = base[s2 * 128], ti = base[s2 * 128 + 1];
        base[s2 * 128] = xr; base[s2 * 128 + 1] = xi;
        float nr = pr * xr - pi * xi + tr, ni = pr * xi + pi * xr + ti;
        xr = nr; xi = ni;
      }
    }
  }
}
__device__ __forceinline__ void ph_attn(const P& p, int layer, int bid, char* smem) {
  const int natt = N_ATT_LAT + (layer == 0 ? N_ATT_CTX : 0);
  for (int w = bid; w < natt; w += gridDim.x) {
    int it = w;
    const bfraw *qp, *kp, *vp; float* op; int nk;
    if (it < N_ATT_LAT) {
      int qb = it & 31, hh = (it >> 5) & 3, b = it >> 7;
      qp = p.Q() + ((size_t)(b * 4 + hh) * SL + qb * 128) * 192; kp = p.K() + (size_t)(b * 4 + hh) * NKEY * 192;
      vp = p.V() + (size_t)(b * 4 + hh) * 128 * NKEY; nk = NKEY; op = p.O() + (size_t)(b * SL + qb * 128) * 512 + hh * 128;
    } else {
      it -= N_ATT_LAT;
      int qb = it & 1, hh = (it >> 1) & 3, b = it >> 3;
      qp = p.Qc() + ((size_t)(b * 4 + hh) * CL + qb * 128) * 192; kp = p.K() + ((size_t)(b * 4 + hh) * NKEY + SL) * 192;
      vp = p.V() + (size_t)(b * 4 + hh) * 128 * NKEY + SL; nk = CL; op = p.O() + (size_t)(TLAT + b * CL + qb * 128) * 512 + hh * 128;
    }
    attn_item(qp, kp, vp, nk, op, smem);
  }
}
__device__ __forceinline__ void ph_mixC(const P& p, int layer, int bid, char* smem) {
  for (int w = bid; w < N_SSD_CH + N_ML_CH + N_S5_BLK / 2; w += gridDim.x) {
    if (w < N_SSD_CH) ssd_out_item(p, layer, w, smem);
    else if (w < N_SSD_CH + N_ML_CH) ml_out_item(p, layer, w - N_SSD_CH, smem);
    else { __syncthreads(); s5_out_item(p, layer, (w - N_SSD_CH - N_ML_CH) * 4 + (threadIdx.x >> 6), smem); }
  }
}

__device__ __forceinline__ void ph_glu(const P& p, int layer, int bid, char* smem) {
  const float* yp = p.ydpre(); float* yg = p.ydg(); const float* gb = p.glu_b + layer * 512;
  auto epi = [=](int row, int col, float v) {
    float y = yp[(size_t)row * 512 + col];
    yg[(size_t)row * 512 + col] = y * sigmoidf_(v + gb[col]);
  };
  gemm_dense<4>(p.ydpre_bf(), 512, p.wgluT() + (size_t)layer * 512 * 512, TTOT, 512, 512, epi, bid, smem);
}

__device__ __forceinline__ void ph_final_mix(const P& p, int layer, int bid, char* smem) {
  const int tid = threadIdx.x, lane = tid & 63, wid = tid >> 6;
  const float* onw = p.out_norm_w + layer * 2048;
  for (int r = bid * 4 + wid; r < TTOT; r += gridDim.x * 4) {
    const float* z = p.Z() + (size_t)r * NIN;
    bfraw* Y = p.Y() + (size_t)r * LDH;
    const int c = lane * 8;
    f32x4v a0 = *(const f32x4v*)(p.O() + (size_t)r * 512 + c), a1 = *(const f32x4v*)(p.O() + (size_t)r * 512 + c + 4);
    f32x4v y0 = *(const f32x4v*)(p.ssd_y() + (size_t)r * 512 + c), y1 = *(const f32x4v*)(p.ssd_y() + (size_t)r * 512 + c + 4);
    f32x4v x0 = *(const f32x4v*)(p.ssd_xs() + (size_t)r * 512 + c), x1 = *(const f32x4v*)(p.ssd_xs() + (size_t)r * 512 + c + 4);
    f32x4v g0 = *(const f32x4v*)(z + ZC_BZ + c), g1 = *(const f32x4v*)(z + ZC_BZ + c + 4);
    f32x4v h0 = *(const f32x4v*)(p.ml_h() + (size_t)r * 512 + c), h1 = *(const f32x4v*)(p.ml_h() + (size_t)r * 512 + c + 4);
    f32x4v o0 = *(const f32x4v*)(z + ZC_MO + c), o1 = *(const f32x4v*)(z + ZC_MO + c + 4);
    f32x4v d0 = *(const f32x4v*)(p.ydg() + (size_t)r * 512 + c), d1 = *(const f32x4v*)(p.ydg() + (size_t)r * 512 + c + 4);
    const float dsk = p.ssd_d[layer * 8 + (c >> 6)];
    float sa = 0.f, sb = 0.f, sc = 0.f, sd = 0.f;
    float bv[8], av[8], cv[8], dv[8];
#pragma unroll
    for (int i = 0; i < 4; ++i) {
      av[i] = a0[i]; av[4 + i] = a1[i];
      bv[i] = (y0[i] + dsk * x0[i]) * siluf_(g0[i]); bv[4 + i] = (y1[i] + dsk * x1[i]) * siluf_(g1[i]);
      cv[i] = h0[i]; cv[4 + i] = h1[i];
      dv[i] = d0[i]; dv[4 + i] = d1[i];
    }
#pragma unroll
    for (int i = 0; i < 8; ++i) { sa += av[i] * av[i]; sb += bv[i] * bv[i]; sc += cv[i] * cv[i]; sd += dv[i] * dv[i]; }
    sa = wave_sum(sa); sb = wave_sum(sb); sd = wave_sum(sd);
    sc += __shfl_xor(sc, 1); sc += __shfl_xor(sc, 2); sc += __shfl_xor(sc, 4); sc += __shfl_xor(sc, 8);
    const float ra = rsqrtf(sa * (1.f / 512.f) + EPSV), rb = rsqrtf(sb * (1.f / 512.f) + EPSV);
    const float rc = rsqrtf(sc * (1.f / 128.f) + EPSV), rd = rsqrtf(sd * (1.f / 512.f) + EPSV);
    float ogv[8];
#pragma unroll
    for (int i = 0; i < 4; ++i) { ogv[i] = sigmoidf_(o0[i]); ogv[4 + i] = sigmoidf_(o1[i]); }
    uint4 ua, ub, uc, ud;
    const float* w = onw + c;
    ua.x = pack_bf16(av[0] * ra * w[0], av[1] * ra * w[1]); ua.y = pack_bf16(av[2] * ra * w[2], av[3] * ra * w[3]);
    ua.z = pack_bf16(av[4] * ra * w[4], av[5] * ra * w[5]); ua.w = pack_bf16(av[6] * ra * w[6], av[7] * ra * w[7]);
    w = onw + 512 + c;
    ub.x = pack_bf16(bv[0] * rb * w[0], bv[1] * rb * w[1]); ub.y = pack_bf16(bv[2] * rb * w[2], bv[3] * rb * w[3]);
    ub.z = pack_bf16(bv[4] * rb * w[4], bv[5] * rb * w[5]); ub.w = pack_bf16(bv[6] * rb * w[6], bv[7] * rb * w[7]);
    w = onw + 1024 + c;
    uc.x = pack_bf16(cv[0] * rc * ogv[0] * w[0], cv[1] * rc * ogv[1] * w[1]); uc.y = pack_bf16(cv[2] * rc * ogv[2] * w[2], cv[3] * rc * ogv[3] * w[3]);
    uc.z = pack_bf16(cv[4] * rc * ogv[4] * w[4], cv[5] * rc * ogv[5] * w[5]); uc.w = pack_bf16(cv[6] * rc * ogv[6] * w[6], cv[7] * rc * ogv[7] * w[7]);
    w = onw + 1536 + c;
    ud.x = pack_bf16(dv[0] * rd * w[0], dv[1] * rd * w[1]); ud.y = pack_bf16(dv[2] * rd * w[2], dv[3] * rd * w[3]);
    ud.z = pack_bf16(dv[4] * rd * w[4], dv[5] * rd * w[5]); ud.w = pack_bf16(dv[6] * rd * w[6], dv[7] * rd * w[7]);
    *(uint4*)(Y + c) = ua; *(uint4*)(Y + 512 + c) = ub; *(uint4*)(Y + 1024 + c) = uc; *(uint4*)(Y + 1536 + c) = ud;
  }
}

__device__ __forceinline__ void ph_wout(const P& p, int layer, int bid, char* smem) {
  const P pp = p;
  const int M = layer == 0 ? TTOT : TLAT;
  auto epi = [=](int row, int col, float v) {
    const int mi = row_modidx(row);
    const float g1 = pp.modv()[(layer * 3 + mi) * 12288 + 2 * 2048 + col];
    float xin;
    if (layer == 0) xin = row < TLAT ? pp.x[(size_t)row * 2048 + col] : pp.ctx[(size_t)(row - TLAT) * 2048 + col];
    else xin = pp.X()[(size_t)row * 2048 + col];
    pp.X()[(size_t)row * 2048 + col] = xin + g1 * v;
  };
  gemm_dense_hybrid(p.Y(), LDH, p.woutT() + (size_t)layer * 2048 * 2048, M, 2048, 2048, epi, bid, smem);
}

__device__ __forceinline__ void ph_router(const P& p, int layer, int bid, char* smem) {
  float* sA = (float*)smem;
  float* sW = sA + 32 * 129;
  float* sNW = sW + 128 * 64;
  float* sSH = sNW + 2048;
  float* srs = sSH + 2048;
  float* sL = srs + 32;
  const int tid = threadIdx.x, lane = tid & 63, wid = tid >> 6, l31 = lane & 31, lh = lane >> 5;
  const int T = layer == 0 ? TTOT : TLAT;
  const float* nw = p.norm2_w + layer * 2048;
  const float* wg = p.w_group + (size_t)layer * 2048 * 4;
  const float* we = p.w_expert + (size_t)layer * 2048 * 32;
  __syncthreads();
  for (int i = tid; i < 128 * 28; i += 256) sW[(i / 28) * 64 + 36 + (i % 28)] = 0.f;
  const int ar = tid >> 3, aks = (tid & 7) * 16;
  const int wk = tid >> 1, whalf = tid & 1;
  for (int item = bid; item < (T >> 5); item += gridDim.x) {
    const int row0 = item * 32;
    const int mi = row_modidx(row0);
    const float* mrow = p.modv() + (layer * 3 + mi) * 12288;
    __syncthreads();
    for (int i = tid; i < 2048; i += 256) { sNW[i] = nw[i] * (1.f + mrow[4 * 2048 + i]); sSH[i] = mrow[3 * 2048 + i]; }
#pragma unroll 2
    for (int rr = 0; rr < 8; ++rr) {
      const float* xr = p.X() + (size_t)(row0 + wid * 8 + rr) * 2048 + lane * 4;
      float ss = 0.f;
#pragma unroll
      for (int i = 0; i < 8; ++i) { float4 v = *(const float4*)(xr + i * 256); ss += v.x * v.x + v.y * v.y + v.z * v.z + v.w * v.w; }
      ss = wave_sum(ss);
      if (lane == 0) srs[wid * 8 + rr] = rsqrtf(ss * (1.f / 2048.f) + EPSV);
    }
    __syncthreads();
    const float rs = srs[ar];
    const float* xrow = p.X() + (size_t)(row0 + ar) * 2048 + aks;
    bfraw* hrow = p.H() + (size_t)(row0 + ar) * LDH + aks;
    float4 xa0, xa1, xa2, xa3, wv0, wv1, wv2, wv3, wv4;
#define RT_GLOAD(k0)                                                                                   \
    {                                                                                                  \
      xa0 = *(const float4*)(xrow + (k0)); xa1 = *(const float4*)(xrow + (k0) + 4);                    \
      xa2 = *(const float4*)(xrow + (k0) + 8); xa3 = *(const float4*)(xrow + (k0) + 12);               \
      const float* er = we + (size_t)((k0) + wk) * 32 + (whalf ? 12 : 0);                              \
      wv0 = *(const float4*)(er); wv1 = *(const float4*)(er + 4); wv2 = *(const float4*)(er + 8);      \
      wv3 = *(const float4*)(er + 12); wv4 = *(const float4*)(er + 16);                                \
      if (!whalf) wv3 = *(const float4*)(wg + (size_t)((k0) + wk) * 4);                                \
    }
#define RT_A4(q, v)                                                                                    \
    {                                                                                                  \
      const int kq = (k0w) + aks + (q) * 4;                                                            \
      float h0 = v.x * rs * sNW[kq] + sSH[kq], h1 = v.y * rs * sNW[kq + 1] + sSH[kq + 1];              \
      float h2 = v.z * rs * sNW[kq + 2] + sSH[kq + 2], h3 = v.w * rs * sNW[kq + 3] + sSH[kq + 3];      \
      float* d = sA + ar * 129 + aks + (q) * 4; d[0] = h0; d[1] = h1; d[2] = h2; d[3] = h3;            \
      uint2 hb; hb.x = pack_bf16(h0, h1); hb.y = pack_bf16(h2, h3);                                    \
      *(uint2*)(hrow + (k0w) + (q) * 4) = hb;                                                          \
    }
#define RT_SWRITE()                                                                                    \
    {                                                                                                  \
      RT_A4(0, xa0) RT_A4(1, xa1) RT_A4(2, xa2) RT_A4(3, xa3)                                          \
      float* w = sW + wk * 64;                                                                         \
      if (!whalf) {                                                                                    \
        w[0] = wv3.x; w[1] = wv3.y; w[2] = wv3.z; w[3] = wv3.w;                                        \
        w[4] = wv0.x; w[5] = wv0.y; w[6] = wv0.z; w[7] = wv0.w; w[8] = wv1.x; w[9] = wv1.y; w[10] = wv1.z; w[11] = wv1.w; \
        w[12] = wv2.x; w[13] = wv2.y; w[14] = wv2.z; w[15] = wv2.w;                                    \
      } else {                                                                                         \
        w[16] = wv0.x; w[17] = wv0.y; w[18] = wv0.z; w[19] = wv0.w; w[20] = wv1.x; w[21] = wv1.y; w[22] = wv1.z; w[23] = wv1.w; \
        w[24] = wv2.x; w[25] = wv2.y; w[26] = wv2.z; w[27] = wv2.w; w[28] = wv3.x; w[29] = wv3.y; w[30] = wv3.z; w[31] = wv3.w; \
        w[32] = wv4.x; w[33] = wv4.y; w[34] = wv4.z; w[35] = wv4.w;                                    \
      }                                                                                                \
    }
    int k0w = 0;
    RT_GLOAD(0)
    RT_SWRITE()
    __syncthreads();
    f32x16 acc;
#pragma unroll
    for (int r = 0; r < 16; ++r) acc[r] = 0.f;
    const int ct = wid & 1, kh = wid >> 1;
    const float* ap = sA + l31 * 129 + kh * 64 + lh;
    const float* bp = sW + (kh * 64 + lh) * 64 + ct * 32 + l31;
    for (int k0 = 0; k0 < 2048; k0 += 128) {
      const bool more = (k0 + 128) < 2048;
      if (more) RT_GLOAD(k0 + 128)
#pragma unroll 8
      for (int kk = 0; kk < 32; ++kk) acc = MFMA32(ap[2 * kk], bp[2 * kk * 64], acc);
      __syncthreads();
      k0w = k0 + 128;
      if (more) RT_SWRITE()
      __syncthreads();
    }
#pragma unroll
    for (int r = 0; r < 16; ++r) sL[(kh * 32 + ROW16(r, lh)) * 64 + ct * 32 + l31] = acc[r];
    __syncthreads();
    if (tid < 32) {
      const int r = row0 + tid;
      const float* l0 = sL + tid * 64;
      const float* l1 = sL + (32 + tid) * 64;
      int gi = 0; float gm = l0[0] + l1[0];
      float gl[4]; gl[0] = gm;
#pragma unroll
      for (int j = 1; j < 4; ++j) { gl[j] = l0[j] + l1[j]; if (gl[j] > gm) { gm = gl[j]; gi = j; } }
      float gs = 0.f;
#pragma unroll
      for (int j = 0; j < 4; ++j) gs += expf(gl[j] - gm);
      const float gw = 1.f / gs;
      int i1 = 0, i2 = -1; float v1 = -INFINITY, v2 = -INFINITY;
      for (int j = 0; j < 8; ++j) {
        const float e = l0[4 + gi * 8 + j] + l1[4 + gi * 8 + j];
        if (e > v1) { v2 = v1; i2 = i1; v1 = e; i1 = j; }
        else if (e > v2) { v2 = e; i2 = j; }
      }
      const float e2 = expf(v2 - v1);
      const float w1 = gw / (1.f + e2), w2 = gw * e2 / (1.f + e2);
      const int ex1 = gi * 8 + i1, ex2 = gi * 8 + i2;
      int* cnt = p.cnt() + layer * 32;
      const int p1 = atomicAdd(&cnt[ex1], 1);
      p.list_tok()[ex1 * CAPE + p1] = r * 2; p.list_w()[ex1 * CAPE + p1] = w1;
      const int p2 = atomicAdd(&cnt[ex2], 1);
      p.list_tok()[ex2 * CAPE + p2] = r * 2 + 1; p.list_w()[ex2 * CAPE + p2] = w2;
    }
  }
}

struct AGather { const bfraw* H; const int* toks; int nvalid;
  __device__ __forceinline__ const bfraw* row(int r) const { return r < nvalid ? H + (size_t)(toks[r] >> 1) * LDH : nullptr; }
  __device__ __forceinline__ const bfraw* safe() const { return H; } };
struct BGateUp { static constexpr bool kT = false; const float *g, *u; int ldb; int nb;
  __device__ __forceinline__ const float* col(int v) const { int wc = v >> 6, j = (v >> 5) & 1, c = v & 31;
    const float* b = g + (ptrdiff_t)j * (u - g); return b + nb + wc * 32 + c; }
  __device__ __forceinline__ const float* safe() const { return g; } };

__device__ __forceinline__ void moe_prefix(const P& p, int layer, int* spre) {
  __syncthreads();
  if (threadIdx.x == 0) {
    int acc = 0;
    for (int e = 0; e < 32; ++e) { spre[e] = acc; acc += (p.cnt()[layer * 32 + e] + 127) >> 7; }
    spre[32] = acc;
  }
  __syncthreads();
}
__device__ __forceinline__ void ph_moe_up(const P& p, int layer, int bid, char* smem) {
  int* spre = (int*)(smem + 98304);
  moe_prefix(p, layer, spre);
  const int ntile = spre[32];
  for (int w = bid; w < ntile * 8; w += gridDim.x) {
    const int rbg = w >> 3, nt = w & 7;
    const int e = __builtin_amdgcn_readfirstlane(__popcll(__ballot((threadIdx.x & 63) < 31 && spre[(threadIdx.x & 63) + 1] <= rbg)));
    const int rb = rbg - spre[e];
    const int cnt = p.cnt()[layer * 32 + e];
    AGather af{p.H(), p.list_tok() + e * CAPE + rb * 128, cnt - rb * 128};
    const size_t wo = ((size_t)layer * 32 + e) * 2048 * 512;
    BGateUp bf{p.w_gate + wo, p.w_up + wo, 512, nt * 64};
    bfraw* act = p.ACT() + (size_t)rbg * 128 * LDACT + nt * 64;
    auto ef = [&](const f32x16 (&acc)[2][2], int wr, int wc, int lane) {
#pragma unroll
      for (int i = 0; i < 2; ++i)
#pragma unroll
        for (int r = 0; r < 16; ++r) {
          int row = ACC_ROW(wr, i, r, lane);
          float gv = acc[i][0][r], uv = acc[i][1][r];
          act[(size_t)row * LDACT + wc * 32 + (lane & 31)] = to_bf16(siluf_(gv) * uv);
        }
    };
    gemm_tile<2>(af, bf, ef, 2048, smem);
  }
}
__device__ __forceinline__ void ph_moe_down(const P& p, int layer, int bid, char* smem) {
  int* spre = (int*)(smem + 98304);
  moe_prefix(p, layer, spre);
  const int ntile = spre[32];
  for (int w = bid; w < ntile * 16; w += gridDim.x) {
    const int rbg = w >> 4, nt = w & 15;
    const int e = __builtin_amdgcn_readfirstlane(__popcll(__ballot((threadIdx.x & 63) < 31 && spre[(threadIdx.x & 63) + 1] <= rbg)));
    const int rb = rbg - spre[e];
    const int nvalid = p.cnt()[layer * 32 + e] - rb * 128;
    ARows af{p.ACT() + (size_t)rbg * 128 * LDACT, LDACT, 0, 128};
    BPlain bf{p.w_down + ((size_t)layer * 32 + e) * 512 * 2048, 2048, nt * 128, 2048};
    const int* toks = p.list_tok() + e * CAPE + rb * 128;
    const float* lw = p.list_w() + e * CAPE + rb * 128;
    bfraw* Ys = p.Yslot();
    auto ef = [&](const f32x16 (&acc)[2][2], int wr, int wc, int lane) {
#pragma unroll
      for (int i = 0; i < 2; ++i)
#pragma unroll
        for (int r = 0; r < 16; ++r) {
          int row = ACC_ROW(wr, i, r, lane);
          if (row < nvalid) {
            int ts = toks[row]; float wgt = lw[row];
#pragma unroll
            for (int j = 0; j < 2; ++j) Ys[(size_t)ts * 2048 + nt * 128 + ACC_COL(wc, j, lane)] = to_bf16(wgt * acc[i][j][r]);
          }
        }
    };
    gemm_tile<2>(af, bf, ef, 512, smem);
  }
}

__device__ __forceinline__ void ph_out(const P& p, int bid, char* smem) {
  const int tid = threadIdx.x, lane = tid & 63, wid = tid >> 6;
  for (int r = bid * 4 + wid; r < TLAT; r += gridDim.x * 4) {
    const int mi = r >> 12;
    const float* g2 = p.modv() + (1 * 3 + mi) * 12288 + 5 * 2048;
    f32x4v v[8];
    float ss = 0.f;
#pragma unroll
    for (int q = 0; q < 8; ++q) {
      const int col = q * 256 + lane * 4;
      f32x4v xv = *(const f32x4v*)(p.X() + (size_t)r * 2048 + col);
      const f32x4v gv = *(const f32x4v*)(g2 + col);
      const f32x4v y0 = ld_bf16x4(p.Yslot() + (size_t)(2 * r) * 2048 + col);
      const f32x4v y1 = ld_bf16x4(p.Yslot() + (size_t)(2 * r + 1) * 2048 + col);
      xv += gv * (y0 + y1);
      v[q] = xv;
      ss += xv[0] * xv[0] + xv[1] * xv[1] + xv[2] * xv[2] + xv[3] * xv[3];
    }
    ss = wave_sum(ss);
    const float rs = rsqrtf(ss * (1.f / 2048.f) + EPSV);
#pragma unroll
    for (int q = 0; q < 8; ++q) {
      const int col = q * 256 + lane * 4;
      const f32x4v w4 = *(const f32x4v*)(p.final_w + col);
      *(f32x4v*)(p.out + (size_t)r * 2048 + col) = v[q] * rs * w4;
    }
  }
}

#define SMEM_BYTES 102400
#define XB_TMO      128
#define XB_XCNT(j)  (256  + 64 * (j))
#define XB_XSUB(j)  (1280 + 64 * (j))
#define XB_XGEN(j)  (2304 + 64 * (j))
#define XB_TOP      3328
#define XB_TOPGEN   3392
#define XB_SPIN_CAP (1u << 22)
#define LAS __attribute__((address_space(3)))
__device__ __forceinline__ unsigned xb_ld(unsigned* p)              { return __hip_atomic_load(p, __ATOMIC_RELAXED, __HIP_MEMORY_SCOPE_AGENT); }
__device__ __forceinline__ unsigned xb_add(unsigned* p, unsigned v) { return __hip_atomic_fetch_add(p, v, __ATOMIC_RELAXED, __HIP_MEMORY_SCOPE_AGENT); }
__device__ __forceinline__ unsigned xb_xcc_id() { return (unsigned)__builtin_amdgcn_s_getreg((3 << 11) | 20) & 0xFu; }
#define XB_SPIN(cond, bar) do { unsigned _sp = 0; while (cond) { __builtin_amdgcn_s_sleep(1); \
    if ((++_sp & 255u) == 0u) { if (xb_ld(&(bar)[XB_TMO])) break; if (_sp > XB_SPIN_CAP) { atomicAdd(&(bar)[XB_TMO], 1u); break; } } } } while (0)
struct XcdBarrier { unsigned* bar; unsigned x; unsigned rank; volatile LAS unsigned* st; };
__device__ __forceinline__ XcdBarrier xcd_barrier_post(unsigned* bar, volatile LAS unsigned* st) {
    XcdBarrier b; b.bar = bar; b.x = xb_xcc_id(); b.st = st;
    b.rank = 0u;
    if (threadIdx.x == 0) b.rank = xb_add(&bar[XB_XCNT(b.x)], 1u);
    return b;
}
__device__ __forceinline__ void xcd_barrier_complete(unsigned* bar, unsigned x, unsigned& nloc, unsigned& nx) {
    const unsigned G = gridDim.x * gridDim.y * gridDim.z;
    unsigned sum, cnt, mine, sp = 0u;
    for (;;) {
        sum = 0u; cnt = 0u; mine = 0u;
#pragma unroll
        for (unsigned j = 0; j < 16; ++j) { const unsigned c = xb_ld(&bar[XB_XCNT(j)]); sum += c; cnt += (c > 0u) ? 1u : 0u; mine = (j == x) ? c : mine; }
        if (sum == G) break;
        __builtin_amdgcn_s_sleep(1);
        if ((++sp & 255u) == 0u) { if (xb_ld(&bar[XB_TMO])) break; if (sp > XB_SPIN_CAP) { atomicAdd(&bar[XB_TMO], 1u); break; } }
    }
    nloc = mine > 0u ? mine : 1u; nx = cnt > 0u ? cnt : 1u;
}
__device__ __forceinline__ void xcd_barrier(const XcdBarrier& b) {
    asm volatile("s_waitcnt vmcnt(0)" ::: "memory");
    __syncthreads();
    if (threadIdx.x == 0) {
        unsigned* bar = b.bar;
        __builtin_amdgcn_s_waitcnt(0);
        unsigned nloc = b.st[0], nx = b.st[1];
        if (nloc == 0u) { xcd_barrier_complete(bar, b.x, nloc, nx); b.st[0] = nloc; b.st[1] = nx; }
        const unsigned old = xb_add(&bar[XB_XSUB(b.x)], 1u);
        const unsigned gen = old / nloc;
        if (old + 1u == (gen + 1u) * nloc) {
            __builtin_amdgcn_fence(__ATOMIC_RELEASE, "agent");
            asm volatile("s_waitcnt vmcnt(0)" ::: "memory");
            const unsigned og = xb_add(&bar[XB_TOP], 1u);
            const unsigned tg = og / nx;
            if (og + 1u == (tg + 1u) * nx) xb_add(&bar[XB_TOPGEN], 1u);
            else XB_SPIN(xb_ld(&bar[XB_TOPGEN]) == tg, bar);
            __builtin_amdgcn_fence(__ATOMIC_ACQUIRE, "agent");
            xb_add(&bar[XB_XGEN(b.x)], 1u);
            asm volatile("s_waitcnt vmcnt(0)" ::: "memory");
        } else {
            XB_SPIN(xb_ld(&bar[XB_XGEN(b.x)]) == gen, bar);
            __builtin_amdgcn_fence(__ATOMIC_ACQUIRE, "agent");
            asm volatile("s_waitcnt vmcnt(0)" ::: "memory");
        }
    }
    __syncthreads();
}

__global__ void __launch_bounds__(256, 1) k_fused(P p, unsigned* bar) {
  extern __shared__ __attribute__((aligned(16))) char smem_all[];
  char* smem = smem_all + 64;
  if (threadIdx.x == 0) *(uint4*)smem_all = make_uint4(0u, 0u, 0u, 0u);
  __syncthreads();
  XcdBarrier b = xcd_barrier_post(bar, (volatile LAS unsigned*)smem_all);
#define LAYER_PROGRAM(L)                                                              \
  {                                                                                   \
    ph_norm1(p, L, bid, smem); xcd_barrier(b);          \
    ph_win(p, L, bid, smem); xcd_barrier(b);                          \
    ph_prep(p, L, bid, smem); xcd_barrier(b);           \
    ph_qkv(p, L, bid, smem); ph_mixA(p, L, bid, smem); xcd_barrier(b);     \
    ph_attn(p, L, bid, smem); ph_scan(p, L, bid, smem); xcd_barrier(b);    \
    ph_mixC(p, L, bid, smem); xcd_barrier(b);             \
    ph_glu(p, L, bid, smem); xcd_barrier(b);                                \
    ph_final_mix(p, L, bid, smem); xcd_barrier(b);      \
    ph_wout(p, L, bid, smem); xcd_barrier(b);                \
    ph_router(p, L, bid, smem); xcd_barrier(b);         \
    ph_moe_up(p, L, bid, smem); xcd_barrier(b);                    \
    ph_moe_down(p, L, bid, smem); xcd_barrier(b);       \
  }
  ph_mod(p, smem); ph_wprep(p, blockIdx.x, smem); xcd_barrier(b);
  if (threadIdx.x == 0) {
    unsigned pre = 0u;
    for (unsigned j = 0; j < 16; ++j) { const unsigned c = xb_ld(&bar[XB_XCNT(j)]); if (j < b.x) pre += c; }
    ((volatile LAS unsigned*)smem_all)[2] = pre + b.rank;
  }
  __syncthreads();
  const int bid = (int)((volatile LAS unsigned*)smem_all)[2];
  LAYER_PROGRAM(0)
  LAYER_PROGRAM(1)
  ph_out(p, bid, smem);
}

extern "C" void kernel_launch(void* const* d_in, const int* in_sizes, int n_in, void* d_out, int out_size, void* d_ws,
                              size_t ws_size, hipStream_t stream) {
  P p{};
  const float* const* in = (const float* const*)d_in;
  p.x = in[0]; p.c = in[1]; p.ctx = in[2]; p.c_ctx = in[3]; p.mod_w = in[4]; p.mod_b = in[5]; p.norm1_w = in[6];
  p.w_in = in[7]; p.q_norm_w = in[8]; p.kv_norm_w = in[9]; p.w_uq = in[10]; p.w_ukv = in[11]; p.conv_w = in[12];
  p.conv_b = in[13]; p.a_log = in[14]; p.dt_bias = in[15]; p.ssd_d = in[16]; p.gate_b = in[17]; p.lam_re = in[18];
  p.lam_im = in[19]; p.log_dt = in[20]; p.b_re = in[21]; p.b_im = in[22]; p.c_re = in[23]; p.c_im = in[24];
  p.s5_d = in[25]; p.glu_w = in[26]; p.glu_b = in[27]; p.out_norm_w = in[28]; p.w_out = in[29]; p.norm2_w = in[30];
  p.w_group = in[31]; p.w_expert = in[32]; p.w_gate = in[33]; p.w_up = in[34]; p.w_down = in[35]; p.final_w = in[36];
  p.out = (float*)d_out;
  p.ws = (float*)d_ws;
  (void)ws_size; (void)in_sizes; (void)n_in; (void)out_size;

  unsigned* bar = (unsigned*)((float*)d_ws + WO_bar);
  static int grid = 0;
  if (!grid) {
    int dev = 0, cus = 0, per_cu = 0;
    hipGetDevice(&dev);
    hipDeviceGetAttribute(&cus, hipDeviceAttributeMultiprocessorCount, dev);
    (void)hipFuncSetAttribute((const void*)k_fused, hipFuncAttributeMaxDynamicSharedMemorySize, SMEM_BYTES + 64);
    (void)hipOccupancyMaxActiveBlocksPerMultiprocessor(&per_cu, k_fused, 256, SMEM_BYTES + 64);
    if (per_cu < 1) per_cu = 1;
    grid = cus * (per_cu < 1 ? per_cu : 1);
  }
  hipMemsetAsync(bar, 0, XCD_BAR_WORDS * sizeof(unsigned), stream);
  hipLaunchKernelGGL(k_fused, dim3(grid), dim3(256), SMEM_BYTES + 64, stream, p, bar);
}
```

```cpp
#include <hip/hip_runtime.h>
#include <stdint.h>

#define DM 2048
#define SL 4096
#define CL 256
#define TLAT 8192
#define TCTX 512
#define TTOT 8704
#define NIN 4192
#define NKEY 4352
#define ZC_CQ 0
#define ZC_CKV 384
#define ZC_KR 512
#define ZC_BZ 576
#define ZC_XBC 1088
#define ZC_DT 2112
#define ZC_MQ 2128
#define ZC_MK 2384
#define ZC_MV 2640
#define ZC_MO 3152
#define ZC_MG 3664
#define ZC_U 3680
#define CAPE 8704
#define EPSV 1e-6f
#define ACT_ROWS 21632

typedef float f32x16 __attribute__((ext_vector_type(16)));
typedef short bf16x8 __attribute__((ext_vector_type(8)));
typedef float f32x4v __attribute__((ext_vector_type(4)));
typedef unsigned u32x4g __attribute__((ext_vector_type(4)));
typedef unsigned short bfraw;
__device__ __forceinline__ unsigned pack_bf16(float lo, float hi) {
  typedef __bf16 bf2 __attribute__((ext_vector_type(2)));
  bf2 v; v[0] = (__bf16)lo; v[1] = (__bf16)hi;
  return __builtin_bit_cast(unsigned, v);
}
__device__ __forceinline__ bfraw to_bf16(float x) { __bf16 b = (__bf16)x; return __builtin_bit_cast(unsigned short, b); }
__device__ __forceinline__ f32x4v ld_bf16x4(const bfraw* q) {
  const uint2 t = *(const uint2*)q;
  f32x4v r; r[0] = __uint_as_float(t.x << 16); r[1] = __uint_as_float(t.x & 0xffff0000u); r[2] = __uint_as_float(t.y << 16); r[3] = __uint_as_float(t.y & 0xffff0000u);
  return r;
}
__device__ __forceinline__ float from_bf16(bfraw x) { return __uint_as_float((unsigned)x << 16); }

#define NSTEP 68
#define LDH 2112
#define LDACT 576
#define XCD_BAR_WORDS 3456
#define WS_RND(n) (((size_t)(n) + 63) & ~(size_t)63)
constexpr size_t WO_cnt = 0;
constexpr size_t WO_modv = WO_cnt + WS_RND(64);
constexpr size_t WO_H = WO_modv + WS_RND(2 * 3 * 12288);
constexpr size_t WO_X = WO_H + WS_RND((size_t)TTOT * (LDH / 2));
constexpr size_t WO_Z = WO_X + WS_RND((size_t)TTOT * 2048);
constexpr size_t WO_Aq = WO_Z + WS_RND((size_t)TTOT * NIN);
constexpr size_t WO_Akv = WO_Aq + WS_RND((size_t)TTOT * 192);
constexpr size_t WO_qraw = WO_Akv + WS_RND((size_t)TTOT * 64);
constexpr size_t WO_kvraw = WO_qraw + WS_RND((size_t)TTOT * 768);
constexpr size_t WO_Q = WO_kvraw + WS_RND((size_t)TTOT * 1024);
constexpr size_t WO_Qc = WO_Q + WS_RND((size_t)8 * SL * 96);
constexpr size_t WO_K = WO_Qc + WS_RND((size_t)8 * CL * 96);
constexpr size_t WO_V = WO_K + WS_RND((size_t)8 * NKEY * 96);
constexpr size_t WO_O = WO_V + WS_RND((size_t)8 * NKEY * 64);
constexpr size_t WO_ssd_xs = WO_O + WS_RND((size_t)TTOT * 512);
constexpr size_t WO_ssd_B = WO_ssd_xs + WS_RND((size_t)TTOT * 512);
constexpr size_t WO_ssd_C = WO_ssd_B + WS_RND((size_t)TTOT * 256);
constexpr size_t WO_ssd_dt = WO_ssd_C + WS_RND((size_t)TTOT * 256);
constexpr size_t WO_ssd_y = WO_ssd_dt + WS_RND((size_t)TTOT * 16);
constexpr size_t WO_ssd_st = WO_ssd_y + WS_RND((size_t)TTOT * 512);
constexpr size_t WO_ssd_atot = WO_ssd_st + WS_RND((size_t)32 * NSTEP * 8192);
constexpr size_t WO_ml_h = WO_ssd_atot + WS_RND(32 * NSTEP);
constexpr size_t WO_ml_st = WO_ml_h + WS_RND((size_t)TTOT * 512);
constexpr size_t WO_ml_nst = WO_ml_st + WS_RND((size_t)16 * NSTEP * 8192);
constexpr size_t WO_ml_gtot = WO_ml_nst + WS_RND((size_t)16 * NSTEP * 64);
constexpr size_t WO_s5_st = WO_ml_gtot + WS_RND(16 * NSTEP);
constexpr size_t WO_s5_a = WO_s5_st + WS_RND((size_t)128 * NSTEP * 128);
constexpr size_t WO_s5_bb = WO_s5_a + WS_RND(2 * 2 * 32 * 64 * 2);
constexpr size_t WO_s5_rf = WO_s5_bb + WS_RND((size_t)2 * 2 * 32 * 64 * 32);
constexpr size_t WO_s5_rb = WO_s5_rf + WS_RND((size_t)TTOT * 512);
constexpr size_t WO_ydpre = WO_s5_rb + WS_RND((size_t)TTOT * 512);
constexpr size_t WO_ydg = WO_ydpre + WS_RND((size_t)TTOT * 512);
constexpr size_t WO_Y = WO_ydg + WS_RND((size_t)TTOT * 512);
constexpr size_t WO_ydpre_bf = WO_Y + WS_RND((size_t)TTOT * (LDH / 2));
constexpr size_t WO_list_tok = WO_ydpre_bf + WS_RND((size_t)TTOT * 256);
constexpr size_t WO_list_w = WO_list_tok + WS_RND((size_t)32 * CAPE);
constexpr size_t WO_ACT = WO_list_w + WS_RND((size_t)32 * CAPE);
constexpr size_t WO_Yslot = WO_ACT + WS_RND((size_t)ACT_ROWS * (LDACT / 2));
constexpr size_t WO_rope_cs = WO_Yslot + WS_RND((size_t)TTOT * 2 * 2048);
constexpr size_t WO_s5_bbh = WO_rope_cs + WS_RND(64 * 16 * 2);
constexpr size_t WO_s5_cmh = WO_s5_bbh + WS_RND(128 * 128 * 16 / 2);
constexpr size_t WO_bar_old = WO_Yslot + WS_RND((size_t)TTOT * 2 * 2048);
constexpr size_t WO_winT = WO_s5_cmh + WS_RND(64 * 32 * 128 / 2);
constexpr size_t WO_woutT = WO_winT + WS_RND((size_t)2 * 4224 * 1024);
constexpr size_t WO_wuqT = WO_woutT + WS_RND((size_t)2 * 2048 * 1024);
constexpr size_t WO_wukvT = WO_wuqT + WS_RND((size_t)2 * 768 * 192);
constexpr size_t WO_wgluT = WO_wukvT + WS_RND((size_t)2 * 1024 * 64);
constexpr size_t WO_O2 = WO_wgluT + WS_RND((size_t)2 * 512 * 256);
constexpr size_t WO_attn_ml = WO_O2 + WS_RND((size_t)TTOT * 512);
constexpr size_t WO_bar = WO_attn_ml + WS_RND((size_t)2 * TTOT * 8);
constexpr size_t WS_TOTAL_FLOATS = WO_bar + 4096;

struct P {
  const float *x, *c, *ctx, *c_ctx, *mod_w, *mod_b, *norm1_w, *w_in, *q_norm_w, *kv_norm_w, *w_uq, *w_ukv;
  const float *conv_w, *conv_b, *a_log, *dt_bias, *ssd_d, *gate_b, *lam_re, *lam_im, *log_dt, *b_re, *b_im;
  const float *c_re, *c_im, *s5_d, *glu_w, *glu_b, *out_norm_w, *w_out, *norm2_w, *w_group, *w_expert;
  const float *w_gate, *w_up, *w_down, *final_w;
  float* out;
  float* ws;
  __device__ __forceinline__ int* cnt() const { return (int*)(ws + WO_cnt); }
  __device__ __forceinline__ float* modv() const { return (float*)(ws + WO_modv); }
  __device__ __forceinline__ bfraw* H() const { return (bfraw*)(ws + WO_H); }
  __device__ __forceinline__ float* X() const { return (float*)(ws + WO_X); }
  __device__ __forceinline__ float* Z() const { return (float*)(ws + WO_Z); }
  __device__ __forceinline__ bfraw* Aq() const { return (bfraw*)(ws + WO_Aq); }
  __device__ __forceinline__ bfraw* Akv() const { return (bfraw*)(ws + WO_Akv); }
  __device__ __forceinline__ float* qraw() const { return (float*)(ws + WO_qraw); }
  __device__ __forceinline__ float* kvraw() const { return (float*)(ws + WO_kvraw); }
  __device__ __forceinline__ bfraw* Q() const { return (bfraw*)(ws + WO_Q); }
  __device__ __forceinline__ bfraw* Qc() const { return (bfraw*)(ws + WO_Qc); }
  __device__ __forceinline__ bfraw* K() const { return (bfraw*)(ws + WO_K); }
  __device__ __forceinline__ bfraw* V() const { return (bfraw*)(ws + WO_V); }
  __device__ __forceinline__ float* O() const { return (float*)(ws + WO_O); }
  __device__ __forceinline__ float* ssd_xs() const { return (float*)(ws + WO_ssd_xs); }
  __device__ __forceinline__ float* ssd_B() const { return (float*)(ws + WO_ssd_B); }
  __device__ __forceinline__ float* ssd_C() const { return (float*)(ws + WO_ssd_C); }
  __device__ __forceinline__ float* ssd_dt() const { return (float*)(ws + WO_ssd_dt); }
  __device__ __forceinline__ float* ssd_y() const { return (float*)(ws + WO_ssd_y); }
  __device__ __forceinline__ bfraw* ssd_st() const { return (bfraw*)(ws + WO_ssd_st); }
  __device__ __forceinline__ float* ssd_atot() const { return (float*)(ws + WO_ssd_atot); }
  __device__ __forceinline__ float* ml_h() const { return (float*)(ws + WO_ml_h); }
  __device__ __forceinline__ bfraw* ml_st() const { return (bfraw*)(ws + WO_ml_st); }
  __device__ __forceinline__ float* ml_nst() const { return (float*)(ws + WO_ml_nst); }
  __device__ __forceinline__ float* ml_gtot() const { return (float*)(ws + WO_ml_gtot); }
  __device__ __forceinline__ float* s5_st() const { return (float*)(ws + WO_s5_st); }
  __device__ __forceinline__ float* s5_a() const { return (float*)(ws + WO_s5_a); }
  __device__ __forceinline__ float* s5_bb() const { return (float*)(ws + WO_s5_bb); }
  __device__ __forceinline__ float* s5_rf() const { return (float*)(ws + WO_s5_rf); }
  __device__ __forceinline__ float* s5_rb() const { return (float*)(ws + WO_s5_rb); }
  __device__ __forceinline__ float* ydpre() const { return (float*)(ws + WO_ydpre); }
  __device__ __forceinline__ float* ydg() const { return (float*)(ws + WO_ydg); }
  __device__ __forceinline__ bfraw* Y() const { return (bfraw*)(ws + WO_Y); }
  __device__ __forceinline__ bfraw* ydpre_bf() const { return (bfraw*)(ws + WO_ydpre_bf); }
  __device__ __forceinline__ int* list_tok() const { return (int*)(ws + WO_list_tok); }
  __device__ __forceinline__ float* list_w() const { return (float*)(ws + WO_list_w); }
  __device__ __forceinline__ bfraw* ACT() const { return (bfraw*)(ws + WO_ACT); }
  __device__ __forceinline__ bfraw* Yslot() const { return (bfraw*)(ws + WO_Yslot); }
  __device__ __forceinline__ float* rope_cs() const { return (float*)(ws + WO_rope_cs); }
  __device__ __forceinline__ bfraw* s5_bbh() const { return (bfraw*)(ws + WO_s5_bbh); }
  __device__ __forceinline__ bfraw* s5_cmh() const { return (bfraw*)(ws + WO_s5_cmh); }
  __device__ __forceinline__ bfraw* winT() const { return (bfraw*)(ws + WO_winT); }
  __device__ __forceinline__ bfraw* woutT() const { return (bfraw*)(ws + WO_woutT); }
  __device__ __forceinline__ bfraw* wuqT() const { return (bfraw*)(ws + WO_wuqT); }
  __device__ __forceinline__ bfraw* wukvT() const { return (bfraw*)(ws + WO_wukvT); }
  __device__ __forceinline__ bfraw* wgluT() const { return (bfraw*)(ws + WO_wgluT); }
  __device__ __forceinline__ float* O2() const { return (float*)(ws + WO_O2); }
  __device__ __forceinline__ float* attn_ml() const { return (float*)(ws + WO_attn_ml); }
};

__device__ __forceinline__ int otid() { int t = threadIdx.x; asm volatile("" : "+v"(t)); return t; }
__device__ __forceinline__ int row_modidx(int r) { return r < TLAT ? (r >> 12) : 2; }
typedef unsigned u32x4wt __attribute__((ext_vector_type(4)));
__device__ __forceinline__ void store16_wt(void* ptr, u32x4wt v) {
  asm volatile("global_store_dwordx4 %0, %1, off sc1\n\ts_nop 1" :: "v"(ptr), "v"(v) : "memory");
}
#define FOR_ROWS_TTOT(r, bid, wid)                                                                      \
  for (int rpb_ = (TTOT % (int)gridDim.x) == 0 ? TTOT / (int)gridDim.x : 0,                              \
           i_ = (wid), r = rpb_ ? (bid) * rpb_ + i_ : (bid) * 4 + (wid);                                 \
       rpb_ ? i_ < rpb_ : r < TTOT;                                                                       \
       i_ += 4, r = rpb_ ? (bid) * rpb_ + i_ : r + (int)gridDim.x * 4)
__device__ __forceinline__ float sigmoidf_(float v) { return 1.f / (1.f + expf(-v)); }
__device__ __forceinline__ float siluf_(float v) { return v / (1.f + expf(-v)); }
typedef unsigned u32x2v __attribute__((ext_vector_type(2)));
__device__ __forceinline__ float xor32(float x) {
  const u32x2v t = __builtin_amdgcn_permlane32_swap(__float_as_uint(x), __float_as_uint(x), false, false);
  return __uint_as_float((threadIdx.x & 32) ? t[0] : t[1]);
}
__device__ __forceinline__ float xor16(float x) {
  const u32x2v t = __builtin_amdgcn_permlane16_swap(__float_as_uint(x), __float_as_uint(x), false, false);
  return __uint_as_float((threadIdx.x & 16) ? t[0] : t[1]);
}
#define DPPF(x, ctrl, rmask) __int_as_float(__builtin_amdgcn_update_dpp(0, __float_as_int(x), (ctrl), (rmask), 0xF, false))
__device__ __forceinline__ float row16_sum(float v) {
  v += DPPF(v, 0xB1, 0xF); v += DPPF(v, 0x4E, 0xF); v += DPPF(v, 0x141, 0xF); v += DPPF(v, 0x140, 0xF);
  return v;
}
__device__ __forceinline__ float wave_sum(float v) {
  v = row16_sum(v); v += xor16(v); v += xor32(v);
  return v;
}
__device__ __forceinline__ float lane63(float v) { return __int_as_float(__builtin_amdgcn_readlane(__float_as_int(v), 63)); }
__device__ __forceinline__ float block_sum(float v, float* red) {
  v = wave_sum(v);
  __syncthreads();
  if ((otid() & 63) == 0) red[otid() >> 6] = v;
  __syncthreads();
  return red[0] + red[1] + red[2] + red[3];
}

__device__ __forceinline__ void ph_mod(const P& p, char* smem) {
  float* sc = (float*)smem;
  float* red = sc + 3 * 2048;
  const int tid = otid();
  if (blockIdx.x == 0 && tid < 64) p.cnt()[tid] = 0;
  if (blockIdx.x == 1) {
    for (int i = tid; i < 64 * 16; i += 256) {
      const int idx = i >> 4, f = i & 15;
      const float ang = (float)idx * powf(10000.f, -(float)f * (1.f / 16.f));
      p.rope_cs()[i * 2] = cosf(ang); p.rope_cs()[i * 2 + 1] = sinf(ang);
    }
  }
  for (int i = blockIdx.x * 256 + tid; i < 64 * 32 * 128; i += gridDim.x * 256) {
    const int pp = i & 127, c = (i >> 7) & 31, lg = i >> 12;
    float v = 0.f;
    if (c < 16) v = pp < 64 ? p.c_re[((size_t)lg * 16 + c) * 64 + pp] : -p.c_im[((size_t)lg * 16 + c) * 64 + pp - 64];
    p.s5_cmh()[i] = to_bf16(v);
  }
  for (int i = blockIdx.x * 256 + tid; i < 2 * 2 * 32 * 64; i += gridDim.x * 256) {
    const int sp = i & 63, g = (i >> 6) & 31, l = i >> 12;
    const float lr = p.lam_re[i], li = p.lam_im[i];
    const float dt = expf(p.log_dt[i >> 6]);
    const float mag = expf(lr * dt);
    const float ar = mag * cosf(li * dt), ai = mag * sinf(li * dt);
    const float den = lr * lr + li * li;
    const float cr_ = ((ar - 1.f) * lr + ai * li) / den;
    const float ci_ = (ai * lr - (ar - 1.f) * li) / den;
    p.s5_a()[i * 2] = ar; p.s5_a()[i * 2 + 1] = ai;
    for (int c = 0; c < 16; ++c) {
      float br = p.b_re[((size_t)(l * 32 + g) * 64 + sp) * 16 + c];
      float bim = p.b_im[((size_t)(l * 32 + g) * 64 + sp) * 16 + c];
      p.s5_bb()[(size_t)i * 32 + c] = cr_ * br - ci_ * bim;
      p.s5_bb()[(size_t)i * 32 + 16 + c] = cr_ * bim + ci_ * br;
      p.s5_bbh()[((size_t)(i >> 6) * 128 + sp) * 16 + c] = to_bf16(cr_ * br - ci_ * bim);
      p.s5_bbh()[((size_t)(i >> 6) * 128 + 64 + sp) * 16 + c] = to_bf16(cr_ * bim + ci_ * br);
    }
  }
  for (int i = tid; i < 3 * 2048; i += 256) {
    int r = i >> 11, k = i & 2047;
    float v = r < 2 ? p.c[r * 2048 + k] : p.c_ctx[k];
    sc[i] = siluf_(v);
  }
  __syncthreads();
  for (int w = blockIdx.x; w < 2 * 96; w += gridDim.x) {
    int l = w / 96, j0 = (w % 96) * 128;
    int cg = tid & 31, ks = tid >> 5;
    const float* W = p.mod_w + (size_t)l * 2048 * 12288 + j0 + cg * 4;
    float acc[3][4];
#pragma unroll
    for (int r = 0; r < 3; ++r)
#pragma unroll
      for (int c = 0; c < 4; ++c) acc[r][c] = 0.f;
#pragma unroll 16
    for (int k = ks * 256; k < ks * 256 + 256; ++k) {
      float4 wv = *(const float4*)(W + (size_t)k * 12288);
      float s0 = sc[k], s1 = sc[2048 + k], s2 = sc[4096 + k];
      acc[0][0] += s0 * wv.x; acc[0][1] += s0 * wv.y; acc[0][2] += s0 * wv.z; acc[0][3] += s0 * wv.w;
      acc[1][0] += s1 * wv.x; acc[1][1] += s1 * wv.y; acc[1][2] += s1 * wv.z; acc[1][3] += s1 * wv.w;
      acc[2][0] += s2 * wv.x; acc[2][1] += s2 * wv.y; acc[2][2] += s2 * wv.z; acc[2][3] += s2 * wv.w;
    }
    __syncthreads();
#pragma unroll
    for (int r = 0; r < 3; ++r)
#pragma unroll
      for (int c = 0; c < 4; ++c) red[(ks * 32 + cg) * 12 + r * 4 + c] = acc[r][c];
    __syncthreads();
    for (int o = tid; o < 384; o += 256) {
      int r = o >> 7, c = o & 127;
      float s = 0.f;
#pragma unroll
      for (int q = 0; q < 8; ++q) s += red[(q * 32 + (c >> 2)) * 12 + r * 4 + (c & 3)];
      s += p.mod_b[l * 12288 + j0 + c];
      p.modv()[(l * 3 + r) * 12288 + j0 + c] = s;
    }
    __syncthreads();
  }
}

__device__ __forceinline__ void wprep_matrix(const float* src, bfraw* dst, int K, int N, int Npad, int& base, int bid, char* smem) {
  const int tid = otid();
  const int tk = K >> 6, tn = Npad >> 6, nt = tk * tn;
  int first = bid - (base % (int)gridDim.x); if (first < 0) first += gridDim.x;
  for (int t = first; t < nt; t += gridDim.x) {
    const int k0 = (t % tk) * 64, n0 = (t / tk) * 64;
    __syncthreads();
#pragma unroll
    for (int u = 0; u < 4; ++u) {
      const int i = tid + 256 * u, kr = i >> 4, c4 = i & 15;
      const int n = n0 + c4 * 4;
      float4 v = make_float4(0.f, 0.f, 0.f, 0.f);
      if (n < N) v = *(const float4*)(src + (size_t)(k0 + kr) * N + n);
      *(bfraw*)(smem + (c4 * 4 + 0) * 144 + kr * 2) = to_bf16(v.x);
      *(bfraw*)(smem + (c4 * 4 + 1) * 144 + kr * 2) = to_bf16(v.y);
      *(bfraw*)(smem + (c4 * 4 + 2) * 144 + kr * 2) = to_bf16(v.z);
      *(bfraw*)(smem + (c4 * 4 + 3) * 144 + kr * 2) = to_bf16(v.w);
    }
    __syncthreads();
#pragma unroll
    for (int u = 0; u < 2; ++u) {
      const int i = tid + 256 * u, nr = i >> 3, c = i & 7;
      store16_wt(dst + (size_t)(n0 + nr) * K + k0 + c * 8, *(const u32x4wt*)(smem + nr * 144 + c * 16));
    }
  }
  base += nt;
}
__device__ __forceinline__ void ph_wprep(const P& p, int bid, char* smem) {
  int base = 0;
  for (int l = 0; l < 2; ++l) {
    wprep_matrix(p.w_in + (size_t)l * 2048 * NIN, p.winT() + (size_t)l * 4224 * 2048, 2048, NIN, 4224, base, bid, smem);
    wprep_matrix(p.w_out + (size_t)l * 2048 * 2048, p.woutT() + (size_t)l * 2048 * 2048, 2048, 2048, 2048, base, bid, smem);
    wprep_matrix(p.w_uq + (size_t)l * 384 * 768, p.wuqT() + (size_t)l * 768 * 384, 384, 768, 768, base, bid, smem);
    wprep_matrix(p.w_ukv + (size_t)l * 128 * 1024, p.wukvT() + (size_t)l * 1024 * 128, 128, 1024, 1024, base, bid, smem);
    wprep_matrix(p.glu_w + (size_t)l * 512 * 512, p.wgluT() + (size_t)l * 512 * 512, 512, 512, 512, base, bid, smem);
  }
}

__device__ __forceinline__ void ph_norm1(const P& p, int layer, int bid, char* smem) {
  const int tid = otid(), lane = tid & 63, wid = tid >> 6;
  const float* nw = p.norm1_w + layer * 2048;
  FOR_ROWS_TTOT(r, bid, wid) {
    const int mi = row_modidx(r);
    const float* mrow = p.modv() + (layer * 3 + mi) * 12288;
    f32x4v v[8];
    float ss = 0.f;
#pragma unroll
    for (int q = 0; q < 8; ++q) {
      const int col = q * 256 + lane * 4;
      f32x4v xv;
      if (layer == 0) {
        const float* src = r < TLAT ? p.x + (size_t)r * 2048 : p.ctx + (size_t)(r - TLAT) * 2048;
        xv = *(const f32x4v*)(src + col);
      } else {
        xv = *(const f32x4v*)(p.X() + (size_t)r * 2048 + col);
        const float* g2 = p.modv() + ((layer - 1) * 3 + mi) * 12288 + 5 * 2048;
        const f32x4v gv = *(const f32x4v*)(g2 + col);
        const f32x4v y0 = ld_bf16x4(p.Yslot() + (size_t)(2 * r) * 2048 + col);
        const f32x4v y1 = ld_bf16x4(p.Yslot() + (size_t)(2 * r + 1) * 2048 + col);
        xv += gv * (y0 + y1);
        store16_wt(p.X() + (size_t)r * 2048 + col, __builtin_bit_cast(u32x4wt, xv));
      }
      v[q] = xv;
      ss += xv[0] * xv[0] + xv[1] * xv[1] + xv[2] * xv[2] + xv[3] * xv[3];
    }
    ss = wave_sum(ss);
    const float rs = rsqrtf(ss * (1.f / 2048.f) + EPSV);
#pragma unroll
    for (int q = 0; q < 8; ++q) {
      const int col = q * 256 + lane * 4;
      const f32x4v w4 = *(const f32x4v*)(nw + col);
      const f32x4v sh = *(const f32x4v*)(mrow + col);
      const f32x4v scv = *(const f32x4v*)(mrow + 2048 + col);
      const f32x4v o = v[q] * rs * w4 * (1.f + scv) + sh;
      uint2 ob; ob.x = pack_bf16(o[0], o[1]); ob.y = pack_bf16(o[2], o[3]);
      *(uint2*)(p.H() + (size_t)r * LDH + col) = ob;
    }
  }
}

template <int MI, int NST = 2, class AF, class BF, class EF>
__device__ __forceinline__ void gemm_tile(const AF& af, const BF& bf, const EF& ef, int K, char* smem) {
  constexpr int BM = MI * 64;
  constexpr int NA = MI * 2;
  constexpr int ABYTES = BM * 128, STAGE = ABYTES + 16384;
  int tid_ = threadIdx.x; asm volatile("" : "+v"(tid_));
  const int tid = tid_, lane = tid & 63, wid = tid >> 6, wr = wid >> 1, wc = wid & 1;
  const int l31 = lane & 31, lh = lane >> 5;
  f32x16 acc[MI][2];
#pragma unroll
  for (int i = 0; i < MI; ++i)
#pragma unroll
    for (int j = 0; j < 2; ++j)
#pragma unroll
      for (int r = 0; r < 16; ++r) acc[i][j][r] = 0.f;
  const int arl = tid >> 3, ac = tid & 7;
  const bfraw* arow[NA];
#pragma unroll
  for (int i = 0; i < NA; ++i) { const bfraw* q = af.row(arl + 32 * i); arow[i] = (q ? q : af.safe()) + ac * 8; }
  const int n4 = tid & 31, kg = tid >> 5;
  const float* bc = nullptr;
  size_t ldb = 0;
  const bfraw* brow[4] = {nullptr, nullptr, nullptr, nullptr};
  if constexpr (BF::kT) {
#pragma unroll
    for (int i = 0; i < 4; ++i) brow[i] = bf.nrow(arl + 32 * i) + ac * 8;
  } else {
    const float* q = bf.col(n4 * 4); bc = (q ? q : bf.safe()) + (size_t)(kg * 8) * bf.ldb;
    ldb = (size_t)bf.ldb;
  }
  typedef unsigned u32x4v __attribute__((ext_vector_type(4)));
  constexpr int NS = NST;
  u32x4v ra[NS][NA];
  f32x4v rb[NS][8];
  u32x4v rbt[NS][4];
#define GM_GL(set, k0)                                                               \
  {                                                                                  \
    _Pragma("unroll") for (int i = 0; i < NA; ++i) ra[set][i] = *(const u32x4v*)(arow[i] + (k0)); \
    if constexpr (BF::kT) {                                                          \
      _Pragma("unroll") for (int i = 0; i < 4; ++i) rbt[set][i] = *(const u32x4v*)(brow[i] + (k0)); \
    } else {                                                                         \
      const float* bq = bc + (size_t)(k0) * ldb;                                     \
      _Pragma("unroll") for (int j = 0; j < 8; ++j) rb[set][j] = *(const f32x4v*)(bq + (size_t)j * ldb); \
    }                                                                                \
  }
#define GM_SW(set, buf)                                                              \
  {                                                                                  \
    char* Ab = smem + (buf) * STAGE; char* Bb = Ab + ABYTES;                         \
    const int asw = (ac ^ ((arl >> 1) & 7)) << 4;                                    \
    _Pragma("unroll") for (int i = 0; i < NA; ++i) *(u32x4v*)(Ab + (arl + 32 * i) * 128 + asw) = ra[set][i]; \
    if constexpr (BF::kT) {                                                          \
      _Pragma("unroll") for (int i = 0; i < 4; ++i) *(u32x4v*)(Bb + (arl + 32 * i) * 128 + asw) = rbt[set][i]; \
    } else                                                                           \
    _Pragma("unroll") for (int i4 = 0; i4 < 4; ++i4) {                               \
      const int n = n4 * 4 + i4;                                                     \
      u32x4v v;                                                                      \
      v[0] = pack_bf16(rb[set][0][i4], rb[set][1][i4]); v[1] = pack_bf16(rb[set][2][i4], rb[set][3][i4]); \
      v[2] = pack_bf16(rb[set][4][i4], rb[set][5][i4]); v[3] = pack_bf16(rb[set][6][i4], rb[set][7][i4]); \
      *(u32x4v*)(Bb + n * 128 + ((kg ^ ((n >> 1) & 7)) << 4)) = v;                   \
    }                                                                                \
  }
#define GM_COMPUTE(buf, KK0, KK1)                                                    \
  {                                                                                  \
    const char* ap = smem + (buf) * STAGE + (wr * (BM / 2) + l31) * 128;             \
    const char* bp = smem + (buf) * STAGE + ABYTES + (wc * 64 + l31) * 128;          \
    _Pragma("unroll") for (int kk = KK0; kk < KK1; ++kk) {                           \
      const int co = ((2 * kk + lh) ^ fsw) << 4;                                     \
      const bf16x8 b0 = *(const bf16x8*)(bp + co), b1 = *(const bf16x8*)(bp + 32 * 128 + co); \
      _Pragma("unroll") for (int i = 0; i < MI; ++i) {                               \
        const bf16x8 a = *(const bf16x8*)(ap + i * 32 * 128 + co);                   \
        acc[i][0] = __builtin_amdgcn_mfma_f32_32x32x16_bf16(a, b0, acc[i][0], 0, 0, 0); \
        acc[i][1] = __builtin_amdgcn_mfma_f32_32x32x16_bf16(a, b1, acc[i][1], 0, 0, 0); \
      }                                                                              \
    }                                                                                \
  }
  const int fsw = (l31 >> 1) & 7;
  const int nsteps = K >> 6;
  __syncthreads();
  const int klast = (nsteps - 1) * 64;
  if constexpr (NST == 1) {
    GM_GL(0, 0)
    GM_SW(0, 0)
    __syncthreads();
    for (int s = 0; s < nsteps; ++s) {
      { const int kn = min((s + 1) * 64, klast); GM_GL(0, kn) }
      GM_COMPUTE(0, 0, 4)
      __syncthreads();
      GM_SW(0, 0)
      __syncthreads();
    }
  } else {
  GM_GL(0, 0)
  GM_SW(0, 0)
  GM_GL(1, 64)
  __syncthreads();
  for (int s = 0; s < nsteps; s += 2) {
    { const int kn = min((s + 2) * 64, klast); GM_GL(0, kn) }
    GM_COMPUTE(0, 0, 2)
    __builtin_amdgcn_sched_barrier(0);
    GM_SW(1, 1)
    __builtin_amdgcn_sched_barrier(0);
    GM_COMPUTE(0, 2, 4)
    __syncthreads();
    { const int kn = min((s + 3) * 64, klast); GM_GL(1, kn) }
    GM_COMPUTE(1, 0, 2)
    __builtin_amdgcn_sched_barrier(0);
    GM_SW(0, 0)
    __builtin_amdgcn_sched_barrier(0);
    GM_COMPUTE(1, 2, 4)
    __syncthreads();
  }
  }
  ef(acc, wr, wc, lane);
}
#define ACC_ROWM(MI, wr, i, r, lane) ((wr) * ((MI) * 32) + (i) * 32 + ((r) & 3) + 8 * ((r) >> 2) + 4 * ((lane) >> 5))
#define ACC_ROW(wr, i, r, lane) ACC_ROWM(2, wr, i, r, lane)
#define ACC_COL(wc, j, lane) ((wc) * 64 + (j) * 32 + ((lane) & 31))

struct ARows { const bfraw* base; int ld; int m0; int M;
  __device__ __forceinline__ const bfraw* row(int r) const { int g = m0 + r; return g < M ? base + (size_t)g * ld : nullptr; }
  __device__ __forceinline__ const bfraw* safe() const { return base; } };
struct BPlain { static constexpr bool kT = false; const float* B; int ldb; int n0; int N;
  __device__ __forceinline__ const float* col(int v) const { int n = n0 + v; return n < N ? B + n : nullptr; }
  __device__ __forceinline__ const float* safe() const { return B; } };

struct BTrans { static constexpr bool kT = true; const bfraw* Bt; int ldk; int n0;
  __device__ __forceinline__ const bfraw* nrow(int v) const { return Bt + (size_t)(n0 + v) * ldk; } };

__device__ __forceinline__ int sched_item(int k, int n, int bid) {
  const int G = (int)gridDim.x, nfull = n / G;
  if (k < nfull) return k * G + bid;
  if (k > nfull) return -1;
  const int R = n - nfull * G;
  int sr = bid;
  if (G == 512) { const int li = bid & 63, x = bid >> 6; sr = (((li >> 5) * 32 + (li & 1) * 16 + ((li & 31) >> 1)) << 3) + x; }
  return sr < R ? nfull * G + sr : -1;
}
#define FOR_ITEMS(w, n, bid) for (int k_ = 0, w = sched_item(0, (n), (bid)); w >= 0; w = sched_item(++k_, (n), (bid)))
template <int MI, int NST, class EPI>
__device__ __forceinline__ void gemm_dense_tile(const bfraw* A, int lda, const bfraw* Bt, int M, int N, int K, const EPI& epi, int m0, int n0, char* smem) {
  ARows af{A, lda, m0, M};
  BTrans bf{Bt, K, n0};
  auto ef = [&](const f32x16 (&acc)[MI][2], int wr, int wc, int lane) {
#pragma unroll
    for (int i = 0; i < MI; ++i)
#pragma unroll
      for (int j = 0; j < 2; ++j)
#pragma unroll
        for (int r = 0; r < 16; ++r) {
          int row = m0 + ACC_ROWM(MI, wr, i, r, lane), col = n0 + ACC_COL(wc, j, lane);
          if (row < M && col < N) epi(row, col, acc[i][j][r]);
        }
  };
  gemm_tile<MI, NST>(af, bf, ef, K, smem);
}
template <int MIUNUSED, class EPI>
__device__ __forceinline__ void gemm_dense(const bfraw* A, int lda, const bfraw* Bt, int M, int N, int K, const EPI& epi, int bid, char* smem) {
  const int mt = (M + 127) >> 7, nt = (N + 127) >> 7, G = (int)gridDim.x;
  const int U = mt * nt;
  int P = 0;
  if ((mt & 1) == 0) { P = ((U / (2 * G)) * G) / mt; if (2 * P > nt) P = nt >> 1; }
  const int nbig = P * mt;
  FOR_ITEMS(w, nbig, bid) {
    const int sr = w / mt, rem = w - sr * mt;
    gemm_dense_tile<4, 1>(A, lda, Bt, M, N, K, epi, (rem >> 1) * 256, (sr * 2 + (rem & 1)) * 128, smem);
  }
  const int ntr = nt - 2 * P;
  if (ntr * mt * 2 <= G) {
    FOR_ITEMS(w, ntr * mt * 2, bid) {
      const int u = w >> 1, nq = u / mt;
      gemm_dense_tile<1, 2>(A, lda, Bt, M, N, K, epi, (u - nq * mt) * 128 + (w & 1) * 64, (2 * P + nq) * 128, smem);
    }
    return;
  }
  const int nslots = ((ntr + 1) >> 1) * mt * 2;
  FOR_ITEMS(w, nslots, bid) {
    const int sr = w / (mt * 2), rem = w - sr * (mt * 2);
    const int n_t = 2 * P + sr * 2 + (rem & 1);
    if (n_t >= nt) continue;
    gemm_dense_tile<2, 2>(A, lda, Bt, M, N, K, epi, (rem >> 1) * 128, n_t * 128, smem);
  }
}


__device__ __forceinline__ void ph_win(const P& p, int layer, int bid, char* smem) {
  float* Z = p.Z();
  auto epi = [=](int row, int col, float v) { Z[(size_t)row * NIN + col] = v; };
  gemm_dense<2>(p.H(), LDH, p.winT() + (size_t)layer * 4224 * 2048, TTOT, NIN, 2048, epi, bid, smem);
}

__device__ __forceinline__ void ph_prep(const P& p, int layer, int bid, char* smem) {
  const int tid = otid(), lane = tid & 63, wid = tid >> 6;
  FOR_ROWS_TTOT(r, bid, wid) {
    const float* z = p.Z() + (size_t)r * NIN;
    float q[6]; float ss = 0.f;
#pragma unroll
    for (int i = 0; i < 6; ++i) { q[i] = z[ZC_CQ + i * 64 + lane]; ss += q[i] * q[i]; }
    ss = wave_sum(ss);
    float rs = rsqrtf(ss * (1.f / 384.f) + EPSV);
#pragma unroll
    for (int i = 0; i < 6; ++i) p.Aq()[(size_t)r * 384 + i * 64 + lane] = to_bf16(q[i] * rs * p.q_norm_w[layer * 384 + i * 64 + lane]);
    float k0 = z[ZC_CKV + lane], k1 = z[ZC_CKV + 64 + lane];
    float s2 = wave_sum(k0 * k0 + k1 * k1);
    float rs2 = rsqrtf(s2 * (1.f / 128.f) + EPSV);
    p.Akv()[(size_t)r * 128 + lane] = to_bf16(k0 * rs2 * p.kv_norm_w[layer * 128 + lane]);
    p.Akv()[(size_t)r * 128 + 64 + lane] = to_bf16(k1 * rs2 * p.kv_norm_w[layer * 128 + 64 + lane]);
  }
  const float* cw = p.conv_w + layer * 5 * 1024;
  const float* cb = p.conv_b + layer * 1024;
  const int ch = tid * 4;
  const f32x4v bias = *(const f32x4v*)(cb + ch);
  f32x4v wk[5];
#pragma unroll
  for (int k = 0; k < 5; ++k) wk[k] = *(const f32x4v*)(cw + k * 1024 + ch);
  FOR_ITEMS(rb, TTOT / 8, bid) {
    const int r0 = rb * 8;
    int base, len;
    if (r0 < TLAT) { base = (r0 >> 12) << 12; len = SL; } else { base = TLAT + (((r0 - TLAT) >> 8) << 8); len = CL; }
    const int t0 = r0 - base;
    f32x4v xw[12];
#pragma unroll
    for (int u = 0; u < 12; ++u) {
      const int tt = t0 + u - 2;
      const f32x4v zero = {0.f, 0.f, 0.f, 0.f};
      xw[u] = (tt >= 0 && tt < len) ? *(const f32x4v*)(p.Z() + (size_t)(base + tt) * NIN + ZC_XBC + ch) : zero;
    }
#pragma unroll
    for (int j = 0; j < 8; ++j) {
      f32x4v acc = bias;
#pragma unroll
      for (int k = 0; k < 5; ++k) acc += xw[j + k] * wk[k];
      acc[0] = siluf_(acc[0]); acc[1] = siluf_(acc[1]); acc[2] = siluf_(acc[2]); acc[3] = siluf_(acc[3]);
      const int r = r0 + j;
      float* cdst = ch < 512 ? p.ssd_xs() + (size_t)r * 512 + ch : (ch < 768 ? p.ssd_B() + (size_t)r * 256 + (ch - 512) : p.ssd_C() + (size_t)r * 256 + (ch - 768));
      store16_wt(cdst, __builtin_bit_cast(u32x4wt, acc));
    }
    if (tid < 128) {
      const int r = r0 + (tid >> 4), c = tid & 15;
      float v = p.Z()[(size_t)r * NIN + ZC_DT + c] + p.dt_bias[layer * 16 + c];
      p.ssd_dt()[(size_t)r * 16 + c] = v > 20.f ? v : log1pf(expf(v));
    }
  }
}

__device__ __forceinline__ void ph_qkv(const P& p, int layer, int bid, char* smem) {
  const int tid = otid();
  const float qscale = 0.07216878364870322f * 1.4426950408889634f;
  const float* rope = p.rope_cs();
  for (int r = bid; r < TTOT; r += gridDim.x) {
    const bool lat = r < TLAT;
    int b, pos;
    if (lat) { b = r >> 12; pos = r & 4095; } else { b = (r - TLAT) >> 8; pos = (r - TLAT) & 255; }
    const int kpos = lat ? pos : SL + pos;
    const float* zr = p.Z() + (size_t)r * NIN + ZC_KR;
    const int h = tid >> 6, e = tid & 63;
    float v;
    if (!lat) v = zr[e];
    else {
      const int a = e >> 5, half = (e >> 4) & 1, f = e & 15;
      const float x1 = zr[a * 32 + f], x2 = zr[a * 32 + 16 + f];
      const int idx = a == 0 ? (pos >> 6) : (pos & 63);
      const float cs = rope[(idx * 16 + f) * 2], sn = rope[(idx * 16 + f) * 2 + 1];
      v = half == 0 ? x1 * cs - x2 * sn : x1 * sn + x2 * cs;
    }
    p.K()[((size_t)(b * 4 + h) * NKEY + kpos) * 192 + 128 + e] = to_bf16(v);
  }
  {
    const bfraw* Bt = p.wuqT() + (size_t)layer * 768 * 384;
    FOR_ITEMS(w, 68 * 6, bid) {
      const int n_t = w / 68, m_t = w - n_t * 68;
      const int m0 = m_t * 128, n0 = n_t * 128;
      ARows af{p.Aq(), 384, m0, TTOT};
      BTrans bf{Bt, 384, n0};
      const bool lat = m0 < TLAT;
      const int b = lat ? (m0 >> 12) : ((m0 - TLAT) >> 8);
      const int pos0 = lat ? (m0 & 4095) : ((m0 - TLAT) & 255);
      auto ef = [&](const f32x16 (&acc)[2][2], int wr, int wc, int lane) {
        const int l31 = lane & 31;
#pragma unroll
        for (int j = 0; j < 2; ++j) {
          const int col = n0 + wc * 64 + j * 32;
          const int h = col / 192, d0 = col - h * 192;
          const bool isrope = lat && d0 >= 128;
          const int f = l31 & 15;
#pragma unroll
          for (int i = 0; i < 2; ++i)
#pragma unroll
            for (int r = 0; r < 16; ++r) {
              const int pos = pos0 + ACC_ROW(wr, i, r, lane);
              float v = acc[i][j][r];
              const float pv = xor16(v);
              if (isrope) {
                const int idx = d0 == 128 ? (pos >> 6) : (pos & 63);
                const float cs = rope[(idx * 16 + f) * 2], sn = rope[(idx * 16 + f) * 2 + 1];
                v = (l31 < 16) ? v * cs - pv * sn : pv * sn + v * cs;
              }
              bfraw* dst = lat ? p.Q() + ((size_t)(b * 4 + h) * SL + pos) * 192 : p.Qc() + ((size_t)(b * 4 + h) * CL + pos) * 192;
              dst[d0 + l31] = to_bf16(v * qscale);
            }
        }
      };
      gemm_tile<2>(af, bf, ef, 384, smem);
    }
  }
  {
    const bfraw* Bt = p.wukvT() + (size_t)layer * 1024 * 128;
    FOR_ITEMS(w, 68 * 8, bid) {
      const int n_t = w / 68, m_t = w - n_t * 68;
      const int m0 = m_t * 128, n0 = n_t * 128;
      ARows af{p.Akv(), 128, m0, TTOT};
      BTrans bf{Bt, 128, n0};
      const bool lat = m0 < TLAT;
      const int b = lat ? (m0 >> 12) : ((m0 - TLAT) >> 8);
      const int kpos0 = lat ? (m0 & 4095) : SL + ((m0 - TLAT) & 255);
      const int h = n_t >> 1;
      const bool isv = n_t & 1;
      auto ef = [&](const f32x16 (&acc)[2][2], int wr, int wc, int lane) {
        const int l31 = lane & 31, lh = lane >> 5;
        if (!isv) {
#pragma unroll
          for (int i = 0; i < 2; ++i)
#pragma unroll
            for (int j = 0; j < 2; ++j)
#pragma unroll
              for (int r = 0; r < 16; ++r) {
                const int kpos = kpos0 + ACC_ROW(wr, i, r, lane);
                p.K()[((size_t)(b * 4 + h) * NKEY + kpos) * 192 + wc * 64 + j * 32 + l31] = to_bf16(acc[i][j][r]);
              }
        } else {
#pragma unroll
          for (int i = 0; i < 2; ++i)
#pragma unroll
            for (int j = 0; j < 2; ++j) {
              const int d = wc * 64 + j * 32 + l31;
              bfraw* vrow = p.V() + ((size_t)(b * 4 + h) * 128 + d) * NKEY + kpos0 + wr * 64 + i * 32;
#pragma unroll
              for (int s = 0; s < 2; ++s) {
                uint4 t;
                t.x = pack_bf16(acc[i][j][8 * s + 0], acc[i][j][8 * s + 1]); t.y = pack_bf16(acc[i][j][8 * s + 2], acc[i][j][8 * s + 3]);
                t.z = pack_bf16(acc[i][j][8 * s + 4], acc[i][j][8 * s + 5]); t.w = pack_bf16(acc[i][j][8 * s + 6], acc[i][j][8 * s + 7]);
                *(uint4*)(vrow + 16 * s + 8 * lh) = t;
              }
            }
        }
      };
      gemm_tile<2>(af, bf, ef, 128, smem);
    }
  }
}

#define ATT_KROW 400
#define ATT_VROW 144
#define MFMA16(a, b, c) __builtin_amdgcn_mfma_f32_32x32x16_bf16(a, b, c, 0, 0, 0)
__device__ __forceinline__ void attn_item(const bfraw* __restrict__ Qp, const bfraw* __restrict__ Kp, const bfraw* __restrict__ Vtp,
                                          int nk, float* __restrict__ Op, float* __restrict__ MLp, char* smem) {
  char* Ks = smem;
  char* Vs = smem + 64 * ATT_KROW;
  int tid_ = threadIdx.x; asm volatile("" : "+v"(tid_));
  const int tid = tid_, lane = tid & 63, wid = tid >> 6, l31 = lane & 31, lh = lane >> 5;
  bf16x8 qf[12];
  {
    const bfraw* qrow = Qp + (size_t)(wid * 32 + l31) * 192 + lh * 8;
#pragma unroll
    for (int ks = 0; ks < 12; ++ks) qf[ks] = *(const bf16x8*)(qrow + ks * 16);
  }
  f32x16 o[4];
#pragma unroll
  for (int d = 0; d < 4; ++d)
#pragma unroll
    for (int r = 0; r < 16; ++r) o[d][r] = 0.f;
  float m = -INFINITY, l = 0.f;
  uint4 rk0, rk1, rk2, rk3, rk4, rk5, rv0, rv1, rv2, rv3;
#define ATT_KSRC(n, kt) (Kp + (size_t)((kt) + (tid + 256 * (n)) / 24) * 192 + ((tid + 256 * (n)) % 24) * 8)
#define ATT_VSRC(n, kt) (Vtp + (size_t)((tid + 256 * (n)) >> 3) * NKEY + (kt) + ((tid + 256 * (n)) & 7) * 8)
#define ATT_GLOAD(kt)                                                                                        \
  {                                                                                                          \
    rk0 = *(const uint4*)ATT_KSRC(0, kt); rk1 = *(const uint4*)ATT_KSRC(1, kt); rk2 = *(const uint4*)ATT_KSRC(2, kt); \
    rk3 = *(const uint4*)ATT_KSRC(3, kt); rk4 = *(const uint4*)ATT_KSRC(4, kt); rk5 = *(const uint4*)ATT_KSRC(5, kt); \
    rv0 = *(const uint4*)ATT_VSRC(0, kt); rv1 = *(const uint4*)ATT_VSRC(1, kt);                              \
    rv2 = *(const uint4*)ATT_VSRC(2, kt); rv3 = *(const uint4*)ATT_VSRC(3, kt);                              \
  }
#define ATT_KDST(n) (Ks + ((tid + 256 * (n)) / 24) * ATT_KROW + ((tid + 256 * (n)) % 24) * 16)
#define ATT_VDST(n) (Vs + ((tid + 256 * (n)) >> 3) * ATT_VROW + ((tid + 256 * (n)) & 7) * 16)
#define ATT_SWRITE()                                                                                         \
  {                                                                                                          \
    *(uint4*)ATT_KDST(0) = rk0; *(uint4*)ATT_KDST(1) = rk1; *(uint4*)ATT_KDST(2) = rk2;                      \
    *(uint4*)ATT_KDST(3) = rk3; *(uint4*)ATT_KDST(4) = rk4; *(uint4*)ATT_KDST(5) = rk5;                      \
    *(uint4*)ATT_VDST(0) = rv0; *(uint4*)ATT_VDST(1) = rv1; *(uint4*)ATT_VDST(2) = rv2; *(uint4*)ATT_VDST(3) = rv3; \
  }
  __syncthreads();
  ATT_GLOAD(0)
  ATT_SWRITE()
  __syncthreads();
  for (int kt = 0; kt < nk; kt += 64) {
    const bool more = (kt + 64) < nk;
    if (more) ATT_GLOAD(kt + 64)
    f32x16 s0, s1;
#pragma unroll
    for (int r = 0; r < 16; ++r) { s0[r] = 0.f; s1[r] = 0.f; }
    const char* kp = Ks + l31 * ATT_KROW + lh * 16;
#pragma unroll
    for (int ks = 0; ks < 12; ++ks) {
      bf16x8 a0 = *(const bf16x8*)(kp + ks * 32);
      bf16x8 a1 = *(const bf16x8*)(kp + 32 * ATT_KROW + ks * 32);
      s0 = MFMA16(a0, qf[ks], s0);
      s1 = MFMA16(a1, qf[ks], s1);
    }
    float tmax = fmaxf(s0[0], s1[0]);
#pragma unroll
    for (int r = 1; r < 16; ++r) tmax = fmaxf(tmax, fmaxf(s0[r], s1[r]));
    tmax = fmaxf(tmax, xor32(tmax));
    const float mn = fmaxf(m, tmax);
    const float alpha = __builtin_amdgcn_exp2f(m - mn);
    float rs = 0.f;
#pragma unroll
    for (int r = 0; r < 16; ++r) { s0[r] = __builtin_amdgcn_exp2f(s0[r] - mn); s1[r] = __builtin_amdgcn_exp2f(s1[r] - mn); rs += s0[r] + s1[r]; }
    rs += xor32(rs);
    l = l * alpha + rs;
    m = mn;
    if (__any(alpha != 1.f)) {
#pragma unroll
      for (int d = 0; d < 4; ++d)
#pragma unroll
        for (int r = 0; r < 16; ++r) o[d][r] *= alpha;
    }
    bf16x8 pf[4];
    {
      uint4 t;
      t.x = pack_bf16(s0[0], s0[1]); t.y = pack_bf16(s0[2], s0[3]); t.z = pack_bf16(s0[4], s0[5]); t.w = pack_bf16(s0[6], s0[7]);
      pf[0] = __builtin_bit_cast(bf16x8, t);
      t.x = pack_bf16(s0[8], s0[9]); t.y = pack_bf16(s0[10], s0[11]); t.z = pack_bf16(s0[12], s0[13]); t.w = pack_bf16(s0[14], s0[15]);
      pf[1] = __builtin_bit_cast(bf16x8, t);
      t.x = pack_bf16(s1[0], s1[1]); t.y = pack_bf16(s1[2], s1[3]); t.z = pack_bf16(s1[4], s1[5]); t.w = pack_bf16(s1[6], s1[7]);
      pf[2] = __builtin_bit_cast(bf16x8, t);
      t.x = pack_bf16(s1[8], s1[9]); t.y = pack_bf16(s1[10], s1[11]); t.z = pack_bf16(s1[12], s1[13]); t.w = pack_bf16(s1[14], s1[15]);
      pf[3] = __builtin_bit_cast(bf16x8, t);
    }
    const char* vp = Vs + l31 * ATT_VROW + lh * 16;
#pragma unroll
    for (int g16 = 0; g16 < 4; ++g16) {
#pragma unroll
      for (int d = 0; d < 4; ++d) {
        bf16x8 a = *(const bf16x8*)(vp + d * 32 * ATT_VROW + g16 * 32);
        o[d] = MFMA16(a, pf[g16], o[d]);
      }
    }
    __syncthreads();
    if (more) ATT_SWRITE()
    __syncthreads();
  }
  const float inv = 1.f;
  if (lh == 0) *(float2*)(MLp + (size_t)(wid * 32 + l31) * 2) = make_float2(m, l);
  float* tb = (float*)smem + wid * (32 * 129);
#pragma unroll
  for (int d = 0; d < 4; ++d)
#pragma unroll
    for (int r = 0; r < 16; ++r) tb[l31 * 129 + d * 32 + (r & 3) + 8 * (r >> 2) + 4 * lh] = o[d][r] * inv;
  __syncthreads();
  for (int i = lane; i < 32 * 32; i += 64) {
    const int q = i >> 5, c4 = i & 31;
    const float* s = tb + q * 129 + c4 * 4;
    { u32x4wt v; v[0] = __float_as_uint(s[0]); v[1] = __float_as_uint(s[1]); v[2] = __float_as_uint(s[2]); v[3] = __float_as_uint(s[3]);
      store16_wt(Op + (size_t)(wid * 32 + q) * 512 + c4 * 4, v); }
  }
  __syncthreads();
}

__device__ __forceinline__ int chunk_row0(int b, int cid) { return cid < 4 ? TLAT + b * CL + cid * 64 : b * SL + (cid - 4) * 64; }
__device__ __forceinline__ int step_of(int cid, int dir) { return dir == 0 ? cid : (cid < 4 ? 3 - cid : 71 - cid); }
__device__ __forceinline__ int cid_of(int s, int dir) { return dir == 0 ? s : (s < 4 ? 3 - s : 71 - s); }
#define MFMA32(a, b, c) __builtin_amdgcn_mfma_f32_32x32x2f32(a, b, c, 0, 0, 0)
#define ROW16(r, lh) (((r) & 3) + 8 * ((r) >> 2) + 4 * (lh))
__device__ __forceinline__ float wave_incl_scan(float v, int lane) {
  v += DPPF(v, 0x111, 0xF); v += DPPF(v, 0x112, 0xF); v += DPPF(v, 0x114, 0xF); v += DPPF(v, 0x118, 0xF);
  v += DPPF(v, 0x142, 0xA);
  v += DPPF(v, 0x143, 0xC);
  (void)lane;
  return v;
}

#define SSD_R256 272
#define SSD_R128 144
__device__ __forceinline__ void ssd_local_item(const P& p, int layer, int item, char* smem) {
  const int h = item & 7, cid = (item >> 3) % NSTEP, b = item / (8 * NSTEP);
  char* sBT = smem;
  char* sxf = sBT + 128 * SSD_R128;
  char* sxb = sxf + 64 * SSD_R128;
  float* swf = (float*)(sxb + 64 * SSD_R128);
  float* swb = swf + 64;
  int tid_ = threadIdx.x; asm volatile("" : "+v"(tid_));
  const int tid = tid_, lane = tid & 63, wid = tid >> 6, l31 = lane & 31, lh = lane >> 5;
  const int row0 = chunk_row0(b, cid), g = h >> 2;
  __syncthreads();
  if (wid < 2) {
    const int dir = wid;
    const float A = -__expf(p.a_log[layer * 16 + dir * 8 + h]);
    const int q = dir ? 63 - lane : lane;
    const float dt = p.ssd_dt()[(size_t)(row0 + q) * 16 + dir * 8 + h];
    const float ac = wave_incl_scan(dt * A, lane);
    const float tot = lane63(ac);
    (dir ? swb : swf)[q] = __expf(tot - ac) * dt;
    if (lane == 0) p.ssd_atot()[((b * 2 + dir) * 8 + h) * NSTEP + step_of(cid, dir)] = tot;
  }
#pragma unroll
  for (int u = 0; u < 8; ++u) {
    const int i = tid + 256 * u, q = i >> 5, c4 = i & 31;
    const float4 v = *(const float4*)(p.ssd_B() + (size_t)(row0 + q) * 256 + g * 128 + c4 * 4);
    *(bfraw*)(sBT + (c4 * 4 + 0) * SSD_R128 + q * 2) = to_bf16(v.x);
    *(bfraw*)(sBT + (c4 * 4 + 1) * SSD_R128 + q * 2) = to_bf16(v.y);
    *(bfraw*)(sBT + (c4 * 4 + 2) * SSD_R128 + q * 2) = to_bf16(v.z);
    *(bfraw*)(sBT + (c4 * 4 + 3) * SSD_R128 + q * 2) = to_bf16(v.w);
  }
  __syncthreads();
#pragma unroll
  for (int u = 0; u < 4; ++u) {
    const int i = tid + 256 * u, q = i >> 4, c4 = i & 15;
    const float4 v = *(const float4*)(p.ssd_xs() + (size_t)(row0 + q) * 512 + h * 64 + c4 * 4);
    const float wf = swf[q], wb = swb[q];
    *(bfraw*)(sxf + (c4 * 4 + 0) * SSD_R128 + q * 2) = to_bf16(v.x * wf); *(bfraw*)(sxb + (c4 * 4 + 0) * SSD_R128 + q * 2) = to_bf16(v.x * wb);
    *(bfraw*)(sxf + (c4 * 4 + 1) * SSD_R128 + q * 2) = to_bf16(v.y * wf); *(bfraw*)(sxb + (c4 * 4 + 1) * SSD_R128 + q * 2) = to_bf16(v.y * wb);
    *(bfraw*)(sxf + (c4 * 4 + 2) * SSD_R128 + q * 2) = to_bf16(v.z * wf); *(bfraw*)(sxb + (c4 * 4 + 2) * SSD_R128 + q * 2) = to_bf16(v.z * wb);
    *(bfraw*)(sxf + (c4 * 4 + 3) * SSD_R128 + q * 2) = to_bf16(v.w * wf); *(bfraw*)(sxb + (c4 * 4 + 3) * SSD_R128 + q * 2) = to_bf16(v.w * wb);
  }
  __syncthreads();
  f32x16 acc[2][2];
#pragma unroll
  for (int d = 0; d < 2; ++d)
#pragma unroll
    for (int t = 0; t < 2; ++t)
#pragma unroll
      for (int r = 0; r < 16; ++r) acc[d][t][r] = 0.f;
  const int pi = wid & 1, jj = wid >> 1;
  {
    const char* af = sxf + (pi * 32 + l31) * SSD_R128 + lh * 16;
    const char* ab = sxb + (pi * 32 + l31) * SSD_R128 + lh * 16;
    const char* bp = sBT + ((2 * jj) * 32 + l31) * SSD_R128 + lh * 16;
#pragma unroll
    for (int ks = 0; ks < 4; ++ks) {
      const bf16x8 a0 = *(const bf16x8*)(af + ks * 32), a1 = *(const bf16x8*)(ab + ks * 32);
      const bf16x8 b0 = *(const bf16x8*)(bp + ks * 32), b1 = *(const bf16x8*)(bp + 32 * SSD_R128 + ks * 32);
      acc[0][0] = MFMA16(a0, b0, acc[0][0]); acc[0][1] = MFMA16(a0, b1, acc[0][1]);
      acc[1][0] = MFMA16(a1, b0, acc[1][0]); acc[1][1] = MFMA16(a1, b1, acc[1][1]);
    }
  }
#pragma unroll
  for (int d = 0; d < 2; ++d) {
    bfraw* dst = p.ssd_st() + ((size_t)((b * 2 + d) * 8 + h) * NSTEP + step_of(cid, d)) * 8192;
#pragma unroll
    for (int t = 0; t < 2; ++t)
#pragma unroll
      for (int r = 0; r < 16; ++r) dst[(pi * 32 + ROW16(r, lh)) * 128 + (2 * jj + t) * 32 + l31] = to_bf16(acc[d][t][r]);
  }
}

__device__ __forceinline__ void ssd_out_item(const P& p, int layer, int item, char* smem) {
  const int h = item & 7, cid = (item >> 3) % NSTEP, b = item / (8 * NSTEP);
  char* sC = smem;
  char* sB = sC + 64 * SSD_R256;
  char* sxT = sB + 64 * SSD_R256;
  char* sP = sxT + 64 * SSD_R128;
  float* saf = (float*)(sP + 64 * SSD_R128);
  float* sab = saf + 64;
  float* sdf = sab + 64;
  float* sdb = sdf + 64;
  int tid_ = threadIdx.x; asm volatile("" : "+v"(tid_));
  const int tid = tid_, lane = tid & 63, wid = tid >> 6, l31 = lane & 31, lh = lane >> 5;
  const int row0 = chunk_row0(b, cid), g = h >> 2;
  const bfraw* hf = p.ssd_st() + ((size_t)((b * 2 + 0) * 8 + h) * NSTEP + step_of(cid, 0)) * 8192;
  const bfraw* hb = p.ssd_st() + ((size_t)((b * 2 + 1) * 8 + h) * NSTEP + step_of(cid, 1)) * 8192;
  u32x4g hreg[4];
#pragma unroll
  for (int u = 0; u < 4; ++u) { const int i = tid + 256 * u; hreg[u] = *(const u32x4g*)(hf + (i >> 4) * 128 + (i & 15) * 8); }
  __syncthreads();
#pragma unroll
  for (int u = 0; u < 4; ++u) {
    const int i = tid + 256 * u, q = i >> 4, c8 = i & 15;
    const float* cs = p.ssd_C() + (size_t)(row0 + q) * 256 + g * 128 + c8 * 8;
    const float* bs = p.ssd_B() + (size_t)(row0 + q) * 256 + g * 128 + c8 * 8;
    const float4 c0 = *(const float4*)cs, c1 = *(const float4*)(cs + 4), b0 = *(const float4*)bs, b1 = *(const float4*)(bs + 4);
    uint4 t;
    t.x = pack_bf16(c0.x, c0.y); t.y = pack_bf16(c0.z, c0.w); t.z = pack_bf16(c1.x, c1.y); t.w = pack_bf16(c1.z, c1.w);
    *(uint4*)(sC + q * SSD_R256 + c8 * 16) = t;
    t.x = pack_bf16(b0.x, b0.y); t.y = pack_bf16(b0.z, b0.w); t.z = pack_bf16(b1.x, b1.y); t.w = pack_bf16(b1.z, b1.w);
    *(uint4*)(sB + q * SSD_R256 + c8 * 16) = t;
  }
#pragma unroll
  for (int u = 0; u < 4; ++u) {
    const int i = tid + 256 * u, j = i >> 4, c4 = i & 15;
    const float4 xv = *(const float4*)(p.ssd_xs() + (size_t)(row0 + j) * 512 + h * 64 + c4 * 4);
    *(bfraw*)(sxT + (c4 * 4 + 0) * SSD_R128 + j * 2) = to_bf16(xv.x);
    *(bfraw*)(sxT + (c4 * 4 + 1) * SSD_R128 + j * 2) = to_bf16(xv.y);
    *(bfraw*)(sxT + (c4 * 4 + 2) * SSD_R128 + j * 2) = to_bf16(xv.z);
    *(bfraw*)(sxT + (c4 * 4 + 3) * SSD_R128 + j * 2) = to_bf16(xv.w);
  }
  if (wid < 2) {
    const int dir = wid;
    const float A = -__expf(p.a_log[layer * 16 + dir * 8 + h]);
    const int q = dir ? 63 - lane : lane;
    const float dt = p.ssd_dt()[(size_t)(row0 + q) * 16 + dir * 8 + h];
    const float ac = wave_incl_scan(dt * A, lane);
    (dir ? sab : saf)[q] = ac;
    (dir ? sdb : sdf)[q] = dt;
  }
  __syncthreads();
  const int it = wid >> 1, jt = wid & 1;
  {
    f32x16 sa;
#pragma unroll
    for (int r = 0; r < 16; ++r) sa[r] = 0.f;
    const char* ap = sC + (it * 32 + l31) * SSD_R256 + lh * 16;
    const char* bp = sB + (jt * 32 + l31) * SSD_R256 + lh * 16;
#pragma unroll
    for (int ks = 0; ks < 8; ++ks) sa = MFMA16(*(const bf16x8*)(ap + ks * 32), *(const bf16x8*)(bp + ks * 32), sa);
    const int j = jt * 32 + l31;
    const float afj = saf[j], abj = sab[j], dfj = sdf[j], dbj = sdb[j];
#pragma unroll
    for (int r = 0; r < 16; ++r) {
      const int i = it * 32 + ROW16(r, lh);
      float wgt = 0.f;
      if (j <= i) wgt += __expf(saf[i] - afj) * dfj;
      if (j >= i) wgt += __expf(sab[i] - abj) * dbj;
      *(bfraw*)(sP + i * SSD_R128 + j * 2) = to_bf16(sa[r] * wgt);
    }
  }
  __syncthreads();
#pragma unroll
  for (int u = 0; u < 4; ++u) { const int i = tid + 256 * u; *(u32x4g*)(sB + (i >> 4) * SSD_R256 + (i & 15) * 16) = hreg[u]; }
#pragma unroll
  for (int u = 0; u < 4; ++u) { const int i = tid + 256 * u; hreg[u] = *(const u32x4g*)(hb + (i >> 4) * 128 + (i & 15) * 8); }
  const int pt = wid & 1;
  f32x16 ya, gf, gb;
#pragma unroll
  for (int r = 0; r < 16; ++r) { ya[r] = 0.f; gf[r] = 0.f; gb[r] = 0.f; }
  {
    const char* ap = sP + (it * 32 + l31) * SSD_R128 + lh * 16;
    const char* bp = sxT + (pt * 32 + l31) * SSD_R128 + lh * 16;
#pragma unroll
    for (int ks = 0; ks < 4; ++ks) ya = MFMA16(*(const bf16x8*)(ap + ks * 32), *(const bf16x8*)(bp + ks * 32), ya);
  }
  __syncthreads();
  {
    const char* ap = sC + (it * 32 + l31) * SSD_R256 + lh * 16;
    const char* bp = sB + (pt * 32 + l31) * SSD_R256 + lh * 16;
#pragma unroll
    for (int ks = 0; ks < 8; ++ks) gf = MFMA16(*(const bf16x8*)(ap + ks * 32), *(const bf16x8*)(bp + ks * 32), gf);
  }
  __syncthreads();
#pragma unroll
  for (int u = 0; u < 4; ++u) { const int i = tid + 256 * u; *(u32x4g*)(sB + (i >> 4) * SSD_R256 + (i & 15) * 16) = hreg[u]; }
  __syncthreads();
  {
    const char* ap = sC + (it * 32 + l31) * SSD_R256 + lh * 16;
    const char* bp = sB + (pt * 32 + l31) * SSD_R256 + lh * 16;
#pragma unroll
    for (int ks = 0; ks < 8; ++ks) gb = MFMA16(*(const bf16x8*)(ap + ks * 32), *(const bf16x8*)(bp + ks * 32), gb);
  }
#pragma unroll
  for (int r = 0; r < 16; ++r) {
    const int i = it * 32 + ROW16(r, lh);
    p.ssd_y()[(size_t)(row0 + i) * 512 + h * 64 + pt * 32 + l31] = ya[r] + __expf(saf[i]) * gf[r] + __expf(sab[i]) * gb[r];
  }
}

__device__ __forceinline__ void ml_gates(const P& p, int layer, int row0, int h, int dir, int lane, float& bcum, float& li, float& tot) {
  const int j = dir ? 63 - lane : lane;
  const float* z = p.Z() + (size_t)(row0 + j) * NIN + ZC_MG + dir * 8;
  li = z[h] + p.gate_b[layer * 16 + dir * 8 + h];
  const float gf = z[4 + h] + p.gate_b[layer * 16 + dir * 8 + 4 + h];
  const float lf = gf >= 0.f ? -log1pf(expf(-gf)) : gf - log1pf(expf(gf));
  bcum = wave_incl_scan(lf, lane);
  tot = lane63(bcum);
}
__device__ __forceinline__ void ml_local_item(const P& p, int layer, int item, char* smem) {
  const int h = item & 3, cid = (item >> 2) % NSTEP, b = item / (4 * NSTEP);
  char* svf = smem;
  char* svb = svf + 128 * SSD_R128;
  char* skT = svb + 128 * SSD_R128;
  float* swf = (float*)(skT + 64 * SSD_R128);
  float* swb = swf + 64;
  int tid_ = threadIdx.x; asm volatile("" : "+v"(tid_));
  const int tid = tid_, lane = tid & 63, wid = tid >> 6, l31 = lane & 31, lh = lane >> 5;
  const int row0 = chunk_row0(b, cid);
  __syncthreads();
  if (wid < 2) {
    const int dir = wid;
    float bc, li, tot;
    ml_gates(p, layer, row0, h, dir, lane, bc, li, tot);
    const int j = dir ? 63 - lane : lane;
    (dir ? swb : swf)[j] = __expf(tot - bc + li);
    if (lane == 0) p.ml_gtot()[((b * 2 + dir) * 4 + h) * NSTEP + step_of(cid, dir)] = tot;
  }
#pragma unroll
  for (int u = 0; u < 4; ++u) {
    const int i = tid + 256 * u, j = i >> 4, c4 = i & 15;
    const float4 v = *(const float4*)(p.Z() + (size_t)(row0 + j) * NIN + ZC_MK + h * 64 + c4 * 4);
    *(bfraw*)(skT + (c4 * 4 + 0) * SSD_R128 + j * 2) = to_bf16(v.x);
    *(bfraw*)(skT + (c4 * 4 + 1) * SSD_R128 + j * 2) = to_bf16(v.y);
    *(bfraw*)(skT + (c4 * 4 + 2) * SSD_R128 + j * 2) = to_bf16(v.z);
    *(bfraw*)(skT + (c4 * 4 + 3) * SSD_R128 + j * 2) = to_bf16(v.w);
  }
  __syncthreads();
#pragma unroll
  for (int u = 0; u < 8; ++u) {
    const int i = tid + 256 * u, j = i >> 5, c4 = i & 31;
    const float4 v = *(const float4*)(p.Z() + (size_t)(row0 + j) * NIN + ZC_MV + h * 128 + c4 * 4);
    const float wf = swf[j], wb = swb[j];
    *(bfraw*)(svf + (c4 * 4 + 0) * SSD_R128 + j * 2) = to_bf16(v.x * wf); *(bfraw*)(svb + (c4 * 4 + 0) * SSD_R128 + j * 2) = to_bf16(v.x * wb);
    *(bfraw*)(svf + (c4 * 4 + 1) * SSD_R128 + j * 2) = to_bf16(v.y * wf); *(bfraw*)(svb + (c4 * 4 + 1) * SSD_R128 + j * 2) = to_bf16(v.y * wb);
    *(bfraw*)(svf + (c4 * 4 + 2) * SSD_R128 + j * 2) = to_bf16(v.z * wf); *(bfraw*)(svb + (c4 * 4 + 2) * SSD_R128 + j * 2) = to_bf16(v.z * wb);
    *(bfraw*)(svf + (c4 * 4 + 3) * SSD_R128 + j * 2) = to_bf16(v.w * wf); *(bfraw*)(svb + (c4 * 4 + 3) * SSD_R128 + j * 2) = to_bf16(v.w * wb);
  }
  __syncthreads();
  f32x16 acc[2][2];
#pragma unroll
  for (int d = 0; d < 2; ++d)
#pragma unroll
    for (int t = 0; t < 2; ++t)
#pragma unroll
      for (int r = 0; r < 16; ++r) acc[d][t][r] = 0.f;
  const int vt = wid;
  {
    const char* af = svf + (vt * 32 + l31) * SSD_R128 + lh * 16;
    const char* ab = svb + (vt * 32 + l31) * SSD_R128 + lh * 16;
    const char* bp = skT + l31 * SSD_R128 + lh * 16;
#pragma unroll
    for (int ks = 0; ks < 4; ++ks) {
      const bf16x8 a0 = *(const bf16x8*)(af + ks * 32), a1 = *(const bf16x8*)(ab + ks * 32);
      const bf16x8 b0 = *(const bf16x8*)(bp + ks * 32), b1 = *(const bf16x8*)(bp + 32 * SSD_R128 + ks * 32);
      acc[0][0] = MFMA16(a0, b0, acc[0][0]); acc[0][1] = MFMA16(a0, b1, acc[0][1]);
      acc[1][0] = MFMA16(a1, b0, acc[1][0]); acc[1][1] = MFMA16(a1, b1, acc[1][1]);
    }
  }
#pragma unroll
  for (int d = 0; d < 2; ++d) {
    bfraw* dst = p.ml_st() + ((size_t)((b * 2 + d) * 4 + h) * NSTEP + step_of(cid, d)) * 8192;
#pragma unroll
    for (int t = 0; t < 2; ++t)
#pragma unroll
      for (int r = 0; r < 16; ++r) dst[(vt * 32 + ROW16(r, lh)) * 64 + t * 32 + l31] = to_bf16(acc[d][t][r]);
  }
  if (tid < 128) {
    const int d = tid >> 6, kk = tid & 63;
    const float* w = d ? swb : swf;
    const char* kr = skT + kk * SSD_R128;
    float sacc = 0.f;
    for (int j = 0; j < 64; ++j) sacc += w[j] * from_bf16(*(const bfraw*)(kr + j * 2));
    p.ml_nst()[((size_t)((b * 2 + d) * 4 + h) * NSTEP + step_of(cid, d)) * 64 + kk] = sacc;
  }
}

__device__ __forceinline__ void ml_out_item(const P& p, int layer, int item, char* smem) {
  const int h = item & 3, cid = (item >> 2) % NSTEP, b = item / (4 * NSTEP);
  char* sq = smem;
  char* sk = sq + 64 * SSD_R128;
  char* svT = sk + 64 * SSD_R128;
  char* sPf = svT + 128 * SSD_R128;
  char* sPb = sPf + 64 * SSD_R128;
  char* sCs = sPb + 64 * SSD_R128;
  float* sbf = (float*)(sCs + 128 * SSD_R128);
  float* sbb = sbf + 64;
  float* slf = sbb + 64;
  float* slb = slf + 64;
  float* sdenf = slb + 64;
  float* sdenb = sdenf + 64;
  float* snf = sdenb + 64;
  float* snb = snf + 64;
  int tid_ = threadIdx.x; asm volatile("" : "+v"(tid_));
  const int tid = tid_, lane = tid & 63, wid = tid >> 6, l31 = lane & 31, lh = lane >> 5;
  const int row0 = chunk_row0(b, cid);
  const size_t slotf = ((size_t)((b * 2 + 0) * 4 + h) * NSTEP + step_of(cid, 0));
  const size_t slotb = ((size_t)((b * 2 + 1) * 4 + h) * NSTEP + step_of(cid, 1));
  const bfraw* csf = p.ml_st() + slotf * 8192;
  const bfraw* csb = p.ml_st() + slotb * 8192;
  u32x4g creg[4];
#pragma unroll
  for (int u = 0; u < 4; ++u) { const int i = tid + 256 * u; creg[u] = *(const u32x4g*)(csf + (i >> 3) * 64 + (i & 7) * 8); }
  __syncthreads();
#pragma unroll
  for (int u = 0; u < 4; ++u) {
    const int i = tid + 256 * u, j = i >> 4, c4 = i & 15;
    const float4 kv = *(const float4*)(p.Z() + (size_t)(row0 + j) * NIN + ZC_MK + h * 64 + c4 * 4);
    const float4 qv = *(const float4*)(p.Z() + (size_t)(row0 + j) * NIN + ZC_MQ + h * 64 + c4 * 4);
    uint2 t;
    t.x = pack_bf16(kv.x, kv.y); t.y = pack_bf16(kv.z, kv.w);
    *(uint2*)(sk + j * SSD_R128 + c4 * 8) = t;
    t.x = pack_bf16(qv.x * 0.125f, qv.y * 0.125f); t.y = pack_bf16(qv.z * 0.125f, qv.w * 0.125f);
    *(uint2*)(sq + j * SSD_R128 + c4 * 8) = t;
  }
#pragma unroll
  for (int u = 0; u < 8; ++u) {
    const int i = tid + 256 * u, j = i >> 5, c4 = i & 31;
    const float4 vv = *(const float4*)(p.Z() + (size_t)(row0 + j) * NIN + ZC_MV + h * 128 + c4 * 4);
    *(bfraw*)(svT + (c4 * 4 + 0) * SSD_R128 + j * 2) = to_bf16(vv.x);
    *(bfraw*)(svT + (c4 * 4 + 1) * SSD_R128 + j * 2) = to_bf16(vv.y);
    *(bfraw*)(svT + (c4 * 4 + 2) * SSD_R128 + j * 2) = to_bf16(vv.z);
    *(bfraw*)(svT + (c4 * 4 + 3) * SSD_R128 + j * 2) = to_bf16(vv.w);
  }
#pragma unroll
  for (int u = 0; u < 4; ++u) { const int i = tid + 256 * u; *(u32x4g*)(sCs + (i >> 3) * SSD_R128 + (i & 7) * 16) = creg[u]; }
#pragma unroll
  for (int u = 0; u < 4; ++u) { const int i = tid + 256 * u; creg[u] = *(const u32x4g*)(csb + (i >> 3) * 64 + (i & 7) * 8); }
  if (wid < 2) {
    const int dir = wid;
    float bc, li, tot;
    ml_gates(p, layer, row0, h, dir, lane, bc, li, tot);
    const int j = dir ? 63 - lane : lane;
    (dir ? sbb : sbf)[j] = bc;
    (dir ? slb : slf)[j] = li;
    (dir ? snb : snf)[lane] = p.ml_nst()[(dir ? slotb : slotf) * 64 + lane];
  }
  __syncthreads();
  const int it = wid >> 1, jt = wid & 1;
  {
    f32x16 sa;
#pragma unroll
    for (int r = 0; r < 16; ++r) sa[r] = 0.f;
    const char* ap = sq + (it * 32 + l31) * SSD_R128 + lh * 16;
    const char* bp = sk + (jt * 32 + l31) * SSD_R128 + lh * 16;
#pragma unroll
    for (int ks = 0; ks < 4; ++ks) sa = MFMA16(*(const bf16x8*)(ap + ks * 32), *(const bf16x8*)(bp + ks * 32), sa);
    const int j = jt * 32 + l31;
    const float bfj = sbf[j], bbj = sbb[j], lfj = slf[j], lbj = slb[j];
#pragma unroll
    for (int r = 0; r < 16; ++r) {
      const int i = it * 32 + ROW16(r, lh);
      *(bfraw*)(sPf + i * SSD_R128 + j * 2) = to_bf16(j <= i ? sa[r] * __expf(sbf[i] - bfj + lfj) : 0.f);
      *(bfraw*)(sPb + i * SSD_R128 + j * 2) = to_bf16(j >= i ? sa[r] * __expf(sbb[i] - bbj + lbj) : 0.f);
    }
  }
  __syncthreads();
  if (tid < 128) {
    const int d = tid >> 6, i = tid & 63;
    const char* Pm = (d ? sPb : sPf) + i * SSD_R128;
    const char* qr = sq + i * SSD_R128;
    const float* ns = d ? snb : snf;
    float rs = 0.f, qn = 0.f;
    for (int j = 0; j < 64; ++j) { rs += from_bf16(*(const bfraw*)(Pm + j * 2)); qn += from_bf16(*(const bfraw*)(qr + j * 2)) * ns[j]; }
    (d ? sdenb : sdenf)[i] = rs + __expf((d ? sbb : sbf)[i]) * qn;
  }
  const int v0 = 2 * (wid & 1);
  f32x16 nf[2], nb[2], gf[2], gb[2];
#pragma unroll
  for (int t = 0; t < 2; ++t)
#pragma unroll
    for (int r = 0; r < 16; ++r) { nf[t][r] = 0.f; nb[t][r] = 0.f; gf[t][r] = 0.f; gb[t][r] = 0.f; }
  {
    const char* apf = sPf + (it * 32 + l31) * SSD_R128 + lh * 16;
    const char* apb = sPb + (it * 32 + l31) * SSD_R128 + lh * 16;
    const char* aq = sq + (it * 32 + l31) * SSD_R128 + lh * 16;
    const char* bv = svT + (v0 * 32 + l31) * SSD_R128 + lh * 16;
    const char* bc = sCs + (v0 * 32 + l31) * SSD_R128 + lh * 16;
#pragma unroll
    for (int ks = 0; ks < 4; ++ks) {
      const bf16x8 af = *(const bf16x8*)(apf + ks * 32), ab = *(const bf16x8*)(apb + ks * 32), qa = *(const bf16x8*)(aq + ks * 32);
      const bf16x8 b0 = *(const bf16x8*)(bv + ks * 32), b1 = *(const bf16x8*)(bv + 32 * SSD_R128 + ks * 32);
      const bf16x8 c0 = *(const bf16x8*)(bc + ks * 32), c1 = *(const bf16x8*)(bc + 32 * SSD_R128 + ks * 32);
      nf[0] = MFMA16(af, b0, nf[0]); nf[1] = MFMA16(af, b1, nf[1]);
      nb[0] = MFMA16(ab, b0, nb[0]); nb[1] = MFMA16(ab, b1, nb[1]);
      gf[0] = MFMA16(qa, c0, gf[0]); gf[1] = MFMA16(qa, c1, gf[1]);
    }
  }
  __syncthreads();
#pragma unroll
  for (int r = 0; r < 16; ++r) {
    const int i = it * 32 + ROW16(r, lh);
    const float ef = __expf(sbf[i]);
    const float idf = 1.f / fmaxf(fabsf(sdenf[i]), 1.f), idb = 1.f / fmaxf(fabsf(sdenb[i]), 1.f);
#pragma unroll
    for (int t = 0; t < 2; ++t) nf[t][r] = (nf[t][r] + ef * gf[t][r]) * idf + nb[t][r] * idb;
  }
#pragma unroll
  for (int u = 0; u < 4; ++u) { const int i = tid + 256 * u; *(u32x4g*)(sCs + (i >> 3) * SSD_R128 + (i & 7) * 16) = creg[u]; }
  __syncthreads();
  {
    const char* aq = sq + (it * 32 + l31) * SSD_R128 + lh * 16;
    const char* bc = sCs + (v0 * 32 + l31) * SSD_R128 + lh * 16;
#pragma unroll
    for (int ks = 0; ks < 4; ++ks) {
      const bf16x8 qa = *(const bf16x8*)(aq + ks * 32);
      gb[0] = MFMA16(qa, *(const bf16x8*)(bc + ks * 32), gb[0]);
      gb[1] = MFMA16(qa, *(const bf16x8*)(bc + 32 * SSD_R128 + ks * 32), gb[1]);
    }
  }
#pragma unroll
  for (int r = 0; r < 16; ++r) {
    const int i = it * 32 + ROW16(r, lh);
    const float eb = __expf(sbb[i]);
    const float idb = 1.f / fmaxf(fabsf(sdenb[i]), 1.f);
#pragma unroll
    for (int t = 0; t < 2; ++t)
      p.ml_h()[(size_t)(row0 + i) * 512 + h * 128 + (v0 + t) * 32 + l31] = nf[t][r] + eb * gb[t][r] * idb;
  }
}

__device__ __forceinline__ float gelu_tanh(float x) {
  const float k0 = 0.7978845608028654f;
  return 0.5f * x * (1.f + tanhf(k0 * (x + 0.044715f * x * x * x)));
}
__device__ __forceinline__ void s5_drive(const P& p, int dg, int row0, int dir, int g, int lane, float (&sre)[64], float (&sim)[64]) {
  const int l31 = lane & 31, lh = lane >> 5;
  bf16x8 ua[2];
#pragma unroll
  for (int tt = 0; tt < 2; ++tt) {
    const int tp = 32 * tt + l31;
    const int row = dir ? row0 + 63 - tp : row0 + tp;
    const float* zp = p.Z() + (size_t)row * NIN + ZC_U + g * 16 + 8 * lh;
    const float4 a = *(const float4*)zp, b = *(const float4*)(zp + 4);
    uint4 t; t.x = pack_bf16(a.x, a.y); t.y = pack_bf16(a.z, a.w); t.z = pack_bf16(b.x, b.y); t.w = pack_bf16(b.z, b.w);
    ua[tt] = __builtin_bit_cast(bf16x8, t);
  }
  bf16x8 bfr[4];
#pragma unroll
  for (int pt = 0; pt < 4; ++pt) bfr[pt] = *(const bf16x8*)(p.s5_bbh() + ((size_t)dg * 128 + 32 * pt + l31) * 16 + 8 * lh);
  f32x16 d[2][4];
#pragma unroll
  for (int tt = 0; tt < 2; ++tt)
#pragma unroll
    for (int pt = 0; pt < 4; ++pt) {
      f32x16 z;
#pragma unroll
      for (int r = 0; r < 16; ++r) z[r] = 0.f;
      d[tt][pt] = __builtin_amdgcn_mfma_f32_32x32x16_bf16(ua[tt], bfr[pt], z, 0, 0, 0);
    }
#pragma unroll
  for (int tt = 0; tt < 2; ++tt)
#pragma unroll
    for (int r = 0; r < 16; ++r) {
      const float myre = lh ? d[tt][1][r] : d[tt][0][r];
      const float myim = lh ? d[tt][3][r] : d[tt][2][r];
      const float gre = lh ? d[tt][0][r] : d[tt][1][r];
      const float gim = lh ? d[tt][2][r] : d[tt][3][r];
      const float ore = xor32(gre), oim = xor32(gim);
      const int tb = 32 * tt + 8 * (r >> 2) + (r & 3);
      sre[tb] = lh ? ore : myre; sre[tb + 4] = lh ? myre : ore;
      sim[tb] = lh ? oim : myim; sim[tb + 4] = lh ? myim : oim;
    }
}

__device__ __forceinline__ void s5_local_item(const P& p, int layer, int witem, char* smem) {
  int tid_ = threadIdx.x; asm volatile("" : "+v"(tid_));
  const int lane = tid_ & 63;
  const int g = witem & 31, st = (witem >> 5) % NSTEP, dir = (witem / (32 * NSTEP)) & 1, b = witem / (64 * NSTEP);
  const int cid = cid_of(st, dir), row0 = chunk_row0(b, cid);
  const int dg = (layer * 2 + dir) * 32 + g;
  float sre[64], sim[64];
  s5_drive(p, dg, row0, dir, g, lane, sre, sim);
  const float ar = p.s5_a()[(dg * 64 + lane) * 2], ai = p.s5_a()[(dg * 64 + lane) * 2 + 1];
  float xr = 0.f, xi = 0.f;
#pragma unroll
  for (int t = 0; t < 64; ++t) {
    const float nr = ar * xr - ai * xi + sre[t];
    const float ni = ar * xi + ai * xr + sim[t];
    xr = nr; xi = ni;
  }
  const size_t slot = ((size_t)((b * 2 + dir) * 32 + g) * NSTEP + st);
  p.s5_st()[(slot * 64 + lane) * 2] = xr; p.s5_st()[(slot * 64 + lane) * 2 + 1] = xi;
}

#define S5_XROW 272
__device__ __forceinline__ void s5_out_item(const P& p, int layer, int witem, char* smem) {
  int tid_ = threadIdx.x; asm volatile("" : "+v"(tid_));
  const int lane = tid_ & 63, wid = tid_ >> 6, l31 = lane & 31, lh = lane >> 5;
  char* sX = smem + wid * (64 * S5_XROW);
  const int g = witem & 31, cid = (witem >> 5) % NSTEP, b = witem / (32 * NSTEP);
  const int row0 = chunk_row0(b, cid);
  const bfraw* cmrow = p.s5_cmh() + ((size_t)(layer * 32 + g) * 32 + l31) * 128 + 8 * lh;
  f32x16 yf[2], yb[2];
#pragma unroll 1
  for (int dir = 0; dir < 2; ++dir) {
    const int st = step_of(cid, dir);
    const int dg = (layer * 2 + dir) * 32 + g;
    const size_t slot = ((size_t)((b * 2 + dir) * 32 + g) * NSTEP + st);
    float sre[64], sim[64];
    s5_drive(p, dg, row0, dir, g, lane, sre, sim);
    const float ar = p.s5_a()[(dg * 64 + lane) * 2], ai = p.s5_a()[(dg * 64 + lane) * 2 + 1];
    float xr = p.s5_st()[(slot * 64 + lane) * 2], xi = p.s5_st()[(slot * 64 + lane) * 2 + 1];
#pragma unroll
    for (int t = 0; t < 64; ++t) {
      const float nr = ar * xr - ai * xi + sre[t];
      const float ni = ar * xi + ai * xr + sim[t];
      xr = nr; xi = ni;
      *(bfraw*)(sX + t * S5_XROW + lane * 2) = to_bf16(xr);
      *(bfraw*)(sX + t * S5_XROW + 128 + lane * 2) = to_bf16(xi);
    }
    f32x16 y0, y1;
#pragma unroll
    for (int r = 0; r < 16; ++r) { y0[r] = 0.f; y1[r] = 0.f; }
    const char* ap = sX + l31 * S5_XROW + lh * 16;
#pragma unroll
    for (int ks = 0; ks < 8; ++ks) {
      const bf16x8 a0 = *(const bf16x8*)(ap + ks * 32);
      const bf16x8 a1 = *(const bf16x8*)(ap + 32 * S5_XROW + ks * 32);
      const bf16x8 cf = *(const bf16x8*)(cmrow + 16 * ks);
      y0 = __builtin_amdgcn_mfma_f32_32x32x16_bf16(a0, cf, y0, 0, 0, 0);
      y1 = __builtin_amdgcn_mfma_f32_32x32x16_bf16(a1, cf, y1, 0, 0, 0);
    }
    if (dir == 0) { yf[0] = y0; yf[1] = y1; } else { yb[0] = y0; yb[1] = y1; }
  }
  const float dsk = p.s5_d[layer * 512 + g * 16 + (l31 & 15)];
#pragma unroll
  for (int tt = 0; tt < 2; ++tt)
#pragma unroll
    for (int r = 0; r < 16; ++r) {
      const float ybv = xor32(yb[1 - tt][15 - r]);
      if (l31 < 16) {
        const int t = 32 * tt + ROW16(r, lh);
        const float u = p.Z()[(size_t)(row0 + t) * NIN + ZC_U + g * 16 + l31];
        const float gy = gelu_tanh(yf[tt][r] + ybv + dsk * u);
        const size_t o = (size_t)(row0 + t) * 512 + g * 16 + l31;
        p.ydpre()[o] = gy;
        p.ydpre_bf()[o] = to_bf16(gy);
      }
    }
}

#define N_SSD_CH (2 * NSTEP * 8)
#define N_ML_CH (2 * NSTEP * 4)
#define N_S5_BLK (2 * 2 * NSTEP * 32 / 4)
__device__ __forceinline__ void ph_mixA(const P& p, int layer, int bid, char* smem) {
  FOR_ITEMS(w, N_SSD_CH + N_ML_CH + N_S5_BLK, bid) {
    if (w < N_SSD_CH) ssd_local_item(p, layer, w, smem);
    else if (w < N_SSD_CH + N_ML_CH) ml_local_item(p, layer, w - N_SSD_CH, smem);
    else { __syncthreads(); s5_local_item(p, layer, (w - N_SSD_CH - N_ML_CH) * 4 + (otid() >> 6), smem); }
  }
}
#define N_ATT_LAT 256
#define N_ATT_CTX 16
__device__ __forceinline__ void ph_scan(const P& p, int layer, int bid, char* smem) {
  const int nitems = 256 + 128 + 4 + 32;
  const int tid = otid();
  for (int w = bid; w < nitems; w += gridDim.x) {
    int it = w;
    if (it < 256) {
      const int idx = it * 256 + tid, seq = idx >> 11, off = idx & 2047;
      uint2* base = (uint2*)(p.ssd_st() + (size_t)seq * NSTEP * 8192) + off;
      const float* at = p.ssd_atot() + seq * NSTEP;
      float4 hh = make_float4(0.f, 0.f, 0.f, 0.f);
#pragma unroll 4
      for (int s2 = 0; s2 < NSTEP; ++s2) {
        const uint2 tb = base[(size_t)s2 * 2048];
        uint2 ob; ob.x = pack_bf16(hh.x, hh.y); ob.y = pack_bf16(hh.z, hh.w);
        base[(size_t)s2 * 2048] = ob;
        const float e = expf(at[s2]);
        hh.x = e * hh.x + __uint_as_float(tb.x << 16); hh.y = e * hh.y + __uint_as_float(tb.x & 0xffff0000u);
        hh.z = e * hh.z + __uint_as_float(tb.y << 16); hh.w = e * hh.w + __uint_as_float(tb.y & 0xffff0000u);
      }
      continue;
    }
    it -= 256;
    if (it < 128) {
      const int idx = it * 256 + tid, seq = idx >> 11, off = idx & 2047;
      uint2* base = (uint2*)(p.ml_st() + (size_t)seq * NSTEP * 8192) + off;
      const float* at = p.ml_gtot() + seq * NSTEP;
      float4 hh = make_float4(0.f, 0.f, 0.f, 0.f);
#pragma unroll 4
      for (int s2 = 0; s2 < NSTEP; ++s2) {
        const uint2 tb = base[(size_t)s2 * 2048];
        uint2 ob; ob.x = pack_bf16(hh.x, hh.y); ob.y = pack_bf16(hh.z, hh.w);
        base[(size_t)s2 * 2048] = ob;
        const float e = expf(at[s2]);
        hh.x = e * hh.x + __uint_as_float(tb.x << 16); hh.y = e * hh.y + __uint_as_float(tb.x & 0xffff0000u);
        hh.z = e * hh.z + __uint_as_float(tb.y << 16); hh.w = e * hh.w + __uint_as_float(tb.y & 0xffff0000u);
      }
      continue;
    }
    it -= 128;
    if (it < 4) {
      const int idx = it * 256 + tid, seq = idx >> 6, off = idx & 63;
      float* base = p.ml_nst() + (size_t)seq * NSTEP * 64 + off;
      const float* at = p.ml_gtot() + seq * NSTEP;
      float hh = 0.f;
      for (int s2 = 0; s2 < NSTEP; ++s2) {
        float t = base[s2 * 64]; base[s2 * 64] = hh;
        hh = expf(at[s2]) * hh + t;
      }
      continue;
    }
    it -= 4;
    {
      const int idx = it * 256 + tid, seq = idx >> 6, sp = idx & 63;
      const int g = seq & 31, dir = (seq >> 5) & 1;
      const int dg = (layer * 2 + dir) * 32 + g;
      float pr = p.s5_a()[(dg * 64 + sp) * 2], pi = p.s5_a()[(dg * 64 + sp) * 2 + 1];
#pragma unroll
      for (int q = 0; q < 6; ++q) { float nr = pr * pr - pi * pi, ni = 2.f * pr * pi; pr = nr; pi = ni; }
      float* base = p.s5_st() + ((size_t)seq * NSTEP * 64 + sp) * 2;
      float xr = 0.f, xi = 0.f;
      for (int s2 = 0; s2 < NSTEP; ++s2) {
        float tr = base[s2 * 128], ti = base[s2 * 128 + 1];
        base[s2 * 128] = xr; base[s2 * 128 + 1] = xi;
        float nr = pr * xr - pi * xi + tr, ni = pr * xi + pi * xr + ti;
        xr = nr; xi = ni;
      }
    }
  }
}
__device__ __forceinline__ void ph_attn(const P& p, int layer, int bid, char* smem) {
  const int natt = 512 + (layer == 0 ? 32 : 0);
  for (int w = bid; w < natt; w += gridDim.x) {
    int it = w;
    const bfraw *qp, *kp, *vp; int nk, row0, hh, part;
    if (it < 512) {
      part = it & 1; const int qb = (it >> 1) & 31; hh = (it >> 6) & 3; const int b = it >> 8;
      qp = p.Q() + ((size_t)(b * 4 + hh) * SL + qb * 128) * 192;
      kp = p.K() + ((size_t)(b * 4 + hh) * NKEY + part * (NKEY / 2)) * 192;
      vp = p.V() + (size_t)(b * 4 + hh) * 128 * NKEY + part * (NKEY / 2);
      nk = NKEY / 2; row0 = b * SL + qb * 128;
    } else {
      it -= 512;
      part = it & 1; const int qb = (it >> 1) & 1; hh = (it >> 2) & 3; const int b = it >> 4;
      qp = p.Qc() + ((size_t)(b * 4 + hh) * CL + qb * 128) * 192;
      kp = p.K() + ((size_t)(b * 4 + hh) * NKEY + SL + part * (CL / 2)) * 192;
      vp = p.V() + (size_t)(b * 4 + hh) * 128 * NKEY + SL + part * (CL / 2);
      nk = CL / 2; row0 = TLAT + b * CL + qb * 128;
    }
    float* op = (part ? p.O2() : p.O()) + (size_t)row0 * 512 + hh * 128;
    float* ml = p.attn_ml() + ((size_t)(part * 4 + hh) * TTOT + row0) * 2;
    attn_item(qp, kp, vp, nk, op, ml, smem);
  }
}
__device__ __forceinline__ void ph_mixC(const P& p, int layer, int bid, char* smem) {
  FOR_ITEMS(w, N_SSD_CH + N_ML_CH + N_S5_BLK / 2, bid) {
    if (w < N_SSD_CH) ssd_out_item(p, layer, w, smem);
    else if (w < N_SSD_CH + N_ML_CH) ml_out_item(p, layer, w - N_SSD_CH, smem);
    else { __syncthreads(); s5_out_item(p, layer, (w - N_SSD_CH - N_ML_CH) * 4 + (otid() >> 6), smem); }
  }
}

__device__ __forceinline__ void ph_glu(const P& p, int layer, int bid, char* smem) {
  const float* yp = p.ydpre(); float* yg = p.ydg(); const float* gb = p.glu_b + layer * 512;
  auto epi = [=](int row, int col, float v) {
    float y = yp[(size_t)row * 512 + col];
    yg[(size_t)row * 512 + col] = y * sigmoidf_(v + gb[col]);
  };
  gemm_dense<2>(p.ydpre_bf(), 512, p.wgluT() + (size_t)layer * 512 * 512, layer == 0 ? TTOT : TLAT, 512, 512, epi, bid, smem);
}

__device__ __forceinline__ void ph_final_mix(const P& p, int layer, int bid, char* smem) {
  const int tid = otid(), lane = tid & 63, wid = tid >> 6;
  const float* onw = p.out_norm_w + layer * 2048;
  const int nrows = layer == 0 ? TTOT : TLAT;
  for (int rpb_ = (nrows % (int)gridDim.x) == 0 ? nrows / (int)gridDim.x : 0, i_ = wid, r = rpb_ ? bid * rpb_ + i_ : bid * 4 + wid;
       rpb_ ? i_ < rpb_ : r < nrows; i_ += 4, r = rpb_ ? bid * rpb_ + i_ : r + (int)gridDim.x * 4) {
    const float* z = p.Z() + (size_t)r * NIN;
    bfraw* Y = p.Y() + (size_t)r * LDH;
    const int c = lane * 8;
    f32x4v a0 = *(const f32x4v*)(p.O() + (size_t)r * 512 + c), a1 = *(const f32x4v*)(p.O() + (size_t)r * 512 + c + 4);
    {
      const f32x4v b0 = *(const f32x4v*)(p.O2() + (size_t)r * 512 + c), b1 = *(const f32x4v*)(p.O2() + (size_t)r * 512 + c + 4);
      const float2 ml0 = *(const float2*)(p.attn_ml() + ((size_t)(lane >> 4) * TTOT + r) * 2);
      const float2 ml1 = *(const float2*)(p.attn_ml() + ((size_t)(4 + (lane >> 4)) * TTOT + r) * 2);
      const float mm = fmaxf(ml0.x, ml1.x);
      const float w0 = exp2f(ml0.x - mm), w1 = exp2f(ml1.x - mm);
      const float inv = 1.f / (ml0.y * w0 + ml1.y * w1);
      a0 = (a0 * w0 + b0 * w1) * inv; a1 = (a1 * w0 + b1 * w1) * inv;
    }
    f32x4v y0 = *(const f32x4v*)(p.ssd_y() + (size_t)r * 512 + c), y1 = *(const f32x4v*)(p.ssd_y() + (size_t)r * 512 + c + 4);
    f32x4v x0 = *(const f32x4v*)(p.ssd_xs() + (size_t)r * 512 + c), x1 = *(const f32x4v*)(p.ssd_xs() + (size_t)r * 512 + c + 4);
    f32x4v g0 = *(const f32x4v*)(z + ZC_BZ + c), g1 = *(const f32x4v*)(z + ZC_BZ + c + 4);
    f32x4v h0 = *(const f32x4v*)(p.ml_h() + (size_t)r * 512 + c), h1 = *(const f32x4v*)(p.ml_h() + (size_t)r * 512 + c + 4);
    f32x4v o0 = *(const f32x4v*)(z + ZC_MO + c), o1 = *(const f32x4v*)(z + ZC_MO + c + 4);
    f32x4v d0 = *(const f32x4v*)(p.ydg() + (size_t)r * 512 + c), d1 = *(const f32x4v*)(p.ydg() + (size_t)r * 512 + c + 4);
    const float dsk = p.ssd_d[layer * 8 + (c >> 6)];
    float sa = 0.f, sb = 0.f, sc = 0.f, sd = 0.f;
    float bv[8], av[8], cv[8], dv[8];
#pragma unroll
    for (int i = 0; i < 4; ++i) {
      av[i] = a0[i]; av[4 + i] = a1[i];
      bv[i] = (y0[i] + dsk * x0[i]) * siluf_(g0[i]); bv[4 + i] = (y1[i] + dsk * x1[i]) * siluf_(g1[i]);
      cv[i] = h0[i]; cv[4 + i] = h1[i];
      dv[i] = d0[i]; dv[4 + i] = d1[i];
    }
#pragma unroll
    for (int i = 0; i < 8; ++i) { sa += av[i] * av[i]; sb += bv[i] * bv[i]; sc += cv[i] * cv[i]; sd += dv[i] * dv[i]; }
    sa = wave_sum(sa); sb = wave_sum(sb); sd = wave_sum(sd);
    sc = row16_sum(sc);
    const float ra = rsqrtf(sa * (1.f / 512.f) + EPSV), rb = rsqrtf(sb * (1.f / 512.f) + EPSV);
    const float rc = rsqrtf(sc * (1.f / 128.f) + EPSV), rd = rsqrtf(sd * (1.f / 512.f) + EPSV);
    float ogv[8];
#pragma unroll
    for (int i = 0; i < 4; ++i) { ogv[i] = sigmoidf_(o0[i]); ogv[4 + i] = sigmoidf_(o1[i]); }
    uint4 ua, ub, uc, ud;
    const float* w = onw + c;
    ua.x = pack_bf16(av[0] * ra * w[0], av[1] * ra * w[1]); ua.y = pack_bf16(av[2] * ra * w[2], av[3] * ra * w[3]);
    ua.z = pack_bf16(av[4] * ra * w[4], av[5] * ra * w[5]); ua.w = pack_bf16(av[6] * ra * w[6], av[7] * ra * w[7]);
    w = onw + 512 + c;
    ub.x = pack_bf16(bv[0] * rb * w[0], bv[1] * rb * w[1]); ub.y = pack_bf16(bv[2] * rb * w[2], bv[3] * rb * w[3]);
    ub.z = pack_bf16(bv[4] * rb * w[4], bv[5] * rb * w[5]); ub.w = pack_bf16(bv[6] * rb * w[6], bv[7] * rb * w[7]);
    w = onw + 1024 + c;
    uc.x = pack_bf16(cv[0] * rc * ogv[0] * w[0], cv[1] * rc * ogv[1] * w[1]); uc.y = pack_bf16(cv[2] * rc * ogv[2] * w[2], cv[3] * rc * ogv[3] * w[3]);
    uc.z = pack_bf16(cv[4] * rc * ogv[4] * w[4], cv[5] * rc * ogv[5] * w[5]); uc.w = pack_bf16(cv[6] * rc * ogv[6] * w[6], cv[7] * rc * ogv[7] * w[7]);
    w = onw + 1536 + c;
    ud.x = pack_bf16(dv[0] * rd * w[0], dv[1] * rd * w[1]); ud.y = pack_bf16(dv[2] * rd * w[2], dv[3] * rd * w[3]);
    ud.z = pack_bf16(dv[4] * rd * w[4], dv[5] * rd * w[5]); ud.w = pack_bf16(dv[6] * rd * w[6], dv[7] * rd * w[7]);
    store16_wt(Y + c, __builtin_bit_cast(u32x4wt, ua)); store16_wt(Y + 512 + c, __builtin_bit_cast(u32x4wt, ub));
    store16_wt(Y + 1024 + c, __builtin_bit_cast(u32x4wt, uc)); store16_wt(Y + 1536 + c, __builtin_bit_cast(u32x4wt, ud));
  }
}

__device__ __forceinline__ void ph_wout(const P& p, int layer, int bid, char* smem) {
  const P pp = p;
  const int M = layer == 0 ? TTOT : TLAT;
  auto epi = [=](int row, int col, float v) {
    const int mi = row_modidx(row);
    const float g1 = pp.modv()[(layer * 3 + mi) * 12288 + 2 * 2048 + col];
    float xin;
    if (layer == 0) xin = row < TLAT ? pp.x[(size_t)row * 2048 + col] : pp.ctx[(size_t)(row - TLAT) * 2048 + col];
    else xin = pp.X()[(size_t)row * 2048 + col];
    pp.X()[(size_t)row * 2048 + col] = xin + g1 * v;
  };
  gemm_dense<2>(p.Y(), LDH, p.woutT() + (size_t)layer * 2048 * 2048, M, 2048, 2048, epi, bid, smem);
}

__device__ __forceinline__ void ph_router(const P& p, int layer, int bid, char* smem) {
  float* sA = (float*)smem;
  float* sW = sA + 16 * 129;
  float* sNW = sW + 128 * 64;
  float* sSH = sNW + 2048;
  float* srs = sSH + 2048;
  float* sL = sW;
  const int tid = otid(), lane = tid & 63, wid = tid >> 6, l15 = lane & 15, l4 = lane >> 4;
  const int T = layer == 0 ? TTOT : TLAT;
  const float* nw = p.norm2_w + layer * 2048;
  const float* wg = p.w_group + (size_t)layer * 2048 * 4;
  const float* we = p.w_expert + (size_t)layer * 2048 * 32;
  typedef float f32x4a __attribute__((ext_vector_type(4)));
  __syncthreads();
  for (int i = tid; i < 128 * 28; i += 256) sW[(i / 28) * 64 + 36 + (i % 28)] = 0.f;
  const int ar = tid >> 4, aks = (tid & 15) * 8;
  const int wk = tid >> 1, whalf = tid & 1;
  for (int item = bid; item < (T >> 4); item += gridDim.x) {
    const int row0 = item * 16;
    const int mi = row_modidx(row0);
    const float* mrow = p.modv() + (layer * 3 + mi) * 12288;
    __syncthreads();
    for (int i = tid; i < 2048; i += 256) { sNW[i] = nw[i] * (1.f + mrow[4 * 2048 + i]); sSH[i] = mrow[3 * 2048 + i]; }
#pragma unroll 2
    for (int rr = 0; rr < 4; ++rr) {
      const float* xr = p.X() + (size_t)(row0 + wid * 4 + rr) * 2048 + lane * 4;
      float ss = 0.f;
#pragma unroll
      for (int i = 0; i < 8; ++i) { float4 v = *(const float4*)(xr + i * 256); ss += v.x * v.x + v.y * v.y + v.z * v.z + v.w * v.w; }
      ss = wave_sum(ss);
      if (lane == 0) srs[wid * 4 + rr] = rsqrtf(ss * (1.f / 2048.f) + EPSV);
    }
    __syncthreads();
    const float rs = srs[ar];
    const float* xrow = p.X() + (size_t)(row0 + ar) * 2048 + aks;
    bfraw* hrow = p.H() + (size_t)(row0 + ar) * LDH + aks;
    float4 xa0, xa1, wv0, wv1, wv2, wv3, wv4;
#define RT_GLOAD(k0)                                                                                   \
    {                                                                                                  \
      xa0 = *(const float4*)(xrow + (k0)); xa1 = *(const float4*)(xrow + (k0) + 4);                    \
      const float* er = we + (size_t)((k0) + wk) * 32 + (whalf ? 12 : 0);                              \
      wv0 = *(const float4*)(er); wv1 = *(const float4*)(er + 4); wv2 = *(const float4*)(er + 8);      \
      wv3 = *(const float4*)(er + 12); wv4 = *(const float4*)(er + 16);                                \
      if (!whalf) wv3 = *(const float4*)(wg + (size_t)((k0) + wk) * 4);                                \
    }
#define RT_A4(q, v)                                                                                    \
    {                                                                                                  \
      const int kq_ = (k0w) + aks + (q) * 4;                                                           \
      float h0 = v.x * rs * sNW[kq_] + sSH[kq_], h1 = v.y * rs * sNW[kq_ + 1] + sSH[kq_ + 1];          \
      float h2 = v.z * rs * sNW[kq_ + 2] + sSH[kq_ + 2], h3 = v.w * rs * sNW[kq_ + 3] + sSH[kq_ + 3];  \
      float* d = sA + ar * 129 + aks + (q) * 4; d[0] = h0; d[1] = h1; d[2] = h2; d[3] = h3;            \
      uint2 hb; hb.x = pack_bf16(h0, h1); hb.y = pack_bf16(h2, h3);                                    \
      *(uint2*)(hrow + (k0w) + (q) * 4) = hb;                                                          \
    }
#define RT_SWRITE()                                                                                    \
    {                                                                                                  \
      RT_A4(0, xa0) RT_A4(1, xa1)                                                                      \
      float* w = sW + wk * 64;                                                                         \
      if (!whalf) {                                                                                    \
        w[0] = wv3.x; w[1] = wv3.y; w[2] = wv3.z; w[3] = wv3.w;                                        \
        w[4] = wv0.x; w[5] = wv0.y; w[6] = wv0.z; w[7] = wv0.w; w[8] = wv1.x; w[9] = wv1.y; w[10] = wv1.z; w[11] = wv1.w; \
        w[12] = wv2.x; w[13] = wv2.y; w[14] = wv2.z; w[15] = wv2.w;                                    \
      } else {                                                                                         \
        w[16] = wv0.x; w[17] = wv0.y; w[18] = wv0.z; w[19] = wv0.w; w[20] = wv1.x; w[21] = wv1.y; w[22] = wv1.z; w[23] = wv1.w; \
        w[24] = wv2.x; w[25] = wv2.y; w[26] = wv2.z; w[27] = wv2.w; w[28] = wv3.x; w[29] = wv3.y; w[30] = wv3.z; w[31] = wv3.w; \
        w[32] = wv4.x; w[33] = wv4.y; w[34] = wv4.z; w[35] = wv4.w;                                    \
      }                                                                                                \
    }
    int k0w = 0;
    RT_GLOAD(0)
    RT_SWRITE()
    __syncthreads();
    f32x4a acc0 = {0.f, 0.f, 0.f, 0.f}, acc1 = acc0, acc2 = acc0;
    const float* ap = sA + l15 * 129 + wid * 32 + l4;
    const float* bp = sW + (wid * 32 + l4) * 64 + l15;
    for (int k0 = 0; k0 < 2048; k0 += 128) {
      const bool more = (k0 + 128) < 2048;
      if (more) RT_GLOAD(k0 + 128)
#pragma unroll
      for (int ks = 0; ks < 8; ++ks) {
        const float a = ap[4 * ks];
        const float* bq = bp + 4 * ks * 64;
        acc0 = __builtin_amdgcn_mfma_f32_16x16x4f32(a, bq[0], acc0, 0, 0, 0);
        acc1 = __builtin_amdgcn_mfma_f32_16x16x4f32(a, bq[16], acc1, 0, 0, 0);
        acc2 = __builtin_amdgcn_mfma_f32_16x16x4f32(a, bq[32], acc2, 0, 0, 0);
      }
      __syncthreads();
      k0w = k0 + 128;
      if (more) RT_SWRITE()
      __syncthreads();
    }
#pragma unroll
    for (int r = 0; r < 4; ++r) {
      float* d = sL + (wid * 16 + 4 * l4 + r) * 64 + l15;
      d[0] = acc0[r]; d[16] = acc1[r]; d[32] = acc2[r];
    }
    __syncthreads();
    if (tid < 16) {
      const int r = row0 + tid;
      float lg[36];
#pragma unroll
      for (int j = 0; j < 36; ++j) lg[j] = sL[(0 * 16 + tid) * 64 + j] + sL[(1 * 16 + tid) * 64 + j] + sL[(2 * 16 + tid) * 64 + j] + sL[(3 * 16 + tid) * 64 + j];
      int gi = 0; float gm = lg[0];
#pragma unroll
      for (int j = 1; j < 4; ++j) if (lg[j] > gm) { gm = lg[j]; gi = j; }
      float gs = 0.f;
#pragma unroll
      for (int j = 0; j < 4; ++j) gs += expf(lg[j] - gm);
      const float gw = 1.f / gs;
      int i1 = 0, i2 = -1; float v1 = -INFINITY, v2 = -INFINITY;
#pragma unroll
      for (int j = 0; j < 8; ++j) {
        const float e = gi == 0 ? lg[4 + j] : (gi == 1 ? lg[12 + j] : (gi == 2 ? lg[20 + j] : lg[28 + j]));
        if (e > v1) { v2 = v1; i2 = i1; v1 = e; i1 = j; }
        else if (e > v2) { v2 = e; i2 = j; }
      }
      const float e2 = expf(v2 - v1);
      const float w1 = gw / (1.f + e2), w2 = gw * e2 / (1.f + e2);
      const int ex1 = gi * 8 + i1, ex2 = gi * 8 + i2;
      int* cnt = p.cnt() + layer * 32;
      const int p1 = atomicAdd(&cnt[ex1], 1);
      p.list_tok()[ex1 * CAPE + p1] = r * 2; p.list_w()[ex1 * CAPE + p1] = w1;
      const int p2 = atomicAdd(&cnt[ex2], 1);
      p.list_tok()[ex2 * CAPE + p2] = r * 2 + 1; p.list_w()[ex2 * CAPE + p2] = w2;
    }
  }
}

struct AGather { const bfraw* H; const int* toks; int nvalid;
  __device__ __forceinline__ const bfraw* row(int r) const { return r < nvalid ? H + (size_t)(toks[r] >> 1) * LDH : nullptr; }
  __device__ __forceinline__ const bfraw* safe() const { return H; } };
struct BGateUp { static constexpr bool kT = false; const float *g, *u; int ldb; int nb;
  __device__ __forceinline__ const float* col(int v) const { int wc = v >> 6, j = (v >> 5) & 1, c = v & 31;
    const float* b = g + (ptrdiff_t)j * (u - g); return b + nb + wc * 32 + c; }
  __device__ __forceinline__ const float* safe() const { return g; } };

__device__ __forceinline__ void moe_prefix(const P& p, int layer, int* spre) {
  __syncthreads();
  if (otid() == 0) {
    int acc = 0;
    for (int e = 0; e < 32; ++e) { spre[e] = acc; acc += (p.cnt()[layer * 32 + e] + 127) >> 7; }
    spre[32] = acc;
  }
  __syncthreads();
}
template <int MI>
__device__ __forceinline__ void moe_up_tile(const P& p, int layer, int e, int row0, int cnt, int arow0, int nt, char* smem) {
  AGather af{p.H(), p.list_tok() + e * CAPE + row0, cnt - row0};
  const size_t wo = ((size_t)layer * 32 + e) * 2048 * 512;
  BGateUp bf{p.w_gate + wo, p.w_up + wo, 512, nt * 64};
  bfraw* act = p.ACT() + (size_t)arow0 * LDACT + nt * 64;
  auto ef = [&](const f32x16 (&acc)[MI][2], int wr, int wc, int lane) {
#pragma unroll
    for (int i = 0; i < MI; ++i)
#pragma unroll
      for (int r = 0; r < 16; ++r) {
        int row = ACC_ROWM(MI, wr, i, r, lane);
        float gv = acc[i][0][r], uv = acc[i][1][r];
        act[(size_t)row * LDACT + wc * 32 + (lane & 31)] = to_bf16(siluf_(gv) * uv);
      }
  };
  gemm_tile<MI>(af, bf, ef, 2048, smem);
}
#define MOE_FIND(spre, t) __builtin_amdgcn_readfirstlane(__popcll(__ballot((otid() & 63) < 31 && (spre)[(otid() & 63) + 1] <= (t))))
__device__ __forceinline__ void ph_moe_up(const P& p, int layer, int bid, char* smem) {
  int* spre = (int*)(smem + 65536);
  moe_prefix(p, layer, spre);
  const int n = spre[32] * 8, G = (int)gridDim.x, nfull = n / G, R = n - nfull * G;
  for (int k = 0; k < nfull; ++k) {
    const int w = k * G + bid, rbg = w >> 3, nt = w & 7;
    const int e = MOE_FIND(spre, rbg);
    const int rb = rbg - spre[e];
    moe_up_tile<2>(p, layer, e, rb * 128, p.cnt()[layer * 32 + e], rbg * 128, nt, smem);
  }
  if (R * 2 <= G) {
    FOR_ITEMS(w2, R * 2, bid) {
      const int w = nfull * G + (w2 >> 1), rbg = w >> 3, nt = w & 7, h = w2 & 1;
      const int e = MOE_FIND(spre, rbg);
      const int rb = rbg - spre[e];
      moe_up_tile<1>(p, layer, e, rb * 128 + h * 64, p.cnt()[layer * 32 + e], rbg * 128 + h * 64, nt, smem);
    }
  } else {
    const int w = sched_item(nfull, n, bid);
    if (w >= 0) {
      const int rbg = w >> 3, nt = w & 7;
      const int e = MOE_FIND(spre, rbg);
      const int rb = rbg - spre[e];
      moe_up_tile<2>(p, layer, e, rb * 128, p.cnt()[layer * 32 + e], rbg * 128, nt, smem);
    }
  }
}
__device__ __forceinline__ void ph_moe_down(const P& p, int layer, int bid, char* smem) {
  int* spre = (int*)(smem + 65536);
  moe_prefix(p, layer, spre);
  const int ntile = spre[32];
  FOR_ITEMS(w, ntile * 16, bid) {
    const int rbg = w >> 4, nt = w & 15;
    const int e = MOE_FIND(spre, rbg);
    const int rb = rbg - spre[e];
    const int nvalid = p.cnt()[layer * 32 + e] - rb * 128;
    ARows af{p.ACT() + (size_t)rbg * 128 * LDACT, LDACT, 0, 128};
    BPlain bf{p.w_down + ((size_t)layer * 32 + e) * 512 * 2048, 2048, nt * 128, 2048};
    const int* toks = p.list_tok() + e * CAPE + rb * 128;
    const float* lw = p.list_w() + e * CAPE + rb * 128;
    bfraw* Ys = p.Yslot();
    auto ef = [&](const f32x16 (&acc)[2][2], int wr, int wc, int lane) {
#pragma unroll
      for (int i = 0; i < 2; ++i)
#pragma unroll
        for (int r = 0; r < 16; ++r) {
          int row = ACC_ROW(wr, i, r, lane);
          if (row < nvalid) {
            int ts = toks[row]; float wgt = lw[row];
#pragma unroll
            for (int j = 0; j < 2; ++j) Ys[(size_t)ts * 2048 + nt * 128 + ACC_COL(wc, j, lane)] = to_bf16(wgt * acc[i][j][r]);
          }
        }
    };
    gemm_tile<2>(af, bf, ef, 512, smem);
  }
}

__device__ __forceinline__ void ph_out(const P& p, int bid, char* smem) {
  const int tid = otid(), lane = tid & 63, wid = tid >> 6;
  for (int r = bid * 4 + wid; r < TLAT; r += gridDim.x * 4) {
    const int mi = r >> 12;
    const float* g2 = p.modv() + (1 * 3 + mi) * 12288 + 5 * 2048;
    f32x4v v[8];
    float ss = 0.f;
#pragma unroll
    for (int q = 0; q < 8; ++q) {
      const int col = q * 256 + lane * 4;
      f32x4v xv = *(const f32x4v*)(p.X() + (size_t)r * 2048 + col);
      const f32x4v gv = *(const f32x4v*)(g2 + col);
      const f32x4v y0 = ld_bf16x4(p.Yslot() + (size_t)(2 * r) * 2048 + col);
      const f32x4v y1 = ld_bf16x4(p.Yslot() + (size_t)(2 * r + 1) * 2048 + col);
      xv += gv * (y0 + y1);
      v[q] = xv;
      ss += xv[0] * xv[0] + xv[1] * xv[1] + xv[2] * xv[2] + xv[3] * xv[3];
    }
    ss = wave_sum(ss);
    const float rs = rsqrtf(ss * (1.f / 2048.f) + EPSV);
#pragma unroll
    for (int q = 0; q < 8; ++q) {
      const int col = q * 256 + lane * 4;
      const f32x4v w4 = *(const f32x4v*)(p.final_w + col);
      { const f32x4v ov = v[q] * rs * w4; store16_wt(p.out + (size_t)r * 2048 + col, __builtin_bit_cast(u32x4wt, ov)); }
    }
  }
}

#define SMEM_BYTES 81792
#define XB_TMO      128
#define XB_XCNT(j)  (256  + 64 * (j))
#define XB_XSUB(j)  (1280 + 64 * (j))
#define XB_XGEN(j)  (2304 + 64 * (j))
#define XB_TOP      3328
#define XB_TOPGEN   3392
#define XB_SPIN_CAP (1u << 22)
#define LAS __attribute__((address_space(3)))
__device__ __forceinline__ unsigned xb_ld(unsigned* p)              { return __hip_atomic_load(p, __ATOMIC_RELAXED, __HIP_MEMORY_SCOPE_AGENT); }
__device__ __forceinline__ unsigned xb_add(unsigned* p, unsigned v) { return __hip_atomic_fetch_add(p, v, __ATOMIC_RELAXED, __HIP_MEMORY_SCOPE_AGENT); }
__device__ __forceinline__ unsigned xb_xcc_id() { return (unsigned)__builtin_amdgcn_s_getreg((3 << 11) | 20) & 0xFu; }
#define XB_SPIN(cond, bar) do { unsigned _sp = 0; while (cond) { __builtin_amdgcn_s_sleep(1); \
    if ((++_sp & 255u) == 0u) { if (xb_ld(&(bar)[XB_TMO])) break; if (_sp > XB_SPIN_CAP) { atomicAdd(&(bar)[XB_TMO], 1u); break; } } } } while (0)
struct XcdBarrier { unsigned* bar; unsigned x; unsigned rank; volatile LAS unsigned* st; };
__device__ __forceinline__ XcdBarrier xcd_barrier_post(unsigned* bar, volatile LAS unsigned* st) {
    XcdBarrier b; b.bar = bar; b.x = xb_xcc_id(); b.st = st;
    b.rank = 0u;
    if (threadIdx.x == 0) b.rank = xb_add(&bar[XB_XCNT(b.x)], 1u);
    return b;
}
__device__ __forceinline__ void xcd_barrier_complete(unsigned* bar, unsigned x, unsigned& nloc, unsigned& nx) {
    const unsigned G = gridDim.x * gridDim.y * gridDim.z;
    unsigned sum, cnt, mine, sp = 0u;
    for (;;) {
        sum = 0u; cnt = 0u; mine = 0u;
#pragma unroll
        for (unsigned j = 0; j < 16; ++j) { const unsigned c = xb_ld(&bar[XB_XCNT(j)]); sum += c; cnt += (c > 0u) ? 1u : 0u; mine = (j == x) ? c : mine; }
        if (sum == G) break;
        __builtin_amdgcn_s_sleep(1);
        if ((++sp & 255u) == 0u) { if (xb_ld(&bar[XB_TMO])) break; if (sp > XB_SPIN_CAP) { atomicAdd(&bar[XB_TMO], 1u); break; } }
    }
    nloc = mine > 0u ? mine : 1u; nx = cnt > 0u ? cnt : 1u;
}
__device__ __forceinline__ void xcd_barrier(const XcdBarrier& b) {
    asm volatile("s_waitcnt vmcnt(0)" ::: "memory");
    __syncthreads();
    if (threadIdx.x == 0) {
        unsigned* bar = b.bar;
        __builtin_amdgcn_s_waitcnt(0);
        unsigned nloc = b.st[0], nx = b.st[1];
        if (nloc == 0u) { xcd_barrier_complete(bar, b.x, nloc, nx); b.st[0] = nloc; b.st[1] = nx; }
        const unsigned old = xb_add(&bar[XB_XSUB(b.x)], 1u);
        const unsigned gen = old / nloc;
        if (old + 1u == (gen + 1u) * nloc) {
            __builtin_amdgcn_fence(__ATOMIC_RELEASE, "agent");
            asm volatile("s_waitcnt vmcnt(0)" ::: "memory");
            const unsigned og = xb_add(&bar[XB_TOP], 1u);
            const unsigned tg = og / nx;
            if (og + 1u == (tg + 1u) * nx) xb_add(&bar[XB_TOPGEN], 1u);
            else XB_SPIN(xb_ld(&bar[XB_TOPGEN]) == tg, bar);
            __builtin_amdgcn_fence(__ATOMIC_ACQUIRE, "agent");
            xb_add(&bar[XB_XGEN(b.x)], 1u);
            asm volatile("s_waitcnt vmcnt(0)" ::: "memory");
        } else {
            XB_SPIN(xb_ld(&bar[XB_XGEN(b.x)]) == gen, bar);
            __builtin_amdgcn_fence(__ATOMIC_ACQUIRE, "agent");
            asm volatile("s_waitcnt vmcnt(0)" ::: "memory");
        }
    }
    __syncthreads();
}

__global__ void __launch_bounds__(256, 2) k_fused(P p, unsigned* bar) {
  extern __shared__ __attribute__((aligned(16))) char smem_all[];
  char* smem = smem_all + 64;
  if (threadIdx.x == 0) *(uint4*)smem_all = make_uint4(0u, 0u, 0u, 0u);
  __syncthreads();
  XcdBarrier b = xcd_barrier_post(bar, (volatile LAS unsigned*)smem_all);
#define LAYER_PROGRAM(L)                                                              \
  {                                                                                   \
    ph_norm1(p, L, bid, smem); xcd_barrier(b);          \
    ph_win(p, L, bid, smem); xcd_barrier(b);                          \
    ph_prep(p, L, bid, smem); xcd_barrier(b);           \
    ph_qkv(p, L, bid, smem); ph_mixA(p, L, bid, smem); xcd_barrier(b);     \
    ph_attn(p, L, bid, smem); ph_scan(p, L, bid, smem); xcd_barrier(b);    \
    ph_mixC(p, L, bid, smem); xcd_barrier(b);             \
    ph_glu(p, L, bid, smem); xcd_barrier(b);                                \
    ph_final_mix(p, L, bid, smem); xcd_barrier(b);      \
    ph_wout(p, L, bid, smem); xcd_barrier(b);                \
    ph_router(p, L, bid, smem); xcd_barrier(b);         \
    ph_moe_up(p, L, bid, smem); xcd_barrier(b);                    \
    ph_moe_down(p, L, bid, smem); xcd_barrier(b);       \
  }
  ph_mod(p, smem); ph_wprep(p, blockIdx.x, smem); xcd_barrier(b);
  if (threadIdx.x == 0) {
    unsigned pre = 0u;
    for (unsigned j = 0; j < 16; ++j) { const unsigned c = xb_ld(&bar[XB_XCNT(j)]); if (j < b.x) pre += c; }
    ((volatile LAS unsigned*)smem_all)[2] = pre + b.rank;
  }
  __syncthreads();
  const int bid = __builtin_amdgcn_readfirstlane((int)((volatile LAS unsigned*)smem_all)[2]);
  LAYER_PROGRAM(0)
  LAYER_PROGRAM(1)
  ph_out(p, bid, smem);
}

extern "C" void kernel_launch(void* const* d_in, const int* in_sizes, int n_in, void* d_out, int out_size, void* d_ws,
                              size_t ws_size, hipStream_t stream) {
  P p{};
  const float* const* in = (const float* const*)d_in;
  p.x = in[0]; p.c = in[1]; p.ctx = in[2]; p.c_ctx = in[3]; p.mod_w = in[4]; p.mod_b = in[5]; p.norm1_w = in[6];
  p.w_in = in[7]; p.q_norm_w = in[8]; p.kv_norm_w = in[9]; p.w_uq = in[10]; p.w_ukv = in[11]; p.conv_w = in[12];
  p.conv_b = in[13]; p.a_log = in[14]; p.dt_bias = in[15]; p.ssd_d = in[16]; p.gate_b = in[17]; p.lam_re = in[18];
  p.lam_im = in[19]; p.log_dt = in[20]; p.b_re = in[21]; p.b_im = in[22]; p.c_re = in[23]; p.c_im = in[24];
  p.s5_d = in[25]; p.glu_w = in[26]; p.glu_b = in[27]; p.out_norm_w = in[28]; p.w_out = in[29]; p.norm2_w = in[30];
  p.w_group = in[31]; p.w_expert = in[32]; p.w_gate = in[33]; p.w_up = in[34]; p.w_down = in[35]; p.final_w = in[36];
  p.out = (float*)d_out;
  p.ws = (float*)d_ws;
  (void)ws_size; (void)in_sizes; (void)n_in; (void)out_size;

  unsigned* bar = (unsigned*)((float*)d_ws + WO_bar);
  static int grid = 0;
  if (!grid) {
    int dev = 0, cus = 0, per_cu = 0;
    hipGetDevice(&dev);
    hipDeviceGetAttribute(&cus, hipDeviceAttributeMultiprocessorCount, dev);
    (void)hipFuncSetAttribute((const void*)k_fused, hipFuncAttributeMaxDynamicSharedMemorySize, SMEM_BYTES + 64);
    (void)hipOccupancyMaxActiveBlocksPerMultiprocessor(&per_cu, k_fused, 256, SMEM_BYTES + 64);
    if (per_cu < 1) per_cu = 1;
    grid = cus * (per_cu < 2 ? per_cu : 2);
  }
  hipMemsetAsync(bar, 0, XCD_BAR_WORDS * sizeof(unsigned), stream);
  hipLaunchKernelGGL(k_fused, dim3(grid), dim3(256), SMEM_BYTES + 64, stream, p, bar);
}
```

```cpp
#include <hip/hip_runtime.h>
#include <stdint.h>

#define DM 2048
#define SL 4096
#define CL 256
#define TLAT 8192
#define TCTX 512
#define TTOT 8704
#define NIN 4192
#define NKEY 4352
#define ZC_CQ 0
#define ZC_CKV 384
#define ZC_KR 512
#define ZC_BZ 576
#define ZC_XBC 1088
#define ZC_DT 2112
#define ZC_MQ 2128
#define ZC_MK 2384
#define ZC_MV 2640
#define ZC_MO 3152
#define ZC_MG 3664
#define ZC_U 3680
#define CAPE 8704
#define EPSV 1e-6f
#define ACT_ROWS 21632

typedef float f32x16 __attribute__((ext_vector_type(16)));
typedef short bf16x8 __attribute__((ext_vector_type(8)));
typedef float f32x4v __attribute__((ext_vector_type(4)));
typedef unsigned u32x4g __attribute__((ext_vector_type(4)));
typedef unsigned short bfraw;
__device__ __forceinline__ unsigned pack_bf16(float lo, float hi) {
  typedef __bf16 bf2 __attribute__((ext_vector_type(2)));
  bf2 v; v[0] = (__bf16)lo; v[1] = (__bf16)hi;
  return __builtin_bit_cast(unsigned, v);
}
__device__ __forceinline__ bfraw to_bf16(float x) { __bf16 b = (__bf16)x; return __builtin_bit_cast(unsigned short, b); }
__device__ __forceinline__ f32x4v ld_bf16x4(const bfraw* q) {
  const uint2 t = *(const uint2*)q;
  f32x4v r; r[0] = __uint_as_float(t.x << 16); r[1] = __uint_as_float(t.x & 0xffff0000u); r[2] = __uint_as_float(t.y << 16); r[3] = __uint_as_float(t.y & 0xffff0000u);
  return r;
}
__device__ __forceinline__ float from_bf16(bfraw x) { return __uint_as_float((unsigned)x << 16); }

#define NSTEP 68
#define LDH 2112
#define LDACT 576
#define XCD_BAR_WORDS 3456
#define WS_RND(n) (((size_t)(n) + 63) & ~(size_t)63)
constexpr size_t WO_cnt = 0;
constexpr size_t WO_modv = WO_cnt + WS_RND(64);
constexpr size_t WO_H = WO_modv + WS_RND(2 * 3 * 12288);
constexpr size_t WO_X = WO_H + WS_RND((size_t)TTOT * (LDH / 2));
constexpr size_t WO_Z = WO_X + WS_RND((size_t)TTOT * 2048);
constexpr size_t WO_Aq = WO_Z + WS_RND((size_t)TTOT * NIN);
constexpr size_t WO_Akv = WO_Aq + WS_RND((size_t)TTOT * 192);
constexpr size_t WO_qraw = WO_Akv + WS_RND((size_t)TTOT * 64);
constexpr size_t WO_kvraw = WO_qraw + WS_RND((size_t)TTOT * 768);
constexpr size_t WO_Q = WO_kvraw + WS_RND((size_t)TTOT * 1024);
constexpr size_t WO_Qc = WO_Q + WS_RND((size_t)8 * SL * 96);
constexpr size_t WO_K = WO_Qc + WS_RND((size_t)8 * CL * 96);
constexpr size_t WO_V = WO_K + WS_RND((size_t)8 * NKEY * 96);
constexpr size_t WO_O = WO_V + WS_RND((size_t)8 * NKEY * 64);
constexpr size_t WO_ssd_xs = WO_O + WS_RND((size_t)TTOT * 512);
constexpr size_t WO_ssd_B = WO_ssd_xs + WS_RND((size_t)TTOT * 512);
constexpr size_t WO_ssd_C = WO_ssd_B + WS_RND((size_t)TTOT * 256);
constexpr size_t WO_ssd_dt = WO_ssd_C + WS_RND((size_t)TTOT * 256);
constexpr size_t WO_ssd_y = WO_ssd_dt + WS_RND((size_t)TTOT * 16);
constexpr size_t WO_ssd_st = WO_ssd_y + WS_RND((size_t)TTOT * 512);
constexpr size_t WO_ssd_atot = WO_ssd_st + WS_RND((size_t)32 * NSTEP * 8192);
constexpr size_t WO_ml_h = WO_ssd_atot + WS_RND(32 * NSTEP);
constexpr size_t WO_ml_st = WO_ml_h + WS_RND((size_t)TTOT * 512);
constexpr size_t WO_ml_nst = WO_ml_st + WS_RND((size_t)16 * NSTEP * 8192);
constexpr size_t WO_ml_gtot = WO_ml_nst + WS_RND((size_t)16 * NSTEP * 64);
constexpr size_t WO_s5_st = WO_ml_gtot + WS_RND(16 * NSTEP);
constexpr size_t WO_s5_a = WO_s5_st + WS_RND((size_t)128 * NSTEP * 128);
constexpr size_t WO_s5_bb = WO_s5_a + WS_RND(2 * 2 * 32 * 64 * 2);
constexpr size_t WO_s5_rf = WO_s5_bb + WS_RND((size_t)2 * 2 * 32 * 64 * 32);
constexpr size_t WO_s5_rb = WO_s5_rf + WS_RND((size_t)TTOT * 512);
constexpr size_t WO_ydpre = WO_s5_rb + WS_RND((size_t)TTOT * 512);
constexpr size_t WO_ydg = WO_ydpre + WS_RND((size_t)TTOT * 512);
constexpr size_t WO_Y = WO_ydg + WS_RND((size_t)TTOT * 512);
constexpr size_t WO_ydpre_bf = WO_Y + WS_RND((size_t)TTOT * (LDH / 2));
constexpr size_t WO_list_tok = WO_ydpre_bf + WS_RND((size_t)TTOT * 256);
constexpr size_t WO_list_w = WO_list_tok + WS_RND((size_t)32 * CAPE);
constexpr size_t WO_ACT = WO_list_w + WS_RND((size_t)32 * CAPE);
constexpr size_t WO_Yslot = WO_ACT + WS_RND((size_t)ACT_ROWS * (LDACT / 2));
constexpr size_t WO_rope_cs = WO_Yslot + WS_RND((size_t)TTOT * 2 * 2048);
constexpr size_t WO_s5_bbh = WO_rope_cs + WS_RND(64 * 16 * 2);
constexpr size_t WO_s5_cmh = WO_s5_bbh + WS_RND(128 * 128 * 16 / 2);
constexpr size_t WO_bar_old = WO_Yslot + WS_RND((size_t)TTOT * 2 * 2048);
constexpr size_t WO_winT = WO_s5_cmh + WS_RND(64 * 32 * 128 / 2);
constexpr size_t WO_woutT = WO_winT + WS_RND((size_t)2 * 4224 * 1024);
constexpr size_t WO_wuqT = WO_woutT + WS_RND((size_t)2 * 2048 * 1024);
constexpr size_t WO_wukvT = WO_wuqT + WS_RND((size_t)2 * 768 * 192);
constexpr size_t WO_wgluT = WO_wukvT + WS_RND((size_t)2 * 1024 * 64);
constexpr size_t WO_O2 = WO_wgluT + WS_RND((size_t)2 * 512 * 256);
constexpr size_t WO_attn_ml = WO_O2 + WS_RND((size_t)TTOT * 512);
constexpr size_t WO_bar = WO_attn_ml + WS_RND((size_t)2 * TTOT * 8);
constexpr size_t WS_TOTAL_FLOATS = WO_bar + 4096;

struct P {
  const float *x, *c, *ctx, *c_ctx, *mod_w, *mod_b, *norm1_w, *w_in, *q_norm_w, *kv_norm_w, *w_uq, *w_ukv;
  const float *conv_w, *conv_b, *a_log, *dt_bias, *ssd_d, *gate_b, *lam_re, *lam_im, *log_dt, *b_re, *b_im;
  const float *c_re, *c_im, *s5_d, *glu_w, *glu_b, *out_norm_w, *w_out, *norm2_w, *w_group, *w_expert;
  const float *w_gate, *w_up, *w_down, *final_w;
  float* out;
  float* ws;
  __device__ __forceinline__ int* cnt() const { return (int*)(ws + WO_cnt); }
  __device__ __forceinline__ float* modv() const { return (float*)(ws + WO_modv); }
  __device__ __forceinline__ bfraw* H() const { return (bfraw*)(ws + WO_H); }
  __device__ __forceinline__ float* X() const { return (float*)(ws + WO_X); }
  __device__ __forceinline__ float* Z() const { return (float*)(ws + WO_Z); }
  __device__ __forceinline__ bfraw* Aq() const { return (bfraw*)(ws + WO_Aq); }
  __device__ __forceinline__ bfraw* Akv() const { return (bfraw*)(ws + WO_Akv); }
  __device__ __forceinline__ float* qraw() const { return (float*)(ws + WO_qraw); }
  __device__ __forceinline__ float* kvraw() const { return (float*)(ws + WO_kvraw); }
  __device__ __forceinline__ bfraw* Q() const { return (bfraw*)(ws + WO_Q); }
  __device__ __forceinline__ bfraw* Qc() const { return (bfraw*)(ws + WO_Qc); }
  __device__ __forceinline__ bfraw* K() const { return (bfraw*)(ws + WO_K); }
  __device__ __forceinline__ bfraw* V() const { return (bfraw*)(ws + WO_V); }
  __device__ __forceinline__ float* O() const { return (float*)(ws + WO_O); }
  __device__ __forceinline__ float* ssd_xs() const { return (float*)(ws + WO_ssd_xs); }
  __device__ __forceinline__ float* ssd_B() const { return (float*)(ws + WO_ssd_B); }
  __device__ __forceinline__ float* ssd_C() const { return (float*)(ws + WO_ssd_C); }
  __device__ __forceinline__ float* ssd_dt() const { return (float*)(ws + WO_ssd_dt); }
  __device__ __forceinline__ float* ssd_y() const { return (float*)(ws + WO_ssd_y); }
  __device__ __forceinline__ bfraw* ssd_st() const { return (bfraw*)(ws + WO_ssd_st); }
  __device__ __forceinline__ float* ssd_atot() const { return (float*)(ws + WO_ssd_atot); }
  __device__ __forceinline__ float* ml_h() const { return (float*)(ws + WO_ml_h); }
  __device__ __forceinline__ bfraw* ml_st() const { return (bfraw*)(ws + WO_ml_st); }
  __device__ __forceinline__ float* ml_nst() const { return (float*)(ws + WO_ml_nst); }
  __device__ __forceinline__ float* ml_gtot() const { return (float*)(ws + WO_ml_gtot); }
  __device__ __forceinline__ float* s5_st() const { return (float*)(ws + WO_s5_st); }
  __device__ __forceinline__ float* s5_a() const { return (float*)(ws + WO_s5_a); }
  __device__ __forceinline__ float* s5_bb() const { return (float*)(ws + WO_s5_bb); }
  __device__ __forceinline__ float* s5_rf() const { return (float*)(ws + WO_s5_rf); }
  __device__ __forceinline__ float* s5_rb() const { return (float*)(ws + WO_s5_rb); }
  __device__ __forceinline__ float* ydpre() const { return (float*)(ws + WO_ydpre); }
  __device__ __forceinline__ float* ydg() const { return (float*)(ws + WO_ydg); }
  __device__ __forceinline__ bfraw* Y() const { return (bfraw*)(ws + WO_Y); }
  __device__ __forceinline__ bfraw* ydpre_bf() const { return (bfraw*)(ws + WO_ydpre_bf); }
  __device__ __forceinline__ int* list_tok() const { return (int*)(ws + WO_list_tok); }
  __device__ __forceinline__ float* list_w() const { return (float*)(ws + WO_list_w); }
  __device__ __forceinline__ bfraw* ACT() const { return (bfraw*)(ws + WO_ACT); }
  __device__ __forceinline__ bfraw* Yslot() const { return (bfraw*)(ws + WO_Yslot); }
  __device__ __forceinline__ float* rope_cs() const { return (float*)(ws + WO_rope_cs); }
  __device__ __forceinline__ bfraw* s5_bbh() const { return (bfraw*)(ws + WO_s5_bbh); }
  __device__ __forceinline__ bfraw* s5_cmh() const { return (bfraw*)(ws + WO_s5_cmh); }
  __device__ __forceinline__ bfraw* winT() const { return (bfraw*)(ws + WO_winT); }
  __device__ __forceinline__ bfraw* woutT() const { return (bfraw*)(ws + WO_woutT); }
  __device__ __forceinline__ bfraw* wuqT() const { return (bfraw*)(ws + WO_wuqT); }
  __device__ __forceinline__ bfraw* wukvT() const { return (bfraw*)(ws + WO_wukvT); }
  __device__ __forceinline__ bfraw* wgluT() const { return (bfraw*)(ws + WO_wgluT); }
  __device__ __forceinline__ float* O2() const { return (float*)(ws + WO_O2); }
  __device__ __forceinline__ float* attn_ml() const { return (float*)(ws + WO_attn_ml); }
};

__device__ __forceinline__ int otid() { int t = threadIdx.x; asm volatile("" : "+v"(t)); return t; }
__device__ __forceinline__ int row_modidx(int r) { return r < TLAT ? (r >> 12) : 2; }
typedef unsigned u32x4wt __attribute__((ext_vector_type(4)));
__device__ __forceinline__ void store16_wt(void* ptr, u32x4wt v) {
  asm volatile("global_store_dwordx4 %0, %1, off sc1\n\ts_nop 1" :: "v"(ptr), "v"(v) : "memory");
}
#define FOR_ROWS_TTOT(r, bid, wid)                                                                      \
  for (int rpb_ = (TTOT % (int)gridDim.x) == 0 ? TTOT / (int)gridDim.x : 0,                              \
           i_ = (wid), r = rpb_ ? (bid) * rpb_ + i_ : (bid) * 4 + (wid);                                 \
       rpb_ ? i_ < rpb_ : r < TTOT;                                                                       \
       i_ += 4, r = rpb_ ? (bid) * rpb_ + i_ : r + (int)gridDim.x * 4)
__device__ __forceinline__ float sigmoidf_(float v) { return 1.f / (1.f + expf(-v)); }
__device__ __forceinline__ float siluf_(float v) { return v / (1.f + expf(-v)); }
typedef unsigned u32x2v __attribute__((ext_vector_type(2)));
__device__ __forceinline__ float xor32(float x) {
  const u32x2v t = __builtin_amdgcn_permlane32_swap(__float_as_uint(x), __float_as_uint(x), false, false);
  return __uint_as_float((threadIdx.x & 32) ? t[0] : t[1]);
}
__device__ __forceinline__ float xor16(float x) {
  const u32x2v t = __builtin_amdgcn_permlane16_swap(__float_as_uint(x), __float_as_uint(x), false, false);
  return __uint_as_float((threadIdx.x & 16) ? t[0] : t[1]);
}
#define DPPF(x, ctrl, rmask) __int_as_float(__builtin_amdgcn_update_dpp(0, __float_as_int(x), (ctrl), (rmask), 0xF, false))
__device__ __forceinline__ float row16_sum(float v) {
  v += DPPF(v, 0xB1, 0xF); v += DPPF(v, 0x4E, 0xF); v += DPPF(v, 0x141, 0xF); v += DPPF(v, 0x140, 0xF);
  return v;
}
__device__ __forceinline__ float wave_sum(float v) {
  v = row16_sum(v); v += xor16(v); v += xor32(v);
  return v;
}
__device__ __forceinline__ float lane63(float v) { return __int_as_float(__builtin_amdgcn_readlane(__float_as_int(v), 63)); }
__device__ __forceinline__ float block_sum(float v, float* red) {
  v = wave_sum(v);
  __syncthreads();
  if ((otid() & 63) == 0) red[otid() >> 6] = v;
  __syncthreads();
  return red[0] + red[1] + red[2] + red[3];
}

__device__ __forceinline__ void ph_mod(const P& p, char* smem) {
  float* sc = (float*)smem;
  float* red = sc + 3 * 2048;
  const int tid = otid();
  if (blockIdx.x == 0 && tid < 64) p.cnt()[tid] = 0;
  if (blockIdx.x == 1) {
    for (int i = tid; i < 64 * 16; i += 256) {
      const int idx = i >> 4, f = i & 15;
      const float ang = (float)idx * powf(10000.f, -(float)f * (1.f / 16.f));
      p.rope_cs()[i * 2] = cosf(ang); p.rope_cs()[i * 2 + 1] = sinf(ang);
    }
  }
  for (int i = blockIdx.x * 256 + tid; i < 64 * 32 * 128; i += gridDim.x * 256) {
    const int pp = i & 127, c = (i >> 7) & 31, lg = i >> 12;
    float v = 0.f;
    if (c < 16) v = pp < 64 ? p.c_re[((size_t)lg * 16 + c) * 64 + pp] : -p.c_im[((size_t)lg * 16 + c) * 64 + pp - 64];
    p.s5_cmh()[i] = to_bf16(v);
  }
  for (int i = blockIdx.x * 256 + tid; i < 2 * 2 * 32 * 64; i += gridDim.x * 256) {
    const int sp = i & 63, g = (i >> 6) & 31, l = i >> 12;
    const float lr = p.lam_re[i], li = p.lam_im[i];
    const float dt = expf(p.log_dt[i >> 6]);
    const float mag = expf(lr * dt);
    const float ar = mag * cosf(li * dt), ai = mag * sinf(li * dt);
    const float den = lr * lr + li * li;
    const float cr_ = ((ar - 1.f) * lr + ai * li) / den;
    const float ci_ = (ai * lr - (ar - 1.f) * li) / den;
    p.s5_a()[i * 2] = ar; p.s5_a()[i * 2 + 1] = ai;
    for (int c = 0; c < 16; ++c) {
      float br = p.b_re[((size_t)(l * 32 + g) * 64 + sp) * 16 + c];
      float bim = p.b_im[((size_t)(l * 32 + g) * 64 + sp) * 16 + c];
      p.s5_bb()[(size_t)i * 32 + c] = cr_ * br - ci_ * bim;
      p.s5_bb()[(size_t)i * 32 + 16 + c] = cr_ * bim + ci_ * br;
      p.s5_bbh()[((size_t)(i >> 6) * 128 + sp) * 16 + c] = to_bf16(cr_ * br - ci_ * bim);
      p.s5_bbh()[((size_t)(i >> 6) * 128 + 64 + sp) * 16 + c] = to_bf16(cr_ * bim + ci_ * br);
    }
  }
  for (int i = tid; i < 3 * 2048; i += 256) {
    int r = i >> 11, k = i & 2047;
    float v = r < 2 ? p.c[r * 2048 + k] : p.c_ctx[k];
    sc[i] = siluf_(v);
  }
  __syncthreads();
  for (int w = blockIdx.x; w < 2 * 96; w += gridDim.x) {
    int l = w / 96, j0 = (w % 96) * 128;
    int cg = tid & 31, ks = tid >> 5;
    const float* W = p.mod_w + (size_t)l * 2048 * 12288 + j0 + cg * 4;
    float acc[3][4];
#pragma unroll
    for (int r = 0; r < 3; ++r)
#pragma unroll
      for (int c = 0; c < 4; ++c) acc[r][c] = 0.f;
#pragma unroll 16
    for (int k = ks * 256; k < ks * 256 + 256; ++k) {
      float4 wv = *(const float4*)(W + (size_t)k * 12288);
      float s0 = sc[k], s1 = sc[2048 + k], s2 = sc[4096 + k];
      acc[0][0] += s0 * wv.x; acc[0][1] += s0 * wv.y; acc[0][2] += s0 * wv.z; acc[0][3] += s0 * wv.w;
      acc[1][0] += s1 * wv.x; acc[1][1] += s1 * wv.y; acc[1][2] += s1 * wv.z; acc[1][3] += s1 * wv.w;
      acc[2][0] += s2 * wv.x; acc[2][1] += s2 * wv.y; acc[2][2] += s2 * wv.z; acc[2][3] += s2 * wv.w;
    }
    __syncthreads();
#pragma unroll
    for (int r = 0; r < 3; ++r)
#pragma unroll
      for (int c = 0; c < 4; ++c) red[(ks * 32 + cg) * 12 + r * 4 + c] = acc[r][c];
    __syncthreads();
    for (int o = tid; o < 384; o += 256) {
      int r = o >> 7, c = o & 127;
      float s = 0.f;
#pragma unroll
      for (int q = 0; q < 8; ++q) s += red[(q * 32 + (c >> 2)) * 12 + r * 4 + (c & 3)];
      s += p.mod_b[l * 12288 + j0 + c];
      p.modv()[(l * 3 + r) * 12288 + j0 + c] = s;
    }
    __syncthreads();
  }
}

__device__ __forceinline__ void wprep_matrix(const float* src, bfraw* dst, int K, int N, int Npad, int& base, int bid, char* smem) {
  const int tid = otid();
  const int tk = K >> 6, tn = Npad >> 6, nt = tk * tn;
  int first = bid - (base % (int)gridDim.x); if (first < 0) first += gridDim.x;
  for (int t = first; t < nt; t += gridDim.x) {
    const int k0 = (t % tk) * 64, n0 = (t / tk) * 64;
    __syncthreads();
#pragma unroll
    for (int u = 0; u < 4; ++u) {
      const int i = tid + 256 * u, kr = i >> 4, c4 = i & 15;
      const int n = n0 + c4 * 4;
      float4 v = make_float4(0.f, 0.f, 0.f, 0.f);
      if (n < N) v = *(const float4*)(src + (size_t)(k0 + kr) * N + n);
      *(bfraw*)(smem + (c4 * 4 + 0) * 144 + kr * 2) = to_bf16(v.x);
      *(bfraw*)(smem + (c4 * 4 + 1) * 144 + kr * 2) = to_bf16(v.y);
      *(bfraw*)(smem + (c4 * 4 + 2) * 144 + kr * 2) = to_bf16(v.z);
      *(bfraw*)(smem + (c4 * 4 + 3) * 144 + kr * 2) = to_bf16(v.w);
    }
    __syncthreads();
#pragma unroll
    for (int u = 0; u < 2; ++u) {
      const int i = tid + 256 * u, nr = i >> 3, c = i & 7;
      store16_wt(dst + (size_t)(n0 + nr) * K + k0 + c * 8, *(const u32x4wt*)(smem + nr * 144 + c * 16));
    }
  }
  base += nt;
}
__device__ __forceinline__ void ph_wprep(const P& p, int bid, char* smem) {
  int base = 0;
  for (int l = 0; l < 2; ++l) {
    wprep_matrix(p.w_in + (size_t)l * 2048 * NIN, p.winT() + (size_t)l * 4224 * 2048, 2048, NIN, 4224, base, bid, smem);
    wprep_matrix(p.w_out + (size_t)l * 2048 * 2048, p.woutT() + (size_t)l * 2048 * 2048, 2048, 2048, 2048, base, bid, smem);
    wprep_matrix(p.w_uq + (size_t)l * 384 * 768, p.wuqT() + (size_t)l * 768 * 384, 384, 768, 768, base, bid, smem);
    wprep_matrix(p.w_ukv + (size_t)l * 128 * 1024, p.wukvT() + (size_t)l * 1024 * 128, 128, 1024, 1024, base, bid, smem);
    wprep_matrix(p.glu_w + (size_t)l * 512 * 512, p.wgluT() + (size_t)l * 512 * 512, 512, 512, 512, base, bid, smem);
  }
}

__device__ __forceinline__ void ph_norm1(const P& p, int layer, int bid, char* smem) {
  const int tid = otid(), lane = tid & 63, wid = tid >> 6;
  const float* nw = p.norm1_w + layer * 2048;
  FOR_ROWS_TTOT(r, bid, wid) {
    const int mi = row_modidx(r);
    const float* mrow = p.modv() + (layer * 3 + mi) * 12288;
    f32x4v v[8];
    float ss = 0.f;
#pragma unroll
    for (int q = 0; q < 8; ++q) {
      const int col = q * 256 + lane * 4;
      f32x4v xv;
      if (layer == 0) {
        const float* src = r < TLAT ? p.x + (size_t)r * 2048 : p.ctx + (size_t)(r - TLAT) * 2048;
        xv = *(const f32x4v*)(src + col);
      } else {
        xv = *(const f32x4v*)(p.X() + (size_t)r * 2048 + col);
        const float* g2 = p.modv() + ((layer - 1) * 3 + mi) * 12288 + 5 * 2048;
        const f32x4v gv = *(const f32x4v*)(g2 + col);
        const f32x4v y0 = ld_bf16x4(p.Yslot() + (size_t)(2 * r) * 2048 + col);
        const f32x4v y1 = ld_bf16x4(p.Yslot() + (size_t)(2 * r + 1) * 2048 + col);
        xv += gv * (y0 + y1);
        store16_wt(p.X() + (size_t)r * 2048 + col, __builtin_bit_cast(u32x4wt, xv));
      }
      v[q] = xv;
      ss += xv[0] * xv[0] + xv[1] * xv[1] + xv[2] * xv[2] + xv[3] * xv[3];
    }
    ss = wave_sum(ss);
    const float rs = rsqrtf(ss * (1.f / 2048.f) + EPSV);
#pragma unroll
    for (int q = 0; q < 8; ++q) {
      const int col = q * 256 + lane * 4;
      const f32x4v w4 = *(const f32x4v*)(nw + col);
      const f32x4v sh = *(const f32x4v*)(mrow + col);
      const f32x4v scv = *(const f32x4v*)(mrow + 2048 + col);
      const f32x4v o = v[q] * rs * w4 * (1.f + scv) + sh;
      uint2 ob; ob.x = pack_bf16(o[0], o[1]); ob.y = pack_bf16(o[2], o[3]);
      *(uint2*)(p.H() + (size_t)r * LDH + col) = ob;
    }
  }
}

template <int MI, int NST = 2, class AF, class BF, class EF>
__device__ __forceinline__ void gemm_tile(const AF& af, const BF& bf, const EF& ef, int K, char* smem) {
  constexpr int BM = MI * 64;
  constexpr int NA = MI * 2;
  constexpr int ABYTES = BM * 128, STAGE = ABYTES + 16384;
  int tid_ = threadIdx.x; asm volatile("" : "+v"(tid_));
  const int tid = tid_, lane = tid & 63, wid = tid >> 6, wr = wid >> 1, wc = wid & 1;
  const int l31 = lane & 31, lh = lane >> 5;
  f32x16 acc[MI][2];
#pragma unroll
  for (int i = 0; i < MI; ++i)
#pragma unroll
    for (int j = 0; j < 2; ++j)
#pragma unroll
      for (int r = 0; r < 16; ++r) acc[i][j][r] = 0.f;
  const int arl = tid >> 3, ac = tid & 7;
  const bfraw* arow[NA];
#pragma unroll
  for (int i = 0; i < NA; ++i) { const bfraw* q = af.row(arl + 32 * i); arow[i] = (q ? q : af.safe()) + ac * 8; }
  const int n4 = tid & 31, kg = tid >> 5;
  const float* bc = nullptr;
  size_t ldb = 0;
  const bfraw* brow[4] = {nullptr, nullptr, nullptr, nullptr};
  if constexpr (BF::kT) {
#pragma unroll
    for (int i = 0; i < 4; ++i) brow[i] = bf.nrow(arl + 32 * i) + ac * 8;
  } else {
    const float* q = bf.col(n4 * 4); bc = (q ? q : bf.safe()) + (size_t)(kg * 8) * bf.ldb;
    ldb = (size_t)bf.ldb;
  }
  typedef unsigned u32x4v __attribute__((ext_vector_type(4)));
  constexpr int NS = NST;
  u32x4v ra[NS][NA];
  f32x4v rb[NS][8];
  u32x4v rbt[NS][4];
#define GM_GL(set, k0)                                                               \
  {                                                                                  \
    _Pragma("unroll") for (int i = 0; i < NA; ++i) ra[set][i] = *(const u32x4v*)(arow[i] + (k0)); \
    if constexpr (BF::kT) {                                                          \
      _Pragma("unroll") for (int i = 0; i < 4; ++i) rbt[set][i] = *(const u32x4v*)(brow[i] + (k0)); \
    } else {                                                                         \
      const float* bq = bc + (size_t)(k0) * ldb;                                     \
      _Pragma("unroll") for (int j = 0; j < 8; ++j) rb[set][j] = *(const f32x4v*)(bq + (size_t)j * ldb); \
    }                                                                                \
  }
#define GM_SW(set, buf)                                                              \
  {                                                                                  \
    char* Ab = smem + (buf) * STAGE; char* Bb = Ab + ABYTES;                         \
    const int asw = (ac ^ ((arl >> 1) & 7)) << 4;                                    \
    _Pragma("unroll") for (int i = 0; i < NA; ++i) *(u32x4v*)(Ab + (arl + 32 * i) * 128 + asw) = ra[set][i]; \
    if constexpr (BF::kT) {                                                          \
      _Pragma("unroll") for (int i = 0; i < 4; ++i) *(u32x4v*)(Bb + (arl + 32 * i) * 128 + asw) = rbt[set][i]; \
    } else                                                                           \
    _Pragma("unroll") for (int i4 = 0; i4 < 4; ++i4) {                               \
      const int n = n4 * 4 + i4;                                                     \
      u32x4v v;                                                                      \
      v[0] = pack_bf16(rb[set][0][i4], rb[set][1][i4]); v[1] = pack_bf16(rb[set][2][i4], rb[set][3][i4]); \
      v[2] = pack_bf16(rb[set][4][i4], rb[set][5][i4]); v[3] = pack_bf16(rb[set][6][i4], rb[set][7][i4]); \
      *(u32x4v*)(Bb + n * 128 + ((kg ^ ((n >> 1) & 7)) << 4)) = v;                   \
    }                                                                                \
  }
#define GM_COMPUTE(buf, KK0, KK1)                                                    \
  {                                                                                  \
    const char* ap = smem + (buf) * STAGE + (wr * (BM / 2) + l31) * 128;             \
    const char* bp = smem + (buf) * STAGE + ABYTES + (wc * 64 + l31) * 128;          \
    _Pragma("unroll") for (int kk = KK0; kk < KK1; ++kk) {                           \
      const int co = ((2 * kk + lh) ^ fsw) << 4;                                     \
      const bf16x8 b0 = *(const bf16x8*)(bp + co), b1 = *(const bf16x8*)(bp + 32 * 128 + co); \
      _Pragma("unroll") for (int i = 0; i < MI; ++i) {                               \
        const bf16x8 a = *(const bf16x8*)(ap + i * 32 * 128 + co);                   \
        acc[i][0] = __builtin_amdgcn_mfma_f32_32x32x16_bf16(a, b0, acc[i][0], 0, 0, 0); \
        acc[i][1] = __builtin_amdgcn_mfma_f32_32x32x16_bf16(a, b1, acc[i][1], 0, 0, 0); \
      }                                                                              \
    }                                                                                \
  }
  const int fsw = (l31 >> 1) & 7;
  const int nsteps = K >> 6;
  __syncthreads();
  const int klast = (nsteps - 1) * 64;
  if constexpr (NST == 1) {
    GM_GL(0, 0)
    GM_SW(0, 0)
    __syncthreads();
    for (int s = 0; s < nsteps; ++s) {
      { const int kn = min((s + 1) * 64, klast); GM_GL(0, kn) }
      GM_COMPUTE(0, 0, 4)
      __syncthreads();
      GM_SW(0, 0)
      __syncthreads();
    }
  } else {
  GM_GL(0, 0)
  GM_SW(0, 0)
  GM_GL(1, 64)
  __syncthreads();
  for (int s = 0; s < nsteps; s += 2) {
    { const int kn = min((s + 2) * 64, klast); GM_GL(0, kn) }
    GM_COMPUTE(0, 0, 2)
    __builtin_amdgcn_sched_barrier(0);
    GM_SW(1, 1)
    __builtin_amdgcn_sched_barrier(0);
    GM_COMPUTE(0, 2, 4)
    __syncthreads();
    { const int kn = min((s + 3) * 64, klast); GM_GL(1, kn) }
    GM_COMPUTE(1, 0, 2)
    __builtin_amdgcn_sched_barrier(0);
    GM_SW(0, 0)
    __builtin_amdgcn_sched_barrier(0);
    GM_COMPUTE(1, 2, 4)
    __syncthreads();
  }
  }
  ef(acc, wr, wc, lane);
}
#define ACC_ROWM(MI, wr, i, r, lane) ((wr) * ((MI) * 32) + (i) * 32 + ((r) & 3) + 8 * ((r) >> 2) + 4 * ((lane) >> 5))
#define ACC_ROW(wr, i, r, lane) ACC_ROWM(2, wr, i, r, lane)
#define ACC_COL(wc, j, lane) ((wc) * 64 + (j) * 32 + ((lane) & 31))

struct ARows { const bfraw* base; int ld; int m0; int M;
  __device__ __forceinline__ const bfraw* row(int r) const { int g = m0 + r; return g < M ? base + (size_t)g * ld : nullptr; }
  __device__ __forceinline__ const bfraw* safe() const { return base; } };
struct BPlain { static constexpr bool kT = false; const float* B; int ldb; int n0; int N;
  __device__ __forceinline__ const float* col(int v) const { int n = n0 + v; return n < N ? B + n : nullptr; }
  __device__ __forceinline__ const float* safe() const { return B; } };

struct BTrans { static constexpr bool kT = true; const bfraw* Bt; int ldk; int n0;
  __device__ __forceinline__ const bfraw* nrow(int v) const { return Bt + (size_t)(n0 + v) * ldk; } };

__device__ __forceinline__ int sched_item(int k, int n, int bid) {
  const int G = (int)gridDim.x, nfull = n / G;
  if (k < nfull) return k * G + bid;
  if (k > nfull) return -1;
  const int R = n - nfull * G;
  int sr = bid;
  if (G == 512) { const int li = bid & 63, x = bid >> 6; sr = (((li >> 5) * 32 + (li & 1) * 16 + ((li & 31) >> 1)) << 3) + x; }
  return sr < R ? nfull * G + sr : -1;
}
#define FOR_ITEMS(w, n, bid) for (int k_ = 0, w = sched_item(0, (n), (bid)); w >= 0; w = sched_item(++k_, (n), (bid)))
template <int MI, int NST, class EPI>
__device__ __forceinline__ void gemm_dense_tile(const bfraw* A, int lda, const bfraw* Bt, int M, int N, int K, const EPI& epi, int m0, int n0, char* smem) {
  ARows af{A, lda, m0, M};
  BTrans bf{Bt, K, n0};
  auto ef = [&](const f32x16 (&acc)[MI][2], int wr, int wc, int lane) {
#pragma unroll
    for (int i = 0; i < MI; ++i)
#pragma unroll
      for (int j = 0; j < 2; ++j)
#pragma unroll
        for (int r = 0; r < 16; ++r) {
          int row = m0 + ACC_ROWM(MI, wr, i, r, lane), col = n0 + ACC_COL(wc, j, lane);
          if (row < M && col < N) epi(row, col, acc[i][j][r]);
        }
  };
  gemm_tile<MI, NST>(af, bf, ef, K, smem);
}
template <int MIUNUSED, class EPI>
__device__ __forceinline__ void gemm_dense(const bfraw* A, int lda, const bfraw* Bt, int M, int N, int K, const EPI& epi, int bid, char* smem) {
  const int mt = (M + 127) >> 7, nt = (N + 127) >> 7, G = (int)gridDim.x;
  const int U = mt * nt;
  int P = 0;
  if ((mt & 1) == 0) { P = ((U / (2 * G)) * G) / mt; if (2 * P > nt) P = nt >> 1; }
  const int nbig = P * mt;
  FOR_ITEMS(w, nbig, bid) {
    const int sr = w / mt, rem = w - sr * mt;
    gemm_dense_tile<4, 1>(A, lda, Bt, M, N, K, epi, (rem >> 1) * 256, (sr * 2 + (rem & 1)) * 128, smem);
  }
  const int ntr = nt - 2 * P;
  if (ntr * mt * 2 <= G) {
    FOR_ITEMS(w, ntr * mt * 2, bid) {
      const int u = w >> 1, nq = u / mt;
      gemm_dense_tile<1, 2>(A, lda, Bt, M, N, K, epi, (u - nq * mt) * 128 + (w & 1) * 64, (2 * P + nq) * 128, smem);
    }
    return;
  }
  const int nslots = ((ntr + 1) >> 1) * mt * 2;
  FOR_ITEMS(w, nslots, bid) {
    const int sr = w / (mt * 2), rem = w - sr * (mt * 2);
    const int n_t = 2 * P + sr * 2 + (rem & 1);
    if (n_t >= nt) continue;
    gemm_dense_tile<2, 2>(A, lda, Bt, M, N, K, epi, (rem >> 1) * 128, n_t * 128, smem);
  }
}


__device__ __forceinline__ void ph_win(const P& p, int layer, int bid, char* smem) {
  float* Z = p.Z();
  auto epi = [=](int row, int col, float v) { Z[(size_t)row * NIN + col] = v; };
  gemm_dense<2>(p.H(), LDH, p.winT() + (size_t)layer * 4224 * 2048, TTOT, NIN, 2048, epi, bid, smem);
}

__device__ __forceinline__ void ph_prep(const P& p, int layer, int bid, char* smem) {
  const int tid = otid(), lane = tid & 63, wid = tid >> 6;
  FOR_ROWS_TTOT(r, bid, wid) {
    const float* z = p.Z() + (size_t)r * NIN;
    float q[6]; float ss = 0.f;
#pragma unroll
    for (int i = 0; i < 6; ++i) { q[i] = z[ZC_CQ + i * 64 + lane]; ss += q[i] * q[i]; }
    ss = wave_sum(ss);
    float rs = rsqrtf(ss * (1.f / 384.f) + EPSV);
#pragma unroll
    for (int i = 0; i < 6; ++i) p.Aq()[(size_t)r * 384 + i * 64 + lane] = to_bf16(q[i] * rs * p.q_norm_w[layer * 384 + i * 64 + lane]);
    float k0 = z[ZC_CKV + lane], k1 = z[ZC_CKV + 64 + lane];
    float s2 = wave_sum(k0 * k0 + k1 * k1);
    float rs2 = rsqrtf(s2 * (1.f / 128.f) + EPSV);
    p.Akv()[(size_t)r * 128 + lane] = to_bf16(k0 * rs2 * p.kv_norm_w[layer * 128 + lane]);
    p.Akv()[(size_t)r * 128 + 64 + lane] = to_bf16(k1 * rs2 * p.kv_norm_w[layer * 128 + 64 + lane]);
  }
  const float* cw = p.conv_w + layer * 5 * 1024;
  const float* cb = p.conv_b + layer * 1024;
  const int ch = tid * 4;
  const f32x4v bias = *(const f32x4v*)(cb + ch);
  f32x4v wk[5];
#pragma unroll
  for (int k = 0; k < 5; ++k) wk[k] = *(const f32x4v*)(cw + k * 1024 + ch);
  FOR_ITEMS(rb, TTOT / 8, bid) {
    const int r0 = rb * 8;
    int base, len;
    if (r0 < TLAT) { base = (r0 >> 12) << 12; len = SL; } else { base = TLAT + (((r0 - TLAT) >> 8) << 8); len = CL; }
    const int t0 = r0 - base;
    f32x4v xw[12];
#pragma unroll
    for (int u = 0; u < 12; ++u) {
      const int tt = t0 + u - 2;
      const f32x4v zero = {0.f, 0.f, 0.f, 0.f};
      xw[u] = (tt >= 0 && tt < len) ? *(const f32x4v*)(p.Z() + (size_t)(base + tt) * NIN + ZC_XBC + ch) : zero;
    }
#pragma unroll
    for (int j = 0; j < 8; ++j) {
      f32x4v acc = bias;
#pragma unroll
      for (int k = 0; k < 5; ++k) acc += xw[j + k] * wk[k];
      acc[0] = siluf_(acc[0]); acc[1] = siluf_(acc[1]); acc[2] = siluf_(acc[2]); acc[3] = siluf_(acc[3]);
      const int r = r0 + j;
      float* cdst = ch < 512 ? p.ssd_xs() + (size_t)r * 512 + ch : (ch < 768 ? p.ssd_B() + (size_t)r * 256 + (ch - 512) : p.ssd_C() + (size_t)r * 256 + (ch - 768));
      store16_wt(cdst, __builtin_bit_cast(u32x4wt, acc));
    }
    if (tid < 128) {
      const int r = r0 + (tid >> 4), c = tid & 15;
      float v = p.Z()[(size_t)r * NIN + ZC_DT + c] + p.dt_bias[layer * 16 + c];
      p.ssd_dt()[(size_t)r * 16 + c] = v > 20.f ? v : log1pf(expf(v));
    }
  }
}

__device__ __forceinline__ void ph_qkv(const P& p, int layer, int bid, char* smem) {
  const int tid = otid();
  const float qscale = 0.07216878364870322f * 1.4426950408889634f;
  const float* rope = p.rope_cs();
  for (int r = bid; r < TTOT; r += gridDim.x) {
    const bool lat = r < TLAT;
    int b, pos;
    if (lat) { b = r >> 12; pos = r & 4095; } else { b = (r - TLAT) >> 8; pos = (r - TLAT) & 255; }
    const int kpos = lat ? pos : SL + pos;
    const float* zr = p.Z() + (size_t)r * NIN + ZC_KR;
    const int h = tid >> 6, e = tid & 63;
    float v;
    if (!lat) v = zr[e];
    else {
      const int a = e >> 5, half = (e >> 4) & 1, f = e & 15;
      const float x1 = zr[a * 32 + f], x2 = zr[a * 32 + 16 + f];
      const int idx = a == 0 ? (pos >> 6) : (pos & 63);
      const float cs = rope[(idx * 16 + f) * 2], sn = rope[(idx * 16 + f) * 2 + 1];
      v = half == 0 ? x1 * cs - x2 * sn : x1 * sn + x2 * cs;
    }
    p.K()[((size_t)(b * 4 + h) * NKEY + kpos) * 192 + 128 + e] = to_bf16(v);
  }
  {
    const bfraw* Bt = p.wuqT() + (size_t)layer * 768 * 384;
    FOR_ITEMS(w, 68 * 6, bid) {
      const int n_t = w / 68, m_t = w - n_t * 68;
      const int m0 = m_t * 128, n0 = n_t * 128;
      ARows af{p.Aq(), 384, m0, TTOT};
      BTrans bf{Bt, 384, n0};
      const bool lat = m0 < TLAT;
      const int b = lat ? (m0 >> 12) : ((m0 - TLAT) >> 8);
      const int pos0 = lat ? (m0 & 4095) : ((m0 - TLAT) & 255);
      auto ef = [&](const f32x16 (&acc)[2][2], int wr, int wc, int lane) {
        const int l31 = lane & 31;
#pragma unroll
        for (int j = 0; j < 2; ++j) {
          const int col = n0 + wc * 64 + j * 32;
          const int h = col / 192, d0 = col - h * 192;
          const bool isrope = lat && d0 >= 128;
          const int f = l31 & 15;
#pragma unroll
          for (int i = 0; i < 2; ++i)
#pragma unroll
            for (int r = 0; r < 16; ++r) {
              const int pos = pos0 + ACC_ROW(wr, i, r, lane);
              float v = acc[i][j][r];
              const float pv = xor16(v);
              if (isrope) {
                const int idx = d0 == 128 ? (pos >> 6) : (pos & 63);
                const float cs = rope[(idx * 16 + f) * 2], sn = rope[(idx * 16 + f) * 2 + 1];
                v = (l31 < 16) ? v * cs - pv * sn : pv * sn + v * cs;
              }
              bfraw* dst = lat ? p.Q() + ((size_t)(b * 4 + h) * SL + pos) * 192 : p.Qc() + ((size_t)(b * 4 + h) * CL + pos) * 192;
              dst[d0 + l31] = to_bf16(v * qscale);
            }
        }
      };
      gemm_tile<2>(af, bf, ef, 384, smem);
    }
  }
  {
    const bfraw* Bt = p.wukvT() + (size_t)layer * 1024 * 128;
    FOR_ITEMS(w, 68 * 8, bid) {
      const int n_t = w / 68, m_t = w - n_t * 68;
      const int m0 = m_t * 128, n0 = n_t * 128;
      ARows af{p.Akv(), 128, m0, TTOT};
      BTrans bf{Bt, 128, n0};
      const bool lat = m0 < TLAT;
      const int b = lat ? (m0 >> 12) : ((m0 - TLAT) >> 8);
      const int kpos0 = lat ? (m0 & 4095) : SL + ((m0 - TLAT) & 255);
      const int h = n_t >> 1;
      const bool isv = n_t & 1;
      auto ef = [&](const f32x16 (&acc)[2][2], int wr, int wc, int lane) {
        const int l31 = lane & 31, lh = lane >> 5;
        if (!isv) {
#pragma unroll
          for (int i = 0; i < 2; ++i)
#pragma unroll
            for (int j = 0; j < 2; ++j)
#pragma unroll
              for (int r = 0; r < 16; ++r) {
                const int kpos = kpos0 + ACC_ROW(wr, i, r, lane);
                p.K()[((size_t)(b * 4 + h) * NKEY + kpos) * 192 + wc * 64 + j * 32 + l31] = to_bf16(acc[i][j][r]);
              }
        } else {
#pragma unroll
          for (int i = 0; i < 2; ++i)
#pragma unroll
            for (int j = 0; j < 2; ++j) {
              const int d = wc * 64 + j * 32 + l31;
              bfraw* vrow = p.V() + ((size_t)(b * 4 + h) * 128 + d) * NKEY + kpos0 + wr * 64 + i * 32;
#pragma unroll
              for (int s = 0; s < 2; ++s) {
                uint4 t;
                t.x = pack_bf16(acc[i][j][8 * s + 0], acc[i][j][8 * s + 1]); t.y = pack_bf16(acc[i][j][8 * s + 2], acc[i][j][8 * s + 3]);
                t.z = pack_bf16(acc[i][j][8 * s + 4], acc[i][j][8 * s + 5]); t.w = pack_bf16(acc[i][j][8 * s + 6], acc[i][j][8 * s + 7]);
                *(uint4*)(vrow + 16 * s + 8 * lh) = t;
              }
            }
        }
      };
      gemm_tile<2>(af, bf, ef, 128, smem);
    }
  }
}

#define ATT_KROW 400
#define ATT_VROW 144
#define MFMA16(a, b, c) __builtin_amdgcn_mfma_f32_32x32x16_bf16(a, b, c, 0, 0, 0)
__device__ __forceinline__ void attn_item(const bfraw* __restrict__ Qp, const bfraw* __restrict__ Kp, const bfraw* __restrict__ Vtp,
                                          int nk, float* __restrict__ Op, float* __restrict__ MLp, char* smem) {
  char* Ks = smem;
  char* Vs = smem + 64 * ATT_KROW;
  int tid_ = threadIdx.x; asm volatile("" : "+v"(tid_));
  const int tid = tid_, lane = tid & 63, wid = tid >> 6, l31 = lane & 31, lh = lane >> 5;
  bf16x8 qf[12];
  {
    const bfraw* qrow = Qp + (size_t)(wid * 32 + l31) * 192 + lh * 8;
#pragma unroll
    for (int ks = 0; ks < 12; ++ks) qf[ks] = *(const bf16x8*)(qrow + ks * 16);
  }
  f32x16 o[4];
#pragma unroll
  for (int d = 0; d < 4; ++d)
#pragma unroll
    for (int r = 0; r < 16; ++r) o[d][r] = 0.f;
  float m = -INFINITY, l = 0.f;
  uint4 rk0, rk1, rk2, rk3, rk4, rk5, rv0, rv1, rv2, rv3;
#define ATT_KSRC(n, kt) (Kp + (size_t)((kt) + (tid + 256 * (n)) / 24) * 192 + ((tid + 256 * (n)) % 24) * 8)
#define ATT_VSRC(n, kt) (Vtp + (size_t)((tid + 256 * (n)) >> 3) * NKEY + (kt) + ((tid + 256 * (n)) & 7) * 8)
#define ATT_GLOAD(kt)                                                                                        \
  {                                                                                                          \
    rk0 = *(const uint4*)ATT_KSRC(0, kt); rk1 = *(const uint4*)ATT_KSRC(1, kt); rk2 = *(const uint4*)ATT_KSRC(2, kt); \
    rk3 = *(const uint4*)ATT_KSRC(3, kt); rk4 = *(const uint4*)ATT_KSRC(4, kt); rk5 = *(const uint4*)ATT_KSRC(5, kt); \
    rv0 = *(const uint4*)ATT_VSRC(0, kt); rv1 = *(const uint4*)ATT_VSRC(1, kt);                              \
    rv2 = *(const uint4*)ATT_VSRC(2, kt); rv3 = *(const uint4*)ATT_VSRC(3, kt);                              \
  }
#define ATT_KDST(n) (Ks + ((tid + 256 * (n)) / 24) * ATT_KROW + ((tid + 256 * (n)) % 24) * 16)
#define ATT_VDST(n) (Vs + ((tid + 256 * (n)) >> 3) * ATT_VROW + ((tid + 256 * (n)) & 7) * 16)
#define ATT_SWRITE()                                                                                         \
  {                                                                                                          \
    *(uint4*)ATT_KDST(0) = rk0; *(uint4*)ATT_KDST(1) = rk1; *(uint4*)ATT_KDST(2) = rk2;                      \
    *(uint4*)ATT_KDST(3) = rk3; *(uint4*)ATT_KDST(4) = rk4; *(uint4*)ATT_KDST(5) = rk5;                      \
    *(uint4*)ATT_VDST(0) = rv0; *(uint4*)ATT_VDST(1) = rv1; *(uint4*)ATT_VDST(2) = rv2; *(uint4*)ATT_VDST(3) = rv3; \
  }
  __syncthreads();
  ATT_GLOAD(0)
  ATT_SWRITE()
  __syncthreads();
  for (int kt = 0; kt < nk; kt += 64) {
    const bool more = (kt + 64) < nk;
    if (more) ATT_GLOAD(kt + 64)
    f32x16 s0, s1;
#pragma unroll
    for (int r = 0; r < 16; ++r) { s0[r] = 0.f; s1[r] = 0.f; }
    const char* kp = Ks + l31 * ATT_KROW + lh * 16;
#pragma unroll
    for (int ks = 0; ks < 12; ++ks) {
      bf16x8 a0 = *(const bf16x8*)(kp + ks * 32);
      bf16x8 a1 = *(const bf16x8*)(kp + 32 * ATT_KROW + ks * 32);
      s0 = MFMA16(a0, qf[ks], s0);
      s1 = MFMA16(a1, qf[ks], s1);
    }
    float tmax = fmaxf(s0[0], s1[0]);
#pragma unroll
    for (int r = 1; r < 16; ++r) tmax = fmaxf(tmax, fmaxf(s0[r], s1[r]));
    tmax = fmaxf(tmax, xor32(tmax));
    const float mn = fmaxf(m, tmax);
    const float alpha = __builtin_amdgcn_exp2f(m - mn);
    float rs = 0.f;
#pragma unroll
    for (int r = 0; r < 16; ++r) { s0[r] = __builtin_amdgcn_exp2f(s0[r] - mn); s1[r] = __builtin_amdgcn_exp2f(s1[r] - mn); rs += s0[r] + s1[r]; }
    rs += xor32(rs);
    l = l * alpha + rs;
    m = mn;
    if (__any(alpha != 1.f)) {
#pragma unroll
      for (int d = 0; d < 4; ++d)
#pragma unroll
        for (int r = 0; r < 16; ++r) o[d][r] *= alpha;
    }
    bf16x8 pf[4];
    {
      uint4 t;
      t.x = pack_bf16(s0[0], s0[1]); t.y = pack_bf16(s0[2], s0[3]); t.z = pack_bf16(s0[4], s0[5]); t.w = pack_bf16(s0[6], s0[7]);
      pf[0] = __builtin_bit_cast(bf16x8, t);
      t.x = pack_bf16(s0[8], s0[9]); t.y = pack_bf16(s0[10], s0[11]); t.z = pack_bf16(s0[12], s0[13]); t.w = pack_bf16(s0[14], s0[15]);
      pf[1] = __builtin_bit_cast(bf16x8, t);
      t.x = pack_bf16(s1[0], s1[1]); t.y = pack_bf16(s1[2], s1[3]); t.z = pack_bf16(s1[4], s1[5]); t.w = pack_bf16(s1[6], s1[7]);
      pf[2] = __builtin_bit_cast(bf16x8, t);
      t.x = pack_bf16(s1[8], s1[9]); t.y = pack_bf16(s1[10], s1[11]); t.z = pack_bf16(s1[12], s1[13]); t.w = pack_bf16(s1[14], s1[15]);
      pf[3] = __builtin_bit_cast(bf16x8, t);
    }
    const char* vp = Vs + l31 * ATT_VROW + lh * 16;
#pragma unroll
    for (int g16 = 0; g16 < 4; ++g16) {
#pragma unroll
      for (int d = 0; d < 4; ++d) {
        bf16x8 a = *(const bf16x8*)(vp + d * 32 * ATT_VROW + g16 * 32);
        o[d] = MFMA16(a, pf[g16], o[d]);
      }
    }
    __syncthreads();
    if (more) ATT_SWRITE()
    __syncthreads();
  }
  const float inv = 1.f;
  if (lh == 0) *(float2*)(MLp + (size_t)(wid * 32 + l31) * 2) = make_float2(m, l);
  float* tb = (float*)smem + wid * (32 * 129);
#pragma unroll
  for (int d = 0; d < 4; ++d)
#pragma unroll
    for (int r = 0; r < 16; ++r) tb[l31 * 129 + d * 32 + (r & 3) + 8 * (r >> 2) + 4 * lh] = o[d][r] * inv;
  __syncthreads();
  for (int i = lane; i < 32 * 32; i += 64) {
    const int q = i >> 5, c4 = i & 31;
    const float* s = tb + q * 129 + c4 * 4;
    { u32x4wt v; v[0] = __float_as_uint(s[0]); v[1] = __float_as_uint(s[1]); v[2] = __float_as_uint(s[2]); v[3] = __float_as_uint(s[3]);
      store16_wt(Op + (size_t)(wid * 32 + q) * 512 + c4 * 4, v); }
  }
  __syncthreads();
}

__device__ __forceinline__ int chunk_row0(int b, int cid) { return cid < 4 ? TLAT + b * CL + cid * 64 : b * SL + (cid - 4) * 64; }
__device__ __forceinline__ int step_of(int cid, int dir) { return dir == 0 ? cid : (cid < 4 ? 3 - cid : 71 - cid); }
__device__ __forceinline__ int cid_of(int s, int dir) { return dir == 0 ? s : (s < 4 ? 3 - s : 71 - s); }
#define MFMA32(a, b, c) __builtin_amdgcn_mfma_f32_32x32x2f32(a, b, c, 0, 0, 0)
#define ROW16(r, lh) (((r) & 3) + 8 * ((r) >> 2) + 4 * (lh))
__device__ __forceinline__ float wave_incl_scan(float v, int lane) {
  v += DPPF(v, 0x111, 0xF); v += DPPF(v, 0x112, 0xF); v += DPPF(v, 0x114, 0xF); v += DPPF(v, 0x118, 0xF);
  v += DPPF(v, 0x142, 0xA);
  v += DPPF(v, 0x143, 0xC);
  (void)lane;
  return v;
}

#define SSD_R256 272
#define SSD_R128 144
__device__ __forceinline__ void ssd_local_item(const P& p, int layer, int item, char* smem) {
  const int h = item & 7, cid = (item >> 3) % NSTEP, b = item / (8 * NSTEP);
  char* sBT = smem;
  char* sxf = sBT + 128 * SSD_R128;
  char* sxb = sxf + 64 * SSD_R128;
  float* swf = (float*)(sxb + 64 * SSD_R128);
  float* swb = swf + 64;
  int tid_ = threadIdx.x; asm volatile("" : "+v"(tid_));
  const int tid = tid_, lane = tid & 63, wid = tid >> 6, l31 = lane & 31, lh = lane >> 5;
  const int row0 = chunk_row0(b, cid), g = h >> 2;
  __syncthreads();
  if (wid < 2) {
    const int dir = wid;
    const float A = -__expf(p.a_log[layer * 16 + dir * 8 + h]);
    const int q = dir ? 63 - lane : lane;
    const float dt = p.ssd_dt()[(size_t)(row0 + q) * 16 + dir * 8 + h];
    const float ac = wave_incl_scan(dt * A, lane);
    const float tot = lane63(ac);
    (dir ? swb : swf)[q] = __expf(tot - ac) * dt;
    if (lane == 0) p.ssd_atot()[((b * 2 + dir) * 8 + h) * NSTEP + step_of(cid, dir)] = tot;
  }
#pragma unroll
  for (int u = 0; u < 8; ++u) {
    const int i = tid + 256 * u, q = i >> 5, c4 = i & 31;
    const float4 v = *(const float4*)(p.ssd_B() + (size_t)(row0 + q) * 256 + g * 128 + c4 * 4);
    *(bfraw*)(sBT + (c4 * 4 + 0) * SSD_R128 + q * 2) = to_bf16(v.x);
    *(bfraw*)(sBT + (c4 * 4 + 1) * SSD_R128 + q * 2) = to_bf16(v.y);
    *(bfraw*)(sBT + (c4 * 4 + 2) * SSD_R128 + q * 2) = to_bf16(v.z);
    *(bfraw*)(sBT + (c4 * 4 + 3) * SSD_R128 + q * 2) = to_bf16(v.w);
  }
  __syncthreads();
#pragma unroll
  for (int u = 0; u < 4; ++u) {
    const int i = tid + 256 * u, q = i >> 4, c4 = i & 15;
    const float4 v = *(const float4*)(p.ssd_xs() + (size_t)(row0 + q) * 512 + h * 64 + c4 * 4);
    const float wf = swf[q], wb = swb[q];
    *(bfraw*)(sxf + (c4 * 4 + 0) * SSD_R128 + q * 2) = to_bf16(v.x * wf); *(bfraw*)(sxb + (c4 * 4 + 0) * SSD_R128 + q * 2) = to_bf16(v.x * wb);
    *(bfraw*)(sxf + (c4 * 4 + 1) * SSD_R128 + q * 2) = to_bf16(v.y * wf); *(bfraw*)(sxb + (c4 * 4 + 1) * SSD_R128 + q * 2) = to_bf16(v.y * wb);
    *(bfraw*)(sxf + (c4 * 4 + 2) * SSD_R128 + q * 2) = to_bf16(v.z * wf); *(bfraw*)(sxb + (c4 * 4 + 2) * SSD_R128 + q * 2) = to_bf16(v.z * wb);
    *(bfraw*)(sxf + (c4 * 4 + 3) * SSD_R128 + q * 2) = to_bf16(v.w * wf); *(bfraw*)(sxb + (c4 * 4 + 3) * SSD_R128 + q * 2) = to_bf16(v.w * wb);
  }
  __syncthreads();
  f32x16 acc[2][2];
#pragma unroll
  for (int d = 0; d < 2; ++d)
#pragma unroll
    for (int t = 0; t < 2; ++t)
#pragma unroll
      for (int r = 0; r < 16; ++r) acc[d][t][r] = 0.f;
  const int pi = wid & 1, jj = wid >> 1;
  {
    const char* af = sxf + (pi * 32 + l31) * SSD_R128 + lh * 16;
    const char* ab = sxb + (pi * 32 + l31) * SSD_R128 + lh * 16;
    const char* bp = sBT + ((2 * jj) * 32 + l31) * SSD_R128 + lh * 16;
#pragma unroll
    for (int ks = 0; ks < 4; ++ks) {
      const bf16x8 a0 = *(const bf16x8*)(af + ks * 32), a1 = *(const bf16x8*)(ab + ks * 32);
      const bf16x8 b0 = *(const bf16x8*)(bp + ks * 32), b1 = *(const bf16x8*)(bp + 32 * SSD_R128 + ks * 32);
      acc[0][0] = MFMA16(a0, b0, acc[0][0]); acc[0][1] = MFMA16(a0, b1, acc[0][1]);
      acc[1][0] = MFMA16(a1, b0, acc[1][0]); acc[1][1] = MFMA16(a1, b1, acc[1][1]);
    }
  }
#pragma unroll
  for (int d = 0; d < 2; ++d) {
    bfraw* dst = p.ssd_st() + ((size_t)((b * 2 + d) * 8 + h) * NSTEP + step_of(cid, d)) * 8192;
#pragma unroll
    for (int t = 0; t < 2; ++t)
#pragma unroll
      for (int r = 0; r < 16; ++r) dst[(pi * 32 + ROW16(r, lh)) * 128 + (2 * jj + t) * 32 + l31] = to_bf16(acc[d][t][r]);
  }
}

__device__ __forceinline__ void ssd_out_item(const P& p, int layer, int item, char* smem) {
  const int h = item & 7, cid = (item >> 3) % NSTEP, b = item / (8 * NSTEP);
  char* sC = smem;
  char* sB = sC + 64 * SSD_R256;
  char* sxT = sB + 64 * SSD_R256;
  char* sP = sxT + 64 * SSD_R128;
  float* saf = (float*)(sP + 64 * SSD_R128);
  float* sab = saf + 64;
  float* sdf = sab + 64;
  float* sdb = sdf + 64;
  int tid_ = threadIdx.x; asm volatile("" : "+v"(tid_));
  const int tid = tid_, lane = tid & 63, wid = tid >> 6, l31 = lane & 31, lh = lane >> 5;
  const int row0 = chunk_row0(b, cid), g = h >> 2;
  const bfraw* hf = p.ssd_st() + ((size_t)((b * 2 + 0) * 8 + h) * NSTEP + step_of(cid, 0)) * 8192;
  const bfraw* hb = p.ssd_st() + ((size_t)((b * 2 + 1) * 8 + h) * NSTEP + step_of(cid, 1)) * 8192;
  u32x4g hreg[4];
#pragma unroll
  for (int u = 0; u < 4; ++u) { const int i = tid + 256 * u; hreg[u] = *(const u32x4g*)(hf + (i >> 4) * 128 + (i & 15) * 8); }
  __syncthreads();
#pragma unroll
  for (int u = 0; u < 4; ++u) {
    const int i = tid + 256 * u, q = i >> 4, c8 = i & 15;
    const float* cs = p.ssd_C() + (size_t)(row0 + q) * 256 + g * 128 + c8 * 8;
    const float* bs = p.ssd_B() + (size_t)(row0 + q) * 256 + g * 128 + c8 * 8;
    const float4 c0 = *(const float4*)cs, c1 = *(const float4*)(cs + 4), b0 = *(const float4*)bs, b1 = *(const float4*)(bs + 4);
    uint4 t;
    t.x = pack_bf16(c0.x, c0.y); t.y = pack_bf16(c0.z, c0.w); t.z = pack_bf16(c1.x, c1.y); t.w = pack_bf16(c1.z, c1.w);
    *(uint4*)(sC + q * SSD_R256 + c8 * 16) = t;
    t.x = pack_bf16(b0.x, b0.y); t.y = pack_bf16(b0.z, b0.w); t.z = pack_bf16(b1.x, b1.y); t.w = pack_bf16(b1.z, b1.w);
    *(uint4*)(sB + q * SSD_R256 + c8 * 16) = t;
  }
#pragma unroll
  for (int u = 0; u < 4; ++u) {
    const int i = tid + 256 * u, j = i >> 4, c4 = i & 15;
    const float4 xv = *(const float4*)(p.ssd_xs() + (size_t)(row0 + j) * 512 + h * 64 + c4 * 4);
    *(bfraw*)(sxT + (c4 * 4 + 0) * SSD_R128 + j * 2) = to_bf16(xv.x);
    *(bfraw*)(sxT + (c4 * 4 + 1) * SSD_R128 + j * 2) = to_bf16(xv.y);
    *(bfraw*)(sxT + (c4 * 4 + 2) * SSD_R128 + j * 2) = to_bf16(xv.z);
    *(bfraw*)(sxT + (c4 * 4 + 3) * SSD_R128 + j * 2) = to_bf16(xv.w);
  }
  if (wid < 2) {
    const int dir = wid;
    const float A = -__expf(p.a_log[layer * 16 + dir * 8 + h]);
    const int q = dir ? 63 - lane : lane;
    const float dt = p.ssd_dt()[(size_t)(row0 + q) * 16 + dir * 8 + h];
    const float ac = wave_incl_scan(dt * A, lane);
    (dir ? sab : saf)[q] = ac;
    (dir ? sdb : sdf)[q] = dt;
  }
  __syncthreads();
  const int it = wid >> 1, jt = wid & 1;
  {
    f32x16 sa;
#pragma unroll
    for (int r = 0; r < 16; ++r) sa[r] = 0.f;
    const char* ap = sC + (it * 32 + l31) * SSD_R256 + lh * 16;
    const char* bp = sB + (jt * 32 + l31) * SSD_R256 + lh * 16;
#pragma unroll
    for (int ks = 0; ks < 8; ++ks) sa = MFMA16(*(const bf16x8*)(ap + ks * 32), *(const bf16x8*)(bp + ks * 32), sa);
    const int j = jt * 32 + l31;
    const float afj = saf[j], abj = sab[j], dfj = sdf[j], dbj = sdb[j];
#pragma unroll
    for (int r = 0; r < 16; ++r) {
      const int i = it * 32 + ROW16(r, lh);
      float wgt = 0.f;
      if (j <= i) wgt += __expf(saf[i] - afj) * dfj;
      if (j >= i) wgt += __expf(sab[i] - abj) * dbj;
      *(bfraw*)(sP + i * SSD_R128 + j * 2) = to_bf16(sa[r] * wgt);
    }
  }
  __syncthreads();
#pragma unroll
  for (int u = 0; u < 4; ++u) { const int i = tid + 256 * u; *(u32x4g*)(sB + (i >> 4) * SSD_R256 + (i & 15) * 16) = hreg[u]; }
#pragma unroll
  for (int u = 0; u < 4; ++u) { const int i = tid + 256 * u; hreg[u] = *(const u32x4g*)(hb + (i >> 4) * 128 + (i & 15) * 8); }
  const int pt = wid & 1;
  f32x16 ya, gf, gb;
#pragma unroll
  for (int r = 0; r < 16; ++r) { ya[r] = 0.f; gf[r] = 0.f; gb[r] = 0.f; }
  {
    const char* ap = sP + (it * 32 + l31) * SSD_R128 + lh * 16;
    const char* bp = sxT + (pt * 32 + l31) * SSD_R128 + lh * 16;
#pragma unroll
    for (int ks = 0; ks < 4; ++ks) ya = MFMA16(*(const bf16x8*)(ap + ks * 32), *(const bf16x8*)(bp + ks * 32), ya);
  }
  __syncthreads();
  {
    const char* ap = sC + (it * 32 + l31) * SSD_R256 + lh * 16;
    const char* bp = sB + (pt * 32 + l31) * SSD_R256 + lh * 16;
#pragma unroll
    for (int ks = 0; ks < 8; ++ks) gf = MFMA16(*(const bf16x8*)(ap + ks * 32), *(const bf16x8*)(bp + ks * 32), gf);
  }
  __syncthreads();
#pragma unroll
  for (int u = 0; u < 4; ++u) { const int i = tid + 256 * u; *(u32x4g*)(sB + (i >> 4) * SSD_R256 + (i & 15) * 16) = hreg[u]; }
  __syncthreads();
  {
    const char* ap = sC + (it * 32 + l31) * SSD_R256 + lh * 16;
    const char* bp = sB + (pt * 32 + l31) * SSD_R256 + lh * 16;
#pragma unroll
    for (int ks = 0; ks < 8; ++ks) gb = MFMA16(*(const bf16x8*)(ap + ks * 32), *(const bf16x8*)(bp + ks * 32), gb);
  }
#pragma unroll
  for (int r = 0; r < 16; ++r) {
    const int i = it * 32 + ROW16(r, lh);
    p.ssd_y()[(size_t)(row0 + i) * 512 + h * 64 + pt * 32 + l31] = ya[r] + __expf(saf[i]) * gf[r] + __expf(sab[i]) * gb[r];
  }
}

__device__ __forceinline__ void ml_gates(const P& p, int layer, int row0, int h, int dir, int lane, float& bcum, float& li, float& tot) {
  const int j = dir ? 63 - lane : lane;
  const float* z = p.Z() + (size_t)(row0 + j) * NIN + ZC_MG + dir * 8;
  li = z[h] + p.gate_b[layer * 16 + dir * 8 + h];
  const float gf = z[4 + h] + p.gate_b[layer * 16 + dir * 8 + 4 + h];
  const float lf = gf >= 0.f ? -log1pf(expf(-gf)) : gf - log1pf(expf(gf));
  bcum = wave_incl_scan(lf, lane);
  tot = lane63(bcum);
}
__device__ __forceinline__ void ml_local_item(const P& p, int layer, int item, char* smem) {
  const int h = item & 3, cid = (item >> 2) % NSTEP, b = item / (4 * NSTEP);
  char* svf = smem;
  char* svb = svf + 128 * SSD_R128;
  char* skT = svb + 128 * SSD_R128;
  float* swf = (float*)(skT + 64 * SSD_R128);
  float* swb = swf + 64;
  int tid_ = threadIdx.x; asm volatile("" : "+v"(tid_));
  const int tid = tid_, lane = tid & 63, wid = tid >> 6, l31 = lane & 31, lh = lane >> 5;
  const int row0 = chunk_row0(b, cid);
  __syncthreads();
  if (wid < 2) {
    const int dir = wid;
    float bc, li, tot;
    ml_gates(p, layer, row0, h, dir, lane, bc, li, tot);
    const int j = dir ? 63 - lane : lane;
    (dir ? swb : swf)[j] = __expf(tot - bc + li);
    if (lane == 0) p.ml_gtot()[((b * 2 + dir) * 4 + h) * NSTEP + step_of(cid, dir)] = tot;
  }
#pragma unroll
  for (int u = 0; u < 4; ++u) {
    const int i = tid + 256 * u, j = i >> 4, c4 = i & 15;
    const float4 v = *(const float4*)(p.Z() + (size_t)(row0 + j) * NIN + ZC_MK + h * 64 + c4 * 4);
    *(bfraw*)(skT + (c4 * 4 + 0) * SSD_R128 + j * 2) = to_bf16(v.x);
    *(bfraw*)(skT + (c4 * 4 + 1) * SSD_R128 + j * 2) = to_bf16(v.y);
    *(bfraw*)(skT + (c4 * 4 + 2) * SSD_R128 + j * 2) = to_bf16(v.z);
    *(bfraw*)(skT + (c4 * 4 + 3) * SSD_R128 + j * 2) = to_bf16(v.w);
  }
  __syncthreads();
#pragma unroll
  for (int u = 0; u < 8; ++u) {
    const int i = tid + 256 * u, j = i >> 5, c4 = i & 31;
    const float4 v = *(const float4*)(p.Z() + (size_t)(row0 + j) * NIN + ZC_MV + h * 128 + c4 * 4);
    const float wf = swf[j], wb = swb[j];
    *(bfraw*)(svf + (c4 * 4 + 0) * SSD_R128 + j * 2) = to_bf16(v.x * wf); *(bfraw*)(svb + (c4 * 4 + 0) * SSD_R128 + j * 2) = to_bf16(v.x * wb);
    *(bfraw*)(svf + (c4 * 4 + 1) * SSD_R128 + j * 2) = to_bf16(v.y * wf); *(bfraw*)(svb + (c4 * 4 + 1) * SSD_R128 + j * 2) = to_bf16(v.y * wb);
    *(bfraw*)(svf + (c4 * 4 + 2) * SSD_R128 + j * 2) = to_bf16(v.z * wf); *(bfraw*)(svb + (c4 * 4 + 2) * SSD_R128 + j * 2) = to_bf16(v.z * wb);
    *(bfraw*)(svf + (c4 * 4 + 3) * SSD_R128 + j * 2) = to_bf16(v.w * wf); *(bfraw*)(svb + (c4 * 4 + 3) * SSD_R128 + j * 2) = to_bf16(v.w * wb);
  }
  __syncthreads();
  f32x16 acc[2][2];
#pragma unroll
  for (int d = 0; d < 2; ++d)
#pragma unroll
    for (int t = 0; t < 2; ++t)
#pragma unroll
      for (int r = 0; r < 16; ++r) acc[d][t][r] = 0.f;
  const int vt = wid;
  {
    const char* af = svf + (vt * 32 + l31) * SSD_R128 + lh * 16;
    const char* ab = svb + (vt * 32 + l31) * SSD_R128 + lh * 16;
    const char* bp = skT + l31 * SSD_R128 + lh * 16;
#pragma unroll
    for (int ks = 0; ks < 4; ++ks) {
      const bf16x8 a0 = *(const bf16x8*)(af + ks * 32), a1 = *(const bf16x8*)(ab + ks * 32);
      const bf16x8 b0 = *(const bf16x8*)(bp + ks * 32), b1 = *(const bf16x8*)(bp + 32 * SSD_R128 + ks * 32);
      acc[0][0] = MFMA16(a0, b0, acc[0][0]); acc[0][1] = MFMA16(a0, b1, acc[0][1]);
      acc[1][0] = MFMA16(a1, b0, acc[1][0]); acc[1][1] = MFMA16(a1, b1, acc[1][1]);
    }
  }
#pragma unroll
  for (int d = 0; d < 2; ++d) {
    bfraw* dst = p.ml_st() + ((size_t)((b * 2 + d) * 4 + h) * NSTEP + step_of(cid, d)) * 8192;
#pragma unroll
    for (int t = 0; t < 2; ++t)
#pragma unroll
      for (int r = 0; r < 16; ++r) dst[(vt * 32 + ROW16(r, lh)) * 64 + t * 32 + l31] = to_bf16(acc[d][t][r]);
  }
  if (tid < 128) {
    const int d = tid >> 6, kk = tid & 63;
    const float* w = d ? swb : swf;
    const char* kr = skT + kk * SSD_R128;
    float sacc = 0.f;
    for (int j = 0; j < 64; ++j) sacc += w[j] * from_bf16(*(const bfraw*)(kr + j * 2));
    p.ml_nst()[((size_t)((b * 2 + d) * 4 + h) * NSTEP + step_of(cid, d)) * 64 + kk] = sacc;
  }
}

__device__ __forceinline__ void ml_out_item(const P& p, int layer, int item, char* smem) {
  const int h = item & 3, cid = (item >> 2) % NSTEP, b = item / (4 * NSTEP);
  char* sq = smem;
  char* sk = sq + 64 * SSD_R128;
  char* svT = sk + 64 * SSD_R128;
  char* sPf = svT + 128 * SSD_R128;
  char* sPb = sPf + 64 * SSD_R128;
  char* sCs = sPb + 64 * SSD_R128;
  float* sbf = (float*)(sCs + 128 * SSD_R128);
  float* sbb = sbf + 64;
  float* slf = sbb + 64;
  float* slb = slf + 64;
  float* sdenf = slb + 64;
  float* sdenb = sdenf + 64;
  float* snf = sdenb + 64;
  float* snb = snf + 64;
  int tid_ = threadIdx.x; asm volatile("" : "+v"(tid_));
  const int tid = tid_, lane = tid & 63, wid = tid >> 6, l31 = lane & 31, lh = lane >> 5;
  const int row0 = chunk_row0(b, cid);
  const size_t slotf = ((size_t)((b * 2 + 0) * 4 + h) * NSTEP + step_of(cid, 0));
  const size_t slotb = ((size_t)((b * 2 + 1) * 4 + h) * NSTEP + step_of(cid, 1));
  const bfraw* csf = p.ml_st() + slotf * 8192;
  const bfraw* csb = p.ml_st() + slotb * 8192;
  u32x4g creg[4];
#pragma unroll
  for (int u = 0; u < 4; ++u) { const int i = tid + 256 * u; creg[u] = *(const u32x4g*)(csf + (i >> 3) * 64 + (i & 7) * 8); }
  __syncthreads();
#pragma unroll
  for (int u = 0; u < 4; ++u) {
    const int i = tid + 256 * u, j = i >> 4, c4 = i & 15;
    const float4 kv = *(const float4*)(p.Z() + (size_t)(row0 + j) * NIN + ZC_MK + h * 64 + c4 * 4);
    const float4 qv = *(const float4*)(p.Z() + (size_t)(row0 + j) * NIN + ZC_MQ + h * 64 + c4 * 4);
    uint2 t;
    t.x = pack_bf16(kv.x, kv.y); t.y = pack_bf16(kv.z, kv.w);
    *(uint2*)(sk + j * SSD_R128 + c4 * 8) = t;
    t.x = pack_bf16(qv.x * 0.125f, qv.y * 0.125f); t.y = pack_bf16(qv.z * 0.125f, qv.w * 0.125f);
    *(uint2*)(sq + j * SSD_R128 + c4 * 8) = t;
  }
#pragma unroll
  for (int u = 0; u < 8; ++u) {
    const int i = tid + 256 * u, j = i >> 5, c4 = i & 31;
    const float4 vv = *(const float4*)(p.Z() + (size_t)(row0 + j) * NIN + ZC_MV + h * 128 + c4 * 4);
    *(bfraw*)(svT + (c4 * 4 + 0) * SSD_R128 + j * 2) = to_bf16(vv.x);
    *(bfraw*)(svT + (c4 * 4 + 1) * SSD_R128 + j * 2) = to_bf16(vv.y);
    *(bfraw*)(svT + (c4 * 4 + 2) * SSD_R128 + j * 2) = to_bf16(vv.z);
    *(bfraw*)(svT + (c4 * 4 + 3) * SSD_R128 + j * 2) = to_bf16(vv.w);
  }
#pragma unroll
  for (int u = 0; u < 4; ++u) { const int i = tid + 256 * u; *(u32x4g*)(sCs + (i >> 3) * SSD_R128 + (i & 7) * 16) = creg[u]; }
#pragma unroll
  for (int u = 0; u < 4; ++u) { const int i = tid + 256 * u; creg[u] = *(const u32x4g*)(csb + (i >> 3) * 64 + (i & 7) * 8); }
  if (wid < 2) {
    const int dir = wid;
    float bc, li, tot;
    ml_gates(p, layer, row0, h, dir, lane, bc, li, tot);
    const int j = dir ? 63 - lane : lane;
    (dir ? sbb : sbf)[j] = bc;
    (dir ? slb : slf)[j] = li;
    (dir ? snb : snf)[lane] = p.ml_nst()[(dir ? slotb : slotf) * 64 + lane];
  }
  __syncthreads();
  const int it = wid >> 1, jt = wid & 1;
  {
    f32x16 sa;
#pragma unroll
    for (int r = 0; r < 16; ++r) sa[r] = 0.f;
    const char* ap = sq + (it * 32 + l31) * SSD_R128 + lh * 16;
    const char* bp = sk + (jt * 32 + l31) * SSD_R128 + lh * 16;
#pragma unroll
    for (int ks = 0; ks < 4; ++ks) sa = MFMA16(*(const bf16x8*)(ap + ks * 32), *(const bf16x8*)(bp + ks * 32), sa);
    const int j = jt * 32 + l31;
    const float bfj = sbf[j], bbj = sbb[j], lfj = slf[j], lbj = slb[j];
#pragma unroll
    for (int r = 0; r < 16; ++r) {
      const int i = it * 32 + ROW16(r, lh);
      *(bfraw*)(sPf + i * SSD_R128 + j * 2) = to_bf16(j <= i ? sa[r] * __expf(sbf[i] - bfj + lfj) : 0.f);
      *(bfraw*)(sPb + i * SSD_R128 + j * 2) = to_bf16(j >= i ? sa[r] * __expf(sbb[i] - bbj + lbj) : 0.f);
    }
  }
  __syncthreads();
  if (tid < 128) {
    const int d = tid >> 6, i = tid & 63;
    const char* Pm = (d ? sPb : sPf) + i * SSD_R128;
    const char* qr = sq + i * SSD_R128;
    const float* ns = d ? snb : snf;
    float rs = 0.f, qn = 0.f;
    for (int j = 0; j < 64; ++j) { rs += from_bf16(*(const bfraw*)(Pm + j * 2)); qn += from_bf16(*(const bfraw*)(qr + j * 2)) * ns[j]; }
    (d ? sdenb : sdenf)[i] = rs + __expf((d ? sbb : sbf)[i]) * qn;
  }
  const int v0 = 2 * (wid & 1);
  f32x16 nf[2], nb[2], gf[2], gb[2];
#pragma unroll
  for (int t = 0; t < 2; ++t)
#pragma unroll
    for (int r = 0; r < 16; ++r) { nf[t][r] = 0.f; nb[t][r] = 0.f; gf[t][r] = 0.f; gb[t][r] = 0.f; }
  {
    const char* apf = sPf + (it * 32 + l31) * SSD_R128 + lh * 16;
    const char* apb = sPb + (it * 32 + l31) * SSD_R128 + lh * 16;
    const char* aq = sq + (it * 32 + l31) * SSD_R128 + lh * 16;
    const char* bv = svT + (v0 * 32 + l31) * SSD_R128 + lh * 16;
    const char* bc = sCs + (v0 * 32 + l31) * SSD_R128 + lh * 16;
#pragma unroll
    for (int ks = 0; ks < 4; ++ks) {
      const bf16x8 af = *(const bf16x8*)(apf + ks * 32), ab = *(const bf16x8*)(apb + ks * 32), qa = *(const bf16x8*)(aq + ks * 32);
      const bf16x8 b0 = *(const bf16x8*)(bv + ks * 32), b1 = *(const bf16x8*)(bv + 32 * SSD_R128 + ks * 32);
      const bf16x8 c0 = *(const bf16x8*)(bc + ks * 32), c1 = *(const bf16x8*)(bc + 32 * SSD_R128 + ks * 32);
      nf[0] = MFMA16(af, b0, nf[0]); nf[1] = MFMA16(af, b1, nf[1]);
      nb[0] = MFMA16(ab, b0, nb[0]); nb[1] = MFMA16(ab, b1, nb[1]);
      gf[0] = MFMA16(qa, c0, gf[0]); gf[1] = MFMA16(qa, c1, gf[1]);
    }
  }
  __syncthreads();
#pragma unroll
  for (int r = 0; r < 16; ++r) {
    const int i = it * 32 + ROW16(r, lh);
    const float ef = __expf(sbf[i]);
    const float idf = 1.f / fmaxf(fabsf(sdenf[i]), 1.f), idb = 1.f / fmaxf(fabsf(sdenb[i]), 1.f);
#pragma unroll
    for (int t = 0; t < 2; ++t) nf[t][r] = (nf[t][r] + ef * gf[t][r]) * idf + nb[t][r] * idb;
  }
#pragma unroll
  for (int u = 0; u < 4; ++u) { const int i = tid + 256 * u; *(u32x4g*)(sCs + (i >> 3) * SSD_R128 + (i & 7) * 16) = creg[u]; }
  __syncthreads();
  {
    const char* aq = sq + (it * 32 + l31) * SSD_R128 + lh * 16;
    const char* bc = sCs + (v0 * 32 + l31) * SSD_R128 + lh * 16;
#pragma unroll
    for (int ks = 0; ks < 4; ++ks) {
      const bf16x8 qa = *(const bf16x8*)(aq + ks * 32);
      gb[0] = MFMA16(qa, *(const bf16x8*)(bc + ks * 32), gb[0]);
      gb[1] = MFMA16(qa, *(const bf16x8*)(bc + 32 * SSD_R128 + ks * 32), gb[1]);
    }
  }
#pragma unroll
  for (int r = 0; r < 16; ++r) {
    const int i = it * 32 + ROW16(r, lh);
    const float eb = __expf(sbb[i]);
    const float idb = 1.f / fmaxf(fabsf(sdenb[i]), 1.f);
#pragma unroll
    for (int t = 0; t < 2; ++t)
      p.ml_h()[(size_t)(row0 + i) * 512 + h * 128 + (v0 + t) * 32 + l31] = nf[t][r] + eb * gb[t][r] * idb;
  }
}

__device__ __forceinline__ float gelu_tanh(float x) {
  const float k0 = 0.7978845608028654f;
  return 0.5f * x * (1.f + tanhf(k0 * (x + 0.044715f * x * x * x)));
}
__device__ __forceinline__ void s5_drive(const P& p, int dg, int row0, int dir, int g, int lane, float (&sre)[64], float (&sim)[64]) {
  const int l31 = lane & 31, lh = lane >> 5;
  bf16x8 ua[2];
#pragma unroll
  for (int tt = 0; tt < 2; ++tt) {
    const int tp = 32 * tt + l31;
    const int row = dir ? row0 + 63 - tp : row0 + tp;
    const float* zp = p.Z() + (size_t)row * NIN + ZC_U + g * 16 + 8 * lh;
    const float4 a = *(const float4*)zp, b = *(const float4*)(zp + 4);
    uint4 t; t.x = pack_bf16(a.x, a.y); t.y = pack_bf16(a.z, a.w); t.z = pack_bf16(b.x, b.y); t.w = pack_bf16(b.z, b.w);
    ua[tt] = __builtin_bit_cast(bf16x8, t);
  }
  bf16x8 bfr[4];
#pragma unroll
  for (int pt = 0; pt < 4; ++pt) bfr[pt] = *(const bf16x8*)(p.s5_bbh() + ((size_t)dg * 128 + 32 * pt + l31) * 16 + 8 * lh);
  f32x16 d[2][4];
#pragma unroll
  for (int tt = 0; tt < 2; ++tt)
#pragma unroll
    for (int pt = 0; pt < 4; ++pt) {
      f32x16 z;
#pragma unroll
      for (int r = 0; r < 16; ++r) z[r] = 0.f;
      d[tt][pt] = __builtin_amdgcn_mfma_f32_32x32x16_bf16(ua[tt], bfr[pt], z, 0, 0, 0);
    }
#pragma unroll
  for (int tt = 0; tt < 2; ++tt)
#pragma unroll
    for (int r = 0; r < 16; ++r) {
      const float myre = lh ? d[tt][1][r] : d[tt][0][r];
      const float myim = lh ? d[tt][3][r] : d[tt][2][r];
      const float gre = lh ? d[tt][0][r] : d[tt][1][r];
      const float gim = lh ? d[tt][2][r] : d[tt][3][r];
      const float ore = xor32(gre), oim = xor32(gim);
      const int tb = 32 * tt + 8 * (r >> 2) + (r & 3);
      sre[tb] = lh ? ore : myre; sre[tb + 4] = lh ? myre : ore;
      sim[tb] = lh ? oim : myim; sim[tb + 4] = lh ? myim : oim;
    }
}

__device__ __forceinline__ void s5_local_item(const P& p, int layer, int witem, char* smem) {
  int tid_ = threadIdx.x; asm volatile("" : "+v"(tid_));
  const int lane = tid_ & 63;
  const int g = witem & 31, st = (witem >> 5) % NSTEP, dir = (witem / (32 * NSTEP)) & 1, b = witem / (64 * NSTEP);
  const int cid = cid_of(st, dir), row0 = chunk_row0(b, cid);
  const int dg = (layer * 2 + dir) * 32 + g;
  float sre[64], sim[64];
  s5_drive(p, dg, row0, dir, g, lane, sre, sim);
  const float ar = p.s5_a()[(dg * 64 + lane) * 2], ai = p.s5_a()[(dg * 64 + lane) * 2 + 1];
  float xr = 0.f, xi = 0.f;
#pragma unroll
  for (int t = 0; t < 64; ++t) {
    const float nr = ar * xr - ai * xi + sre[t];
    const float ni = ar * xi + ai * xr + sim[t];
    xr = nr; xi = ni;
  }
  const size_t slot = ((size_t)((b * 2 + dir) * 32 + g) * NSTEP + st);
  *(float2*)(p.s5_st() + (slot * 64 + lane) * 2) = make_float2(xr, xi);
}

#define S5_XROW 272
__device__ __forceinline__ void s5_out_item(const P& p, int layer, int witem, char* smem) {
  int tid_ = threadIdx.x; asm volatile("" : "+v"(tid_));
  const int lane = tid_ & 63, wid = tid_ >> 6, l31 = lane & 31, lh = lane >> 5;
  char* sX = smem + wid * (64 * S5_XROW);
  const int g = witem & 31, cid = (witem >> 5) % NSTEP, b = witem / (32 * NSTEP);
  const int row0 = chunk_row0(b, cid);
  const bfraw* cmrow = p.s5_cmh() + ((size_t)(layer * 32 + g) * 32 + l31) * 128 + 8 * lh;
  f32x16 yf[2], yb[2];
#pragma unroll 1
  for (int dir = 0; dir < 2; ++dir) {
    const int st = step_of(cid, dir);
    const int dg = (layer * 2 + dir) * 32 + g;
    const size_t slot = ((size_t)((b * 2 + dir) * 32 + g) * NSTEP + st);
    float sre[64], sim[64];
    s5_drive(p, dg, row0, dir, g, lane, sre, sim);
    const float ar = p.s5_a()[(dg * 64 + lane) * 2], ai = p.s5_a()[(dg * 64 + lane) * 2 + 1];
    float xr = p.s5_st()[(slot * 64 + lane) * 2], xi = p.s5_st()[(slot * 64 + lane) * 2 + 1];
#pragma unroll
    for (int t = 0; t < 64; ++t) {
      const float nr = ar * xr - ai * xi + sre[t];
      const float ni = ar * xi + ai * xr + sim[t];
      xr = nr; xi = ni;
      *(bfraw*)(sX + t * S5_XROW + lane * 2) = to_bf16(xr);
      *(bfraw*)(sX + t * S5_XROW + 128 + lane * 2) = to_bf16(xi);
    }
    f32x16 y0, y1;
#pragma unroll
    for (int r = 0; r < 16; ++r) { y0[r] = 0.f; y1[r] = 0.f; }
    const char* ap = sX + l31 * S5_XROW + lh * 16;
#pragma unroll
    for (int ks = 0; ks < 8; ++ks) {
      const bf16x8 a0 = *(const bf16x8*)(ap + ks * 32);
      const bf16x8 a1 = *(const bf16x8*)(ap + 32 * S5_XROW + ks * 32);
      const bf16x8 cf = *(const bf16x8*)(cmrow + 16 * ks);
      y0 = __builtin_amdgcn_mfma_f32_32x32x16_bf16(a0, cf, y0, 0, 0, 0);
      y1 = __builtin_amdgcn_mfma_f32_32x32x16_bf16(a1, cf, y1, 0, 0, 0);
    }
    if (dir == 0) { yf[0] = y0; yf[1] = y1; } else { yb[0] = y0; yb[1] = y1; }
  }
  const float dsk = p.s5_d[layer * 512 + g * 16 + (l31 & 15)];
#pragma unroll
  for (int tt = 0; tt < 2; ++tt)
#pragma unroll
    for (int r = 0; r < 16; ++r) {
      const float ybv = xor32(yb[1 - tt][15 - r]);
      if (l31 < 16) {
        const int t = 32 * tt + ROW16(r, lh);
        const float u = p.Z()[(size_t)(row0 + t) * NIN + ZC_U + g * 16 + l31];
        const float gy = gelu_tanh(yf[tt][r] + ybv + dsk * u);
        const size_t o = (size_t)(row0 + t) * 512 + g * 16 + l31;
        p.ydpre()[o] = gy;
        p.ydpre_bf()[o] = to_bf16(gy);
      }
    }
}

#define N_SSD_CH (2 * NSTEP * 8)
#define N_ML_CH (2 * NSTEP * 4)
#define N_S5_BLK (2 * 2 * NSTEP * 32 / 4)
__device__ __forceinline__ void ph_mixA(const P& p, int layer, int bid, char* smem) {
  FOR_ITEMS(w, N_SSD_CH + N_ML_CH + N_S5_BLK, bid) {
    if (w < N_SSD_CH) ssd_local_item(p, layer, w, smem);
    else if (w < N_SSD_CH + N_ML_CH) ml_local_item(p, layer, w - N_SSD_CH, smem);
    else { __syncthreads(); s5_local_item(p, layer, (w - N_SSD_CH - N_ML_CH) * 4 + (otid() >> 6), smem); }
  }
}
#define N_ATT_LAT 256
#define N_ATT_CTX 16
__device__ __forceinline__ void ph_scan(const P& p, int layer, int bid, char* smem) {
  const int nitems = 256 + 128 + 4 + 32;
  const int tid = otid();
  for (int w = bid; w < nitems; w += gridDim.x) {
    int it = w;
    if (it < 256) {
      const int idx = it * 256 + tid, seq = idx >> 11, off = idx & 2047;
      uint2* base = (uint2*)(p.ssd_st() + (size_t)seq * NSTEP * 8192) + off;
      const float* at = p.ssd_atot() + seq * NSTEP;
      float4 hh = make_float4(0.f, 0.f, 0.f, 0.f);
#pragma unroll 4
      for (int s2 = 0; s2 < NSTEP; ++s2) {
        const uint2 tb = base[(size_t)s2 * 2048];
        uint2 ob; ob.x = pack_bf16(hh.x, hh.y); ob.y = pack_bf16(hh.z, hh.w);
        base[(size_t)s2 * 2048] = ob;
        const float e = expf(at[s2]);
        hh.x = e * hh.x + __uint_as_float(tb.x << 16); hh.y = e * hh.y + __uint_as_float(tb.x & 0xffff0000u);
        hh.z = e * hh.z + __uint_as_float(tb.y << 16); hh.w = e * hh.w + __uint_as_float(tb.y & 0xffff0000u);
      }
      continue;
    }
    it -= 256;
    if (it < 128) {
      const int idx = it * 256 + tid, seq = idx >> 11, off = idx & 2047;
      uint2* base = (uint2*)(p.ml_st() + (size_t)seq * NSTEP * 8192) + off;
      const float* at = p.ml_gtot() + seq * NSTEP;
      float4 hh = make_float4(0.f, 0.f, 0.f, 0.f);
#pragma unroll 4
      for (int s2 = 0; s2 < NSTEP; ++s2) {
        const uint2 tb = base[(size_t)s2 * 2048];
        uint2 ob; ob.x = pack_bf16(hh.x, hh.y); ob.y = pack_bf16(hh.z, hh.w);
        base[(size_t)s2 * 2048] = ob;
        const float e = expf(at[s2]);
        hh.x = e * hh.x + __uint_as_float(tb.x << 16); hh.y = e * hh.y + __uint_as_float(tb.x & 0xffff0000u);
        hh.z = e * hh.z + __uint_as_float(tb.y << 16); hh.w = e * hh.w + __uint_as_float(tb.y & 0xffff0000u);
      }
      continue;
    }
    it -= 128;
    if (it < 4) {
      const int idx = it * 256 + tid, seq = idx >> 6, off = idx & 63;
      float* base = p.ml_nst() + (size_t)seq * NSTEP * 64 + off;
      const float* at = p.ml_gtot() + seq * NSTEP;
      float hh = 0.f;
      for (int s2 = 0; s2 < NSTEP; ++s2) {
        float t = base[s2 * 64]; base[s2 * 64] = hh;
        hh = expf(at[s2]) * hh + t;
      }
      continue;
    }
    it -= 4;
    {
      const int idx = it * 256 + tid, seq = idx >> 6, sp = idx & 63;
      const int g = seq & 31, dir = (seq >> 5) & 1;
      const int dg = (layer * 2 + dir) * 32 + g;
      float pr = p.s5_a()[(dg * 64 + sp) * 2], pi = p.s5_a()[(dg * 64 + sp) * 2 + 1];
#pragma unroll
      for (int q = 0; q < 6; ++q) { float nr = pr * pr - pi * pi, ni = 2.f * pr * pi; pr = nr; pi = ni; }
      float* base = p.s5_st() + ((size_t)seq * NSTEP * 64 + sp) * 2;
      float xr = 0.f, xi = 0.f;
      for (int s2 = 0; s2 < NSTEP; ++s2) {
        float tr = base[s2 * 128], ti = base[s2 * 128 + 1];
        base[s2 * 128] = xr; base[s2 * 128 + 1] = xi;
        float nr = pr * xr - pi * xi + tr, ni = pr * xi + pi * xr + ti;
        xr = nr; xi = ni;
      }
    }
  }
}
__device__ __forceinline__ void ph_attn(const P& p, int layer, int bid, char* smem) {
  const int natt = 512 + (layer == 0 ? 32 : 0);
  for (int w = bid; w < natt; w += gridDim.x) {
    int it = w;
    const bfraw *qp, *kp, *vp; int nk, row0, hh, part;
    if (it < 512) {
      part = it & 1; const int qb = (it >> 1) & 31; hh = (it >> 6) & 3; const int b = it >> 8;
      qp = p.Q() + ((size_t)(b * 4 + hh) * SL + qb * 128) * 192;
      kp = p.K() + ((size_t)(b * 4 + hh) * NKEY + part * (NKEY / 2)) * 192;
      vp = p.V() + (size_t)(b * 4 + hh) * 128 * NKEY + part * (NKEY / 2);
      nk = NKEY / 2; row0 = b * SL + qb * 128;
    } else {
      it -= 512;
      part = it & 1; const int qb = (it >> 1) & 1; hh = (it >> 2) & 3; const int b = it >> 4;
      qp = p.Qc() + ((size_t)(b * 4 + hh) * CL + qb * 128) * 192;
      kp = p.K() + ((size_t)(b * 4 + hh) * NKEY + SL + part * (CL / 2)) * 192;
      vp = p.V() + (size_t)(b * 4 + hh) * 128 * NKEY + SL + part * (CL / 2);
      nk = CL / 2; row0 = TLAT + b * CL + qb * 128;
    }
    float* op = (part ? p.O2() : p.O()) + (size_t)row0 * 512 + hh * 128;
    float* ml = p.attn_ml() + ((size_t)(part * 4 + hh) * TTOT + row0) * 2;
    attn_item(qp, kp, vp, nk, op, ml, smem);
  }
}
__device__ __forceinline__ void ph_mixC(const P& p, int layer, int bid, char* smem) {
  FOR_ITEMS(w, N_SSD_CH + N_ML_CH + N_S5_BLK / 2, bid) {
    if (w < N_SSD_CH) ssd_out_item(p, layer, w, smem);
    else if (w < N_SSD_CH + N_ML_CH) ml_out_item(p, layer, w - N_SSD_CH, smem);
    else { __syncthreads(); s5_out_item(p, layer, (w - N_SSD_CH - N_ML_CH) * 4 + (otid() >> 6), smem); }
  }
}

__device__ __forceinline__ void ph_glu(const P& p, int layer, int bid, char* smem) {
  const float* yp = p.ydpre(); float* yg = p.ydg(); const float* gb = p.glu_b + layer * 512;
  auto epi = [=](int row, int col, float v) {
    float y = yp[(size_t)row * 512 + col];
    yg[(size_t)row * 512 + col] = y * sigmoidf_(v + gb[col]);
  };
  gemm_dense<2>(p.ydpre_bf(), 512, p.wgluT() + (size_t)layer * 512 * 512, layer == 0 ? TTOT : TLAT, 512, 512, epi, bid, smem);
}

__device__ __forceinline__ void ph_final_mix(const P& p, int layer, int bid, char* smem) {
  const int tid = otid(), lane = tid & 63, wid = tid >> 6;
  const float* onw = p.out_norm_w + layer * 2048;
  const int nrows = layer == 0 ? TTOT : TLAT;
  for (int rpb_ = (nrows % (int)gridDim.x) == 0 ? nrows / (int)gridDim.x : 0, i_ = wid, r = rpb_ ? bid * rpb_ + i_ : bid * 4 + wid;
       rpb_ ? i_ < rpb_ : r < nrows; i_ += 4, r = rpb_ ? bid * rpb_ + i_ : r + (int)gridDim.x * 4) {
    const float* z = p.Z() + (size_t)r * NIN;
    bfraw* Y = p.Y() + (size_t)r * LDH;
    const int c = lane * 8;
    f32x4v a0 = *(const f32x4v*)(p.O() + (size_t)r * 512 + c), a1 = *(const f32x4v*)(p.O() + (size_t)r * 512 + c + 4);
    {
      const f32x4v b0 = *(const f32x4v*)(p.O2() + (size_t)r * 512 + c), b1 = *(const f32x4v*)(p.O2() + (size_t)r * 512 + c + 4);
      const float2 ml0 = *(const float2*)(p.attn_ml() + ((size_t)(lane >> 4) * TTOT + r) * 2);
      const float2 ml1 = *(const float2*)(p.attn_ml() + ((size_t)(4 + (lane >> 4)) * TTOT + r) * 2);
      const float mm = fmaxf(ml0.x, ml1.x);
      const float w0 = exp2f(ml0.x - mm), w1 = exp2f(ml1.x - mm);
      const float inv = 1.f / (ml0.y * w0 + ml1.y * w1);
      a0 = (a0 * w0 + b0 * w1) * inv; a1 = (a1 * w0 + b1 * w1) * inv;
    }
    f32x4v y0 = *(const f32x4v*)(p.ssd_y() + (size_t)r * 512 + c), y1 = *(const f32x4v*)(p.ssd_y() + (size_t)r * 512 + c + 4);
    f32x4v x0 = *(const f32x4v*)(p.ssd_xs() + (size_t)r * 512 + c), x1 = *(const f32x4v*)(p.ssd_xs() + (size_t)r * 512 + c + 4);
    f32x4v g0 = *(const f32x4v*)(z + ZC_BZ + c), g1 = *(const f32x4v*)(z + ZC_BZ + c + 4);
    f32x4v h0 = *(const f32x4v*)(p.ml_h() + (size_t)r * 512 + c), h1 = *(const f32x4v*)(p.ml_h() + (size_t)r * 512 + c + 4);
    f32x4v o0 = *(const f32x4v*)(z + ZC_MO + c), o1 = *(const f32x4v*)(z + ZC_MO + c + 4);
    f32x4v d0 = *(const f32x4v*)(p.ydg() + (size_t)r * 512 + c), d1 = *(const f32x4v*)(p.ydg() + (size_t)r * 512 + c + 4);
    const float dsk = p.ssd_d[layer * 8 + (c >> 6)];
    float sa = 0.f, sb = 0.f, sc = 0.f, sd = 0.f;
    float bv[8], av[8], cv[8], dv[8];
#pragma unroll
    for (int i = 0; i < 4; ++i) {
      av[i] = a0[i]; av[4 + i] = a1[i];
      bv[i] = (y0[i] + dsk * x0[i]) * siluf_(g0[i]); bv[4 + i] = (y1[i] + dsk * x1[i]) * siluf_(g1[i]);
      cv[i] = h0[i]; cv[4 + i] = h1[i];
      dv[i] = d0[i]; dv[4 + i] = d1[i];
    }
#pragma unroll
    for (int i = 0; i < 8; ++i) { sa += av[i] * av[i]; sb += bv[i] * bv[i]; sc += cv[i] * cv[i]; sd += dv[i] * dv[i]; }
    sa = wave_sum(sa); sb = wave_sum(sb); sd = wave_sum(sd);
    sc = row16_sum(sc);
    const float ra = rsqrtf(sa * (1.f / 512.f) + EPSV), rb = rsqrtf(sb * (1.f / 512.f) + EPSV);
    const float rc = rsqrtf(sc * (1.f / 128.f) + EPSV), rd = rsqrtf(sd * (1.f / 512.f) + EPSV);
    float ogv[8];
#pragma unroll
    for (int i = 0; i < 4; ++i) { ogv[i] = sigmoidf_(o0[i]); ogv[4 + i] = sigmoidf_(o1[i]); }
    uint4 ua, ub, uc, ud;
    const float* w = onw + c;
    ua.x = pack_bf16(av[0] * ra * w[0], av[1] * ra * w[1]); ua.y = pack_bf16(av[2] * ra * w[2], av[3] * ra * w[3]);
    ua.z = pack_bf16(av[4] * ra * w[4], av[5] * ra * w[5]); ua.w = pack_bf16(av[6] * ra * w[6], av[7] * ra * w[7]);
    w = onw + 512 + c;
    ub.x = pack_bf16(bv[0] * rb * w[0], bv[1] * rb * w[1]); ub.y = pack_bf16(bv[2] * rb * w[2], bv[3] * rb * w[3]);
    ub.z = pack_bf16(bv[4] * rb * w[4], bv[5] * rb * w[5]); ub.w = pack_bf16(bv[6] * rb * w[6], bv[7] * rb * w[7]);
    w = onw + 1024 + c;
    uc.x = pack_bf16(cv[0] * rc * ogv[0] * w[0], cv[1] * rc * ogv[1] * w[1]); uc.y = pack_bf16(cv[2] * rc * ogv[2] * w[2], cv[3] * rc * ogv[3] * w[3]);
    uc.z = pack_bf16(cv[4] * rc * ogv[4] * w[4], cv[5] * rc * ogv[5] * w[5]); uc.w = pack_bf16(cv[6] * rc * ogv[6] * w[6], cv[7] * rc * ogv[7] * w[7]);
    w = onw + 1536 + c;
    ud.x = pack_bf16(dv[0] * rd * w[0], dv[1] * rd * w[1]); ud.y = pack_bf16(dv[2] * rd * w[2], dv[3] * rd * w[3]);
    ud.z = pack_bf16(dv[4] * rd * w[4], dv[5] * rd * w[5]); ud.w = pack_bf16(dv[6] * rd * w[6], dv[7] * rd * w[7]);
    store16_wt(Y + c, __builtin_bit_cast(u32x4wt, ua)); store16_wt(Y + 512 + c, __builtin_bit_cast(u32x4wt, ub));
    store16_wt(Y + 1024 + c, __builtin_bit_cast(u32x4wt, uc)); store16_wt(Y + 1536 + c, __builtin_bit_cast(u32x4wt, ud));
  }
}

__device__ __forceinline__ void ph_wout(const P& p, int layer, int bid, char* smem) {
  const P pp = p;
  const int M = layer == 0 ? TTOT : TLAT;
  auto epi = [=](int row, int col, float v) {
    const int mi = row_modidx(row);
    const float g1 = pp.modv()[(layer * 3 + mi) * 12288 + 2 * 2048 + col];
    float xin;
    if (layer == 0) xin = row < TLAT ? pp.x[(size_t)row * 2048 + col] : pp.ctx[(size_t)(row - TLAT) * 2048 + col];
    else xin = pp.X()[(size_t)row * 2048 + col];
    pp.X()[(size_t)row * 2048 + col] = xin + g1 * v;
  };
  gemm_dense<2>(p.Y(), LDH, p.woutT() + (size_t)layer * 2048 * 2048, M, 2048, 2048, epi, bid, smem);
}

__device__ __forceinline__ void ph_router(const P& p, int layer, int bid, char* smem) {
  float* sA = (float*)smem;
  float* sW = sA + 16 * 129;
  float* sNW = sW + 128 * 64;
  float* sSH = sNW + 2048;
  float* srs = sSH + 2048;
  float* sL = sW;
  const int tid = otid(), lane = tid & 63, wid = tid >> 6, l15 = lane & 15, l4 = lane >> 4;
  const int T = layer == 0 ? TTOT : TLAT;
  const float* nw = p.norm2_w + layer * 2048;
  const float* wg = p.w_group + (size_t)layer * 2048 * 4;
  const float* we = p.w_expert + (size_t)layer * 2048 * 32;
  typedef float f32x4a __attribute__((ext_vector_type(4)));
  __syncthreads();
  for (int i = tid; i < 128 * 28; i += 256) sW[(i / 28) * 64 + 36 + (i % 28)] = 0.f;
  const int ar = tid >> 4, aks = (tid & 15) * 8;
  const int wk = tid >> 1, whalf = tid & 1;
  for (int item = bid; item < (T >> 4); item += gridDim.x) {
    const int row0 = item * 16;
    const int mi = row_modidx(row0);
    const float* mrow = p.modv() + (layer * 3 + mi) * 12288;
    __syncthreads();
    for (int i = tid; i < 2048; i += 256) { sNW[i] = nw[i] * (1.f + mrow[4 * 2048 + i]); sSH[i] = mrow[3 * 2048 + i]; }
#pragma unroll 2
    for (int rr = 0; rr < 4; ++rr) {
      const float* xr = p.X() + (size_t)(row0 + wid * 4 + rr) * 2048 + lane * 4;
      float ss = 0.f;
#pragma unroll
      for (int i = 0; i < 8; ++i) { float4 v = *(const float4*)(xr + i * 256); ss += v.x * v.x + v.y * v.y + v.z * v.z + v.w * v.w; }
      ss = wave_sum(ss);
      if (lane == 0) srs[wid * 4 + rr] = rsqrtf(ss * (1.f / 2048.f) + EPSV);
    }
    __syncthreads();
    const float rs = srs[ar];
    const float* xrow = p.X() + (size_t)(row0 + ar) * 2048 + aks;
    bfraw* hrow = p.H() + (size_t)(row0 + ar) * LDH + aks;
    float4 xa0, xa1, wv0, wv1, wv2, wv3, wv4;
#define RT_GLOAD(k0)                                                                                   \
    {                                                                                                  \
      xa0 = *(const float4*)(xrow + (k0)); xa1 = *(const float4*)(xrow + (k0) + 4);                    \
      const float* er = we + (size_t)((k0) + wk) * 32 + (whalf ? 12 : 0);                              \
      wv0 = *(const float4*)(er); wv1 = *(const float4*)(er + 4); wv2 = *(const float4*)(er + 8);      \
      wv3 = *(const float4*)(er + 12); wv4 = *(const float4*)(er + 16);                                \
      if (!whalf) wv3 = *(const float4*)(wg + (size_t)((k0) + wk) * 4);                                \
    }
#define RT_A4(q, v)                                                                                    \
    {                                                                                                  \
      const int kq_ = (k0w) + aks + (q) * 4;                                                           \
      float h0 = v.x * rs * sNW[kq_] + sSH[kq_], h1 = v.y * rs * sNW[kq_ + 1] + sSH[kq_ + 1];          \
      float h2 = v.z * rs * sNW[kq_ + 2] + sSH[kq_ + 2], h3 = v.w * rs * sNW[kq_ + 3] + sSH[kq_ + 3];  \
      float* d = sA + ar * 129 + aks + (q) * 4; d[0] = h0; d[1] = h1; d[2] = h2; d[3] = h3;            \
      uint2 hb; hb.x = pack_bf16(h0, h1); hb.y = pack_bf16(h2, h3);                                    \
      *(uint2*)(hrow + (k0w) + (q) * 4) = hb;                                                          \
    }
#define RT_SWRITE()                                                                                    \
    {                                                                                                  \
      RT_A4(0, xa0) RT_A4(1, xa1)                                                                      \
      float* w = sW + wk * 64;                                                                         \
      if (!whalf) {                                                                                    \
        w[0] = wv3.x; w[1] = wv3.y; w[2] = wv3.z; w[3] = wv3.w;                                        \
        w[4] = wv0.x; w[5] = wv0.y; w[6] = wv0.z; w[7] = wv0.w; w[8] = wv1.x; w[9] = wv1.y; w[10] = wv1.z; w[11] = wv1.w; \
        w[12] = wv2.x; w[13] = wv2.y; w[14] = wv2.z; w[15] = wv2.w;                                    \
      } else {                                                                                         \
        w[16] = wv0.x; w[17] = wv0.y; w[18] = wv0.z; w[19] = wv0.w; w[20] = wv1.x; w[21] = wv1.y; w[22] = wv1.z; w[23] = wv1.w; \
        w[24] = wv2.x; w[25] = wv2.y; w[26] = wv2.z; w[27] = wv2.w; w[28] = wv3.x; w[29] = wv3.y; w[30] = wv3.z; w[31] = wv3.w; \
        w[32] = wv4.x; w[33] = wv4.y; w[34] = wv4.z; w[35] = wv4.w;                                    \
      }                                                                                                \
    }
    int k0w = 0;
    RT_GLOAD(0)
    RT_SWRITE()
    __syncthreads();
    f32x4a acc0 = {0.f, 0.f, 0.f, 0.f}, acc1 = acc0, acc2 = acc0;
    const float* ap = sA + l15 * 129 + wid * 32 + l4;
    const float* bp = sW + (wid * 32 + l4) * 64 + l15;
    for (int k0 = 0; k0 < 2048; k0 += 128) {
      const bool more = (k0 + 128) < 2048;
      if (more) RT_GLOAD(k0 + 128)
#pragma unroll
      for (int ks = 0; ks < 8; ++ks) {
        const float a = ap[4 * ks];
        const float* bq = bp + 4 * ks * 64;
        acc0 = __builtin_amdgcn_mfma_f32_16x16x4f32(a, bq[0], acc0, 0, 0, 0);
        acc1 = __builtin_amdgcn_mfma_f32_16x16x4f32(a, bq[16], acc1, 0, 0, 0);
        acc2 = __builtin_amdgcn_mfma_f32_16x16x4f32(a, bq[32], acc2, 0, 0, 0);
      }
      __syncthreads();
      k0w = k0 + 128;
      if (more) RT_SWRITE()
      __syncthreads();
    }
#pragma unroll
    for (int r = 0; r < 4; ++r) {
      float* d = sL + (wid * 16 + 4 * l4 + r) * 64 + l15;
      d[0] = acc0[r]; d[16] = acc1[r]; d[32] = acc2[r];
    }
    __syncthreads();
    if (tid < 16) {
      const int r = row0 + tid;
      float lg[36];
#pragma unroll
      for (int j = 0; j < 36; ++j) lg[j] = sL[(0 * 16 + tid) * 64 + j] + sL[(1 * 16 + tid) * 64 + j] + sL[(2 * 16 + tid) * 64 + j] + sL[(3 * 16 + tid) * 64 + j];
      int gi = 0; float gm = lg[0];
#pragma unroll
      for (int j = 1; j < 4; ++j) if (lg[j] > gm) { gm = lg[j]; gi = j; }
      float gs = 0.f;
#pragma unroll
      for (int j = 0; j < 4; ++j) gs += expf(lg[j] - gm);
      const float gw = 1.f / gs;
      int i1 = 0, i2 = -1; float v1 = -INFINITY, v2 = -INFINITY;
#pragma unroll
      for (int j = 0; j < 8; ++j) {
        const float e = gi == 0 ? lg[4 + j] : (gi == 1 ? lg[12 + j] : (gi == 2 ? lg[20 + j] : lg[28 + j]));
        if (e > v1) { v2 = v1; i2 = i1; v1 = e; i1 = j; }
        else if (e > v2) { v2 = e; i2 = j; }
      }
      const float e2 = expf(v2 - v1);
      const float w1 = gw / (1.f + e2), w2 = gw * e2 / (1.f + e2);
      const int ex1 = gi * 8 + i1, ex2 = gi * 8 + i2;
      int* cnt = p.cnt() + layer * 32;
      const int p1 = atomicAdd(&cnt[ex1], 1);
      p.list_tok()[ex1 * CAPE + p1] = r * 2; p.list_w()[ex1 * CAPE + p1] = w1;
      const int p2 = atomicAdd(&cnt[ex2], 1);
      p.list_tok()[ex2 * CAPE + p2] = r * 2 + 1; p.list_w()[ex2 * CAPE + p2] = w2;
    }
  }
}

struct AGather { const bfraw* H; const int* toks; int nvalid;
  __device__ __forceinline__ const bfraw* row(int r) const { return r < nvalid ? H + (size_t)(toks[r] >> 1) * LDH : nullptr; }
  __device__ __forceinline__ const bfraw* safe() const { return H; } };
struct BGateUp { static constexpr bool kT = false; const float *g, *u; int ldb; int nb;
  __device__ __forceinline__ const float* col(int v) const { int wc = v >> 6, j = (v >> 5) & 1, c = v & 31;
    const float* b = g + (ptrdiff_t)j * (u - g); return b + nb + wc * 32 + c; }
  __device__ __forceinline__ const float* safe() const { return g; } };

__device__ __forceinline__ void moe_prefix(const P& p, int layer, int* spre) {
  __syncthreads();
  if (otid() == 0) {
    int acc = 0;
    for (int e = 0; e < 32; ++e) { spre[e] = acc; acc += (p.cnt()[layer * 32 + e] + 127) >> 7; }
    spre[32] = acc;
  }
  __syncthreads();
}
template <int MI>
__device__ __forceinline__ void moe_up_tile(const P& p, int layer, int e, int row0, int cnt, int arow0, int nt, char* smem) {
  AGather af{p.H(), p.list_tok() + e * CAPE + row0, cnt - row0};
  const size_t wo = ((size_t)layer * 32 + e) * 2048 * 512;
  BGateUp bf{p.w_gate + wo, p.w_up + wo, 512, nt * 64};
  bfraw* act = p.ACT() + (size_t)arow0 * LDACT + nt * 64;
  auto ef = [&](const f32x16 (&acc)[MI][2], int wr, int wc, int lane) {
#pragma unroll
    for (int i = 0; i < MI; ++i)
#pragma unroll
      for (int r = 0; r < 16; ++r) {
        int row = ACC_ROWM(MI, wr, i, r, lane);
        float gv = acc[i][0][r], uv = acc[i][1][r];
        act[(size_t)row * LDACT + wc * 32 + (lane & 31)] = to_bf16(siluf_(gv) * uv);
      }
  };
  gemm_tile<MI>(af, bf, ef, 2048, smem);
}
#define MOE_FIND(spre, t) __builtin_amdgcn_readfirstlane(__popcll(__ballot((otid() & 63) < 31 && (spre)[(otid() & 63) + 1] <= (t))))
__device__ __forceinline__ void ph_moe_up(const P& p, int layer, int bid, char* smem) {
  int* spre = (int*)(smem + 65536);
  moe_prefix(p, layer, spre);
  const int n = spre[32] * 8, G = (int)gridDim.x, nfull = n / G, R = n - nfull * G;
  for (int k = 0; k < nfull; ++k) {
    const int w = k * G + bid, rbg = w >> 3, nt = w & 7;
    const int e = MOE_FIND(spre, rbg);
    const int rb = rbg - spre[e];
    moe_up_tile<2>(p, layer, e, rb * 128, p.cnt()[layer * 32 + e], rbg * 128, nt, smem);
  }
  if (R * 2 <= G) {
    FOR_ITEMS(w2, R * 2, bid) {
      const int w = nfull * G + (w2 >> 1), rbg = w >> 3, nt = w & 7, h = w2 & 1;
      const int e = MOE_FIND(spre, rbg);
      const int rb = rbg - spre[e];
      moe_up_tile<1>(p, layer, e, rb * 128 + h * 64, p.cnt()[layer * 32 + e], rbg * 128 + h * 64, nt, smem);
    }
  } else {
    const int w = sched_item(nfull, n, bid);
    if (w >= 0) {
      const int rbg = w >> 3, nt = w & 7;
      const int e = MOE_FIND(spre, rbg);
      const int rb = rbg - spre[e];
      moe_up_tile<2>(p, layer, e, rb * 128, p.cnt()[layer * 32 + e], rbg * 128, nt, smem);
    }
  }
}
__device__ __forceinline__ void ph_moe_down(const P& p, int layer, int bid, char* smem) {
  int* spre = (int*)(smem + 65536);
  moe_prefix(p, layer, spre);
  const int ntile = spre[32];
  FOR_ITEMS(w, ntile * 16, bid) {
    const int rbg = w >> 4, nt = w & 15;
    const int e = MOE_FIND(spre, rbg);
    const int rb = rbg - spre[e];
    const int nvalid = p.cnt()[layer * 32 + e] - rb * 128;
    ARows af{p.ACT() + (size_t)rbg * 128 * LDACT, LDACT, 0, 128};
    BPlain bf{p.w_down + ((size_t)layer * 32 + e) * 512 * 2048, 2048, nt * 128, 2048};
    const int* toks = p.list_tok() + e * CAPE + rb * 128;
    const float* lw = p.list_w() + e * CAPE + rb * 128;
    bfraw* Ys = p.Yslot();
    auto ef = [&](const f32x16 (&acc)[2][2], int wr, int wc, int lane) {
#pragma unroll
      for (int i = 0; i < 2; ++i)
#pragma unroll
        for (int r = 0; r < 16; ++r) {
          int row = ACC_ROW(wr, i, r, lane);
          if (row < nvalid) {
            int ts = toks[row]; float wgt = lw[row];
#pragma unroll
            for (int j = 0; j < 2; ++j) Ys[(size_t)ts * 2048 + nt * 128 + ACC_COL(wc, j, lane)] = to_bf16(wgt * acc[i][j][r]);
          }
        }
    };
    gemm_tile<2>(af, bf, ef, 512, smem);
  }
}

__device__ __forceinline__ void ph_out(const P& p, int bid, char* smem) {
  const int tid = otid(), lane = tid & 63, wid = tid >> 6;
  for (int r = bid * 4 + wid; r < TLAT; r += gridDim.x * 4) {
    const int mi = r >> 12;
    const float* g2 = p.modv() + (1 * 3 + mi) * 12288 + 5 * 2048;
    f32x4v v[8];
    float ss = 0.f;
#pragma unroll
    for (int q = 0; q < 8; ++q) {
      const int col = q * 256 + lane * 4;
      f32x4v xv = *(const f32x4v*)(p.X() + (size_t)r * 2048 + col);
      const f32x4v gv = *(const f32x4v*)(g2 + col);
      const f32x4v y0 = ld_bf16x4(p.Yslot() + (size_t)(2 * r) * 2048 + col);
      const f32x4v y1 = ld_bf16x4(p.Yslot() + (size_t)(2 * r + 1) * 2048 + col);
      xv += gv * (y0 + y1);
      v[q] = xv;
      ss += xv[0] * xv[0] + xv[1] * xv[1] + xv[2] * xv[2] + xv[3] * xv[3];
    }
    ss = wave_sum(ss);
    const float rs = rsqrtf(ss * (1.f / 2048.f) + EPSV);
#pragma unroll
    for (int q = 0; q < 8; ++q) {
      const int col = q * 256 + lane * 4;
      const f32x4v w4 = *(const f32x4v*)(p.final_w + col);
      *(f32x4v*)(p.out + (size_t)r * 2048 + col) = v[q] * rs * w4;
    }
  }
}

#define SMEM_BYTES 81792
#define XB_TMO      128
#define XB_XCNT(j)  (256  + 64 * (j))
#define XB_XSUB(j)  (1280 + 64 * (j))
#define XB_XGEN(j)  (2304 + 64 * (j))
#define XB_TOP      3328
#define XB_TOPGEN   3392
#define XB_SPIN_CAP (1u << 22)
#define LAS __attribute__((address_space(3)))
__device__ __forceinline__ unsigned xb_ld(unsigned* p)              { return __hip_atomic_load(p, __ATOMIC_RELAXED, __HIP_MEMORY_SCOPE_AGENT); }
__device__ __forceinline__ unsigned xb_add(unsigned* p, unsigned v) { return __hip_atomic_fetch_add(p, v, __ATOMIC_RELAXED, __HIP_MEMORY_SCOPE_AGENT); }
__device__ __forceinline__ unsigned xb_xcc_id() { return (unsigned)__builtin_amdgcn_s_getreg((3 << 11) | 20) & 0xFu; }
#define XB_SPIN(cond, bar) do { unsigned _sp = 0; while (cond) { __builtin_amdgcn_s_sleep(1); \
    if ((++_sp & 255u) == 0u) { if (xb_ld(&(bar)[XB_TMO])) break; if (_sp > XB_SPIN_CAP) { atomicAdd(&(bar)[XB_TMO], 1u); break; } } } } while (0)
struct XcdBarrier { unsigned* bar; unsigned x; unsigned rank; volatile LAS unsigned* st; };
__device__ __forceinline__ XcdBarrier xcd_barrier_post(unsigned* bar, volatile LAS unsigned* st) {
    XcdBarrier b; b.bar = bar; b.x = xb_xcc_id(); b.st = st;
    b.rank = 0u;
    if (threadIdx.x == 0) b.rank = xb_add(&bar[XB_XCNT(b.x)], 1u);
    return b;
}
__device__ __forceinline__ void xcd_barrier_complete(unsigned* bar, unsigned x, unsigned& nloc, unsigned& nx) {
    const unsigned G = gridDim.x * gridDim.y * gridDim.z;
    unsigned sum, cnt, mine, sp = 0u;
    for (;;) {
        sum = 0u; cnt = 0u; mine = 0u;
#pragma unroll
        for (unsigned j = 0; j < 16; ++j) { const unsigned c = xb_ld(&bar[XB_XCNT(j)]); sum += c; cnt += (c > 0u) ? 1u : 0u; mine = (j == x) ? c : mine; }
        if (sum == G) break;
        __builtin_amdgcn_s_sleep(1);
        if ((++sp & 255u) == 0u) { if (xb_ld(&bar[XB_TMO])) break; if (sp > XB_SPIN_CAP) { atomicAdd(&bar[XB_TMO], 1u); break; } }
    }
    nloc = mine > 0u ? mine : 1u; nx = cnt > 0u ? cnt : 1u;
}
__device__ __forceinline__ void xcd_barrier(const XcdBarrier& b) {
    asm volatile("s_waitcnt vmcnt(0)" ::: "memory");
    __syncthreads();
    if (threadIdx.x == 0) {
        unsigned* bar = b.bar;
        __builtin_amdgcn_s_waitcnt(0);
        unsigned nloc = b.st[0], nx = b.st[1];
        if (nloc == 0u) { xcd_barrier_complete(bar, b.x, nloc, nx); b.st[0] = nloc; b.st[1] = nx; }
        const unsigned old = xb_add(&bar[XB_XSUB(b.x)], 1u);
        const unsigned gen = old / nloc;
        if (old + 1u == (gen + 1u) * nloc) {
            __builtin_amdgcn_fence(__ATOMIC_RELEASE, "agent");
            asm volatile("s_waitcnt vmcnt(0)" ::: "memory");
            const unsigned og = xb_add(&bar[XB_TOP], 1u);
            const unsigned tg = og / nx;
            if (og + 1u == (tg + 1u) * nx) xb_add(&bar[XB_TOPGEN], 1u);
            else XB_SPIN(xb_ld(&bar[XB_TOPGEN]) == tg, bar);
            __builtin_amdgcn_fence(__ATOMIC_ACQUIRE, "agent");
            xb_add(&bar[XB_XGEN(b.x)], 1u);
            asm volatile("s_waitcnt vmcnt(0)" ::: "memory");
        } else {
            XB_SPIN(xb_ld(&bar[XB_XGEN(b.x)]) == gen, bar);
            __builtin_amdgcn_fence(__ATOMIC_ACQUIRE, "agent");
            asm volatile("s_waitcnt vmcnt(0)" ::: "memory");
        }
    }
    __syncthreads();
}

__global__ void __launch_bounds__(256, 2) k_fused(P p, unsigned* bar) {
  extern __shared__ __attribute__((aligned(16))) char smem_all[];
  char* smem = smem_all + 64;
  if (threadIdx.x == 0) *(uint4*)smem_all = make_uint4(0u, 0u, 0u, 0u);
  __syncthreads();
  XcdBarrier b = xcd_barrier_post(bar, (volatile LAS unsigned*)smem_all);
#define LAYER_PROGRAM(L)                                                              \
  {                                                                                   \
    ph_norm1(p, L, bid, smem); xcd_barrier(b);          \
    ph_win(p, L, bid, smem); xcd_barrier(b);                          \
    ph_prep(p, L, bid, smem); xcd_barrier(b);           \
    ph_qkv(p, L, bid, smem); ph_mixA(p, L, bid, smem); xcd_barrier(b);     \
    ph_attn(p, L, bid, smem); ph_scan(p, L, bid, smem); xcd_barrier(b);    \
    ph_mixC(p, L, bid, smem); xcd_barrier(b);             \
    ph_glu(p, L, bid, smem); xcd_barrier(b);                                \
    ph_final_mix(p, L, bid, smem); xcd_barrier(b);      \
    ph_wout(p, L, bid, smem); xcd_barrier(b);                \
    ph_router(p, L, bid, smem); xcd_barrier(b);         \
    ph_moe_up(p, L, bid, smem); xcd_barrier(b);                    \
    ph_moe_down(p, L, bid, smem); xcd_barrier(b);       \
  }
  ph_mod(p, smem); ph_wprep(p, blockIdx.x, smem); xcd_barrier(b);
  if (threadIdx.x == 0) {
    unsigned pre = 0u;
    for (unsigned j = 0; j < 16; ++j) { const unsigned c = xb_ld(&bar[XB_XCNT(j)]); if (j < b.x) pre += c; }
    ((volatile LAS unsigned*)smem_all)[2] = pre + b.rank;
  }
  __syncthreads();
  const int bid = __builtin_amdgcn_readfirstlane((int)((volatile LAS unsigned*)smem_all)[2]);
  LAYER_PROGRAM(0)
  LAYER_PROGRAM(1)
  ph_out(p, bid, smem);
}

extern "C" void kernel_launch(void* const* d_in, const int* in_sizes, int n_in, void* d_out, int out_size, void* d_ws,
                              size_t ws_size, hipStream_t stream) {
  P p{};
  const float* const* in = (const float* const*)d_in;
  p.x = in[0]; p.c = in[1]; p.ctx = in[2]; p.c_ctx = in[3]; p.mod_w = in[4]; p.mod_b = in[5]; p.norm1_w = in[6];
  p.w_in = in[7]; p.q_norm_w = in[8]; p.kv_norm_w = in[9]; p.w_uq = in[10]; p.w_ukv = in[11]; p.conv_w = in[12];
  p.conv_b = in[13]; p.a_log = in[14]; p.dt_bias = in[15]; p.ssd_d = in[16]; p.gate_b = in[17]; p.lam_re = in[18];
  p.lam_im = in[19]; p.log_dt = in[20]; p.b_re = in[21]; p.b_im = in[22]; p.c_re = in[23]; p.c_im = in[24];
  p.s5_d = in[25]; p.glu_w = in[26]; p.glu_b = in[27]; p.out_norm_w = in[28]; p.w_out = in[29]; p.norm2_w = in[30];
  p.w_group = in[31]; p.w_expert = in[32]; p.w_gate = in[33]; p.w_up = in[34]; p.w_down = in[35]; p.final_w = in[36];
  p.out = (float*)d_out;
  p.ws = (float*)d_ws;
  (void)ws_size; (void)in_sizes; (void)n_in; (void)out_size;

  unsigned* bar = (unsigned*)((float*)d_ws + WO_bar);
  static int grid = 0;
  if (!grid) {
    int dev = 0, cus = 0, per_cu = 0;
    hipGetDevice(&dev);
    hipDeviceGetAttribute(&cus, hipDeviceAttributeMultiprocessorCount, dev);
    (void)hipFuncSetAttribute((const void*)k_fused, hipFuncAttributeMaxDynamicSharedMemorySize, SMEM_BYTES + 64);
    (void)hipOccupancyMaxActiveBlocksPerMultiprocessor(&per_cu, k_fused, 256, SMEM_BYTES + 64);
    if (per_cu < 1) per_cu = 1;
    grid = cus * (per_cu < 2 ? per_cu : 2);
  }
  hipMemsetAsync(bar, 0, XCD_BAR_WORDS * sizeof(unsigned), stream);
  hipLaunchKernelGGL(k_fused, dim3(grid), dim3(256), SMEM_BYTES + 64, stream, p, bar);
}
```

```cpp
#include <hip/hip_runtime.h>
#include <stdint.h>

#define DM 2048
#define SL 4096
#define CL 256
#define TLAT 8192
#define TCTX 512
#define TTOT 8704
#define NIN 4192
#define NKEY 4352
#define ZC_CQ 0
#define ZC_CKV 384
#define ZC_KR 512
#define ZC_BZ 576
#define ZC_XBC 1088
#define ZC_DT 2112
#define ZC_MQ 2128
#define ZC_MK 2384
#define ZC_MV 2640
#define ZC_MO 3152
#define ZC_MG 3664
#define ZC_U 3680
#define CAPE 8704
#define EPSV 1e-6f
#define ACT_ROWS 21632

typedef float f32x16 __attribute__((ext_vector_type(16)));
typedef short bf16x8 __attribute__((ext_vector_type(8)));
typedef float f32x4v __attribute__((ext_vector_type(4)));
typedef unsigned u32x4g __attribute__((ext_vector_type(4)));
typedef unsigned short bfraw;
__device__ __forceinline__ unsigned pack_bf16(float lo, float hi) {
  typedef __bf16 bf2 __attribute__((ext_vector_type(2)));
  bf2 v; v[0] = (__bf16)lo; v[1] = (__bf16)hi;
  return __builtin_bit_cast(unsigned, v);
}
__device__ __forceinline__ bfraw to_bf16(float x) { __bf16 b = (__bf16)x; return __builtin_bit_cast(unsigned short, b); }
__device__ __forceinline__ f32x4v ld_bf16x4(const bfraw* q) {
  const uint2 t = *(const uint2*)q;
  f32x4v r; r[0] = __uint_as_float(t.x << 16); r[1] = __uint_as_float(t.x & 0xffff0000u); r[2] = __uint_as_float(t.y << 16); r[3] = __uint_as_float(t.y & 0xffff0000u);
  return r;
}
__device__ __forceinline__ float from_bf16(bfraw x) { return __uint_as_float((unsigned)x << 16); }

#define NSTEP 68
#define LDH 2112
#define LDACT 576
#define XCD_BAR_WORDS 3456
#define WS_RND(n) (((size_t)(n) + 63) & ~(size_t)63)
constexpr size_t WO_cnt = 0;
constexpr size_t WO_modv = WO_cnt + WS_RND(64);
constexpr size_t WO_H = WO_modv + WS_RND(2 * 3 * 12288);
constexpr size_t WO_X = WO_H + WS_RND((size_t)TTOT * (LDH / 2));
constexpr size_t WO_Z = WO_X + WS_RND((size_t)TTOT * 2048);
constexpr size_t WO_Aq = WO_Z + WS_RND((size_t)TTOT * NIN);
constexpr size_t WO_Akv = WO_Aq + WS_RND((size_t)TTOT * 192);
constexpr size_t WO_qraw = WO_Akv + WS_RND((size_t)TTOT * 64);
constexpr size_t WO_kvraw = WO_qraw + WS_RND((size_t)TTOT * 768);
constexpr size_t WO_Q = WO_kvraw + WS_RND((size_t)TTOT * 1024);
constexpr size_t WO_Qc = WO_Q + WS_RND((size_t)8 * SL * 96);
constexpr size_t WO_K = WO_Qc + WS_RND((size_t)8 * CL * 96);
constexpr size_t WO_V = WO_K + WS_RND((size_t)8 * NKEY * 96);
constexpr size_t WO_O = WO_V + WS_RND((size_t)8 * NKEY * 64);
constexpr size_t WO_ssd_xs = WO_O + WS_RND((size_t)TTOT * 512);
constexpr size_t WO_ssd_B = WO_ssd_xs + WS_RND((size_t)TTOT * 512);
constexpr size_t WO_ssd_C = WO_ssd_B + WS_RND((size_t)TTOT * 256);
constexpr size_t WO_ssd_dt = WO_ssd_C + WS_RND((size_t)TTOT * 256);
constexpr size_t WO_ssd_y = WO_ssd_dt + WS_RND((size_t)TTOT * 16);
constexpr size_t WO_ssd_st = WO_ssd_y + WS_RND((size_t)TTOT * 512);
constexpr size_t WO_ssd_atot = WO_ssd_st + WS_RND((size_t)32 * NSTEP * 8192);
constexpr size_t WO_ml_h = WO_ssd_atot + WS_RND(32 * NSTEP);
constexpr size_t WO_ml_st = WO_ml_h + WS_RND((size_t)TTOT * 512);
constexpr size_t WO_ml_nst = WO_ml_st + WS_RND((size_t)16 * NSTEP * 8192);
constexpr size_t WO_ml_gtot = WO_ml_nst + WS_RND((size_t)16 * NSTEP * 64);
constexpr size_t WO_s5_st = WO_ml_gtot + WS_RND(16 * NSTEP);
constexpr size_t WO_s5_a = WO_s5_st + WS_RND((size_t)128 * NSTEP * 128);
constexpr size_t WO_s5_bb = WO_s5_a + WS_RND(2 * 2 * 32 * 64 * 2);
constexpr size_t WO_s5_rf = WO_s5_bb + WS_RND((size_t)2 * 2 * 32 * 64 * 32);
constexpr size_t WO_s5_rb = WO_s5_rf + WS_RND((size_t)TTOT * 512);
constexpr size_t WO_ydpre = WO_s5_rb + WS_RND((size_t)TTOT * 512);
constexpr size_t WO_ydg = WO_ydpre + WS_RND((size_t)TTOT * 512);
constexpr size_t WO_Y = WO_ydg + WS_RND((size_t)TTOT * 512);
constexpr size_t WO_ydpre_bf = WO_Y + WS_RND((size_t)TTOT * (LDH / 2));
constexpr size_t WO_list_tok = WO_ydpre_bf + WS_RND((size_t)TTOT * 256);
constexpr size_t WO_list_w = WO_list_tok + WS_RND((size_t)32 * CAPE);
constexpr size_t WO_ACT = WO_list_w + WS_RND((size_t)32 * CAPE);
constexpr size_t WO_Yslot = WO_ACT + WS_RND((size_t)ACT_ROWS * (LDACT / 2));
constexpr size_t WO_rope_cs = WO_Yslot + WS_RND((size_t)TTOT * 2 * 2048);
constexpr size_t WO_s5_bbh = WO_rope_cs + WS_RND(64 * 16 * 2);
constexpr size_t WO_s5_cmh = WO_s5_bbh + WS_RND(128 * 128 * 16 / 2);
constexpr size_t WO_bar_old = WO_Yslot + WS_RND((size_t)TTOT * 2 * 2048);
constexpr size_t WO_winT = WO_s5_cmh + WS_RND(64 * 32 * 128 / 2);
constexpr size_t WO_woutT = WO_winT + WS_RND((size_t)2 * 4224 * 1024);
constexpr size_t WO_wuqT = WO_woutT + WS_RND((size_t)2 * 2048 * 1024);
constexpr size_t WO_wukvT = WO_wuqT + WS_RND((size_t)2 * 768 * 192);
constexpr size_t WO_wgluT = WO_wukvT + WS_RND((size_t)2 * 1024 * 64);
constexpr size_t WO_O2 = WO_wgluT + WS_RND((size_t)2 * 512 * 256);
constexpr size_t WO_attn_ml = WO_O2 + WS_RND((size_t)TTOT * 512);
constexpr size_t WO_bar = WO_attn_ml + WS_RND((size_t)2 * TTOT * 8);
constexpr size_t WS_TOTAL_FLOATS = WO_bar + 4096;

struct P {
  const float *x, *c, *ctx, *c_ctx, *mod_w, *mod_b, *norm1_w, *w_in, *q_norm_w, *kv_norm_w, *w_uq, *w_ukv;
  const float *conv_w, *conv_b, *a_log, *dt_bias, *ssd_d, *gate_b, *lam_re, *lam_im, *log_dt, *b_re, *b_im;
  const float *c_re, *c_im, *s5_d, *glu_w, *glu_b, *out_norm_w, *w_out, *norm2_w, *w_group, *w_expert;
  const float *w_gate, *w_up, *w_down, *final_w;
  float* out;
  float* ws;
  __device__ __forceinline__ int* cnt() const { return (int*)(ws + WO_cnt); }
  __device__ __forceinline__ float* modv() const { return (float*)(ws + WO_modv); }
  __device__ __forceinline__ bfraw* H() const { return (bfraw*)(ws + WO_H); }
  __device__ __forceinline__ float* X() const { return (float*)(ws + WO_X); }
  __device__ __forceinline__ float* Z() const { return (float*)(ws + WO_Z); }
  __device__ __forceinline__ bfraw* Aq() const { return (bfraw*)(ws + WO_Aq); }
  __device__ __forceinline__ bfraw* Akv() const { return (bfraw*)(ws + WO_Akv); }
  __device__ __forceinline__ float* qraw() const { return (float*)(ws + WO_qraw); }
  __device__ __forceinline__ float* kvraw() const { return (float*)(ws + WO_kvraw); }
  __device__ __forceinline__ bfraw* Q() const { return (bfraw*)(ws + WO_Q); }
  __device__ __forceinline__ bfraw* Qc() const { return (bfraw*)(ws + WO_Qc); }
  __device__ __forceinline__ bfraw* K() const { return (bfraw*)(ws + WO_K); }
  __device__ __forceinline__ bfraw* V() const { return (bfraw*)(ws + WO_V); }
  __device__ __forceinline__ float* O() const { return (float*)(ws + WO_O); }
  __device__ __forceinline__ float* ssd_xs() const { return (float*)(ws + WO_ssd_xs); }
  __device__ __forceinline__ float* ssd_B() const { return (float*)(ws + WO_ssd_B); }
  __device__ __forceinline__ float* ssd_C() const { return (float*)(ws + WO_ssd_C); }
  __device__ __forceinline__ float* ssd_dt() const { return (float*)(ws + WO_ssd_dt); }
  __device__ __forceinline__ float* ssd_y() const { return (float*)(ws + WO_ssd_y); }
  __device__ __forceinline__ bfraw* ssd_st() const { return (bfraw*)(ws + WO_ssd_st); }
  __device__ __forceinline__ float* ssd_atot() const { return (float*)(ws + WO_ssd_atot); }
  __device__ __forceinline__ float* ml_h() const { return (float*)(ws + WO_ml_h); }
  __device__ __forceinline__ bfraw* ml_st() const { return (bfraw*)(ws + WO_ml_st); }
  __device__ __forceinline__ float* ml_nst() const { return (float*)(ws + WO_ml_nst); }
  __device__ __forceinline__ float* ml_gtot() const { return (float*)(ws + WO_ml_gtot); }
  __device__ __forceinline__ float* s5_st() const { return (float*)(ws + WO_s5_st); }
  __device__ __forceinline__ float* s5_a() const { return (float*)(ws + WO_s5_a); }
  __device__ __forceinline__ float* s5_bb() const { return (float*)(ws + WO_s5_bb); }
  __device__ __forceinline__ float* s5_rf() const { return (float*)(ws + WO_s5_rf); }
  __device__ __forceinline__ float* s5_rb() const { return (float*)(ws + WO_s5_rb); }
  __device__ __forceinline__ float* ydpre() const { return (float*)(ws + WO_ydpre); }
  __device__ __forceinline__ float* ydg() const { return (float*)(ws + WO_ydg); }
  __device__ __forceinline__ bfraw* Y() const { return (bfraw*)(ws + WO_Y); }
  __device__ __forceinline__ bfraw* ydpre_bf() const { return (bfraw*)(ws + WO_ydpre_bf); }
  __device__ __forceinline__ int* list_tok() const { return (int*)(ws + WO_list_tok); }
  __device__ __forceinline__ float* list_w() const { return (float*)(ws + WO_list_w); }
  __device__ __forceinline__ bfraw* ACT() const { return (bfraw*)(ws + WO_ACT); }
  __device__ __forceinline__ bfraw* Yslot() const { return (bfraw*)(ws + WO_Yslot); }
  __device__ __forceinline__ float* rope_cs() const { return (float*)(ws + WO_rope_cs); }
  __device__ __forceinline__ bfraw* s5_bbh() const { return (bfraw*)(ws + WO_s5_bbh); }
  __device__ __forceinline__ bfraw* s5_cmh() const { return (bfraw*)(ws + WO_s5_cmh); }
  __device__ __forceinline__ bfraw* winT() const { return (bfraw*)(ws + WO_winT); }
  __device__ __forceinline__ bfraw* woutT() const { return (bfraw*)(ws + WO_woutT); }
  __device__ __forceinline__ bfraw* wuqT() const { return (bfraw*)(ws + WO_wuqT); }
  __device__ __forceinline__ bfraw* wukvT() const { return (bfraw*)(ws + WO_wukvT); }
  __device__ __forceinline__ bfraw* wgluT() const { return (bfraw*)(ws + WO_wgluT); }
  __device__ __forceinline__ float* O2() const { return (float*)(ws + WO_O2); }
  __device__ __forceinline__ float* attn_ml() const { return (float*)(ws + WO_attn_ml); }
};

__device__ __forceinline__ int otid() { int t = threadIdx.x; asm volatile("" : "+v"(t)); return t; }
__device__ __forceinline__ int row_modidx(int r) { return r < TLAT ? (r >> 12) : 2; }
typedef unsigned u32x4wt __attribute__((ext_vector_type(4)));
__device__ __forceinline__ void store16_wt(void* ptr, u32x4wt v) {
  asm volatile("global_store_dwordx4 %0, %1, off sc1\n\ts_nop 1" :: "v"(ptr), "v"(v) : "memory");
}
#define FOR_ROWS_TTOT(r, bid, wid)                                                                      \
  for (int rpb_ = (TTOT % (int)gridDim.x) == 0 ? TTOT / (int)gridDim.x : 0,                              \
           i_ = (wid), r = rpb_ ? (bid) * rpb_ + i_ : (bid) * 4 + (wid);                                 \
       rpb_ ? i_ < rpb_ : r < TTOT;                                                                       \
       i_ += 4, r = rpb_ ? (bid) * rpb_ + i_ : r + (int)gridDim.x * 4)
__device__ __forceinline__ float sigmoidf_(float v) { return 1.f / (1.f + expf(-v)); }
__device__ __forceinline__ float siluf_(float v) { return v / (1.f + expf(-v)); }
typedef unsigned u32x2v __attribute__((ext_vector_type(2)));
__device__ __forceinline__ float xor32(float x) {
  const u32x2v t = __builtin_amdgcn_permlane32_swap(__float_as_uint(x), __float_as_uint(x), false, false);
  return __uint_as_float((threadIdx.x & 32) ? t[0] : t[1]);
}
__device__ __forceinline__ float xor16(float x) {
  const u32x2v t = __builtin_amdgcn_permlane16_swap(__float_as_uint(x), __float_as_uint(x), false, false);
  return __uint_as_float((threadIdx.x & 16) ? t[0] : t[1]);
}
#define DPPF(x, ctrl, rmask) __int_as_float(__builtin_amdgcn_update_dpp(0, __float_as_int(x), (ctrl), (rmask), 0xF, false))
__device__ __forceinline__ float row16_sum(float v) {
  v += DPPF(v, 0xB1, 0xF); v += DPPF(v, 0x4E, 0xF); v += DPPF(v, 0x141, 0xF); v += DPPF(v, 0x140, 0xF);
  return v;
}
__device__ __forceinline__ float wave_sum(float v) {
  v = row16_sum(v); v += xor16(v); v += xor32(v);
  return v;
}
__device__ __forceinline__ float lane63(float v) { return __int_as_float(__builtin_amdgcn_readlane(__float_as_int(v), 63)); }
__device__ __forceinline__ float block_sum(float v, float* red) {
  v = wave_sum(v);
  __syncthreads();
  if ((otid() & 63) == 0) red[otid() >> 6] = v;
  __syncthreads();
  return red[0] + red[1] + red[2] + red[3];
}

__device__ __forceinline__ void ph_mod(const P& p, char* smem) {
  float* sc = (float*)smem;
  float* red = sc + 3 * 2048;
  const int tid = otid();
  if (blockIdx.x == 0 && tid < 64) p.cnt()[tid] = 0;
  if (blockIdx.x == 1) {
    for (int i = tid; i < 64 * 16; i += 256) {
      const int idx = i >> 4, f = i & 15;
      const float ang = (float)idx * powf(10000.f, -(float)f * (1.f / 16.f));
      p.rope_cs()[i * 2] = cosf(ang); p.rope_cs()[i * 2 + 1] = sinf(ang);
    }
  }
  for (int i = blockIdx.x * 256 + tid; i < 64 * 32 * 128; i += gridDim.x * 256) {
    const int pp = i & 127, c = (i >> 7) & 31, lg = i >> 12;
    float v = 0.f;
    if (c < 16) v = pp < 64 ? p.c_re[((size_t)lg * 16 + c) * 64 + pp] : -p.c_im[((size_t)lg * 16 + c) * 64 + pp - 64];
    p.s5_cmh()[i] = to_bf16(v);
  }
  for (int i = blockIdx.x * 256 + tid; i < 2 * 2 * 32 * 64; i += gridDim.x * 256) {
    const int sp = i & 63, g = (i >> 6) & 31, l = i >> 12;
    const float lr = p.lam_re[i], li = p.lam_im[i];
    const float dt = expf(p.log_dt[i >> 6]);
    const float mag = expf(lr * dt);
    const float ar = mag * cosf(li * dt), ai = mag * sinf(li * dt);
    const float den = lr * lr + li * li;
    const float cr_ = ((ar - 1.f) * lr + ai * li) / den;
    const float ci_ = (ai * lr - (ar - 1.f) * li) / den;
    p.s5_a()[i * 2] = ar; p.s5_a()[i * 2 + 1] = ai;
    for (int c = 0; c < 16; ++c) {
      float br = p.b_re[((size_t)(l * 32 + g) * 64 + sp) * 16 + c];
      float bim = p.b_im[((size_t)(l * 32 + g) * 64 + sp) * 16 + c];
      p.s5_bb()[(size_t)i * 32 + c] = cr_ * br - ci_ * bim;
      p.s5_bb()[(size_t)i * 32 + 16 + c] = cr_ * bim + ci_ * br;
      p.s5_bbh()[((size_t)(i >> 6) * 128 + sp) * 16 + c] = to_bf16(cr_ * br - ci_ * bim);
      p.s5_bbh()[((size_t)(i >> 6) * 128 + 64 + sp) * 16 + c] = to_bf16(cr_ * bim + ci_ * br);
    }
  }
  for (int i = tid; i < 3 * 2048; i += 256) {
    int r = i >> 11, k = i & 2047;
    float v = r < 2 ? p.c[r * 2048 + k] : p.c_ctx[k];
    sc[i] = siluf_(v);
  }
  __syncthreads();
  for (int w = blockIdx.x; w < 2 * 96; w += gridDim.x) {
    int l = w / 96, j0 = (w % 96) * 128;
    int cg = tid & 31, ks = tid >> 5;
    const float* W = p.mod_w + (size_t)l * 2048 * 12288 + j0 + cg * 4;
    float acc[3][4];
#pragma unroll
    for (int r = 0; r < 3; ++r)
#pragma unroll
      for (int c = 0; c < 4; ++c) acc[r][c] = 0.f;
#pragma unroll 16
    for (int k = ks * 256; k < ks * 256 + 256; ++k) {
      float4 wv = *(const float4*)(W + (size_t)k * 12288);
      float s0 = sc[k], s1 = sc[2048 + k], s2 = sc[4096 + k];
      acc[0][0] += s0 * wv.x; acc[0][1] += s0 * wv.y; acc[0][2] += s0 * wv.z; acc[0][3] += s0 * wv.w;
      acc[1][0] += s1 * wv.x; acc[1][1] += s1 * wv.y; acc[1][2] += s1 * wv.z; acc[1][3] += s1 * wv.w;
      acc[2][0] += s2 * wv.x; acc[2][1] += s2 * wv.y; acc[2][2] += s2 * wv.z; acc[2][3] += s2 * wv.w;
    }
    __syncthreads();
#pragma unroll
    for (int r = 0; r < 3; ++r)
#pragma unroll
      for (int c = 0; c < 4; ++c) red[(ks * 32 + cg) * 12 + r * 4 + c] = acc[r][c];
    __syncthreads();
    for (int o = tid; o < 384; o += 256) {
      int r = o >> 7, c = o & 127;
      float s = 0.f;
#pragma unroll
      for (int q = 0; q < 8; ++q) s += red[(q * 32 + (c >> 2)) * 12 + r * 4 + (c & 3)];
      s += p.mod_b[l * 12288 + j0 + c];
      p.modv()[(l * 3 + r) * 12288 + j0 + c] = s;
    }
    __syncthreads();
  }
}

__device__ __forceinline__ void wprep_matrix(const float* src, bfraw* dst, int K, int N, int Npad, int& base, int bid, char* smem) {
  const int tid = otid();
  const int tk = K >> 6, tn = Npad >> 6, nt = tk * tn;
  int first = bid - (base % (int)gridDim.x); if (first < 0) first += gridDim.x;
  for (int t = first; t < nt; t += gridDim.x) {
    const int k0 = (t % tk) * 64, n0 = (t / tk) * 64;
    __syncthreads();
#pragma unroll
    for (int u = 0; u < 4; ++u) {
      const int i = tid + 256 * u, kr = i >> 4, c4 = i & 15;
      const int n = n0 + c4 * 4;
      float4 v = make_float4(0.f, 0.f, 0.f, 0.f);
      if (n < N) v = *(const float4*)(src + (size_t)(k0 + kr) * N + n);
      *(bfraw*)(smem + (c4 * 4 + 0) * 144 + kr * 2) = to_bf16(v.x);
      *(bfraw*)(smem + (c4 * 4 + 1) * 144 + kr * 2) = to_bf16(v.y);
      *(bfraw*)(smem + (c4 * 4 + 2) * 144 + kr * 2) = to_bf16(v.z);
      *(bfraw*)(smem + (c4 * 4 + 3) * 144 + kr * 2) = to_bf16(v.w);
    }
    __syncthreads();
#pragma unroll
    for (int u = 0; u < 2; ++u) {
      const int i = tid + 256 * u, nr = i >> 3, c = i & 7;
      store16_wt(dst + (size_t)(n0 + nr) * K + k0 + c * 8, *(const u32x4wt*)(smem + nr * 144 + c * 16));
    }
  }
  base += nt;
}
__device__ __forceinline__ void ph_wprep(const P& p, int bid, char* smem) {
  int base = 0;
  for (int l = 0; l < 2; ++l) {
    wprep_matrix(p.w_in + (size_t)l * 2048 * NIN, p.winT() + (size_t)l * 4224 * 2048, 2048, NIN, 4224, base, bid, smem);
    wprep_matrix(p.w_out + (size_t)l * 2048 * 2048, p.woutT() + (size_t)l * 2048 * 2048, 2048, 2048, 2048, base, bid, smem);
    wprep_matrix(p.w_uq + (size_t)l * 384 * 768, p.wuqT() + (size_t)l * 768 * 384, 384, 768, 768, base, bid, smem);
    wprep_matrix(p.w_ukv + (size_t)l * 128 * 1024, p.wukvT() + (size_t)l * 1024 * 128, 128, 1024, 1024, base, bid, smem);
    wprep_matrix(p.glu_w + (size_t)l * 512 * 512, p.wgluT() + (size_t)l * 512 * 512, 512, 512, 512, base, bid, smem);
  }
}

__device__ __forceinline__ void ph_norm1(const P& p, int layer, int bid, char* smem) {
  const int tid = otid(), lane = tid & 63, wid = tid >> 6;
  const float* nw = p.norm1_w + layer * 2048;
  FOR_ROWS_TTOT(r, bid, wid) {
    const int mi = row_modidx(r);
    const float* mrow = p.modv() + (layer * 3 + mi) * 12288;
    f32x4v v[8];
    float ss = 0.f;
#pragma unroll
    for (int q = 0; q < 8; ++q) {
      const int col = q * 256 + lane * 4;
      f32x4v xv;
      if (layer == 0) {
        const float* src = r < TLAT ? p.x + (size_t)r * 2048 : p.ctx + (size_t)(r - TLAT) * 2048;
        xv = *(const f32x4v*)(src + col);
      } else {
        xv = *(const f32x4v*)(p.X() + (size_t)r * 2048 + col);
        const float* g2 = p.modv() + ((layer - 1) * 3 + mi) * 12288 + 5 * 2048;
        const f32x4v gv = *(const f32x4v*)(g2 + col);
        const f32x4v y0 = ld_bf16x4(p.Yslot() + (size_t)(2 * r) * 2048 + col);
        const f32x4v y1 = ld_bf16x4(p.Yslot() + (size_t)(2 * r + 1) * 2048 + col);
        xv += gv * (y0 + y1);
        store16_wt(p.X() + (size_t)r * 2048 + col, __builtin_bit_cast(u32x4wt, xv));
      }
      v[q] = xv;
      ss += xv[0] * xv[0] + xv[1] * xv[1] + xv[2] * xv[2] + xv[3] * xv[3];
    }
    ss = wave_sum(ss);
    const float rs = rsqrtf(ss * (1.f / 2048.f) + EPSV);
#pragma unroll
    for (int q = 0; q < 8; ++q) {
      const int col = q * 256 + lane * 4;
      const f32x4v w4 = *(const f32x4v*)(nw + col);
      const f32x4v sh = *(const f32x4v*)(mrow + col);
      const f32x4v scv = *(const f32x4v*)(mrow + 2048 + col);
      const f32x4v o = v[q] * rs * w4 * (1.f + scv) + sh;
      uint2 ob; ob.x = pack_bf16(o[0], o[1]); ob.y = pack_bf16(o[2], o[3]);
      *(uint2*)(p.H() + (size_t)r * LDH + col) = ob;
    }
  }
}

template <int MI, int NST = 2, class AF, class BF, class EF>
__device__ __forceinline__ void gemm_tile(const AF& af, const BF& bf, const EF& ef, int K, char* smem) {
  constexpr int BM = MI * 64;
  constexpr int NA = MI * 2;
  constexpr int ABYTES = BM * 128, STAGE = ABYTES + 16384;
  int tid_ = threadIdx.x; asm volatile("" : "+v"(tid_));
  const int tid = tid_, lane = tid & 63, wid = tid >> 6, wr = wid >> 1, wc = wid & 1;
  const int l31 = lane & 31, lh = lane >> 5;
  f32x16 acc[MI][2];
#pragma unroll
  for (int i = 0; i < MI; ++i)
#pragma unroll
    for (int j = 0; j < 2; ++j)
#pragma unroll
      for (int r = 0; r < 16; ++r) acc[i][j][r] = 0.f;
  const int arl = tid >> 3, ac = tid & 7;
  const bfraw* arow[NA];
#pragma unroll
  for (int i = 0; i < NA; ++i) { const bfraw* q = af.row(arl + 32 * i); arow[i] = (q ? q : af.safe()) + ac * 8; }
  const int n4 = tid & 31, kg = tid >> 5;
  const float* bc = nullptr;
  size_t ldb = 0;
  const bfraw* brow[4] = {nullptr, nullptr, nullptr, nullptr};
  if constexpr (BF::kT) {
#pragma unroll
    for (int i = 0; i < 4; ++i) brow[i] = bf.nrow(arl + 32 * i) + ac * 8;
  } else {
    const float* q = bf.col(n4 * 4); bc = (q ? q : bf.safe()) + (size_t)(kg * 8) * bf.ldb;
    ldb = (size_t)bf.ldb;
  }
  typedef unsigned u32x4v __attribute__((ext_vector_type(4)));
  constexpr int NS = NST;
  u32x4v ra[NS][NA];
  f32x4v rb[NS][8];
  u32x4v rbt[NS][4];
#define GM_GL(set, k0)                                                               \
  {                                                                                  \
    _Pragma("unroll") for (int i = 0; i < NA; ++i) ra[set][i] = *(const u32x4v*)(arow[i] + (k0)); \
    if constexpr (BF::kT) {                                                          \
      _Pragma("unroll") for (int i = 0; i < 4; ++i) rbt[set][i] = *(const u32x4v*)(brow[i] + (k0)); \
    } else {                                                                         \
      const float* bq = bc + (size_t)(k0) * ldb;                                     \
      _Pragma("unroll") for (int j = 0; j < 8; ++j) rb[set][j] = *(const f32x4v*)(bq + (size_t)j * ldb); \
    }                                                                                \
  }
#define GM_SW(set, buf)                                                              \
  {                                                                                  \
    char* Ab = smem + (buf) * STAGE; char* Bb = Ab + ABYTES;                         \
    const int asw = (ac ^ ((arl >> 1) & 7)) << 4;                                    \
    _Pragma("unroll") for (int i = 0; i < NA; ++i) *(u32x4v*)(Ab + (arl + 32 * i) * 128 + asw) = ra[set][i]; \
    if constexpr (BF::kT) {                                                          \
      _Pragma("unroll") for (int i = 0; i < 4; ++i) *(u32x4v*)(Bb + (arl + 32 * i) * 128 + asw) = rbt[set][i]; \
    } else                                                                           \
    _Pragma("unroll") for (int i4 = 0; i4 < 4; ++i4) {                               \
      const int n = n4 * 4 + i4;                                                     \
      u32x4v v;                                                                      \
      v[0] = pack_bf16(rb[set][0][i4], rb[set][1][i4]); v[1] = pack_bf16(rb[set][2][i4], rb[set][3][i4]); \
      v[2] = pack_bf16(rb[set][4][i4], rb[set][5][i4]); v[3] = pack_bf16(rb[set][6][i4], rb[set][7][i4]); \
      *(u32x4v*)(Bb + n * 128 + ((kg ^ ((n >> 1) & 7)) << 4)) = v;                   \
    }                                                                                \
  }
#define GM_COMPUTE(buf, KK0, KK1)                                                    \
  {                                                                                  \
    const char* ap = smem + (buf) * STAGE + (wr * (BM / 2) + l31) * 128;             \
    const char* bp = smem + (buf) * STAGE + ABYTES + (wc * 64 + l31) * 128;          \
    _Pragma("unroll") for (int kk = KK0; kk < KK1; ++kk) {                           \
      const int co = ((2 * kk + lh) ^ fsw) << 4;                                     \
      const bf16x8 b0 = *(const bf16x8*)(bp + co), b1 = *(const bf16x8*)(bp + 32 * 128 + co); \
      _Pragma("unroll") for (int i = 0; i < MI; ++i) {                               \
        const bf16x8 a = *(const bf16x8*)(ap + i * 32 * 128 + co);                   \
        acc[i][0] = __builtin_amdgcn_mfma_f32_32x32x16_bf16(a, b0, acc[i][0], 0, 0, 0); \
        acc[i][1] = __builtin_amdgcn_mfma_f32_32x32x16_bf16(a, b1, acc[i][1], 0, 0, 0); \
      }                                                                              \
    }                                                                                \
  }
  const int fsw = (l31 >> 1) & 7;
  const int nsteps = K >> 6;
  __syncthreads();
  const int klast = (nsteps - 1) * 64;
  if constexpr (NST == 1) {
    GM_GL(0, 0)
    GM_SW(0, 0)
    __syncthreads();
    for (int s = 0; s < nsteps; ++s) {
      { const int kn = min((s + 1) * 64, klast); GM_GL(0, kn) }
      GM_COMPUTE(0, 0, 4)
      __syncthreads();
      GM_SW(0, 0)
      __syncthreads();
    }
  } else {
  GM_GL(0, 0)
  GM_SW(0, 0)
  GM_GL(1, 64)
  __syncthreads();
  for (int s = 0; s < nsteps; s += 2) {
    { const int kn = min((s + 2) * 64, klast); GM_GL(0, kn) }
    GM_COMPUTE(0, 0, 2)
    __builtin_amdgcn_sched_barrier(0);
    GM_SW(1, 1)
    __builtin_amdgcn_sched_barrier(0);
    GM_COMPUTE(0, 2, 4)
    __syncthreads();
    { const int kn = min((s + 3) * 64, klast); GM_GL(1, kn) }
    GM_COMPUTE(1, 0, 2)
    __builtin_amdgcn_sched_barrier(0);
    GM_SW(0, 0)
    __builtin_amdgcn_sched_barrier(0);
    GM_COMPUTE(1, 2, 4)
    __syncthreads();
  }
  }
  ef(acc, wr, wc, lane);
}
#define ACC_ROWM(MI, wr, i, r, lane) ((wr) * ((MI) * 32) + (i) * 32 + ((r) & 3) + 8 * ((r) >> 2) + 4 * ((lane) >> 5))
#define ACC_ROW(wr, i, r, lane) ACC_ROWM(2, wr, i, r, lane)
#define ACC_COL(wc, j, lane) ((wc) * 64 + (j) * 32 + ((lane) & 31))

struct ARows { const bfraw* base; int ld; int m0; int M;
  __device__ __forceinline__ const bfraw* row(int r) const { int g = m0 + r; return g < M ? base + (size_t)g * ld : nullptr; }
  __device__ __forceinline__ const bfraw* safe() const { return base; } };
struct BPlain { static constexpr bool kT = false; const float* B; int ldb; int n0; int N;
  __device__ __forceinline__ const float* col(int v) const { int n = n0 + v; return n < N ? B + n : nullptr; }
  __device__ __forceinline__ const float* safe() const { return B; } };

struct BTrans { static constexpr bool kT = true; const bfraw* Bt; int ldk; int n0;
  __device__ __forceinline__ const bfraw* nrow(int v) const { return Bt + (size_t)(n0 + v) * ldk; } };

__device__ __forceinline__ int sched_item(int k, int n, int bid) {
  const int G = (int)gridDim.x, nfull = n / G;
  if (k < nfull) return k * G + bid;
  if (k > nfull) return -1;
  const int R = n - nfull * G;
  int sr = bid;
  if (G == 512) { const int li = bid & 63, x = bid >> 6; sr = (((li >> 5) * 32 + (li & 1) * 16 + ((li & 31) >> 1)) << 3) + x; }
  return sr < R ? nfull * G + sr : -1;
}
#define FOR_ITEMS(w, n, bid) for (int k_ = 0, w = sched_item(0, (n), (bid)); w >= 0; w = sched_item(++k_, (n), (bid)))
template <int MI, int NST, class EPI>
__device__ __forceinline__ void gemm_dense_tile(const bfraw* A, int lda, const bfraw* Bt, int M, int N, int K, const EPI& epi, int m0, int n0, char* smem) {
  ARows af{A, lda, m0, M};
  BTrans bf{Bt, K, n0};
  auto ef = [&](const f32x16 (&acc)[MI][2], int wr, int wc, int lane) {
#pragma unroll
    for (int i = 0; i < MI; ++i)
#pragma unroll
      for (int j = 0; j < 2; ++j)
#pragma unroll
        for (int r = 0; r < 16; ++r) {
          int row = m0 + ACC_ROWM(MI, wr, i, r, lane), col = n0 + ACC_COL(wc, j, lane);
          if (row < M && col < N) epi(row, col, acc[i][j][r]);
        }
  };
  gemm_tile<MI, NST>(af, bf, ef, K, smem);
}
template <int MIUNUSED, class EPI>
__device__ __forceinline__ void gemm_dense(const bfraw* A, int lda, const bfraw* Bt, int M, int N, int K, const EPI& epi, int bid, char* smem) {
  const int mt = (M + 127) >> 7, nt = (N + 127) >> 7, G = (int)gridDim.x;
  const int U = mt * nt;
  int P = 0;
  if ((mt & 1) == 0) { P = ((U / (2 * G)) * G) / mt; if (2 * P > nt) P = nt >> 1; }
  const int nbig = P * mt;
  FOR_ITEMS(w, nbig, bid) {
    const int sr = w / mt, rem = w - sr * mt;
    gemm_dense_tile<4, 1>(A, lda, Bt, M, N, K, epi, (rem >> 1) * 256, (sr * 2 + (rem & 1)) * 128, smem);
  }
  const int ntr = nt - 2 * P;
  if (ntr * mt * 2 <= G) {
    FOR_ITEMS(w, ntr * mt * 2, bid) {
      const int u = w >> 1, nq = u / mt;
      gemm_dense_tile<1, 2>(A, lda, Bt, M, N, K, epi, (u - nq * mt) * 128 + (w & 1) * 64, (2 * P + nq) * 128, smem);
    }
    return;
  }
  const int nslots = ((ntr + 1) >> 1) * mt * 2;
  FOR_ITEMS(w, nslots, bid) {
    const int sr = w / (mt * 2), rem = w - sr * (mt * 2);
    const int n_t = 2 * P + sr * 2 + (rem & 1);
    if (n_t >= nt) continue;
    gemm_dense_tile<2, 2>(A, lda, Bt, M, N, K, epi, (rem >> 1) * 128, n_t * 128, smem);
  }
}


__device__ __forceinline__ void ph_win(const P& p, int layer, int bid, char* smem) {
  float* Z = p.Z();
  auto epi = [=](int row, int col, float v) { Z[(size_t)row * NIN + col] = v; };
  gemm_dense<2>(p.H(), LDH, p.winT() + (size_t)layer * 4224 * 2048, TTOT, NIN, 2048, epi, bid, smem);
}

__device__ __forceinline__ void ph_prep(const P& p, int layer, int bid, char* smem) {
  const int tid = otid(), lane = tid & 63, wid = tid >> 6;
  FOR_ROWS_TTOT(r, bid, wid) {
    const float* z = p.Z() + (size_t)r * NIN;
    float q[6]; float ss = 0.f;
#pragma unroll
    for (int i = 0; i < 6; ++i) { q[i] = z[ZC_CQ + i * 64 + lane]; ss += q[i] * q[i]; }
    ss = wave_sum(ss);
    float rs = rsqrtf(ss * (1.f / 384.f) + EPSV);
#pragma unroll
    for (int i = 0; i < 6; ++i) p.Aq()[(size_t)r * 384 + i * 64 + lane] = to_bf16(q[i] * rs * p.q_norm_w[layer * 384 + i * 64 + lane]);
    float k0 = z[ZC_CKV + lane], k1 = z[ZC_CKV + 64 + lane];
    float s2 = wave_sum(k0 * k0 + k1 * k1);
    float rs2 = rsqrtf(s2 * (1.f / 128.f) + EPSV);
    p.Akv()[(size_t)r * 128 + lane] = to_bf16(k0 * rs2 * p.kv_norm_w[layer * 128 + lane]);
    p.Akv()[(size_t)r * 128 + 64 + lane] = to_bf16(k1 * rs2 * p.kv_norm_w[layer * 128 + 64 + lane]);
  }
  const float* cw = p.conv_w + layer * 5 * 1024;
  const float* cb = p.conv_b + layer * 1024;
  const int ch = tid * 4;
  const f32x4v bias = *(const f32x4v*)(cb + ch);
  f32x4v wk[5];
#pragma unroll
  for (int k = 0; k < 5; ++k) wk[k] = *(const f32x4v*)(cw + k * 1024 + ch);
  FOR_ITEMS(rb, TTOT / 8, bid) {
    const int r0 = rb * 8;
    int base, len;
    if (r0 < TLAT) { base = (r0 >> 12) << 12; len = SL; } else { base = TLAT + (((r0 - TLAT) >> 8) << 8); len = CL; }
    const int t0 = r0 - base;
    f32x4v xw[12];
#pragma unroll
    for (int u = 0; u < 12; ++u) {
      const int tt = t0 + u - 2;
      const f32x4v zero = {0.f, 0.f, 0.f, 0.f};
      xw[u] = (tt >= 0 && tt < len) ? *(const f32x4v*)(p.Z() + (size_t)(base + tt) * NIN + ZC_XBC + ch) : zero;
    }
#pragma unroll
    for (int j = 0; j < 8; ++j) {
      f32x4v acc = bias;
#pragma unroll
      for (int k = 0; k < 5; ++k) acc += xw[j + k] * wk[k];
      acc[0] = siluf_(acc[0]); acc[1] = siluf_(acc[1]); acc[2] = siluf_(acc[2]); acc[3] = siluf_(acc[3]);
      const int r = r0 + j;
      float* cdst = ch < 512 ? p.ssd_xs() + (size_t)r * 512 + ch : (ch < 768 ? p.ssd_B() + (size_t)r * 256 + (ch - 512) : p.ssd_C() + (size_t)r * 256 + (ch - 768));
      store16_wt(cdst, __builtin_bit_cast(u32x4wt, acc));
    }
    if (tid < 128) {
      const int r = r0 + (tid >> 4), c = tid & 15;
      float v = p.Z()[(size_t)r * NIN + ZC_DT + c] + p.dt_bias[layer * 16 + c];
      p.ssd_dt()[(size_t)r * 16 + c] = v > 20.f ? v : log1pf(expf(v));
    }
  }
}

__device__ __forceinline__ void ph_qkv(const P& p, int layer, int bid, char* smem) {
  const int tid = otid();
  const float qscale = 0.07216878364870322f * 1.4426950408889634f;
  const float* rope = p.rope_cs();
  for (int r = bid; r < TTOT; r += gridDim.x) {
    const bool lat = r < TLAT;
    int b, pos;
    if (lat) { b = r >> 12; pos = r & 4095; } else { b = (r - TLAT) >> 8; pos = (r - TLAT) & 255; }
    const int kpos = lat ? pos : SL + pos;
    const float* zr = p.Z() + (size_t)r * NIN + ZC_KR;
    const int h = tid >> 6, e = tid & 63;
    float v;
    if (!lat) v = zr[e];
    else {
      const int a = e >> 5, half = (e >> 4) & 1, f = e & 15;
      const float x1 = zr[a * 32 + f], x2 = zr[a * 32 + 16 + f];
      const int idx = a == 0 ? (pos >> 6) : (pos & 63);
      const float cs = rope[(idx * 16 + f) * 2], sn = rope[(idx * 16 + f) * 2 + 1];
      v = half == 0 ? x1 * cs - x2 * sn : x1 * sn + x2 * cs;
    }
    p.K()[((size_t)(b * 4 + h) * NKEY + kpos) * 192 + 128 + e] = to_bf16(v);
  }
  {
    const bfraw* Bt = p.wuqT() + (size_t)layer * 768 * 384;
    FOR_ITEMS(w, 68 * 6, bid) {
      const int n_t = w / 68, m_t = w - n_t * 68;
      const int m0 = m_t * 128, n0 = n_t * 128;
      ARows af{p.Aq(), 384, m0, TTOT};
      BTrans bf{Bt, 384, n0};
      const bool lat = m0 < TLAT;
      const int b = lat ? (m0 >> 12) : ((m0 - TLAT) >> 8);
      const int pos0 = lat ? (m0 & 4095) : ((m0 - TLAT) & 255);
      auto ef = [&](const f32x16 (&acc)[2][2], int wr, int wc, int lane) {
        const int l31 = lane & 31;
#pragma unroll
        for (int j = 0; j < 2; ++j) {
          const int col = n0 + wc * 64 + j * 32;
          const int h = col / 192, d0 = col - h * 192;
          const bool isrope = lat && d0 >= 128;
          const int f = l31 & 15;
#pragma unroll
          for (int i = 0; i < 2; ++i)
#pragma unroll
            for (int r = 0; r < 16; ++r) {
              const int pos = pos0 + ACC_ROW(wr, i, r, lane);
              float v = acc[i][j][r];
              const float pv = xor16(v);
              if (isrope) {
                const int idx = d0 == 128 ? (pos >> 6) : (pos & 63);
                const float cs = rope[(idx * 16 + f) * 2], sn = rope[(idx * 16 + f) * 2 + 1];
                v = (l31 < 16) ? v * cs - pv * sn : pv * sn + v * cs;
              }
              bfraw* dst = lat ? p.Q() + ((size_t)(b * 4 + h) * SL + pos) * 192 : p.Qc() + ((size_t)(b * 4 + h) * CL + pos) * 192;
              dst[d0 + l31] = to_bf16(v * qscale);
            }
        }
      };
      gemm_tile<2>(af, bf, ef, 384, smem);
    }
  }
  {
    const bfraw* Bt = p.wukvT() + (size_t)layer * 1024 * 128;
    FOR_ITEMS(w, 68 * 8, bid) {
      const int n_t = w / 68, m_t = w - n_t * 68;
      const int m0 = m_t * 128, n0 = n_t * 128;
      ARows af{p.Akv(), 128, m0, TTOT};
      BTrans bf{Bt, 128, n0};
      const bool lat = m0 < TLAT;
      const int b = lat ? (m0 >> 12) : ((m0 - TLAT) >> 8);
      const int kpos0 = lat ? (m0 & 4095) : SL + ((m0 - TLAT) & 255);
      const int h = n_t >> 1;
      const bool isv = n_t & 1;
      auto ef = [&](const f32x16 (&acc)[2][2], int wr, int wc, int lane) {
        const int l31 = lane & 31, lh = lane >> 5;
        if (!isv) {
#pragma unroll
          for (int i = 0; i < 2; ++i)
#pragma unroll
            for (int j = 0; j < 2; ++j)
#pragma unroll
              for (int r = 0; r < 16; ++r) {
                const int kpos = kpos0 + ACC_ROW(wr, i, r, lane);
                p.K()[((size_t)(b * 4 + h) * NKEY + kpos) * 192 + wc * 64 + j * 32 + l31] = to_bf16(acc[i][j][r]);
              }
        } else {
#pragma unroll
          for (int i = 0; i < 2; ++i)
#pragma unroll
            for (int j = 0; j < 2; ++j) {
              const int d = wc * 64 + j * 32 + l31;
              bfraw* vrow = p.V() + ((size_t)(b * 4 + h) * 128 + d) * NKEY + kpos0 + wr * 64 + i * 32;
#pragma unroll
              for (int s = 0; s < 2; ++s) {
                uint4 t;
                t.x = pack_bf16(acc[i][j][8 * s + 0], acc[i][j][8 * s + 1]); t.y = pack_bf16(acc[i][j][8 * s + 2], acc[i][j][8 * s + 3]);
                t.z = pack_bf16(acc[i][j][8 * s + 4], acc[i][j][8 * s + 5]); t.w = pack_bf16(acc[i][j][8 * s + 6], acc[i][j][8 * s + 7]);
                *(uint4*)(vrow + 16 * s + 8 * lh) = t;
              }
            }
        }
      };
      gemm_tile<2>(af, bf, ef, 128, smem);
    }
  }
}

#define ATT_KROW 400
#define ATT_VROW 144
#define MFMA16(a, b, c) __builtin_amdgcn_mfma_f32_32x32x16_bf16(a, b, c, 0, 0, 0)
__device__ __forceinline__ void attn_item(const bfraw* __restrict__ Qp, const bfraw* __restrict__ Kp, const bfraw* __restrict__ Vtp,
                                          int nk, float* __restrict__ Op, float* __restrict__ MLp, char* smem) {
  char* Ks = smem;
  char* Vs = smem + 64 * ATT_KROW;
  int tid_ = threadIdx.x; asm volatile("" : "+v"(tid_));
  const int tid = tid_, lane = tid & 63, wid = tid >> 6, l31 = lane & 31, lh = lane >> 5;
  bf16x8 qf[12];
  {
    const bfraw* qrow = Qp + (size_t)(wid * 32 + l31) * 192 + lh * 8;
#pragma unroll
    for (int ks = 0; ks < 12; ++ks) qf[ks] = *(const bf16x8*)(qrow + ks * 16);
  }
  f32x16 o[4];
#pragma unroll
  for (int d = 0; d < 4; ++d)
#pragma unroll
    for (int r = 0; r < 16; ++r) o[d][r] = 0.f;
  float m = -INFINITY, l = 0.f;
  uint4 rk0, rk1, rk2, rk3, rk4, rk5, rv0, rv1, rv2, rv3;
#define ATT_KSRC(n, kt) (Kp + (size_t)((kt) + (tid + 256 * (n)) / 24) * 192 + ((tid + 256 * (n)) % 24) * 8)
#define ATT_VSRC(n, kt) (Vtp + (size_t)((tid + 256 * (n)) >> 3) * NKEY + (kt) + ((tid + 256 * (n)) & 7) * 8)
#define ATT_GLOAD(kt)                                                                                        \
  {                                                                                                          \
    rk0 = *(const uint4*)ATT_KSRC(0, kt); rk1 = *(const uint4*)ATT_KSRC(1, kt); rk2 = *(const uint4*)ATT_KSRC(2, kt); \
    rk3 = *(const uint4*)ATT_KSRC(3, kt); rk4 = *(const uint4*)ATT_KSRC(4, kt); rk5 = *(const uint4*)ATT_KSRC(5, kt); \
    rv0 = *(const uint4*)ATT_VSRC(0, kt); rv1 = *(const uint4*)ATT_VSRC(1, kt);                              \
    rv2 = *(const uint4*)ATT_VSRC(2, kt); rv3 = *(const uint4*)ATT_VSRC(3, kt);                              \
  }
#define ATT_KDST(n) (Ks + ((tid + 256 * (n)) / 24) * ATT_KROW + ((tid + 256 * (n)) % 24) * 16)
#define ATT_VDST(n) (Vs + ((tid + 256 * (n)) >> 3) * ATT_VROW + ((tid + 256 * (n)) & 7) * 16)
#define ATT_SWRITE()                                                                                         \
  {                                                                                                          \
    *(uint4*)ATT_KDST(0) = rk0; *(uint4*)ATT_KDST(1) = rk1; *(uint4*)ATT_KDST(2) = rk2;                      \
    *(uint4*)ATT_KDST(3) = rk3; *(uint4*)ATT_KDST(4) = rk4; *(uint4*)ATT_KDST(5) = rk5;                      \
    *(uint4*)ATT_VDST(0) = rv0; *(uint4*)ATT_VDST(1) = rv1; *(uint4*)ATT_VDST(2) = rv2; *(uint4*)ATT_VDST(3) = rv3; \
  }
  __syncthreads();
  ATT_GLOAD(0)
  ATT_SWRITE()
  __syncthreads();
  for (int kt = 0; kt < nk; kt += 64) {
    const bool more = (kt + 64) < nk;
    if (more) ATT_GLOAD(kt + 64)
    f32x16 s0, s1;
#pragma unroll
    for (int r = 0; r < 16; ++r) { s0[r] = 0.f; s1[r] = 0.f; }
    const char* kp = Ks + l31 * ATT_KROW + lh * 16;
#pragma unroll
    for (int ks = 0; ks < 12; ++ks) {
      bf16x8 a0 = *(const bf16x8*)(kp + ks * 32);
      bf16x8 a1 = *(const bf16x8*)(kp + 32 * ATT_KROW + ks * 32);
      s0 = MFMA16(a0, qf[ks], s0);
      s1 = MFMA16(a1, qf[ks], s1);
    }
    float tmax = fmaxf(s0[0], s1[0]);
#pragma unroll
    for (int r = 1; r < 16; ++r) tmax = fmaxf(tmax, fmaxf(s0[r], s1[r]));
    tmax = fmaxf(tmax, xor32(tmax));
    const float mn = fmaxf(m, tmax);
    const float alpha = __builtin_amdgcn_exp2f(m - mn);
    float rs = 0.f;
#pragma unroll
    for (int r = 0; r < 16; ++r) { s0[r] = __builtin_amdgcn_exp2f(s0[r] - mn); s1[r] = __builtin_amdgcn_exp2f(s1[r] - mn); rs += s0[r] + s1[r]; }
    rs += xor32(rs);
    l = l * alpha + rs;
    m = mn;
    if (__any(alpha != 1.f)) {
#pragma unroll
      for (int d = 0; d < 4; ++d)
#pragma unroll
        for (int r = 0; r < 16; ++r) o[d][r] *= alpha;
    }
    bf16x8 pf[4];
    {
      uint4 t;
      t.x = pack_bf16(s0[0], s0[1]); t.y = pack_bf16(s0[2], s0[3]); t.z = pack_bf16(s0[4], s0[5]); t.w = pack_bf16(s0[6], s0[7]);
      pf[0] = __builtin_bit_cast(bf16x8, t);
      t.x = pack_bf16(s0[8], s0[9]); t.y = pack_bf16(s0[10], s0[11]); t.z = pack_bf16(s0[12], s0[13]); t.w = pack_bf16(s0[14], s0[15]);
      pf[1] = __builtin_bit_cast(bf16x8, t);
      t.x = pack_bf16(s1[0], s1[1]); t.y = pack_bf16(s1[2], s1[3]); t.z = pack_bf16(s1[4], s1[5]); t.w = pack_bf16(s1[6], s1[7]);
      pf[2] = __builtin_bit_cast(bf16x8, t);
      t.x = pack_bf16(s1[8], s1[9]); t.y = pack_bf16(s1[10], s1[11]); t.z = pack_bf16(s1[12], s1[13]); t.w = pack_bf16(s1[14], s1[15]);
      pf[3] = __builtin_bit_cast(bf16x8, t);
    }
    const char* vp = Vs + l31 * ATT_VROW + lh * 16;
#pragma unroll
    for (int g16 = 0; g16 < 4; ++g16) {
#pragma unroll
      for (int d = 0; d < 4; ++d) {
        bf16x8 a = *(const bf16x8*)(vp + d * 32 * ATT_VROW + g16 * 32);
        o[d] = MFMA16(a, pf[g16], o[d]);
      }
    }
    __syncthreads();
    if (more) ATT_SWRITE()
    __syncthreads();
  }
  const float inv = 1.f;
  if (lh == 0) *(float2*)(MLp + (size_t)(wid * 32 + l31) * 2) = make_float2(m, l);
  float* tb = (float*)smem + wid * (32 * 129);
#pragma unroll
  for (int d = 0; d < 4; ++d)
#pragma unroll
    for (int r = 0; r < 16; ++r) tb[l31 * 129 + d * 32 + (r & 3) + 8 * (r >> 2) + 4 * lh] = o[d][r] * inv;
  __syncthreads();
  for (int i = lane; i < 32 * 32; i += 64) {
    const int q = i >> 5, c4 = i & 31;
    const float* s = tb + q * 129 + c4 * 4;
    { u32x4wt v; v[0] = __float_as_uint(s[0]); v[1] = __float_as_uint(s[1]); v[2] = __float_as_uint(s[2]); v[3] = __float_as_uint(s[3]);
      store16_wt(Op + (size_t)(wid * 32 + q) * 512 + c4 * 4, v); }
  }
  __syncthreads();
}

__device__ __forceinline__ int chunk_row0(int b, int cid) { return cid < 4 ? TLAT + b * CL + cid * 64 : b * SL + (cid - 4) * 64; }
__device__ __forceinline__ int step_of(int cid, int dir) { return dir == 0 ? cid : (cid < 4 ? 3 - cid : 71 - cid); }
__device__ __forceinline__ int cid_of(int s, int dir) { return dir == 0 ? s : (s < 4 ? 3 - s : 71 - s); }
#define MFMA32(a, b, c) __builtin_amdgcn_mfma_f32_32x32x2f32(a, b, c, 0, 0, 0)
#define ROW16(r, lh) (((r) & 3) + 8 * ((r) >> 2) + 4 * (lh))
__device__ __forceinline__ float wave_incl_scan(float v, int lane) {
  v += DPPF(v, 0x111, 0xF); v += DPPF(v, 0x112, 0xF); v += DPPF(v, 0x114, 0xF); v += DPPF(v, 0x118, 0xF);
  v += DPPF(v, 0x142, 0xA);
  v += DPPF(v, 0x143, 0xC);
  (void)lane;
  return v;
}

#define SSD_R256 272
#define SSD_R128 144
__device__ __forceinline__ void ssd_local_item(const P& p, int layer, int item, char* smem) {
  const int h = item & 7, cid = (item >> 3) % NSTEP, b = item / (8 * NSTEP);
  char* sBT = smem;
  char* sxf = sBT + 128 * SSD_R128;
  char* sxb = sxf + 64 * SSD_R128;
  float* swf = (float*)(sxb + 64 * SSD_R128);
  float* swb = swf + 64;
  int tid_ = threadIdx.x; asm volatile("" : "+v"(tid_));
  const int tid = tid_, lane = tid & 63, wid = tid >> 6, l31 = lane & 31, lh = lane >> 5;
  const int row0 = chunk_row0(b, cid), g = h >> 2;
  __syncthreads();
  if (wid < 2) {
    const int dir = wid;
    const float A = -__expf(p.a_log[layer * 16 + dir * 8 + h]);
    const int q = dir ? 63 - lane : lane;
    const float dt = p.ssd_dt()[(size_t)(row0 + q) * 16 + dir * 8 + h];
    const float ac = wave_incl_scan(dt * A, lane);
    const float tot = lane63(ac);
    (dir ? swb : swf)[q] = __expf(tot - ac) * dt;
    if (lane == 0) p.ssd_atot()[((b * 2 + dir) * 8 + h) * NSTEP + step_of(cid, dir)] = tot;
  }
#pragma unroll
  for (int u = 0; u < 8; ++u) {
    const int i = tid + 256 * u, q = i >> 5, c4 = i & 31;
    const float4 v = *(const float4*)(p.ssd_B() + (size_t)(row0 + q) * 256 + g * 128 + c4 * 4);
    *(bfraw*)(sBT + (c4 * 4 + 0) * SSD_R128 + q * 2) = to_bf16(v.x);
    *(bfraw*)(sBT + (c4 * 4 + 1) * SSD_R128 + q * 2) = to_bf16(v.y);
    *(bfraw*)(sBT + (c4 * 4 + 2) * SSD_R128 + q * 2) = to_bf16(v.z);
    *(bfraw*)(sBT + (c4 * 4 + 3) * SSD_R128 + q * 2) = to_bf16(v.w);
  }
  __syncthreads();
#pragma unroll
  for (int u = 0; u < 4; ++u) {
    const int i = tid + 256 * u, q = i >> 4, c4 = i & 15;
    const float4 v = *(const float4*)(p.ssd_xs() + (size_t)(row0 + q) * 512 + h * 64 + c4 * 4);
    const float wf = swf[q], wb = swb[q];
    *(bfraw*)(sxf + (c4 * 4 + 0) * SSD_R128 + q * 2) = to_bf16(v.x * wf); *(bfraw*)(sxb + (c4 * 4 + 0) * SSD_R128 + q * 2) = to_bf16(v.x * wb);
    *(bfraw*)(sxf + (c4 * 4 + 1) * SSD_R128 + q * 2) = to_bf16(v.y * wf); *(bfraw*)(sxb + (c4 * 4 + 1) * SSD_R128 + q * 2) = to_bf16(v.y * wb);
    *(bfraw*)(sxf + (c4 * 4 + 2) * SSD_R128 + q * 2) = to_bf16(v.z * wf); *(bfraw*)(sxb + (c4 * 4 + 2) * SSD_R128 + q * 2) = to_bf16(v.z * wb);
    *(bfraw*)(sxf + (c4 * 4 + 3) * SSD_R128 + q * 2) = to_bf16(v.w * wf); *(bfraw*)(sxb + (c4 * 4 + 3) * SSD_R128 + q * 2) = to_bf16(v.w * wb);
  }
  __syncthreads();
  f32x16 acc[2][2];
#pragma unroll
  for (int d = 0; d < 2; ++d)
#pragma unroll
    for (int t = 0; t < 2; ++t)
#pragma unroll
      for (int r = 0; r < 16; ++r) acc[d][t][r] = 0.f;
  const int pi = wid & 1, jj = wid >> 1;
  {
    const char* af = sxf + (pi * 32 + l31) * SSD_R128 + lh * 16;
    const char* ab = sxb + (pi * 32 + l31) * SSD_R128 + lh * 16;
    const char* bp = sBT + ((2 * jj) * 32 + l31) * SSD_R128 + lh * 16;
#pragma unroll
    for (int ks = 0; ks < 4; ++ks) {
      const bf16x8 a0 = *(const bf16x8*)(af + ks * 32), a1 = *(const bf16x8*)(ab + ks * 32);
      const bf16x8 b0 = *(const bf16x8*)(bp + ks * 32), b1 = *(const bf16x8*)(bp + 32 * SSD_R128 + ks * 32);
      acc[0][0] = MFMA16(a0, b0, acc[0][0]); acc[0][1] = MFMA16(a0, b1, acc[0][1]);
      acc[1][0] = MFMA16(a1, b0, acc[1][0]); acc[1][1] = MFMA16(a1, b1, acc[1][1]);
    }
  }
#pragma unroll
  for (int d = 0; d < 2; ++d) {
    bfraw* dst = p.ssd_st() + ((size_t)((b * 2 + d) * 8 + h) * NSTEP + step_of(cid, d)) * 8192;
#pragma unroll
    for (int t = 0; t < 2; ++t)
#pragma unroll
      for (int r = 0; r < 16; ++r) dst[(pi * 32 + ROW16(r, lh)) * 128 + (2 * jj + t) * 32 + l31] = to_bf16(acc[d][t][r]);
  }
}

__device__ __forceinline__ void ssd_out_item(const P& p, int layer, int item, char* smem) {
  const int h = item & 7, cid = (item >> 3) % NSTEP, b = item / (8 * NSTEP);
  char* sC = smem;
  char* sB = sC + 64 * SSD_R256;
  char* sxT = sB + 64 * SSD_R256;
  char* sP = sxT + 64 * SSD_R128;
  float* saf = (float*)(sP + 64 * SSD_R128);
  float* sab = saf + 64;
  float* sdf = sab + 64;
  float* sdb = sdf + 64;
  int tid_ = threadIdx.x; asm volatile("" : "+v"(tid_));
  const int tid = tid_, lane = tid & 63, wid = tid >> 6, l31 = lane & 31, lh = lane >> 5;
  const int row0 = chunk_row0(b, cid), g = h >> 2;
  const bfraw* hf = p.ssd_st() + ((size_t)((b * 2 + 0) * 8 + h) * NSTEP + step_of(cid, 0)) * 8192;
  const bfraw* hb = p.ssd_st() + ((size_t)((b * 2 + 1) * 8 + h) * NSTEP + step_of(cid, 1)) * 8192;
  u32x4g hreg[4];
#pragma unroll
  for (int u = 0; u < 4; ++u) { const int i = tid + 256 * u; hreg[u] = *(const u32x4g*)(hf + (i >> 4) * 128 + (i & 15) * 8); }
  __syncthreads();
#pragma unroll
  for (int u = 0; u < 4; ++u) {
    const int i = tid + 256 * u, q = i >> 4, c8 = i & 15;
    const float* cs = p.ssd_C() + (size_t)(row0 + q) * 256 + g * 128 + c8 * 8;
    const float* bs = p.ssd_B() + (size_t)(row0 + q) * 256 + g * 128 + c8 * 8;
    const float4 c0 = *(const float4*)cs, c1 = *(const float4*)(cs + 4), b0 = *(const float4*)bs, b1 = *(const float4*)(bs + 4);
    uint4 t;
    t.x = pack_bf16(c0.x, c0.y); t.y = pack_bf16(c0.z, c0.w); t.z = pack_bf16(c1.x, c1.y); t.w = pack_bf16(c1.z, c1.w);
    *(uint4*)(sC + q * SSD_R256 + c8 * 16) = t;
    t.x = pack_bf16(b0.x, b0.y); t.y = pack_bf16(b0.z, b0.w); t.z = pack_bf16(b1.x, b1.y); t.w = pack_bf16(b1.z, b1.w);
    *(uint4*)(sB + q * SSD_R256 + c8 * 16) = t;
  }
#pragma unroll
  for (int u = 0; u < 4; ++u) {
    const int i = tid + 256 * u, j = i >> 4, c4 = i & 15;
    const float4 xv = *(const float4*)(p.ssd_xs() + (size_t)(row0 + j) * 512 + h * 64 + c4 * 4);
    *(bfraw*)(sxT + (c4 * 4 + 0) * SSD_R128 + j * 2) = to_bf16(xv.x);
    *(bfraw*)(sxT + (c4 * 4 + 1) * SSD_R128 + j * 2) = to_bf16(xv.y);
    *(bfraw*)(sxT + (c4 * 4 + 2) * SSD_R128 + j * 2) = to_bf16(xv.z);
    *(bfraw*)(sxT + (c4 * 4 + 3) * SSD_R128 + j * 2) = to_bf16(xv.w);
  }
  if (wid < 2) {
    const int dir = wid;
    const float A = -__expf(p.a_log[layer * 16 + dir * 8 + h]);
    const int q = dir ? 63 - lane : lane;
    const float dt = p.ssd_dt()[(size_t)(row0 + q) * 16 + dir * 8 + h];
    const float ac = wave_incl_scan(dt * A, lane);
    (dir ? sab : saf)[q] = ac;
    (dir ? sdb : sdf)[q] = dt;
  }
  __syncthreads();
  const int it = wid >> 1, jt = wid & 1;
  {
    f32x16 sa;
#pragma unroll
    for (int r = 0; r < 16; ++r) sa[r] = 0.f;
    const char* ap = sC + (it * 32 + l31) * SSD_R256 + lh * 16;
    const char* bp = sB + (jt * 32 + l31) * SSD_R256 + lh * 16;
#pragma unroll
    for (int ks = 0; ks < 8; ++ks) sa = MFMA16(*(const bf16x8*)(ap + ks * 32), *(const bf16x8*)(bp + ks * 32), sa);
    const int j = jt * 32 + l31;
    const float afj = saf[j], abj = sab[j], dfj = sdf[j], dbj = sdb[j];
#pragma unroll
    for (int r = 0; r < 16; ++r) {
      const int i = it * 32 + ROW16(r, lh);
      float wgt = 0.f;
      if (j <= i) wgt += __expf(saf[i] - afj) * dfj;
      if (j >= i) wgt += __expf(sab[i] - abj) * dbj;
      *(bfraw*)(sP + i * SSD_R128 + j * 2) = to_bf16(sa[r] * wgt);
    }
  }
  __syncthreads();
#pragma unroll
  for (int u = 0; u < 4; ++u) { const int i = tid + 256 * u; *(u32x4g*)(sB + (i >> 4) * SSD_R256 + (i & 15) * 16) = hreg[u]; }
#pragma unroll
  for (int u = 0; u < 4; ++u) { const int i = tid + 256 * u; hreg[u] = *(const u32x4g*)(hb + (i >> 4) * 128 + (i & 15) * 8); }
  const int pt = wid & 1;
  f32x16 ya, gf, gb;
#pragma unroll
  for (int r = 0; r < 16; ++r) { ya[r] = 0.f; gf[r] = 0.f; gb[r] = 0.f; }
  {
    const char* ap = sP + (it * 32 + l31) * SSD_R128 + lh * 16;
    const char* bp = sxT + (pt * 32 + l31) * SSD_R128 + lh * 16;
#pragma unroll
    for (int ks = 0; ks < 4; ++ks) ya = MFMA16(*(const bf16x8*)(ap + ks * 32), *(const bf16x8*)(bp + ks * 32), ya);
  }
  __syncthreads();
  {
    const char* ap = sC + (it * 32 + l31) * SSD_R256 + lh * 16;
    const char* bp = sB + (pt * 32 + l31) * SSD_R256 + lh * 16;
#pragma unroll
    for (int ks = 0; ks < 8; ++ks) gf = MFMA16(*(const bf16x8*)(ap + ks * 32), *(const bf16x8*)(bp + ks * 32), gf);
  }
  __syncthreads();
#pragma unroll
  for (int u = 0; u < 4; ++u) { const int i = tid + 256 * u; *(u32x4g*)(sB + (i >> 4) * SSD_R256 + (i & 15) * 16) = hreg[u]; }
  __syncthreads();
  {
    const char* ap = sC + (it * 32 + l31) * SSD_R256 + lh * 16;
    const char* bp = sB + (pt * 32 + l31) * SSD_R256 + lh * 16;
#pragma unroll
    for (int ks = 0; ks < 8; ++ks) gb = MFMA16(*(const bf16x8*)(ap + ks * 32), *(const bf16x8*)(bp + ks * 32), gb);
  }
#pragma unroll
  for (int r = 0; r < 16; ++r) {
    const int i = it * 32 + ROW16(r, lh);
    p.ssd_y()[(size_t)(row0 + i) * 512 + h * 64 + pt * 32 + l31] = ya[r] + __expf(saf[i]) * gf[r] + __expf(sab[i]) * gb[r];
  }
}

__device__ __forceinline__ void ml_gates(const P& p, int layer, int row0, int h, int dir, int lane, float& bcum, float& li, float& tot) {
  const int j = dir ? 63 - lane : lane;
  const float* z = p.Z() + (size_t)(row0 + j) * NIN + ZC_MG + dir * 8;
  li = z[h] + p.gate_b[layer * 16 + dir * 8 + h];
  const float gf = z[4 + h] + p.gate_b[layer * 16 + dir * 8 + 4 + h];
  const float lf = gf >= 0.f ? -log1pf(expf(-gf)) : gf - log1pf(expf(gf));
  bcum = wave_incl_scan(lf, lane);
  tot = lane63(bcum);
}
__device__ __forceinline__ void ml_local_item(const P& p, int layer, int item, char* smem) {
  const int h = item & 3, cid = (item >> 2) % NSTEP, b = item / (4 * NSTEP);
  char* svf = smem;
  char* svb = svf + 128 * SSD_R128;
  char* skT = svb + 128 * SSD_R128;
  float* swf = (float*)(skT + 64 * SSD_R128);
  float* swb = swf + 64;
  int tid_ = threadIdx.x; asm volatile("" : "+v"(tid_));
  const int tid = tid_, lane = tid & 63, wid = tid >> 6, l31 = lane & 31, lh = lane >> 5;
  const int row0 = chunk_row0(b, cid);
  __syncthreads();
  if (wid < 2) {
    const int dir = wid;
    float bc, li, tot;
    ml_gates(p, layer, row0, h, dir, lane, bc, li, tot);
    const int j = dir ? 63 - lane : lane;
    (dir ? swb : swf)[j] = __expf(tot - bc + li);
    if (lane == 0) p.ml_gtot()[((b * 2 + dir) * 4 + h) * NSTEP + step_of(cid, dir)] = tot;
  }
#pragma unroll
  for (int u = 0; u < 4; ++u) {
    const int i = tid + 256 * u, j = i >> 4, c4 = i & 15;
    const float4 v = *(const float4*)(p.Z() + (size_t)(row0 + j) * NIN + ZC_MK + h * 64 + c4 * 4);
    *(bfraw*)(skT + (c4 * 4 + 0) * SSD_R128 + j * 2) = to_bf16(v.x);
    *(bfraw*)(skT + (c4 * 4 + 1) * SSD_R128 + j * 2) = to_bf16(v.y);
    *(bfraw*)(skT + (c4 * 4 + 2) * SSD_R128 + j * 2) = to_bf16(v.z);
    *(bfraw*)(skT + (c4 * 4 + 3) * SSD_R128 + j * 2) = to_bf16(v.w);
  }
  __syncthreads();
#pragma unroll
  for (int u = 0; u < 8; ++u) {
    const int i = tid + 256 * u, j = i >> 5, c4 = i & 31;
    const float4 v = *(const float4*)(p.Z() + (size_t)(row0 + j) * NIN + ZC_MV + h * 128 + c4 * 4);
    const float wf = swf[j], wb = swb[j];
    *(bfraw*)(svf + (c4 * 4 + 0) * SSD_R128 + j * 2) = to_bf16(v.x * wf); *(bfraw*)(svb + (c4 * 4 + 0) * SSD_R128 + j * 2) = to_bf16(v.x * wb);
    *(bfraw*)(svf + (c4 * 4 + 1) * SSD_R128 + j * 2) = to_bf16(v.y * wf); *(bfraw*)(svb + (c4 * 4 + 1) * SSD_R128 + j * 2) = to_bf16(v.y * wb);
    *(bfraw*)(svf + (c4 * 4 + 2) * SSD_R128 + j * 2) = to_bf16(v.z * wf); *(bfraw*)(svb + (c4 * 4 + 2) * SSD_R128 + j * 2) = to_bf16(v.z * wb);
    *(bfraw*)(svf + (c4 * 4 + 3) * SSD_R128 + j * 2) = to_bf16(v.w * wf); *(bfraw*)(svb + (c4 * 4 + 3) * SSD_R128 + j * 2) = to_bf16(v.w * wb);
  }
  __syncthreads();
  f32x16 acc[2][2];
#pragma unroll
  for (int d = 0; d < 2; ++d)
#pragma unroll
    for (int t = 0; t < 2; ++t)
#pragma unroll
      for (int r = 0; r < 16; ++r) acc[d][t][r] = 0.f;
  const int vt = wid;
  {
    const char* af = svf + (vt * 32 + l31) * SSD_R128 + lh * 16;
    const char* ab = svb + (vt * 32 + l31) * SSD_R128 + lh * 16;
    const char* bp = skT + l31 * SSD_R128 + lh * 16;
#pragma unroll
    for (int ks = 0; ks < 4; ++ks) {
      const bf16x8 a0 = *(const bf16x8*)(af + ks * 32), a1 = *(const bf16x8*)(ab + ks * 32);
      const bf16x8 b0 = *(const bf16x8*)(bp + ks * 32), b1 = *(const bf16x8*)(bp + 32 * SSD_R128 + ks * 32);
      acc[0][0] = MFMA16(a0, b0, acc[0][0]); acc[0][1] = MFMA16(a0, b1, acc[0][1]);
      acc[1][0] = MFMA16(a1, b0, acc[1][0]); acc[1][1] = MFMA16(a1, b1, acc[1][1]);
    }
  }
#pragma unroll
  for (int d = 0; d < 2; ++d) {
    bfraw* dst = p.ml_st() + ((size_t)((b * 2 + d) * 4 + h) * NSTEP + step_of(cid, d)) * 8192;
#pragma unroll
    for (int t = 0; t < 2; ++t)
#pragma unroll
      for (int r = 0; r < 16; ++r) dst[(vt * 32 + ROW16(r, lh)) * 64 + t * 32 + l31] = to_bf16(acc[d][t][r]);
  }
  if (tid < 128) {
    const int d = tid >> 6, kk = tid & 63;
    const float* w = d ? swb : swf;
    const char* kr = skT + kk * SSD_R128;
    float sacc = 0.f;
    for (int j = 0; j < 64; ++j) sacc += w[j] * from_bf16(*(const bfraw*)(kr + j * 2));
    p.ml_nst()[((size_t)((b * 2 + d) * 4 + h) * NSTEP + step_of(cid, d)) * 64 + kk] = sacc;
  }
}

__device__ __forceinline__ void ml_out_item(const P& p, int layer, int item, char* smem) {
  const int h = item & 3, cid = (item >> 2) % NSTEP, b = item / (4 * NSTEP);
  char* sq = smem;
  char* sk = sq + 64 * SSD_R128;
  char* svT = sk + 64 * SSD_R128;
  char* sPf = svT + 128 * SSD_R128;
  char* sPb = sPf + 64 * SSD_R128;
  char* sCs = sPb + 64 * SSD_R128;
  float* sbf = (float*)(sCs + 128 * SSD_R128);
  float* sbb = sbf + 64;
  float* slf = sbb + 64;
  float* slb = slf + 64;
  float* sdenf = slb + 64;
  float* sdenb = sdenf + 64;
  float* snf = sdenb + 64;
  float* snb = snf + 64;
  int tid_ = threadIdx.x; asm volatile("" : "+v"(tid_));
  const int tid = tid_, lane = tid & 63, wid = tid >> 6, l31 = lane & 31, lh = lane >> 5;
  const int row0 = chunk_row0(b, cid);
  const size_t slotf = ((size_t)((b * 2 + 0) * 4 + h) * NSTEP + step_of(cid, 0));
  const size_t slotb = ((size_t)((b * 2 + 1) * 4 + h) * NSTEP + step_of(cid, 1));
  const bfraw* csf = p.ml_st() + slotf * 8192;
  const bfraw* csb = p.ml_st() + slotb * 8192;
  u32x4g creg[4];
#pragma unroll
  for (int u = 0; u < 4; ++u) { const int i = tid + 256 * u; creg[u] = *(const u32x4g*)(csf + (i >> 3) * 64 + (i & 7) * 8); }
  __syncthreads();
#pragma unroll
  for (int u = 0; u < 4; ++u) {
    const int i = tid + 256 * u, j = i >> 4, c4 = i & 15;
    const float4 kv = *(const float4*)(p.Z() + (size_t)(row0 + j) * NIN + ZC_MK + h * 64 + c4 * 4);
    const float4 qv = *(const float4*)(p.Z() + (size_t)(row0 + j) * NIN + ZC_MQ + h * 64 + c4 * 4);
    uint2 t;
    t.x = pack_bf16(kv.x, kv.y); t.y = pack_bf16(kv.z, kv.w);
    *(uint2*)(sk + j * SSD_R128 + c4 * 8) = t;
    t.x = pack_bf16(qv.x * 0.125f, qv.y * 0.125f); t.y = pack_bf16(qv.z * 0.125f, qv.w * 0.125f);
    *(uint2*)(sq + j * SSD_R128 + c4 * 8) = t;
  }
#pragma unroll
  for (int u = 0; u < 8; ++u) {
    const int i = tid + 256 * u, j = i >> 5, c4 = i & 31;
    const float4 vv = *(const float4*)(p.Z() + (size_t)(row0 + j) * NIN + ZC_MV + h * 128 + c4 * 4);
    *(bfraw*)(svT + (c4 * 4 + 0) * SSD_R128 + j * 2) = to_bf16(vv.x);
    *(bfraw*)(svT + (c4 * 4 + 1) * SSD_R128 + j * 2) = to_bf16(vv.y);
    *(bfraw*)(svT + (c4 * 4 + 2) * SSD_R128 + j * 2) = to_bf16(vv.z);
    *(bfraw*)(svT + (c4 * 4 + 3) * SSD_R128 + j * 2) = to_bf16(vv.w);
  }
#pragma unroll
  for (int u = 0; u < 4; ++u) { const int i = tid + 256 * u; *(u32x4g*)(sCs + (i >> 3) * SSD_R128 + (i & 7) * 16) = creg[u]; }
#pragma unroll
  for (int u = 0; u < 4; ++u) { const int i = tid + 256 * u; creg[u] = *(const u32x4g*)(csb + (i >> 3) * 64 + (i & 7) * 8); }
  if (wid < 2) {
    const int dir = wid;
    float bc, li, tot;
    ml_gates(p, layer, row0, h, dir, lane, bc, li, tot);
    const int j = dir ? 63 - lane : lane;
    (dir ? sbb : sbf)[j] = bc;
    (dir ? slb : slf)[j] = li;
    (dir ? snb : snf)[lane] = p.ml_nst()[(dir ? slotb : slotf) * 64 + lane];
  }
  __syncthreads();
  const int it = wid >> 1, jt = wid & 1;
  {
    f32x16 sa;
#pragma unroll
    for (int r = 0; r < 16; ++r) sa[r] = 0.f;
    const char* ap = sq + (it * 32 + l31) * SSD_R128 + lh * 16;
    const char* bp = sk + (jt * 32 + l31) * SSD_R128 + lh * 16;
#pragma unroll
    for (int ks = 0; ks < 4; ++ks) sa = MFMA16(*(const bf16x8*)(ap + ks * 32), *(const bf16x8*)(bp + ks * 32), sa);
    const int j = jt * 32 + l31;
    const float bfj = sbf[j], bbj = sbb[j], lfj = slf[j], lbj = slb[j];
#pragma unroll
    for (int r = 0; r < 16; ++r) {
      const int i = it * 32 + ROW16(r, lh);
      *(bfraw*)(sPf + i * SSD_R128 + j * 2) = to_bf16(j <= i ? sa[r] * __expf(sbf[i] - bfj + lfj) : 0.f);
      *(bfraw*)(sPb + i * SSD_R128 + j * 2) = to_bf16(j >= i ? sa[r] * __expf(sbb[i] - bbj + lbj) : 0.f);
    }
  }
  __syncthreads();
  if (tid < 128) {
    const int d = tid >> 6, i = tid & 63;
    const char* Pm = (d ? sPb : sPf) + i * SSD_R128;
    const char* qr = sq + i * SSD_R128;
    const float* ns = d ? snb : snf;
    float rs = 0.f, qn = 0.f;
    for (int j = 0; j < 64; ++j) { rs += from_bf16(*(const bfraw*)(Pm + j * 2)); qn += from_bf16(*(const bfraw*)(qr + j * 2)) * ns[j]; }
    (d ? sdenb : sdenf)[i] = rs + __expf((d ? sbb : sbf)[i]) * qn;
  }
  const int v0 = 2 * (wid & 1);
  f32x16 nf[2], nb[2], gf[2], gb[2];
#pragma unroll
  for (int t = 0; t < 2; ++t)
#pragma unroll
    for (int r = 0; r < 16; ++r) { nf[t][r] = 0.f; nb[t][r] = 0.f; gf[t][r] = 0.f; gb[t][r] = 0.f; }
  {
    const char* apf = sPf + (it * 32 + l31) * SSD_R128 + lh * 16;
    const char* apb = sPb + (it * 32 + l31) * SSD_R128 + lh * 16;
    const char* aq = sq + (it * 32 + l31) * SSD_R128 + lh * 16;
    const char* bv = svT + (v0 * 32 + l31) * SSD_R128 + lh * 16;
    const char* bc = sCs + (v0 * 32 + l31) * SSD_R128 + lh * 16;
#pragma unroll
    for (int ks = 0; ks < 4; ++ks) {
      const bf16x8 af = *(const bf16x8*)(apf + ks * 32), ab = *(const bf16x8*)(apb + ks * 32), qa = *(const bf16x8*)(aq + ks * 32);
      const bf16x8 b0 = *(const bf16x8*)(bv + ks * 32), b1 = *(const bf16x8*)(bv + 32 * SSD_R128 + ks * 32);
      const bf16x8 c0 = *(const bf16x8*)(bc + ks * 32), c1 = *(const bf16x8*)(bc + 32 * SSD_R128 + ks * 32);
      nf[0] = MFMA16(af, b0, nf[0]); nf[1] = MFMA16(af, b1, nf[1]);
      nb[0] = MFMA16(ab, b0, nb[0]); nb[1] = MFMA16(ab, b1, nb[1]);
      gf[0] = MFMA16(qa, c0, gf[0]); gf[1] = MFMA16(qa, c1, gf[1]);
    }
  }
  __syncthreads();
#pragma unroll
  for (int r = 0; r < 16; ++r) {
    const int i = it * 32 + ROW16(r, lh);
    const float ef = __expf(sbf[i]);
    const float idf = 1.f / fmaxf(fabsf(sdenf[i]), 1.f), idb = 1.f / fmaxf(fabsf(sdenb[i]), 1.f);
#pragma unroll
    for (int t = 0; t < 2; ++t) nf[t][r] = (nf[t][r] + ef * gf[t][r]) * idf + nb[t][r] * idb;
  }
#pragma unroll
  for (int u = 0; u < 4; ++u) { const int i = tid + 256 * u; *(u32x4g*)(sCs + (i >> 3) * SSD_R128 + (i & 7) * 16) = creg[u]; }
  __syncthreads();
  {
    const char* aq = sq + (it * 32 + l31) * SSD_R128 + lh * 16;
    const char* bc = sCs + (v0 * 32 + l31) * SSD_R128 + lh * 16;
#pragma unroll
    for (int ks = 0; ks < 4; ++ks) {
      const bf16x8 qa = *(const bf16x8*)(aq + ks * 32);
      gb[0] = MFMA16(qa, *(const bf16x8*)(bc + ks * 32), gb[0]);
      gb[1] = MFMA16(qa, *(const bf16x8*)(bc + 32 * SSD_R128 + ks * 32), gb[1]);
    }
  }
#pragma unroll
  for (int r = 0; r < 16; ++r) {
    const int i = it * 32 + ROW16(r, lh);
    const float eb = __expf(sbb[i]);
    const float idb = 1.f / fmaxf(fabsf(sdenb[i]), 1.f);
#pragma unroll
    for (int t = 0; t < 2; ++t)
      p.ml_h()[(size_t)(row0 + i) * 512 + h * 128 + (v0 + t) * 32 + l31] = nf[t][r] + eb * gb[t][r] * idb;
  }
}

__device__ __forceinline__ float gelu_tanh(float x) {
  const float k0 = 0.7978845608028654f;
  return 0.5f * x * (1.f + tanhf(k0 * (x + 0.044715f * x * x * x)));
}
__device__ __forceinline__ void s5_drive(const P& p, int dg, int row0, int dir, int g, int lane, float (&sre)[64], float (&sim)[64]) {
  const int l31 = lane & 31, lh = lane >> 5;
  bf16x8 ua[2];
#pragma unroll
  for (int tt = 0; tt < 2; ++tt) {
    const int tp = 32 * tt + l31;
    const int row = dir ? row0 + 63 - tp : row0 + tp;
    const float* zp = p.Z() + (size_t)row * NIN + ZC_U + g * 16 + 8 * lh;
    const float4 a = *(const float4*)zp, b = *(const float4*)(zp + 4);
    uint4 t; t.x = pack_bf16(a.x, a.y); t.y = pack_bf16(a.z, a.w); t.z = pack_bf16(b.x, b.y); t.w = pack_bf16(b.z, b.w);
    ua[tt] = __builtin_bit_cast(bf16x8, t);
  }
  bf16x8 bfr[4];
#pragma unroll
  for (int pt = 0; pt < 4; ++pt) bfr[pt] = *(const bf16x8*)(p.s5_bbh() + ((size_t)dg * 128 + 32 * pt + l31) * 16 + 8 * lh);
  f32x16 d[2][4];
#pragma unroll
  for (int tt = 0; tt < 2; ++tt)
#pragma unroll
    for (int pt = 0; pt < 4; ++pt) {
      f32x16 z;
#pragma unroll
      for (int r = 0; r < 16; ++r) z[r] = 0.f;
      d[tt][pt] = __builtin_amdgcn_mfma_f32_32x32x16_bf16(ua[tt], bfr[pt], z, 0, 0, 0);
    }
#pragma unroll
  for (int tt = 0; tt < 2; ++tt)
#pragma unroll
    for (int r = 0; r < 16; ++r) {
      const float myre = lh ? d[tt][1][r] : d[tt][0][r];
      const float myim = lh ? d[tt][3][r] : d[tt][2][r];
      const float gre = lh ? d[tt][0][r] : d[tt][1][r];
      const float gim = lh ? d[tt][2][r] : d[tt][3][r];
      const float ore = xor32(gre), oim = xor32(gim);
      const int tb = 32 * tt + 8 * (r >> 2) + (r & 3);
      sre[tb] = lh ? ore : myre; sre[tb + 4] = lh ? myre : ore;
      sim[tb] = lh ? oim : myim; sim[tb + 4] = lh ? myim : oim;
    }
}

__device__ __forceinline__ void s5_local_item(const P& p, int layer, int witem, char* smem) {
  int tid_ = threadIdx.x; asm volatile("" : "+v"(tid_));
  const int lane = tid_ & 63;
  const int g = witem & 31, st = (witem >> 5) % NSTEP, dir = (witem / (32 * NSTEP)) & 1, b = witem / (64 * NSTEP);
  const int cid = cid_of(st, dir), row0 = chunk_row0(b, cid);
  const int dg = (layer * 2 + dir) * 32 + g;
  float sre[64], sim[64];
  s5_drive(p, dg, row0, dir, g, lane, sre, sim);
  const float ar = p.s5_a()[(dg * 64 + lane) * 2], ai = p.s5_a()[(dg * 64 + lane) * 2 + 1];
  float xr = 0.f, xi = 0.f;
#pragma unroll
  for (int t = 0; t < 64; ++t) {
    const float nr = ar * xr - ai * xi + sre[t];
    const float ni = ar * xi + ai * xr + sim[t];
    xr = nr; xi = ni;
  }
  const size_t slot = ((size_t)((b * 2 + dir) * 32 + g) * NSTEP + st);
  p.s5_st()[(slot * 64 + lane) * 2] = xr; p.s5_st()[(slot * 64 + lane) * 2 + 1] = xi;
}

#define S5_XROW 272
__device__ __forceinline__ void s5_out_item(const P& p, int layer, int witem, char* smem) {
  int tid_ = threadIdx.x; asm volatile("" : "+v"(tid_));
  const int lane = tid_ & 63, wid = tid_ >> 6, l31 = lane & 31, lh = lane >> 5;
  char* sX = smem + wid * (64 * S5_XROW);
  const int g = witem & 31, cid = (witem >> 5) % NSTEP, b = witem / (32 * NSTEP);
  const int row0 = chunk_row0(b, cid);
  const bfraw* cmrow = p.s5_cmh() + ((size_t)(layer * 32 + g) * 32 + l31) * 128 + 8 * lh;
  f32x16 yf[2], yb[2];
#pragma unroll 1
  for (int dir = 0; dir < 2; ++dir) {
    const int st = step_of(cid, dir);
    const int dg = (layer * 2 + dir) * 32 + g;
    const size_t slot = ((size_t)((b * 2 + dir) * 32 + g) * NSTEP + st);
    float sre[64], sim[64];
    s5_drive(p, dg, row0, dir, g, lane, sre, sim);
    const float ar = p.s5_a()[(dg * 64 + lane) * 2], ai = p.s5_a()[(dg * 64 + lane) * 2 + 1];
    float xr = p.s5_st()[(slot * 64 + lane) * 2], xi = p.s5_st()[(slot * 64 + lane) * 2 + 1];
#pragma unroll
    for (int t = 0; t < 64; ++t) {
      const float nr = ar * xr - ai * xi + sre[t];
      const float ni = ar * xi + ai * xr + sim[t];
      xr = nr; xi = ni;
      *(bfraw*)(sX + t * S5_XROW + lane * 2) = to_bf16(xr);
      *(bfraw*)(sX + t * S5_XROW + 128 + lane * 2) = to_bf16(xi);
    }
    f32x16 y0, y1;
#pragma unroll
    for (int r = 0; r < 16; ++r) { y0[r] = 0.f; y1[r] = 0.f; }
    const char* ap = sX + l31 * S5_XROW + lh * 16;
#pragma unroll
    for (int ks = 0; ks < 8; ++ks) {
      const bf16x8 a0 = *(const bf16x8*)(ap + ks * 32);
      const bf16x8 a1 = *(const bf16x8*)(ap + 32 * S5_XROW + ks * 32);
      const bf16x8 cf = *(const bf16x8*)(cmrow + 16 * ks);
      y0 = __builtin_amdgcn_mfma_f32_32x32x16_bf16(a0, cf, y0, 0, 0, 0);
      y1 = __builtin_amdgcn_mfma_f32_32x32x16_bf16(a1, cf, y1, 0, 0, 0);
    }
    if (dir == 0) { yf[0] = y0; yf[1] = y1; } else { yb[0] = y0; yb[1] = y1; }
  }
  const float dsk = p.s5_d[layer * 512 + g * 16 + (l31 & 15)];
#pragma unroll
  for (int tt = 0; tt < 2; ++tt)
#pragma unroll
    for (int r = 0; r < 16; ++r) {
      const float ybv = xor32(yb[1 - tt][15 - r]);
      if (l31 < 16) {
        const int t = 32 * tt + ROW16(r, lh);
        const float u = p.Z()[(size_t)(row0 + t) * NIN + ZC_U + g * 16 + l31];
        const float gy = gelu_tanh(yf[tt][r] + ybv + dsk * u);
        const size_t o = (size_t)(row0 + t) * 512 + g * 16 + l31;
        p.ydpre()[o] = gy;
        p.ydpre_bf()[o] = to_bf16(gy);
      }
    }
}

#define N_SSD_CH (2 * NSTEP * 8)
#define N_ML_CH (2 * NSTEP * 4)
#define N_S5_BLK (2 * 2 * NSTEP * 32 / 4)
__device__ __forceinline__ void ph_mixA(const P& p, int layer, int bid, char* smem) {
  FOR_ITEMS(w, N_SSD_CH + N_ML_CH + N_S5_BLK, bid) {
    if (w < N_SSD_CH) ssd_local_item(p, layer, w, smem);
    else if (w < N_SSD_CH + N_ML_CH) ml_local_item(p, layer, w - N_SSD_CH, smem);
    else { __syncthreads(); s5_local_item(p, layer, (w - N_SSD_CH - N_ML_CH) * 4 + (otid() >> 6), smem); }
  }
}
#define N_ATT_LAT 256
#define N_ATT_CTX 16
__device__ __forceinline__ void ph_scan(const P& p, int layer, int bid, char* smem) {
  const int nitems = 256 + 128 + 4 + 32;
  const int tid = otid();
  for (int w = bid; w < nitems; w += gridDim.x) {
    int it = w;
    if (it < 256) {
      const int idx = it * 256 + tid, seq = idx >> 11, off = idx & 2047;
      uint2* base = (uint2*)(p.ssd_st() + (size_t)seq * NSTEP * 8192) + off;
      const float* at = p.ssd_atot() + seq * NSTEP;
      float4 hh = make_float4(0.f, 0.f, 0.f, 0.f);
#pragma unroll 4
      for (int s2 = 0; s2 < NSTEP; ++s2) {
        const uint2 tb = base[(size_t)s2 * 2048];
        uint2 ob; ob.x = pack_bf16(hh.x, hh.y); ob.y = pack_bf16(hh.z, hh.w);
        base[(size_t)s2 * 2048] = ob;
        const float e = expf(at[s2]);
        hh.x = e * hh.x + __uint_as_float(tb.x << 16); hh.y = e * hh.y + __uint_as_float(tb.x & 0xffff0000u);
        hh.z = e * hh.z + __uint_as_float(tb.y << 16); hh.w = e * hh.w + __uint_as_float(tb.y & 0xffff0000u);
      }
      continue;
    }
    it -= 256;
    if (it < 128) {
      const int idx = it * 256 + tid, seq = idx >> 11, off = idx & 2047;
      uint2* base = (uint2*)(p.ml_st() + (size_t)seq * NSTEP * 8192) + off;
      const float* at = p.ml_gtot() + seq * NSTEP;
      float4 hh = make_float4(0.f, 0.f, 0.f, 0.f);
#pragma unroll 4
      for (int s2 = 0; s2 < NSTEP; ++s2) {
        const uint2 tb = base[(size_t)s2 * 2048];
        uint2 ob; ob.x = pack_bf16(hh.x, hh.y); ob.y = pack_bf16(hh.z, hh.w);
        base[(size_t)s2 * 2048] = ob;
        const float e = expf(at[s2]);
        hh.x = e * hh.x + __uint_as_float(tb.x << 16); hh.y = e * hh.y + __uint_as_float(tb.x & 0xffff0000u);
        hh.z = e * hh.z + __uint_as_float(tb.y << 16); hh.w = e * hh.w + __uint_as_float(tb.y & 0xffff0000u);
      }
      continue;
    }
    it -= 128;
    if (it < 4) {
      const int idx = it * 256 + tid, seq = idx >> 6, off = idx & 63;
      float* base = p.ml_nst() + (size_t)seq * NSTEP * 64 + off;
      const float* at = p.ml_gtot() + seq * NSTEP;
      float hh = 0.f;
      for (int s2 = 0; s2 < NSTEP; ++s2) {
        float t = base[s2 * 64]; base[s2 * 64] = hh;
        hh = expf(at[s2]) * hh + t;
      }
      continue;
    }
    it -= 4;
    {
      const int idx = it * 256 + tid, seq = idx >> 6, sp = idx & 63;
      const int g = seq & 31, dir = (seq >> 5) & 1;
      const int dg = (layer * 2 + dir) * 32 + g;
      float pr = p.s5_a()[(dg * 64 + sp) * 2], pi = p.s5_a()[(dg * 64 + sp) * 2 + 1];
#pragma unroll
      for (int q = 0; q < 6; ++q) { float nr = pr * pr - pi * pi, ni = 2.f * pr * pi; pr = nr; pi = ni; }
      float* base = p.s5_st() + ((size_t)seq * NSTEP * 64 + sp) * 2;
      float xr = 0.f, xi = 0.f;
      for (int s2 = 0; s2 < NSTEP; ++s2) {
        float tr = base[s2 * 128], ti = base[s2 * 128 + 1];
        base[s2 * 128] = xr; base[s2 * 128 + 1] = xi;
        float nr = pr * xr - pi * xi + tr, ni = pr * xi + pi * xr + ti;
        xr = nr; xi = ni;
      }
    }
  }
}
__device__ __forceinline__ void ph_attn(const P& p, int layer, int bid, char* smem) {
  const int natt = 512 + (layer == 0 ? 32 : 0);
  FOR_ITEMS(w, natt, bid) {
    int it = w;
    const bfraw *qp, *kp, *vp; int nk, row0, hh, part;
    if (it < 512) {
      part = it & 1; const int qb = (it >> 1) & 31; hh = (it >> 6) & 3; const int b = it >> 8;
      qp = p.Q() + ((size_t)(b * 4 + hh) * SL + qb * 128) * 192;
      kp = p.K() + ((size_t)(b * 4 + hh) * NKEY + part * (NKEY / 2)) * 192;
      vp = p.V() + (size_t)(b * 4 + hh) * 128 * NKEY + part * (NKEY / 2);
      nk = NKEY / 2; row0 = b * SL + qb * 128;
    } else {
      it -= 512;
      part = it & 1; const int qb = (it >> 1) & 1; hh = (it >> 2) & 3; const int b = it >> 4;
      qp = p.Qc() + ((size_t)(b * 4 + hh) * CL + qb * 128) * 192;
      kp = p.K() + ((size_t)(b * 4 + hh) * NKEY + SL + part * (CL / 2)) * 192;
      vp = p.V() + (size_t)(b * 4 + hh) * 128 * NKEY + SL + part * (CL / 2);
      nk = CL / 2; row0 = TLAT + b * CL + qb * 128;
    }
    float* op = (part ? p.O2() : p.O()) + (size_t)row0 * 512 + hh * 128;
    float* ml = p.attn_ml() + ((size_t)(part * 4 + hh) * TTOT + row0) * 2;
    attn_item(qp, kp, vp, nk, op, ml, smem);
  }
}
__device__ __forceinline__ void ph_mixC(const P& p, int layer, int bid, char* smem) {
  FOR_ITEMS(w, N_SSD_CH + N_ML_CH + N_S5_BLK / 2, bid) {
    if (w < N_SSD_CH) ssd_out_item(p, layer, w, smem);
    else if (w < N_SSD_CH + N_ML_CH) ml_out_item(p, layer, w - N_SSD_CH, smem);
    else { __syncthreads(); s5_out_item(p, layer, (w - N_SSD_CH - N_ML_CH) * 4 + (otid() >> 6), smem); }
  }
}

__device__ __forceinline__ void ph_glu(const P& p, int layer, int bid, char* smem) {
  const float* yp = p.ydpre(); float* yg = p.ydg(); const float* gb = p.glu_b + layer * 512;
  auto epi = [=](int row, int col, float v) {
    float y = yp[(size_t)row * 512 + col];
    yg[(size_t)row * 512 + col] = y * sigmoidf_(v + gb[col]);
  };
  gemm_dense<2>(p.ydpre_bf(), 512, p.wgluT() + (size_t)layer * 512 * 512, layer == 0 ? TTOT : TLAT, 512, 512, epi, bid, smem);
}

__device__ __forceinline__ void ph_final_mix(const P& p, int layer, int bid, char* smem) {
  const int tid = otid(), lane = tid & 63, wid = tid >> 6;
  const float* onw = p.out_norm_w + layer * 2048;
  const int nrows = layer == 0 ? TTOT : TLAT;
  for (int rpb_ = (nrows % (int)gridDim.x) == 0 ? nrows / (int)gridDim.x : 0, i_ = wid, r = rpb_ ? bid * rpb_ + i_ : bid * 4 + wid;
       rpb_ ? i_ < rpb_ : r < nrows; i_ += 4, r = rpb_ ? bid * rpb_ + i_ : r + (int)gridDim.x * 4) {
    const float* z = p.Z() + (size_t)r * NIN;
    bfraw* Y = p.Y() + (size_t)r * LDH;
    const int c = lane * 8;
    f32x4v a0 = *(const f32x4v*)(p.O() + (size_t)r * 512 + c), a1 = *(const f32x4v*)(p.O() + (size_t)r * 512 + c + 4);
    {
      const f32x4v b0 = *(const f32x4v*)(p.O2() + (size_t)r * 512 + c), b1 = *(const f32x4v*)(p.O2() + (size_t)r * 512 + c + 4);
      const float2 ml0 = *(const float2*)(p.attn_ml() + ((size_t)(lane >> 4) * TTOT + r) * 2);
      const float2 ml1 = *(const float2*)(p.attn_ml() + ((size_t)(4 + (lane >> 4)) * TTOT + r) * 2);
      const float mm = fmaxf(ml0.x, ml1.x);
      const float w0 = exp2f(ml0.x - mm), w1 = exp2f(ml1.x - mm);
      const float inv = 1.f / (ml0.y * w0 + ml1.y * w1);
      a0 = (a0 * w0 + b0 * w1) * inv; a1 = (a1 * w0 + b1 * w1) * inv;
    }
    f32x4v y0 = *(const f32x4v*)(p.ssd_y() + (size_t)r * 512 + c), y1 = *(const f32x4v*)(p.ssd_y() + (size_t)r * 512 + c + 4);
    f32x4v x0 = *(const f32x4v*)(p.ssd_xs() + (size_t)r * 512 + c), x1 = *(const f32x4v*)(p.ssd_xs() + (size_t)r * 512 + c + 4);
    f32x4v g0 = *(const f32x4v*)(z + ZC_BZ + c), g1 = *(const f32x4v*)(z + ZC_BZ + c + 4);
    f32x4v h0 = *(const f32x4v*)(p.ml_h() + (size_t)r * 512 + c), h1 = *(const f32x4v*)(p.ml_h() + (size_t)r * 512 + c + 4);
    f32x4v o0 = *(const f32x4v*)(z + ZC_MO + c), o1 = *(const f32x4v*)(z + ZC_MO + c + 4);
    f32x4v d0 = *(const f32x4v*)(p.ydg() + (size_t)r * 512 + c), d1 = *(const f32x4v*)(p.ydg() + (size_t)r * 512 + c + 4);
    const float dsk = p.ssd_d[layer * 8 + (c >> 6)];
    float sa = 0.f, sb = 0.f, sc = 0.f, sd = 0.f;
    float bv[8], av[8], cv[8], dv[8];
#pragma unroll
    for (int i = 0; i < 4; ++i) {
      av[i] = a0[i]; av[4 + i] = a1[i];
      bv[i] = (y0[i] + dsk * x0[i]) * siluf_(g0[i]); bv[4 + i] = (y1[i] + dsk * x1[i]) * siluf_(g1[i]);
      cv[i] = h0[i]; cv[4 + i] = h1[i];
      dv[i] = d0[i]; dv[4 + i] = d1[i];
    }
#pragma unroll
    for (int i = 0; i < 8; ++i) { sa += av[i] * av[i]; sb += bv[i] * bv[i]; sc += cv[i] * cv[i]; sd += dv[i] * dv[i]; }
    sa = wave_sum(sa); sb = wave_sum(sb); sd = wave_sum(sd);
    sc = row16_sum(sc);
    const float ra = rsqrtf(sa * (1.f / 512.f) + EPSV), rb = rsqrtf(sb * (1.f / 512.f) + EPSV);
    const float rc = rsqrtf(sc * (1.f / 128.f) + EPSV), rd = rsqrtf(sd * (1.f / 512.f) + EPSV);
    float ogv[8];
#pragma unroll
    for (int i = 0; i < 4; ++i) { ogv[i] = sigmoidf_(o0[i]); ogv[4 + i] = sigmoidf_(o1[i]); }
    uint4 ua, ub, uc, ud;
    const float* w = onw + c;
    ua.x = pack_bf16(av[0] * ra * w[0], av[1] * ra * w[1]); ua.y = pack_bf16(av[2] * ra * w[2], av[3] * ra * w[3]);
    ua.z = pack_bf16(av[4] * ra * w[4], av[5] * ra * w[5]); ua.w = pack_bf16(av[6] * ra * w[6], av[7] * ra * w[7]);
    w = onw + 512 + c;
    ub.x = pack_bf16(bv[0] * rb * w[0], bv[1] * rb * w[1]); ub.y = pack_bf16(bv[2] * rb * w[2], bv[3] * rb * w[3]);
    ub.z = pack_bf16(bv[4] * rb * w[4], bv[5] * rb * w[5]); ub.w = pack_bf16(bv[6] * rb * w[6], bv[7] * rb * w[7]);
    w = onw + 1024 + c;
    uc.x = pack_bf16(cv[0] * rc * ogv[0] * w[0], cv[1] * rc * ogv[1] * w[1]); uc.y = pack_bf16(cv[2] * rc * ogv[2] * w[2], cv[3] * rc * ogv[3] * w[3]);
    uc.z = pack_bf16(cv[4] * rc * ogv[4] * w[4], cv[5] * rc * ogv[5] * w[5]); uc.w = pack_bf16(cv[6] * rc * ogv[6] * w[6], cv[7] * rc * ogv[7] * w[7]);
    w = onw + 1536 + c;
    ud.x = pack_bf16(dv[0] * rd * w[0], dv[1] * rd * w[1]); ud.y = pack_bf16(dv[2] * rd * w[2], dv[3] * rd * w[3]);
    ud.z = pack_bf16(dv[4] * rd * w[4], dv[5] * rd * w[5]); ud.w = pack_bf16(dv[6] * rd * w[6], dv[7] * rd * w[7]);
    store16_wt(Y + c, __builtin_bit_cast(u32x4wt, ua)); store16_wt(Y + 512 + c, __builtin_bit_cast(u32x4wt, ub));
    store16_wt(Y + 1024 + c, __builtin_bit_cast(u32x4wt, uc)); store16_wt(Y + 1536 + c, __builtin_bit_cast(u32x4wt, ud));
  }
}

__device__ __forceinline__ void ph_wout(const P& p, int layer, int bid, char* smem) {
  const P pp = p;
  const int M = layer == 0 ? TTOT : TLAT;
  auto epi = [=](int row, int col, float v) {
    const int mi = row_modidx(row);
    const float g1 = pp.modv()[(layer * 3 + mi) * 12288 + 2 * 2048 + col];
    float xin;
    if (layer == 0) xin = row < TLAT ? pp.x[(size_t)row * 2048 + col] : pp.ctx[(size_t)(row - TLAT) * 2048 + col];
    else xin = pp.X()[(size_t)row * 2048 + col];
    pp.X()[(size_t)row * 2048 + col] = xin + g1 * v;
  };
  gemm_dense<2>(p.Y(), LDH, p.woutT() + (size_t)layer * 2048 * 2048, M, 2048, 2048, epi, bid, smem);
}

__device__ __forceinline__ void ph_router(const P& p, int layer, int bid, char* smem) {
  float* sA = (float*)smem;
  float* sW = sA + 16 * 129;
  float* sNW = sW + 128 * 64;
  float* sSH = sNW + 2048;
  float* srs = sSH + 2048;
  float* sL = sW;
  const int tid = otid(), lane = tid & 63, wid = tid >> 6, l15 = lane & 15, l4 = lane >> 4;
  const int T = layer == 0 ? TTOT : TLAT;
  const float* nw = p.norm2_w + layer * 2048;
  const float* wg = p.w_group + (size_t)layer * 2048 * 4;
  const float* we = p.w_expert + (size_t)layer * 2048 * 32;
  typedef float f32x4a __attribute__((ext_vector_type(4)));
  __syncthreads();
  for (int i = tid; i < 128 * 28; i += 256) sW[(i / 28) * 64 + 36 + (i % 28)] = 0.f;
  const int ar = tid >> 4, aks = (tid & 15) * 8;
  const int wk = tid >> 1, whalf = tid & 1;
  FOR_ITEMS(item, (T >> 4), bid) {
    const int row0 = item * 16;
    const int mi = row_modidx(row0);
    const float* mrow = p.modv() + (layer * 3 + mi) * 12288;
    __syncthreads();
    for (int i = tid; i < 2048; i += 256) { sNW[i] = nw[i] * (1.f + mrow[4 * 2048 + i]); sSH[i] = mrow[3 * 2048 + i]; }
#pragma unroll 2
    for (int rr = 0; rr < 4; ++rr) {
      const float* xr = p.X() + (size_t)(row0 + wid * 4 + rr) * 2048 + lane * 4;
      float ss = 0.f;
#pragma unroll
      for (int i = 0; i < 8; ++i) { float4 v = *(const float4*)(xr + i * 256); ss += v.x * v.x + v.y * v.y + v.z * v.z + v.w * v.w; }
      ss = wave_sum(ss);
      if (lane == 0) srs[wid * 4 + rr] = rsqrtf(ss * (1.f / 2048.f) + EPSV);
    }
    __syncthreads();
    const float rs = srs[ar];
    const float* xrow = p.X() + (size_t)(row0 + ar) * 2048 + aks;
    bfraw* hrow = p.H() + (size_t)(row0 + ar) * LDH + aks;
    float4 xa0, xa1, wv0, wv1, wv2, wv3, wv4;
#define RT_GLOAD(k0)                                                                                   \
    {                                                                                                  \
      xa0 = *(const float4*)(xrow + (k0)); xa1 = *(const float4*)(xrow + (k0) + 4);                    \
      const float* er = we + (size_t)((k0) + wk) * 32 + (whalf ? 12 : 0);                              \
      wv0 = *(const float4*)(er); wv1 = *(const float4*)(er + 4); wv2 = *(const float4*)(er + 8);      \
      wv3 = *(const float4*)(er + 12); wv4 = *(const float4*)(er + 16);                                \
      if (!whalf) wv3 = *(const float4*)(wg + (size_t)((k0) + wk) * 4);                                \
    }
#define RT_A4(q, v)                                                                                    \
    {                                                                                                  \
      const int kq_ = (k0w) + aks + (q) * 4;                                                           \
      float h0 = v.x * rs * sNW[kq_] + sSH[kq_], h1 = v.y * rs * sNW[kq_ + 1] + sSH[kq_ + 1];          \
      float h2 = v.z * rs * sNW[kq_ + 2] + sSH[kq_ + 2], h3 = v.w * rs * sNW[kq_ + 3] + sSH[kq_ + 3];  \
      float* d = sA + ar * 129 + aks + (q) * 4; d[0] = h0; d[1] = h1; d[2] = h2; d[3] = h3;            \
      uint2 hb; hb.x = pack_bf16(h0, h1); hb.y = pack_bf16(h2, h3);                                    \
      *(uint2*)(hrow + (k0w) + (q) * 4) = hb;                                                          \
    }
#define RT_SWRITE()                                                                                    \
    {                                                                                                  \
      RT_A4(0, xa0) RT_A4(1, xa1)                                                                      \
      float* w = sW + wk * 64;                                                                         \
      if (!whalf) {                                                                                    \
        w[0] = wv3.x; w[1] = wv3.y; w[2] = wv3.z; w[3] = wv3.w;                                        \
        w[4] = wv0.x; w[5] = wv0.y; w[6] = wv0.z; w[7] = wv0.w; w[8] = wv1.x; w[9] = wv1.y; w[10] = wv1.z; w[11] = wv1.w; \
        w[12] = wv2.x; w[13] = wv2.y; w[14] = wv2.z; w[15] = wv2.w;                                    \
      } else {                                                                                         \
        w[16] = wv0.x; w[17] = wv0.y; w[18] = wv0.z; w[19] = wv0.w; w[20] = wv1.x; w[21] = wv1.y; w[22] = wv1.z; w[23] = wv1.w; \
        w[24] = wv2.x; w[25] = wv2.y; w[26] = wv2.z; w[27] = wv2.w; w[28] = wv3.x; w[29] = wv3.y; w[30] = wv3.z; w[31] = wv3.w; \
        w[32] = wv4.x; w[33] = wv4.y; w[34] = wv4.z; w[35] = wv4.w;                                    \
      }                                                                                                \
    }
    int k0w = 0;
    RT_GLOAD(0)
    RT_SWRITE()
    __syncthreads();
    f32x4a acc0 = {0.f, 0.f, 0.f, 0.f}, acc1 = acc0, acc2 = acc0;
    const float* ap = sA + l15 * 129 + wid * 32 + l4;
    const float* bp = sW + (wid * 32 + l4) * 64 + l15;
    for (int k0 = 0; k0 < 2048; k0 += 128) {
      const bool more = (k0 + 128) < 2048;
      if (more) RT_GLOAD(k0 + 128)
#pragma unroll
      for (int ks = 0; ks < 8; ++ks) {
        const float a = ap[4 * ks];
        const float* bq = bp + 4 * ks * 64;
        acc0 = __builtin_amdgcn_mfma_f32_16x16x4f32(a, bq[0], acc0, 0, 0, 0);
        acc1 = __builtin_amdgcn_mfma_f32_16x16x4f32(a, bq[16], acc1, 0, 0, 0);
        acc2 = __builtin_amdgcn_mfma_f32_16x16x4f32(a, bq[32], acc2, 0, 0, 0);
      }
      __syncthreads();
      k0w = k0 + 128;
      if (more) RT_SWRITE()
      __syncthreads();
    }
#pragma unroll
    for (int r = 0; r < 4; ++r) {
      float* d = sL + (wid * 16 + 4 * l4 + r) * 64 + l15;
      d[0] = acc0[r]; d[16] = acc1[r]; d[32] = acc2[r];
    }
    __syncthreads();
    if (tid < 16) {
      const int r = row0 + tid;
      float lg[36];
#pragma unroll
      for (int j = 0; j < 36; ++j) lg[j] = sL[(0 * 16 + tid) * 64 + j] + sL[(1 * 16 + tid) * 64 + j] + sL[(2 * 16 + tid) * 64 + j] + sL[(3 * 16 + tid) * 64 + j];
      int gi = 0; float gm = lg[0];
#pragma unroll
      for (int j = 1; j < 4; ++j) if (lg[j] > gm) { gm = lg[j]; gi = j; }
      float gs = 0.f;
#pragma unroll
      for (int j = 0; j < 4; ++j) gs += expf(lg[j] - gm);
      const float gw = 1.f / gs;
      int i1 = 0, i2 = -1; float v1 = -INFINITY, v2 = -INFINITY;
#pragma unroll
      for (int j = 0; j < 8; ++j) {
        const float e = gi == 0 ? lg[4 + j] : (gi == 1 ? lg[12 + j] : (gi == 2 ? lg[20 + j] : lg[28 + j]));
        if (e > v1) { v2 = v1; i2 = i1; v1 = e; i1 = j; }
        else if (e > v2) { v2 = e; i2 = j; }
      }
      const float e2 = expf(v2 - v1);
      const float w1 = gw / (1.f + e2), w2 = gw * e2 / (1.f + e2);
      const int ex1 = gi * 8 + i1, ex2 = gi * 8 + i2;
      int* cnt = p.cnt() + layer * 32;
      const int p1 = atomicAdd(&cnt[ex1], 1);
      p.list_tok()[ex1 * CAPE + p1] = r * 2; p.list_w()[ex1 * CAPE + p1] = w1;
      const int p2 = atomicAdd(&cnt[ex2], 1);
      p.list_tok()[ex2 * CAPE + p2] = r * 2 + 1; p.list_w()[ex2 * CAPE + p2] = w2;
    }
  }
}

struct AGather { const bfraw* H; const int* toks; int nvalid;
  __device__ __forceinline__ const bfraw* row(int r) const { return r < nvalid ? H + (size_t)(toks[r] >> 1) * LDH : nullptr; }
  __device__ __forceinline__ const bfraw* safe() const { return H; } };
struct BGateUp { static constexpr bool kT = false; const float *g, *u; int ldb; int nb;
  __device__ __forceinline__ const float* col(int v) const { int wc = v >> 6, j = (v >> 5) & 1, c = v & 31;
    const float* b = g + (ptrdiff_t)j * (u - g); return b + nb + wc * 32 + c; }
  __device__ __forceinline__ const float* safe() const { return g; } };

__device__ __forceinline__ void moe_prefix(const P& p, int layer, int* spre) {
  __syncthreads();
  if (otid() == 0) {
    int acc = 0;
    for (int e = 0; e < 32; ++e) { spre[e] = acc; acc += (p.cnt()[layer * 32 + e] + 127) >> 7; }
    spre[32] = acc;
  }
  __syncthreads();
}
template <int MI>
__device__ __forceinline__ void moe_up_tile(const P& p, int layer, int e, int row0, int cnt, int arow0, int nt, char* smem) {
  AGather af{p.H(), p.list_tok() + e * CAPE + row0, cnt - row0};
  const size_t wo = ((size_t)layer * 32 + e) * 2048 * 512;
  BGateUp bf{p.w_gate + wo, p.w_up + wo, 512, nt * 64};
  bfraw* act = p.ACT() + (size_t)arow0 * LDACT + nt * 64;
  auto ef = [&](const f32x16 (&acc)[MI][2], int wr, int wc, int lane) {
#pragma unroll
    for (int i = 0; i < MI; ++i)
#pragma unroll
      for (int r = 0; r < 16; ++r) {
        int row = ACC_ROWM(MI, wr, i, r, lane);
        float gv = acc[i][0][r], uv = acc[i][1][r];
        act[(size_t)row * LDACT + wc * 32 + (lane & 31)] = to_bf16(siluf_(gv) * uv);
      }
  };
  gemm_tile<MI>(af, bf, ef, 2048, smem);
}
#define MOE_FIND(spre, t) __builtin_amdgcn_readfirstlane(__popcll(__ballot((otid() & 63) < 31 && (spre)[(otid() & 63) + 1] <= (t))))
__device__ __forceinline__ void ph_moe_up(const P& p, int layer, int bid, char* smem) {
  int* spre = (int*)(smem + 65536);
  moe_prefix(p, layer, spre);
  const int n = spre[32] * 8, G = (int)gridDim.x, nfull = n / G, R = n - nfull * G;
  for (int k = 0; k < nfull; ++k) {
    const int w = k * G + bid, rbg = w >> 3, nt = w & 7;
    const int e = MOE_FIND(spre, rbg);
    const int rb = rbg - spre[e];
    moe_up_tile<2>(p, layer, e, rb * 128, p.cnt()[layer * 32 + e], rbg * 128, nt, smem);
  }
  if (R * 2 <= G) {
    FOR_ITEMS(w2, R * 2, bid) {
      const int w = nfull * G + (w2 >> 1), rbg = w >> 3, nt = w & 7, h = w2 & 1;
      const int e = MOE_FIND(spre, rbg);
      const int rb = rbg - spre[e];
      moe_up_tile<1>(p, layer, e, rb * 128 + h * 64, p.cnt()[layer * 32 + e], rbg * 128 + h * 64, nt, smem);
    }
  } else {
    const int w = sched_item(nfull, n, bid);
    if (w >= 0) {
      const int rbg = w >> 3, nt = w & 7;
      const int e = MOE_FIND(spre, rbg);
      const int rb = rbg - spre[e];
      moe_up_tile<2>(p, layer, e, rb * 128, p.cnt()[layer * 32 + e], rbg * 128, nt, smem);
    }
  }
}
__device__ __forceinline__ void ph_moe_down(const P& p, int layer, int bid, char* smem) {
  int* spre = (int*)(smem + 65536);
  moe_prefix(p, layer, spre);
  const int ntile = spre[32];
  FOR_ITEMS(w, ntile * 16, bid) {
    const int rbg = w >> 4, nt = w & 15;
    const int e = MOE_FIND(spre, rbg);
    const int rb = rbg - spre[e];
    const int nvalid = p.cnt()[layer * 32 + e] - rb * 128;
    ARows af{p.ACT() + (size_t)rbg * 128 * LDACT, LDACT, 0, 128};
    BPlain bf{p.w_down + ((size_t)layer * 32 + e) * 512 * 2048, 2048, nt * 128, 2048};
    const int* toks = p.list_tok() + e * CAPE + rb * 128;
    const float* lw = p.list_w() + e * CAPE + rb * 128;
    bfraw* Ys = p.Yslot();
    auto ef = [&](const f32x16 (&acc)[2][2], int wr, int wc, int lane) {
#pragma unroll
      for (int i = 0; i < 2; ++i)
#pragma unroll
        for (int r = 0; r < 16; ++r) {
          int row = ACC_ROW(wr, i, r, lane);
          if (row < nvalid) {
            int ts = toks[row]; float wgt = lw[row];
#pragma unroll
            for (int j = 0; j < 2; ++j) Ys[(size_t)ts * 2048 + nt * 128 + ACC_COL(wc, j, lane)] = to_bf16(wgt * acc[i][j][r]);
          }
        }
    };
    gemm_tile<2>(af, bf, ef, 512, smem);
  }
}

__device__ __forceinline__ void ph_out(const P& p, int bid, char* smem) {
  const int tid = otid(), lane = tid & 63, wid = tid >> 6;
  for (int r = bid * 4 + wid; r < TLAT; r += gridDim.x * 4) {
    const int mi = r >> 12;
    const float* g2 = p.modv() + (1 * 3 + mi) * 12288 + 5 * 2048;
    f32x4v v[8];
    float ss = 0.f;
#pragma unroll
    for (int q = 0; q < 8; ++q) {
      const int col = q * 256 + lane * 4;
      f32x4v xv = *(const f32x4v*)(p.X() + (size_t)r * 2048 + col);
      const f32x4v gv = *(const f32x4v*)(g2 + col);
      const f32x4v y0 = ld_bf16x4(p.Yslot() + (size_t)(2 * r) * 2048 + col);
      const f32x4v y1 = ld_bf16x4(p.Yslot() + (size_t)(2 * r + 1) * 2048 + col);
      xv += gv * (y0 + y1);
      v[q] = xv;
      ss += xv[0] * xv[0] + xv[1] * xv[1] + xv[2] * xv[2] + xv[3] * xv[3];
    }
    ss = wave_sum(ss);
    const float rs = rsqrtf(ss * (1.f / 2048.f) + EPSV);
#pragma unroll
    for (int q = 0; q < 8; ++q) {
      const int col = q * 256 + lane * 4;
      const f32x4v w4 = *(const f32x4v*)(p.final_w + col);
      *(f32x4v*)(p.out + (size_t)r * 2048 + col) = v[q] * rs * w4;
    }
  }
}

#define SMEM_BYTES 81792
#define XB_TMO      128
#define XB_XCNT(j)  (256  + 64 * (j))
#define XB_XSUB(j)  (1280 + 64 * (j))
#define XB_XGEN(j)  (2304 + 64 * (j))
#define XB_TOP      3328
#define XB_TOPGEN   3392
#define XB_SPIN_CAP (1u << 22)
#define LAS __attribute__((address_space(3)))
__device__ __forceinline__ unsigned xb_ld(unsigned* p)              { return __hip_atomic_load(p, __ATOMIC_RELAXED, __HIP_MEMORY_SCOPE_AGENT); }
__device__ __forceinline__ unsigned xb_add(unsigned* p, unsigned v) { return __hip_atomic_fetch_add(p, v, __ATOMIC_RELAXED, __HIP_MEMORY_SCOPE_AGENT); }
__device__ __forceinline__ unsigned xb_xcc_id() { return (unsigned)__builtin_amdgcn_s_getreg((3 << 11) | 20) & 0xFu; }
#define XB_SPIN(cond, bar) do { unsigned _sp = 0; while (cond) { __builtin_amdgcn_s_sleep(1); \
    if ((++_sp & 255u) == 0u) { if (xb_ld(&(bar)[XB_TMO])) break; if (_sp > XB_SPIN_CAP) { atomicAdd(&(bar)[XB_TMO], 1u); break; } } } } while (0)
struct XcdBarrier { unsigned* bar; unsigned x; unsigned rank; volatile LAS unsigned* st; };
__device__ __forceinline__ XcdBarrier xcd_barrier_post(unsigned* bar, volatile LAS unsigned* st) {
    XcdBarrier b; b.bar = bar; b.x = xb_xcc_id(); b.st = st;
    b.rank = 0u;
    if (threadIdx.x == 0) b.rank = xb_add(&bar[XB_XCNT(b.x)], 1u);
    return b;
}
__device__ __forceinline__ void xcd_barrier_complete(unsigned* bar, unsigned x, unsigned& nloc, unsigned& nx) {
    const unsigned G = gridDim.x * gridDim.y * gridDim.z;
    unsigned sum, cnt, mine, sp = 0u;
    for (;;) {
        sum = 0u; cnt = 0u; mine = 0u;
#pragma unroll
        for (unsigned j = 0; j < 16; ++j) { const unsigned c = xb_ld(&bar[XB_XCNT(j)]); sum += c; cnt += (c > 0u) ? 1u : 0u; mine = (j == x) ? c : mine; }
        if (sum == G) break;
        __builtin_amdgcn_s_sleep(1);
        if ((++sp & 255u) == 0u) { if (xb_ld(&bar[XB_TMO])) break; if (sp > XB_SPIN_CAP) { atomicAdd(&bar[XB_TMO], 1u); break; } }
    }
    nloc = mine > 0u ? mine : 1u; nx = cnt > 0u ? cnt : 1u;
}
__device__ __forceinline__ void xcd_barrier(const XcdBarrier& b) {
    asm volatile("s_waitcnt vmcnt(0)" ::: "memory");
    __syncthreads();
    if (threadIdx.x == 0) {
        unsigned* bar = b.bar;
        __builtin_amdgcn_s_waitcnt(0);
        unsigned nloc = b.st[0], nx = b.st[1];
        if (nloc == 0u) { xcd_barrier_complete(bar, b.x, nloc, nx); b.st[0] = nloc; b.st[1] = nx; }
        const unsigned old = xb_add(&bar[XB_XSUB(b.x)], 1u);
        const unsigned gen = old / nloc;
        if (old + 1u == (gen + 1u) * nloc) {
            __builtin_amdgcn_fence(__ATOMIC_RELEASE, "agent");
            asm volatile("s_waitcnt vmcnt(0)" ::: "memory");
            const unsigned og = xb_add(&bar[XB_TOP], 1u);
            const unsigned tg = og / nx;
            if (og + 1u == (tg + 1u) * nx) xb_add(&bar[XB_TOPGEN], 1u);
            else XB_SPIN(xb_ld(&bar[XB_TOPGEN]) == tg, bar);
            __builtin_amdgcn_fence(__ATOMIC_ACQUIRE, "agent");
            xb_add(&bar[XB_XGEN(b.x)], 1u);
            asm volatile("s_waitcnt vmcnt(0)" ::: "memory");
        } else {
            XB_SPIN(xb_ld(&bar[XB_XGEN(b.x)]) == gen, bar);
            __builtin_amdgcn_fence(__ATOMIC_ACQUIRE, "agent");
            asm volatile("s_waitcnt vmcnt(0)" ::: "memory");
        }
    }
    __syncthreads();
}

__global__ void __launch_bounds__(256, 2) k_fused(P p, unsigned* bar) {
  extern __shared__ __attribute__((aligned(16))) char smem_all[];
  char* smem = smem_all + 64;
  if (threadIdx.x == 0) *(uint4*)smem_all = make_uint4(0u, 0u, 0u, 0u);
  __syncthreads();
  XcdBarrier b = xcd_barrier_post(bar, (volatile LAS unsigned*)smem_all);
#define LAYER_PROGRAM(L)                                                              \
  {                                                                                   \
    ph_norm1(p, L, bid, smem); xcd_barrier(b);          \
    ph_win(p, L, bid, smem); xcd_barrier(b);                          \
    ph_prep(p, L, bid, smem); xcd_barrier(b);           \
    ph_qkv(p, L, bid, smem); ph_mixA(p, L, bid, smem); xcd_barrier(b);     \
    ph_attn(p, L, bid, smem); ph_scan(p, L, bid, smem); xcd_barrier(b);    \
    ph_mixC(p, L, bid, smem); xcd_barrier(b);             \
    ph_glu(p, L, bid, smem); xcd_barrier(b);                                \
    ph_final_mix(p, L, bid, smem); xcd_barrier(b);      \
    ph_wout(p, L, bid, smem); xcd_barrier(b);                \
    ph_router(p, L, bid, smem); xcd_barrier(b);         \
    ph_moe_up(p, L, bid, smem); xcd_barrier(b);                    \
    ph_moe_down(p, L, bid, smem); xcd_barrier(b);       \
  }
  ph_mod(p, smem); ph_wprep(p, blockIdx.x, smem); xcd_barrier(b);
  if (threadIdx.x == 0) {
    unsigned pre = 0u;
    for (unsigned j = 0; j < 16; ++j) { const unsigned c = xb_ld(&bar[XB_XCNT(j)]); if (j < b.x) pre += c; }
    ((volatile LAS unsigned*)smem_all)[2] = pre + b.rank;
  }
  __syncthreads();
  const int bid = __builtin_amdgcn_readfirstlane((int)((volatile LAS unsigned*)smem_all)[2]);
  LAYER_PROGRAM(0)
  LAYER_PROGRAM(1)
  ph_out(p, bid, smem);
}

extern "C" void kernel_launch(void* const* d_in, const int* in_sizes, int n_in, void* d_out, int out_size, void* d_ws,
                              size_t ws_size, hipStream_t stream) {
  P p{};
  const float* const* in = (const float* const*)d_in;
  p.x = in[0]; p.c = in[1]; p.ctx = in[2]; p.c_ctx = in[3]; p.mod_w = in[4]; p.mod_b = in[5]; p.norm1_w = in[6];
  p.w_in = in[7]; p.q_norm_w = in[8]; p.kv_norm_w = in[9]; p.w_uq = in[10]; p.w_ukv = in[11]; p.conv_w = in[12];
  p.conv_b = in[13]; p.a_log = in[14]; p.dt_bias = in[15]; p.ssd_d = in[16]; p.gate_b = in[17]; p.lam_re = in[18];
  p.lam_im = in[19]; p.log_dt = in[20]; p.b_re = in[21]; p.b_im = in[22]; p.c_re = in[23]; p.c_im = in[24];
  p.s5_d = in[25]; p.glu_w = in[26]; p.glu_b = in[27]; p.out_norm_w = in[28]; p.w_out = in[29]; p.norm2_w = in[30];
  p.w_group = in[31]; p.w_expert = in[32]; p.w_gate = in[33]; p.w_up = in[34]; p.w_down = in[35]; p.final_w = in[36];
  p.out = (float*)d_out;
  p.ws = (float*)d_ws;
  (void)ws_size; (void)in_sizes; (void)n_in; (void)out_size;

  unsigned* bar = (unsigned*)((float*)d_ws + WO_bar);
  static int grid = 0;
  if (!grid) {
    int dev = 0, cus = 0, per_cu = 0;
    hipGetDevice(&dev);
    hipDeviceGetAttribute(&cus, hipDeviceAttributeMultiprocessorCount, dev);
    (void)hipFuncSetAttribute((const void*)k_fused, hipFuncAttributeMaxDynamicSharedMemorySize, SMEM_BYTES + 64);
    (void)hipOccupancyMaxActiveBlocksPerMultiprocessor(&per_cu, k_fused, 256, SMEM_BYTES + 64);
    if (per_cu < 1) per_cu = 1;
    grid = cus * (per_cu < 2 ? per_cu : 2);
  }
  hipMemsetAsync(bar, 0, XCD_BAR_WORDS * sizeof(unsigned), stream);
  hipLaunchKernelGGL(k_fused, dim3(grid), dim3(256), SMEM_BYTES + 64, stream, p, bar);
}
```
